# Optimizing an MI355X kernel written in HIP

```python
import math
import jax, jax.numpy as jnp
from jax import lax
import numpy as np

D_MODEL = 1024
BATCH = 8
SEQ = 2048
DEPTH = 2

SSM_WIDTH = D_MODEL
MLSTM_WIDTH = D_MODEL
MIX_WIDTH = SSM_WIDTH + MLSTM_WIDTH
SSM_GROUP = 16
SSM_GROUPS = SSM_WIDTH // SSM_GROUP
SSM_STATE = 64
MLSTM_HEADS = 4
MLSTM_HEAD_DIM = MLSTM_WIDTH // MLSTM_HEADS
CONV_WIDTH = 4
MLSTM_CHUNK = 64
IN_COLS = 2 * SSM_WIDTH + 3 * MLSTM_WIDTH
EPS = 1e-6

kernel_name = "hybrid_s5_mlstm_parallel_heads"


def rms_norm(x, gain):
    xf = x.astype(jnp.float32)
    y = xf * lax.rsqrt(jnp.mean(xf * xf, axis=-1, keepdims=True) + EPS)
    return y * gain.astype(jnp.float32)


def s5_branch(u, lam_re, lam_im, log_dt, b_re, b_im, c_re, c_im, d_skip, w_glu, b_glu):
    bsz, seq, _ = u.shape
    f32 = jnp.float32
    uf = u.astype(f32).reshape(bsz, seq, SSM_GROUPS, SSM_GROUP)
    lam = lax.complex(lam_re.astype(f32), lam_im.astype(f32))
    dt = jnp.exp(log_dt.astype(f32))[:, None]
    a_bar = jnp.exp(lam * dt)
    b_cplx = lax.complex(b_re.astype(f32), b_im.astype(f32))
    b_bar = ((a_bar - 1.0) / lam)[..., None] * b_cplx
    bu = jnp.einsum('bsgc,gpc->bsgp', uf.astype(jnp.complex64), b_bar)
    a_seq = jnp.broadcast_to(a_bar, (1, seq) + a_bar.shape)

    def combine(left, right):
        a_l, b_l = left
        a_r, b_r = right
        return a_r * a_l, a_r * b_l + b_r

    _, states = lax.associative_scan(combine, (a_seq, bu), axis=1)
    c_cplx = lax.complex(c_re.astype(f32), c_im.astype(f32))
    y = jnp.real(jnp.einsum('bsgp,gcp->bsgc', states, c_cplx))
    y = y + d_skip.astype(f32).reshape(SSM_GROUPS, SSM_GROUP) * uf
    y = jax.nn.gelu(y.reshape(bsz, seq, SSM_WIDTH))
    return y * jax.nn.sigmoid(y @ w_glu.astype(f32) + b_glu.astype(f32))


def mlstm_cell(q, k, v, i_pre, log_f):
    bsz, nh, seq, dh = q.shape
    L = MLSTM_CHUNK
    nc = seq // L

    def to_chunks(t):
        t = t.reshape((bsz, nh, nc, L) + t.shape[3:])
        return jnp.moveaxis(t, 2, 0)

    causal = jnp.tril(jnp.ones((L, L), dtype=bool))

    def step(carry, inp):
        c_mat, n_vec, m_prev = carry
        q_, k_, v_, i_, lf = inp
        b = jnp.cumsum(lf, axis=-1)
        b_tot = b[..., -1]
        log_d = jnp.where(causal, b[..., :, None] - b[..., None, :] + i_[..., None, :], -jnp.inf)
        m_inter = b + m_prev[..., None]
        m_t = jnp.maximum(m_inter, jnp.max(log_d, axis=-1))
        w_inter = jnp.exp(m_inter - m_t)
        s = jnp.einsum('bhld,bhsd->bhls', q_, k_) * jnp.exp(log_d - m_t[..., None])
        num = (w_inter[..., None] * jnp.einsum('bhvd,bhld->bhlv', c_mat, q_)
               + jnp.einsum('bhls,bhsv->bhlv', s, v_))
        den = w_inter * jnp.einsum('bhd,bhld->bhl', n_vec, q_) + jnp.sum(s, axis=-1)
        h = num / jnp.maximum(jnp.abs(den), jnp.exp(-m_t))[..., None]
        log_w = b_tot[..., None] - b + i_
        m_next = jnp.maximum(b_tot + m_prev, jnp.max(log_w, axis=-1))
        decay = jnp.exp(b_tot + m_prev - m_next)
        w = jnp.exp(log_w - m_next[..., None])
        c_mat = decay[..., None, None] * c_mat + jnp.einsum('bhs,bhsv,bhsd->bhvd', w, v_, k_)
        n_vec = decay[..., None] * n_vec + jnp.einsum('bhs,bhsd->bhd', w, k_)
        return (c_mat, n_vec, m_next), h

    init = (jnp.zeros((bsz, nh, dh, dh), jnp.float32),
            jnp.zeros((bsz, nh, dh), jnp.float32),
            jnp.zeros((bsz, nh), jnp.float32))
    _, hs = lax.scan(step, init, (to_chunks(q), to_chunks(k), to_chunks(v),
                                  to_chunks(i_pre), to_chunks(log_f)))
    return jnp.moveaxis(hs, 0, 2).reshape(bsz, nh, seq, dh)


def mlstm_branch(xm, o_pre, conv_w, conv_b, wq, wk, wv, w_gates, b_igate, b_fgate, norm_gain, skip):
    bsz, seq, _ = xm.shape
    f32 = jnp.float32
    H, dh = MLSTM_HEADS, MLSTM_HEAD_DIM
    xc = lax.conv_general_dilated(
        xm, conv_w[:, None, :].astype(xm.dtype), window_strides=(1,),
        padding=[(CONV_WIDTH - 1, 0)], dimension_numbers=('NWC', 'WIO', 'NWC'),
        feature_group_count=MLSTM_WIDTH)
    xc = jax.nn.silu(xc.astype(f32) + conv_b.astype(f32))
    xmf = xm.astype(f32)
    q = jnp.einsum('bshd,hde->bshe', xc.reshape(bsz, seq, H, dh), wq.astype(f32))
    k = jnp.einsum('bshd,hde->bshe', xc.reshape(bsz, seq, H, dh), wk.astype(f32)) * (dh ** -0.5)
    v = jnp.einsum('bshd,hde->bshe', xmf.reshape(bsz, seq, H, dh), wv.astype(f32))
    qkv = jnp.concatenate([q.reshape(bsz, seq, -1), k.reshape(bsz, seq, -1),
                           v.reshape(bsz, seq, -1)], axis=-1)
    gates = qkv @ w_gates.astype(f32)
    i_pre = gates[..., :H] + b_igate.astype(f32)
    log_f = jax.nn.log_sigmoid(gates[..., H:] + b_fgate.astype(f32))
    h = mlstm_cell(q.transpose(0, 2, 1, 3), k.transpose(0, 2, 1, 3), v.transpose(0, 2, 1, 3),
                   i_pre.transpose(0, 2, 1), log_f.transpose(0, 2, 1))
    h = h.transpose(0, 2, 1, 3) * jax.nn.sigmoid(o_pre.astype(f32)).reshape(bsz, seq, H, dh)
    mu = jnp.mean(h, axis=-1, keepdims=True)
    var = jnp.mean(jnp.square(h - mu), axis=-1, keepdims=True)
    hn = ((h - mu) * lax.rsqrt(var + EPS)).reshape(bsz, seq, MLSTM_WIDTH) * norm_gain.astype(f32)
    return hn + skip.astype(f32) * xc


def hybrid_layer(x, cond, norm_gain, w_mod, b_mod, w_in,
                 ssm_lambda_re, ssm_lambda_im, ssm_log_dt, ssm_b_re, ssm_b_im, ssm_c_re, ssm_c_im,
                 ssm_d, ssm_w_glu, ssm_b_glu, ssm_out_gain,
                 m_conv_w, m_conv_b, m_wq, m_wk, m_wv, m_w_gates, m_b_igate, m_b_fgate,
                 m_norm_gain, m_skip, w_out):
    mod = jax.nn.silu(cond) @ w_mod + b_mod
    shift, scale, gate = jnp.split(mod.astype(jnp.float32), 3, axis=-1)
    h = (rms_norm(x, norm_gain) * (1.0 + scale[:, None, :]) + shift[:, None, :]).astype(x.dtype)
    proj = h @ w_in
    w = SSM_WIDTH
    ssm_in, ssm_gate, m_in, m_o, m_gate = jnp.split(
        proj, [w, 2 * w, 2 * w + MLSTM_WIDTH, 2 * w + 2 * MLSTM_WIDTH], axis=-1)
    ssm_y = s5_branch(ssm_in, ssm_lambda_re, ssm_lambda_im, ssm_log_dt, ssm_b_re, ssm_b_im,
                      ssm_c_re, ssm_c_im, ssm_d, ssm_w_glu, ssm_b_glu)
    ssm_y = rms_norm(ssm_y, ssm_out_gain) * jax.nn.silu(ssm_gate.astype(jnp.float32))
    m_y = mlstm_branch(m_in, m_o, m_conv_w, m_conv_b, m_wq, m_wk, m_wv, m_w_gates,
                       m_b_igate, m_b_fgate, m_norm_gain, m_skip)
    m_y = m_y * jax.nn.silu(m_gate.astype(jnp.float32))
    mixed = jnp.concatenate([ssm_y, m_y], axis=-1).astype(x.dtype)
    out = mixed @ w_out
    return (x.astype(jnp.float32) + gate[:, None, :] * out.astype(jnp.float32)).astype(x.dtype)


def setup_inputs(seed: int = 0) -> dict:
    key = jax.random.key(seed)
    ks = list(jax.random.split(key, 32))
    ctr = [0]

    def nk():
        ctr[0] += 1
        return ks[ctr[0] - 1]

    def nrm(shape, scale):
        return jax.random.normal(nk(), shape, jnp.float32) * scale

    L, D, W, MW = DEPTH, D_MODEL, SSM_WIDTH, MLSTM_WIDTH
    G, P, Cg = SSM_GROUPS, SSM_STATE, SSM_GROUP
    H, dh = MLSTM_HEADS, MLSTM_HEAD_DIM
    n_idx = jnp.arange(P, dtype=jnp.float32)[None, None, :]
    return {
        "x": nrm((BATCH, SEQ, D), 1.0),
        "c": nrm((BATCH, D), 1.0),
        "norm_gain": 1.0 + nrm((L, D), 0.02),
        "w_mod": nrm((L, D, 3 * D), 0.5 * D ** -0.5),
        "b_mod": nrm((L, 3 * D), 0.02),
        "w_in": nrm((L, D, IN_COLS), D ** -0.5),
        "ssm_lambda_re": -0.5 + nrm((L, G, P), 0.01),
        "ssm_lambda_im": math.pi * n_idx + nrm((L, G, P), 0.01),
        "ssm_log_dt": jax.random.uniform(nk(), (L, G), jnp.float32,
                                         minval=math.log(1e-3), maxval=math.log(1e-1)),
        "ssm_b_re": nrm((L, G, P, Cg), (2 * Cg) ** -0.5),
        "ssm_b_im": nrm((L, G, P, Cg), (2 * Cg) ** -0.5),
        "ssm_c_re": nrm((L, G, Cg, P), 0.5),
        "ssm_c_im": nrm((L, G, Cg, P), 0.5),
        "ssm_d": nrm((L, W), 1.0),
        "ssm_w_glu": nrm((L, W, W), W ** -0.5),
        "ssm_b_glu": nrm((L, W), 0.02),
        "ssm_out_gain": 1.0 + nrm((L, W), 0.02),
        "m_conv_w": nrm((L, CONV_WIDTH, MW), CONV_WIDTH ** -0.5),
        "m_conv_b": nrm((L, MW), 0.02),
        "m_wq": nrm((L, H, dh, dh), dh ** -0.5),
        "m_wk": nrm((L, H, dh, dh), dh ** -0.5),
        "m_wv": nrm((L, H, dh, dh), dh ** -0.5),
        "m_w_gates": nrm((L, 3 * MW, 2 * H), 0.1 * (3 * MW) ** -0.5),
        "m_b_igate": nrm((L, H), 0.1),
        "m_b_fgate": jnp.linspace(3.0, 6.0, H, dtype=jnp.float32)[None, :] + nrm((L, H), 0.1),
        "m_norm_gain": 1.0 + nrm((L, MW), 0.02),
        "m_skip": 1.0 + nrm((L, MW), 0.02),
        "w_out": nrm((L, MIX_WIDTH, D), MIX_WIDTH ** -0.5),
        "final_gain": 1.0 + nrm((D,), 0.02),
    }


def reference(x, c, norm_gain, w_mod, b_mod, w_in,
              ssm_lambda_re, ssm_lambda_im, ssm_log_dt, ssm_b_re, ssm_b_im, ssm_c_re, ssm_c_im,
              ssm_d, ssm_w_glu, ssm_b_glu, ssm_out_gain,
              m_conv_w, m_conv_b, m_wq, m_wk, m_wv, m_w_gates, m_b_igate, m_b_fgate,
              m_norm_gain, m_skip, w_out, final_gain):
    h = x
    for l in range(DEPTH):
        h = hybrid_layer(h, c, norm_gain[l], w_mod[l], b_mod[l], w_in[l],
                         ssm_lambda_re[l], ssm_lambda_im[l], ssm_log_dt[l], ssm_b_re[l], ssm_b_im[l],
                         ssm_c_re[l], ssm_c_im[l], ssm_d[l], ssm_w_glu[l], ssm_b_glu[l], ssm_out_gain[l],
                         m_conv_w[l], m_conv_b[l], m_wq[l], m_wk[l], m_wv[l], m_w_gates[l],
                         m_b_igate[l], m_b_fgate[l], m_norm_gain[l], m_skip[l], w_out[l])
    return rms_norm(h, final_gain).astype(x.dtype)
```

```cpp
#include <hip/hip_runtime.h>
#include <cstdio>
#include <cstdint>

typedef unsigned short bf16_t;
#define DEV __device__ __forceinline__

constexpr int BATCH = 8, SEQ = 2048, DM = 1024, MTOK = BATCH * SEQ;
constexpr int NG = 64, NP = 64, GC = 16, NH = 4, DH = 256, CHUNK = 64, INC = 5120;
constexpr float EPS = 1e-6f;

DEV float bf2f(bf16_t v) { return __uint_as_float(((unsigned)v) << 16); }
DEV bf16_t f2bf(float f) { unsigned u = __float_as_uint(f); return (bf16_t)((u + 0x7fffu + ((u >> 16) & 1u)) >> 16); }
DEV float sigmoidf_(float x) { return 1.f / (1.f + __expf(-x)); }
DEV float siluf_(float x) { return x / (1.f + __expf(-x)); }
DEV float geluf_(float x) { float t = 0.7978845608028654f * (x + 0.044715f * x * x * x); return 0.5f * x * (1.f + tanhf(t)); }
DEV float logsigmoidf_(float x) { return fminf(x, 0.f) - log1pf(__expf(-fabsf(x))); }

DEV float wave_sum(float v) {
#pragma unroll
    for (int o = 1; o < 64; o <<= 1) v += __shfl_xor(v, o);
    return v;
}
DEV float block_sum256(float v, float* red) {
    v = wave_sum(v);
    __syncthreads();
    if ((threadIdx.x & 63) == 0) red[threadIdx.x >> 6] = v;
    __syncthreads();
    return red[0] + red[1] + red[2] + red[3];
}

__global__ __launch_bounds__(256) void k_mod(const float* c, const float* w_mod, const float* b_mod, float* mod) {
    __shared__ float sc[BATCH][DM];
    const int l = blockIdx.y, n = blockIdx.x * 256 + threadIdx.x;
    for (int i = threadIdx.x; i < BATCH * DM; i += 256) sc[i / DM][i % DM] = siluf_(c[i]);
    __syncthreads();
    float acc[BATCH];
#pragma unroll
    for (int b = 0; b < BATCH; ++b) acc[b] = 0.f;
    const float* W = w_mod + (size_t)l * DM * 3 * DM;
    for (int k = 0; k < DM; ++k) {
        float w = W[(size_t)k * 3 * DM + n];
#pragma unroll
        for (int b = 0; b < BATCH; ++b) acc[b] += sc[b][k] * w;
    }
#pragma unroll
    for (int b = 0; b < BATCH; ++b) mod[((size_t)l * BATCH + b) * 3 * DM + n] = acc[b] + b_mod[l * 3 * DM + n];
}

__global__ __launch_bounds__(256) void k_norm_mod(const float* x, const float* gain, const float* mod  , bf16_t* h) {
    __shared__ float red[4];
    const int m = blockIdx.x, b = m / SEQ, t = threadIdx.x;
    const float4 v = ((const float4*)(x + (size_t)m * DM))[t];
    float ss = v.x * v.x + v.y * v.y + v.z * v.z + v.w * v.w;
    ss = block_sum256(ss, red);
    const float rstd = rsqrtf(ss * (1.f / DM) + EPS);
    const float* shift = mod + (size_t)b * 3 * DM;
    const float* scale = shift + DM;
    float xv[4] = {v.x, v.y, v.z, v.w};
#pragma unroll
    for (int i = 0; i < 4; ++i) {
        int n = t * 4 + i;
        float y = xv[i] * rstd * gain[n] * (1.f + scale[n]) + shift[n];
        h[(size_t)m * DM + n] = f2bf(y);
    }
}

struct GemmP {
    const bf16_t* A; const bf16_t* A2; int lda; int ksplit;
    const float* B; int ldb;
    int K;
    bf16_t* C; int ldc;
    float scale;
    const float* bias; const bf16_t* Y;
    const float* xin; float* xout; const float* gate;
    long zA, zB, zC;
};
enum { EPI_STORE = 0, EPI_GLU = 1, EPI_RES = 2 };

template <int EPI>
__global__ __launch_bounds__(256) void k_gemm(GemmP p) {
    __shared__ float As[16][68];
    __shared__ float Bs[16][68];
    const int tid = threadIdx.x, tx = tid & 15, ty = tid >> 4;
    const int m0 = blockIdx.y * 64, n0 = blockIdx.x * 64, z = blockIdx.z;
    const bf16_t* A = p.A + z * p.zA; const bf16_t* A2 = p.A2 ? p.A2 + z * p.zA : nullptr;
    const float* B = p.B + z * p.zB;
    float acc[4][4];
#pragma unroll
    for (int i = 0; i < 4; ++i)
#pragma unroll
        for (int j = 0; j < 4; ++j) acc[i][j] = 0.f;
    const int ar = tid >> 2, ak = (tid & 3) * 4;
    const int bk = tid >> 4, bn = (tid & 15) * 4;
    for (int k0 = 0; k0 < p.K; k0 += 16) {
        const bf16_t* Ap = (k0 < p.ksplit) ? (A + (size_t)(m0 + ar) * p.lda + k0 + ak) : (A2 + (size_t)(m0 + ar) * p.lda + (k0 - p.ksplit) + ak);
        const uint2 av = *(const uint2*)Ap;
        As[ak + 0][ar] = bf2f((bf16_t)(av.x & 0xffff)); As[ak + 1][ar] = bf2f((bf16_t)(av.x >> 16));
        As[ak + 2][ar] = bf2f((bf16_t)(av.y & 0xffff)); As[ak + 3][ar] = bf2f((bf16_t)(av.y >> 16));
        const float4 bv = *(const float4*)(B + (size_t)(k0 + bk) * p.ldb + n0 + bn);
        Bs[bk][bn + 0] = bv.x; Bs[bk][bn + 1] = bv.y; Bs[bk][bn + 2] = bv.z; Bs[bk][bn + 3] = bv.w;
        __syncthreads();
#pragma unroll
        for (int kk = 0; kk < 16; ++kk) {
            float a[4], b[4];
#pragma unroll
            for (int i = 0; i < 4; ++i) a[i] = As[kk][ty * 4 + i];
#pragma unroll
            for (int j = 0; j < 4; ++j) b[j] = Bs[kk][tx * 4 + j];
#pragma unroll
            for (int i = 0; i < 4; ++i)
#pragma unroll
                for (int j = 0; j < 4; ++j) acc[i][j] += a[i] * b[j];
        }
        __syncthreads();
    }
#pragma unroll
    for (int i = 0; i < 4; ++i) {
        const int m = m0 + ty * 4 + i;
#pragma unroll
        for (int j = 0; j < 4; ++j) {
            const int n = n0 + tx * 4 + j;
            float v = acc[i][j];
            if (EPI == EPI_STORE) {
                p.C[z * p.zC + (size_t)m * p.ldc + n] = f2bf(v * p.scale);
            } else if (EPI == EPI_GLU) {
                float y = bf2f(p.Y[(size_t)m * DM + n]);
                p.C[(size_t)m * p.ldc + n] = f2bf(y * sigmoidf_(v + p.bias[n]));
            } else {
                const int b = m / SEQ;
                p.xout[(size_t)m * DM + n] = p.xin[(size_t)m * DM + n] + p.gate[(size_t)b * 3 * DM + n] * v;
            }
        }
    }
}

__global__ __launch_bounds__(64) void k_s5(const bf16_t* u, bf16_t* y, const float* lam_re, const float* lam_im, const float* log_dt,
                                           const float* b_re, const float* b_im, const float* c_re, const float* c_im, const float* dskip) {
    __shared__ float part[64][17];
    const int g = blockIdx.x & 63, b = blockIdx.x >> 6, p = threadIdx.x;
    const double lr = lam_re[g * NP + p], li = lam_im[g * NP + p], dt = exp((double)log_dt[g]);
    const double er = exp(lr * dt);
    const double ard = er * cos(li * dt), aid = er * sin(li * dt);
    const double dr = ard - 1.0, di = aid, den = lr * lr + li * li;
    const double cr = (dr * lr + di * li) / den, ci = (di * lr - dr * li) / den;
    float bbr[16], bbi[16], ccr[16], cci[16];
#pragma unroll
    for (int c = 0; c < 16; ++c) {
        const double br = b_re[(g * NP + p) * GC + c], bi = b_im[(g * NP + p) * GC + c];
        bbr[c] = (float)(cr * br - ci * bi); bbi[c] = (float)(cr * bi + ci * br);
        ccr[c] = c_re[(g * GC + c) * NP + p]; cci[c] = c_im[(g * GC + c) * NP + p];
    }
    const float ar = (float)ard, ai = (float)aid;
    const float dsk = dskip[g * GC + (p & 15)];
    float sr = 0.f, si = 0.f;
    for (int t = 0; t < SEQ; ++t) {
        const bf16_t* up = u + (size_t)(b * SEQ + t) * DM + g * GC;
        const uint4 u0 = *(const uint4*)up, u1 = *(const uint4*)(up + 8);
        float uf[16];
        uf[0] = bf2f(u0.x & 0xffff); uf[1] = bf2f(u0.x >> 16); uf[2] = bf2f(u0.y & 0xffff); uf[3] = bf2f(u0.y >> 16);
        uf[4] = bf2f(u0.z & 0xffff); uf[5] = bf2f(u0.z >> 16); uf[6] = bf2f(u0.w & 0xffff); uf[7] = bf2f(u0.w >> 16);
        uf[8] = bf2f(u1.x & 0xffff); uf[9] = bf2f(u1.x >> 16); uf[10] = bf2f(u1.y & 0xffff); uf[11] = bf2f(u1.y >> 16);
        uf[12] = bf2f(u1.z & 0xffff); uf[13] = bf2f(u1.z >> 16); uf[14] = bf2f(u1.w & 0xffff); uf[15] = bf2f(u1.w >> 16);
        float bur = 0.f, bui = 0.f;
#pragma unroll
        for (int c = 0; c < 16; ++c) { bur += bbr[c] * uf[c]; bui += bbi[c] * uf[c]; }
        const float nr = ar * sr - ai * si + bur, ni = ar * si + ai * sr + bui;
        sr = nr; si = ni;
#pragma unroll
        for (int c = 0; c < 16; ++c) part[p][c] = ccr[c] * sr - cci[c] * si;
        __syncthreads();
        float s = 0.f;
#pragma unroll
        for (int k = 0; k < 16; ++k) s += part[(p >> 4) * 16 + k][p & 15];
        s += __shfl_xor(s, 16); s += __shfl_xor(s, 32);
        if (p < 16) {
            const float yv = s + dsk * bf2f(up[p]);
            y[(size_t)(b * SEQ + t) * DM + g * GC + p] = f2bf(geluf_(yv));
        }
        __syncthreads();
    }
}

__global__ __launch_bounds__(256) void k_ssm_post(bf16_t* z, const bf16_t* sg, const float* gain) {
    __shared__ float red[4];
    const int m = blockIdx.x, t = threadIdx.x;
    float zv[4]; float ss = 0.f;
#pragma unroll
    for (int i = 0; i < 4; ++i) { zv[i] = bf2f(z[(size_t)m * DM + t * 4 + i]); ss += zv[i] * zv[i]; }
    ss = block_sum256(ss, red);
    const float rstd = rsqrtf(ss * (1.f / DM) + EPS);
#pragma unroll
    for (int i = 0; i < 4; ++i) {
        const int n = t * 4 + i;
        z[(size_t)m * DM + n] = f2bf(zv[i] * rstd * gain[n] * siluf_(bf2f(sg[(size_t)m * DM + n])));
    }
}

DEV float conv_xc(const bf16_t* mi, int m, int n, const float* cw, const float* cb) {
    const int t = m % SEQ;
    float acc = cb[n];
#pragma unroll
    for (int j = 0; j < 4; ++j) {
        const int tt = t - 3 + j;
        if (tt >= 0) acc += bf2f(mi[(size_t)(m - 3 + j) * DM + n]) * cw[j * DM + n];
    }
    return siluf_(acc);
}
__global__ __launch_bounds__(256) void k_conv(const bf16_t* mi, bf16_t* xc, const float* cw, const float* cb) {
    const size_t idx = (size_t)blockIdx.x * 256 + threadIdx.x;
    const int m = (int)(idx / DM), n = (int)(idx % DM);
    xc[idx] = f2bf(conv_xc(mi, m, n, cw, cb));
}

__global__ __launch_bounds__(256) void k_gates(const bf16_t* q, const bf16_t* k, const bf16_t* v, const float* wg  , const float* bi, const float* bfg,
                                               float* ipre, float* logf) {
    __shared__ float red[4][8];
    const int m = blockIdx.x, t = threadIdx.x;
    float acc[8];
#pragma unroll
    for (int j = 0; j < 8; ++j) acc[j] = 0.f;
    for (int e = t; e < 3 * DM; e += 256) {
        const bf16_t* src = (e < DM) ? q : (e < 2 * DM ? k : v);
        const float xv = bf2f(src[(size_t)m * DM + (e & (DM - 1))]);
#pragma unroll
        for (int j = 0; j < 8; ++j) acc[j] += xv * wg[e * 8 + j];
    }
#pragma unroll
    for (int j = 0; j < 8; ++j) acc[j] = wave_sum(acc[j]);
    if ((t & 63) == 0) {
#pragma unroll
        for (int j = 0; j < 8; ++j) red[t >> 6][j] = acc[j];
    }
    __syncthreads();
    if (t < 8) {
        const float s = red[0][t] + red[1][t] + red[2][t] + red[3][t];
        if (t < 4) ipre[(size_t)m * 4 + t] = s + bi[t];
        else logf[(size_t)m * 4 + (t - 4)] = logsigmoidf_(s + bfg[t - 4]);
    }
}

__global__ __launch_bounds__(256) void k_mlstm(const bf16_t* q, const bf16_t* k, const bf16_t* v, const float* ipre, const float* logf, bf16_t* hc) {
    __shared__ float Cs[32][257];
    __shared__ float St[64][65];
    __shared__ float nvec[256];
    __shared__ float bcum[64], ig[64], mt[64], winter[64], ws_[64], hden[64];
    __shared__ float sc[4];
    const int tid = threadIdx.x;
    const int vs = blockIdx.x & 7, h = (blockIdx.x >> 3) & 3, b = blockIdx.x >> 5;
    for (int i = tid; i < 32 * 257; i += 256) (&Cs[0][0])[i] = 0.f;
    nvec[tid] = 0.f;
    if (tid == 0) sc[0] = 0.f;
    __syncthreads();
    const size_t base = (size_t)b * SEQ * DM + h * DH;
    for (int j = 0; j < SEQ / CHUNK; ++j) {
        const size_t cb = base + (size_t)j * CHUNK * DM;
        const int m0 = b * SEQ + j * CHUNK;
        if (tid < 64) {
            ig[tid] = ipre[(size_t)(m0 + tid) * 4 + h];
            ws_[tid] = logf[(size_t)(m0 + tid) * 4 + h];
        }
        __syncthreads();
        if (tid < 64) { float s = 0.f; for (int i = 0; i <= tid; ++i) s += ws_[i]; bcum[tid] = s; }
        __syncthreads();
        const float m_prev = sc[0];
        if (tid < 64) {
            const float m_inter = bcum[tid] + m_prev;
            float mx = -INFINITY;
            for (int s = 0; s <= tid; ++s) mx = fmaxf(mx, bcum[tid] - bcum[s] + ig[s]);
            const float m = fmaxf(m_inter, mx);
            mt[tid] = m; winter[tid] = __expf(m_inter - m);
        }
        __syncthreads();
        for (int idx = tid; idx < 4096; idx += 256) {
            const int t = idx >> 6, s = idx & 63;
            float r = 0.f;
            if (s <= t) {
                const bf16_t* qp = q + cb + (size_t)t * DM; const bf16_t* kp = k + cb + (size_t)s * DM;
                float dot = 0.f;
                for (int d = 0; d < DH; d += 8) {
                    const uint4 qa = *(const uint4*)(qp + d), ka = *(const uint4*)(kp + d);
                    dot += bf2f(qa.x & 0xffff) * bf2f(ka.x & 0xffff) + bf2f(qa.x >> 16) * bf2f(ka.x >> 16);
                    dot += bf2f(qa.y & 0xffff) * bf2f(ka.y & 0xffff) + bf2f(qa.y >> 16) * bf2f(ka.y >> 16);
                    dot += bf2f(qa.z & 0xffff) * bf2f(ka.z & 0xffff) + bf2f(qa.z >> 16) * bf2f(ka.z >> 16);
                    dot += bf2f(qa.w & 0xffff) * bf2f(ka.w & 0xffff) + bf2f(qa.w >> 16) * bf2f(ka.w >> 16);
                }
                r = dot * __expf(bcum[t] - bcum[s] + ig[s] - mt[t]);
            }
            St[t][s] = r;
        }
        __syncthreads();
        if (tid < 64) {
            const bf16_t* qp = q + cb + (size_t)tid * DM;
            float dn = 0.f;
            for (int d = 0; d < DH; ++d) dn += nvec[d] * bf2f(qp[d]);
            float sm = 0.f;
            for (int s = 0; s < 64; ++s) sm += St[tid][s];
            const float den = winter[tid] * dn + sm;
            hden[tid] = fmaxf(fabsf(den), __expf(-mt[tid]));
        }
        __syncthreads();
        for (int idx = tid; idx < 2048; idx += 256) {
            const int t = idx >> 5, vv = idx & 31;
            const bf16_t* qp = q + cb + (size_t)t * DM;
            float a = 0.f;
            for (int d = 0; d < DH; ++d) a += Cs[vv][d] * bf2f(qp[d]);
            float s2 = 0.f;
            for (int s = 0; s < 64; ++s) s2 += St[t][s] * bf2f(v[cb + (size_t)s * DM + vs * 32 + vv]);
            const float num = winter[t] * a + s2;
            hc[cb + (size_t)t * DM + vs * 32 + vv] = f2bf(num / hden[t]);
        }
        __syncthreads();
        const float b_tot = bcum[63];
        if (tid < 64) ws_[tid] = b_tot - bcum[tid] + ig[tid];
        __syncthreads();
        if (tid == 0) {
            float mx = b_tot + m_prev;
            for (int s = 0; s < 64; ++s) mx = fmaxf(mx, ws_[s]);
            sc[1] = __expf(b_tot + m_prev - mx); sc[0] = mx;
        }
        __syncthreads();
        const float m_next = sc[0], decay = sc[1];
        float myw = 0.f;
        if (tid < 64) myw = __expf(ws_[tid] - m_next);
        __syncthreads();
        if (tid < 64) ws_[tid] = myw;
        __syncthreads();
        for (int idx = tid; idx < 32 * 256; idx += 256) {
            const int vv = idx >> 8, d = idx & 255;
            float a = 0.f;
            for (int s = 0; s < 64; ++s) a += ws_[s] * bf2f(v[cb + (size_t)s * DM + vs * 32 + vv]) * bf2f(k[cb + (size_t)s * DM + d]);
            Cs[vv][d] = decay * Cs[vv][d] + a;
        }
        {
            float a = 0.f;
            for (int s = 0; s < 64; ++s) a += ws_[s] * bf2f(k[cb + (size_t)s * DM + tid]);
            nvec[tid] = decay * nvec[tid] + a;
        }
        __syncthreads();
    }
}

__global__ __launch_bounds__(256) void k_mlstm_post(bf16_t* hc, const bf16_t* mo, const bf16_t* mg, const bf16_t* mi, const float* cw, const float* cb,
                                                    const float* ngain, const float* skip) {
    const int m = blockIdx.x, t = threadIdx.x;
    float hv[4]; float s = 0.f;
#pragma unroll
    for (int i = 0; i < 4; ++i) {
        const size_t o = (size_t)m * DM + t * 4 + i;
        hv[i] = bf2f(hc[o]) * sigmoidf_(bf2f(mo[o])); s += hv[i];
    }
    const float mu = wave_sum(s) * (1.f / DH);
    float s2 = 0.f;
#pragma unroll
    for (int i = 0; i < 4; ++i) { hv[i] -= mu; s2 += hv[i] * hv[i]; }
    const float rstd = rsqrtf(wave_sum(s2) * (1.f / DH) + EPS);
#pragma unroll
    for (int i = 0; i < 4; ++i) {
        const int n = t * 4 + i; const size_t o = (size_t)m * DM + n;
        const float xc = conv_xc(mi, m, n, cw, cb);
        const float hn = hv[i] * rstd * ngain[n] + skip[n] * xc;
        hc[o] = f2bf(hn * siluf_(bf2f(mg[o])));
    }
}

__global__ __launch_bounds__(256) void k_final(float* x, const float* gain) {
    __shared__ float red[4];
    const int m = blockIdx.x, t = threadIdx.x;
    float4 v = ((float4*)(x + (size_t)m * DM))[t];
    float ss = v.x * v.x + v.y * v.y + v.z * v.z + v.w * v.w;
    ss = block_sum256(ss, red);
    const float rstd = rsqrtf(ss * (1.f / DM) + EPS);
    const float4 g = ((const float4*)gain)[t];
    v.x *= rstd * g.x; v.y *= rstd * g.y; v.z *= rstd * g.z; v.w *= rstd * g.w;
    ((float4*)(x + (size_t)m * DM))[t] = v;
}

extern "C" void kernel_launch(void* const* d_in, const int* in_sizes, int n_in, void* d_out, int out_size, void* d_ws, size_t ws_size, hipStream_t stream) {
    const float* x = (const float*)d_in[0];
    const float* c = (const float*)d_in[1];
    const float* norm_gain = (const float*)d_in[2];
    const float* w_mod = (const float*)d_in[3];
    const float* b_mod = (const float*)d_in[4];
    const float* w_in = (const float*)d_in[5];
    const float* lam_re = (const float*)d_in[6];
    const float* lam_im = (const float*)d_in[7];
    const float* log_dt = (const float*)d_in[8];
    const float* sb_re = (const float*)d_in[9];
    const float* sb_im = (const float*)d_in[10];
    const float* sc_re = (const float*)d_in[11];
    const float* sc_im = (const float*)d_in[12];
    const float* ssm_d = (const float*)d_in[13];
    const float* w_glu = (const float*)d_in[14];
    const float* b_glu = (const float*)d_in[15];
    const float* ssm_og = (const float*)d_in[16];
    const float* conv_w = (const float*)d_in[17];
    const float* conv_b = (const float*)d_in[18];
    const float* wq = (const float*)d_in[19];
    const float* wk = (const float*)d_in[20];
    const float* wv = (const float*)d_in[21];
    const float* w_gates = (const float*)d_in[22];
    const float* b_ig = (const float*)d_in[23];
    const float* b_fg = (const float*)d_in[24];
    const float* m_ng = (const float*)d_in[25];
    const float* m_skip = (const float*)d_in[26];
    const float* w_out = (const float*)d_in[27];
    const float* final_gain = (const float*)d_in[28];
    float* out = (float*)d_out;
    char* ws = (char*)d_ws;
    const size_t SLOT = (size_t)MTOK * DM * 2;
    bf16_t* S[7];
    for (int i = 0; i < 7; ++i) S[i] = (bf16_t*)(ws + SLOT * i);
    char* misc = ws + SLOT * 7;
    float* mod = (float*)misc;
    float* ipre = (float*)(misc + (1 << 20));
    float* logf = (float*)(misc + (2 << 20));

    k_mod<<<dim3(12, 2), 256, 0, stream>>>(c, w_mod, b_mod, mod);
    for (int l = 0; l < 2; ++l) {
        const float* xin = (l == 0) ? x : out;
        const float* modl = mod + (size_t)l * BATCH * 3 * DM;
        const float* Win = w_in + (size_t)l * DM * INC;
        bf16_t *H = S[0], *U = S[1], *Y = S[2], *Z = S[3], *SG = S[4], *MI = S[5], *Q = S[6], *Kb = S[1], *V = S[2], *XC = S[4], *HC = S[4], *MO = S[1], *MG = S[2];
        k_norm_mod<<<MTOK, 256, 0, stream>>>(xin, norm_gain + l * DM, modl, H);
        GemmP g{}; g.A = H; g.A2 = nullptr; g.lda = DM; g.ksplit = 1 << 30; g.ldb = INC; g.K = DM; g.ldc = DM; g.scale = 1.f;
        g.B = Win + 0; g.C = U; k_gemm<EPI_STORE><<<dim3(16, 256, 1), 256, 0, stream>>>(g);
        g.B = Win + 1024; g.C = SG; k_gemm<EPI_STORE><<<dim3(16, 256, 1), 256, 0, stream>>>(g);
        k_s5<<<BATCH * NG, 64, 0, stream>>>(U, Y, lam_re + l * NG * NP, lam_im + l * NG * NP, log_dt + l * NG, sb_re + (size_t)l * NG * NP * GC, sb_im + (size_t)l * NG * NP * GC,
                                          sc_re + (size_t)l * NG * GC * NP, sc_im + (size_t)l * NG * GC * NP, ssm_d + l * DM);
        { GemmP e = g; e.A = Y; e.B = w_glu + (size_t)l * DM * DM; e.ldb = DM; e.C = Z; e.bias = b_glu + l * DM; e.Y = Y;
          k_gemm<EPI_GLU><<<dim3(16, 256, 1), 256, 0, stream>>>(e); }
        k_ssm_post<<<MTOK, 256, 0, stream>>>(Z, SG, ssm_og + l * DM);
        g.B = Win + 2048; g.C = MI; k_gemm<EPI_STORE><<<dim3(16, 256, 1), 256, 0, stream>>>(g);
        k_conv<<<MTOK * DM / 256, 256, 0, stream>>>(MI, XC, conv_w + l * 4 * DM, conv_b + l * DM);
        { GemmP e{}; e.lda = DM; e.ksplit = 1 << 30; e.ldb = DH; e.K = DH; e.ldc = DM; e.zA = DH; e.zB = DH * DH; e.zC = DH;
          e.A = XC; e.B = wq + (size_t)l * NH * DH * DH; e.C = Q; e.scale = 1.f; k_gemm<EPI_STORE><<<dim3(4, 256, 4), 256, 0, stream>>>(e);
          e.A = XC; e.B = wk + (size_t)l * NH * DH * DH; e.C = Kb; e.scale = 0.0625f; k_gemm<EPI_STORE><<<dim3(4, 256, 4), 256, 0, stream>>>(e);
          e.A = MI; e.B = wv + (size_t)l * NH * DH * DH; e.C = V; e.scale = 1.f; k_gemm<EPI_STORE><<<dim3(4, 256, 4), 256, 0, stream>>>(e); }
        k_gates<<<MTOK, 256, 0, stream>>>(Q, Kb, V, w_gates + (size_t)l * 3 * DM * 8, b_ig + l * 4, b_fg + l * 4, ipre, logf);
        k_mlstm<<<BATCH * NH * 8, 256, 0, stream>>>(Q, Kb, V, ipre, logf, HC);
        g.B = Win + 3072; g.C = MO; k_gemm<EPI_STORE><<<dim3(16, 256, 1), 256, 0, stream>>>(g);
        g.B = Win + 4096; g.C = MG; k_gemm<EPI_STORE><<<dim3(16, 256, 1), 256, 0, stream>>>(g);
        k_mlstm_post<<<MTOK, 256, 0, stream>>>(HC, MO, MG, MI, conv_w + l * 4 * DM, conv_b + l * DM, m_ng + l * DM, m_skip + l * DM);
        { GemmP e{}; e.A = Z; e.A2 = HC; e.lda = DM; e.ksplit = DM; e.B = w_out + (size_t)l * 2 * DM * DM; e.ldb = DM; e.K = 2 * DM;
          e.xin = xin; e.xout = out; e.gate = modl + 2 * DM;
          k_gemm<EPI_RES><<<dim3(16, 256, 1), 256, 0, stream>>>(e); }
    }
    k_final<<<MTOK, 256, 0, stream>>>(out, final_gain);
}
```

```cpp
#include <hip/hip_runtime.h>
#include <cstdio>
#include <cstdint>
#include <hip/hip_cooperative_groups.h>
namespace cg = cooperative_groups;

typedef unsigned short bf16_t;
#define DEV __device__ __forceinline__

constexpr int BATCH = 8, SEQ = 2048, DM = 1024, MTOK = BATCH * SEQ;
constexpr int NG = 64, NP = 64, GC = 16, NH = 4, DH = 256, CHUNK = 64, INC = 5120;
constexpr float EPS = 1e-6f;

DEV float bf2f(bf16_t v) { return __uint_as_float(((unsigned)v) << 16); }
DEV bf16_t f2bf(float f) { unsigned u = __float_as_uint(f); return (bf16_t)((u + 0x7fffu + ((u >> 16) & 1u)) >> 16); }
DEV float sigmoidf_(float x) { return 1.f / (1.f + __expf(-x)); }
DEV float siluf_(float x) { return x / (1.f + __expf(-x)); }
DEV float geluf_(float x) { float t = 0.7978845608028654f * (x + 0.044715f * x * x * x); return 0.5f * x * (1.f + tanhf(t)); }
DEV float logsigmoidf_(float x) { return fminf(x, 0.f) - log1pf(__expf(-fabsf(x))); }

DEV float wave_sum(float v) {
#pragma unroll
    for (int o = 1; o < 64; o <<= 1) v += __shfl_xor(v, o);
    return v;
}
DEV float block_sum256(float v, float* red) {
    v = wave_sum(v);
    __syncthreads();
    if ((threadIdx.x & 63) == 0) red[threadIdx.x >> 6] = v;
    __syncthreads();
    return red[0] + red[1] + red[2] + red[3];
}

DEV void k_mod(int vb, float* ldsf, const float* c, const float* w_mod, const float* b_mod, float* mod) {
    float (*sc)[DM] = (float (*)[DM])ldsf;
    const int l = vb / 12, n = (vb % 12) * 256 + threadIdx.x;
    __syncthreads();
    for (int i = threadIdx.x; i < BATCH * DM; i += 256) sc[i / DM][i % DM] = siluf_(c[i]);
    __syncthreads();
    float acc[BATCH];
#pragma unroll
    for (int b = 0; b < BATCH; ++b) acc[b] = 0.f;
    const float* W = w_mod + (size_t)l * DM * 3 * DM;
    for (int k = 0; k < DM; ++k) {
        float w = W[(size_t)k * 3 * DM + n];
#pragma unroll
        for (int b = 0; b < BATCH; ++b) acc[b] += sc[b][k] * w;
    }
#pragma unroll
    for (int b = 0; b < BATCH; ++b) mod[((size_t)l * BATCH + b) * 3 * DM + n] = acc[b] + b_mod[l * 3 * DM + n];
}

DEV void k_norm_mod(int vb, float* red, const float* x, const float* gain, const float* mod  , bf16_t* h) {
    const int m = vb, b = m / SEQ, t = threadIdx.x;
    const float4 v = ((const float4*)(x + (size_t)m * DM))[t];
    float ss = v.x * v.x + v.y * v.y + v.z * v.z + v.w * v.w;
    ss = block_sum256(ss, red);
    const float rstd = rsqrtf(ss * (1.f / DM) + EPS);
    const float* shift = mod + (size_t)b * 3 * DM;
    const float* scale = shift + DM;
    float xv[4] = {v.x, v.y, v.z, v.w};
#pragma unroll
    for (int i = 0; i < 4; ++i) {
        int n = t * 4 + i;
        float y = xv[i] * rstd * gain[n] * (1.f + scale[n]) + shift[n];
        h[(size_t)m * DM + n] = f2bf(y);
    }
}

struct GemmP {
    const bf16_t* A; const bf16_t* A2; int lda; int ksplit;
    const float* B; int ldb;
    int K;
    bf16_t* C; int ldc;
    float scale;
    const float* bias; const bf16_t* Y;
    const float* xin; float* xout; const float* gate;
    long zA, zB, zC;
};
enum { EPI_STORE = 0, EPI_GLU = 1, EPI_RES = 2 };

template <int EPI>
DEV void k_gemm(int vb, float* ldsf, const GemmP& p, int nbx, int nby) {
    float (*As)[68] = (float (*)[68])ldsf;
    float (*Bs)[68] = (float (*)[68])(ldsf + 16 * 68);
    const int tid = threadIdx.x, tx = tid & 15, ty = tid >> 4;
    const int bx_ = vb % nbx, by_ = (vb / nbx) % nby, z = vb / (nbx * nby);
    const int m0 = by_ * 64, n0 = bx_ * 64;
    const bf16_t* A = p.A + z * p.zA; const bf16_t* A2 = p.A2 ? p.A2 + z * p.zA : nullptr;
    const float* B = p.B + z * p.zB;
    float acc[4][4];
#pragma unroll
    for (int i = 0; i < 4; ++i)
#pragma unroll
        for (int j = 0; j < 4; ++j) acc[i][j] = 0.f;
    const int ar = tid >> 2, ak = (tid & 3) * 4;
    const int bk = tid >> 4, bn = (tid & 15) * 4;
    for (int k0 = 0; k0 < p.K; k0 += 16) {
        const bf16_t* Ap = (k0 < p.ksplit) ? (A + (size_t)(m0 + ar) * p.lda + k0 + ak) : (A2 + (size_t)(m0 + ar) * p.lda + (k0 - p.ksplit) + ak);
        const uint2 av = *(const uint2*)Ap;
        As[ak + 0][ar] = bf2f((bf16_t)(av.x & 0xffff)); As[ak + 1][ar] = bf2f((bf16_t)(av.x >> 16));
        As[ak + 2][ar] = bf2f((bf16_t)(av.y & 0xffff)); As[ak + 3][ar] = bf2f((bf16_t)(av.y >> 16));
        const float4 bv = *(const float4*)(B + (size_t)(k0 + bk) * p.ldb + n0 + bn);
        Bs[bk][bn + 0] = bv.x; Bs[bk][bn + 1] = bv.y; Bs[bk][bn + 2] = bv.z; Bs[bk][bn + 3] = bv.w;
        __syncthreads();
#pragma unroll
        for (int kk = 0; kk < 16; ++kk) {
            float a[4], b[4];
#pragma unroll
            for (int i = 0; i < 4; ++i) a[i] = As[kk][ty * 4 + i];
#pragma unroll
            for (int j = 0; j < 4; ++j) b[j] = Bs[kk][tx * 4 + j];
#pragma unroll
            for (int i = 0; i < 4; ++i)
#pragma unroll
                for (int j = 0; j < 4; ++j) acc[i][j] += a[i] * b[j];
        }
        __syncthreads();
    }
#pragma unroll
    for (int i = 0; i < 4; ++i) {
        const int m = m0 + ty * 4 + i;
#pragma unroll
        for (int j = 0; j < 4; ++j) {
            const int n = n0 + tx * 4 + j;
            float v = acc[i][j];
            if (EPI == EPI_STORE) {
                p.C[z * p.zC + (size_t)m * p.ldc + n] = f2bf(v * p.scale);
            } else if (EPI == EPI_GLU) {
                float y = bf2f(p.Y[(size_t)m * DM + n]);
                p.C[(size_t)m * p.ldc + n] = f2bf(y * sigmoidf_(v + p.bias[n]));
            } else {
                const int b = m / SEQ;
                p.xout[(size_t)m * DM + n] = p.xin[(size_t)m * DM + n] + p.gate[(size_t)b * 3 * DM + n] * v;
            }
        }
    }
}

DEV void k_s5(int item, float* ldsf, const bf16_t* u, bf16_t* y, const float* lam_re, const float* lam_im, const float* log_dt,
                                           const float* b_re, const float* b_im, const float* c_re, const float* c_im, const float* dskip) {
    float (*part)[17] = (float (*)[17])(ldsf + (threadIdx.x >> 6) * 64 * 17);
    const int g = item & 63, b = item >> 6, p = threadIdx.x & 63;
    const double lr = lam_re[g * NP + p], li = lam_im[g * NP + p], dt = exp((double)log_dt[g]);
    const double er = exp(lr * dt);
    const double ard = er * cos(li * dt), aid = er * sin(li * dt);
    const double dr = ard - 1.0, di = aid, den = lr * lr + li * li;
    const double cr = (dr * lr + di * li) / den, ci = (di * lr - dr * li) / den;
    float bbr[16], bbi[16], ccr[16], cci[16];
#pragma unroll
    for (int c = 0; c < 16; ++c) {
        const double br = b_re[(g * NP + p) * GC + c], bi = b_im[(g * NP + p) * GC + c];
        bbr[c] = (float)(cr * br - ci * bi); bbi[c] = (float)(cr * bi + ci * br);
        ccr[c] = c_re[(g * GC + c) * NP + p]; cci[c] = c_im[(g * GC + c) * NP + p];
    }
    const float ar = (float)ard, ai = (float)aid;
    const float dsk = dskip[g * GC + (p & 15)];
    float sr = 0.f, si = 0.f;
    for (int t = 0; t < SEQ; ++t) {
        const bf16_t* up = u + (size_t)(b * SEQ + t) * DM + g * GC;
        const uint4 u0 = *(const uint4*)up, u1 = *(const uint4*)(up + 8);
        float uf[16];
        uf[0] = bf2f(u0.x & 0xffff); uf[1] = bf2f(u0.x >> 16); uf[2] = bf2f(u0.y & 0xffff); uf[3] = bf2f(u0.y >> 16);
        uf[4] = bf2f(u0.z & 0xffff); uf[5] = bf2f(u0.z >> 16); uf[6] = bf2f(u0.w & 0xffff); uf[7] = bf2f(u0.w >> 16);
        uf[8] = bf2f(u1.x & 0xffff); uf[9] = bf2f(u1.x >> 16); uf[10] = bf2f(u1.y & 0xffff); uf[11] = bf2f(u1.y >> 16);
        uf[12] = bf2f(u1.z & 0xffff); uf[13] = bf2f(u1.z >> 16); uf[14] = bf2f(u1.w & 0xffff); uf[15] = bf2f(u1.w >> 16);
        float bur = 0.f, bui = 0.f;
#pragma unroll
        for (int c = 0; c < 16; ++c) { bur += bbr[c] * uf[c]; bui += bbi[c] * uf[c]; }
        const float nr = ar * sr - ai * si + bur, ni = ar * si + ai * sr + bui;
        sr = nr; si = ni;
#pragma unroll
        for (int c = 0; c < 16; ++c) part[p][c] = ccr[c] * sr - cci[c] * si;
        asm volatile("s_waitcnt lgkmcnt(0)" ::: "memory");
        float s = 0.f;
#pragma unroll
        for (int k = 0; k < 16; ++k) s += part[(p >> 4) * 16 + k][p & 15];
        s += __shfl_xor(s, 16); s += __shfl_xor(s, 32);
        if (p < 16) {
            const float yv = s + dsk * bf2f(up[p]);
            y[(size_t)(b * SEQ + t) * DM + g * GC + p] = f2bf(geluf_(yv));
        }
        asm volatile("s_waitcnt lgkmcnt(0)" ::: "memory");
    }
}

DEV void k_ssm_post(int vb, float* red, bf16_t* z, const bf16_t* sg, const float* gain) {
    const int m = vb, t = threadIdx.x;
    float zv[4]; float ss = 0.f;
#pragma unroll
    for (int i = 0; i < 4; ++i) { zv[i] = bf2f(z[(size_t)m * DM + t * 4 + i]); ss += zv[i] * zv[i]; }
    ss = block_sum256(ss, red);
    const float rstd = rsqrtf(ss * (1.f / DM) + EPS);
#pragma unroll
    for (int i = 0; i < 4; ++i) {
        const int n = t * 4 + i;
        z[(size_t)m * DM + n] = f2bf(zv[i] * rstd * gain[n] * siluf_(bf2f(sg[(size_t)m * DM + n])));
    }
}

DEV float conv_xc(const bf16_t* mi, int m, int n, const float* cw, const float* cb) {
    const int t = m % SEQ;
    float acc = cb[n];
#pragma unroll
    for (int j = 0; j < 4; ++j) {
        const int tt = t - 3 + j;
        if (tt >= 0) acc += bf2f(mi[(size_t)(m - 3 + j) * DM + n]) * cw[j * DM + n];
    }
    return siluf_(acc);
}
DEV void k_conv(int vb, const bf16_t* mi, bf16_t* xc, const float* cw, const float* cb) {
    const size_t idx = (size_t)vb * 256 + threadIdx.x;
    const int m = (int)(idx / DM), n = (int)(idx % DM);
    xc[idx] = f2bf(conv_xc(mi, m, n, cw, cb));
}

DEV void k_gates(int vb, float* ldsf, const bf16_t* q, const bf16_t* k, const bf16_t* v, const float* wg  , const float* bi, const float* bfg,
                                               float* ipre, float* logf) {
    float (*red)[8] = (float (*)[8])ldsf;
    const int m = vb, t = threadIdx.x;
    __syncthreads();
    float acc[8];
#pragma unroll
    for (int j = 0; j < 8; ++j) acc[j] = 0.f;
    for (int e = t; e < 3 * DM; e += 256) {
        const bf16_t* src = (e < DM) ? q : (e < 2 * DM ? k : v);
        const float xv = bf2f(src[(size_t)m * DM + (e & (DM - 1))]);
#pragma unroll
        for (int j = 0; j < 8; ++j) acc[j] += xv * wg[e * 8 + j];
    }
#pragma unroll
    for (int j = 0; j < 8; ++j) acc[j] = wave_sum(acc[j]);
    if ((t & 63) == 0) {
#pragma unroll
        for (int j = 0; j < 8; ++j) red[t >> 6][j] = acc[j];
    }
    __syncthreads();
    if (t < 8) {
        const float s = red[0][t] + red[1][t] + red[2][t] + red[3][t];
        if (t < 4) ipre[(size_t)m * 4 + t] = s + bi[t];
        else logf[(size_t)m * 4 + (t - 4)] = logsigmoidf_(s + bfg[t - 4]);
    }
}

DEV void k_mlstm(int vb, float* ldsf, const bf16_t* q, const bf16_t* k, const bf16_t* v, const float* ipre, const float* logf, bf16_t* hc) {
    float (*Cs)[257] = (float (*)[257])ldsf;
    float (*St)[65] = (float (*)[65])(ldsf + 32 * 257);
    float* nvec = ldsf + 32 * 257 + 64 * 65;
    float* bcum = nvec + 256; float* ig = bcum + 64; float* mt = ig + 64; float* winter = mt + 64; float* ws_ = winter + 64; float* hden = ws_ + 64;
    float* sc = hden + 64;
    const int tid = threadIdx.x;
    const int vs = vb & 7, h = (vb >> 3) & 3, b = vb >> 5;
    __syncthreads();
    for (int i = tid; i < 32 * 257; i += 256) (&Cs[0][0])[i] = 0.f;
    nvec[tid] = 0.f;
    if (tid == 0) sc[0] = 0.f;
    __syncthreads();
    const size_t base = (size_t)b * SEQ * DM + h * DH;
    for (int j = 0; j < SEQ / CHUNK; ++j) {
        const size_t cb = base + (size_t)j * CHUNK * DM;
        const int m0 = b * SEQ + j * CHUNK;
        if (tid < 64) {
            ig[tid] = ipre[(size_t)(m0 + tid) * 4 + h];
            ws_[tid] = logf[(size_t)(m0 + tid) * 4 + h];
        }
        __syncthreads();
        if (tid < 64) { float s = 0.f; for (int i = 0; i <= tid; ++i) s += ws_[i]; bcum[tid] = s; }
        __syncthreads();
        const float m_prev = sc[0];
        if (tid < 64) {
            const float m_inter = bcum[tid] + m_prev;
            float mx = -INFINITY;
            for (int s = 0; s <= tid; ++s) mx = fmaxf(mx, bcum[tid] - bcum[s] + ig[s]);
            const float m = fmaxf(m_inter, mx);
            mt[tid] = m; winter[tid] = __expf(m_inter - m);
        }
        __syncthreads();
        for (int idx = tid; idx < 4096; idx += 256) {
            const int t = idx >> 6, s = idx & 63;
            float r = 0.f;
            if (s <= t) {
                const bf16_t* qp = q + cb + (size_t)t * DM; const bf16_t* kp = k + cb + (size_t)s * DM;
                float dot = 0.f;
                for (int d = 0; d < DH; d += 8) {
                    const uint4 qa = *(const uint4*)(qp + d), ka = *(const uint4*)(kp + d);
                    dot += bf2f(qa.x & 0xffff) * bf2f(ka.x & 0xffff) + bf2f(qa.x >> 16) * bf2f(ka.x >> 16);
                    dot += bf2f(qa.y & 0xffff) * bf2f(ka.y & 0xffff) + bf2f(qa.y >> 16) * bf2f(ka.y >> 16);
                    dot += bf2f(qa.z & 0xffff) * bf2f(ka.z & 0xffff) + bf2f(qa.z >> 16) * bf2f(ka.z >> 16);
                    dot += bf2f(qa.w & 0xffff) * bf2f(ka.w & 0xffff) + bf2f(qa.w >> 16) * bf2f(ka.w >> 16);
                }
                r = dot * __expf(bcum[t] - bcum[s] + ig[s] - mt[t]);
            }
            St[t][s] = r;
        }
        __syncthreads();
        if (tid < 64) {
            const bf16_t* qp = q + cb + (size_t)tid * DM;
            float dn = 0.f;
            for (int d = 0; d < DH; ++d) dn += nvec[d] * bf2f(qp[d]);
            float sm = 0.f;
            for (int s = 0; s < 64; ++s) sm += St[tid][s];
            const float den = winter[tid] * dn + sm;
            hden[tid] = fmaxf(fabsf(den), __expf(-mt[tid]));
        }
        __syncthreads();
        for (int idx = tid; idx < 2048; idx += 256) {
            const int t = idx >> 5, vv = idx & 31;
            const bf16_t* qp = q + cb + (size_t)t * DM;
            float a = 0.f;
            for (int d = 0; d < DH; ++d) a += Cs[vv][d] * bf2f(qp[d]);
            float s2 = 0.f;
            for (int s = 0; s < 64; ++s) s2 += St[t][s] * bf2f(v[cb + (size_t)s * DM + vs * 32 + vv]);
            const float num = winter[t] * a + s2;
            hc[cb + (size_t)t * DM + vs * 32 + vv] = f2bf(num / hden[t]);
        }
        __syncthreads();
        const float b_tot = bcum[63];
        if (tid < 64) ws_[tid] = b_tot - bcum[tid] + ig[tid];
        __syncthreads();
        if (tid == 0) {
            float mx = b_tot + m_prev;
            for (int s = 0; s < 64; ++s) mx = fmaxf(mx, ws_[s]);
            sc[1] = __expf(b_tot + m_prev - mx); sc[0] = mx;
        }
        __syncthreads();
        const float m_next = sc[0], decay = sc[1];
        float myw = 0.f;
        if (tid < 64) myw = __expf(ws_[tid] - m_next);
        __syncthreads();
        if (tid < 64) ws_[tid] = myw;
        __syncthreads();
        for (int idx = tid; idx < 32 * 256; idx += 256) {
            const int vv = idx >> 8, d = idx & 255;
            float a = 0.f;
            for (int s = 0; s < 64; ++s) a += ws_[s] * bf2f(v[cb + (size_t)s * DM + vs * 32 + vv]) * bf2f(k[cb + (size_t)s * DM + d]);
            Cs[vv][d] = decay * Cs[vv][d] + a;
        }
        {
            float a = 0.f;
            for (int s = 0; s < 64; ++s) a += ws_[s] * bf2f(k[cb + (size_t)s * DM + tid]);
            nvec[tid] = decay * nvec[tid] + a;
        }
        __syncthreads();
    }
}

DEV void k_mlstm_post(int vb, bf16_t* hc, const bf16_t* mo, const bf16_t* mg, const bf16_t* mi, const float* cw, const float* cb,
                                                    const float* ngain, const float* skip) {
    const int m = vb, t = threadIdx.x;
    float hv[4]; float s = 0.f;
#pragma unroll
    for (int i = 0; i < 4; ++i) {
        const size_t o = (size_t)m * DM + t * 4 + i;
        hv[i] = bf2f(hc[o]) * sigmoidf_(bf2f(mo[o])); s += hv[i];
    }
    const float mu = wave_sum(s) * (1.f / DH);
    float s2 = 0.f;
#pragma unroll
    for (int i = 0; i < 4; ++i) { hv[i] -= mu; s2 += hv[i] * hv[i]; }
    const float rstd = rsqrtf(wave_sum(s2) * (1.f / DH) + EPS);
#pragma unroll
    for (int i = 0; i < 4; ++i) {
        const int n = t * 4 + i; const size_t o = (size_t)m * DM + n;
        const float xc = conv_xc(mi, m, n, cw, cb);
        const float hn = hv[i] * rstd * ngain[n] + skip[n] * xc;
        hc[o] = f2bf(hn * siluf_(bf2f(mg[o])));
    }
}

DEV void k_final(int vb, float* red, float* x, const float* gain) {
    const int m = vb, t = threadIdx.x;
    float4 v = ((float4*)(x + (size_t)m * DM))[t];
    float ss = v.x * v.x + v.y * v.y + v.z * v.z + v.w * v.w;
    ss = block_sum256(ss, red);
    const float rstd = rsqrtf(ss * (1.f / DM) + EPS);
    const float4 g = ((const float4*)gain)[t];
    v.x *= rstd * g.x; v.y *= rstd * g.y; v.z *= rstd * g.z; v.w *= rstd * g.w;
    ((float4*)(x + (size_t)m * DM))[t] = v;
}


struct Params {
    const float *x, *c, *norm_gain, *w_mod, *b_mod, *w_in, *lam_re, *lam_im, *log_dt, *sb_re, *sb_im, *sc_re, *sc_im, *ssm_d, *w_glu, *b_glu, *ssm_og,
        *conv_w, *conv_b, *wq, *wk, *wv, *w_gates, *b_ig, *b_fg, *m_ng, *m_skip, *w_out, *final_gain;
    float* out; char* ws;
};
constexpr int LDS_BYTES = 56 * 1024;
#define FOR_VB(nvb) for (int vb = blockIdx.x; vb < (nvb); vb += gridDim.x)

__global__ void __launch_bounds__(256) mega(Params P) {
    extern __shared__ __attribute__((aligned(16))) unsigned char lds_raw[];
    float* ldsf = (float*)lds_raw;
    cg::grid_group grid = cg::this_grid();
    const size_t SLOT = (size_t)MTOK * DM * 2;
    bf16_t* S[7];
#pragma unroll
    for (int i = 0; i < 7; ++i) S[i] = (bf16_t*)(P.ws + SLOT * i);
    char* misc = P.ws + SLOT * 7;
    float* mod = (float*)misc;
    float* ipre = (float*)(misc + (1 << 20));
    float* logf = (float*)(misc + (2 << 20));
    float* out = P.out;

    FOR_VB(24) k_mod(vb, ldsf, P.c, P.w_mod, P.b_mod, mod);
    grid.sync();
    for (int l = 0; l < 2; ++l) {
        const float* xin = (l == 0) ? P.x : out;
        const float* modl = mod + (size_t)l * BATCH * 3 * DM;
        const float* Win = P.w_in + (size_t)l * DM * INC;
        bf16_t *H = S[0], *U = S[1], *Y = S[2], *Z = S[3], *SG = S[4], *MI = S[5], *Q = S[6], *Kb = S[1], *V = S[2], *XC = S[4], *HC = S[4], *MO = S[1], *MG = S[2];
        FOR_VB(MTOK) k_norm_mod(vb, ldsf, xin, P.norm_gain + l * DM, modl, H);
        grid.sync();
        GemmP g{}; g.A = H; g.A2 = nullptr; g.lda = DM; g.ksplit = 1 << 30; g.ldb = INC; g.K = DM; g.ldc = DM; g.scale = 1.f;
        FOR_VB(3 * 4096) {
            const int which = vb / 4096;
            GemmP e = g; e.B = Win + (which == 0 ? 0 : (which == 1 ? 1024 : 2048)); e.C = (which == 0 ? U : (which == 1 ? SG : MI));
            k_gemm<EPI_STORE>(vb % 4096, ldsf, e, 16, 256);
        }
        grid.sync();
        for (int it = blockIdx.x * 4 + (threadIdx.x >> 6); it < BATCH * NG; it += gridDim.x * 4)
            k_s5(it, ldsf, U, Y, P.lam_re + l * NG * NP, P.lam_im + l * NG * NP, P.log_dt + l * NG, P.sb_re + (size_t)l * NG * NP * GC, P.sb_im + (size_t)l * NG * NP * GC,
                 P.sc_re + (size_t)l * NG * GC * NP, P.sc_im + (size_t)l * NG * GC * NP, P.ssm_d + l * DM);
        grid.sync();
        { GemmP e = g; e.A = Y; e.B = P.w_glu + (size_t)l * DM * DM; e.ldb = DM; e.C = Z; e.bias = P.b_glu + l * DM; e.Y = Y;
          FOR_VB(4096) k_gemm<EPI_GLU>(vb, ldsf, e, 16, 256); }
        grid.sync();
        FOR_VB(MTOK) k_ssm_post(vb, ldsf, Z, SG, P.ssm_og + l * DM);
        grid.sync();
        FOR_VB(MTOK * DM / 256) k_conv(vb, MI, XC, P.conv_w + l * 4 * DM, P.conv_b + l * DM);
        grid.sync();
        { GemmP e{}; e.lda = DM; e.ksplit = 1 << 30; e.ldb = DH; e.K = DH; e.ldc = DM; e.zA = DH; e.zB = DH * DH; e.zC = DH;
          FOR_VB(3 * 4096) {
              const int which = vb / 4096;
              GemmP f = e;
              f.A = (which == 2) ? MI : XC;
              f.B = (which == 0 ? P.wq : (which == 1 ? P.wk : P.wv)) + (size_t)l * NH * DH * DH;
              f.C = (which == 0 ? Q : (which == 1 ? Kb : V)); f.scale = (which == 1) ? 0.0625f : 1.f;
              k_gemm<EPI_STORE>(vb % 4096, ldsf, f, 4, 256);
          } }
        grid.sync();
        FOR_VB(MTOK) k_gates(vb, ldsf, Q, Kb, V, P.w_gates + (size_t)l * 3 * DM * 8, P.b_ig + l * 4, P.b_fg + l * 4, ipre, logf);
        grid.sync();
        FOR_VB(BATCH * NH * 8) k_mlstm(vb, ldsf, Q, Kb, V, ipre, logf, HC);
        grid.sync();
        FOR_VB(2 * 4096) {
            const int which = vb / 4096;
            GemmP e = g; e.B = Win + (which == 0 ? 3072 : 4096); e.C = (which == 0 ? MO : MG);
            k_gemm<EPI_STORE>(vb % 4096, ldsf, e, 16, 256);
        }
        grid.sync();
        FOR_VB(MTOK) k_mlstm_post(vb, HC, MO, MG, MI, P.conv_w + l * 4 * DM, P.conv_b + l * DM, P.m_ng + l * DM, P.m_skip + l * DM);
        grid.sync();
        { GemmP e{}; e.A = Z; e.A2 = HC; e.lda = DM; e.ksplit = DM; e.B = P.w_out + (size_t)l * 2 * DM * DM; e.ldb = DM; e.K = 2 * DM;
          e.xin = xin; e.xout = out; e.gate = modl + 2 * DM;
          FOR_VB(4096) k_gemm<EPI_RES>(vb, ldsf, e, 16, 256); }
        grid.sync();
    }
    FOR_VB(MTOK) k_final(vb, ldsf, out, P.final_gain);
}

extern "C" void kernel_launch(void* const* d_in, const int* in_sizes, int n_in, void* d_out, int out_size, void* d_ws, size_t ws_size, hipStream_t stream) {
    static int grid_blocks = 0;
    if (!grid_blocks) {
        int dev = 0, cus = 0, per_cu = 0;
        hipGetDevice(&dev);
        hipDeviceGetAttribute(&cus, hipDeviceAttributeMultiprocessorCount, dev);
        hipFuncSetAttribute((const void*)mega, hipFuncAttributeMaxDynamicSharedMemorySize, LDS_BYTES);
        hipOccupancyMaxActiveBlocksPerMultiprocessor(&per_cu, (const void*)mega, 256, LDS_BYTES);
        if (per_cu > 2) per_cu = 2;
        if (per_cu < 1) per_cu = 1;
        grid_blocks = cus * per_cu;
        fprintf(stderr, "mega: cus=%d per_cu=%d grid=%d\n", cus, per_cu, grid_blocks);
    }
    Params P{};
    const float** pp = (const float**)&P;
    for (int i = 0; i < 29; ++i) pp[i] = (const float*)d_in[i];
    P.out = (float*)d_out; P.ws = (char*)d_ws;
    void* args[] = {&P};
    hipError_t e = hipLaunchCooperativeKernel((const void*)mega, dim3(grid_blocks), dim3(256), args, LDS_BYTES, stream);
    if (e != hipSuccess) fprintf(stderr, "cooperative launch failed: %s (grid %d)\n", hipGetErrorString(e), grid_blocks);
}
```

```cpp
#include <hip/hip_runtime.h>
#include <cstdio>
#include <cstdint>
#include <hip/hip_cooperative_groups.h>
namespace cg = cooperative_groups;

typedef unsigned short bf16_t;
#define DEV __device__ __forceinline__

constexpr int BATCH = 8, SEQ = 2048, DM = 1024, MTOK = BATCH * SEQ;
constexpr int NG = 64, NP = 64, GC = 16, NH = 4, DH = 256, CHUNK = 64, INC = 5120;
constexpr float EPS = 1e-6f;

DEV int opaque_tid() { int t = threadIdx.x; asm volatile("" : "+v"(t)); return t; }
#define TIDH (opaque_tid() & 255)
#define HALF (opaque_tid() >> 8)
DEV float bf2f(bf16_t v) { return __uint_as_float(((unsigned)v) << 16); }
DEV bf16_t f2bf(float f) { unsigned u = __float_as_uint(f); return (bf16_t)((u + 0x7fffu + ((u >> 16) & 1u)) >> 16); }
DEV float sigmoidf_(float x) { return 1.f / (1.f + __expf(-x)); }
DEV float siluf_(float x) { return x / (1.f + __expf(-x)); }
DEV float geluf_(float x) { float t = 0.7978845608028654f * (x + 0.044715f * x * x * x); return 0.5f * x * (1.f + tanhf(t)); }
DEV float logsigmoidf_(float x) { return fminf(x, 0.f) - log1pf(__expf(-fabsf(x))); }

DEV float wave_sum(float v) {
#pragma unroll
    for (int o = 1; o < 64; o <<= 1) v += __shfl_xor(v, o);
    return v;
}
DEV float block_sum256(float v, float* red) {
    v = wave_sum(v);
    __syncthreads();
    if ((TIDH & 63) == 0) red[TIDH >> 6] = v;
    __syncthreads();
    return red[0] + red[1] + red[2] + red[3];
}

DEV void k_mod(int vb, float* ldsf, const float* c, const float* w_mod, const float* b_mod, float* mod) {
    float (*sc)[DM] = (float (*)[DM])ldsf;
    const int l = vb / 12, n = (vb % 12) * 256 + TIDH;
    __syncthreads();
    for (int i = TIDH; i < BATCH * DM; i += 256) sc[i / DM][i % DM] = siluf_(c[i]);
    __syncthreads();
    float acc[BATCH];
#pragma unroll
    for (int b = 0; b < BATCH; ++b) acc[b] = 0.f;
    const float* W = w_mod + (size_t)l * DM * 3 * DM;
    for (int k = 0; k < DM; ++k) {
        float w = W[(size_t)k * 3 * DM + n];
#pragma unroll
        for (int b = 0; b < BATCH; ++b) acc[b] += sc[b][k] * w;
    }
#pragma unroll
    for (int b = 0; b < BATCH; ++b) mod[((size_t)l * BATCH + b) * 3 * DM + n] = acc[b] + b_mod[l * 3 * DM + n];
}

DEV void k_norm_mod(int vb, float* red, const float* x, const float* gain, const float* mod  , bf16_t* h) {
    const int m = vb, b = m / SEQ, t = TIDH;
    const float4 v = ((const float4*)(x + (size_t)m * DM))[t];
    float ss = v.x * v.x + v.y * v.y + v.z * v.z + v.w * v.w;
    ss = block_sum256(ss, red);
    const float rstd = rsqrtf(ss * (1.f / DM) + EPS);
    const float* shift = mod + (size_t)b * 3 * DM;
    const float* scale = shift + DM;
    float xv[4] = {v.x, v.y, v.z, v.w};
#pragma unroll
    for (int i = 0; i < 4; ++i) {
        int n = t * 4 + i;
        float y = xv[i] * rstd * gain[n] * (1.f + scale[n]) + shift[n];
        h[(size_t)m * DM + n] = f2bf(y);
    }
}

DEV void k_s5(int item, float* ldsf, const bf16_t* u, bf16_t* y, const float* lam_re, const float* lam_im, const float* log_dt,
                                           const float* b_re, const float* b_im, const float* c_re, const float* c_im, const float* dskip) {
    const int tid_ = opaque_tid();
    float (*part)[17] = (float (*)[17])(ldsf + (tid_ >> 6) * 64 * 17);
    const int g = item & 63, b = item >> 6, p = tid_ & 63;
    const double lr = lam_re[g * NP + p], li = lam_im[g * NP + p], dt = exp((double)log_dt[g]);
    const double er = exp(lr * dt);
    const double ard = er * cos(li * dt), aid = er * sin(li * dt);
    const double dr = ard - 1.0, di = aid, den = lr * lr + li * li;
    const double cr = (dr * lr + di * li) / den, ci = (di * lr - dr * li) / den;
    float bbr[16], bbi[16], ccr[16], cci[16];
#pragma unroll
    for (int c = 0; c < 16; ++c) {
        const double br = b_re[(g * NP + p) * GC + c], bi = b_im[(g * NP + p) * GC + c];
        bbr[c] = (float)(cr * br - ci * bi); bbi[c] = (float)(cr * bi + ci * br);
        ccr[c] = c_re[(g * GC + c) * NP + p]; cci[c] = c_im[(g * GC + c) * NP + p];
    }
    const float ar = (float)ard, ai = (float)aid;
    const float dsk = dskip[g * GC + (p & 15)];
    float sr = 0.f, si = 0.f;
    for (int t = 0; t < SEQ; ++t) {
        const bf16_t* up = u + (size_t)(b * SEQ + t) * DM + g * GC;
        const uint4 u0 = *(const uint4*)up, u1 = *(const uint4*)(up + 8);
        float uf[16];
        uf[0] = bf2f(u0.x & 0xffff); uf[1] = bf2f(u0.x >> 16); uf[2] = bf2f(u0.y & 0xffff); uf[3] = bf2f(u0.y >> 16);
        uf[4] = bf2f(u0.z & 0xffff); uf[5] = bf2f(u0.z >> 16); uf[6] = bf2f(u0.w & 0xffff); uf[7] = bf2f(u0.w >> 16);
        uf[8] = bf2f(u1.x & 0xffff); uf[9] = bf2f(u1.x >> 16); uf[10] = bf2f(u1.y & 0xffff); uf[11] = bf2f(u1.y >> 16);
        uf[12] = bf2f(u1.z & 0xffff); uf[13] = bf2f(u1.z >> 16); uf[14] = bf2f(u1.w & 0xffff); uf[15] = bf2f(u1.w >> 16);
        float bur = 0.f, bui = 0.f;
#pragma unroll
        for (int c = 0; c < 16; ++c) { bur += bbr[c] * uf[c]; bui += bbi[c] * uf[c]; }
        const float nr = ar * sr - ai * si + bur, ni = ar * si + ai * sr + bui;
        sr = nr; si = ni;
#pragma unroll
        for (int c = 0; c < 16; ++c) part[p][c] = ccr[c] * sr - cci[c] * si;
        asm volatile("s_waitcnt lgkmcnt(0)" ::: "memory");
        float s = 0.f;
#pragma unroll
        for (int k = 0; k < 16; ++k) s += part[(p >> 4) * 16 + k][p & 15];
        s += __shfl_xor(s, 16); s += __shfl_xor(s, 32);
        if (p < 16) {
            const float yv = s + dsk * bf2f(up[p]);
            y[(size_t)(b * SEQ + t) * DM + g * GC + p] = f2bf(geluf_(yv));
        }
        asm volatile("s_waitcnt lgkmcnt(0)" ::: "memory");
    }
}

DEV void k_ssm_post(int vb, float* red, bf16_t* z, const bf16_t* sg, const float* gain) {
    const int m = vb, t = TIDH;
    float zv[4]; float ss = 0.f;
#pragma unroll
    for (int i = 0; i < 4; ++i) { zv[i] = bf2f(z[(size_t)m * DM + t * 4 + i]); ss += zv[i] * zv[i]; }
    ss = block_sum256(ss, red);
    const float rstd = rsqrtf(ss * (1.f / DM) + EPS);
#pragma unroll
    for (int i = 0; i < 4; ++i) {
        const int n = t * 4 + i;
        z[(size_t)m * DM + n] = f2bf(zv[i] * rstd * gain[n] * siluf_(bf2f(sg[(size_t)m * DM + n])));
    }
}

DEV float conv_xc(const bf16_t* mi, int m, int n, const float* cw, const float* cb) {
    const int t = m % SEQ;
    float acc = cb[n];
#pragma unroll
    for (int j = 0; j < 4; ++j) {
        const int tt = t - 3 + j;
        if (tt >= 0) acc += bf2f(mi[(size_t)(m - 3 + j) * DM + n]) * cw[j * DM + n];
    }
    return siluf_(acc);
}
DEV void k_conv(int vb, const bf16_t* mi, bf16_t* xc, const float* cw, const float* cb) {
    const size_t idx = (size_t)vb * 256 + TIDH;
    const int m = (int)(idx / DM), n = (int)(idx % DM);
    xc[idx] = f2bf(conv_xc(mi, m, n, cw, cb));
}

DEV void k_gates(int vb, float* ldsf, const bf16_t* q, const bf16_t* k, const bf16_t* v, const float* wg  , const float* bi, const float* bfg,
                                               float* ipre, float* logf) {
    float (*red)[8] = (float (*)[8])ldsf;
    const int m = vb, t = TIDH;
    __syncthreads();
    float acc[8];
#pragma unroll
    for (int j = 0; j < 8; ++j) acc[j] = 0.f;
    for (int e = t; e < 3 * DM; e += 256) {
        const bf16_t* src = (e < DM) ? q : (e < 2 * DM ? k : v);
        const float xv = bf2f(src[(size_t)m * DM + (e & (DM - 1))]);
#pragma unroll
        for (int j = 0; j < 8; ++j) acc[j] += xv * wg[e * 8 + j];
    }
#pragma unroll
    for (int j = 0; j < 8; ++j) acc[j] = wave_sum(acc[j]);
    if ((t & 63) == 0) {
#pragma unroll
        for (int j = 0; j < 8; ++j) red[t >> 6][j] = acc[j];
    }
    __syncthreads();
    if (t < 8) {
        const float s = red[0][t] + red[1][t] + red[2][t] + red[3][t];
        if (t < 4) ipre[(size_t)m * 4 + t] = s + bi[t];
        else logf[(size_t)m * 4 + (t - 4)] = logsigmoidf_(s + bfg[t - 4]);
    }
}

DEV void k_mlstm(int vb, float* ldsf, const bf16_t* q, const bf16_t* k, const bf16_t* v, const float* ipre, const float* logf, bf16_t* hc) {
    float (*Cs)[257] = (float (*)[257])ldsf;
    float (*St)[65] = (float (*)[65])(ldsf + 32 * 257);
    float* nvec = ldsf + 32 * 257 + 64 * 65;
    float* bcum = nvec + 256; float* ig = bcum + 64; float* mt = ig + 64; float* winter = mt + 64; float* ws_ = winter + 64; float* hden = ws_ + 64;
    float* sc = hden + 64;
    const int tid = TIDH;
    const int vs = vb & 7, h = (vb >> 3) & 3, b = vb >> 5;
    __syncthreads();
    for (int i = tid; i < 32 * 257; i += 256) (&Cs[0][0])[i] = 0.f;
    nvec[tid] = 0.f;
    if (tid == 0) sc[0] = 0.f;
    __syncthreads();
    const size_t base = (size_t)b * SEQ * DM + h * DH;
    for (int j = 0; j < SEQ / CHUNK; ++j) {
        const size_t cb = base + (size_t)j * CHUNK * DM;
        const int m0 = b * SEQ + j * CHUNK;
        if (tid < 64) {
            ig[tid] = ipre[(size_t)(m0 + tid) * 4 + h];
            ws_[tid] = logf[(size_t)(m0 + tid) * 4 + h];
        }
        __syncthreads();
        if (tid < 64) { float s = 0.f; for (int i = 0; i <= tid; ++i) s += ws_[i]; bcum[tid] = s; }
        __syncthreads();
        const float m_prev = sc[0];
        if (tid < 64) {
            const float m_inter = bcum[tid] + m_prev;
            float mx = -INFINITY;
            for (int s = 0; s <= tid; ++s) mx = fmaxf(mx, bcum[tid] - bcum[s] + ig[s]);
            const float m = fmaxf(m_inter, mx);
            mt[tid] = m; winter[tid] = __expf(m_inter - m);
        }
        __syncthreads();
        for (int idx = tid; idx < 4096; idx += 256) {
            const int t = idx >> 6, s = idx & 63;
            float r = 0.f;
            if (s <= t) {
                const bf16_t* qp = q + cb + (size_t)t * DM; const bf16_t* kp = k + cb + (size_t)s * DM;
                float dot = 0.f;
                for (int d = 0; d < DH; d += 8) {
                    const uint4 qa = *(const uint4*)(qp + d), ka = *(const uint4*)(kp + d);
                    dot += bf2f(qa.x & 0xffff) * bf2f(ka.x & 0xffff) + bf2f(qa.x >> 16) * bf2f(ka.x >> 16);
                    dot += bf2f(qa.y & 0xffff) * bf2f(ka.y & 0xffff) + bf2f(qa.y >> 16) * bf2f(ka.y >> 16);
                    dot += bf2f(qa.z & 0xffff) * bf2f(ka.z & 0xffff) + bf2f(qa.z >> 16) * bf2f(ka.z >> 16);
                    dot += bf2f(qa.w & 0xffff) * bf2f(ka.w & 0xffff) + bf2f(qa.w >> 16) * bf2f(ka.w >> 16);
                }
                r = dot * __expf(bcum[t] - bcum[s] + ig[s] - mt[t]);
            }
            St[t][s] = r;
        }
        __syncthreads();
        if (tid < 64) {
            const bf16_t* qp = q + cb + (size_t)tid * DM;
            float dn = 0.f;
            for (int d = 0; d < DH; ++d) dn += nvec[d] * bf2f(qp[d]);
            float sm = 0.f;
            for (int s = 0; s < 64; ++s) sm += St[tid][s];
            const float den = winter[tid] * dn + sm;
            hden[tid] = fmaxf(fabsf(den), __expf(-mt[tid]));
        }
        __syncthreads();
        for (int idx = tid; idx < 2048; idx += 256) {
            const int t = idx >> 5, vv = idx & 31;
            const bf16_t* qp = q + cb + (size_t)t * DM;
            float a = 0.f;
            for (int d = 0; d < DH; ++d) a += Cs[vv][d] * bf2f(qp[d]);
            float s2 = 0.f;
            for (int s = 0; s < 64; ++s) s2 += St[t][s] * bf2f(v[cb + (size_t)s * DM + vs * 32 + vv]);
            const float num = winter[t] * a + s2;
            hc[cb + (size_t)t * DM + vs * 32 + vv] = f2bf(num / hden[t]);
        }
        __syncthreads();
        const float b_tot = bcum[63];
        if (tid < 64) ws_[tid] = b_tot - bcum[tid] + ig[tid];
        __syncthreads();
        if (tid == 0) {
            float mx = b_tot + m_prev;
            for (int s = 0; s < 64; ++s) mx = fmaxf(mx, ws_[s]);
            sc[1] = __expf(b_tot + m_prev - mx); sc[0] = mx;
        }
        __syncthreads();
        const float m_next = sc[0], decay = sc[1];
        float myw = 0.f;
        if (tid < 64) myw = __expf(ws_[tid] - m_next);
        __syncthreads();
        if (tid < 64) ws_[tid] = myw;
        __syncthreads();
        for (int idx = tid; idx < 32 * 256; idx += 256) {
            const int vv = idx >> 8, d = idx & 255;
            float a = 0.f;
            for (int s = 0; s < 64; ++s) a += ws_[s] * bf2f(v[cb + (size_t)s * DM + vs * 32 + vv]) * bf2f(k[cb + (size_t)s * DM + d]);
            Cs[vv][d] = decay * Cs[vv][d] + a;
        }
        {
            float a = 0.f;
            for (int s = 0; s < 64; ++s) a += ws_[s] * bf2f(k[cb + (size_t)s * DM + tid]);
            nvec[tid] = decay * nvec[tid] + a;
        }
        __syncthreads();
    }
}

DEV void k_mlstm_post(int vb, bf16_t* hc, const bf16_t* mo, const bf16_t* mg, const bf16_t* mi, const float* cw, const float* cb,
                                                    const float* ngain, const float* skip) {
    const int m = vb, t = TIDH;
    float hv[4]; float s = 0.f;
#pragma unroll
    for (int i = 0; i < 4; ++i) {
        const size_t o = (size_t)m * DM + t * 4 + i;
        hv[i] = bf2f(hc[o]) * sigmoidf_(bf2f(mo[o])); s += hv[i];
    }
    const float mu = wave_sum(s) * (1.f / DH);
    float s2 = 0.f;
#pragma unroll
    for (int i = 0; i < 4; ++i) { hv[i] -= mu; s2 += hv[i] * hv[i]; }
    const float rstd = rsqrtf(wave_sum(s2) * (1.f / DH) + EPS);
#pragma unroll
    for (int i = 0; i < 4; ++i) {
        const int n = t * 4 + i; const size_t o = (size_t)m * DM + n;
        const float xc = conv_xc(mi, m, n, cw, cb);
        const float hn = hv[i] * rstd * ngain[n] + skip[n] * xc;
        hc[o] = f2bf(hn * siluf_(bf2f(mg[o])));
    }
}

DEV void k_final(int vb, float* red, float* x, const float* gain) {
    const int m = vb, t = TIDH;
    float4 v = ((float4*)(x + (size_t)m * DM))[t];
    float ss = v.x * v.x + v.y * v.y + v.z * v.z + v.w * v.w;
    ss = block_sum256(ss, red);
    const float rstd = rsqrtf(ss * (1.f / DM) + EPS);
    const float4 g = ((const float4*)gain)[t];
    v.x *= rstd * g.x; v.y *= rstd * g.y; v.z *= rstd * g.z; v.w *= rstd * g.w;
    ((float4*)(x + (size_t)m * DM))[t] = v;
}


#define LAS __attribute__((address_space(3)))
typedef short bf16x8 __attribute__((ext_vector_type(8)));
typedef float f32x4 __attribute__((ext_vector_type(4)));
#define WAIT_V(n) asm volatile("s_waitcnt vmcnt(" #n ")" ::: "memory")
#define WAIT_L(n) asm volatile("s_waitcnt lgkmcnt(" #n ")" ::: "memory")
#define SCHED() __builtin_amdgcn_sched_barrier(0)

DEV int lds_byte(int r, int c) { int st = (r >> 4) * 2 + (c >> 5), ob = (r & 15) * 64 + (c & 31) * 2; return st * 1024 + (ob ^ (((ob >> 9) & 1) << 5)); }
DEV void stage_rc(int b, int& R, int& C) { int st = b >> 10, sb = b & 1023, swz = sb ^ (((sb >> 9) & 1) << 5); R = (st >> 1) * 16 + swz / 64; C = (st & 1) * 32 + (swz % 64) / 2; }
template <class T> DEV T* sel3(int w, T* p0, T* p1, T* p2) { return p0 + ((w >= 1) ? (p1 - p0) : 0) + ((w >= 2) ? (p2 - p1) : 0); }
DEV uint2 pack4(f32x4 v) { uint2 r; r.x = (unsigned)f2bf(v[0]) | ((unsigned)f2bf(v[1]) << 16); r.y = (unsigned)f2bf(v[2]) | ((unsigned)f2bf(v[3]) << 16); return r; }

template <class Prob>
DEV void gemm_phase(LAS char* shm, const Prob& pb) {
    constexpr int TILE_B = 256 * 64 * 2, STAGE_B = 2 * TILE_B;
    const int tid = opaque_tid(), wid = __builtin_amdgcn_readfirstlane(tid >> 6), lane = tid & 63, wr = wid >> 2, wc = wid & 3, fr = lane & 15, fq = lane >> 4;
    int sR[4], sC[4];
#pragma unroll
    for (int i = 0; i < 4; ++i) stage_rc(wid * 1024 + i * 8192 + lane * 16, sR[i], sC[i]);
    const int nN = pb.nN, ntiles = 64 * nN, nt = Prob::K / 64, lda = Prob::lda, ldb = Prob::ldb;
    for (int t = blockIdx.x; t < ntiles; t += gridDim.x) {
        const int base = t & ~255, loc = t & 255;
        const int w = base + (loc & 7) * 32 + (loc >> 3);
        const int nig = 8 * nN, gid = w / nig, pm = gid * 8 + (w % nig) % 8, pn = (w % nig) / 8;
        const int brow = pm * 256, bcol = pn * 256;
        const bf16_t* Bb = pb.bptr(pn);
#define GLDS_STAGE(buf, kt) do { const bf16_t* Ak_ = pb.aptr(pn, kt) + (long)brow * lda; const bf16_t* Bk_ = Bb + (kt) * 64; \
        _Pragma("unroll") for (int i = 0; i < 4; ++i) { \
            __builtin_amdgcn_global_load_lds((const unsigned*)(Ak_ + (long)sR[i] * lda + sC[i]), (LAS unsigned*)(shm + (buf) * STAGE_B + wid * 1024 + i * 8192), 16, 0, 0); \
            __builtin_amdgcn_global_load_lds((const unsigned*)(Bk_ + (long)sR[i] * ldb + sC[i]), (LAS unsigned*)(shm + (buf) * STAGE_B + TILE_B + wid * 1024 + i * 8192), 16, 0, 0); } } while (0)
        f32x4 acc[8][4];
#pragma unroll
        for (int m = 0; m < 8; ++m)
#pragma unroll
            for (int n = 0; n < 4; ++n) acc[m][n] = (f32x4){0.f, 0.f, 0.f, 0.f};
        GLDS_STAGE(0, 0); WAIT_V(0); __syncthreads();
#pragma nounroll
        for (int kt = 0; kt < nt; ++kt) {
            const int cur = kt & 1;
            if (kt + 1 < nt) GLDS_STAGE(cur ^ 1, kt + 1);
#pragma unroll
            for (int ks = 0; ks < 2; ++ks) {
                bf16x8 At[8], Bf[4];
#pragma unroll
                for (int m = 0; m < 8; ++m) At[m] = *(const LAS bf16x8*)(shm + cur * STAGE_B + lds_byte(wr * 128 + m * 16 + fr, ks * 32 + fq * 8));
#pragma unroll
                for (int n = 0; n < 4; ++n) Bf[n] = *(const LAS bf16x8*)(shm + cur * STAGE_B + TILE_B + lds_byte(wc * 64 + n * 16 + fr, ks * 32 + fq * 8));
#pragma unroll
                for (int m = 0; m < 8; ++m)
#pragma unroll
                    for (int n = 0; n < 4; ++n) acc[m][n] = __builtin_amdgcn_mfma_f32_16x16x32_bf16(Bf[n], At[m], acc[m][n], 0, 0, 0);
                SCHED();
            }
            WAIT_V(0); __syncthreads();
        }
#undef GLDS_STAGE
#pragma unroll
        for (int m = 0; m < 8; ++m)
#pragma unroll
            for (int n = 0; n < 4; ++n) pb.epi(pn, brow + wr * 128 + m * 16 + fr, bcol + wc * 64 + n * 16 + fq * 4, acc[m][n]);
    }
}

struct ProbIn {
    static constexpr int K = 1024, lda = 1024, ldb = 1024;
    const bf16_t* H; const bf16_t* Wt; bf16_t* C0; bf16_t* C1; bf16_t* C2; int nN;
    DEV const bf16_t* aptr(int pn, int kt) const { return H + kt * 64; }
    DEV const bf16_t* bptr(int pn) const { return Wt + (long)pn * 256 * 1024; }
    DEV void epi(int pn, int row, int col, f32x4 v) const {
        bf16_t* C = sel3(col >> 10, C0, C1, C2);
        *(uint2*)(C + (size_t)row * DM + (col & 1023)) = pack4(v);
    }
};
struct ProbGlu {
    static constexpr int K = 1024, lda = 1024, ldb = 1024;
    const bf16_t* Y; const bf16_t* Wt; bf16_t* Z; const float* bias; int nN;
    DEV const bf16_t* aptr(int pn, int kt) const { return Y + kt * 64; }
    DEV const bf16_t* bptr(int pn) const { return Wt + (long)pn * 256 * 1024; }
    DEV void epi(int pn, int row, int col, f32x4 v) const {
        const uint2 yv = *(const uint2*)(Y + (size_t)row * DM + col);
        const float4 b = *(const float4*)(bias + col);
        f32x4 o;
        o[0] = bf2f(yv.x & 0xffff) * sigmoidf_(v[0] + b.x); o[1] = bf2f(yv.x >> 16) * sigmoidf_(v[1] + b.y);
        o[2] = bf2f(yv.y & 0xffff) * sigmoidf_(v[2] + b.z); o[3] = bf2f(yv.y >> 16) * sigmoidf_(v[3] + b.w);
        *(uint2*)(Z + (size_t)row * DM + col) = pack4(o);
    }
};
struct ProbQkv {
    static constexpr int K = 256, lda = 1024, ldb = 256;
    const bf16_t* XC; const bf16_t* MI; const bf16_t* Wt; bf16_t* Q; bf16_t* Kk; bf16_t* V; int nN;
    DEV const bf16_t* aptr(int pn, int kt) const { return ((pn >> 2) == 2 ? MI : XC) + (pn & 3) * 256 + kt * 64; }
    DEV const bf16_t* bptr(int pn) const { return Wt + (long)pn * 256 * 256; }
    DEV void epi(int pn, int row, int col, f32x4 v) const {
        const int which = pn >> 2; bf16_t* C = sel3(which, Q, Kk, V);
        if (which == 1) { v[0] *= 0.0625f; v[1] *= 0.0625f; v[2] *= 0.0625f; v[3] *= 0.0625f; }
        *(uint2*)(C + (size_t)row * DM + (col & 1023)) = pack4(v);
    }
};
struct ProbOut {
    static constexpr int K = 2048, lda = 1024, ldb = 2048;
    const bf16_t* A1; const bf16_t* A2; const bf16_t* Wt; const float* xin; float* xout; const float* gate; int nN;
    DEV const bf16_t* aptr(int pn, int kt) const { return (kt < 16) ? (A1 + kt * 64) : (A2 + (kt - 16) * 64); }
    DEV const bf16_t* bptr(int pn) const { return Wt + (long)pn * 256 * 2048; }
    DEV void epi(int pn, int row, int col, f32x4 v) const {
        const int b = row / SEQ;
        const float4 xi = *(const float4*)(xin + (size_t)row * DM + col);
        const float4 g = *(const float4*)(gate + (size_t)b * 3 * DM + col);
        float4 o; o.x = xi.x + g.x * v[0]; o.y = xi.y + g.y * v[1]; o.z = xi.z + g.z * v[2]; o.w = xi.w + g.w * v[3];
        *(float4*)(xout + (size_t)row * DM + col) = o;
    }
};

DEV void transpose_item(const float* W, int ldw, int ncols, bf16_t* WT, int ldwt, LAS float* scr, int item, int lane) {
    const int nblk = ncols / 32, kb = item / nblk, nb = item % nblk, k0 = 64 * kb, n0 = 32 * nb;
#pragma unroll 8
    for (int i = 0; i < 32; ++i) { const int kk = 2 * i + (lane >> 5); scr[kk * 33 + (lane & 31)] = W[(size_t)(k0 + kk) * ldw + n0 + (lane & 31)]; }
    asm volatile("s_waitcnt lgkmcnt(0)" ::: "memory");
    const int c = lane & 7;
#pragma unroll
    for (int j = 0; j < 4; ++j) {
        const int n = (lane >> 3) + 8 * j; const LAS float* s = scr + (8 * c) * 33 + n;
        uint4 o;
        o.x = (unsigned)f2bf(s[0 * 33]) | ((unsigned)f2bf(s[1 * 33]) << 16); o.y = (unsigned)f2bf(s[2 * 33]) | ((unsigned)f2bf(s[3 * 33]) << 16);
        o.z = (unsigned)f2bf(s[4 * 33]) | ((unsigned)f2bf(s[5 * 33]) << 16); o.w = (unsigned)f2bf(s[6 * 33]) | ((unsigned)f2bf(s[7 * 33]) << 16);
        *(uint4*)(WT + (size_t)(n0 + n) * ldwt + k0 + 8 * c) = o;
    }
    asm volatile("s_waitcnt lgkmcnt(0)" ::: "memory");
}

struct Params {
    const float *x, *c, *norm_gain, *w_mod, *b_mod, *w_in, *lam_re, *lam_im, *log_dt, *sb_re, *sb_im, *sc_re, *sc_im, *ssm_d, *w_glu, *b_glu, *ssm_og,
        *conv_w, *conv_b, *wq, *wk, *wv, *w_gates, *b_ig, *b_fg, *m_ng, *m_skip, *w_out, *final_gain;
    float* out; char* ws;
};
constexpr int LDS_BYTES = 132 * 1024;
constexpr int HALF_FLOATS = 56 * 1024 / 4;
constexpr size_t SLOT = (size_t)MTOK * DM * 2;
constexpr size_t W_IN_OFF = 0, W_GLU_OFF = 10485760, W_QKV_OFF = 12582912, W_OUT_OFF = 14155776, MOD_OFF = 20u << 20, IPRE_OFF = 21u << 20, LOGF_OFF = 22u << 20;
#define FOR_VB(nvb) for (int vb = blockIdx.x * 2 + HALF; vb < (nvb); vb += gridDim.x * 2)

__global__ void __launch_bounds__(512, 2) mega(Params P) {
    extern __shared__ __attribute__((aligned(16))) unsigned char lds_raw[];
    LAS char* shm = (LAS char*)lds_raw;
    float* ldsf = (float*)lds_raw + HALF * HALF_FLOATS;
    cg::grid_group grid = cg::this_grid();
    bf16_t* S[7];
#pragma unroll
    for (int i = 0; i < 7; ++i) S[i] = (bf16_t*)(P.ws + SLOT * i);
    char* s7 = P.ws + SLOT * 7;
    bf16_t* WinT = (bf16_t*)(s7 + W_IN_OFF); bf16_t* WgluT = (bf16_t*)(s7 + W_GLU_OFF); bf16_t* WqkvT = (bf16_t*)(s7 + W_QKV_OFF); bf16_t* WoutT = (bf16_t*)(s7 + W_OUT_OFF);
    float* mod = (float*)(s7 + MOD_OFF);
    float* ipre = (float*)(s7 + IPRE_OFF);
    float* logf = (float*)(s7 + LOGF_OFF);
    float* out = P.out;
    FOR_VB(24) k_mod(vb, ldsf, P.c, P.w_mod, P.b_mod, mod);
    grid.sync();
    for (int l = 0; l < 2; ++l) {
        const int wave = opaque_tid() >> 6, lane = opaque_tid() & 63;
        const float* xin = (l == 0) ? P.x : out;
        const float* modl = mod + (size_t)l * BATCH * 3 * DM;
        bf16_t *H = S[0], *U = S[1], *Y = S[2], *Z = S[3], *SG = S[4], *MI = S[5], *Q = S[6], *Kb = S[1], *V = S[2], *XC = S[4], *HC = S[4], *MO = S[1], *MG = S[2];
        {
            LAS float* scr = (LAS float*)(shm + wave * 8448);
            const float* Win = P.w_in + (size_t)l * DM * INC;
            constexpr int I_IN = 16 * 160, I_GLU = 16 * 32, I_QKV = 12 * 32, I_OUT = 32 * 32;
            for (int it = blockIdx.x * 8 + wave; it < I_IN + I_GLU + I_QKV + I_OUT; it += gridDim.x * 8) {
                int r = it;
                if (r < I_IN) { transpose_item(Win, INC, INC, WinT, DM, scr, r, lane); continue; } r -= I_IN;
                if (r < I_GLU) { transpose_item(P.w_glu + (size_t)l * DM * DM, DM, DM, WgluT, DM, scr, r, lane); continue; } r -= I_GLU;
                if (r < I_QKV) { const int mat = r / 32, which = mat >> 2, hd = mat & 3;
                    const float* W = sel3(which, P.wq, P.wk, P.wv) + ((size_t)l * NH + hd) * DH * DH;
                    transpose_item(W, DH, DH, WqkvT + (size_t)mat * DH * DH, DH, scr, r % 32, lane); continue; } r -= I_QKV;
                transpose_item(P.w_out + (size_t)l * 2 * DM * DM, DM, DM, WoutT, 2 * DM, scr, r, lane);
            }
        }
        __syncthreads();
        FOR_VB(MTOK) k_norm_mod(vb, ldsf, xin, P.norm_gain + l * DM, modl, H);
        grid.sync();
        { ProbIn pb{H, WinT, U, SG, MI, 12}; gemm_phase(shm, pb); }
        grid.sync();
        for (int it = blockIdx.x * 8 + wave; it < BATCH * NG; it += gridDim.x * 8)
            k_s5(it, (float*)lds_raw, U, Y, P.lam_re + l * NG * NP, P.lam_im + l * NG * NP, P.log_dt + l * NG, P.sb_re + (size_t)l * NG * NP * GC, P.sb_im + (size_t)l * NG * NP * GC,
                 P.sc_re + (size_t)l * NG * GC * NP, P.sc_im + (size_t)l * NG * GC * NP, P.ssm_d + l * DM);
        grid.sync();
        { ProbGlu pb{Y, WgluT, Z, P.b_glu + l * DM, 4}; gemm_phase(shm, pb); }
        grid.sync();
        FOR_VB(MTOK) k_ssm_post(vb, ldsf, Z, SG, P.ssm_og + l * DM);
        grid.sync();
        FOR_VB(MTOK * DM / 256) k_conv(vb, MI, XC, P.conv_w + l * 4 * DM, P.conv_b + l * DM);
        grid.sync();
        { ProbQkv pb{XC, MI, WqkvT, Q, Kb, V, 12}; gemm_phase(shm, pb); }
        grid.sync();
        FOR_VB(MTOK) k_gates(vb, ldsf, Q, Kb, V, P.w_gates + (size_t)l * 3 * DM * 8, P.b_ig + l * 4, P.b_fg + l * 4, ipre, logf);
        grid.sync();
        FOR_VB(BATCH * NH * 8) k_mlstm(vb, ldsf, Q, Kb, V, ipre, logf, HC);
        grid.sync();
        { ProbIn pb{H, WinT + (size_t)3072 * DM, MO, MG, MG, 8}; gemm_phase(shm, pb); }
        grid.sync();
        FOR_VB(MTOK) k_mlstm_post(vb, HC, MO, MG, MI, P.conv_w + l * 4 * DM, P.conv_b + l * DM, P.m_ng + l * DM, P.m_skip + l * DM);
        grid.sync();
        { ProbOut pb{Z, HC, WoutT, xin, out, modl + 2 * DM, 4}; gemm_phase(shm, pb); }
        grid.sync();
    }
    FOR_VB(MTOK) k_final(vb, ldsf, out, P.final_gain);
}

extern "C" void kernel_launch(void* const* d_in, const int* in_sizes, int n_in, void* d_out, int out_size, void* d_ws, size_t ws_size, hipStream_t stream) {
    static int grid_blocks = 0;
    if (!grid_blocks) {
        int dev = 0, cus = 0, per_cu = 0;
        (void)hipGetDevice(&dev);
        (void)hipDeviceGetAttribute(&cus, hipDeviceAttributeMultiprocessorCount, dev);
        (void)hipFuncSetAttribute((const void*)mega, hipFuncAttributeMaxDynamicSharedMemorySize, LDS_BYTES);
        (void)hipOccupancyMaxActiveBlocksPerMultiprocessor(&per_cu, (const void*)mega, 512, LDS_BYTES);
        grid_blocks = cus;
        fprintf(stderr, "mega: cus=%d occupancy per_cu=%d grid=%d\n", cus, per_cu, grid_blocks);
    }
    Params P{};
    const float** pp = (const float**)&P;
    for (int i = 0; i < 29; ++i) pp[i] = (const float*)d_in[i];
    P.out = (float*)d_out; P.ws = (char*)d_ws;
    void* args[] = {&P};
    hipError_t e = hipLaunchCooperativeKernel((const void*)mega, dim3(grid_blocks), dim3(512), args, LDS_BYTES, stream);
    if (e != hipSuccess) fprintf(stderr, "cooperative launch failed: %s (grid %d)\n", hipGetErrorString(e), grid_blocks);
}
```

```cpp
#include <hip/hip_runtime.h>
#include <cstdio>
#include <cstdint>
#include <hip/hip_cooperative_groups.h>
namespace cg = cooperative_groups;

typedef unsigned short bf16_t;
#define DEV __device__ __forceinline__

constexpr int BATCH = 8, SEQ = 2048, DM = 1024, MTOK = BATCH * SEQ;
constexpr int NG = 64, NP = 64, GC = 16, NH = 4, DH = 256, CHUNK = 64, INC = 5120;
constexpr float EPS = 1e-6f;

DEV int opaque_tid() { int t = threadIdx.x; asm volatile("" : "+v"(t)); return t; }
#define TIDH (opaque_tid() & 255)
#define HALF (opaque_tid() >> 8)
DEV float bf2f(bf16_t v) { return __uint_as_float(((unsigned)v) << 16); }
DEV bf16_t f2bf(float f) { unsigned u = __float_as_uint(f); return (bf16_t)((u + 0x7fffu + ((u >> 16) & 1u)) >> 16); }
DEV float sigmoidf_(float x) { return 1.f / (1.f + __expf(-x)); }
DEV float siluf_(float x) { return x / (1.f + __expf(-x)); }
DEV float geluf_(float x) { float t = 0.7978845608028654f * (x + 0.044715f * x * x * x); return 0.5f * x * (1.f + tanhf(t)); }
DEV float logsigmoidf_(float x) { return fminf(x, 0.f) - log1pf(__expf(-fabsf(x))); }

DEV float wave_sum(float v) {
#pragma unroll
    for (int o = 1; o < 64; o <<= 1) v += __shfl_xor(v, o);
    return v;
}
DEV float block_sum256(float v, float* red) {
    v = wave_sum(v);
    __syncthreads();
    if ((TIDH & 63) == 0) red[TIDH >> 6] = v;
    __syncthreads();
    return red[0] + red[1] + red[2] + red[3];
}

DEV void k_mod(int vb, float* ldsf, const float* c, const float* w_mod, const float* b_mod, float* mod) {
    float (*sc)[DM] = (float (*)[DM])ldsf;
    const int l = vb / 12, n = (vb % 12) * 256 + TIDH;
    __syncthreads();
    for (int i = TIDH; i < BATCH * DM; i += 256) sc[i / DM][i % DM] = siluf_(c[i]);
    __syncthreads();
    float acc[BATCH];
#pragma unroll
    for (int b = 0; b < BATCH; ++b) acc[b] = 0.f;
    const float* W = w_mod + (size_t)l * DM * 3 * DM;
    for (int k = 0; k < DM; ++k) {
        float w = W[(size_t)k * 3 * DM + n];
#pragma unroll
        for (int b = 0; b < BATCH; ++b) acc[b] += sc[b][k] * w;
    }
#pragma unroll
    for (int b = 0; b < BATCH; ++b) mod[((size_t)l * BATCH + b) * 3 * DM + n] = acc[b] + b_mod[l * 3 * DM + n];
}

DEV void k_norm_mod(int vb, float* red, const float* x, const float* gain, const float* mod  , bf16_t* h) {
    const int m = vb, b = m / SEQ, t = TIDH;
    const float4 v = ((const float4*)(x + (size_t)m * DM))[t];
    float ss = v.x * v.x + v.y * v.y + v.z * v.z + v.w * v.w;
    ss = block_sum256(ss, red);
    const float rstd = rsqrtf(ss * (1.f / DM) + EPS);
    const float* shift = mod + (size_t)b * 3 * DM;
    const float* scale = shift + DM;
    float xv[4] = {v.x, v.y, v.z, v.w};
#pragma unroll
    for (int i = 0; i < 4; ++i) {
        int n = t * 4 + i;
        float y = xv[i] * rstd * gain[n] * (1.f + scale[n]) + shift[n];
        h[(size_t)m * DM + n] = f2bf(y);
    }
}

DEV void k_s5(int item, float* ldsf, const bf16_t* u, bf16_t* y, const float* lam_re, const float* lam_im, const float* log_dt,
                                           const float* b_re, const float* b_im, const float* c_re, const float* c_im, const float* dskip) {
    const int tid_ = opaque_tid();
    float (*part)[17] = (float (*)[17])(ldsf + (tid_ >> 6) * 64 * 17);
    const int g = item & 63, b = item >> 6, p = tid_ & 63;
    const double lr = lam_re[g * NP + p], li = lam_im[g * NP + p], dt = exp((double)log_dt[g]);
    const double er = exp(lr * dt);
    const double ard = er * cos(li * dt), aid = er * sin(li * dt);
    const double dr = ard - 1.0, di = aid, den = lr * lr + li * li;
    const double cr = (dr * lr + di * li) / den, ci = (di * lr - dr * li) / den;
    float bbr[16], bbi[16], ccr[16], cci[16];
#pragma unroll
    for (int c = 0; c < 16; ++c) {
        const double br = b_re[(g * NP + p) * GC + c], bi = b_im[(g * NP + p) * GC + c];
        bbr[c] = (float)(cr * br - ci * bi); bbi[c] = (float)(cr * bi + ci * br);
        ccr[c] = c_re[(g * GC + c) * NP + p]; cci[c] = c_im[(g * GC + c) * NP + p];
    }
    const float ar = (float)ard, ai = (float)aid;
    const float dsk = dskip[g * GC + (p & 15)];
    float sr = 0.f, si = 0.f;
    for (int t = 0; t < SEQ; ++t) {
        const bf16_t* up = u + (size_t)(b * SEQ + t) * DM + g * GC;
        const uint4 u0 = *(const uint4*)up, u1 = *(const uint4*)(up + 8);
        float uf[16];
        uf[0] = bf2f(u0.x & 0xffff); uf[1] = bf2f(u0.x >> 16); uf[2] = bf2f(u0.y & 0xffff); uf[3] = bf2f(u0.y >> 16);
        uf[4] = bf2f(u0.z & 0xffff); uf[5] = bf2f(u0.z >> 16); uf[6] = bf2f(u0.w & 0xffff); uf[7] = bf2f(u0.w >> 16);
        uf[8] = bf2f(u1.x & 0xffff); uf[9] = bf2f(u1.x >> 16); uf[10] = bf2f(u1.y & 0xffff); uf[11] = bf2f(u1.y >> 16);
        uf[12] = bf2f(u1.z & 0xffff); uf[13] = bf2f(u1.z >> 16); uf[14] = bf2f(u1.w & 0xffff); uf[15] = bf2f(u1.w >> 16);
        float bur = 0.f, bui = 0.f;
#pragma unroll
        for (int c = 0; c < 16; ++c) { bur += bbr[c] * uf[c]; bui += bbi[c] * uf[c]; }
        const float nr = ar * sr - ai * si + bur, ni = ar * si + ai * sr + bui;
        sr = nr; si = ni;
#pragma unroll
        for (int c = 0; c < 16; ++c) part[p][c] = ccr[c] * sr - cci[c] * si;
        asm volatile("s_waitcnt lgkmcnt(0)" ::: "memory");
        float s = 0.f;
#pragma unroll
        for (int k = 0; k < 16; ++k) s += part[(p >> 4) * 16 + k][p & 15];
        s += __shfl_xor(s, 16); s += __shfl_xor(s, 32);
        if (p < 16) {
            const float yv = s + dsk * bf2f(up[p]);
            y[(size_t)(b * SEQ + t) * DM + g * GC + p] = f2bf(geluf_(yv));
        }
        asm volatile("s_waitcnt lgkmcnt(0)" ::: "memory");
    }
}

DEV void k_ssm_post(int vb, float* red, bf16_t* z, const bf16_t* sg, const float* gain) {
    const int m = vb, t = TIDH;
    float zv[4]; float ss = 0.f;
#pragma unroll
    for (int i = 0; i < 4; ++i) { zv[i] = bf2f(z[(size_t)m * DM + t * 4 + i]); ss += zv[i] * zv[i]; }
    ss = block_sum256(ss, red);
    const float rstd = rsqrtf(ss * (1.f / DM) + EPS);
#pragma unroll
    for (int i = 0; i < 4; ++i) {
        const int n = t * 4 + i;
        z[(size_t)m * DM + n] = f2bf(zv[i] * rstd * gain[n] * siluf_(bf2f(sg[(size_t)m * DM + n])));
    }
}

DEV float conv_xc(const bf16_t* mi, int m, int n, const float* cw, const float* cb) {
    const int t = m % SEQ;
    float acc = cb[n];
#pragma unroll
    for (int j = 0; j < 4; ++j) {
        const int tt = t - 3 + j;
        if (tt >= 0) acc += bf2f(mi[(size_t)(m - 3 + j) * DM + n]) * cw[j * DM + n];
    }
    return siluf_(acc);
}
DEV void k_conv(int vb, const bf16_t* mi, bf16_t* xc, const float* cw, const float* cb) {
    const size_t idx = (size_t)vb * 256 + TIDH;
    const int m = (int)(idx / DM), n = (int)(idx % DM);
    xc[idx] = f2bf(conv_xc(mi, m, n, cw, cb));
}

DEV void k_gates(int vb, float* ldsf, const bf16_t* q, const bf16_t* k, const bf16_t* v, const float* wg  , const float* bi, const float* bfg,
                                               float* ipre, float* logf) {
    float (*red)[8] = (float (*)[8])ldsf;
    const int m = vb, t = TIDH;
    __syncthreads();
    float acc[8];
#pragma unroll
    for (int j = 0; j < 8; ++j) acc[j] = 0.f;
    for (int e = t; e < 3 * DM; e += 256) {
        const bf16_t* src = (e < DM) ? q : (e < 2 * DM ? k : v);
        const float xv = bf2f(src[(size_t)m * DM + (e & (DM - 1))]);
#pragma unroll
        for (int j = 0; j < 8; ++j) acc[j] += xv * wg[e * 8 + j];
    }
#pragma unroll
    for (int j = 0; j < 8; ++j) acc[j] = wave_sum(acc[j]);
    if ((t & 63) == 0) {
#pragma unroll
        for (int j = 0; j < 8; ++j) red[t >> 6][j] = acc[j];
    }
    __syncthreads();
    if (t < 8) {
        const float s = red[0][t] + red[1][t] + red[2][t] + red[3][t];
        if (t < 4) ipre[(size_t)m * 4 + t] = s + bi[t];
        else logf[(size_t)m * 4 + (t - 4)] = logsigmoidf_(s + bfg[t - 4]);
    }
}

DEV void k_mlstm(int vb, float* ldsf, const bf16_t* q, const bf16_t* k, const bf16_t* v, const float* ipre, const float* logf, bf16_t* hc) {
    float (*Cs)[257] = (float (*)[257])ldsf;
    float (*St)[65] = (float (*)[65])(ldsf + 32 * 257);
    float* nvec = ldsf + 32 * 257 + 64 * 65;
    float* bcum = nvec + 256; float* ig = bcum + 64; float* mt = ig + 64; float* winter = mt + 64; float* ws_ = winter + 64; float* hden = ws_ + 64;
    float* sc = hden + 64;
    const int tid = TIDH;
    const int vs = vb & 7, h = (vb >> 3) & 3, b = vb >> 5;
    __syncthreads();
    for (int i = tid; i < 32 * 257; i += 256) (&Cs[0][0])[i] = 0.f;
    nvec[tid] = 0.f;
    if (tid == 0) sc[0] = 0.f;
    __syncthreads();
    const size_t base = (size_t)b * SEQ * DM + h * DH;
    for (int j = 0; j < SEQ / CHUNK; ++j) {
        const size_t cb = base + (size_t)j * CHUNK * DM;
        const int m0 = b * SEQ + j * CHUNK;
        if (tid < 64) {
            ig[tid] = ipre[(size_t)(m0 + tid) * 4 + h];
            ws_[tid] = logf[(size_t)(m0 + tid) * 4 + h];
        }
        __syncthreads();
        if (tid < 64) { float s = 0.f; for (int i = 0; i <= tid; ++i) s += ws_[i]; bcum[tid] = s; }
        __syncthreads();
        const float m_prev = sc[0];
        if (tid < 64) {
            const float m_inter = bcum[tid] + m_prev;
            float mx = -INFINITY;
            for (int s = 0; s <= tid; ++s) mx = fmaxf(mx, bcum[tid] - bcum[s] + ig[s]);
            const float m = fmaxf(m_inter, mx);
            mt[tid] = m; winter[tid] = __expf(m_inter - m);
        }
        __syncthreads();
        for (int idx = tid; idx < 4096; idx += 256) {
            const int t = idx >> 6, s = idx & 63;
            float r = 0.f;
            if (s <= t) {
                const bf16_t* qp = q + cb + (size_t)t * DM; const bf16_t* kp = k + cb + (size_t)s * DM;
                float dot = 0.f;
                for (int d = 0; d < DH; d += 8) {
                    const uint4 qa = *(const uint4*)(qp + d), ka = *(const uint4*)(kp + d);
                    dot += bf2f(qa.x & 0xffff) * bf2f(ka.x & 0xffff) + bf2f(qa.x >> 16) * bf2f(ka.x >> 16);
                    dot += bf2f(qa.y & 0xffff) * bf2f(ka.y & 0xffff) + bf2f(qa.y >> 16) * bf2f(ka.y >> 16);
                    dot += bf2f(qa.z & 0xffff) * bf2f(ka.z & 0xffff) + bf2f(qa.z >> 16) * bf2f(ka.z >> 16);
                    dot += bf2f(qa.w & 0xffff) * bf2f(ka.w & 0xffff) + bf2f(qa.w >> 16) * bf2f(ka.w >> 16);
                }
                r = dot * __expf(bcum[t] - bcum[s] + ig[s] - mt[t]);
            }
            St[t][s] = r;
        }
        __syncthreads();
        if (tid < 64) {
            const bf16_t* qp = q + cb + (size_t)tid * DM;
            float dn = 0.f;
            for (int d = 0; d < DH; ++d) dn += nvec[d] * bf2f(qp[d]);
            float sm = 0.f;
            for (int s = 0; s < 64; ++s) sm += St[tid][s];
            const float den = winter[tid] * dn + sm;
            hden[tid] = fmaxf(fabsf(den), __expf(-mt[tid]));
        }
        __syncthreads();
        for (int idx = tid; idx < 2048; idx += 256) {
            const int t = idx >> 5, vv = idx & 31;
            const bf16_t* qp = q + cb + (size_t)t * DM;
            float a = 0.f;
            for (int d = 0; d < DH; ++d) a += Cs[vv][d] * bf2f(qp[d]);
            float s2 = 0.f;
            for (int s = 0; s < 64; ++s) s2 += St[t][s] * bf2f(v[cb + (size_t)s * DM + vs * 32 + vv]);
            const float num = winter[t] * a + s2;
            hc[cb + (size_t)t * DM + vs * 32 + vv] = f2bf(num / hden[t]);
        }
        __syncthreads();
        const float b_tot = bcum[63];
        if (tid < 64) ws_[tid] = b_tot - bcum[tid] + ig[tid];
        __syncthreads();
        if (tid == 0) {
            float mx = b_tot + m_prev;
            for (int s = 0; s < 64; ++s) mx = fmaxf(mx, ws_[s]);
            sc[1] = __expf(b_tot + m_prev - mx); sc[0] = mx;
        }
        __syncthreads();
        const float m_next = sc[0], decay = sc[1];
        float myw = 0.f;
        if (tid < 64) myw = __expf(ws_[tid] - m_next);
        __syncthreads();
        if (tid < 64) ws_[tid] = myw;
        __syncthreads();
        for (int idx = tid; idx < 32 * 256; idx += 256) {
            const int vv = idx >> 8, d = idx & 255;
            float a = 0.f;
            for (int s = 0; s < 64; ++s) a += ws_[s] * bf2f(v[cb + (size_t)s * DM + vs * 32 + vv]) * bf2f(k[cb + (size_t)s * DM + d]);
            Cs[vv][d] = decay * Cs[vv][d] + a;
        }
        {
            float a = 0.f;
            for (int s = 0; s < 64; ++s) a += ws_[s] * bf2f(k[cb + (size_t)s * DM + tid]);
            nvec[tid] = decay * nvec[tid] + a;
        }
        __syncthreads();
    }
}

DEV void k_mlstm_post(int vb, bf16_t* hc, const bf16_t* mo, const bf16_t* mg, const bf16_t* mi, const float* cw, const float* cb,
                                                    const float* ngain, const float* skip) {
    const int m = vb, t = TIDH;
    float hv[4]; float s = 0.f;
#pragma unroll
    for (int i = 0; i < 4; ++i) {
        const size_t o = (size_t)m * DM + t * 4 + i;
        hv[i] = bf2f(hc[o]) * sigmoidf_(bf2f(mo[o])); s += hv[i];
    }
    const float mu = wave_sum(s) * (1.f / DH);
    float s2 = 0.f;
#pragma unroll
    for (int i = 0; i < 4; ++i) { hv[i] -= mu; s2 += hv[i] * hv[i]; }
    const float rstd = rsqrtf(wave_sum(s2) * (1.f / DH) + EPS);
#pragma unroll
    for (int i = 0; i < 4; ++i) {
        const int n = t * 4 + i; const size_t o = (size_t)m * DM + n;
        const float xc = conv_xc(mi, m, n, cw, cb);
        const float hn = hv[i] * rstd * ngain[n] + skip[n] * xc;
        hc[o] = f2bf(hn * siluf_(bf2f(mg[o])));
    }
}

DEV void k_final(int vb, float* red, float* x, const float* gain) {
    const int m = vb, t = TIDH;
    float4 v = ((float4*)(x + (size_t)m * DM))[t];
    float ss = v.x * v.x + v.y * v.y + v.z * v.z + v.w * v.w;
    ss = block_sum256(ss, red);
    const float rstd = rsqrtf(ss * (1.f / DM) + EPS);
    const float4 g = ((const float4*)gain)[t];
    v.x *= rstd * g.x; v.y *= rstd * g.y; v.z *= rstd * g.z; v.w *= rstd * g.w;
    ((float4*)(x + (size_t)m * DM))[t] = v;
}


#define LAS __attribute__((address_space(3)))
typedef short bf16x8 __attribute__((ext_vector_type(8)));
typedef float f32x4 __attribute__((ext_vector_type(4)));
#define WAIT_V(n) asm volatile("s_waitcnt vmcnt(" #n ")" ::: "memory")
#define WAIT_L(n) asm volatile("s_waitcnt lgkmcnt(" #n ")" ::: "memory")
#define SCHED() __builtin_amdgcn_sched_barrier(0)

DEV int lds_byte(int r, int c) { int st = (r >> 4) * 2 + (c >> 5), ob = (r & 15) * 64 + (c & 31) * 2; return st * 1024 + (ob ^ (((ob >> 9) & 1) << 5)); }
DEV void stage_rc(int b, int& R, int& C) { int st = b >> 10, sb = b & 1023, swz = sb ^ (((sb >> 9) & 1) << 5); R = (st >> 1) * 16 + swz / 64; C = (st & 1) * 32 + (swz % 64) / 2; }
template <class T> DEV T* sel3(int w, T* p0, T* p1, T* p2) { return p0 + ((w >= 1) ? (p1 - p0) : 0) + ((w >= 2) ? (p2 - p1) : 0); }
DEV uint2 pack4(f32x4 v) { uint2 r; r.x = (unsigned)f2bf(v[0]) | ((unsigned)f2bf(v[1]) << 16); r.y = (unsigned)f2bf(v[2]) | ((unsigned)f2bf(v[3]) << 16); return r; }

template <class Prob>
DEV void gemm_phase(LAS char* shm, const Prob& pb) {
    constexpr int TILE_B = 256 * 64 * 2, STAGE_B = 2 * TILE_B;
    const int tid = opaque_tid(), wid = __builtin_amdgcn_readfirstlane(tid >> 6), lane = tid & 63, wr = wid >> 2, wc = wid & 3, fr = lane & 15, fq = lane >> 4;
    int sR[4], sC[4];
#pragma unroll
    for (int i = 0; i < 4; ++i) stage_rc(wid * 1024 + i * 8192 + lane * 16, sR[i], sC[i]);
    const int nN = pb.nN, ntiles = 64 * nN, nt = Prob::K / 64, lda = Prob::lda, ldb = Prob::ldb;
    for (int t = blockIdx.x; t < ntiles; t += gridDim.x) {
        const int base = t & ~255, loc = t & 255;
        const int w = base + (loc & 7) * 32 + (loc >> 3);
        const int nig = 8 * nN, gid = w / nig, pm = gid * 8 + (w % nig) % 8, pn = (w % nig) / 8;
        const int brow = pm * 256, bcol = pn * 256;
        const bf16_t* Bb = pb.bptr(pn);
#define GLDS_STAGE(buf, kt) do { const bf16_t* Ak_ = pb.aptr(pn, kt) + (long)brow * lda; const bf16_t* Bk_ = Bb + (kt) * 64; \
        _Pragma("unroll") for (int i = 0; i < 4; ++i) { \
            __builtin_amdgcn_global_load_lds((const unsigned*)(Ak_ + (long)sR[i] * lda + sC[i]), (LAS unsigned*)(shm + (buf) * STAGE_B + wid * 1024 + i * 8192), 16, 0, 0); \
            __builtin_amdgcn_global_load_lds((const unsigned*)(Bk_ + (long)sR[i] * ldb + sC[i]), (LAS unsigned*)(shm + (buf) * STAGE_B + TILE_B + wid * 1024 + i * 8192), 16, 0, 0); } } while (0)
        f32x4 acc[8][4];
#pragma unroll
        for (int m = 0; m < 8; ++m)
#pragma unroll
            for (int n = 0; n < 4; ++n) acc[m][n] = (f32x4){0.f, 0.f, 0.f, 0.f};
        GLDS_STAGE(0, 0); WAIT_V(0); __syncthreads();
#pragma nounroll
        for (int kt = 0; kt < nt; ++kt) {
            const int cur = kt & 1;
            if (kt + 1 < nt) GLDS_STAGE(cur ^ 1, kt + 1);
#pragma unroll
            for (int ks = 0; ks < 2; ++ks) {
                bf16x8 At[8], Bf[4];
#pragma unroll
                for (int m = 0; m < 8; ++m) At[m] = *(const LAS bf16x8*)(shm + cur * STAGE_B + lds_byte(wr * 128 + m * 16 + fr, ks * 32 + fq * 8));
#pragma unroll
                for (int n = 0; n < 4; ++n) Bf[n] = *(const LAS bf16x8*)(shm + cur * STAGE_B + TILE_B + lds_byte(wc * 64 + n * 16 + fr, ks * 32 + fq * 8));
#pragma unroll
                for (int m = 0; m < 8; ++m)
#pragma unroll
                    for (int n = 0; n < 4; ++n) acc[m][n] = __builtin_amdgcn_mfma_f32_16x16x32_bf16(Bf[n], At[m], acc[m][n], 0, 0, 0);
                SCHED();
            }
            WAIT_V(0); __syncthreads();
        }
#undef GLDS_STAGE
#pragma unroll
        for (int m = 0; m < 8; ++m)
#pragma unroll
            for (int n = 0; n < 4; ++n) pb.epi(pn, brow + wr * 128 + m * 16 + fr, bcol + wc * 64 + n * 16 + fq * 4, acc[m][n]);
    }
}

struct ProbIn {
    static constexpr int K = 1024, lda = 1024, ldb = 1024;
    const bf16_t* H; const bf16_t* Wt; bf16_t* C0; bf16_t* C1; bf16_t* C2; int nN;
    DEV const bf16_t* aptr(int pn, int kt) const { return H + kt * 64; }
    DEV const bf16_t* bptr(int pn) const { return Wt + (long)pn * 256 * 1024; }
    DEV void epi(int pn, int row, int col, f32x4 v) const {
        bf16_t* C = sel3(col >> 10, C0, C1, C2);
        *(uint2*)(C + (size_t)row * DM + (col & 1023)) = pack4(v);
    }
};
struct ProbGlu {
    static constexpr int K = 1024, lda = 1024, ldb = 1024;
    const bf16_t* Y; const bf16_t* Wt; bf16_t* Z; const float* bias; int nN;
    DEV const bf16_t* aptr(int pn, int kt) const { return Y + kt * 64; }
    DEV const bf16_t* bptr(int pn) const { return Wt + (long)pn * 256 * 1024; }
    DEV void epi(int pn, int row, int col, f32x4 v) const {
        const uint2 yv = *(const uint2*)(Y + (size_t)row * DM + col);
        const float4 b = *(const float4*)(bias + col);
        f32x4 o;
        o[0] = bf2f(yv.x & 0xffff) * sigmoidf_(v[0] + b.x); o[1] = bf2f(yv.x >> 16) * sigmoidf_(v[1] + b.y);
        o[2] = bf2f(yv.y & 0xffff) * sigmoidf_(v[2] + b.z); o[3] = bf2f(yv.y >> 16) * sigmoidf_(v[3] + b.w);
        *(uint2*)(Z + (size_t)row * DM + col) = pack4(o);
    }
};
struct ProbQkv {
    static constexpr int K = 256, lda = 1024, ldb = 256;
    const bf16_t* XC; const bf16_t* MI; const bf16_t* Wt; bf16_t* Q; bf16_t* Kk; bf16_t* V; int nN;
    DEV const bf16_t* aptr(int pn, int kt) const { return ((pn >> 2) == 2 ? MI : XC) + (pn & 3) * 256 + kt * 64; }
    DEV const bf16_t* bptr(int pn) const { return Wt + (long)pn * 256 * 256; }
    DEV void epi(int pn, int row, int col, f32x4 v) const {
        const int which = pn >> 2; bf16_t* C = sel3(which, Q, Kk, V);
        if (which == 1) { v[0] *= 0.0625f; v[1] *= 0.0625f; v[2] *= 0.0625f; v[3] *= 0.0625f; }
        *(uint2*)(C + (size_t)row * DM + (col & 1023)) = pack4(v);
    }
};
struct ProbOut {
    static constexpr int K = 2048, lda = 1024, ldb = 2048;
    const bf16_t* A1; const bf16_t* A2; const bf16_t* Wt; const float* xin; float* xout; const float* gate; int nN;
    DEV const bf16_t* aptr(int pn, int kt) const { return (kt < 16) ? (A1 + kt * 64) : (A2 + (kt - 16) * 64); }
    DEV const bf16_t* bptr(int pn) const { return Wt + (long)pn * 256 * 2048; }
    DEV void epi(int pn, int row, int col, f32x4 v) const {
        const int b = row / SEQ;
        const float4 xi = *(const float4*)(xin + (size_t)row * DM + col);
        const float4 g = *(const float4*)(gate + (size_t)b * 3 * DM + col);
        float4 o; o.x = xi.x + g.x * v[0]; o.y = xi.y + g.y * v[1]; o.z = xi.z + g.z * v[2]; o.w = xi.w + g.w * v[3];
        *(float4*)(xout + (size_t)row * DM + col) = o;
    }
};

DEV void transpose_item(const float* W, int ldw, int ncols, bf16_t* WT, int ldwt, LAS float* scr, int item, int lane) {
    const int nblk = ncols / 32, kb = item / nblk, nb = item % nblk, k0 = 64 * kb, n0 = 32 * nb;
#pragma unroll 8
    for (int i = 0; i < 32; ++i) { const int kk = 2 * i + (lane >> 5); scr[kk * 33 + (lane & 31)] = W[(size_t)(k0 + kk) * ldw + n0 + (lane & 31)]; }
    asm volatile("s_waitcnt lgkmcnt(0)" ::: "memory");
    const int c = lane & 7;
#pragma unroll
    for (int j = 0; j < 4; ++j) {
        const int n = (lane >> 3) + 8 * j; const LAS float* s = scr + (8 * c) * 33 + n;
        uint4 o;
        o.x = (unsigned)f2bf(s[0 * 33]) | ((unsigned)f2bf(s[1 * 33]) << 16); o.y = (unsigned)f2bf(s[2 * 33]) | ((unsigned)f2bf(s[3 * 33]) << 16);
        o.z = (unsigned)f2bf(s[4 * 33]) | ((unsigned)f2bf(s[5 * 33]) << 16); o.w = (unsigned)f2bf(s[6 * 33]) | ((unsigned)f2bf(s[7 * 33]) << 16);
        *(uint4*)(WT + (size_t)(n0 + n) * ldwt + k0 + 8 * c) = o;
    }
    asm volatile("s_waitcnt lgkmcnt(0)" ::: "memory");
}

typedef short s16x4 __attribute__((ext_vector_type(4)));
typedef unsigned u32x4 __attribute__((ext_vector_type(4)));
typedef unsigned u32x2 __attribute__((ext_vector_type(2)));
typedef float f32x2 __attribute__((ext_vector_type(2)));
DEV float wave_scan_add(float v, int lane) {
#pragma unroll
    for (int o = 1; o < 64; o <<= 1) { const float u = __shfl_up(v, o); if (lane >= o) v += u; }
    return v;
}
DEV float wave_scan_max(float v, int lane) {
#pragma unroll
    for (int o = 1; o < 64; o <<= 1) { const float u = __shfl_up(v, o); if (lane >= o) v = fmaxf(v, u); }
    return v;
}
DEV unsigned pk2(float lo, float hi) { return (unsigned)f2bf(lo) | ((unsigned)f2bf(hi) << 16); }

DEV void mlstm_phase(LAS char* shm, const bf16_t* q, const bf16_t* k, const bf16_t* v, const float* ipre, const float* logf, bf16_t* hc) {
    const int tid = opaque_tid(), wid = __builtin_amdgcn_readfirstlane(tid >> 6), lane = tid & 63, fr = lane & 15, fq = lane >> 4;
    constexpr int QS = 0, KS = 33792, VT = 67584, VWT = 74496, CB = 81408, PART = 106752, SC = 120064, RS = 528, VRS = 144, PRS = 52;
    LAS float* sc = (LAS float*)(shm + SC);
    LAS float* part = (LAS float*)(shm + PART);
    for (int item = blockIdx.x; item < BATCH * NH * 8; item += gridDim.x) {
        const int vs = (item >> 3) & 7, bh = (item & 7) + 8 * (item >> 6), h = bh & 3, b = bh >> 2;
        __syncthreads();
        for (int i = tid; i < (CB + 25344 - VT) / 4; i += 512) ((LAS unsigned*)(shm + VT))[i] = 0u;
        __syncthreads();
        if (tid < 64) *(LAS bf16_t*)(shm + VT + 32 * VRS + tid * 2) = (bf16_t)0x3F80;
        f32x4 cacc[2][3];
#pragma unroll
        for (int i = 0; i < 2; ++i)
#pragma unroll
            for (int vt = 0; vt < 3; ++vt) cacc[i][vt] = (f32x4){0.f, 0.f, 0.f, 0.f};
        float m_prev = 0.f;
#pragma nounroll
        for (int j = 0; j < SEQ / CHUNK; ++j) {
            const size_t cb = ((size_t)(b * SEQ + j * CHUNK)) * DM + h * DH;
            const int m0 = b * SEQ + j * CHUNK;
            uint4 qv[4], kv[4], vv = make_uint4(0, 0, 0, 0);
#pragma unroll
            for (int i = 0; i < 4; ++i) {
                const int idx = tid + 512 * i, row = idx >> 5, c16 = idx & 31;
                qv[i] = *(const uint4*)(q + cb + (size_t)row * DM + c16 * 8);
                kv[i] = *(const uint4*)(k + cb + (size_t)row * DM + c16 * 8);
            }
            if (tid < 256) vv = *(const uint4*)(v + cb + (size_t)(tid >> 2) * DM + vs * 32 + (tid & 3) * 8);
            if (wid == 0) {
                const float lf = logf[(size_t)(m0 + lane) * 4 + h], ig = ipre[(size_t)(m0 + lane) * 4 + h];
                const float bc = wave_scan_add(lf, lane);
                const float a = ig - bc;
                const float pm = wave_scan_max(a, lane);
                const float btot = __shfl(bc, 63), amax = __shfl(pm, 63);
                const float mt = bc + fmaxf(m_prev, pm);
                sc[lane] = bc - mt; sc[64 + lane] = a; sc[128 + lane] = __expf(bc + m_prev - mt); sc[192 + lane] = __expf(-mt);
                const float m_next = btot + fmaxf(m_prev, amax);
                sc[256 + lane] = __expf(btot + a - m_next);
                if (lane == 0) sc[320] = __expf(btot + m_prev - m_next);
                m_prev = m_next;
            }
#pragma unroll
            for (int i = 0; i < 4; ++i) {
                const int idx = tid + 512 * i, row = idx >> 5, c16 = idx & 31;
                *(LAS u32x4*)(shm + QS + row * RS + c16 * 16) = (u32x4){qv[i].x, qv[i].y, qv[i].z, qv[i].w};
                *(LAS u32x4*)(shm + KS + row * RS + c16 * 16) = (u32x4){kv[i].x, kv[i].y, kv[i].z, kv[i].w};
            }
            if (tid < 256) {
                const int s_ = tid >> 2, v0 = (tid & 3) * 8;
                const unsigned w_[4] = {vv.x, vv.y, vv.z, vv.w};
#pragma unroll
                for (int e = 0; e < 8; ++e) *(LAS bf16_t*)(shm + VT + (v0 + e) * VRS + s_ * 2) = (bf16_t)((w_[e >> 1] >> ((e & 1) * 16)) & 0xffff);
            }
            __syncthreads();
            if (tid < 256) {
                const int s_ = tid >> 2, v0 = (tid & 3) * 8;
                const float ws = sc[256 + s_];
                const unsigned w_[4] = {vv.x, vv.y, vv.z, vv.w};
#pragma unroll
                for (int e = 0; e < 8; ++e) *(LAS bf16_t*)(shm + VWT + (v0 + e) * VRS + s_ * 2) = f2bf(ws * bf2f((bf16_t)((w_[e >> 1] >> ((e & 1) * 16)) & 0xffff)));
            } else if (tid < 320) {
                *(LAS bf16_t*)(shm + VWT + 32 * VRS + (tid - 256) * 2) = f2bf(sc[256 + tid - 256]);
            }
            f32x4 nacc[3];
#pragma unroll
            for (int vt = 0; vt < 3; ++vt) nacc[vt] = (f32x4){0.f, 0.f, 0.f, 0.f};
            const int tt = wid & 3;
            if (wid < 4) {
                f32x4 sacc[4];
#pragma unroll
                for (int jj = 0; jj < 4; ++jj) sacc[jj] = (f32x4){0.f, 0.f, 0.f, 0.f};
#pragma unroll
                for (int ks = 0; ks < 8; ++ks) {
                    const bf16x8 qf = *(const LAS bf16x8*)(shm + QS + (16 * tt + fr) * RS + (32 * ks + 8 * fq) * 2);
#pragma unroll
                    for (int jj = 0; jj < 4; ++jj) if (jj <= tt) {
                        const bf16x8 kf = *(const LAS bf16x8*)(shm + KS + (16 * jj + fr) * RS + (32 * ks + 8 * fq) * 2);
                        sacc[jj] = __builtin_amdgcn_mfma_f32_16x16x32_bf16(kf, qf, sacc[jj], 0, 0, 0);
                    }
                }
                const int t = 16 * tt + fr;
                const float btm = sc[t];
#pragma unroll
                for (int jj = 0; jj < 4; ++jj) {
                    const f32x4 a4 = *(const LAS f32x4*)(sc + 64 + 16 * jj + 4 * fq);
#pragma unroll
                    for (int r = 0; r < 4; ++r) {
                        const int s_ = 16 * jj + 4 * fq + r;
                        sacc[jj][r] = (s_ <= t) ? sacc[jj][r] * __expf(btm + a4[r]) : 0.f;
                    }
                }
#pragma unroll
                for (int kk = 0; kk < 2; ++kk) if (2 * kk <= tt) {
                    bf16x8 af;
                    { const unsigned p0 = pk2(sacc[2 * kk][0], sacc[2 * kk][1]), p1 = pk2(sacc[2 * kk][2], sacc[2 * kk][3]);
                      const unsigned p2 = pk2(sacc[2 * kk + 1][0], sacc[2 * kk + 1][1]), p3 = pk2(sacc[2 * kk + 1][2], sacc[2 * kk + 1][3]);
                      const u32x4 u = (u32x4){p0, p1, p2, p3}; af = *(const bf16x8*)&u; }
#pragma unroll
                    for (int vt = 0; vt < 3; ++vt) {
                        const u32x2 lo = *(const LAS u32x2*)(shm + VT + (16 * vt + fr) * VRS + (32 * kk + 4 * fq) * 2);
                        const u32x2 hi = *(const LAS u32x2*)(shm + VT + (16 * vt + fr) * VRS + (32 * kk + 16 + 4 * fq) * 2);
                        const u32x4 u = (u32x4){lo[0], lo[1], hi[0], hi[1]};
                        nacc[vt] = __builtin_amdgcn_mfma_f32_16x16x32_bf16(af, *(const bf16x8*)&u, nacc[vt], 0, 0, 0);
                    }
                }
            } else {
#pragma unroll
                for (int ks = 0; ks < 8; ++ks) {
                    const bf16x8 qf = *(const LAS bf16x8*)(shm + QS + (16 * tt + fr) * RS + (32 * ks + 8 * fq) * 2);
#pragma unroll
                    for (int vt = 0; vt < 3; ++vt) {
                        const bf16x8 cf = *(const LAS bf16x8*)(shm + CB + (16 * vt + fr) * RS + (32 * ks + 8 * fq) * 2);
                        nacc[vt] = __builtin_amdgcn_mfma_f32_16x16x32_bf16(qf, cf, nacc[vt], 0, 0, 0);
                    }
                }
                const f32x4 wi = *(const LAS f32x4*)(sc + 128 + 16 * tt + 4 * fq);
#pragma unroll
                for (int vt = 0; vt < 3; ++vt)
#pragma unroll
                    for (int r = 0; r < 4; ++r) part[(16 * tt + 4 * fq + r) * PRS + 16 * vt + fr] = wi[r] * nacc[vt][r];
            }
            __syncthreads();
            if (wid < 4) {
                const f32x4 en = *(const LAS f32x4*)(sc + 192 + 16 * tt + 4 * fq);
#pragma unroll
                for (int vt = 0; vt < 3; ++vt)
#pragma unroll
                    for (int r = 0; r < 4; ++r) nacc[vt][r] += part[(16 * tt + 4 * fq + r) * PRS + 16 * vt + fr];
#pragma unroll
                for (int r = 0; r < 4; ++r) {
                    const float den = __shfl(nacc[2][r], lane & 48);
                    const float inv = 1.f / fmaxf(fabsf(den), en[r]);
                    const size_t o = cb + (size_t)(16 * tt + 4 * fq + r) * DM + vs * 32 + fr;
                    hc[o] = f2bf(nacc[0][r] * inv);
                    hc[o + 16] = f2bf(nacc[1][r] * inv);
                }
            }
            {
                const float decay = sc[320];
#pragma unroll
                for (int i = 0; i < 2; ++i)
#pragma unroll
                    for (int vt = 0; vt < 3; ++vt) cacc[i][vt] *= decay;
                const int q_ = fr >> 2, p_ = fr & 3;
#pragma unroll
                for (int kk = 0; kk < 2; ++kk) {
                    bf16x8 bfv[3];
#pragma unroll
                    for (int vt = 0; vt < 3; ++vt) bfv[vt] = *(const LAS bf16x8*)(shm + VWT + (16 * vt + fr) * VRS + (32 * kk + 8 * fq) * 2);
#pragma unroll
                    for (int i = 0; i < 2; ++i) {
                        const int dt = 2 * wid + i;
                        const s16x4 t0 = __builtin_amdgcn_ds_read_tr16_b64_v4i16((LAS s16x4*)(shm + KS + (32 * kk + 8 * fq + q_) * RS + (16 * dt + 4 * p_) * 2));
                        const s16x4 t1 = __builtin_amdgcn_ds_read_tr16_b64_v4i16((LAS s16x4*)(shm + KS + (32 * kk + 8 * fq + 4 + q_) * RS + (16 * dt + 4 * p_) * 2));
                        bf16x8 af; af[0] = t0[0]; af[1] = t0[1]; af[2] = t0[2]; af[3] = t0[3]; af[4] = t1[0]; af[5] = t1[1]; af[6] = t1[2]; af[7] = t1[3];
#pragma unroll
                        for (int vt = 0; vt < 3; ++vt) cacc[i][vt] = __builtin_amdgcn_mfma_f32_16x16x32_bf16(af, bfv[vt], cacc[i][vt], 0, 0, 0);
                    }
                }
#pragma unroll
                for (int i = 0; i < 2; ++i)
#pragma unroll
                    for (int vt = 0; vt < 3; ++vt) {
                        u32x2 o; o[0] = pk2(cacc[i][vt][0], cacc[i][vt][1]); o[1] = pk2(cacc[i][vt][2], cacc[i][vt][3]);
                        *(LAS u32x2*)(shm + CB + (16 * vt + fr) * RS + (16 * (2 * wid + i) + 4 * fq) * 2) = o;
                    }
            }
            __syncthreads();
        }
    }
}

constexpr int S5L = 32, S5NCH = SEQ / S5L;
constexpr size_t T_KT_OFF = 0, T_WS_OFF = 2u << 20, T_V_OFF = 10u << 20, T_AL_OFF = 18u << 20;
constexpr int KT_G = 33 * 256, WS_G = 128 * 512, V_G = 512 * 128;

DEV void s5_tables(LAS char* shm, char* tab, const float* lam_re, const float* lam_im, const float* log_dt, const float* b_re, const float* b_im,
                   const float* c_re, const float* c_im) {
    const int tid = opaque_tid();
    LAS f32x2* apw = (LAS f32x2*)shm;
    LAS f32x2* bb = (LAS f32x2*)(shm + 64 * 33 * 8);
    LAS f32x2* cc = (LAS f32x2*)(shm + 64 * 33 * 8 + 8192);
    bf16_t* KT = (bf16_t*)(tab + T_KT_OFF); bf16_t* WS = (bf16_t*)(tab + T_WS_OFF); bf16_t* VV = (bf16_t*)(tab + T_V_OFF); float2* AL = (float2*)(tab + T_AL_OFF);
    for (int it = blockIdx.x; it < 256; it += gridDim.x) {
        const int g = it & 63, qd = it >> 6;
        __syncthreads();
        if (tid < 64) {
            const int pp = tid;
            const double lr = lam_re[g * NP + pp], li = lam_im[g * NP + pp], dt = exp((double)log_dt[g]);
            const double er = exp(lr * dt);
            const double ar = er * cos(li * dt), ai = er * sin(li * dt);
            const double dr = ar - 1.0, di = ai, den = lr * lr + li * li;
            const double cr = (dr * lr + di * li) / den, ci = (di * lr - dr * li) / den;
            double pr = 1.0, pi_ = 0.0;
            for (int e = 0; e <= 32; ++e) {
                apw[pp * 33 + e] = (f32x2){(float)pr, (float)pi_};
                const double nr = pr * ar - pi_ * ai, ni = pr * ai + pi_ * ar; pr = nr; pi_ = ni;
            }
            if (qd == 0) { const f32x2 t_ = apw[pp * 33 + 32]; AL[g * NP + pp] = make_float2(t_.x, t_.y); }
            for (int c = 0; c < 16; ++c) {
                const double br = b_re[(g * NP + pp) * GC + c], bi = b_im[(g * NP + pp) * GC + c];
                bb[pp * 16 + c] = (f32x2){(float)(cr * br - ci * bi), (float)(cr * bi + ci * br)};
                cc[c * 64 + pp] = (f32x2){c_re[(g * GC + c) * NP + pp], c_im[(g * GC + c) * NP + pp]};
            }
        }
        __syncthreads();
        for (int o = tid; o < 8 * 256; o += 512) {
            const int d = 8 * qd + (o >> 8), c1 = (o >> 4) & 15, c0 = o & 15;
            float acc = 0.f;
            for (int pp = 0; pp < 64; ++pp) {
                const f32x2 a = apw[pp * 33 + d], b = bb[pp * 16 + c0], c = cc[c1 * 64 + pp];
                const float mr = a.x * b.x - a.y * b.y, mi = a.x * b.y + a.y * b.x;
                acc += c.x * mr - c.y * mi;
            }
            KT[(size_t)g * KT_G + (d + 1) * 256 + c1 * 16 + c0] = f2bf(acc);
        }
        if (qd == 0 && tid < 256) KT[(size_t)g * KT_G + tid] = 0;
        for (int o = tid; o < 2 * 16 * 64; o += 512) {
            const int mt = 2 * qd + (o >> 10), sp = (o >> 6) & 15, ln = o & 63;
            const int row = 16 * mt + (ln & 15), ri = row >> 6, pp = row & 63, s_ = 2 * sp + (ln >> 5), c0 = 8 * ((ln >> 4) & 1);
            const f32x2 a = apw[pp * 33 + 31 - s_];
            unsigned w[4];
#pragma unroll
            for (int jj = 0; jj < 8; jj += 2) {
                const f32x2 b0 = bb[pp * 16 + c0 + jj], b1 = bb[pp * 16 + c0 + jj + 1];
                const float v0 = ri ? (a.x * b0.y + a.y * b0.x) : (a.x * b0.x - a.y * b0.y);
                const float v1 = ri ? (a.x * b1.y + a.y * b1.x) : (a.x * b1.x - a.y * b1.y);
                w[jj >> 1] = (unsigned)f2bf(v0) | ((unsigned)f2bf(v1) << 16);
            }
            *(uint4*)(WS + (size_t)g * WS_G + ((size_t)(mt * 16 + sp) * 64 + ln) * 8) = make_uint4(w[0], w[1], w[2], w[3]);
        }
        for (int o = tid; o < 8 * 4 * 64; o += 512) {
            const int i = 8 * qd + (o >> 8), ks = (o >> 6) & 3, ln = o & 63;
            const int c1 = ln & 15, k0 = 32 * ks + 8 * (ln >> 4);
            unsigned w[4];
#pragma unroll
            for (int jj = 0; jj < 8; jj += 2) {
                float v[2];
#pragma unroll
                for (int e = 0; e < 2; ++e) {
                    const int kk = k0 + jj + e, ri = kk >> 6, pp = kk & 63;
                    const f32x2 a = apw[pp * 33 + i + 1], c = cc[c1 * 64 + pp];
                    v[e] = ri ? -(c.x * a.y + c.y * a.x) : (c.x * a.x - c.y * a.y);
                }
                w[jj >> 1] = (unsigned)f2bf(v[0]) | ((unsigned)f2bf(v[1]) << 16);
            }
            *(uint4*)(VV + (size_t)g * V_G + ((size_t)(i * 4 + ks) * 64 + ln) * 8) = make_uint4(w[0], w[1], w[2], w[3]);
        }
    }
}

DEV void s5_phase(LAS char* shm, bf16_t* UY, const char* tab, const float* dskip) {
    const int tid = opaque_tid(), wid = __builtin_amdgcn_readfirstlane(tid >> 6), lane = tid & 63, fr = lane & 15, fq = lane >> 4;
    constexpr int PLANE = 64 * 528, KTL = 2 * PLANE, SL = KTL + 33 * 512, HB = SL + 64 * 528, SRS = 528, HRS = 272;
    const bf16_t* KT = (const bf16_t*)(tab + T_KT_OFF); const bf16_t* WS = (const bf16_t*)(tab + T_WS_OFF); const bf16_t* VV = (const bf16_t*)(tab + T_V_OFF);
    const float2* AL = (const float2*)(tab + T_AL_OFF);
    for (int item = blockIdx.x; item < BATCH * NG; item += gridDim.x) {
        const int g = item & 63, b = item >> 6;
        bf16_t* Ub = UY + (size_t)b * SEQ * DM + g * GC;
        __syncthreads();
#pragma unroll
        for (int i = 0; i < 8; ++i) {
            const int idx = tid + 512 * i, tok = idx >> 1, hf = idx & 1;
            const uint4 uv = *(const uint4*)(Ub + (size_t)tok * DM + hf * 8);
            *(LAS u32x4*)(shm + hf * PLANE + (tok >> 5) * 528 + (tok & 31) * 16) = (u32x4){uv.x, uv.y, uv.z, uv.w};
        }
        for (int idx = tid; idx < 33 * 32; idx += 512) {
            const uint4 kv = *(const uint4*)(KT + (size_t)g * KT_G + idx * 8);
            *(LAS u32x4*)(shm + KTL + idx * 16) = (u32x4){kv.x, kv.y, kv.z, kv.w};
        }
        __syncthreads();
        f32x4 acc[4][4], sac[4];
#pragma unroll
        for (int q = 0; q < 4; ++q)
#pragma unroll
            for (int nt = 0; nt < 4; ++nt) acc[q][nt] = (f32x4){0.f, 0.f, 0.f, 0.f};
#pragma unroll
        for (int nt = 0; nt < 4; ++nt) sac[nt] = (f32x4){0.f, 0.f, 0.f, 0.f};
        const bf16_t* wsp = WS + (size_t)g * WS_G + ((size_t)(wid * 16) * 64 + lane) * 8;
        bf16x8 wnext = *(const bf16x8*)wsp;
#pragma nounroll
        for (int sp = 0; sp < 16; ++sp) {
            const bf16x8 wcur = wnext;
            if (sp + 1 < 16) wnext = *(const bf16x8*)(wsp + (size_t)(sp + 1) * 64 * 8);
            bf16x8 bu[4];
#pragma unroll
            for (int nt = 0; nt < 4; ++nt) bu[nt] = *(const LAS bf16x8*)(shm + (fq & 1) * PLANE + (16 * nt + fr) * 528 + (2 * sp + (fq >> 1)) * 16);
#pragma unroll
            for (int nt = 0; nt < 4; ++nt) sac[nt] = __builtin_amdgcn_mfma_f32_16x16x32_bf16(wcur, bu[nt], sac[nt], 0, 0, 0);
#pragma unroll
            for (int q = 0; q < 4; ++q) {
                const int i = wid + 8 * q;
                if (i >= 2 * sp) {
                    const int d = i - 2 * sp;
                    const bf16x8 kf = *(const LAS bf16x8*)(shm + KTL + (d - (fq >> 1) + 1) * 512 + fr * 32 + (fq & 1) * 16);
#pragma unroll
                    for (int nt = 0; nt < 4; ++nt) acc[q][nt] = __builtin_amdgcn_mfma_f32_16x16x32_bf16(kf, bu[nt], acc[q][nt], 0, 0, 0);
                }
            }
        }
#pragma unroll
        for (int nt = 0; nt < 4; ++nt) *(LAS f32x4*)(shm + SL + (16 * nt + fr) * SRS + (16 * wid + 4 * fq) * 4) = sac[nt];
        __syncthreads();
        if (wid == 0) {
            const float2 al = AL[g * NP + lane];
            float hr = 0.f, hi = 0.f;
#pragma unroll 8
            for (int n = 0; n < S5NCH; ++n) {
                *(LAS bf16_t*)(shm + HB + n * HRS + lane * 2) = f2bf(hr);
                *(LAS bf16_t*)(shm + HB + n * HRS + (64 + lane) * 2) = f2bf(hi);
                const float sr = *(const LAS float*)(shm + SL + n * SRS + lane * 4), si = *(const LAS float*)(shm + SL + n * SRS + (64 + lane) * 4);
                const float nr = al.x * hr - al.y * hi + sr, ni = al.x * hi + al.y * hr + si;
                hr = nr; hi = ni;
            }
        }
        __syncthreads();
        const bf16_t* vvp = VV + (size_t)g * V_G + (size_t)lane * 8;
#pragma unroll
        for (int ks = 0; ks < 4; ++ks) {
            bf16x8 hb[4], va[4];
#pragma unroll
            for (int q = 0; q < 4; ++q) va[q] = *(const bf16x8*)(vvp + ((size_t)((wid + 8 * q) * 4 + ks) * 64) * 8);
#pragma unroll
            for (int nt = 0; nt < 4; ++nt) hb[nt] = *(const LAS bf16x8*)(shm + HB + (16 * nt + fr) * HRS + (32 * ks + 8 * fq) * 2);
#pragma unroll
            for (int q = 0; q < 4; ++q)
#pragma unroll
                for (int nt = 0; nt < 4; ++nt) acc[q][nt] = __builtin_amdgcn_mfma_f32_16x16x32_bf16(va[q], hb[nt], acc[q][nt], 0, 0, 0);
        }
        const float4 dsk = *(const float4*)(dskip + g * GC + 4 * fq);
#pragma unroll
        for (int q = 0; q < 4; ++q) {
            const int i = wid + 8 * q;
#pragma unroll
            for (int nt = 0; nt < 4; ++nt) {
                const int n = 16 * nt + fr;
                const u32x2 uu = *(const LAS u32x2*)(shm + (fq >> 1) * PLANE + n * 528 + i * 16 + ((4 * fq) & 7) * 2);
                f32x4 o;
                o[0] = geluf_(acc[q][nt][0] + dsk.x * bf2f((bf16_t)(uu[0] & 0xffff))); o[1] = geluf_(acc[q][nt][1] + dsk.y * bf2f((bf16_t)(uu[0] >> 16)));
                o[2] = geluf_(acc[q][nt][2] + dsk.z * bf2f((bf16_t)(uu[1] & 0xffff))); o[3] = geluf_(acc[q][nt][3] + dsk.w * bf2f((bf16_t)(uu[1] >> 16)));
                *(uint2*)(Ub + (size_t)(n * 32 + i) * DM + 4 * fq) = pack4(o);
            }
        }
    }
}

struct Params {
    const float *x, *c, *norm_gain, *w_mod, *b_mod, *w_in, *lam_re, *lam_im, *log_dt, *sb_re, *sb_im, *sc_re, *sc_im, *ssm_d, *w_glu, *b_glu, *ssm_og,
        *conv_w, *conv_b, *wq, *wk, *wv, *w_gates, *b_ig, *b_fg, *m_ng, *m_skip, *w_out, *final_gain;
    float* out; char* ws;
};
constexpr int LDS_BYTES = 136 * 1024;
constexpr int HALF_FLOATS = 56 * 1024 / 4;
constexpr size_t SLOT = (size_t)MTOK * DM * 2;
constexpr size_t W_IN_OFF = 0, W_GLU_OFF = 10485760, W_QKV_OFF = 12582912, W_OUT_OFF = 14155776, MOD_OFF = 20u << 20, IPRE_OFF = 21u << 20, LOGF_OFF = 22u << 20;
#define FOR_VB(nvb) for (int vb = blockIdx.x * 2 + HALF; vb < (nvb); vb += gridDim.x * 2)

__global__ void __launch_bounds__(512, 2) mega(Params P) {
    extern __shared__ __attribute__((aligned(16))) unsigned char lds_raw[];
    LAS char* shm = (LAS char*)lds_raw;
    float* ldsf = (float*)lds_raw + HALF * HALF_FLOATS;
    cg::grid_group grid = cg::this_grid();
    bf16_t* S[7];
#pragma unroll
    for (int i = 0; i < 7; ++i) S[i] = (bf16_t*)(P.ws + SLOT * i);
    char* s7 = P.ws + SLOT * 7;
    bf16_t* WinT = (bf16_t*)(s7 + W_IN_OFF); bf16_t* WgluT = (bf16_t*)(s7 + W_GLU_OFF); bf16_t* WqkvT = (bf16_t*)(s7 + W_QKV_OFF); bf16_t* WoutT = (bf16_t*)(s7 + W_OUT_OFF);
    float* mod = (float*)(s7 + MOD_OFF);
    float* ipre = (float*)(s7 + IPRE_OFF);
    float* logf = (float*)(s7 + LOGF_OFF);
    float* out = P.out;
    FOR_VB(24) k_mod(vb, ldsf, P.c, P.w_mod, P.b_mod, mod);
    grid.sync();
    for (int l = 0; l < 2; ++l) {
        const int wave = opaque_tid() >> 6, lane = opaque_tid() & 63;
        const float* xin = (l == 0) ? P.x : out;
        const float* modl = mod + (size_t)l * BATCH * 3 * DM;
        bf16_t *H = S[0], *U = S[1], *Y = S[1], *Z = S[3], *SG = S[4], *MI = S[5], *Q = S[6], *Kb = S[1], *V = S[2], *XC = S[4], *HC = S[4], *MO = S[1], *MG = S[2];
        {
            LAS float* scr = (LAS float*)(shm + wave * 8448);
            const float* Win = P.w_in + (size_t)l * DM * INC;
            constexpr int I_IN = 16 * 160, I_GLU = 16 * 32, I_QKV = 12 * 32, I_OUT = 32 * 32;
            for (int it = blockIdx.x * 8 + wave; it < I_IN + I_GLU + I_QKV + I_OUT; it += gridDim.x * 8) {
                int r = it;
                if (r < I_IN) { transpose_item(Win, INC, INC, WinT, DM, scr, r, lane); continue; } r -= I_IN;
                if (r < I_GLU) { transpose_item(P.w_glu + (size_t)l * DM * DM, DM, DM, WgluT, DM, scr, r, lane); continue; } r -= I_GLU;
                if (r < I_QKV) { const int mat = r / 32, which = mat >> 2, hd = mat & 3;
                    const float* W = sel3(which, P.wq, P.wk, P.wv) + ((size_t)l * NH + hd) * DH * DH;
                    transpose_item(W, DH, DH, WqkvT + (size_t)mat * DH * DH, DH, scr, r % 32, lane); continue; } r -= I_QKV;
                transpose_item(P.w_out + (size_t)l * 2 * DM * DM, DM, DM, WoutT, 2 * DM, scr, r, lane);
            }
        }
        __syncthreads();
        s5_tables(shm, (char*)S[3], P.lam_re + l * NG * NP, P.lam_im + l * NG * NP, P.log_dt + l * NG, P.sb_re + (size_t)l * NG * NP * GC, P.sb_im + (size_t)l * NG * NP * GC,
                  P.sc_re + (size_t)l * NG * GC * NP, P.sc_im + (size_t)l * NG * GC * NP);
        __syncthreads();
        FOR_VB(MTOK) k_norm_mod(vb, ldsf, xin, P.norm_gain + l * DM, modl, H);
        grid.sync();
        { ProbIn pb{H, WinT, U, SG, MI, 12}; gemm_phase(shm, pb); }
        grid.sync();
        s5_phase(shm, U, (const char*)S[3], P.ssm_d + l * DM);
        grid.sync();
        { ProbGlu pb{Y, WgluT, Z, P.b_glu + l * DM, 4}; gemm_phase(shm, pb); }
        grid.sync();
        FOR_VB(MTOK) k_ssm_post(vb, ldsf, Z, SG, P.ssm_og + l * DM);
        grid.sync();
        FOR_VB(MTOK * DM / 256) k_conv(vb, MI, XC, P.conv_w + l * 4 * DM, P.conv_b + l * DM);
        grid.sync();
        { ProbQkv pb{XC, MI, WqkvT, Q, Kb, V, 12}; gemm_phase(shm, pb); }
        grid.sync();
        FOR_VB(MTOK) k_gates(vb, ldsf, Q, Kb, V, P.w_gates + (size_t)l * 3 * DM * 8, P.b_ig + l * 4, P.b_fg + l * 4, ipre, logf);
        grid.sync();
        mlstm_phase(shm, Q, Kb, V, ipre, logf, HC);
        grid.sync();
        { ProbIn pb{H, WinT + (size_t)3072 * DM, MO, MG, MG, 8}; gemm_phase(shm, pb); }
        grid.sync();
        FOR_VB(MTOK) k_mlstm_post(vb, HC, MO, MG, MI, P.conv_w + l * 4 * DM, P.conv_b + l * DM, P.m_ng + l * DM, P.m_skip + l * DM);
        grid.sync();
        { ProbOut pb{Z, HC, WoutT, xin, out, modl + 2 * DM, 4}; gemm_phase(shm, pb); }
        grid.sync();
    }
    FOR_VB(MTOK) k_final(vb, ldsf, out, P.final_gain);
}

extern "C" void kernel_launch(void* const* d_in, const int* in_sizes, int n_in, void* d_out, int out_size, void* d_ws, size_t ws_size, hipStream_t stream) {
    static int grid_blocks = 0;
    if (!grid_blocks) {
        int dev = 0, cus = 0, per_cu = 0;
        (void)hipGetDevice(&dev);
        (void)hipDeviceGetAttribute(&cus, hipDeviceAttributeMultiprocessorCount, dev);
        (void)hipFuncSetAttribute((const void*)mega, hipFuncAttributeMaxDynamicSharedMemorySize, LDS_BYTES);
        (void)hipOccupancyMaxActiveBlocksPerMultiprocessor(&per_cu, (const void*)mega, 512, LDS_BYTES);
        grid_blocks = cus;
        fprintf(stderr, "mega: cus=%d occupancy per_cu=%d grid=%d\n", cus, per_cu, grid_blocks);
    }
    Params P{};
    const float** pp = (const float**)&P;
    for (int i = 0; i < 29; ++i) pp[i] = (const float*)d_in[i];
    P.out = (float*)d_out; P.ws = (char*)d_ws;
    void* args[] = {&P};
    hipError_t e = hipLaunchCooperativeKernel((const void*)mega, dim3(grid_blocks), dim3(512), args, LDS_BYTES, stream);
    if (e != hipSuccess) fprintf(stderr, "cooperative launch failed: %s (grid %d)\n", hipGetErrorString(e), grid_blocks);
}
```

```cpp
#include <hip/hip_runtime.h>
#include <cstdio>
#include <cstdint>
#include <hip/hip_cooperative_groups.h>
namespace cg = cooperative_groups;

typedef unsigned short bf16_t;
#define DEV __device__ __forceinline__

constexpr int BATCH = 8, SEQ = 2048, DM = 1024, MTOK = BATCH * SEQ;
constexpr int NG = 64, NP = 64, GC = 16, NH = 4, DH = 256, CHUNK = 64, INC = 5120;
constexpr float EPS = 1e-6f;

DEV int opaque_tid() { int t = threadIdx.x; asm volatile("" : "+v"(t)); return t; }
#define TIDH (opaque_tid() & 255)
#define HALF (opaque_tid() >> 8)
DEV float bf2f(bf16_t v) { return __uint_as_float(((unsigned)v) << 16); }
DEV bf16_t f2bf(float f) { unsigned u = __float_as_uint(f); return (bf16_t)((u + 0x7fffu + ((u >> 16) & 1u)) >> 16); }
DEV float sigmoidf_(float x) { return 1.f / (1.f + __expf(-x)); }
DEV float siluf_(float x) { return x / (1.f + __expf(-x)); }
DEV float geluf_(float x) { float t = 0.7978845608028654f * (x + 0.044715f * x * x * x); return 0.5f * x * (1.f + tanhf(t)); }
DEV float logsigmoidf_(float x) { return fminf(x, 0.f) - log1pf(__expf(-fabsf(x))); }

DEV float wave_sum(float v) {
#pragma unroll
    for (int o = 1; o < 64; o <<= 1) v += __shfl_xor(v, o);
    return v;
}
DEV float block_sum256(float v, float* red) {
    v = wave_sum(v);
    __syncthreads();
    if ((TIDH & 63) == 0) red[TIDH >> 6] = v;
    __syncthreads();
    return red[0] + red[1] + red[2] + red[3];
}

DEV void k_mod(int vb, float* ldsf, const float* c, const float* w_mod, const float* b_mod, float* mod) {
    float (*sc)[DM] = (float (*)[DM])ldsf;
    const int l = vb / 12, n = (vb % 12) * 256 + TIDH;
    __syncthreads();
    for (int i = TIDH; i < BATCH * DM; i += 256) sc[i / DM][i % DM] = siluf_(c[i]);
    __syncthreads();
    float acc[BATCH];
#pragma unroll
    for (int b = 0; b < BATCH; ++b) acc[b] = 0.f;
    const float* W = w_mod + (size_t)l * DM * 3 * DM;
    for (int k = 0; k < DM; ++k) {
        float w = W[(size_t)k * 3 * DM + n];
#pragma unroll
        for (int b = 0; b < BATCH; ++b) acc[b] += sc[b][k] * w;
    }
#pragma unroll
    for (int b = 0; b < BATCH; ++b) mod[((size_t)l * BATCH + b) * 3 * DM + n] = acc[b] + b_mod[l * 3 * DM + n];
}

DEV void k_norm_mod(int vb, float* red, const float* x, const float* gain, const float* mod  , bf16_t* h) {
    const int m = vb, b = m / SEQ, t = TIDH;
    const float4 v = ((const float4*)(x + (size_t)m * DM))[t];
    float ss = v.x * v.x + v.y * v.y + v.z * v.z + v.w * v.w;
    ss = block_sum256(ss, red);
    const float rstd = rsqrtf(ss * (1.f / DM) + EPS);
    const float* shift = mod + (size_t)b * 3 * DM;
    const float* scale = shift + DM;
    float xv[4] = {v.x, v.y, v.z, v.w};
#pragma unroll
    for (int i = 0; i < 4; ++i) {
        int n = t * 4 + i;
        float y = xv[i] * rstd * gain[n] * (1.f + scale[n]) + shift[n];
        h[(size_t)m * DM + n] = f2bf(y);
    }
}

DEV void k_s5(int item, float* ldsf, const bf16_t* u, bf16_t* y, const float* lam_re, const float* lam_im, const float* log_dt,
                                           const float* b_re, const float* b_im, const float* c_re, const float* c_im, const float* dskip) {
    const int tid_ = opaque_tid();
    float (*part)[17] = (float (*)[17])(ldsf + (tid_ >> 6) * 64 * 17);
    const int g = item & 63, b = item >> 6, p = tid_ & 63;
    const double lr = lam_re[g * NP + p], li = lam_im[g * NP + p], dt = exp((double)log_dt[g]);
    const double er = exp(lr * dt);
    const double ard = er * cos(li * dt), aid = er * sin(li * dt);
    const double dr = ard - 1.0, di = aid, den = lr * lr + li * li;
    const double cr = (dr * lr + di * li) / den, ci = (di * lr - dr * li) / den;
    float bbr[16], bbi[16], ccr[16], cci[16];
#pragma unroll
    for (int c = 0; c < 16; ++c) {
        const double br = b_re[(g * NP + p) * GC + c], bi = b_im[(g * NP + p) * GC + c];
        bbr[c] = (float)(cr * br - ci * bi); bbi[c] = (float)(cr * bi + ci * br);
        ccr[c] = c_re[(g * GC + c) * NP + p]; cci[c] = c_im[(g * GC + c) * NP + p];
    }
    const float ar = (float)ard, ai = (float)aid;
    const float dsk = dskip[g * GC + (p & 15)];
    float sr = 0.f, si = 0.f;
    for (int t = 0; t < SEQ; ++t) {
        const bf16_t* up = u + (size_t)(b * SEQ + t) * DM + g * GC;
        const uint4 u0 = *(const uint4*)up, u1 = *(const uint4*)(up + 8);
        float uf[16];
        uf[0] = bf2f(u0.x & 0xffff); uf[1] = bf2f(u0.x >> 16); uf[2] = bf2f(u0.y & 0xffff); uf[3] = bf2f(u0.y >> 16);
        uf[4] = bf2f(u0.z & 0xffff); uf[5] = bf2f(u0.z >> 16); uf[6] = bf2f(u0.w & 0xffff); uf[7] = bf2f(u0.w >> 16);
        uf[8] = bf2f(u1.x & 0xffff); uf[9] = bf2f(u1.x >> 16); uf[10] = bf2f(u1.y & 0xffff); uf[11] = bf2f(u1.y >> 16);
        uf[12] = bf2f(u1.z & 0xffff); uf[13] = bf2f(u1.z >> 16); uf[14] = bf2f(u1.w & 0xffff); uf[15] = bf2f(u1.w >> 16);
        float bur = 0.f, bui = 0.f;
#pragma unroll
        for (int c = 0; c < 16; ++c) { bur += bbr[c] * uf[c]; bui += bbi[c] * uf[c]; }
        const float nr = ar * sr - ai * si + bur, ni = ar * si + ai * sr + bui;
        sr = nr; si = ni;
#pragma unroll
        for (int c = 0; c < 16; ++c) part[p][c] = ccr[c] * sr - cci[c] * si;
        asm volatile("s_waitcnt lgkmcnt(0)" ::: "memory");
        float s = 0.f;
#pragma unroll
        for (int k = 0; k < 16; ++k) s += part[(p >> 4) * 16 + k][p & 15];
        s += __shfl_xor(s, 16); s += __shfl_xor(s, 32);
        if (p < 16) {
            const float yv = s + dsk * bf2f(up[p]);
            y[(size_t)(b * SEQ + t) * DM + g * GC + p] = f2bf(geluf_(yv));
        }
        asm volatile("s_waitcnt lgkmcnt(0)" ::: "memory");
    }
}

DEV void k_ssm_post(int vb, float* red, bf16_t* z, const bf16_t* sg, const float* gain) {
    const int m = vb, t = TIDH;
    float zv[4]; float ss = 0.f;
#pragma unroll
    for (int i = 0; i < 4; ++i) { zv[i] = bf2f(z[(size_t)m * DM + t * 4 + i]); ss += zv[i] * zv[i]; }
    ss = block_sum256(ss, red);
    const float rstd = rsqrtf(ss * (1.f / DM) + EPS);
#pragma unroll
    for (int i = 0; i < 4; ++i) {
        const int n = t * 4 + i;
        z[(size_t)m * DM + n] = f2bf(zv[i] * rstd * gain[n] * siluf_(bf2f(sg[(size_t)m * DM + n])));
    }
}

DEV float conv_xc(const bf16_t* mi, int m, int n, const float* cw, const float* cb) {
    const int t = m % SEQ;
    float acc = cb[n];
#pragma unroll
    for (int j = 0; j < 4; ++j) {
        const int tt = t - 3 + j;
        if (tt >= 0) acc += bf2f(mi[(size_t)(m - 3 + j) * DM + n]) * cw[j * DM + n];
    }
    return siluf_(acc);
}
DEV void k_conv(int vb, const bf16_t* mi, bf16_t* xc, const float* cw, const float* cb) {
    const size_t idx = (size_t)vb * 256 + TIDH;
    const int m = (int)(idx / DM), n = (int)(idx % DM);
    xc[idx] = f2bf(conv_xc(mi, m, n, cw, cb));
}

DEV void k_gates(int vb, float* ldsf, const bf16_t* q, const bf16_t* k, const bf16_t* v, const float* wg  , const float* bi, const float* bfg,
                                               float* ipre, float* logf) {
    float (*red)[8] = (float (*)[8])ldsf;
    const int m = vb, t = TIDH;
    __syncthreads();
    float acc[8];
#pragma unroll
    for (int j = 0; j < 8; ++j) acc[j] = 0.f;
    for (int e = t; e < 3 * DM; e += 256) {
        const bf16_t* src = (e < DM) ? q : (e < 2 * DM ? k : v);
        const float xv = bf2f(src[(size_t)m * DM + (e & (DM - 1))]);
#pragma unroll
        for (int j = 0; j < 8; ++j) acc[j] += xv * wg[e * 8 + j];
    }
#pragma unroll
    for (int j = 0; j < 8; ++j) acc[j] = wave_sum(acc[j]);
    if ((t & 63) == 0) {
#pragma unroll
        for (int j = 0; j < 8; ++j) red[t >> 6][j] = acc[j];
    }
    __syncthreads();
    if (t < 8) {
        const float s = red[0][t] + red[1][t] + red[2][t] + red[3][t];
        if (t < 4) ipre[(size_t)m * 4 + t] = s + bi[t];
        else logf[(size_t)m * 4 + (t - 4)] = logsigmoidf_(s + bfg[t - 4]);
    }
}

DEV void k_mlstm(int vb, float* ldsf, const bf16_t* q, const bf16_t* k, const bf16_t* v, const float* ipre, const float* logf, bf16_t* hc) {
    float (*Cs)[257] = (float (*)[257])ldsf;
    float (*St)[65] = (float (*)[65])(ldsf + 32 * 257);
    float* nvec = ldsf + 32 * 257 + 64 * 65;
    float* bcum = nvec + 256; float* ig = bcum + 64; float* mt = ig + 64; float* winter = mt + 64; float* ws_ = winter + 64; float* hden = ws_ + 64;
    float* sc = hden + 64;
    const int tid = TIDH;
    const int vs = vb & 7, h = (vb >> 3) & 3, b = vb >> 5;
    __syncthreads();
    for (int i = tid; i < 32 * 257; i += 256) (&Cs[0][0])[i] = 0.f;
    nvec[tid] = 0.f;
    if (tid == 0) sc[0] = 0.f;
    __syncthreads();
    const size_t base = (size_t)b * SEQ * DM + h * DH;
    for (int j = 0; j < SEQ / CHUNK; ++j) {
        const size_t cb = base + (size_t)j * CHUNK * DM;
        const int m0 = b * SEQ + j * CHUNK;
        if (tid < 64) {
            ig[tid] = ipre[(size_t)(m0 + tid) * 4 + h];
            ws_[tid] = logf[(size_t)(m0 + tid) * 4 + h];
        }
        __syncthreads();
        if (tid < 64) { float s = 0.f; for (int i = 0; i <= tid; ++i) s += ws_[i]; bcum[tid] = s; }
        __syncthreads();
        const float m_prev = sc[0];
        if (tid < 64) {
            const float m_inter = bcum[tid] + m_prev;
            float mx = -INFINITY;
            for (int s = 0; s <= tid; ++s) mx = fmaxf(mx, bcum[tid] - bcum[s] + ig[s]);
            const float m = fmaxf(m_inter, mx);
            mt[tid] = m; winter[tid] = __expf(m_inter - m);
        }
        __syncthreads();
        for (int idx = tid; idx < 4096; idx += 256) {
            const int t = idx >> 6, s = idx & 63;
            float r = 0.f;
            if (s <= t) {
                const bf16_t* qp = q + cb + (size_t)t * DM; const bf16_t* kp = k + cb + (size_t)s * DM;
                float dot = 0.f;
                for (int d = 0; d < DH; d += 8) {
                    const uint4 qa = *(const uint4*)(qp + d), ka = *(const uint4*)(kp + d);
                    dot += bf2f(qa.x & 0xffff) * bf2f(ka.x & 0xffff) + bf2f(qa.x >> 16) * bf2f(ka.x >> 16);
                    dot += bf2f(qa.y & 0xffff) * bf2f(ka.y & 0xffff) + bf2f(qa.y >> 16) * bf2f(ka.y >> 16);
                    dot += bf2f(qa.z & 0xffff) * bf2f(ka.z & 0xffff) + bf2f(qa.z >> 16) * bf2f(ka.z >> 16);
                    dot += bf2f(qa.w & 0xffff) * bf2f(ka.w & 0xffff) + bf2f(qa.w >> 16) * bf2f(ka.w >> 16);
                }
                r = dot * __expf(bcum[t] - bcum[s] + ig[s] - mt[t]);
            }
            St[t][s] = r;
        }
        __syncthreads();
        if (tid < 64) {
            const bf16_t* qp = q + cb + (size_t)tid * DM;
            float dn = 0.f;
            for (int d = 0; d < DH; ++d) dn += nvec[d] * bf2f(qp[d]);
            float sm = 0.f;
            for (int s = 0; s < 64; ++s) sm += St[tid][s];
            const float den = winter[tid] * dn + sm;
            hden[tid] = fmaxf(fabsf(den), __expf(-mt[tid]));
        }
        __syncthreads();
        for (int idx = tid; idx < 2048; idx += 256) {
            const int t = idx >> 5, vv = idx & 31;
            const bf16_t* qp = q + cb + (size_t)t * DM;
            float a = 0.f;
            for (int d = 0; d < DH; ++d) a += Cs[vv][d] * bf2f(qp[d]);
            float s2 = 0.f;
            for (int s = 0; s < 64; ++s) s2 += St[t][s] * bf2f(v[cb + (size_t)s * DM + vs * 32 + vv]);
            const float num = winter[t] * a + s2;
            hc[cb + (size_t)t * DM + vs * 32 + vv] = f2bf(num / hden[t]);
        }
        __syncthreads();
        const float b_tot = bcum[63];
        if (tid < 64) ws_[tid] = b_tot - bcum[tid] + ig[tid];
        __syncthreads();
        if (tid == 0) {
            float mx = b_tot + m_prev;
            for (int s = 0; s < 64; ++s) mx = fmaxf(mx, ws_[s]);
            sc[1] = __expf(b_tot + m_prev - mx); sc[0] = mx;
        }
        __syncthreads();
        const float m_next = sc[0], decay = sc[1];
        float myw = 0.f;
        if (tid < 64) myw = __expf(ws_[tid] - m_next);
        __syncthreads();
        if (tid < 64) ws_[tid] = myw;
        __syncthreads();
        for (int idx = tid; idx < 32 * 256; idx += 256) {
            const int vv = idx >> 8, d = idx & 255;
            float a = 0.f;
            for (int s = 0; s < 64; ++s) a += ws_[s] * bf2f(v[cb + (size_t)s * DM + vs * 32 + vv]) * bf2f(k[cb + (size_t)s * DM + d]);
            Cs[vv][d] = decay * Cs[vv][d] + a;
        }
        {
            float a = 0.f;
            for (int s = 0; s < 64; ++s) a += ws_[s] * bf2f(k[cb + (size_t)s * DM + tid]);
            nvec[tid] = decay * nvec[tid] + a;
        }
        __syncthreads();
    }
}

DEV void k_mlstm_post(int vb, bf16_t* hc, const bf16_t* mo, const bf16_t* mg, const bf16_t* mi, const float* cw, const float* cb,
                                                    const float* ngain, const float* skip) {
    const int m = vb, t = TIDH;
    float hv[4]; float s = 0.f;
#pragma unroll
    for (int i = 0; i < 4; ++i) {
        const size_t o = (size_t)m * DM + t * 4 + i;
        hv[i] = bf2f(hc[o]) * sigmoidf_(bf2f(mo[o])); s += hv[i];
    }
    const float mu = wave_sum(s) * (1.f / DH);
    float s2 = 0.f;
#pragma unroll
    for (int i = 0; i < 4; ++i) { hv[i] -= mu; s2 += hv[i] * hv[i]; }
    const float rstd = rsqrtf(wave_sum(s2) * (1.f / DH) + EPS);
#pragma unroll
    for (int i = 0; i < 4; ++i) {
        const int n = t * 4 + i; const size_t o = (size_t)m * DM + n;
        const float xc = conv_xc(mi, m, n, cw, cb);
        const float hn = hv[i] * rstd * ngain[n] + skip[n] * xc;
        hc[o] = f2bf(hn * siluf_(bf2f(mg[o])));
    }
}

DEV void k_final(int vb, float* red, float* x, const float* gain) {
    const int m = vb, t = TIDH;
    float4 v = ((float4*)(x + (size_t)m * DM))[t];
    float ss = v.x * v.x + v.y * v.y + v.z * v.z + v.w * v.w;
    ss = block_sum256(ss, red);
    const float rstd = rsqrtf(ss * (1.f / DM) + EPS);
    const float4 g = ((const float4*)gain)[t];
    v.x *= rstd * g.x; v.y *= rstd * g.y; v.z *= rstd * g.z; v.w *= rstd * g.w;
    ((float4*)(x + (size_t)m * DM))[t] = v;
}


#define LAS __attribute__((address_space(3)))
typedef short bf16x8 __attribute__((ext_vector_type(8)));
typedef float f32x4 __attribute__((ext_vector_type(4)));
#define WAIT_V(n) asm volatile("s_waitcnt vmcnt(" #n ")" ::: "memory")
#define WAIT_L(n) asm volatile("s_waitcnt lgkmcnt(" #n ")" ::: "memory")
#define SCHED() __builtin_amdgcn_sched_barrier(0)

DEV int lds_byte(int r, int c) { int st = (r >> 4) * 2 + (c >> 5), ob = (r & 15) * 64 + (c & 31) * 2; return st * 1024 + (ob ^ (((ob >> 9) & 1) << 5)); }
DEV void stage_rc(int b, int& R, int& C) { int st = b >> 10, sb = b & 1023, swz = sb ^ (((sb >> 9) & 1) << 5); R = (st >> 1) * 16 + swz / 64; C = (st & 1) * 32 + (swz % 64) / 2; }
template <class T> DEV T* sel3(int w, T* p0, T* p1, T* p2) { return p0 + ((w >= 1) ? (p1 - p0) : 0) + ((w >= 2) ? (p2 - p1) : 0); }
DEV uint2 pack4(f32x4 v) { uint2 r; r.x = (unsigned)f2bf(v[0]) | ((unsigned)f2bf(v[1]) << 16); r.y = (unsigned)f2bf(v[2]) | ((unsigned)f2bf(v[3]) << 16); return r; }

template <class Prob>
DEV void gemm_phase(LAS char* shm, const Prob& pb) {
    constexpr int TILE_B = 256 * 64 * 2, STAGE_B = 2 * TILE_B;
    const int tid = opaque_tid(), wid = __builtin_amdgcn_readfirstlane(tid >> 6), lane = tid & 63, wr = wid >> 2, wc = wid & 3, fr = lane & 15, fq = lane >> 4;
    int sR[4], sC[4];
#pragma unroll
    for (int i = 0; i < 4; ++i) stage_rc(wid * 1024 + i * 8192 + lane * 16, sR[i], sC[i]);
    const int nN = pb.nN, ntiles = 64 * nN, nt = Prob::K / 64, lda = Prob::lda, ldb = Prob::ldb;
    for (int t = blockIdx.x; t < ntiles; t += gridDim.x) {
        const int base = t & ~255, loc = t & 255;
        const int w = base + (loc & 7) * 32 + (loc >> 3);
        const int nig = 8 * nN, gid = w / nig, pm = gid * 8 + (w % nig) % 8, pn = (w % nig) / 8;
        const int brow = pm * 256, bcol = pn * 256;
        const bf16_t* Bb = pb.bptr(pn);
#define GLDS_STAGE(buf, kt) do { const bf16_t* Ak_ = pb.aptr(pn, kt) + (long)brow * lda; const bf16_t* Bk_ = Bb + (kt) * 64; \
        _Pragma("unroll") for (int i = 0; i < 4; ++i) { \
            __builtin_amdgcn_global_load_lds((const unsigned*)(Ak_ + (long)sR[i] * lda + sC[i]), (LAS unsigned*)(shm + (buf) * STAGE_B + wid * 1024 + i * 8192), 16, 0, 0); \
            __builtin_amdgcn_global_load_lds((const unsigned*)(Bk_ + (long)sR[i] * ldb + sC[i]), (LAS unsigned*)(shm + (buf) * STAGE_B + TILE_B + wid * 1024 + i * 8192), 16, 0, 0); } } while (0)
        f32x4 acc[8][4];
#pragma unroll
        for (int m = 0; m < 8; ++m)
#pragma unroll
            for (int n = 0; n < 4; ++n) acc[m][n] = (f32x4){0.f, 0.f, 0.f, 0.f};
        GLDS_STAGE(0, 0); WAIT_V(0); __syncthreads();
#pragma nounroll
        for (int kt = 0; kt < nt; ++kt) {
            const int cur = kt & 1;
            if (kt + 1 < nt) GLDS_STAGE(cur ^ 1, kt + 1);
#pragma unroll
            for (int ks = 0; ks < 2; ++ks) {
                bf16x8 At[8], Bf[4];
#pragma unroll
                for (int m = 0; m < 8; ++m) At[m] = *(const LAS bf16x8*)(shm + cur * STAGE_B + lds_byte(wr * 128 + m * 16 + fr, ks * 32 + fq * 8));
#pragma unroll
                for (int n = 0; n < 4; ++n) Bf[n] = *(const LAS bf16x8*)(shm + cur * STAGE_B + TILE_B + lds_byte(wc * 64 + n * 16 + fr, ks * 32 + fq * 8));
#pragma unroll
                for (int m = 0; m < 8; ++m)
#pragma unroll
                    for (int n = 0; n < 4; ++n) acc[m][n] = __builtin_amdgcn_mfma_f32_16x16x32_bf16(Bf[n], At[m], acc[m][n], 0, 0, 0);
                SCHED();
            }
            WAIT_V(0); __syncthreads();
        }
#undef GLDS_STAGE
#pragma unroll
        for (int m = 0; m < 8; ++m)
#pragma unroll
            for (int n = 0; n < 4; ++n) pb.epi(pn, brow + wr * 128 + m * 16 + fr, bcol + wc * 64 + n * 16 + fq * 4, acc[m][n]);
    }
}

struct ProbIn {
    static constexpr int K = 1024, lda = 1024, ldb = 1024;
    const bf16_t* H; const bf16_t* Wt; bf16_t* C0; bf16_t* C1; bf16_t* C2; int nN;
    DEV const bf16_t* aptr(int pn, int kt) const { return H + kt * 64; }
    DEV const bf16_t* bptr(int pn) const { return Wt + (long)pn * 256 * 1024; }
    DEV void epi(int pn, int row, int col, f32x4 v) const {
        bf16_t* C = sel3(col >> 10, C0, C1, C2);
        *(uint2*)(C + (size_t)row * DM + (col & 1023)) = pack4(v);
    }
};
struct ProbGlu {
    static constexpr int K = 1024, lda = 1024, ldb = 1024;
    const bf16_t* Y; const bf16_t* Wt; bf16_t* Z; const float* bias; int nN;
    DEV const bf16_t* aptr(int pn, int kt) const { return Y + kt * 64; }
    DEV const bf16_t* bptr(int pn) const { return Wt + (long)pn * 256 * 1024; }
    DEV void epi(int pn, int row, int col, f32x4 v) const {
        const uint2 yv = *(const uint2*)(Y + (size_t)row * DM + col);
        const float4 b = *(const float4*)(bias + col);
        f32x4 o;
        o[0] = bf2f(yv.x & 0xffff) * sigmoidf_(v[0] + b.x); o[1] = bf2f(yv.x >> 16) * sigmoidf_(v[1] + b.y);
        o[2] = bf2f(yv.y & 0xffff) * sigmoidf_(v[2] + b.z); o[3] = bf2f(yv.y >> 16) * sigmoidf_(v[3] + b.w);
        *(uint2*)(Z + (size_t)row * DM + col) = pack4(o);
    }
};
struct ProbQkv {
    static constexpr int K = 256, lda = 1024, ldb = 256;
    const bf16_t* XC; const bf16_t* MI; const bf16_t* Wt; bf16_t* Q; bf16_t* Kk; bf16_t* V; int nN;
    DEV const bf16_t* aptr(int pn, int kt) const { return ((pn >> 2) == 2 ? MI : XC) + (pn & 3) * 256 + kt * 64; }
    DEV const bf16_t* bptr(int pn) const { return Wt + (long)pn * 256 * 256; }
    DEV void epi(int pn, int row, int col, f32x4 v) const {
        const int which = pn >> 2; bf16_t* C = sel3(which, Q, Kk, V);
        if (which == 1) { v[0] *= 0.0625f; v[1] *= 0.0625f; v[2] *= 0.0625f; v[3] *= 0.0625f; }
        *(uint2*)(C + (size_t)row * DM + (col & 1023)) = pack4(v);
    }
};
struct ProbOut {
    static constexpr int K = 2048, lda = 1024, ldb = 2048;
    const bf16_t* A1; const bf16_t* A2; const bf16_t* Wt; const float* xin; float* xout; const float* gate; int nN;
    DEV const bf16_t* aptr(int pn, int kt) const { return (kt < 16) ? (A1 + kt * 64) : (A2 + (kt - 16) * 64); }
    DEV const bf16_t* bptr(int pn) const { return Wt + (long)pn * 256 * 2048; }
    DEV void epi(int pn, int row, int col, f32x4 v) const {
        const int b = row / SEQ;
        const float4 xi = *(const float4*)(xin + (size_t)row * DM + col);
        const float4 g = *(const float4*)(gate + (size_t)b * 3 * DM + col);
        float4 o; o.x = xi.x + g.x * v[0]; o.y = xi.y + g.y * v[1]; o.z = xi.z + g.z * v[2]; o.w = xi.w + g.w * v[3];
        *(float4*)(xout + (size_t)row * DM + col) = o;
    }
};

DEV void transpose_item(const float* W, int ldw, int ncols, bf16_t* WT, int ldwt, LAS float* scr, int item, int lane) {
    const int nblk = ncols / 32, kb = item / nblk, nb = item % nblk, k0 = 64 * kb, n0 = 32 * nb;
#pragma unroll 8
    for (int i = 0; i < 32; ++i) { const int kk = 2 * i + (lane >> 5); scr[kk * 33 + (lane & 31)] = W[(size_t)(k0 + kk) * ldw + n0 + (lane & 31)]; }
    asm volatile("s_waitcnt lgkmcnt(0)" ::: "memory");
    const int c = lane & 7;
#pragma unroll
    for (int j = 0; j < 4; ++j) {
        const int n = (lane >> 3) + 8 * j; const LAS float* s = scr + (8 * c) * 33 + n;
        uint4 o;
        o.x = (unsigned)f2bf(s[0 * 33]) | ((unsigned)f2bf(s[1 * 33]) << 16); o.y = (unsigned)f2bf(s[2 * 33]) | ((unsigned)f2bf(s[3 * 33]) << 16);
        o.z = (unsigned)f2bf(s[4 * 33]) | ((unsigned)f2bf(s[5 * 33]) << 16); o.w = (unsigned)f2bf(s[6 * 33]) | ((unsigned)f2bf(s[7 * 33]) << 16);
        *(uint4*)(WT + (size_t)(n0 + n) * ldwt + k0 + 8 * c) = o;
    }
    asm volatile("s_waitcnt lgkmcnt(0)" ::: "memory");
}

typedef short s16x4 __attribute__((ext_vector_type(4)));
typedef unsigned u32x4 __attribute__((ext_vector_type(4)));
typedef unsigned u32x2 __attribute__((ext_vector_type(2)));
typedef float f32x2 __attribute__((ext_vector_type(2)));
DEV float wave_scan_add(float v, int lane) {
#pragma unroll
    for (int o = 1; o < 64; o <<= 1) { const float u = __shfl_up(v, o); if (lane >= o) v += u; }
    return v;
}
DEV float wave_scan_max(float v, int lane) {
#pragma unroll
    for (int o = 1; o < 64; o <<= 1) { const float u = __shfl_up(v, o); if (lane >= o) v = fmaxf(v, u); }
    return v;
}
DEV unsigned pk2(float lo, float hi) { return (unsigned)f2bf(lo) | ((unsigned)f2bf(hi) << 16); }

DEV void mlstm_phase(LAS char* shm, const bf16_t* q, const bf16_t* k, const bf16_t* v, const float* gpart, const float* b_ig, const float* b_fg, bf16_t* hc) {
    const int tid = opaque_tid(), wid = __builtin_amdgcn_readfirstlane(tid >> 6), lane = tid & 63, fr = lane & 15, fq = lane >> 4;
    constexpr int QS = 0, KS = 33792, VT = 67584, VWT = 74496, CB = 81408, PART = 106752, SC = 120064, RS = 528, VRS = 144, PRS = 52;
    LAS float* sc = (LAS float*)(shm + SC);
    LAS float* part = (LAS float*)(shm + PART);
    for (int item = blockIdx.x; item < BATCH * NH * 8; item += gridDim.x) {
        const int vs = (item >> 3) & 7, bh = (item & 7) + 8 * (item >> 6), h = bh & 3, b = bh >> 2;
        __syncthreads();
        for (int i = tid; i < (CB + 25344 - VT) / 4; i += 512) ((LAS unsigned*)(shm + VT))[i] = 0u;
        __syncthreads();
        if (tid < 64) *(LAS bf16_t*)(shm + VT + 32 * VRS + tid * 2) = (bf16_t)0x3F80;
        f32x4 cacc[2][3];
#pragma unroll
        for (int i = 0; i < 2; ++i)
#pragma unroll
            for (int vt = 0; vt < 3; ++vt) cacc[i][vt] = (f32x4){0.f, 0.f, 0.f, 0.f};
        float m_prev = 0.f;
#pragma nounroll
        for (int j = 0; j < SEQ / CHUNK; ++j) {
            const size_t cb = ((size_t)(b * SEQ + j * CHUNK)) * DM + h * DH;
            const int m0 = b * SEQ + j * CHUNK;
            uint4 qv[4], kv[4], vv = make_uint4(0, 0, 0, 0);
#pragma unroll
            for (int i = 0; i < 4; ++i) {
                const int idx = tid + 512 * i, row = idx >> 5, c16 = idx & 31;
                qv[i] = *(const uint4*)(q + cb + (size_t)row * DM + c16 * 8);
                kv[i] = *(const uint4*)(k + cb + (size_t)row * DM + c16 * 8);
            }
            if (tid < 256) vv = *(const uint4*)(v + cb + (size_t)(tid >> 2) * DM + vs * 32 + (tid & 3) * 8);
            if (wid == 0) {
                const float* gp = gpart + (size_t)(m0 + lane) * 8;
                const float ig = gp[h] + gp[(size_t)MTOK * 8 + h] + b_ig[h];
                const float lf = logsigmoidf_(gp[4 + h] + gp[(size_t)MTOK * 8 + 4 + h] + b_fg[h]);
                const float bc = wave_scan_add(lf, lane);
                const float a = ig - bc;
                const float pm = wave_scan_max(a, lane);
                const float btot = __shfl(bc, 63), amax = __shfl(pm, 63);
                const float mt = bc + fmaxf(m_prev, pm);
                sc[lane] = bc - mt; sc[64 + lane] = a; sc[128 + lane] = __expf(bc + m_prev - mt); sc[192 + lane] = __expf(-mt);
                const float m_next = btot + fmaxf(m_prev, amax);
                sc[256 + lane] = __expf(btot + a - m_next);
                if (lane == 0) sc[320] = __expf(btot + m_prev - m_next);
                m_prev = m_next;
            }
#pragma unroll
            for (int i = 0; i < 4; ++i) {
                const int idx = tid + 512 * i, row = idx >> 5, c16 = idx & 31;
                *(LAS u32x4*)(shm + QS + row * RS + c16 * 16) = (u32x4){qv[i].x, qv[i].y, qv[i].z, qv[i].w};
                *(LAS u32x4*)(shm + KS + row * RS + c16 * 16) = (u32x4){kv[i].x, kv[i].y, kv[i].z, kv[i].w};
            }
            if (tid < 256) {
                const int s_ = tid >> 2, v0 = (tid & 3) * 8;
                const unsigned w_[4] = {vv.x, vv.y, vv.z, vv.w};
#pragma unroll
                for (int e = 0; e < 8; ++e) *(LAS bf16_t*)(shm + VT + (v0 + e) * VRS + s_ * 2) = (bf16_t)((w_[e >> 1] >> ((e & 1) * 16)) & 0xffff);
            }
            __syncthreads();
            if (tid < 256) {
                const int s_ = tid >> 2, v0 = (tid & 3) * 8;
                const float ws = sc[256 + s_];
                const unsigned w_[4] = {vv.x, vv.y, vv.z, vv.w};
#pragma unroll
                for (int e = 0; e < 8; ++e) *(LAS bf16_t*)(shm + VWT + (v0 + e) * VRS + s_ * 2) = f2bf(ws * bf2f((bf16_t)((w_[e >> 1] >> ((e & 1) * 16)) & 0xffff)));
            } else if (tid < 320) {
                *(LAS bf16_t*)(shm + VWT + 32 * VRS + (tid - 256) * 2) = f2bf(sc[256 + tid - 256]);
            }
            f32x4 nacc[3];
#pragma unroll
            for (int vt = 0; vt < 3; ++vt) nacc[vt] = (f32x4){0.f, 0.f, 0.f, 0.f};
            const int tt = wid & 3;
            if (wid < 4) {
                f32x4 sacc[4];
#pragma unroll
                for (int jj = 0; jj < 4; ++jj) sacc[jj] = (f32x4){0.f, 0.f, 0.f, 0.f};
#pragma unroll
                for (int ks = 0; ks < 8; ++ks) {
                    const bf16x8 qf = *(const LAS bf16x8*)(shm + QS + (16 * tt + fr) * RS + (32 * ks + 8 * fq) * 2);
#pragma unroll
                    for (int jj = 0; jj < 4; ++jj) if (jj <= tt) {
                        const bf16x8 kf = *(const LAS bf16x8*)(shm + KS + (16 * jj + fr) * RS + (32 * ks + 8 * fq) * 2);
                        sacc[jj] = __builtin_amdgcn_mfma_f32_16x16x32_bf16(kf, qf, sacc[jj], 0, 0, 0);
                    }
                }
                const int t = 16 * tt + fr;
                const float btm = sc[t];
#pragma unroll
                for (int jj = 0; jj < 4; ++jj) {
                    const f32x4 a4 = *(const LAS f32x4*)(sc + 64 + 16 * jj + 4 * fq);
#pragma unroll
                    for (int r = 0; r < 4; ++r) {
                        const int s_ = 16 * jj + 4 * fq + r;
                        sacc[jj][r] = (s_ <= t) ? sacc[jj][r] * __expf(btm + a4[r]) : 0.f;
                    }
                }
#pragma unroll
                for (int kk = 0; kk < 2; ++kk) if (2 * kk <= tt) {
                    bf16x8 af;
                    { const unsigned p0 = pk2(sacc[2 * kk][0], sacc[2 * kk][1]), p1 = pk2(sacc[2 * kk][2], sacc[2 * kk][3]);
                      const unsigned p2 = pk2(sacc[2 * kk + 1][0], sacc[2 * kk + 1][1]), p3 = pk2(sacc[2 * kk + 1][2], sacc[2 * kk + 1][3]);
                      const u32x4 u = (u32x4){p0, p1, p2, p3}; af = *(const bf16x8*)&u; }
#pragma unroll
                    for (int vt = 0; vt < 3; ++vt) {
                        const u32x2 lo = *(const LAS u32x2*)(shm + VT + (16 * vt + fr) * VRS + (32 * kk + 4 * fq) * 2);
                        const u32x2 hi = *(const LAS u32x2*)(shm + VT + (16 * vt + fr) * VRS + (32 * kk + 16 + 4 * fq) * 2);
                        const u32x4 u = (u32x4){lo[0], lo[1], hi[0], hi[1]};
                        nacc[vt] = __builtin_amdgcn_mfma_f32_16x16x32_bf16(af, *(const bf16x8*)&u, nacc[vt], 0, 0, 0);
                    }
                }
            } else {
#pragma unroll
                for (int ks = 0; ks < 8; ++ks) {
                    const bf16x8 qf = *(const LAS bf16x8*)(shm + QS + (16 * tt + fr) * RS + (32 * ks + 8 * fq) * 2);
#pragma unroll
                    for (int vt = 0; vt < 3; ++vt) {
                        const bf16x8 cf = *(const LAS bf16x8*)(shm + CB + (16 * vt + fr) * RS + (32 * ks + 8 * fq) * 2);
                        nacc[vt] = __builtin_amdgcn_mfma_f32_16x16x32_bf16(qf, cf, nacc[vt], 0, 0, 0);
                    }
                }
                const f32x4 wi = *(const LAS f32x4*)(sc + 128 + 16 * tt + 4 * fq);
#pragma unroll
                for (int vt = 0; vt < 3; ++vt)
#pragma unroll
                    for (int r = 0; r < 4; ++r) part[(16 * tt + 4 * fq + r) * PRS + 16 * vt + fr] = wi[r] * nacc[vt][r];
            }
            __syncthreads();
            if (wid < 4) {
                const f32x4 en = *(const LAS f32x4*)(sc + 192 + 16 * tt + 4 * fq);
#pragma unroll
                for (int vt = 0; vt < 3; ++vt)
#pragma unroll
                    for (int r = 0; r < 4; ++r) nacc[vt][r] += part[(16 * tt + 4 * fq + r) * PRS + 16 * vt + fr];
#pragma unroll
                for (int r = 0; r < 4; ++r) {
                    const float den = __shfl(nacc[2][r], lane & 48);
                    const float inv = 1.f / fmaxf(fabsf(den), en[r]);
                    const size_t o = cb + (size_t)(16 * tt + 4 * fq + r) * DM + vs * 32 + fr;
                    hc[o] = f2bf(nacc[0][r] * inv);
                    hc[o + 16] = f2bf(nacc[1][r] * inv);
                }
            }
            {
                const float decay = sc[320];
#pragma unroll
                for (int i = 0; i < 2; ++i)
#pragma unroll
                    for (int vt = 0; vt < 3; ++vt) cacc[i][vt] *= decay;
                const int q_ = fr >> 2, p_ = fr & 3;
#pragma unroll
                for (int kk = 0; kk < 2; ++kk) {
                    bf16x8 bfv[3];
#pragma unroll
                    for (int vt = 0; vt < 3; ++vt) bfv[vt] = *(const LAS bf16x8*)(shm + VWT + (16 * vt + fr) * VRS + (32 * kk + 8 * fq) * 2);
#pragma unroll
                    for (int i = 0; i < 2; ++i) {
                        const int dt = 2 * wid + i;
                        const s16x4 t0 = __builtin_amdgcn_ds_read_tr16_b64_v4i16((LAS s16x4*)(shm + KS + (32 * kk + 8 * fq + q_) * RS + (16 * dt + 4 * p_) * 2));
                        const s16x4 t1 = __builtin_amdgcn_ds_read_tr16_b64_v4i16((LAS s16x4*)(shm + KS + (32 * kk + 8 * fq + 4 + q_) * RS + (16 * dt + 4 * p_) * 2));
                        bf16x8 af; af[0] = t0[0]; af[1] = t0[1]; af[2] = t0[2]; af[3] = t0[3]; af[4] = t1[0]; af[5] = t1[1]; af[6] = t1[2]; af[7] = t1[3];
#pragma unroll
                        for (int vt = 0; vt < 3; ++vt) cacc[i][vt] = __builtin_amdgcn_mfma_f32_16x16x32_bf16(af, bfv[vt], cacc[i][vt], 0, 0, 0);
                    }
                }
#pragma unroll
                for (int i = 0; i < 2; ++i)
#pragma unroll
                    for (int vt = 0; vt < 3; ++vt) {
                        u32x2 o; o[0] = pk2(cacc[i][vt][0], cacc[i][vt][1]); o[1] = pk2(cacc[i][vt][2], cacc[i][vt][3]);
                        *(LAS u32x2*)(shm + CB + (16 * vt + fr) * RS + (16 * (2 * wid + i) + 4 * fq) * 2) = o;
                    }
            }
            __syncthreads();
        }
    }
}

constexpr int S5L = 32, S5NCH = SEQ / S5L;
constexpr size_t T_KT_OFF = 0, T_WS_OFF = 2u << 20, T_V_OFF = 10u << 20, T_AL_OFF = 18u << 20;
constexpr int KT_G = 33 * 256, WS_G = 128 * 512, V_G = 512 * 128;

DEV void s5_tables(LAS char* shm, char* tab, const float* lam_re, const float* lam_im, const float* log_dt, const float* b_re, const float* b_im,
                   const float* c_re, const float* c_im) {
    const int tid = opaque_tid();
    LAS f32x2* apw = (LAS f32x2*)shm;
    LAS f32x2* bb = (LAS f32x2*)(shm + 64 * 33 * 8);
    LAS f32x2* cc = (LAS f32x2*)(shm + 64 * 33 * 8 + 8192);
    bf16_t* KT = (bf16_t*)(tab + T_KT_OFF); bf16_t* WS = (bf16_t*)(tab + T_WS_OFF); bf16_t* VV = (bf16_t*)(tab + T_V_OFF); float2* AL = (float2*)(tab + T_AL_OFF);
    for (int it = blockIdx.x; it < 256; it += gridDim.x) {
        const int g = it & 63, qd = it >> 6;
        __syncthreads();
        if (tid < 64) {
            const int pp = tid;
            const double lr = lam_re[g * NP + pp], li = lam_im[g * NP + pp], dt = exp((double)log_dt[g]);
            const double er = exp(lr * dt);
            const double ar = er * cos(li * dt), ai = er * sin(li * dt);
            const double dr = ar - 1.0, di = ai, den = lr * lr + li * li;
            const double cr = (dr * lr + di * li) / den, ci = (di * lr - dr * li) / den;
            double pr = 1.0, pi_ = 0.0;
            for (int e = 0; e <= 32; ++e) {
                apw[pp * 33 + e] = (f32x2){(float)pr, (float)pi_};
                const double nr = pr * ar - pi_ * ai, ni = pr * ai + pi_ * ar; pr = nr; pi_ = ni;
            }
            if (qd == 0) { const f32x2 t_ = apw[pp * 33 + 32]; AL[g * NP + pp] = make_float2(t_.x, t_.y); }
            for (int c = 0; c < 16; ++c) {
                const double br = b_re[(g * NP + pp) * GC + c], bi = b_im[(g * NP + pp) * GC + c];
                bb[pp * 16 + c] = (f32x2){(float)(cr * br - ci * bi), (float)(cr * bi + ci * br)};
                cc[c * 64 + pp] = (f32x2){c_re[(g * GC + c) * NP + pp], c_im[(g * GC + c) * NP + pp]};
            }
        }
        __syncthreads();
        for (int o = tid; o < 8 * 256; o += 512) {
            const int d = 8 * qd + (o >> 8), c1 = (o >> 4) & 15, c0 = o & 15;
            float acc = 0.f;
            for (int pp = 0; pp < 64; ++pp) {
                const f32x2 a = apw[pp * 33 + d], b = bb[pp * 16 + c0], c = cc[c1 * 64 + pp];
                const float mr = a.x * b.x - a.y * b.y, mi = a.x * b.y + a.y * b.x;
                acc += c.x * mr - c.y * mi;
            }
            KT[(size_t)g * KT_G + (d + 1) * 256 + c1 * 16 + c0] = f2bf(acc);
        }
        if (qd == 0 && tid < 256) KT[(size_t)g * KT_G + tid] = 0;
        for (int o = tid; o < 2 * 16 * 64; o += 512) {
            const int mt = 2 * qd + (o >> 10), sp = (o >> 6) & 15, ln = o & 63;
            const int row = 16 * mt + (ln & 15), ri = row >> 6, pp = row & 63, s_ = 2 * sp + (ln >> 5), c0 = 8 * ((ln >> 4) & 1);
            const f32x2 a = apw[pp * 33 + 31 - s_];
            unsigned w[4];
#pragma unroll
            for (int jj = 0; jj < 8; jj += 2) {
                const f32x2 b0 = bb[pp * 16 + c0 + jj], b1 = bb[pp * 16 + c0 + jj + 1];
                const float v0 = ri ? (a.x * b0.y + a.y * b0.x) : (a.x * b0.x - a.y * b0.y);
                const float v1 = ri ? (a.x * b1.y + a.y * b1.x) : (a.x * b1.x - a.y * b1.y);
                w[jj >> 1] = (unsigned)f2bf(v0) | ((unsigned)f2bf(v1) << 16);
            }
            *(uint4*)(WS + (size_t)g * WS_G + ((size_t)(mt * 16 + sp) * 64 + ln) * 8) = make_uint4(w[0], w[1], w[2], w[3]);
        }
        for (int o = tid; o < 8 * 4 * 64; o += 512) {
            const int i = 8 * qd + (o >> 8), ks = (o >> 6) & 3, ln = o & 63;
            const int c1 = ln & 15, k0 = 32 * ks + 8 * (ln >> 4);
            unsigned w[4];
#pragma unroll
            for (int jj = 0; jj < 8; jj += 2) {
                float v[2];
#pragma unroll
                for (int e = 0; e < 2; ++e) {
                    const int kk = k0 + jj + e, ri = kk >> 6, pp = kk & 63;
                    const f32x2 a = apw[pp * 33 + i + 1], c = cc[c1 * 64 + pp];
                    v[e] = ri ? -(c.x * a.y + c.y * a.x) : (c.x * a.x - c.y * a.y);
                }
                w[jj >> 1] = (unsigned)f2bf(v[0]) | ((unsigned)f2bf(v[1]) << 16);
            }
            *(uint4*)(VV + (size_t)g * V_G + ((size_t)(i * 4 + ks) * 64 + ln) * 8) = make_uint4(w[0], w[1], w[2], w[3]);
        }
    }
}

DEV void s5_phase(LAS char* shm, bf16_t* UY, const char* tab, const float* dskip) {
    const int tid = opaque_tid(), wid = __builtin_amdgcn_readfirstlane(tid >> 6), lane = tid & 63, fr = lane & 15, fq = lane >> 4;
    constexpr int PLANE = 64 * 528, KTL = 2 * PLANE, SL = KTL + 33 * 512, HB = SL + 64 * 528, SRS = 528, HRS = 272;
    const bf16_t* KT = (const bf16_t*)(tab + T_KT_OFF); const bf16_t* WS = (const bf16_t*)(tab + T_WS_OFF); const bf16_t* VV = (const bf16_t*)(tab + T_V_OFF);
    const float2* AL = (const float2*)(tab + T_AL_OFF);
    for (int item = blockIdx.x; item < BATCH * NG; item += gridDim.x) {
        const int g = item & 63, b = item >> 6;
        bf16_t* Ub = UY + (size_t)b * SEQ * DM + g * GC;
        __syncthreads();
#pragma unroll
        for (int i = 0; i < 8; ++i) {
            const int idx = tid + 512 * i, tok = idx >> 1, hf = idx & 1;
            const uint4 uv = *(const uint4*)(Ub + (size_t)tok * DM + hf * 8);
            *(LAS u32x4*)(shm + hf * PLANE + (tok >> 5) * 528 + (tok & 31) * 16) = (u32x4){uv.x, uv.y, uv.z, uv.w};
        }
        for (int idx = tid; idx < 33 * 32; idx += 512) {
            const uint4 kv = *(const uint4*)(KT + (size_t)g * KT_G + idx * 8);
            *(LAS u32x4*)(shm + KTL + idx * 16) = (u32x4){kv.x, kv.y, kv.z, kv.w};
        }
        __syncthreads();
        f32x4 acc[4][4], sac[4];
#pragma unroll
        for (int q = 0; q < 4; ++q)
#pragma unroll
            for (int nt = 0; nt < 4; ++nt) acc[q][nt] = (f32x4){0.f, 0.f, 0.f, 0.f};
#pragma unroll
        for (int nt = 0; nt < 4; ++nt) sac[nt] = (f32x4){0.f, 0.f, 0.f, 0.f};
        const bf16_t* wsp = WS + (size_t)g * WS_G + ((size_t)(wid * 16) * 64 + lane) * 8;
        bf16x8 wnext = *(const bf16x8*)wsp;
#pragma nounroll
        for (int sp = 0; sp < 16; ++sp) {
            const bf16x8 wcur = wnext;
            if (sp + 1 < 16) wnext = *(const bf16x8*)(wsp + (size_t)(sp + 1) * 64 * 8);
            bf16x8 bu[4];
#pragma unroll
            for (int nt = 0; nt < 4; ++nt) bu[nt] = *(const LAS bf16x8*)(shm + (fq & 1) * PLANE + (16 * nt + fr) * 528 + (2 * sp + (fq >> 1)) * 16);
#pragma unroll
            for (int nt = 0; nt < 4; ++nt) sac[nt] = __builtin_amdgcn_mfma_f32_16x16x32_bf16(wcur, bu[nt], sac[nt], 0, 0, 0);
#pragma unroll
            for (int q = 0; q < 4; ++q) {
                const int i = wid + 8 * q;
                if (i >= 2 * sp) {
                    const int d = i - 2 * sp;
                    const bf16x8 kf = *(const LAS bf16x8*)(shm + KTL + (d - (fq >> 1) + 1) * 512 + fr * 32 + (fq & 1) * 16);
#pragma unroll
                    for (int nt = 0; nt < 4; ++nt) acc[q][nt] = __builtin_amdgcn_mfma_f32_16x16x32_bf16(kf, bu[nt], acc[q][nt], 0, 0, 0);
                }
            }
        }
#pragma unroll
        for (int nt = 0; nt < 4; ++nt) *(LAS f32x4*)(shm + SL + (16 * nt + fr) * SRS + (16 * wid + 4 * fq) * 4) = sac[nt];
        __syncthreads();
        if (wid == 0) {
            const float2 al = AL[g * NP + lane];
            float hr = 0.f, hi = 0.f;
#pragma unroll 8
            for (int n = 0; n < S5NCH; ++n) {
                *(LAS bf16_t*)(shm + HB + n * HRS + lane * 2) = f2bf(hr);
                *(LAS bf16_t*)(shm + HB + n * HRS + (64 + lane) * 2) = f2bf(hi);
                const float sr = *(const LAS float*)(shm + SL + n * SRS + lane * 4), si = *(const LAS float*)(shm + SL + n * SRS + (64 + lane) * 4);
                const float nr = al.x * hr - al.y * hi + sr, ni = al.x * hi + al.y * hr + si;
                hr = nr; hi = ni;
            }
        }
        __syncthreads();
        const bf16_t* vvp = VV + (size_t)g * V_G + (size_t)lane * 8;
#pragma unroll
        for (int ks = 0; ks < 4; ++ks) {
            bf16x8 hb[4], va[4];
#pragma unroll
            for (int q = 0; q < 4; ++q) va[q] = *(const bf16x8*)(vvp + ((size_t)((wid + 8 * q) * 4 + ks) * 64) * 8);
#pragma unroll
            for (int nt = 0; nt < 4; ++nt) hb[nt] = *(const LAS bf16x8*)(shm + HB + (16 * nt + fr) * HRS + (32 * ks + 8 * fq) * 2);
#pragma unroll
            for (int q = 0; q < 4; ++q)
#pragma unroll
                for (int nt = 0; nt < 4; ++nt) acc[q][nt] = __builtin_amdgcn_mfma_f32_16x16x32_bf16(va[q], hb[nt], acc[q][nt], 0, 0, 0);
        }
        const float4 dsk = *(const float4*)(dskip + g * GC + 4 * fq);
#pragma unroll
        for (int q = 0; q < 4; ++q) {
            const int i = wid + 8 * q;
#pragma unroll
            for (int nt = 0; nt < 4; ++nt) {
                const int n = 16 * nt + fr;
                const u32x2 uu = *(const LAS u32x2*)(shm + (fq >> 1) * PLANE + n * 528 + i * 16 + ((4 * fq) & 7) * 2);
                f32x4 o;
                o[0] = geluf_(acc[q][nt][0] + dsk.x * bf2f((bf16_t)(uu[0] & 0xffff))); o[1] = geluf_(acc[q][nt][1] + dsk.y * bf2f((bf16_t)(uu[0] >> 16)));
                o[2] = geluf_(acc[q][nt][2] + dsk.z * bf2f((bf16_t)(uu[1] & 0xffff))); o[3] = geluf_(acc[q][nt][3] + dsk.w * bf2f((bf16_t)(uu[1] >> 16)));
                *(uint2*)(Ub + (size_t)(n * 32 + i) * DM + 4 * fq) = pack4(o);
            }
        }
    }
}

DEV void unpack8(const uint4 v, float* f) {
    f[0] = bf2f((bf16_t)(v.x & 0xffff)); f[1] = bf2f((bf16_t)(v.x >> 16)); f[2] = bf2f((bf16_t)(v.y & 0xffff)); f[3] = bf2f((bf16_t)(v.y >> 16));
    f[4] = bf2f((bf16_t)(v.z & 0xffff)); f[5] = bf2f((bf16_t)(v.z >> 16)); f[6] = bf2f((bf16_t)(v.w & 0xffff)); f[7] = bf2f((bf16_t)(v.w >> 16));
}
DEV uint4 pack8(const float* f) { return make_uint4(pk2(f[0], f[1]), pk2(f[2], f[3]), pk2(f[4], f[5]), pk2(f[6], f[7])); }

DEV void norm_rows(const float* x, const float* gain, const float* modl, bf16_t* h) {
    const int tid = opaque_tid(), lane = tid & 63, gw = blockIdx.x * 8 + (tid >> 6), NGW = gridDim.x * 8;
    for (int m = gw; m < MTOK; m += NGW) {
        const float4* xr = (const float4*)(x + (size_t)m * DM) + lane;
        float4 v[4]; float ss = 0.f;
#pragma unroll
        for (int j = 0; j < 4; ++j) { v[j] = xr[64 * j]; ss += v[j].x * v[j].x + v[j].y * v[j].y + v[j].z * v[j].z + v[j].w * v[j].w; }
        const float rstd = rsqrtf(wave_sum(ss) * (1.f / DM) + EPS);
        const float* shift = modl + (size_t)(m / SEQ) * 3 * DM; const float* scale = shift + DM;
#pragma unroll
        for (int j = 0; j < 4; ++j) {
            const int n = 4 * lane + 256 * j;
            const float4 g = *(const float4*)(gain + n), sc = *(const float4*)(scale + n), sh = *(const float4*)(shift + n);
            f32x4 o; o[0] = v[j].x * rstd * g.x * (1.f + sc.x) + sh.x; o[1] = v[j].y * rstd * g.y * (1.f + sc.y) + sh.y;
            o[2] = v[j].z * rstd * g.z * (1.f + sc.z) + sh.z; o[3] = v[j].w * rstd * g.w * (1.f + sc.w) + sh.w;
            *(uint2*)(h + (size_t)m * DM + n) = pack4(o);
        }
    }
}
DEV void ssm_post_rows(bf16_t* z, const bf16_t* sg, const float* gain) {
    const int tid = opaque_tid(), lane = tid & 63, gw = blockIdx.x * 8 + (tid >> 6), NGW = gridDim.x * 8;
    for (int m = gw; m < MTOK; m += NGW) {
        float zv[2][8], gv[2][8]; float ss = 0.f;
#pragma unroll
        for (int j = 0; j < 2; ++j) {
            unpack8(*(const uint4*)(z + (size_t)m * DM + 8 * lane + 512 * j), zv[j]);
            unpack8(*(const uint4*)(sg + (size_t)m * DM + 8 * lane + 512 * j), gv[j]);
#pragma unroll
            for (int e = 0; e < 8; ++e) ss += zv[j][e] * zv[j][e];
        }
        const float rstd = rsqrtf(wave_sum(ss) * (1.f / DM) + EPS);
#pragma unroll
        for (int j = 0; j < 2; ++j) {
            const int n = 8 * lane + 512 * j; float o[8];
#pragma unroll
            for (int e = 0; e < 8; ++e) o[e] = zv[j][e] * rstd * gain[n + e] * siluf_(gv[j][e]);
            *(uint4*)(z + (size_t)m * DM + n) = pack8(o);
        }
    }
}
DEV void mlstm_post_rows(bf16_t* hc, const bf16_t* mo, const bf16_t* mg, const bf16_t* mi, const float* cw, const float* cb, const float* ngain, const float* skip) {
    const int tid = opaque_tid(), lane = tid & 63, gw = blockIdx.x * 8 + (tid >> 6), NGW = gridDim.x * 8;
    for (int m = gw; m < MTOK; m += NGW) {
        const size_t o0 = (size_t)m * DM + 16 * lane;
        float hv[16], t8[8]; float s1 = 0.f;
#pragma unroll
        for (int j = 0; j < 2; ++j) {
            unpack8(*(const uint4*)(hc + o0 + 8 * j), hv + 8 * j);
            unpack8(*(const uint4*)(mo + o0 + 8 * j), t8);
#pragma unroll
            for (int e = 0; e < 8; ++e) { hv[8 * j + e] *= sigmoidf_(t8[e]); s1 += hv[8 * j + e]; }
        }
#pragma unroll
        for (int o = 1; o < 16; o <<= 1) s1 += __shfl_xor(s1, o);
        const float mu = s1 * (1.f / DH); float s2 = 0.f;
#pragma unroll
        for (int e = 0; e < 16; ++e) { hv[e] -= mu; s2 += hv[e] * hv[e]; }
#pragma unroll
        for (int o = 1; o < 16; o <<= 1) s2 += __shfl_xor(s2, o);
        const float rstd = rsqrtf(s2 * (1.f / DH) + EPS);
#pragma unroll
        for (int j = 0; j < 2; ++j) {
            float xv[8], gv[8], ov[8], t8b[8];
            { const int n0 = 16 * lane + 8 * j, tpos = m % SEQ;
#pragma unroll
              for (int e = 0; e < 8; ++e) xv[e] = cb[n0 + e];
#pragma unroll
              for (int tap = 0; tap < 4; ++tap) if (tpos - 3 + tap >= 0) {
                  unpack8(*(const uint4*)(mi + (size_t)(m - 3 + tap) * DM + n0), t8b);
#pragma unroll
                  for (int e = 0; e < 8; ++e) xv[e] += t8b[e] * cw[tap * DM + n0 + e];
              }
#pragma unroll
              for (int e = 0; e < 8; ++e) xv[e] = siluf_(xv[e]); }
            unpack8(*(const uint4*)(mg + o0 + 8 * j), gv);
#pragma unroll
            for (int e = 0; e < 8; ++e) { const int n = 16 * lane + 8 * j + e; ov[e] = (hv[8 * j + e] * rstd * ngain[n] + skip[n] * xv[e]) * siluf_(gv[e]); }
            *(uint4*)(hc + o0 + 8 * j) = pack8(ov);
        }
    }
}
DEV void final_rows(float* x, const float* gain) {
    const int tid = opaque_tid(), lane = tid & 63, gw = blockIdx.x * 8 + (tid >> 6), NGW = gridDim.x * 8;
    for (int m = gw; m < MTOK; m += NGW) {
        float4* xr = (float4*)(x + (size_t)m * DM) + lane;
        float4 v[4]; float ss = 0.f;
#pragma unroll
        for (int j = 0; j < 4; ++j) { v[j] = xr[64 * j]; ss += v[j].x * v[j].x + v[j].y * v[j].y + v[j].z * v[j].z + v[j].w * v[j].w; }
        const float rstd = rsqrtf(wave_sum(ss) * (1.f / DM) + EPS);
#pragma unroll
        for (int j = 0; j < 4; ++j) {
            const float4 g = *(const float4*)(gain + 4 * lane + 256 * j);
            v[j].x *= rstd * g.x; v[j].y *= rstd * g.y; v[j].z *= rstd * g.z; v[j].w *= rstd * g.w;
            xr[64 * j] = v[j];
        }
    }
}
DEV void mod_phase(LAS char* shm, const float* c, const float* w_mod, const float* b_mod, float* mod) {
    const int tid = opaque_tid();
    LAS float* sc = (LAS float*)shm;
    LAS float* pr = (LAS float*)(shm + 32768);
    __syncthreads();
    for (int i = tid; i < BATCH * DM; i += 512) sc[i] = siluf_(c[i]);
    __syncthreads();
    for (int it = blockIdx.x; it < 48; it += gridDim.x) {
        const int l = it / 24, n0 = (it % 24) * 128, cq = tid & 31, kg = tid >> 5;
        const float* W = w_mod + (size_t)l * DM * 3 * DM + n0 + 4 * cq;
        float acc[BATCH][4];
#pragma unroll
        for (int b = 0; b < BATCH; ++b) { acc[b][0] = acc[b][1] = acc[b][2] = acc[b][3] = 0.f; }
        for (int k = kg * 64; k < kg * 64 + 64; ++k) {
            const float4 w = *(const float4*)(W + (size_t)k * 3 * DM);
#pragma unroll
            for (int b = 0; b < BATCH; ++b) { const float s_ = sc[b * DM + k]; acc[b][0] += s_ * w.x; acc[b][1] += s_ * w.y; acc[b][2] += s_ * w.z; acc[b][3] += s_ * w.w; }
        }
#pragma unroll
        for (int b = 0; b < BATCH; ++b) *(LAS f32x4*)(pr + (kg * 8 + b) * 128 + 4 * cq) = (f32x4){acc[b][0], acc[b][1], acc[b][2], acc[b][3]};
        __syncthreads();
        for (int o = tid; o < 8 * 128; o += 512) {
            const int b = o >> 7, n = o & 127; float s_ = 0.f;
#pragma unroll
            for (int g2 = 0; g2 < 16; ++g2) s_ += pr[(g2 * 8 + b) * 128 + n];
            mod[((size_t)l * BATCH + b) * 3 * DM + n0 + n] = s_ + b_mod[l * 3 * DM + n0 + n];
        }
        __syncthreads();
    }
}

DEV void wfold_prep(bf16_t* WfT, const float* wq, const float* wk, const float* wv, const float* wg  ) {
    const int tid = opaque_tid();
    for (int o = blockIdx.x * 512 + tid; o < 2 * 16 * 1024; o += gridDim.x * 512) {
        const int which = o >> 14, j = (o >> 10) & 15, ch = o & 1023, hd = ch >> 8, d = ch & 255;
        float acc = 0.f;
        if (j < 8) {
            if (which == 0) {
                const float* rq = wq + ((size_t)hd * DH + d) * DH; const float* rk = wk + ((size_t)hd * DH + d) * DH;
                float a1 = 0.f, a2 = 0.f;
                for (int e = 0; e < DH; ++e) { a1 += rq[e] * wg[(size_t)(hd * DH + e) * 8 + j]; a2 += rk[e] * wg[(size_t)(DM + hd * DH + e) * 8 + j]; }
                acc = a1 + 0.0625f * a2;
            } else {
                const float* rv = wv + ((size_t)hd * DH + d) * DH;
                for (int e = 0; e < DH; ++e) acc += rv[e] * wg[(size_t)(2 * DM + hd * DH + e) * 8 + j];
            }
        }
        WfT[o] = f2bf(acc);
    }
}
DEV void xc_gates_phase(LAS char* shm, const bf16_t* mi, bf16_t* xc, const bf16_t* WfT, const float* cw, const float* cb, float* gpart  ) {
    const int tid = opaque_tid(), wid = __builtin_amdgcn_readfirstlane(tid >> 6), lane = tid & 63, fr = lane & 15, fq = lane >> 4;
    constexpr int WRS = 2064, WIMG = 16 * WRS, STG = 2 * WIMG, SRS_ = 528, STG_W = 19 * SRS_;
    __syncthreads();
    for (int i = tid; i < 2 * 16 * 128; i += 512) {
        const int rowi = i >> 7, pc = i & 127;
        const uint4 v = *(const uint4*)(WfT + (size_t)rowi * 1024 + pc * 8);
        *(LAS u32x4*)(shm + rowi * WRS + pc * 16) = (u32x4){v.x, v.y, v.z, v.w};
    }
    __syncthreads();
    LAS char* stg = shm + STG + wid * STG_W;
    for (int task = blockIdx.x * 8 + wid; task < (MTOK / 16) * 2; task += gridDim.x * 8) {
        const int chalf = task & 1, m0 = (task >> 1) * 16, tpos0 = m0 % SEQ;
        f32x4 acc = (f32x4){0.f, 0.f, 0.f, 0.f};
#pragma nounroll
        for (int sl = 0; sl < 2; ++sl) {
            const int c0 = chalf * 512 + sl * 256;
            for (int i = lane; i < 19 * 32; i += 64) {
                const int row = i >> 5, pc = i & 31;
                uint4 v = make_uint4(0, 0, 0, 0);
                if (tpos0 - 3 + row >= 0) v = *(const uint4*)(mi + (size_t)(m0 - 3 + row) * DM + c0 + pc * 8);
                *(LAS u32x4*)(stg + row * SRS_ + pc * 16) = (u32x4){v.x, v.y, v.z, v.w};
            }
#pragma nounroll
            for (int ks = 0; ks < 8; ++ks) {
                const int cl = 32 * ks + 8 * fq, c = c0 + cl;
                float xv[8], t8[8], w8[8];
                { const float4 b0 = *(const float4*)(cb + c), b1 = *(const float4*)(cb + c + 4);
                  xv[0] = b0.x; xv[1] = b0.y; xv[2] = b0.z; xv[3] = b0.w; xv[4] = b1.x; xv[5] = b1.y; xv[6] = b1.z; xv[7] = b1.w; }
                u32x4 raw3;
#pragma unroll
                for (int tap = 0; tap < 4; ++tap) {
                    const u32x4 rw = *(const LAS u32x4*)(stg + (fr + tap) * SRS_ + cl * 2);
                    if (tap == 3) raw3 = rw;
                    unpack8(make_uint4(rw[0], rw[1], rw[2], rw[3]), t8);
                    const float4 w0 = *(const float4*)(cw + tap * DM + c), w1 = *(const float4*)(cw + tap * DM + c + 4);
                    w8[0] = w0.x; w8[1] = w0.y; w8[2] = w0.z; w8[3] = w0.w; w8[4] = w1.x; w8[5] = w1.y; w8[6] = w1.z; w8[7] = w1.w;
#pragma unroll
                    for (int e = 0; e < 8; ++e) xv[e] += t8[e] * w8[e];
                }
#pragma unroll
                for (int e = 0; e < 8; ++e) xv[e] = siluf_(xv[e]);
                const uint4 xp = pack8(xv);
                *(uint4*)(xc + (size_t)(m0 + fr) * DM + c) = xp;
                const u32x4 xpu = (u32x4){xp.x, xp.y, xp.z, xp.w};
                const bf16x8 bx = *(const LAS bf16x8*)(shm + fr * WRS + c * 2);
                const bf16x8 bv = *(const LAS bf16x8*)(shm + WIMG + fr * WRS + c * 2);
                acc = __builtin_amdgcn_mfma_f32_16x16x32_bf16(*(const bf16x8*)&xpu, bx, acc, 0, 0, 0);
                acc = __builtin_amdgcn_mfma_f32_16x16x32_bf16(*(const bf16x8*)&raw3, bv, acc, 0, 0, 0);
            }
        }
        if (fr < 8) {
#pragma unroll
            for (int r = 0; r < 4; ++r) gpart[((size_t)chalf * MTOK + m0 + 4 * fq + r) * 8 + fr] = acc[r];
        }
    }
}

#define XB_TMO      128
#define XB_XCNT(j)  (256  + 64 * (j))
#define XB_XSUB(j)  (1280 + 64 * (j))
#define XB_XGEN(j)  (2304 + 64 * (j))
#define XB_TOP      3328
#define XB_TOPGEN   3392
#define XCD_BAR_WORDS 3456
#define XB_SPIN_CAP (1u << 18)
DEV unsigned xb_ld(unsigned* p) { return __hip_atomic_load(p, __ATOMIC_RELAXED, __HIP_MEMORY_SCOPE_AGENT); }
DEV unsigned xb_add(unsigned* p, unsigned v) { return __hip_atomic_fetch_add(p, v, __ATOMIC_RELAXED, __HIP_MEMORY_SCOPE_AGENT); }
DEV unsigned xb_xcc_id() { return (unsigned)__builtin_amdgcn_s_getreg((3 << 11) | 20) & 0xFu; }
#define XB_SPIN(cond, bar) do { unsigned _sp = 0; while (cond) { __builtin_amdgcn_s_sleep(1); \
    if ((++_sp & 255u) == 0u) { if (xb_ld(&(bar)[XB_TMO])) break; if (_sp > XB_SPIN_CAP) { atomicAdd(&(bar)[XB_TMO], 1u); break; } } } } while (0)
struct XcdBarrier { unsigned* bar; unsigned x; volatile LAS unsigned* st; };
DEV XcdBarrier xcd_barrier_post(unsigned* bar, volatile LAS unsigned* st) {
    XcdBarrier b; b.bar = bar; b.x = xb_xcc_id(); b.st = st;
    if (threadIdx.x == 0) (void)xb_add(&bar[XB_XCNT(b.x)], 1u);
    return b;
}
DEV void xcd_barrier_complete(unsigned* bar, unsigned x, unsigned& nloc, unsigned& nx) {
    const unsigned G = gridDim.x * gridDim.y * gridDim.z;
    unsigned sum, cnt, mine, sp = 0u;
    for (;;) {
        sum = 0u; cnt = 0u; mine = 0u;
#pragma unroll
        for (unsigned j = 0; j < 16; ++j) { const unsigned c = xb_ld(&bar[XB_XCNT(j)]); sum += c; cnt += (c > 0u) ? 1u : 0u; mine = (j == x) ? c : mine; }
        if (sum == G) break;
        __builtin_amdgcn_s_sleep(1);
        if ((++sp & 255u) == 0u) { if (xb_ld(&bar[XB_TMO])) break; if (sp > XB_SPIN_CAP) { atomicAdd(&bar[XB_TMO], 1u); break; } }
    }
    nloc = mine > 0u ? mine : 1u; nx = cnt > 0u ? cnt : 1u;
}
DEV void xcd_barrier(const XcdBarrier& b) {
    asm volatile("s_waitcnt vmcnt(0)" ::: "memory");
    __syncthreads();
    if (threadIdx.x == 0) {
        unsigned* bar = b.bar;
        __builtin_amdgcn_s_waitcnt(0);
        unsigned nloc = b.st[0], nx = b.st[1];
        if (nloc == 0u) { xcd_barrier_complete(bar, b.x, nloc, nx); b.st[0] = nloc; b.st[1] = nx; }
        const unsigned old = xb_add(&bar[XB_XSUB(b.x)], 1u);
        const unsigned gen = old / nloc;
        if (old + 1u == (gen + 1u) * nloc) {
            __builtin_amdgcn_fence(__ATOMIC_RELEASE, "agent");
            asm volatile("s_waitcnt vmcnt(0)" ::: "memory");
            const unsigned og = xb_add(&bar[XB_TOP], 1u);
            const unsigned tg = og / nx;
            if (og + 1u == (tg + 1u) * nx) xb_add(&bar[XB_TOPGEN], 1u);
            else XB_SPIN(xb_ld(&bar[XB_TOPGEN]) == tg, bar);
            __builtin_amdgcn_fence(__ATOMIC_ACQUIRE, "agent");
            xb_add(&bar[XB_XGEN(b.x)], 1u);
            asm volatile("s_waitcnt vmcnt(0)" ::: "memory");
        } else {
            XB_SPIN(xb_ld(&bar[XB_XGEN(b.x)]) == gen, bar);
            __builtin_amdgcn_fence(__ATOMIC_ACQUIRE, "agent");
            asm volatile("s_waitcnt vmcnt(0)" ::: "memory");
        }
    }
    __syncthreads();
}

struct Params {
    const float *x, *c, *norm_gain, *w_mod, *b_mod, *w_in, *lam_re, *lam_im, *log_dt, *sb_re, *sb_im, *sc_re, *sc_im, *ssm_d, *w_glu, *b_glu, *ssm_og,
        *conv_w, *conv_b, *wq, *wk, *wv, *w_gates, *b_ig, *b_fg, *m_ng, *m_skip, *w_out, *final_gain;
    float* out; char* ws;
};
constexpr int LDS_BYTES = 148 * 1024;
constexpr int HALF_FLOATS = 56 * 1024 / 4;
constexpr size_t SLOT = (size_t)MTOK * DM * 2;
constexpr size_t W_IN_OFF = 0, W_GLU_OFF = 10485760, W_QKV_OFF = 12582912, W_OUT_OFF = 14155776, MOD_OFF = 20u << 20, IPRE_OFF = 21u << 20, LOGF_OFF = 22u << 20, BAR_OFF = 23u << 20, WF_OFF = 19u << 20;
#define FOR_VB(nvb) for (int vb = blockIdx.x * 2 + HALF; vb < (nvb); vb += gridDim.x * 2)

__global__ void __launch_bounds__(512, 2) mega(Params P) {
    extern __shared__ __attribute__((aligned(16))) unsigned char lds_raw[];
    LAS char* shm = (LAS char*)lds_raw;
    float* ldsf = (float*)lds_raw + HALF * HALF_FLOATS;
    volatile LAS unsigned* bst = (volatile LAS unsigned*)(shm + LDS_BYTES - 16);
    if (threadIdx.x < 4) bst[threadIdx.x] = 0u;
    __syncthreads();
    const XcdBarrier gbar = xcd_barrier_post((unsigned*)(P.ws + SLOT * 7 + BAR_OFF), bst);
    bf16_t* S[7];
#pragma unroll
    for (int i = 0; i < 7; ++i) S[i] = (bf16_t*)(P.ws + SLOT * i);
    char* s7 = P.ws + SLOT * 7;
    bf16_t* WinT = (bf16_t*)(s7 + W_IN_OFF); bf16_t* WgluT = (bf16_t*)(s7 + W_GLU_OFF); bf16_t* WqkvT = (bf16_t*)(s7 + W_QKV_OFF); bf16_t* WoutT = (bf16_t*)(s7 + W_OUT_OFF);
    float* mod = (float*)(s7 + MOD_OFF);
    float* gpart = (float*)(s7 + IPRE_OFF);
    bf16_t* WfT = (bf16_t*)(s7 + WF_OFF);
    float* out = P.out;
    mod_phase(shm, P.c, P.w_mod, P.b_mod, mod);
    xcd_barrier(gbar);
    for (int l = 0; l < 2; ++l) {
        const int wave = opaque_tid() >> 6, lane = opaque_tid() & 63;
        const float* xin = (l == 0) ? P.x : out;
        const float* modl = mod + (size_t)l * BATCH * 3 * DM;
        bf16_t *H = S[0], *U = S[1], *Y = S[1], *Z = S[3], *SG = S[4], *MI = S[5], *Q = S[6], *Kb = S[1], *V = S[2], *XC = S[4], *HC = S[4], *MO = S[1], *MG = S[2];
        {
            LAS float* scr = (LAS float*)(shm + wave * 8448);
            const float* Win = P.w_in + (size_t)l * DM * INC;
            constexpr int I_IN = 16 * 160, I_GLU = 16 * 32, I_QKV = 12 * 32, I_OUT = 32 * 32;
            for (int it = blockIdx.x * 8 + wave; it < I_IN + I_GLU + I_QKV + I_OUT; it += gridDim.x * 8) {
                int r = it;
                if (r < I_IN) { transpose_item(Win, INC, INC, WinT, DM, scr, r, lane); continue; } r -= I_IN;
                if (r < I_GLU) { transpose_item(P.w_glu + (size_t)l * DM * DM, DM, DM, WgluT, DM, scr, r, lane); continue; } r -= I_GLU;
                if (r < I_QKV) { const int mat = r / 32, which = mat >> 2, hd = mat & 3;
                    const float* W = sel3(which, P.wq, P.wk, P.wv) + ((size_t)l * NH + hd) * DH * DH;
                    transpose_item(W, DH, DH, WqkvT + (size_t)mat * DH * DH, DH, scr, r % 32, lane); continue; } r -= I_QKV;
                transpose_item(P.w_out + (size_t)l * 2 * DM * DM, DM, DM, WoutT, 2 * DM, scr, r, lane);
            }
        }
        wfold_prep(WfT, P.wq + (size_t)l * NH * DH * DH, P.wk + (size_t)l * NH * DH * DH, P.wv + (size_t)l * NH * DH * DH, P.w_gates + (size_t)l * 3 * DM * 8);
        __syncthreads();
        s5_tables(shm, (char*)S[3], P.lam_re + l * NG * NP, P.lam_im + l * NG * NP, P.log_dt + l * NG, P.sb_re + (size_t)l * NG * NP * GC, P.sb_im + (size_t)l * NG * NP * GC,
                  P.sc_re + (size_t)l * NG * GC * NP, P.sc_im + (size_t)l * NG * GC * NP);
        __syncthreads();
        norm_rows(xin, P.norm_gain + l * DM, modl, H);
        xcd_barrier(gbar);
        { ProbIn pb{H, WinT, U, SG, MI, 12}; gemm_phase(shm, pb); }
        xcd_barrier(gbar);
        s5_phase(shm, U, (const char*)S[3], P.ssm_d + l * DM);
        xcd_barrier(gbar);
        { ProbGlu pb{Y, WgluT, Z, P.b_glu + l * DM, 4}; gemm_phase(shm, pb); }
        xcd_barrier(gbar);
        ssm_post_rows(Z, SG, P.ssm_og + l * DM);
        xcd_barrier(gbar);
        xc_gates_phase(shm, MI, XC, WfT, P.conv_w + l * 4 * DM, P.conv_b + l * DM, gpart);
        xcd_barrier(gbar);
        { ProbQkv pb{XC, MI, WqkvT, Q, Kb, V, 12}; gemm_phase(shm, pb); }
        xcd_barrier(gbar);
        mlstm_phase(shm, Q, Kb, V, gpart, P.b_ig + l * 4, P.b_fg + l * 4, HC);
        xcd_barrier(gbar);
        { ProbIn pb{H, WinT + (size_t)3072 * DM, MO, MG, MG, 8}; gemm_phase(shm, pb); }
        xcd_barrier(gbar);
        mlstm_post_rows(HC, MO, MG, MI, P.conv_w + l * 4 * DM, P.conv_b + l * DM, P.m_ng + l * DM, P.m_skip + l * DM);
        xcd_barrier(gbar);
        { ProbOut pb{Z, HC, WoutT, xin, out, modl + 2 * DM, 4}; gemm_phase(shm, pb); }
        xcd_barrier(gbar);
    }
    final_rows(out, P.final_gain);
}

extern "C" void kernel_launch(void* const* d_in, const int* in_sizes, int n_in, void* d_out, int out_size, void* d_ws, size_t ws_size, hipStream_t stream) {
    static int grid_blocks = 0;
    if (!grid_blocks) {
        int dev = 0, cus = 0, per_cu = 0;
        (void)hipGetDevice(&dev);
        (void)hipDeviceGetAttribute(&cus, hipDeviceAttributeMultiprocessorCount, dev);
        (void)hipFuncSetAttribute((const void*)mega, hipFuncAttributeMaxDynamicSharedMemorySize, LDS_BYTES);
        (void)hipOccupancyMaxActiveBlocksPerMultiprocessor(&per_cu, (const void*)mega, 512, LDS_BYTES);
        grid_blocks = cus;
        fprintf(stderr, "mega: cus=%d occupancy per_cu=%d grid=%d\n", cus, per_cu, grid_blocks);
    }
    (void)hipMemsetAsync((char*)d_ws + SLOT * 7 + BAR_OFF, 0, XCD_BAR_WORDS * 4, stream);
    Params P{};
    const float** pp = (const float**)&P;
    for (int i = 0; i < 29; ++i) pp[i] = (const float*)d_in[i];
    P.out = (float*)d_out; P.ws = (char*)d_ws;
    void* args[] = {&P};
    hipError_t e = hipLaunchCooperativeKernel((const void*)mega, dim3(grid_blocks), dim3(512), args, LDS_BYTES, stream);
    if (e != hipSuccess) fprintf(stderr, "cooperative launch failed: %s (grid %d)\n", hipGetErrorString(e), grid_blocks);
}
```

```cpp
#include <hip/hip_runtime.h>
#include <cstdio>
#include <cstdint>
#include <hip/hip_cooperative_groups.h>
namespace cg = cooperative_groups;

#ifndef REPMASK
#define REPMASK 0
#endif
typedef unsigned short bf16_t;
#define DEV __device__ __forceinline__

constexpr int BATCH = 8, SEQ = 2048, DM = 1024, MTOK = BATCH * SEQ;
constexpr int NG = 64, NP = 64, GC = 16, NH = 4, DH = 256, CHUNK = 64, INC = 5120;
constexpr float EPS = 1e-6f;

DEV int opaque_tid() { int t = threadIdx.x; asm volatile("" : "+v"(t)); return t; }
#define TIDH (opaque_tid() & 255)
#define HALF (opaque_tid() >> 8)
DEV float bf2f(bf16_t v) { return __uint_as_float(((unsigned)v) << 16); }
typedef __bf16 bf16n2 __attribute__((ext_vector_type(2)));
typedef float f32n2 __attribute__((ext_vector_type(2)));
DEV bf16_t f2bf(float f) { __bf16 b = (__bf16)f; return __builtin_bit_cast(unsigned short, b); }
DEV unsigned pk2(float lo, float hi) { f32n2 v = {lo, hi}; bf16n2 b = __builtin_convertvector(v, bf16n2); return __builtin_bit_cast(unsigned, b); }
DEV float sigmoidf_(float x) { return 1.f / (1.f + __expf(-x)); }
DEV float siluf_(float x) { return x / (1.f + __expf(-x)); }
DEV float geluf_(float x) { float t = 0.7978845608028654f * (x + 0.044715f * x * x * x); return 0.5f * x * (1.f + tanhf(t)); }
DEV float logsigmoidf_(float x) { return fminf(x, 0.f) - log1pf(__expf(-fabsf(x))); }

DEV float wave_sum(float v) {
#pragma unroll
    for (int o = 1; o < 64; o <<= 1) v += __shfl_xor(v, o);
    return v;
}
DEV float block_sum256(float v, float* red) {
    v = wave_sum(v);
    __syncthreads();
    if ((TIDH & 63) == 0) red[TIDH >> 6] = v;
    __syncthreads();
    return red[0] + red[1] + red[2] + red[3];
}

DEV void k_mod(int vb, float* ldsf, const float* c, const float* w_mod, const float* b_mod, float* mod) {
    float (*sc)[DM] = (float (*)[DM])ldsf;
    const int l = vb / 12, n = (vb % 12) * 256 + TIDH;
    __syncthreads();
    for (int i = TIDH; i < BATCH * DM; i += 256) sc[i / DM][i % DM] = siluf_(c[i]);
    __syncthreads();
    float acc[BATCH];
#pragma unroll
    for (int b = 0; b < BATCH; ++b) acc[b] = 0.f;
    const float* W = w_mod + (size_t)l * DM * 3 * DM;
    for (int k = 0; k < DM; ++k) {
        float w = W[(size_t)k * 3 * DM + n];
#pragma unroll
        for (int b = 0; b < BATCH; ++b) acc[b] += sc[b][k] * w;
    }
#pragma unroll
    for (int b = 0; b < BATCH; ++b) mod[((size_t)l * BATCH + b) * 3 * DM + n] = acc[b] + b_mod[l * 3 * DM + n];
}

DEV void k_norm_mod(int vb, float* red, const float* x, const float* gain, const float* mod  , bf16_t* h) {
    const int m = vb, b = m / SEQ, t = TIDH;
    const float4 v = ((const float4*)(x + (size_t)m * DM))[t];
    float ss = v.x * v.x + v.y * v.y + v.z * v.z + v.w * v.w;
    ss = block_sum256(ss, red);
    const float rstd = rsqrtf(ss * (1.f / DM) + EPS);
    const float* shift = mod + (size_t)b * 3 * DM;
    const float* scale = shift + DM;
    float xv[4] = {v.x, v.y, v.z, v.w};
#pragma unroll
    for (int i = 0; i < 4; ++i) {
        int n = t * 4 + i;
        float y = xv[i] * rstd * gain[n] * (1.f + scale[n]) + shift[n];
        h[(size_t)m * DM + n] = f2bf(y);
    }
}

DEV void k_s5(int item, float* ldsf, const bf16_t* u, bf16_t* y, const float* lam_re, const float* lam_im, const float* log_dt,
                                           const float* b_re, const float* b_im, const float* c_re, const float* c_im, const float* dskip) {
    const int tid_ = opaque_tid();
    float (*part)[17] = (float (*)[17])(ldsf + (tid_ >> 6) * 64 * 17);
    const int g = item & 63, b = item >> 6, p = tid_ & 63;
    const double lr = lam_re[g * NP + p], li = lam_im[g * NP + p], dt = exp((double)log_dt[g]);
    const double er = exp(lr * dt);
    const double ard = er * cos(li * dt), aid = er * sin(li * dt);
    const double dr = ard - 1.0, di = aid, den = lr * lr + li * li;
    const double cr = (dr * lr + di * li) / den, ci = (di * lr - dr * li) / den;
    float bbr[16], bbi[16], ccr[16], cci[16];
#pragma unroll
    for (int c = 0; c < 16; ++c) {
        const double br = b_re[(g * NP + p) * GC + c], bi = b_im[(g * NP + p) * GC + c];
        bbr[c] = (float)(cr * br - ci * bi); bbi[c] = (float)(cr * bi + ci * br);
        ccr[c] = c_re[(g * GC + c) * NP + p]; cci[c] = c_im[(g * GC + c) * NP + p];
    }
    const float ar = (float)ard, ai = (float)aid;
    const float dsk = dskip[g * GC + (p & 15)];
    float sr = 0.f, si = 0.f;
    for (int t = 0; t < SEQ; ++t) {
        const bf16_t* up = u + (size_t)(b * SEQ + t) * DM + g * GC;
        const uint4 u0 = *(const uint4*)up, u1 = *(const uint4*)(up + 8);
        float uf[16];
        uf[0] = bf2f(u0.x & 0xffff); uf[1] = bf2f(u0.x >> 16); uf[2] = bf2f(u0.y & 0xffff); uf[3] = bf2f(u0.y >> 16);
        uf[4] = bf2f(u0.z & 0xffff); uf[5] = bf2f(u0.z >> 16); uf[6] = bf2f(u0.w & 0xffff); uf[7] = bf2f(u0.w >> 16);
        uf[8] = bf2f(u1.x & 0xffff); uf[9] = bf2f(u1.x >> 16); uf[10] = bf2f(u1.y & 0xffff); uf[11] = bf2f(u1.y >> 16);
        uf[12] = bf2f(u1.z & 0xffff); uf[13] = bf2f(u1.z >> 16); uf[14] = bf2f(u1.w & 0xffff); uf[15] = bf2f(u1.w >> 16);
        float bur = 0.f, bui = 0.f;
#pragma unroll
        for (int c = 0; c < 16; ++c) { bur += bbr[c] * uf[c]; bui += bbi[c] * uf[c]; }
        const float nr = ar * sr - ai * si + bur, ni = ar * si + ai * sr + bui;
        sr = nr; si = ni;
#pragma unroll
        for (int c = 0; c < 16; ++c) part[p][c] = ccr[c] * sr - cci[c] * si;
        asm volatile("s_waitcnt lgkmcnt(0)" ::: "memory");
        float s = 0.f;
#pragma unroll
        for (int k = 0; k < 16; ++k) s += part[(p >> 4) * 16 + k][p & 15];
        s += __shfl_xor(s, 16); s += __shfl_xor(s, 32);
        if (p < 16) {
            const float yv = s + dsk * bf2f(up[p]);
            y[(size_t)(b * SEQ + t) * DM + g * GC + p] = f2bf(geluf_(yv));
        }
        asm volatile("s_waitcnt lgkmcnt(0)" ::: "memory");
    }
}

DEV void k_ssm_post(int vb, float* red, bf16_t* z, const bf16_t* sg, const float* gain) {
    const int m = vb, t = TIDH;
    float zv[4]; float ss = 0.f;
#pragma unroll
    for (int i = 0; i < 4; ++i) { zv[i] = bf2f(z[(size_t)m * DM + t * 4 + i]); ss += zv[i] * zv[i]; }
    ss = block_sum256(ss, red);
    const float rstd = rsqrtf(ss * (1.f / DM) + EPS);
#pragma unroll
    for (int i = 0; i < 4; ++i) {
        const int n = t * 4 + i;
        z[(size_t)m * DM + n] = f2bf(zv[i] * rstd * gain[n] * siluf_(bf2f(sg[(size_t)m * DM + n])));
    }
}

DEV float conv_xc(const bf16_t* mi, int m, int n, const float* cw, const float* cb) {
    const int t = m % SEQ;
    float acc = cb[n];
#pragma unroll
    for (int j = 0; j < 4; ++j) {
        const int tt = t - 3 + j;
        if (tt >= 0) acc += bf2f(mi[(size_t)(m - 3 + j) * DM + n]) * cw[j * DM + n];
    }
    return siluf_(acc);
}
DEV void k_conv(int vb, const bf16_t* mi, bf16_t* xc, const float* cw, const float* cb) {
    const size_t idx = (size_t)vb * 256 + TIDH;
    const int m = (int)(idx / DM), n = (int)(idx % DM);
    xc[idx] = f2bf(conv_xc(mi, m, n, cw, cb));
}

DEV void k_gates(int vb, float* ldsf, const bf16_t* q, const bf16_t* k, const bf16_t* v, const float* wg  , const float* bi, const float* bfg,
                                               float* ipre, float* logf) {
    float (*red)[8] = (float (*)[8])ldsf;
    const int m = vb, t = TIDH;
    __syncthreads();
    float acc[8];
#pragma unroll
    for (int j = 0; j < 8; ++j) acc[j] = 0.f;
    for (int e = t; e < 3 * DM; e += 256) {
        const bf16_t* src = (e < DM) ? q : (e < 2 * DM ? k : v);
        const float xv = bf2f(src[(size_t)m * DM + (e & (DM - 1))]);
#pragma unroll
        for (int j = 0; j < 8; ++j) acc[j] += xv * wg[e * 8 + j];
    }
#pragma unroll
    for (int j = 0; j < 8; ++j) acc[j] = wave_sum(acc[j]);
    if ((t & 63) == 0) {
#pragma unroll
        for (int j = 0; j < 8; ++j) red[t >> 6][j] = acc[j];
    }
    __syncthreads();
    if (t < 8) {
        const float s = red[0][t] + red[1][t] + red[2][t] + red[3][t];
        if (t < 4) ipre[(size_t)m * 4 + t] = s + bi[t];
        else logf[(size_t)m * 4 + (t - 4)] = logsigmoidf_(s + bfg[t - 4]);
    }
}

DEV void k_mlstm(int vb, float* ldsf, const bf16_t* q, const bf16_t* k, const bf16_t* v, const float* ipre, const float* logf, bf16_t* hc) {
    float (*Cs)[257] = (float (*)[257])ldsf;
    float (*St)[65] = (float (*)[65])(ldsf + 32 * 257);
    float* nvec = ldsf + 32 * 257 + 64 * 65;
    float* bcum = nvec + 256; float* ig = bcum + 64; float* mt = ig + 64; float* winter = mt + 64; float* ws_ = winter + 64; float* hden = ws_ + 64;
    float* sc = hden + 64;
    const int tid = TIDH;
    const int vs = vb & 7, h = (vb >> 3) & 3, b = vb >> 5;
    __syncthreads();
    for (int i = tid; i < 32 * 257; i += 256) (&Cs[0][0])[i] = 0.f;
    nvec[tid] = 0.f;
    if (tid == 0) sc[0] = 0.f;
    __syncthreads();
    const size_t base = (size_t)b * SEQ * DM + h * DH;
    for (int j = 0; j < SEQ / CHUNK; ++j) {
        const size_t cb = base + (size_t)j * CHUNK * DM;
        const int m0 = b * SEQ + j * CHUNK;
        if (tid < 64) {
            ig[tid] = ipre[(size_t)(m0 + tid) * 4 + h];
            ws_[tid] = logf[(size_t)(m0 + tid) * 4 + h];
        }
        __syncthreads();
        if (tid < 64) { float s = 0.f; for (int i = 0; i <= tid; ++i) s += ws_[i]; bcum[tid] = s; }
        __syncthreads();
        const float m_prev = sc[0];
        if (tid < 64) {
            const float m_inter = bcum[tid] + m_prev;
            float mx = -INFINITY;
            for (int s = 0; s <= tid; ++s) mx = fmaxf(mx, bcum[tid] - bcum[s] + ig[s]);
            const float m = fmaxf(m_inter, mx);
            mt[tid] = m; winter[tid] = __expf(m_inter - m);
        }
        __syncthreads();
        for (int idx = tid; idx < 4096; idx += 256) {
            const int t = idx >> 6, s = idx & 63;
            float r = 0.f;
            if (s <= t) {
                const bf16_t* qp = q + cb + (size_t)t * DM; const bf16_t* kp = k + cb + (size_t)s * DM;
                float dot = 0.f;
                for (int d = 0; d < DH; d += 8) {
                    const uint4 qa = *(const uint4*)(qp + d), ka = *(const uint4*)(kp + d);
                    dot += bf2f(qa.x & 0xffff) * bf2f(ka.x & 0xffff) + bf2f(qa.x >> 16) * bf2f(ka.x >> 16);
                    dot += bf2f(qa.y & 0xffff) * bf2f(ka.y & 0xffff) + bf2f(qa.y >> 16) * bf2f(ka.y >> 16);
                    dot += bf2f(qa.z & 0xffff) * bf2f(ka.z & 0xffff) + bf2f(qa.z >> 16) * bf2f(ka.z >> 16);
                    dot += bf2f(qa.w & 0xffff) * bf2f(ka.w & 0xffff) + bf2f(qa.w >> 16) * bf2f(ka.w >> 16);
                }
                r = dot * __expf(bcum[t] - bcum[s] + ig[s] - mt[t]);
            }
            St[t][s] = r;
        }
        __syncthreads();
        if (tid < 64) {
            const bf16_t* qp = q + cb + (size_t)tid * DM;
            float dn = 0.f;
            for (int d = 0; d < DH; ++d) dn += nvec[d] * bf2f(qp[d]);
            float sm = 0.f;
            for (int s = 0; s < 64; ++s) sm += St[tid][s];
            const float den = winter[tid] * dn + sm;
            hden[tid] = fmaxf(fabsf(den), __expf(-mt[tid]));
        }
        __syncthreads();
        for (int idx = tid; idx < 2048; idx += 256) {
            const int t = idx >> 5, vv = idx & 31;
            const bf16_t* qp = q + cb + (size_t)t * DM;
            float a = 0.f;
            for (int d = 0; d < DH; ++d) a += Cs[vv][d] * bf2f(qp[d]);
            float s2 = 0.f;
            for (int s = 0; s < 64; ++s) s2 += St[t][s] * bf2f(v[cb + (size_t)s * DM + vs * 32 + vv]);
            const float num = winter[t] * a + s2;
            hc[cb + (size_t)t * DM + vs * 32 + vv] = f2bf(num / hden[t]);
        }
        __syncthreads();
        const float b_tot = bcum[63];
        if (tid < 64) ws_[tid] = b_tot - bcum[tid] + ig[tid];
        __syncthreads();
        if (tid == 0) {
            float mx = b_tot + m_prev;
            for (int s = 0; s < 64; ++s) mx = fmaxf(mx, ws_[s]);
            sc[1] = __expf(b_tot + m_prev - mx); sc[0] = mx;
        }
        __syncthreads();
        const float m_next = sc[0], decay = sc[1];
        float myw = 0.f;
        if (tid < 64) myw = __expf(ws_[tid] - m_next);
        __syncthreads();
        if (tid < 64) ws_[tid] = myw;
        __syncthreads();
        for (int idx = tid; idx < 32 * 256; idx += 256) {
            const int vv = idx >> 8, d = idx & 255;
            float a = 0.f;
            for (int s = 0; s < 64; ++s) a += ws_[s] * bf2f(v[cb + (size_t)s * DM + vs * 32 + vv]) * bf2f(k[cb + (size_t)s * DM + d]);
            Cs[vv][d] = decay * Cs[vv][d] + a;
        }
        {
            float a = 0.f;
            for (int s = 0; s < 64; ++s) a += ws_[s] * bf2f(k[cb + (size_t)s * DM + tid]);
            nvec[tid] = decay * nvec[tid] + a;
        }
        __syncthreads();
    }
}

DEV void k_mlstm_post(int vb, bf16_t* hc, const bf16_t* mo, const bf16_t* mg, const bf16_t* mi, const float* cw, const float* cb,
                                                    const float* ngain, const float* skip) {
    const int m = vb, t = TIDH;
    float hv[4]; float s = 0.f;
#pragma unroll
    for (int i = 0; i < 4; ++i) {
        const size_t o = (size_t)m * DM + t * 4 + i;
        hv[i] = bf2f(hc[o]) * sigmoidf_(bf2f(mo[o])); s += hv[i];
    }
    const float mu = wave_sum(s) * (1.f / DH);
    float s2 = 0.f;
#pragma unroll
    for (int i = 0; i < 4; ++i) { hv[i] -= mu; s2 += hv[i] * hv[i]; }
    const float rstd = rsqrtf(wave_sum(s2) * (1.f / DH) + EPS);
#pragma unroll
    for (int i = 0; i < 4; ++i) {
        const int n = t * 4 + i; const size_t o = (size_t)m * DM + n;
        const float xc = conv_xc(mi, m, n, cw, cb);
        const float hn = hv[i] * rstd * ngain[n] + skip[n] * xc;
        hc[o] = f2bf(hn * siluf_(bf2f(mg[o])));
    }
}

DEV void k_final(int vb, float* red, float* x, const float* gain) {
    const int m = vb, t = TIDH;
    float4 v = ((float4*)(x + (size_t)m * DM))[t];
    float ss = v.x * v.x + v.y * v.y + v.z * v.z + v.w * v.w;
    ss = block_sum256(ss, red);
    const float rstd = rsqrtf(ss * (1.f / DM) + EPS);
    const float4 g = ((const float4*)gain)[t];
    v.x *= rstd * g.x; v.y *= rstd * g.y; v.z *= rstd * g.z; v.w *= rstd * g.w;
    ((float4*)(x + (size_t)m * DM))[t] = v;
}


#define LAS __attribute__((address_space(3)))
typedef short bf16x8 __attribute__((ext_vector_type(8)));
typedef float f32x4 __attribute__((ext_vector_type(4)));
#define WAIT_V(n) asm volatile("s_waitcnt vmcnt(" #n ")" ::: "memory")
#define WAIT_L(n) asm volatile("s_waitcnt lgkmcnt(" #n ")" ::: "memory")
#define SCHED() __builtin_amdgcn_sched_barrier(0)

DEV int lds_byte(int r, int c) { int st = (r >> 4) * 2 + (c >> 5), ob = (r & 15) * 64 + (c & 31) * 2; return st * 1024 + (ob ^ (((ob >> 9) & 1) << 5)); }
DEV void stage_rc(int b, int& R, int& C) { int st = b >> 10, sb = b & 1023, swz = sb ^ (((sb >> 9) & 1) << 5); R = (st >> 1) * 16 + swz / 64; C = (st & 1) * 32 + (swz % 64) / 2; }
template <class T> DEV T* sel3(int w, T* p0, T* p1, T* p2) { return p0 + ((w >= 1) ? (p1 - p0) : 0) + ((w >= 2) ? (p2 - p1) : 0); }
DEV uint2 pack4(f32x4 v) { uint2 r; r.x = pk2(v[0], v[1]); r.y = pk2(v[2], v[3]); return r; }

struct GemmCtx { int wid, lane, wr, wc, fr, fq; int sR[4], sC[4]; };
DEV GemmCtx gemm_ctx() {
    GemmCtx c; const int tid = opaque_tid();
    c.wid = __builtin_amdgcn_readfirstlane(tid >> 6); c.lane = tid & 63; c.wr = c.wid >> 2; c.wc = c.wid & 3; c.fr = c.lane & 15; c.fq = c.lane >> 4;
#pragma unroll
    for (int i = 0; i < 4; ++i) stage_rc(c.wid * 1024 + i * 8192 + c.lane * 16, c.sR[i], c.sC[i]);
    return c;
}
DEV void gemm_mainloop(LAS char* shm, const GemmCtx& c, const bf16_t* A1row, const bf16_t* A2row, int ktsplit, int lda, const bf16_t* Bb, int ldb, int nt, f32x4 (&acc)[8][4]) {
    constexpr int TILE_B = 256 * 64 * 2, STAGE_B = 2 * TILE_B;
    const int wid = c.wid, wr = c.wr, wc = c.wc, fr = c.fr, fq = c.fq;
    unsigned voA[4], voB[4];
#pragma unroll
    for (int i = 0; i < 4; ++i) { voA[i] = (unsigned)(c.sR[i] * lda + c.sC[i]) * 2u; voB[i] = (unsigned)(c.sR[i] * ldb + c.sC[i]) * 2u; asm volatile("" : "+v"(voA[i]), "+v"(voB[i])); }
#define GLDS_STAGE(buf, kt) do { const char* Ak_ = (const char*)(((kt) < ktsplit) ? (A1row + (kt) * 64) : (A2row + ((kt) - ktsplit) * 64)); const char* Bk_ = (const char*)(Bb + (kt) * 64); \
        _Pragma("unroll") for (int i = 0; i < 4; ++i) { \
            __builtin_amdgcn_global_load_lds((const unsigned*)(Ak_ + voA[i]), (LAS unsigned*)(shm + (buf) * STAGE_B + wid * 1024 + i * 8192), 16, 0, 0); \
            __builtin_amdgcn_global_load_lds((const unsigned*)(Bk_ + voB[i]), (LAS unsigned*)(shm + (buf) * STAGE_B + TILE_B + wid * 1024 + i * 8192), 16, 0, 0); } } while (0)
#pragma unroll
    for (int m = 0; m < 8; ++m)
#pragma unroll
        for (int n = 0; n < 4; ++n) acc[m][n] = (f32x4){0.f, 0.f, 0.f, 0.f};
    GLDS_STAGE(0, 0); WAIT_V(0); __syncthreads();
#pragma nounroll
    for (int kt = 0; kt < nt; ++kt) {
        const int cur = kt & 1;
        if (kt + 1 < nt) GLDS_STAGE(cur ^ 1, kt + 1);
#pragma unroll
        for (int ks = 0; ks < 2; ++ks) {
            bf16x8 At[8], Bf[4];
#pragma unroll
            for (int m = 0; m < 8; ++m) At[m] = *(const LAS bf16x8*)(shm + cur * STAGE_B + lds_byte(wr * 128 + m * 16 + fr, ks * 32 + fq * 8));
#pragma unroll
            for (int n = 0; n < 4; ++n) Bf[n] = *(const LAS bf16x8*)(shm + cur * STAGE_B + TILE_B + lds_byte(wc * 64 + n * 16 + fr, ks * 32 + fq * 8));
#pragma unroll
            for (int m = 0; m < 8; ++m)
#pragma unroll
                for (int n = 0; n < 4; ++n) acc[m][n] = __builtin_amdgcn_mfma_f32_16x16x32_bf16(Bf[n], At[m], acc[m][n], 0, 0, 0);
            SCHED();
        }
        WAIT_V(0); __syncthreads();
    }
#undef GLDS_STAGE
}
DEV void tile_map(int t, int nN, int& pm, int& pn) {
    const int base = t & ~255, loc = t & 255;
    const int w = base + (loc & 7) * 32 + (loc >> 3);
    const int nig = 8 * nN, gid = w / nig;
    pm = gid * 8 + (w % nig) % 8; pn = (w % nig) / 8;
}
template <class Prob>
DEV void gemm_phase(LAS char* shm, const Prob& pb) {
    const GemmCtx c = gemm_ctx();
    const int nN = pb.nN, ntiles = 64 * nN;
    for (int t = blockIdx.x; t < ntiles; t += gridDim.x) {
        int pm, pn; tile_map(t, nN, pm, pn);
        const int brow = pm * 256, bcol = pn * 256;
        f32x4 acc[8][4];
        gemm_mainloop(shm, c, pb.a1(pn) + (long)brow * Prob::lda, pb.a2(pn) + (long)brow * Prob::lda, Prob::ktsplit, Prob::lda, pb.bptr(pn), Prob::ldb, Prob::K / 64, acc);
        pb.epi_begin(shm, c, pn, brow);
#pragma unroll
        for (int m = 0; m < 8; ++m)
#pragma unroll
            for (int n = 0; n < 4; ++n) pb.epi(pn, brow + c.wr * 128 + m * 16 + c.fr, bcol + c.wc * 64 + n * 16 + c.fq * 4, acc[m][n]);
        pb.epi_end(c, pn, brow, acc);
    }
}

struct ProbG1 {
    static constexpr int K = 1024, lda = 1024, ldb = 1024, ktsplit = 1 << 20;
    const bf16_t* H; const bf16_t* Wt; bf16_t* U; bf16_t* MI; int nN;
    DEV const bf16_t* a1(int pn) const { return H; }
    DEV const bf16_t* a2(int pn) const { return H; }
    DEV const bf16_t* bptr(int pn) const { return Wt + (long)((pn < 4) ? pn * 256 : 2048 + (pn - 4) * 256) * 1024; }
    DEV void epi_begin(LAS char*, const GemmCtx&, int, int) const {}
    DEV void epi(int pn, int row, int col, f32x4 v) const { bf16_t* C = (pn < 4) ? U : MI; *(uint2*)(C + (size_t)row * DM + (col & 1023)) = pack4(v); }
    DEV void epi_end(const GemmCtx&, int, int, f32x4 (&)[8][4]) const {}
};
struct ProbGlu {
    static constexpr int K = 1024, lda = 1024, ldb = 1024, ktsplit = 1 << 20;
    const bf16_t* Y; const bf16_t* Wt; bf16_t* Z; const float* bias; float* rowss; int nN;
    DEV const bf16_t* a1(int pn) const { return Y; }
    DEV const bf16_t* a2(int pn) const { return Y; }
    DEV const bf16_t* bptr(int pn) const { return Wt + (long)pn * 256 * 1024; }
    DEV void epi_begin(LAS char*, const GemmCtx&, int, int) const {}
    DEV void epi(int pn, int row, int col, f32x4 v) const {}
    DEV void epi_end(const GemmCtx& c0, int pn, int brow, f32x4 (&acc)[8][4]) const {
        struct { int fr, fq, wr, wc; } c = {c0.fr, c0.fq, c0.wr, c0.wc};
        asm volatile("" : "+v"(c.fr), "+v"(c.fq));
#pragma unroll
        for (int m = 0; m < 8; ++m) {
            SCHED();
            const int row = brow + c.wr * 128 + m * 16 + c.fr;
            float ss = 0.f;
#pragma unroll
            for (int n = 0; n < 4; ++n) {
                const int col = pn * 256 + c.wc * 64 + n * 16 + c.fq * 4;
                const uint2 yv = *(const uint2*)(Y + (size_t)row * DM + col);
                const float4 b = *(const float4*)(bias + col);
                f32x4 o;
                o[0] = bf2f(yv.x & 0xffff) * sigmoidf_(acc[m][n][0] + b.x); o[1] = bf2f(yv.x >> 16) * sigmoidf_(acc[m][n][1] + b.y);
                o[2] = bf2f(yv.y & 0xffff) * sigmoidf_(acc[m][n][2] + b.z); o[3] = bf2f(yv.y >> 16) * sigmoidf_(acc[m][n][3] + b.w);
                const uint2 pk = pack4(o);
                *(uint2*)(Z + (size_t)row * DM + col) = pk;
                const float r0 = bf2f(pk.x & 0xffff), r1 = bf2f(pk.x >> 16), r2 = bf2f(pk.y & 0xffff), r3 = bf2f(pk.y >> 16);
                ss += r0 * r0 + r1 * r1 + r2 * r2 + r3 * r3;
            }
            ss += __shfl_xor(ss, 16); ss += __shfl_xor(ss, 32);
            if (c.fq == 0) rowss[(size_t)(pn * 4 + c.wc) * MTOK + row] = ss;
        }
    }
};
struct ProbQkv {
    static constexpr int K = 256, lda = 1024, ldb = 256, ktsplit = 1 << 20;
    const bf16_t* XC; const bf16_t* MI; const bf16_t* Wt; bf16_t* Q; bf16_t* Kk; bf16_t* V; int nN;
    DEV const bf16_t* a1(int pn) const { return ((pn >> 2) == 2 ? MI : XC) + (pn & 3) * 256; }
    DEV const bf16_t* a2(int pn) const { return a1(pn); }
    DEV const bf16_t* bptr(int pn) const { return Wt + (long)pn * 256 * 256; }
    DEV void epi_begin(LAS char*, const GemmCtx&, int, int) const {}
    DEV void epi(int pn, int row, int col, f32x4 v) const {
        const int which = pn >> 2; bf16_t* C = sel3(which, Q, Kk, V);
        if (which == 1) { v[0] *= 0.0625f; v[1] *= 0.0625f; v[2] *= 0.0625f; v[3] *= 0.0625f; }
        *(uint2*)(C + (size_t)row * DM + (col & 1023)) = pack4(v);
    }
    DEV void epi_end(const GemmCtx&, int, int, f32x4 (&)[8][4]) const {}
};
struct ProbOut {
    static constexpr int K = 2048, lda = 1024, ldb = 2048, ktsplit = 16;
    const bf16_t* A1; const bf16_t* A2; const bf16_t* Wt; const float* xin; float* xout; const float* gate; int nN;
    DEV const bf16_t* a1(int pn) const { return A1; }
    DEV const bf16_t* a2(int pn) const { return A2; }
    DEV const bf16_t* bptr(int pn) const { return Wt + (long)pn * 256 * 2048; }
    DEV void epi_begin(LAS char*, const GemmCtx&, int, int) const {}
    DEV void epi(int pn, int row, int col, f32x4 v) const {
        const int b = row / SEQ;
        const float4 xi = *(const float4*)(xin + (size_t)row * DM + col);
        const float4 g = *(const float4*)(gate + (size_t)b * 3 * DM + col);
        float4 o; o.x = xi.x + g.x * v[0]; o.y = xi.y + g.y * v[1]; o.z = xi.z + g.z * v[2]; o.w = xi.w + g.w * v[3];
        *(float4*)(xout + (size_t)row * DM + col) = o;
    }
    DEV void epi_end(const GemmCtx&, int, int, f32x4 (&)[8][4]) const {}
};

struct G2Args {
    const bf16_t* H; const bf16_t* Wt;
    bf16_t* Z; const float* rowss; const float* og;
    bf16_t* HC; const bf16_t* XC; const float* ngain; const float* skip;
};
DEV void gemm2_phase(LAS char* shm, const G2Args& g) {
    const GemmCtx c = gemm_ctx();
    int efr, efq;
    LAS float* rst = (LAS float*)(shm + 131072);
    LAS float* red = (LAS float*)(shm + 131072 + 1024);
    for (int u = blockIdx.x; u < 512; u += gridDim.x) {
        f32x4 acc[8][4];
        if (u < 256) {
            int pm, pn; tile_map(u, 4, pm, pn);
            const int brow = pm * 256, bcol = pn * 256;
            gemm_mainloop(shm, c, g.H + (long)brow * DM, g.H, 1 << 20, DM, g.Wt + (long)(1024 + bcol) * DM, DM, 16, acc);
            efr = c.fr; efq = c.fq; asm volatile("" : "+v"(efr), "+v"(efq));
            { const int tid = c.wid * 64 + c.lane;
              if (tid < 256) { float s_ = 0.f;
#pragma unroll
                  for (int p_ = 0; p_ < 16; ++p_) s_ += g.rowss[(size_t)p_ * MTOK + brow + tid];
                  rst[tid] = rsqrtf(s_ * (1.f / DM) + EPS); } }
            __syncthreads();
#pragma unroll
            for (int m = 0; m < 8; ++m) {
                SCHED();
                const int rl = c.wr * 128 + m * 16 + efr, row = brow + rl;
                const float rs = rst[rl];
#pragma unroll
                for (int n = 0; n < 4; ++n) {
                    const int col = bcol + c.wc * 64 + n * 16 + efq * 4;
                    const uint2 zv = *(const uint2*)(g.Z + (size_t)row * DM + col);
                    const float4 gn = *(const float4*)(g.og + col);
                    f32x4 o;
                    o[0] = bf2f(zv.x & 0xffff) * rs * gn.x * siluf_(acc[m][n][0]); o[1] = bf2f(zv.x >> 16) * rs * gn.y * siluf_(acc[m][n][1]);
                    o[2] = bf2f(zv.y & 0xffff) * rs * gn.z * siluf_(acc[m][n][2]); o[3] = bf2f(zv.y >> 16) * rs * gn.w * siluf_(acc[m][n][3]);
                    *(uint2*)(g.Z + (size_t)row * DM + col) = pack4(o);
                }
            }
            __syncthreads();
        } else {
            int pm, hd; tile_map(u - 256, 4, pm, hd);
            const int brow = pm * 256, bcol = hd * 256;
            gemm_mainloop(shm, c, g.H + (long)brow * DM, g.H, 1 << 20, DM, g.Wt + (long)(3072 + bcol) * DM, DM, 16, acc);
            efr = c.fr; efq = c.fq; asm volatile("" : "+v"(efr), "+v"(efq));
        #pragma unroll
            for (int m = 0; m < 8; ++m) {
                SCHED();
                const int row = brow + c.wr * 128 + m * 16 + efr;
                float s_ = 0.f;
#pragma unroll
                for (int n = 0; n < 4; ++n) {
                    const int col = bcol + c.wc * 64 + n * 16 + efq * 4;
                    const uint2 hv = *(const uint2*)(g.HC + (size_t)row * DM + col);
                    acc[m][n][0] = bf2f(hv.x & 0xffff) * sigmoidf_(acc[m][n][0]); acc[m][n][1] = bf2f(hv.x >> 16) * sigmoidf_(acc[m][n][1]);
                    acc[m][n][2] = bf2f(hv.y & 0xffff) * sigmoidf_(acc[m][n][2]); acc[m][n][3] = bf2f(hv.y >> 16) * sigmoidf_(acc[m][n][3]);
                    s_ += (acc[m][n][0] + acc[m][n][1]) + (acc[m][n][2] + acc[m][n][3]);
                }
                s_ += __shfl_xor(s_, 16); s_ += __shfl_xor(s_, 32);
                if (efq == 0) red[c.wid * 128 + m * 16 + efr] = s_;
            }
            __syncthreads();
#pragma unroll
            for (int m = 0; m < 8; ++m) {
                SCHED();
                float tot = 0.f;
#pragma unroll
                for (int w2 = 0; w2 < 4; ++w2) tot += red[(c.wr * 4 + w2) * 128 + m * 16 + efr];
                const float mu = tot * (1.f / DH);
                float s_ = 0.f;
#pragma unroll
                for (int n = 0; n < 4; ++n)
#pragma unroll
                    for (int j = 0; j < 4; ++j) { acc[m][n][j] -= mu; s_ += acc[m][n][j] * acc[m][n][j]; }
                s_ += __shfl_xor(s_, 16); s_ += __shfl_xor(s_, 32);
                if (efq == 0) red[1024 + c.wid * 128 + m * 16 + efr] = s_;
            }
            __syncthreads();
#pragma unroll
            for (int m = 0; m < 8; ++m) {
                SCHED();
                const int row = brow + c.wr * 128 + m * 16 + efr;
                float tot = 0.f;
#pragma unroll
                for (int w2 = 0; w2 < 4; ++w2) tot += red[1024 + (c.wr * 4 + w2) * 128 + m * 16 + efr];
                const float rs = rsqrtf(tot * (1.f / DH) + EPS);
#pragma unroll
                for (int n = 0; n < 4; ++n) {
                    const int col = bcol + c.wc * 64 + n * 16 + efq * 4;
                    const uint2 xv = *(const uint2*)(g.XC + (size_t)row * DM + col);
                    const float4 gn = *(const float4*)(g.ngain + col), sk = *(const float4*)(g.skip + col);
                    f32x4 o;
                    o[0] = acc[m][n][0] * rs * gn.x + sk.x * bf2f(xv.x & 0xffff); o[1] = acc[m][n][1] * rs * gn.y + sk.y * bf2f(xv.x >> 16);
                    o[2] = acc[m][n][2] * rs * gn.z + sk.z * bf2f(xv.y & 0xffff); o[3] = acc[m][n][3] * rs * gn.w + sk.w * bf2f(xv.y >> 16);
                    *(uint2*)(g.HC + (size_t)row * DM + col) = pack4(o);
                }
            }
            gemm_mainloop(shm, c, g.H + (long)brow * DM, g.H, 1 << 20, DM, g.Wt + (long)(4096 + bcol) * DM, DM, 16, acc);
            efr = c.fr; efq = c.fq; asm volatile("" : "+v"(efr), "+v"(efq));
#pragma unroll
            for (int m = 0; m < 8; ++m) {
                SCHED();
                const int row = brow + c.wr * 128 + m * 16 + efr;
#pragma unroll
                for (int n = 0; n < 4; ++n) {
                    const int col = bcol + c.wc * 64 + n * 16 + efq * 4;
                    const uint2 hv = *(const uint2*)(g.HC + (size_t)row * DM + col);
                    f32x4 o;
                    o[0] = bf2f(hv.x & 0xffff) * siluf_(acc[m][n][0]); o[1] = bf2f(hv.x >> 16) * siluf_(acc[m][n][1]);
                    o[2] = bf2f(hv.y & 0xffff) * siluf_(acc[m][n][2]); o[3] = bf2f(hv.y >> 16) * siluf_(acc[m][n][3]);
                    *(uint2*)(g.HC + (size_t)row * DM + col) = pack4(o);
                }
            }
        }
    }
}

DEV void transpose_item(const float* W, int ldw, int ncols, bf16_t* WT, int ldwt, LAS float* scr, int item, int lane) {
    const int nblk = ncols / 32, kb = item / nblk, nb = item % nblk, k0 = 64 * kb, n0 = 32 * nb;
#pragma unroll 8
    for (int i = 0; i < 32; ++i) { const int kk = 2 * i + (lane >> 5); scr[kk * 33 + (lane & 31)] = W[(size_t)(k0 + kk) * ldw + n0 + (lane & 31)]; }
    asm volatile("s_waitcnt lgkmcnt(0)" ::: "memory");
    const int c = lane & 7;
#pragma unroll
    for (int j = 0; j < 4; ++j) {
        const int n = (lane >> 3) + 8 * j; const LAS float* s = scr + (8 * c) * 33 + n;
        uint4 o;
        o.x = pk2(s[0 * 33], s[1 * 33]); o.y = pk2(s[2 * 33], s[3 * 33]);
        o.z = pk2(s[4 * 33], s[5 * 33]); o.w = pk2(s[6 * 33], s[7 * 33]);
        *(uint4*)(WT + (size_t)(n0 + n) * ldwt + k0 + 8 * c) = o;
    }
    asm volatile("s_waitcnt lgkmcnt(0)" ::: "memory");
}

typedef short s16x4 __attribute__((ext_vector_type(4)));
typedef unsigned u32x4 __attribute__((ext_vector_type(4)));
typedef unsigned u32x2 __attribute__((ext_vector_type(2)));
typedef float f32x2 __attribute__((ext_vector_type(2)));
DEV float wave_scan_add(float v, int lane) {
#pragma unroll
    for (int o = 1; o < 64; o <<= 1) { const float u = __shfl_up(v, o); if (lane >= o) v += u; }
    return v;
}
DEV float wave_scan_max(float v, int lane) {
#pragma unroll
    for (int o = 1; o < 64; o <<= 1) { const float u = __shfl_up(v, o); if (lane >= o) v = fmaxf(v, u); }
    return v;
}

DEV void mlstm_phase(LAS char* shm, const bf16_t* q, const bf16_t* k, const bf16_t* v, const float* gpart, const float* b_ig, const float* b_fg, bf16_t* hc) {
    const int tid = opaque_tid(), wid = __builtin_amdgcn_readfirstlane(tid >> 6), lane = tid & 63, fr = lane & 15, fq = lane >> 4;
    constexpr int QS = 0, KS = 33792, VT = 67584, VWT = 74496, CB = 81408, PART = 106752, TB = 120064, TA = 128256, TP = 136448, TC = 144640, RS = 528, VRS = 144, PRS = 52;
    LAS float* part = (LAS float*)(shm + PART);
    LAS float* tb = (LAS float*)(shm + TB); LAS float* ta = (LAS float*)(shm + TA); LAS float* tp = (LAS float*)(shm + TP); LAS float* tc = (LAS float*)(shm + TC);
    for (int item = blockIdx.x; item < BATCH * NH * 8; item += gridDim.x) {
        const int vs = (item >> 3) & 7, bh = (item & 7) + 8 * (item >> 6), h = bh & 3, b = bh >> 2;
        __syncthreads();
        for (int i = tid; i < (CB + 25344 - VT) / 4; i += 512) ((LAS unsigned*)(shm + VT))[i] = 0u;
        for (int j = wid; j < SEQ / CHUNK; j += 8) {
            const int m = b * SEQ + j * CHUNK + lane;
            const float* gp = gpart + (size_t)m * 8;
            const float ig = gp[h] + gp[(size_t)MTOK * 8 + h] + b_ig[h];
            const float lf = logsigmoidf_(gp[4 + h] + gp[(size_t)MTOK * 8 + 4 + h] + b_fg[h]);
            const float bc = wave_scan_add(lf, lane);
            const float a_ = ig - bc;
            const float pm = wave_scan_max(a_, lane);
            tb[j * 64 + lane] = bc; ta[j * 64 + lane] = a_; tp[j * 64 + lane] = pm;
            if (lane == 63) { tc[2 * j] = bc; tc[2 * j + 1] = pm; }
        }
        __syncthreads();
        if (tid < 64) *(LAS bf16_t*)(shm + VT + 32 * VRS + tid * 2) = (bf16_t)0x3F80;
        f32x4 cacc[2][3];
#pragma unroll
        for (int i = 0; i < 2; ++i)
#pragma unroll
            for (int vt = 0; vt < 3; ++vt) cacc[i][vt] = (f32x4){0.f, 0.f, 0.f, 0.f};
        float m_prev = 0.f;
        const size_t cb0 = ((size_t)(b * SEQ)) * DM + h * DH;
        uint4 qv[4], kv[4], vv = make_uint4(0, 0, 0, 0);
#pragma unroll
        for (int i = 0; i < 4; ++i) {
            const int idx = tid + 512 * i, row = idx >> 5, c16 = idx & 31;
            qv[i] = *(const uint4*)(q + cb0 + (size_t)row * DM + c16 * 8);
            kv[i] = *(const uint4*)(k + cb0 + (size_t)row * DM + c16 * 8);
        }
        if (tid < 256) vv = *(const uint4*)(v + cb0 + (size_t)(tid >> 2) * DM + vs * 32 + (tid & 3) * 8);
#pragma nounroll
        for (int j = 0; j < SEQ / CHUNK; ++j) {
            const size_t cb = cb0 + (size_t)j * CHUNK * DM;
            const float btot = tc[2 * j], amax = tc[2 * j + 1];
            const float mxc = fmaxf(m_prev, amax);
#pragma unroll
            for (int i = 0; i < 4; ++i) {
                const int idx = tid + 512 * i, row = idx >> 5, c16 = idx & 31;
                *(LAS u32x4*)(shm + QS + row * RS + c16 * 16) = (u32x4){qv[i].x, qv[i].y, qv[i].z, qv[i].w};
                *(LAS u32x4*)(shm + KS + row * RS + c16 * 16) = (u32x4){kv[i].x, kv[i].y, kv[i].z, kv[i].w};
            }
            if (tid < 256) {
                const int s_ = tid >> 2, v0 = (tid & 3) * 8;
                const float ws = __expf(ta[j * 64 + s_] - mxc);
                const unsigned w_[4] = {vv.x, vv.y, vv.z, vv.w};
#pragma unroll
                for (int e = 0; e < 8; ++e) {
                    const bf16_t raw = (bf16_t)((w_[e >> 1] >> ((e & 1) * 16)) & 0xffff);
                    *(LAS bf16_t*)(shm + VT + (v0 + e) * VRS + s_ * 2) = raw;
                    *(LAS bf16_t*)(shm + VWT + (v0 + e) * VRS + s_ * 2) = f2bf(ws * bf2f(raw));
                }
            } else if (tid < 320) {
                *(LAS bf16_t*)(shm + VWT + 32 * VRS + (tid - 256) * 2) = f2bf(__expf(ta[j * 64 + tid - 256] - mxc));
            }
            if (j + 1 < SEQ / CHUNK) {
                const size_t cn = cb + (size_t)CHUNK * DM;
#pragma unroll
                for (int i = 0; i < 4; ++i) {
                    const int idx = tid + 512 * i, row = idx >> 5, c16 = idx & 31;
                    qv[i] = *(const uint4*)(q + cn + (size_t)row * DM + c16 * 8);
                    kv[i] = *(const uint4*)(k + cn + (size_t)row * DM + c16 * 8);
                }
                if (tid < 256) vv = *(const uint4*)(v + cn + (size_t)(tid >> 2) * DM + vs * 32 + (tid & 3) * 8);
            }
            __syncthreads();
            f32x4 nacc[3];
#pragma unroll
            for (int vt = 0; vt < 3; ++vt) nacc[vt] = (f32x4){0.f, 0.f, 0.f, 0.f};
            const int tt = wid & 3;
            if (wid < 4) {
                f32x4 sacc[4];
#pragma unroll
                for (int jj = 0; jj < 4; ++jj) sacc[jj] = (f32x4){0.f, 0.f, 0.f, 0.f};
#pragma unroll
                for (int ks = 0; ks < 8; ++ks) {
                    const bf16x8 qf = *(const LAS bf16x8*)(shm + QS + (16 * tt + fr) * RS + (32 * ks + 8 * fq) * 2);
#pragma unroll
                    for (int jj = 0; jj < 4; ++jj) if (jj <= tt) {
                        const bf16x8 kf = *(const LAS bf16x8*)(shm + KS + (16 * jj + fr) * RS + (32 * ks + 8 * fq) * 2);
                        sacc[jj] = __builtin_amdgcn_mfma_f32_16x16x32_bf16(kf, qf, sacc[jj], 0, 0, 0);
                    }
                }
                const int t = 16 * tt + fr;
                const float btm = -fmaxf(m_prev, tp[j * 64 + t]);
#pragma unroll
                for (int jj = 0; jj < 4; ++jj) {
                    const f32x4 a4 = *(const LAS f32x4*)(ta + j * 64 + 16 * jj + 4 * fq);
#pragma unroll
                    for (int r = 0; r < 4; ++r) {
                        const int s_ = 16 * jj + 4 * fq + r;
                        sacc[jj][r] = (s_ <= t) ? sacc[jj][r] * __expf(btm + a4[r]) : 0.f;
                    }
                }
#pragma unroll
                for (int kk = 0; kk < 2; ++kk) if (2 * kk <= tt) {
                    bf16x8 af;
                    { const unsigned p0 = pk2(sacc[2 * kk][0], sacc[2 * kk][1]), p1 = pk2(sacc[2 * kk][2], sacc[2 * kk][3]);
                      const unsigned p2 = pk2(sacc[2 * kk + 1][0], sacc[2 * kk + 1][1]), p3 = pk2(sacc[2 * kk + 1][2], sacc[2 * kk + 1][3]);
                      const u32x4 u = (u32x4){p0, p1, p2, p3}; af = *(const bf16x8*)&u; }
#pragma unroll
                    for (int vt = 0; vt < 3; ++vt) {
                        const u32x2 lo = *(const LAS u32x2*)(shm + VT + (16 * vt + fr) * VRS + (32 * kk + 4 * fq) * 2);
                        const u32x2 hi = *(const LAS u32x2*)(shm + VT + (16 * vt + fr) * VRS + (32 * kk + 16 + 4 * fq) * 2);
                        const u32x4 u = (u32x4){lo[0], lo[1], hi[0], hi[1]};
                        nacc[vt] = __builtin_amdgcn_mfma_f32_16x16x32_bf16(af, *(const bf16x8*)&u, nacc[vt], 0, 0, 0);
                    }
                }
            } else {
#pragma unroll
                for (int ks = 0; ks < 8; ++ks) {
                    const bf16x8 qf = *(const LAS bf16x8*)(shm + QS + (16 * tt + fr) * RS + (32 * ks + 8 * fq) * 2);
#pragma unroll
                    for (int vt = 0; vt < 3; ++vt) {
                        const bf16x8 cf = *(const LAS bf16x8*)(shm + CB + (16 * vt + fr) * RS + (32 * ks + 8 * fq) * 2);
                        nacc[vt] = __builtin_amdgcn_mfma_f32_16x16x32_bf16(qf, cf, nacc[vt], 0, 0, 0);
                    }
                }
                const f32x4 pm4 = *(const LAS f32x4*)(tp + j * 64 + 16 * tt + 4 * fq);
#pragma unroll
                for (int vt = 0; vt < 3; ++vt)
#pragma unroll
                    for (int r = 0; r < 4; ++r) part[(16 * tt + 4 * fq + r) * PRS + 16 * vt + fr] = __expf(m_prev - fmaxf(m_prev, pm4[r])) * nacc[vt][r];
            }
            {
                const float decay = __expf(m_prev - mxc);
#pragma unroll
                for (int i = 0; i < 2; ++i)
#pragma unroll
                    for (int vt = 0; vt < 3; ++vt) cacc[i][vt] *= decay;
                const int q_ = fr >> 2, p_ = fr & 3;
#pragma unroll
                for (int kk = 0; kk < 2; ++kk) {
                    bf16x8 bfv[3];
#pragma unroll
                    for (int vt = 0; vt < 3; ++vt) bfv[vt] = *(const LAS bf16x8*)(shm + VWT + (16 * vt + fr) * VRS + (32 * kk + 8 * fq) * 2);
#pragma unroll
                    for (int i = 0; i < 2; ++i) {
                        const int dt = 2 * wid + i;
                        const s16x4 t0 = __builtin_amdgcn_ds_read_tr16_b64_v4i16((LAS s16x4*)(shm + KS + (32 * kk + 8 * fq + q_) * RS + (16 * dt + 4 * p_) * 2));
                        const s16x4 t1 = __builtin_amdgcn_ds_read_tr16_b64_v4i16((LAS s16x4*)(shm + KS + (32 * kk + 8 * fq + 4 + q_) * RS + (16 * dt + 4 * p_) * 2));
                        bf16x8 af; af[0] = t0[0]; af[1] = t0[1]; af[2] = t0[2]; af[3] = t0[3]; af[4] = t1[0]; af[5] = t1[1]; af[6] = t1[2]; af[7] = t1[3];
#pragma unroll
                        for (int vt = 0; vt < 3; ++vt) cacc[i][vt] = __builtin_amdgcn_mfma_f32_16x16x32_bf16(af, bfv[vt], cacc[i][vt], 0, 0, 0);
                    }
                }
            }
            __syncthreads();
            if (wid < 4) {
                const f32x4 pm4 = *(const LAS f32x4*)(tp + j * 64 + 16 * tt + 4 * fq);
                const f32x4 bc4 = *(const LAS f32x4*)(tb + j * 64 + 16 * tt + 4 * fq);
#pragma unroll
                for (int vt = 0; vt < 3; ++vt)
#pragma unroll
                    for (int r = 0; r < 4; ++r) nacc[vt][r] += part[(16 * tt + 4 * fq + r) * PRS + 16 * vt + fr];
#pragma unroll
                for (int r = 0; r < 4; ++r) {
                    const float den = __shfl(nacc[2][r], lane & 48);
                    const float inv = 1.f / fmaxf(fabsf(den), __expf(-(bc4[r] + fmaxf(m_prev, pm4[r]))));
                    const size_t o = cb + (size_t)(16 * tt + 4 * fq + r) * DM + vs * 32 + fr;
                    hc[o] = f2bf(nacc[0][r] * inv);
                    hc[o + 16] = f2bf(nacc[1][r] * inv);
                }
            }
#pragma unroll
            for (int i = 0; i < 2; ++i)
#pragma unroll
                for (int vt = 0; vt < 3; ++vt) {
                    u32x2 o; o[0] = pk2(cacc[i][vt][0], cacc[i][vt][1]); o[1] = pk2(cacc[i][vt][2], cacc[i][vt][3]);
                    *(LAS u32x2*)(shm + CB + (16 * vt + fr) * RS + (16 * (2 * wid + i) + 4 * fq) * 2) = o;
                }
            m_prev = btot + mxc;
        }
    }
}

constexpr int S5L = 32, S5NCH = SEQ / S5L;
constexpr size_t T_KT_OFF = 0, T_WS_OFF = 2u << 20, T_V_OFF = 10u << 20, T_AL_OFF = 18u << 20;
constexpr int KT_G = 33 * 256, WS_G = 128 * 512, V_G = 512 * 128;

DEV void s5_tables(LAS char* shm, char* tab, const float* lam_re, const float* lam_im, const float* log_dt, const float* b_re, const float* b_im,
                   const float* c_re, const float* c_im) {
    const int tid = opaque_tid();
    LAS f32x2* apw = (LAS f32x2*)shm;
    LAS f32x2* bb = (LAS f32x2*)(shm + 64 * 33 * 8);
    LAS f32x2* cc = (LAS f32x2*)(shm + 64 * 33 * 8 + 8192);
    bf16_t* KT = (bf16_t*)(tab + T_KT_OFF); bf16_t* WS = (bf16_t*)(tab + T_WS_OFF); bf16_t* VV = (bf16_t*)(tab + T_V_OFF); float2* AL = (float2*)(tab + T_AL_OFF);
    for (int it = blockIdx.x; it < 256; it += gridDim.x) {
        const int g = it & 63, qd = it >> 6;
        __syncthreads();
        if (tid < 64) {
            const int pp = tid;
            const double lr = lam_re[g * NP + pp], li = lam_im[g * NP + pp], dt = exp((double)log_dt[g]);
            const double er = exp(lr * dt);
            const double ar = er * cos(li * dt), ai = er * sin(li * dt);
            const double dr = ar - 1.0, di = ai, den = lr * lr + li * li;
            const double cr = (dr * lr + di * li) / den, ci = (di * lr - dr * li) / den;
            double pr = 1.0, pi_ = 0.0;
            for (int e = 0; e <= 32; ++e) {
                apw[pp * 33 + e] = (f32x2){(float)pr, (float)pi_};
                const double nr = pr * ar - pi_ * ai, ni = pr * ai + pi_ * ar; pr = nr; pi_ = ni;
            }
            if (qd == 0) { const f32x2 t_ = apw[pp * 33 + 32]; AL[g * NP + pp] = make_float2(t_.x, t_.y); }
            for (int c = 0; c < 16; ++c) {
                const double br = b_re[(g * NP + pp) * GC + c], bi = b_im[(g * NP + pp) * GC + c];
                bb[pp * 16 + c] = (f32x2){(float)(cr * br - ci * bi), (float)(cr * bi + ci * br)};
                cc[c * 64 + pp] = (f32x2){c_re[(g * GC + c) * NP + pp], c_im[(g * GC + c) * NP + pp]};
            }
        }
        __syncthreads();
        for (int o = tid; o < 8 * 256; o += 512) {
            const int d = 8 * qd + (o >> 8), c1 = (o >> 4) & 15, c0 = o & 15;
            float acc = 0.f;
            for (int pp = 0; pp < 64; ++pp) {
                const f32x2 a = apw[pp * 33 + d], b = bb[pp * 16 + c0], c = cc[c1 * 64 + pp];
                const float mr = a.x * b.x - a.y * b.y, mi = a.x * b.y + a.y * b.x;
                acc += c.x * mr - c.y * mi;
            }
            KT[(size_t)g * KT_G + (d + 1) * 256 + c1 * 16 + c0] = f2bf(acc);
        }
        if (qd == 0 && tid < 256) KT[(size_t)g * KT_G + tid] = 0;
        for (int o = tid; o < 2 * 16 * 64; o += 512) {
            const int mt = 2 * qd + (o >> 10), sp = (o >> 6) & 15, ln = o & 63;
            const int row = 16 * mt + (ln & 15), ri = row >> 6, pp = row & 63, s_ = 2 * sp + (ln >> 5), c0 = 8 * ((ln >> 4) & 1);
            const f32x2 a = apw[pp * 33 + 31 - s_];
            unsigned w[4];
#pragma unroll
            for (int jj = 0; jj < 8; jj += 2) {
                const f32x2 b0 = bb[pp * 16 + c0 + jj], b1 = bb[pp * 16 + c0 + jj + 1];
                const float v0 = ri ? (a.x * b0.y + a.y * b0.x) : (a.x * b0.x - a.y * b0.y);
                const float v1 = ri ? (a.x * b1.y + a.y * b1.x) : (a.x * b1.x - a.y * b1.y);
                w[jj >> 1] = pk2(v0, v1);
            }
            *(uint4*)(WS + (size_t)g * WS_G + ((size_t)(mt * 16 + sp) * 64 + ln) * 8) = make_uint4(w[0], w[1], w[2], w[3]);
        }
        for (int o = tid; o < 8 * 4 * 64; o += 512) {
            const int i = 8 * qd + (o >> 8), ks = (o >> 6) & 3, ln = o & 63;
            const int c1 = ln & 15, k0 = 32 * ks + 8 * (ln >> 4);
            unsigned w[4];
#pragma unroll
            for (int jj = 0; jj < 8; jj += 2) {
                float v[2];
#pragma unroll
                for (int e = 0; e < 2; ++e) {
                    const int kk = k0 + jj + e, ri = kk >> 6, pp = kk & 63;
                    const f32x2 a = apw[pp * 33 + i + 1], c = cc[c1 * 64 + pp];
                    v[e] = ri ? -(c.x * a.y + c.y * a.x) : (c.x * a.x - c.y * a.y);
                }
                w[jj >> 1] = pk2(v[0], v[1]);
            }
            *(uint4*)(VV + (size_t)g * V_G + ((size_t)(i * 4 + ks) * 64 + ln) * 8) = make_uint4(w[0], w[1], w[2], w[3]);
        }
    }
}

DEV void s5_phase(LAS char* shm, const bf16_t* Uin, bf16_t* Yout, const char* tab, const float* dskip) {
    const int tid = opaque_tid(), wid = __builtin_amdgcn_readfirstlane(tid >> 6), lane = tid & 63, fr = lane & 15, fq = lane >> 4;
    constexpr int PLANE = 64 * 528, KTL = 2 * PLANE, SL = KTL + 33 * 512, HB = SL + 64 * 528, SRS = 528, HRS = 272;
    const bf16_t* KT = (const bf16_t*)(tab + T_KT_OFF); const bf16_t* WS = (const bf16_t*)(tab + T_WS_OFF); const bf16_t* VV = (const bf16_t*)(tab + T_V_OFF);
    const float2* AL = (const float2*)(tab + T_AL_OFF);
    for (int item = blockIdx.x; item < BATCH * NG; item += gridDim.x) {
        const int g = item & 63, b = item >> 6;
        const bf16_t* Ub = Uin + (size_t)b * SEQ * DM + g * GC;
        bf16_t* Yb = Yout + (size_t)b * SEQ * DM + g * GC;
        __syncthreads();
#pragma unroll
        for (int i = 0; i < 8; ++i) {
            const int idx = tid + 512 * i, tok = idx >> 1, hf = idx & 1;
            const uint4 uv = *(const uint4*)(Ub + (size_t)tok * DM + hf * 8);
            *(LAS u32x4*)(shm + hf * PLANE + (tok >> 5) * 528 + (tok & 31) * 16) = (u32x4){uv.x, uv.y, uv.z, uv.w};
        }
        for (int idx = tid; idx < 33 * 32; idx += 512) {
            const uint4 kv = *(const uint4*)(KT + (size_t)g * KT_G + idx * 8);
            *(LAS u32x4*)(shm + KTL + idx * 16) = (u32x4){kv.x, kv.y, kv.z, kv.w};
        }
        __syncthreads();
        f32x4 acc[4][4], sac[4];
#pragma unroll
        for (int q = 0; q < 4; ++q)
#pragma unroll
            for (int nt = 0; nt < 4; ++nt) acc[q][nt] = (f32x4){0.f, 0.f, 0.f, 0.f};
#pragma unroll
        for (int nt = 0; nt < 4; ++nt) sac[nt] = (f32x4){0.f, 0.f, 0.f, 0.f};
        const bf16_t* wsp = WS + (size_t)g * WS_G + ((size_t)(wid * 16) * 64 + lane) * 8;
        bf16x8 wnext = *(const bf16x8*)wsp;
#pragma nounroll
        for (int sp = 0; sp < 16; ++sp) {
            const bf16x8 wcur = wnext;
            if (sp + 1 < 16) wnext = *(const bf16x8*)(wsp + (size_t)(sp + 1) * 64 * 8);
            bf16x8 bu[4];
#pragma unroll
            for (int nt = 0; nt < 4; ++nt) bu[nt] = *(const LAS bf16x8*)(shm + (fq & 1) * PLANE + (16 * nt + fr) * 528 + (2 * sp + (fq >> 1)) * 16);
#pragma unroll
            for (int nt = 0; nt < 4; ++nt) sac[nt] = __builtin_amdgcn_mfma_f32_16x16x32_bf16(wcur, bu[nt], sac[nt], 0, 0, 0);
#pragma unroll
            for (int q = 0; q < 4; ++q) {
                const int i = wid + 8 * q;
                if (i >= 2 * sp) {
                    const int d = i - 2 * sp;
                    const bf16x8 kf = *(const LAS bf16x8*)(shm + KTL + (d - (fq >> 1) + 1) * 512 + fr * 32 + (fq & 1) * 16);
#pragma unroll
                    for (int nt = 0; nt < 4; ++nt) acc[q][nt] = __builtin_amdgcn_mfma_f32_16x16x32_bf16(kf, bu[nt], acc[q][nt], 0, 0, 0);
                }
            }
        }
#pragma unroll
        for (int nt = 0; nt < 4; ++nt) *(LAS f32x4*)(shm + SL + (16 * nt + fr) * SRS + (16 * wid + 4 * fq) * 4) = sac[nt];
        __syncthreads();
        if (wid == 0) {
            const float2 al = AL[g * NP + lane];
            float hr = 0.f, hi = 0.f;
#pragma unroll 8
            for (int n = 0; n < S5NCH; ++n) {
                *(LAS bf16_t*)(shm + HB + n * HRS + lane * 2) = f2bf(hr);
                *(LAS bf16_t*)(shm + HB + n * HRS + (64 + lane) * 2) = f2bf(hi);
                const float sr = *(const LAS float*)(shm + SL + n * SRS + lane * 4), si = *(const LAS float*)(shm + SL + n * SRS + (64 + lane) * 4);
                const float nr = al.x * hr - al.y * hi + sr, ni = al.x * hi + al.y * hr + si;
                hr = nr; hi = ni;
            }
        }
        __syncthreads();
        const bf16_t* vvp = VV + (size_t)g * V_G + (size_t)lane * 8;
#pragma unroll
        for (int ks = 0; ks < 4; ++ks) {
            bf16x8 hb[4], va[4];
#pragma unroll
            for (int q = 0; q < 4; ++q) va[q] = *(const bf16x8*)(vvp + ((size_t)((wid + 8 * q) * 4 + ks) * 64) * 8);
#pragma unroll
            for (int nt = 0; nt < 4; ++nt) hb[nt] = *(const LAS bf16x8*)(shm + HB + (16 * nt + fr) * HRS + (32 * ks + 8 * fq) * 2);
#pragma unroll
            for (int q = 0; q < 4; ++q)
#pragma unroll
                for (int nt = 0; nt < 4; ++nt) acc[q][nt] = __builtin_amdgcn_mfma_f32_16x16x32_bf16(va[q], hb[nt], acc[q][nt], 0, 0, 0);
        }
        const float4 dsk = *(const float4*)(dskip + g * GC + 4 * fq);
#pragma unroll
        for (int q = 0; q < 4; ++q) {
            const int i = wid + 8 * q;
#pragma unroll
            for (int nt = 0; nt < 4; ++nt) {
                const int n = 16 * nt + fr;
                const u32x2 uu = *(const LAS u32x2*)(shm + (fq >> 1) * PLANE + n * 528 + i * 16 + ((4 * fq) & 7) * 2);
                f32x4 o;
                o[0] = geluf_(acc[q][nt][0] + dsk.x * bf2f((bf16_t)(uu[0] & 0xffff))); o[1] = geluf_(acc[q][nt][1] + dsk.y * bf2f((bf16_t)(uu[0] >> 16)));
                o[2] = geluf_(acc[q][nt][2] + dsk.z * bf2f((bf16_t)(uu[1] & 0xffff))); o[3] = geluf_(acc[q][nt][3] + dsk.w * bf2f((bf16_t)(uu[1] >> 16)));
                *(uint2*)(Yb + (size_t)(n * 32 + i) * DM + 4 * fq) = pack4(o);
            }
        }
    }
}

DEV void unpack8(const uint4 v, float* f) {
    f[0] = bf2f((bf16_t)(v.x & 0xffff)); f[1] = bf2f((bf16_t)(v.x >> 16)); f[2] = bf2f((bf16_t)(v.y & 0xffff)); f[3] = bf2f((bf16_t)(v.y >> 16));
    f[4] = bf2f((bf16_t)(v.z & 0xffff)); f[5] = bf2f((bf16_t)(v.z >> 16)); f[6] = bf2f((bf16_t)(v.w & 0xffff)); f[7] = bf2f((bf16_t)(v.w >> 16));
}
DEV uint4 pack8(const float* f) { return make_uint4(pk2(f[0], f[1]), pk2(f[2], f[3]), pk2(f[4], f[5]), pk2(f[6], f[7])); }

DEV void norm_rows(const float* x, const float* gain, const float* modl, bf16_t* h) {
    const int tid = opaque_tid(), lane = tid & 63, gw = blockIdx.x * 8 + (tid >> 6), NGW = gridDim.x * 8;
    for (int m = gw; m < MTOK; m += NGW) {
        const float4* xr = (const float4*)(x + (size_t)m * DM) + lane;
        float4 v[4]; float ss = 0.f;
#pragma unroll
        for (int j = 0; j < 4; ++j) { v[j] = xr[64 * j]; ss += v[j].x * v[j].x + v[j].y * v[j].y + v[j].z * v[j].z + v[j].w * v[j].w; }
        const float rstd = rsqrtf(wave_sum(ss) * (1.f / DM) + EPS);
        const float* shift = modl + (size_t)(m / SEQ) * 3 * DM; const float* scale = shift + DM;
#pragma unroll
        for (int j = 0; j < 4; ++j) {
            const int n = 4 * lane + 256 * j;
            const float4 g = *(const float4*)(gain + n), sc = *(const float4*)(scale + n), sh = *(const float4*)(shift + n);
            f32x4 o; o[0] = v[j].x * rstd * g.x * (1.f + sc.x) + sh.x; o[1] = v[j].y * rstd * g.y * (1.f + sc.y) + sh.y;
            o[2] = v[j].z * rstd * g.z * (1.f + sc.z) + sh.z; o[3] = v[j].w * rstd * g.w * (1.f + sc.w) + sh.w;
            *(uint2*)(h + (size_t)m * DM + n) = pack4(o);
        }
    }
}
DEV void ssm_post_rows(const bf16_t* z, bf16_t* zo, const bf16_t* sg, const float* gain) {
    const int tid = opaque_tid(), lane = tid & 63, gw = blockIdx.x * 8 + (tid >> 6), NGW = gridDim.x * 8;
    for (int m = gw; m < MTOK; m += NGW) {
        float zv[2][8], gv[2][8]; float ss = 0.f;
#pragma unroll
        for (int j = 0; j < 2; ++j) {
            unpack8(*(const uint4*)(z + (size_t)m * DM + 8 * lane + 512 * j), zv[j]);
            unpack8(*(const uint4*)(sg + (size_t)m * DM + 8 * lane + 512 * j), gv[j]);
#pragma unroll
            for (int e = 0; e < 8; ++e) ss += zv[j][e] * zv[j][e];
        }
        const float rstd = rsqrtf(wave_sum(ss) * (1.f / DM) + EPS);
#pragma unroll
        for (int j = 0; j < 2; ++j) {
            const int n = 8 * lane + 512 * j; float o[8];
#pragma unroll
            for (int e = 0; e < 8; ++e) o[e] = zv[j][e] * rstd * gain[n + e] * siluf_(gv[j][e]);
            *(uint4*)(zo + (size_t)m * DM + n) = pack8(o);
        }
    }
}
DEV void mlstm_post_rows(const bf16_t* hc, bf16_t* ho, const bf16_t* mo, const bf16_t* mg, const bf16_t* mi, const float* cw, const float* cb, const float* ngain, const float* skip) {
    const int tid = opaque_tid(), lane = tid & 63, gw = blockIdx.x * 8 + (tid >> 6), NGW = gridDim.x * 8;
    for (int m = gw; m < MTOK; m += NGW) {
        const size_t o0 = (size_t)m * DM + 16 * lane;
        float hv[16], t8[8]; float s1 = 0.f;
#pragma unroll
        for (int j = 0; j < 2; ++j) {
            unpack8(*(const uint4*)(hc + o0 + 8 * j), hv + 8 * j);
            unpack8(*(const uint4*)(mo + o0 + 8 * j), t8);
#pragma unroll
            for (int e = 0; e < 8; ++e) { hv[8 * j + e] *= sigmoidf_(t8[e]); s1 += hv[8 * j + e]; }
        }
#pragma unroll
        for (int o = 1; o < 16; o <<= 1) s1 += __shfl_xor(s1, o);
        const float mu = s1 * (1.f / DH); float s2 = 0.f;
#pragma unroll
        for (int e = 0; e < 16; ++e) { hv[e] -= mu; s2 += hv[e] * hv[e]; }
#pragma unroll
        for (int o = 1; o < 16; o <<= 1) s2 += __shfl_xor(s2, o);
        const float rstd = rsqrtf(s2 * (1.f / DH) + EPS);
#pragma unroll
        for (int j = 0; j < 2; ++j) {
            float xv[8], gv[8], ov[8], t8b[8];
            { const int n0 = 16 * lane + 8 * j, tpos = m % SEQ;
#pragma unroll
              for (int e = 0; e < 8; ++e) xv[e] = cb[n0 + e];
#pragma unroll
              for (int tap = 0; tap < 4; ++tap) if (tpos - 3 + tap >= 0) {
                  unpack8(*(const uint4*)(mi + (size_t)(m - 3 + tap) * DM + n0), t8b);
#pragma unroll
                  for (int e = 0; e < 8; ++e) xv[e] += t8b[e] * cw[tap * DM + n0 + e];
              }
#pragma unroll
              for (int e = 0; e < 8; ++e) xv[e] = siluf_(xv[e]); }
            unpack8(*(const uint4*)(mg + o0 + 8 * j), gv);
#pragma unroll
            for (int e = 0; e < 8; ++e) { const int n = 16 * lane + 8 * j + e; ov[e] = (hv[8 * j + e] * rstd * ngain[n] + skip[n] * xv[e]) * siluf_(gv[e]); }
            *(uint4*)(ho + o0 + 8 * j) = pack8(ov);
        }
    }
}
DEV void final_rows(float* x, const float* gain) {
    const int tid = opaque_tid(), lane = tid & 63, gw = blockIdx.x * 8 + (tid >> 6), NGW = gridDim.x * 8;
    for (int m = gw; m < MTOK; m += NGW) {
        float4* xr = (float4*)(x + (size_t)m * DM) + lane;
        float4 v[4]; float ss = 0.f;
#pragma unroll
        for (int j = 0; j < 4; ++j) { v[j] = xr[64 * j]; ss += v[j].x * v[j].x + v[j].y * v[j].y + v[j].z * v[j].z + v[j].w * v[j].w; }
        const float rstd = rsqrtf(wave_sum(ss) * (1.f / DM) + EPS);
#pragma unroll
        for (int j = 0; j < 4; ++j) {
            const float4 g = *(const float4*)(gain + 4 * lane + 256 * j);
            v[j].x *= rstd * g.x; v[j].y *= rstd * g.y; v[j].z *= rstd * g.z; v[j].w *= rstd * g.w;
            xr[64 * j] = v[j];
        }
    }
}
DEV void mod_phase(LAS char* shm, const float* c, const float* w_mod, const float* b_mod, float* mod) {
    const int tid = opaque_tid();
    LAS float* sc = (LAS float*)shm;
    LAS float* pr = (LAS float*)(shm + 32768);
    __syncthreads();
    for (int i = tid; i < BATCH * DM; i += 512) sc[i] = siluf_(c[i]);
    __syncthreads();
    for (int it = blockIdx.x; it < 48; it += gridDim.x) {
        const int l = it / 24, n0 = (it % 24) * 128, cq = tid & 31, kg = tid >> 5;
        const float* W = w_mod + (size_t)l * DM * 3 * DM + n0 + 4 * cq;
        float acc[BATCH][4];
#pragma unroll
        for (int b = 0; b < BATCH; ++b) { acc[b][0] = acc[b][1] = acc[b][2] = acc[b][3] = 0.f; }
        for (int k = kg * 64; k < kg * 64 + 64; ++k) {
            const float4 w = *(const float4*)(W + (size_t)k * 3 * DM);
#pragma unroll
            for (int b = 0; b < BATCH; ++b) { const float s_ = sc[b * DM + k]; acc[b][0] += s_ * w.x; acc[b][1] += s_ * w.y; acc[b][2] += s_ * w.z; acc[b][3] += s_ * w.w; }
        }
#pragma unroll
        for (int b = 0; b < BATCH; ++b) *(LAS f32x4*)(pr + (kg * 8 + b) * 128 + 4 * cq) = (f32x4){acc[b][0], acc[b][1], acc[b][2], acc[b][3]};
        __syncthreads();
        for (int o = tid; o < 8 * 128; o += 512) {
            const int b = o >> 7, n = o & 127; float s_ = 0.f;
#pragma unroll
            for (int g2 = 0; g2 < 16; ++g2) s_ += pr[(g2 * 8 + b) * 128 + n];
            mod[((size_t)l * BATCH + b) * 3 * DM + n0 + n] = s_ + b_mod[l * 3 * DM + n0 + n];
        }
        __syncthreads();
    }
}

DEV void wfold_prep(bf16_t* WfT, const float* wq, const float* wk, const float* wv, const float* wg  ) {
    const int tid = opaque_tid();
    for (int o = blockIdx.x * 512 + tid; o < 2 * 16 * 1024; o += gridDim.x * 512) {
        const int which = o >> 14, j = (o >> 10) & 15, ch = o & 1023, hd = ch >> 8, d = ch & 255;
        float acc = 0.f;
        if (j < 8) {
            if (which == 0) {
                const float* rq = wq + ((size_t)hd * DH + d) * DH; const float* rk = wk + ((size_t)hd * DH + d) * DH;
                float a1 = 0.f, a2 = 0.f;
                for (int e = 0; e < DH; ++e) { a1 += rq[e] * wg[(size_t)(hd * DH + e) * 8 + j]; a2 += rk[e] * wg[(size_t)(DM + hd * DH + e) * 8 + j]; }
                acc = a1 + 0.0625f * a2;
            } else {
                const float* rv = wv + ((size_t)hd * DH + d) * DH;
                for (int e = 0; e < DH; ++e) acc += rv[e] * wg[(size_t)(2 * DM + hd * DH + e) * 8 + j];
            }
        }
        WfT[o] = f2bf(acc);
    }
}
DEV void xc_gates_phase(LAS char* shm, const bf16_t* mi, bf16_t* xc, const bf16_t* WfT, const float* cw, const float* cb, float* gpart  ) {
    const int tid = opaque_tid(), wid = __builtin_amdgcn_readfirstlane(tid >> 6), lane = tid & 63, fr = lane & 15, fq = lane >> 4;
    constexpr int WRS = 2064, WIMG = 16 * WRS, STG = 2 * WIMG, SRS_ = 528, STG_W = 19 * SRS_;
    __syncthreads();
    for (int i = tid; i < 2 * 16 * 128; i += 512) {
        const int rowi = i >> 7, pc = i & 127;
        const uint4 v = *(const uint4*)(WfT + (size_t)rowi * 1024 + pc * 8);
        *(LAS u32x4*)(shm + rowi * WRS + pc * 16) = (u32x4){v.x, v.y, v.z, v.w};
    }
    __syncthreads();
    LAS char* stg = shm + STG + wid * STG_W;
    for (int task = blockIdx.x * 8 + wid; task < (MTOK / 16) * 2; task += gridDim.x * 8) {
        const int chalf = task & 1, m0 = (task >> 1) * 16, tpos0 = m0 % SEQ;
        f32x4 acc = (f32x4){0.f, 0.f, 0.f, 0.f};
#pragma nounroll
        for (int sl = 0; sl < 2; ++sl) {
            const int c0 = chalf * 512 + sl * 256;
            for (int i = lane; i < 19 * 32; i += 64) {
                const int row = i >> 5, pc = i & 31;
                uint4 v = make_uint4(0, 0, 0, 0);
                if (tpos0 - 3 + row >= 0) v = *(const uint4*)(mi + (size_t)(m0 - 3 + row) * DM + c0 + pc * 8);
                *(LAS u32x4*)(stg + row * SRS_ + pc * 16) = (u32x4){v.x, v.y, v.z, v.w};
            }
#pragma nounroll
            for (int ks = 0; ks < 8; ++ks) {
                const int cl = 32 * ks + 8 * fq, c = c0 + cl;
                float xv[8], t8[8], w8[8];
                { const float4 b0 = *(const float4*)(cb + c), b1 = *(const float4*)(cb + c + 4);
                  xv[0] = b0.x; xv[1] = b0.y; xv[2] = b0.z; xv[3] = b0.w; xv[4] = b1.x; xv[5] = b1.y; xv[6] = b1.z; xv[7] = b1.w; }
                u32x4 raw3;
#pragma unroll
                for (int tap = 0; tap < 4; ++tap) {
                    const u32x4 rw = *(const LAS u32x4*)(stg + (fr + tap) * SRS_ + cl * 2);
                    if (tap == 3) raw3 = rw;
                    unpack8(make_uint4(rw[0], rw[1], rw[2], rw[3]), t8);
                    const float4 w0 = *(const float4*)(cw + tap * DM + c), w1 = *(const float4*)(cw + tap * DM + c + 4);
                    w8[0] = w0.x; w8[1] = w0.y; w8[2] = w0.z; w8[3] = w0.w; w8[4] = w1.x; w8[5] = w1.y; w8[6] = w1.z; w8[7] = w1.w;
#pragma unroll
                    for (int e = 0; e < 8; ++e) xv[e] += t8[e] * w8[e];
                }
#pragma unroll
                for (int e = 0; e < 8; ++e) xv[e] = siluf_(xv[e]);
                const uint4 xp = pack8(xv);
                *(uint4*)(xc + (size_t)(m0 + fr) * DM + c) = xp;
                const u32x4 xpu = (u32x4){xp.x, xp.y, xp.z, xp.w};
                const bf16x8 bx = *(const LAS bf16x8*)(shm + fr * WRS + c * 2);
                const bf16x8 bv = *(const LAS bf16x8*)(shm + WIMG + fr * WRS + c * 2);
                acc = __builtin_amdgcn_mfma_f32_16x16x32_bf16(*(const bf16x8*)&xpu, bx, acc, 0, 0, 0);
                acc = __builtin_amdgcn_mfma_f32_16x16x32_bf16(*(const bf16x8*)&raw3, bv, acc, 0, 0, 0);
            }
        }
        if (fr < 8) {
#pragma unroll
            for (int r = 0; r < 4; ++r) gpart[((size_t)chalf * MTOK + m0 + 4 * fq + r) * 8 + fr] = acc[r];
        }
    }
}

#define XB_TMO      128
#define XB_XCNT(j)  (256  + 64 * (j))
#define XB_XSUB(j)  (1280 + 64 * (j))
#define XB_XGEN(j)  (2304 + 64 * (j))
#define XB_TOP      3328
#define XB_TOPGEN   3392
#define XCD_BAR_WORDS 3456
#define XB_SPIN_CAP (1u << 18)
DEV unsigned xb_ld(unsigned* p) { return __hip_atomic_load(p, __ATOMIC_RELAXED, __HIP_MEMORY_SCOPE_AGENT); }
DEV unsigned xb_add(unsigned* p, unsigned v) { return __hip_atomic_fetch_add(p, v, __ATOMIC_RELAXED, __HIP_MEMORY_SCOPE_AGENT); }
DEV unsigned xb_xcc_id() { return (unsigned)__builtin_amdgcn_s_getreg((3 << 11) | 20) & 0xFu; }
#define XB_SPIN(cond, bar) do { unsigned _sp = 0; while (cond) { __builtin_amdgcn_s_sleep(1); \
    if ((++_sp & 255u) == 0u) { if (xb_ld(&(bar)[XB_TMO])) break; if (_sp > XB_SPIN_CAP) { atomicAdd(&(bar)[XB_TMO], 1u); break; } } } } while (0)
struct XcdBarrier { unsigned* bar; unsigned x; volatile LAS unsigned* st; };
DEV XcdBarrier xcd_barrier_post(unsigned* bar, volatile LAS unsigned* st) {
    XcdBarrier b; b.bar = bar; b.x = xb_xcc_id(); b.st = st;
    if (threadIdx.x == 0) (void)xb_add(&bar[XB_XCNT(b.x)], 1u);
    return b;
}
DEV void xcd_barrier_complete(unsigned* bar, unsigned x, unsigned& nloc, unsigned& nx) {
    const unsigned G = gridDim.x * gridDim.y * gridDim.z;
    unsigned sum, cnt, mine, sp = 0u;
    for (;;) {
        sum = 0u; cnt = 0u; mine = 0u;
#pragma nounroll
        for (unsigned j = 0; j < 16; ++j) { const unsigned c = xb_ld(&bar[XB_XCNT(j)]); sum += c; cnt += (c > 0u) ? 1u : 0u; }
        mine = xb_ld(&bar[XB_XCNT(x)]);
        if (sum == G) break;
        __builtin_amdgcn_s_sleep(1);
        if ((++sp & 255u) == 0u) { if (xb_ld(&bar[XB_TMO])) break; if (sp > XB_SPIN_CAP) { atomicAdd(&bar[XB_TMO], 1u); break; } }
    }
    nloc = mine > 0u ? mine : 1u; nx = cnt > 0u ? cnt : 1u;
}
DEV void xcd_barrier1(const XcdBarrier& b) {
    asm volatile("s_waitcnt vmcnt(0)" ::: "memory");
    __syncthreads();
    if (threadIdx.x == 0) {
        unsigned* bar = b.bar;
        __builtin_amdgcn_s_waitcnt(0);
        unsigned nloc = b.st[0], nx = b.st[1];
        if (nloc == 0u) { xcd_barrier_complete(bar, b.x, nloc, nx); b.st[0] = nloc; b.st[1] = nx; }
        const unsigned old = xb_add(&bar[XB_XSUB(b.x)], 1u);
        const unsigned gen = old / nloc;
        if (old + 1u == (gen + 1u) * nloc) {
            __builtin_amdgcn_fence(__ATOMIC_RELEASE, "agent");
            asm volatile("s_waitcnt vmcnt(0)" ::: "memory");
            const unsigned og = xb_add(&bar[XB_TOP], 1u);
            const unsigned tg = og / nx;
            if (og + 1u == (tg + 1u) * nx) xb_add(&bar[XB_TOPGEN], 1u);
            else XB_SPIN(xb_ld(&bar[XB_TOPGEN]) == tg, bar);
            __builtin_amdgcn_fence(__ATOMIC_ACQUIRE, "agent");
            xb_add(&bar[XB_XGEN(b.x)], 1u);
            asm volatile("s_waitcnt vmcnt(0)" ::: "memory");
        } else {
            XB_SPIN(xb_ld(&bar[XB_XGEN(b.x)]) == gen, bar);
            __builtin_amdgcn_fence(__ATOMIC_ACQUIRE, "agent");
            asm volatile("s_waitcnt vmcnt(0)" ::: "memory");
        }
    }
    __syncthreads();
}

DEV void xcd_barrier(const XcdBarrier& b) { xcd_barrier1(b); if (REPMASK & 2048) xcd_barrier1(b); }
constexpr int LDS_BYTES = 148 * 1024;
DEV const void* ldptr(LAS char* shm, int i) {
    volatile LAS unsigned* pt = (volatile LAS unsigned*)(shm + LDS_BYTES - 512);
    const unsigned lo = __builtin_amdgcn_readfirstlane(pt[2 * i]), hi = __builtin_amdgcn_readfirstlane(pt[2 * i + 1]);
    return (const void*)(((unsigned long long)hi << 32) | lo);
}
#define PF(i) ((const float*)ldptr(shm, (i)))
struct Params {
    const float *x, *c, *norm_gain, *w_mod, *b_mod, *w_in, *lam_re, *lam_im, *log_dt, *sb_re, *sb_im, *sc_re, *sc_im, *ssm_d, *w_glu, *b_glu, *ssm_og,
        *conv_w, *conv_b, *wq, *wk, *wv, *w_gates, *b_ig, *b_fg, *m_ng, *m_skip, *w_out, *final_gain;
    float* out; char* ws;
};
constexpr int HALF_FLOATS = 56 * 1024 / 4;
constexpr size_t SLOT = (size_t)MTOK * DM * 2;
constexpr size_t W_IN_OFF = 0, W_GLU_OFF = 10485760, W_QKV_OFF = 12582912, W_OUT_OFF = 14155776, MOD_OFF = 20u << 20, IPRE_OFF = 21u << 20, LOGF_OFF = 22u << 20, BAR_OFF = 23u << 20, WF_OFF = 19u << 20, ROWSS_OFF = 24u << 20;
#define REP(bit) _Pragma("nounroll") for (int rep_ = 0; rep_ < (((REPMASK) & (bit)) ? 2 : 1); ++rep_)
#define FOR_VB(nvb) for (int vb = blockIdx.x * 2 + HALF; vb < (nvb); vb += gridDim.x * 2)

#define WSB ((char*)ldptr(shm, 30))
#define SL(i) ((bf16_t*)(WSB + SLOT * (i)))
#define S7(off) (WSB + SLOT * 7 + (off))
#define WinT ((bf16_t*)S7(W_IN_OFF))
#define WgluT ((bf16_t*)S7(W_GLU_OFF))
#define WqkvT ((bf16_t*)S7(W_QKV_OFF))
#define WoutT ((bf16_t*)S7(W_OUT_OFF))
#define mod ((float*)S7(MOD_OFF))
#define gpart ((float*)S7(IPRE_OFF))
#define WfT ((bf16_t*)S7(WF_OFF))
#define rowss ((float*)S7(ROWSS_OFF))
#define OUTP ((float*)ldptr(shm, 29))
#define H SL(0)
#define U SL(1)
#define Y SL(2)
#define Z SL(3)
#define XC SL(4)
#define MI SL(5)
#define Q SL(6)
#define Kb SL(1)
#define V SL(2)
#define HC SL(5)
template <int l>
DEV void layer_body(LAS char* shm, const XcdBarrier& gbar) {
        const int wave = opaque_tid() >> 6, lane = opaque_tid() & 63;
        const float* xin = (l == 0) ? PF(0) : OUTP;
        const float* modl = mod + (size_t)l * BATCH * 3 * DM;
        REP(1) { {
            LAS float* scr = (LAS float*)(shm + wave * 8448);
            const float* Win = PF(5) + (size_t)l * DM * INC;
            constexpr int I_IN = 16 * 160, I_GLU = 16 * 32, I_QKV = 12 * 32, I_OUT = 32 * 32;
            for (int it = blockIdx.x * 8 + wave; it < I_IN + I_GLU + I_QKV + I_OUT; it += gridDim.x * 8) {
                int r = it;
                if (r < I_IN) { transpose_item(Win, INC, INC, WinT, DM, scr, r, lane); continue; } r -= I_IN;
                if (r < I_GLU) { transpose_item(PF(14) + (size_t)l * DM * DM, DM, DM, WgluT, DM, scr, r, lane); continue; } r -= I_GLU;
                if (r < I_QKV) { const int mat = r / 32, which = mat >> 2, hd = mat & 3;
                    const float* W = sel3(which, PF(19), PF(20), PF(21)) + ((size_t)l * NH + hd) * DH * DH;
                    transpose_item(W, DH, DH, WqkvT + (size_t)mat * DH * DH, DH, scr, r % 32, lane); continue; } r -= I_QKV;
                transpose_item(PF(27) + (size_t)l * 2 * DM * DM, DM, DM, WoutT, 2 * DM, scr, r, lane);
            }
        }
        wfold_prep(WfT, PF(19) + (size_t)l * NH * DH * DH, PF(20) + (size_t)l * NH * DH * DH, PF(21) + (size_t)l * NH * DH * DH, PF(22) + (size_t)l * 3 * DM * 8);
        __syncthreads();
        s5_tables(shm, (char*)SL(3), PF(6) + l * NG * NP, PF(7) + l * NG * NP, PF(8) + l * NG, PF(9) + (size_t)l * NG * NP * GC, PF(10) + (size_t)l * NG * NP * GC,
                  PF(11) + (size_t)l * NG * GC * NP, PF(12) + (size_t)l * NG * GC * NP);
        __syncthreads();
        norm_rows(xin, PF(2) + l * DM, modl, H);
        }
        xcd_barrier(gbar);
        REP(2) { ProbG1 pb{H, WinT, U, MI, 8}; gemm_phase(shm, pb); }
        xcd_barrier(gbar);
        REP(256) s5_phase(shm, U, Y, (const char*)SL(3), PF(13) + l * DM);
        REP(8) xc_gates_phase(shm, MI, XC, WfT, PF(17) + l * 4 * DM, PF(18) + l * DM, gpart);
        xcd_barrier(gbar);
        REP(4) { ProbGlu pb{Y, WgluT, Z, PF(15) + l * DM, rowss, 4}; gemm_phase(shm, pb); }
        xcd_barrier(gbar);
        REP(16) { ProbQkv pb{XC, MI, WqkvT, Q, Kb, V, 12}; gemm_phase(shm, pb); }
        xcd_barrier(gbar);
        REP(32) mlstm_phase(shm, Q, Kb, V, gpart, PF(23) + l * 4, PF(24) + l * 4, HC);
        xcd_barrier(gbar);
        { G2Args ga{H, WinT, Z, rowss, PF(16) + l * DM, HC, XC, PF(25) + l * DM, PF(26) + l * DM}; gemm2_phase(shm, ga); }
        xcd_barrier(gbar);
        REP(l == 0 ? 128 : 0) { ProbOut pb{Z, HC, WoutT, xin, OUTP, modl + 2 * DM, 4}; gemm_phase(shm, pb); }
        xcd_barrier(gbar);
    }
__global__ void __launch_bounds__(512, 2) mega(Params Pk) {
    extern __shared__ __attribute__((aligned(16))) unsigned char lds_raw[];
    {
        volatile LAS unsigned long long* pt = (volatile LAS unsigned long long*)((LAS char*)lds_raw + LDS_BYTES - 512);
        if (threadIdx.x == 0) {
            pt[0] = (unsigned long long)Pk.x;
            pt[1] = (unsigned long long)Pk.c;
            pt[2] = (unsigned long long)Pk.norm_gain;
            pt[3] = (unsigned long long)Pk.w_mod;
            pt[4] = (unsigned long long)Pk.b_mod;
            pt[5] = (unsigned long long)Pk.w_in;
            pt[6] = (unsigned long long)Pk.lam_re;
            pt[7] = (unsigned long long)Pk.lam_im;
            pt[8] = (unsigned long long)Pk.log_dt;
            pt[9] = (unsigned long long)Pk.sb_re;
            pt[10] = (unsigned long long)Pk.sb_im;
            pt[11] = (unsigned long long)Pk.sc_re;
            pt[12] = (unsigned long long)Pk.sc_im;
            pt[13] = (unsigned long long)Pk.ssm_d;
            pt[14] = (unsigned long long)Pk.w_glu;
            pt[15] = (unsigned long long)Pk.b_glu;
            pt[16] = (unsigned long long)Pk.ssm_og;
            pt[17] = (unsigned long long)Pk.conv_w;
            pt[18] = (unsigned long long)Pk.conv_b;
            pt[19] = (unsigned long long)Pk.wq;
            pt[20] = (unsigned long long)Pk.wk;
            pt[21] = (unsigned long long)Pk.wv;
            pt[22] = (unsigned long long)Pk.w_gates;
            pt[23] = (unsigned long long)Pk.b_ig;
            pt[24] = (unsigned long long)Pk.b_fg;
            pt[25] = (unsigned long long)Pk.m_ng;
            pt[26] = (unsigned long long)Pk.m_skip;
            pt[27] = (unsigned long long)Pk.w_out;
            pt[28] = (unsigned long long)Pk.final_gain;
            pt[29] = (unsigned long long)Pk.out; pt[30] = (unsigned long long)Pk.ws;
        }
    }
    __syncthreads();
    LAS char* shm = (LAS char*)lds_raw;
    float* ldsf = (float*)lds_raw + HALF * HALF_FLOATS;
    volatile LAS unsigned* bst = (volatile LAS unsigned*)(shm + LDS_BYTES - 16);
    if (threadIdx.x < 4) bst[threadIdx.x] = 0u;
    __syncthreads();
    const XcdBarrier gbar = xcd_barrier_post((unsigned*)((char*)ldptr(shm, 30) + SLOT * 7 + BAR_OFF), bst);
    REP(4096) mod_phase(shm, PF(1), PF(3), PF(4), mod);
    xcd_barrier(gbar);
    layer_body<0>(shm, gbar);
    layer_body<1>(shm, gbar);
    final_rows(OUTP, PF(28));
}

#undef WSB
#undef SL
#undef S7
#undef WinT
#undef WgluT
#undef WqkvT
#undef WoutT
#undef mod
#undef gpart
#undef WfT
#undef rowss
#undef OUTP
#undef H
#undef U
#undef Y
#undef Z
#undef XC
#undef MI
#undef Q
#undef Kb
#undef V
#undef HC
extern "C" void kernel_launch(void* const* d_in, const int* in_sizes, int n_in, void* d_out, int out_size, void* d_ws, size_t ws_size, hipStream_t stream) {
    static int grid_blocks = 0;
    if (!grid_blocks) {
        int dev = 0, cus = 0, per_cu = 0;
        (void)hipGetDevice(&dev);
        (void)hipDeviceGetAttribute(&cus, hipDeviceAttributeMultiprocessorCount, dev);
        (void)hipFuncSetAttribute((const void*)mega, hipFuncAttributeMaxDynamicSharedMemorySize, LDS_BYTES);
        (void)hipOccupancyMaxActiveBlocksPerMultiprocessor(&per_cu, (const void*)mega, 512, LDS_BYTES);
        grid_blocks = cus;
        fprintf(stderr, "mega: cus=%d occupancy per_cu=%d grid=%d\n", cus, per_cu, grid_blocks);
    }
    (void)hipMemsetAsync((char*)d_ws + SLOT * 7 + BAR_OFF, 0, XCD_BAR_WORDS * 4, stream);
    Params P{};
    const float** pp = (const float**)&P;
    for (int i = 0; i < 29; ++i) pp[i] = (const float*)d_in[i];
    P.out = (float*)d_out; P.ws = (char*)d_ws;
    void* args[] = {&P};
    hipError_t e = hipLaunchCooperativeKernel((const void*)mega, dim3(grid_blocks), dim3(512), args, LDS_BYTES, stream);
    if (e != hipSuccess) fprintf(stderr, "cooperative launch failed: %s (grid %d)\n", hipGetErrorString(e), grid_blocks);
}
```

```cpp
#include <hip/hip_runtime.h>
#include <cstdio>
#include <cstdint>
#include <hip/hip_cooperative_groups.h>
namespace cg = cooperative_groups;

#ifndef REPMASK
#define REPMASK 0
#endif
typedef unsigned short bf16_t;
#define DEV __device__ __forceinline__

constexpr int BATCH = 8, SEQ = 2048, DM = 1024, MTOK = BATCH * SEQ;
constexpr int NG = 64, NP = 64, GC = 16, NH = 4, DH = 256, CHUNK = 64, INC = 5120;
constexpr float EPS = 1e-6f;

DEV int opaque_tid() { int t = threadIdx.x; asm volatile("" : "+v"(t)); return t; }
#define TIDH (opaque_tid() & 255)
#define HALF (opaque_tid() >> 8)
DEV float bf2f(bf16_t v) { return __uint_as_float(((unsigned)v) << 16); }
typedef __bf16 bf16n2 __attribute__((ext_vector_type(2)));
typedef float f32n2 __attribute__((ext_vector_type(2)));
DEV bf16_t f2bf(float f) { __bf16 b = (__bf16)f; return __builtin_bit_cast(unsigned short, b); }
DEV unsigned pk2(float lo, float hi) { f32n2 v = {lo, hi}; bf16n2 b = __builtin_convertvector(v, bf16n2); return __builtin_bit_cast(unsigned, b); }
DEV float sigmoidf_(float x) { return 1.f / (1.f + __expf(-x)); }
DEV float siluf_(float x) { return x / (1.f + __expf(-x)); }
DEV float geluf_(float x) { float t = 0.7978845608028654f * (x + 0.044715f * x * x * x); return 0.5f * x * (1.f + tanhf(t)); }
DEV float logsigmoidf_(float x) { return fminf(x, 0.f) - log1pf(__expf(-fabsf(x))); }

DEV float wave_sum(float v) {
#pragma unroll
    for (int o = 1; o < 64; o <<= 1) v += __shfl_xor(v, o);
    return v;
}
DEV float block_sum256(float v, float* red) {
    v = wave_sum(v);
    __syncthreads();
    if ((TIDH & 63) == 0) red[TIDH >> 6] = v;
    __syncthreads();
    return red[0] + red[1] + red[2] + red[3];
}

DEV void k_mod(int vb, float* ldsf, const float* c, const float* w_mod, const float* b_mod, float* mod) {
    float (*sc)[DM] = (float (*)[DM])ldsf;
    const int l = vb / 12, n = (vb % 12) * 256 + TIDH;
    __syncthreads();
    for (int i = TIDH; i < BATCH * DM; i += 256) sc[i / DM][i % DM] = siluf_(c[i]);
    __syncthreads();
    float acc[BATCH];
#pragma unroll
    for (int b = 0; b < BATCH; ++b) acc[b] = 0.f;
    const float* W = w_mod + (size_t)l * DM * 3 * DM;
    for (int k = 0; k < DM; ++k) {
        float w = W[(size_t)k * 3 * DM + n];
#pragma unroll
        for (int b = 0; b < BATCH; ++b) acc[b] += sc[b][k] * w;
    }
#pragma unroll
    for (int b = 0; b < BATCH; ++b) mod[((size_t)l * BATCH + b) * 3 * DM + n] = acc[b] + b_mod[l * 3 * DM + n];
}

DEV void k_norm_mod(int vb, float* red, const float* x, const float* gain, const float* mod  , bf16_t* h) {
    const int m = vb, b = m / SEQ, t = TIDH;
    const float4 v = ((const float4*)(x + (size_t)m * DM))[t];
    float ss = v.x * v.x + v.y * v.y + v.z * v.z + v.w * v.w;
    ss = block_sum256(ss, red);
    const float rstd = rsqrtf(ss * (1.f / DM) + EPS);
    const float* shift = mod + (size_t)b * 3 * DM;
    const float* scale = shift + DM;
    float xv[4] = {v.x, v.y, v.z, v.w};
#pragma unroll
    for (int i = 0; i < 4; ++i) {
        int n = t * 4 + i;
        float y = xv[i] * rstd * gain[n] * (1.f + scale[n]) + shift[n];
        h[(size_t)m * DM + n] = f2bf(y);
    }
}

DEV void k_s5(int item, float* ldsf, const bf16_t* u, bf16_t* y, const float* lam_re, const float* lam_im, const float* log_dt,
                                           const float* b_re, const float* b_im, const float* c_re, const float* c_im, const float* dskip) {
    const int tid_ = opaque_tid();
    float (*part)[17] = (float (*)[17])(ldsf + (tid_ >> 6) * 64 * 17);
    const int g = item & 63, b = item >> 6, p = tid_ & 63;
    const double lr = lam_re[g * NP + p], li = lam_im[g * NP + p], dt = exp((double)log_dt[g]);
    const double er = exp(lr * dt);
    const double ard = er * cos(li * dt), aid = er * sin(li * dt);
    const double dr = ard - 1.0, di = aid, den = lr * lr + li * li;
    const double cr = (dr * lr + di * li) / den, ci = (di * lr - dr * li) / den;
    float bbr[16], bbi[16], ccr[16], cci[16];
#pragma unroll
    for (int c = 0; c < 16; ++c) {
        const double br = b_re[(g * NP + p) * GC + c], bi = b_im[(g * NP + p) * GC + c];
        bbr[c] = (float)(cr * br - ci * bi); bbi[c] = (float)(cr * bi + ci * br);
        ccr[c] = c_re[(g * GC + c) * NP + p]; cci[c] = c_im[(g * GC + c) * NP + p];
    }
    const float ar = (float)ard, ai = (float)aid;
    const float dsk = dskip[g * GC + (p & 15)];
    float sr = 0.f, si = 0.f;
    for (int t = 0; t < SEQ; ++t) {
        const bf16_t* up = u + (size_t)(b * SEQ + t) * DM + g * GC;
        const uint4 u0 = *(const uint4*)up, u1 = *(const uint4*)(up + 8);
        float uf[16];
        uf[0] = bf2f(u0.x & 0xffff); uf[1] = bf2f(u0.x >> 16); uf[2] = bf2f(u0.y & 0xffff); uf[3] = bf2f(u0.y >> 16);
        uf[4] = bf2f(u0.z & 0xffff); uf[5] = bf2f(u0.z >> 16); uf[6] = bf2f(u0.w & 0xffff); uf[7] = bf2f(u0.w >> 16);
        uf[8] = bf2f(u1.x & 0xffff); uf[9] = bf2f(u1.x >> 16); uf[10] = bf2f(u1.y & 0xffff); uf[11] = bf2f(u1.y >> 16);
        uf[12] = bf2f(u1.z & 0xffff); uf[13] = bf2f(u1.z >> 16); uf[14] = bf2f(u1.w & 0xffff); uf[15] = bf2f(u1.w >> 16);
        float bur = 0.f, bui = 0.f;
#pragma unroll
        for (int c = 0; c < 16; ++c) { bur += bbr[c] * uf[c]; bui += bbi[c] * uf[c]; }
        const float nr = ar * sr - ai * si + bur, ni = ar * si + ai * sr + bui;
        sr = nr; si = ni;
#pragma unroll
        for (int c = 0; c < 16; ++c) part[p][c] = ccr[c] * sr - cci[c] * si;
        asm volatile("s_waitcnt lgkmcnt(0)" ::: "memory");
        float s = 0.f;
#pragma unroll
        for (int k = 0; k < 16; ++k) s += part[(p >> 4) * 16 + k][p & 15];
        s += __shfl_xor(s, 16); s += __shfl_xor(s, 32);
        if (p < 16) {
            const float yv = s + dsk * bf2f(up[p]);
            y[(size_t)(b * SEQ + t) * DM + g * GC + p] = f2bf(geluf_(yv));
        }
        asm volatile("s_waitcnt lgkmcnt(0)" ::: "memory");
    }
}

DEV void k_ssm_post(int vb, float* red, bf16_t* z, const bf16_t* sg, const float* gain) {
    const int m = vb, t = TIDH;
    float zv[4]; float ss = 0.f;
#pragma unroll
    for (int i = 0; i < 4; ++i) { zv[i] = bf2f(z[(size_t)m * DM + t * 4 + i]); ss += zv[i] * zv[i]; }
    ss = block_sum256(ss, red);
    const float rstd = rsqrtf(ss * (1.f / DM) + EPS);
#pragma unroll
    for (int i = 0; i < 4; ++i) {
        const int n = t * 4 + i;
        z[(size_t)m * DM + n] = f2bf(zv[i] * rstd * gain[n] * siluf_(bf2f(sg[(size_t)m * DM + n])));
    }
}

DEV float conv_xc(const bf16_t* mi, int m, int n, const float* cw, const float* cb) {
    const int t = m % SEQ;
    float acc = cb[n];
#pragma unroll
    for (int j = 0; j < 4; ++j) {
        const int tt = t - 3 + j;
        if (tt >= 0) acc += bf2f(mi[(size_t)(m - 3 + j) * DM + n]) * cw[j * DM + n];
    }
    return siluf_(acc);
}
DEV void k_conv(int vb, const bf16_t* mi, bf16_t* xc, const float* cw, const float* cb) {
    const size_t idx = (size_t)vb * 256 + TIDH;
    const int m = (int)(idx / DM), n = (int)(idx % DM);
    xc[idx] = f2bf(conv_xc(mi, m, n, cw, cb));
}

DEV void k_gates(int vb, float* ldsf, const bf16_t* q, const bf16_t* k, const bf16_t* v, const float* wg  , const float* bi, const float* bfg,
                                               float* ipre, float* logf) {
    float (*red)[8] = (float (*)[8])ldsf;
    const int m = vb, t = TIDH;
    __syncthreads();
    float acc[8];
#pragma unroll
    for (int j = 0; j < 8; ++j) acc[j] = 0.f;
    for (int e = t; e < 3 * DM; e += 256) {
        const bf16_t* src = (e < DM) ? q : (e < 2 * DM ? k : v);
        const float xv = bf2f(src[(size_t)m * DM + (e & (DM - 1))]);
#pragma unroll
        for (int j = 0; j < 8; ++j) acc[j] += xv * wg[e * 8 + j];
    }
#pragma unroll
    for (int j = 0; j < 8; ++j) acc[j] = wave_sum(acc[j]);
    if ((t & 63) == 0) {
#pragma unroll
        for (int j = 0; j < 8; ++j) red[t >> 6][j] = acc[j];
    }
    __syncthreads();
    if (t < 8) {
        const float s = red[0][t] + red[1][t] + red[2][t] + red[3][t];
        if (t < 4) ipre[(size_t)m * 4 + t] = s + bi[t];
        else logf[(size_t)m * 4 + (t - 4)] = logsigmoidf_(s + bfg[t - 4]);
    }
}

DEV void k_mlstm(int vb, float* ldsf, const bf16_t* q, const bf16_t* k, const bf16_t* v, const float* ipre, const float* logf, bf16_t* hc) {
    float (*Cs)[257] = (float (*)[257])ldsf;
    float (*St)[65] = (float (*)[65])(ldsf + 32 * 257);
    float* nvec = ldsf + 32 * 257 + 64 * 65;
    float* bcum = nvec + 256; float* ig = bcum + 64; float* mt = ig + 64; float* winter = mt + 64; float* ws_ = winter + 64; float* hden = ws_ + 64;
    float* sc = hden + 64;
    const int tid = TIDH;
    const int vs = vb & 7, h = (vb >> 3) & 3, b = vb >> 5;
    __syncthreads();
    for (int i = tid; i < 32 * 257; i += 256) (&Cs[0][0])[i] = 0.f;
    nvec[tid] = 0.f;
    if (tid == 0) sc[0] = 0.f;
    __syncthreads();
    const size_t base = (size_t)b * SEQ * DM + h * DH;
    for (int j = 0; j < SEQ / CHUNK; ++j) {
        const size_t cb = base + (size_t)j * CHUNK * DM;
        const int m0 = b * SEQ + j * CHUNK;
        if (tid < 64) {
            ig[tid] = ipre[(size_t)(m0 + tid) * 4 + h];
            ws_[tid] = logf[(size_t)(m0 + tid) * 4 + h];
        }
        __syncthreads();
        if (tid < 64) { float s = 0.f; for (int i = 0; i <= tid; ++i) s += ws_[i]; bcum[tid] = s; }
        __syncthreads();
        const float m_prev = sc[0];
        if (tid < 64) {
            const float m_inter = bcum[tid] + m_prev;
            float mx = -INFINITY;
            for (int s = 0; s <= tid; ++s) mx = fmaxf(mx, bcum[tid] - bcum[s] + ig[s]);
            const float m = fmaxf(m_inter, mx);
            mt[tid] = m; winter[tid] = __expf(m_inter - m);
        }
        __syncthreads();
        for (int idx = tid; idx < 4096; idx += 256) {
            const int t = idx >> 6, s = idx & 63;
            float r = 0.f;
            if (s <= t) {
                const bf16_t* qp = q + cb + (size_t)t * DM; const bf16_t* kp = k + cb + (size_t)s * DM;
                float dot = 0.f;
                for (int d = 0; d < DH; d += 8) {
                    const uint4 qa = *(const uint4*)(qp + d), ka = *(const uint4*)(kp + d);
                    dot += bf2f(qa.x & 0xffff) * bf2f(ka.x & 0xffff) + bf2f(qa.x >> 16) * bf2f(ka.x >> 16);
                    dot += bf2f(qa.y & 0xffff) * bf2f(ka.y & 0xffff) + bf2f(qa.y >> 16) * bf2f(ka.y >> 16);
                    dot += bf2f(qa.z & 0xffff) * bf2f(ka.z & 0xffff) + bf2f(qa.z >> 16) * bf2f(ka.z >> 16);
                    dot += bf2f(qa.w & 0xffff) * bf2f(ka.w & 0xffff) + bf2f(qa.w >> 16) * bf2f(ka.w >> 16);
                }
                r = dot * __expf(bcum[t] - bcum[s] + ig[s] - mt[t]);
            }
            St[t][s] = r;
        }
        __syncthreads();
        if (tid < 64) {
            const bf16_t* qp = q + cb + (size_t)tid * DM;
            float dn = 0.f;
            for (int d = 0; d < DH; ++d) dn += nvec[d] * bf2f(qp[d]);
            float sm = 0.f;
            for (int s = 0; s < 64; ++s) sm += St[tid][s];
            const float den = winter[tid] * dn + sm;
            hden[tid] = fmaxf(fabsf(den), __expf(-mt[tid]));
        }
        __syncthreads();
        for (int idx = tid; idx < 2048; idx += 256) {
            const int t = idx >> 5, vv = idx & 31;
            const bf16_t* qp = q + cb + (size_t)t * DM;
            float a = 0.f;
            for (int d = 0; d < DH; ++d) a += Cs[vv][d] * bf2f(qp[d]);
            float s2 = 0.f;
            for (int s = 0; s < 64; ++s) s2 += St[t][s] * bf2f(v[cb + (size_t)s * DM + vs * 32 + vv]);
            const float num = winter[t] * a + s2;
            hc[cb + (size_t)t * DM + vs * 32 + vv] = f2bf(num / hden[t]);
        }
        __syncthreads();
        const float b_tot = bcum[63];
        if (tid < 64) ws_[tid] = b_tot - bcum[tid] + ig[tid];
        __syncthreads();
        if (tid == 0) {
            float mx = b_tot + m_prev;
            for (int s = 0; s < 64; ++s) mx = fmaxf(mx, ws_[s]);
            sc[1] = __expf(b_tot + m_prev - mx); sc[0] = mx;
        }
        __syncthreads();
        const float m_next = sc[0], decay = sc[1];
        float myw = 0.f;
        if (tid < 64) myw = __expf(ws_[tid] - m_next);
        __syncthreads();
        if (tid < 64) ws_[tid] = myw;
        __syncthreads();
        for (int idx = tid; idx < 32 * 256; idx += 256) {
            const int vv = idx >> 8, d = idx & 255;
            float a = 0.f;
            for (int s = 0; s < 64; ++s) a += ws_[s] * bf2f(v[cb + (size_t)s * DM + vs * 32 + vv]) * bf2f(k[cb + (size_t)s * DM + d]);
            Cs[vv][d] = decay * Cs[vv][d] + a;
        }
        {
            float a = 0.f;
            for (int s = 0; s < 64; ++s) a += ws_[s] * bf2f(k[cb + (size_t)s * DM + tid]);
            nvec[tid] = decay * nvec[tid] + a;
        }
        __syncthreads();
    }
}

DEV void k_mlstm_post(int vb, bf16_t* hc, const bf16_t* mo, const bf16_t* mg, const bf16_t* mi, const float* cw, const float* cb,
                                                    const float* ngain, const float* skip) {
    const int m = vb, t = TIDH;
    float hv[4]; float s = 0.f;
#pragma unroll
    for (int i = 0; i < 4; ++i) {
        const size_t o = (size_t)m * DM + t * 4 + i;
        hv[i] = bf2f(hc[o]) * sigmoidf_(bf2f(mo[o])); s += hv[i];
    }
    const float mu = wave_sum(s) * (1.f / DH);
    float s2 = 0.f;
#pragma unroll
    for (int i = 0; i < 4; ++i) { hv[i] -= mu; s2 += hv[i] * hv[i]; }
    const float rstd = rsqrtf(wave_sum(s2) * (1.f / DH) + EPS);
#pragma unroll
    for (int i = 0; i < 4; ++i) {
        const int n = t * 4 + i; const size_t o = (size_t)m * DM + n;
        const float xc = conv_xc(mi, m, n, cw, cb);
        const float hn = hv[i] * rstd * ngain[n] + skip[n] * xc;
        hc[o] = f2bf(hn * siluf_(bf2f(mg[o])));
    }
}

DEV void k_final(int vb, float* red, float* x, const float* gain) {
    const int m = vb, t = TIDH;
    float4 v = ((float4*)(x + (size_t)m * DM))[t];
    float ss = v.x * v.x + v.y * v.y + v.z * v.z + v.w * v.w;
    ss = block_sum256(ss, red);
    const float rstd = rsqrtf(ss * (1.f / DM) + EPS);
    const float4 g = ((const float4*)gain)[t];
    v.x *= rstd * g.x; v.y *= rstd * g.y; v.z *= rstd * g.z; v.w *= rstd * g.w;
    ((float4*)(x + (size_t)m * DM))[t] = v;
}


#define LAS __attribute__((address_space(3)))
typedef short bf16x8 __attribute__((ext_vector_type(8)));
typedef float f32x4 __attribute__((ext_vector_type(4)));
#define WAIT_V(n) asm volatile("s_waitcnt vmcnt(" #n ")" ::: "memory")
#define WAIT_L(n) asm volatile("s_waitcnt lgkmcnt(" #n ")" ::: "memory")
#define SCHED() __builtin_amdgcn_sched_barrier(0)

DEV int lds_byte(int r, int c) { int st = (r >> 4) * 2 + (c >> 5), ob = (r & 15) * 64 + (c & 31) * 2; return st * 1024 + (ob ^ (((ob >> 9) & 1) << 5)); }
DEV void stage_rc(int b, int& R, int& C) { int st = b >> 10, sb = b & 1023, swz = sb ^ (((sb >> 9) & 1) << 5); R = (st >> 1) * 16 + swz / 64; C = (st & 1) * 32 + (swz % 64) / 2; }
template <class T> DEV T* sel3(int w, T* p0, T* p1, T* p2) { return p0 + ((w >= 1) ? (p1 - p0) : 0) + ((w >= 2) ? (p2 - p1) : 0); }
DEV void unpack8(const uint4 v, float* f) {
    f[0] = bf2f((bf16_t)(v.x & 0xffff)); f[1] = bf2f((bf16_t)(v.x >> 16)); f[2] = bf2f((bf16_t)(v.y & 0xffff)); f[3] = bf2f((bf16_t)(v.y >> 16));
    f[4] = bf2f((bf16_t)(v.z & 0xffff)); f[5] = bf2f((bf16_t)(v.z >> 16)); f[6] = bf2f((bf16_t)(v.w & 0xffff)); f[7] = bf2f((bf16_t)(v.w >> 16));
}
DEV uint4 pack8(const float* f) { return make_uint4(pk2(f[0], f[1]), pk2(f[2], f[3]), pk2(f[4], f[5]), pk2(f[6], f[7])); }
DEV uint2 pack4(f32x4 v) { uint2 r; r.x = pk2(v[0], v[1]); r.y = pk2(v[2], v[3]); return r; }

struct GemmCtx { int wid, lane, wr, wc, fr, fq; int sR[4], sC[4]; };
DEV GemmCtx gemm_ctx() {
    GemmCtx c; const int tid = opaque_tid();
    c.wid = __builtin_amdgcn_readfirstlane(tid >> 6); c.lane = tid & 63; c.wr = c.wid >> 2; c.wc = c.wid & 3; c.fr = c.lane & 15; c.fq = c.lane >> 4;
#pragma unroll
    for (int i = 0; i < 4; ++i) stage_rc(c.wid * 1024 + i * 8192 + c.lane * 16, c.sR[i], c.sC[i]);
    return c;
}
DEV void gemm_mainloop(LAS char* shm, const GemmCtx& c, const bf16_t* A1row, const bf16_t* A2row, int ktsplit, int lda, const bf16_t* Bb, int ldb, int nt, f32x4 (&acc)[8][4]) {
    constexpr int TILE_B = 256 * 64 * 2, STAGE_B = 2 * TILE_B;
    const int wid = c.wid, wr = c.wr, wc = c.wc, fr = c.fr, fq = c.fq;
    unsigned voA[4], voB[4];
#pragma unroll
    for (int i = 0; i < 4; ++i) { voA[i] = (unsigned)(c.sR[i] * lda + c.sC[i]) * 2u; voB[i] = (unsigned)(c.sR[i] * ldb + c.sC[i]) * 2u; asm volatile("" : "+v"(voA[i]), "+v"(voB[i])); }
#define GLDS_STAGE(buf, kt) do { const char* Ak_ = (const char*)(((kt) < ktsplit) ? (A1row + (kt) * 64) : (A2row + ((kt) - ktsplit) * 64)); const char* Bk_ = (const char*)(Bb + (kt) * 64); \
        _Pragma("unroll") for (int i = 0; i < 4; ++i) { \
            __builtin_amdgcn_global_load_lds((const unsigned*)(Ak_ + voA[i]), (LAS unsigned*)(shm + (buf) * STAGE_B + wid * 1024 + i * 8192), 16, 0, 0); \
            __builtin_amdgcn_global_load_lds((const unsigned*)(Bk_ + voB[i]), (LAS unsigned*)(shm + (buf) * STAGE_B + TILE_B + wid * 1024 + i * 8192), 16, 0, 0); } } while (0)
#pragma unroll
    for (int m = 0; m < 8; ++m)
#pragma unroll
        for (int n = 0; n < 4; ++n) acc[m][n] = (f32x4){0.f, 0.f, 0.f, 0.f};
    GLDS_STAGE(0, 0); WAIT_V(0); __syncthreads();
#pragma nounroll
    for (int kt = 0; kt < nt; ++kt) {
        const int cur = kt & 1;
        if (kt + 1 < nt) GLDS_STAGE(cur ^ 1, kt + 1);
#pragma unroll
        for (int ks = 0; ks < 2; ++ks) {
            bf16x8 At[8], Bf[4];
#pragma unroll
            for (int m = 0; m < 8; ++m) At[m] = *(const LAS bf16x8*)(shm + cur * STAGE_B + lds_byte(wr * 128 + m * 16 + fr, ks * 32 + fq * 8));
#pragma unroll
            for (int n = 0; n < 4; ++n) Bf[n] = *(const LAS bf16x8*)(shm + cur * STAGE_B + TILE_B + lds_byte(wc * 64 + n * 16 + fr, ks * 32 + fq * 8));
#pragma unroll
            for (int m = 0; m < 8; ++m)
#pragma unroll
                for (int n = 0; n < 4; ++n) acc[m][n] = __builtin_amdgcn_mfma_f32_16x16x32_bf16(Bf[n], At[m], acc[m][n], 0, 0, 0);
            SCHED();
        }
        WAIT_V(0); __syncthreads();
    }
#undef GLDS_STAGE
}
DEV void tile_map(int t, int nN, int& pm, int& pn) {
    const int base = t & ~255, loc = t & 255;
    const int w = base + (loc & 7) * 32 + (loc >> 3);
    const int nig = 8 * nN, gid = w / nig;
    pm = gid * 8 + (w % nig) % 8; pn = (w % nig) / 8;
}
template <class Prob>
DEV void gemm_phase(LAS char* shm, const Prob& pb) {
    const GemmCtx c = gemm_ctx();
    const int nN = pb.nN, ntiles = 64 * nN;
    for (int t = blockIdx.x; t < ntiles; t += gridDim.x) {
        int pm, pn; tile_map(t, nN, pm, pn);
        const int brow = pm * 256, bcol = pn * 256;
        f32x4 acc[8][4];
        gemm_mainloop(shm, c, pb.a1(pn) + (long)brow * Prob::lda, pb.a2(pn) + (long)brow * Prob::lda, Prob::ktsplit, Prob::lda, pb.bptr(pn), Prob::ldb, Prob::K / 64, acc);
        pb.epi_begin(shm, c, pn, brow);
#pragma unroll
        for (int m = 0; m < 8; ++m)
#pragma unroll
            for (int n = 0; n < 4; ++n) pb.epi(pn, brow + c.wr * 128 + m * 16 + c.fr, bcol + c.wc * 64 + n * 16 + c.fq * 4, acc[m][n]);
        pb.epi_end(c, pn, brow, acc);
    }
}

struct ProbG1 {
    static constexpr int K = 1024, lda = 1024, ldb = 1024, ktsplit = 1 << 20;
    const bf16_t* H; const bf16_t* Wt; bf16_t* U; bf16_t* MI; int nN;
    DEV const bf16_t* a1(int pn) const { return H; }
    DEV const bf16_t* a2(int pn) const { return H; }
    DEV const bf16_t* bptr(int pn) const { return Wt + (long)((pn < 4) ? pn * 256 : 2048 + (pn - 4) * 256) * 1024; }
    DEV void epi_begin(LAS char*, const GemmCtx&, int, int) const {}
    DEV void epi(int pn, int row, int col, f32x4 v) const { bf16_t* C = (pn < 4) ? U : MI; *(uint2*)(C + (size_t)row * DM + (col & 1023)) = pack4(v); }
    DEV void epi_end(const GemmCtx&, int, int, f32x4 (&)[8][4]) const {}
};
struct ProbGlu {
    static constexpr int K = 1024, lda = 1024, ldb = 1024, ktsplit = 1 << 20;
    const bf16_t* Y; const bf16_t* Wt; bf16_t* Z; const float* bias; float* rowss; int nN;
    DEV const bf16_t* a1(int pn) const { return Y; }
    DEV const bf16_t* a2(int pn) const { return Y; }
    DEV const bf16_t* bptr(int pn) const { return Wt + (long)pn * 256 * 1024; }
    DEV void epi_begin(LAS char*, const GemmCtx&, int, int) const {}
    DEV void epi(int pn, int row, int col, f32x4 v) const {}
    DEV void epi_end(const GemmCtx& c0, int pn, int brow, f32x4 (&acc)[8][4]) const {
        struct { int fr, fq, wr, wc; } c = {c0.fr, c0.fq, c0.wr, c0.wc};
        asm volatile("" : "+v"(c.fr), "+v"(c.fq));
#pragma unroll
        for (int m = 0; m < 8; ++m) {
            SCHED();
            const int row = brow + c.wr * 128 + m * 16 + c.fr;
            float ss = 0.f;
#pragma unroll
            for (int n = 0; n < 4; ++n) {
                const int col = pn * 256 + c.wc * 64 + n * 16 + c.fq * 4;
                const uint2 yv = *(const uint2*)(Y + (size_t)row * DM + col);
                const float4 b = *(const float4*)(bias + col);
                f32x4 o;
                o[0] = bf2f(yv.x & 0xffff) * sigmoidf_(acc[m][n][0] + b.x); o[1] = bf2f(yv.x >> 16) * sigmoidf_(acc[m][n][1] + b.y);
                o[2] = bf2f(yv.y & 0xffff) * sigmoidf_(acc[m][n][2] + b.z); o[3] = bf2f(yv.y >> 16) * sigmoidf_(acc[m][n][3] + b.w);
                const uint2 pk = pack4(o);
                *(uint2*)(Z + (size_t)row * DM + col) = pk;
                const float r0 = bf2f(pk.x & 0xffff), r1 = bf2f(pk.x >> 16), r2 = bf2f(pk.y & 0xffff), r3 = bf2f(pk.y >> 16);
                ss += r0 * r0 + r1 * r1 + r2 * r2 + r3 * r3;
            }
            ss += __shfl_xor(ss, 16); ss += __shfl_xor(ss, 32);
            if (c.fq == 0) rowss[(size_t)(pn * 4 + c.wc) * MTOK + row] = ss;
        }
    }
};
struct ProbQkv {
    static constexpr int K = 256, lda = 1024, ldb = 256, ktsplit = 1 << 20;
    const bf16_t* XC; const bf16_t* MI; const bf16_t* Wt; bf16_t* Q; bf16_t* Kk; bf16_t* V; int nN;
    DEV const bf16_t* a1(int pn) const { return ((pn >> 2) == 2 ? MI : XC) + (pn & 3) * 256; }
    DEV const bf16_t* a2(int pn) const { return a1(pn); }
    DEV const bf16_t* bptr(int pn) const { return Wt + (long)pn * 256 * 256; }
    DEV void epi_begin(LAS char*, const GemmCtx&, int, int) const {}
    DEV void epi(int pn, int row, int col, f32x4 v) const {
        const int which = pn >> 2; bf16_t* C = sel3(which, Q, Kk, V);
        if (which == 1) { v[0] *= 0.0625f; v[1] *= 0.0625f; v[2] *= 0.0625f; v[3] *= 0.0625f; }
        *(uint2*)(C + (size_t)row * DM + (col & 1023)) = pack4(v);
    }
    DEV void epi_end(const GemmCtx&, int, int, f32x4 (&)[8][4]) const {}
};
struct ProbOut {
    static constexpr int K = 2048, lda = 1024, ldb = 2048, ktsplit = 16;
    const bf16_t* A1; const bf16_t* A2; const bf16_t* Wt; const float* xin; float* xout; const float* gate; int nN;
    DEV const bf16_t* a1(int pn) const { return A1; }
    DEV const bf16_t* a2(int pn) const { return A2; }
    DEV const bf16_t* bptr(int pn) const { return Wt + (long)pn * 256 * 2048; }
    DEV void epi_begin(LAS char*, const GemmCtx&, int, int) const {}
    DEV void epi(int pn, int row, int col, f32x4 v) const {
        const int b = row / SEQ;
        const float4 xi = *(const float4*)(xin + (size_t)row * DM + col);
        const float4 g = *(const float4*)(gate + (size_t)b * 3 * DM + col);
        float4 o; o.x = xi.x + g.x * v[0]; o.y = xi.y + g.y * v[1]; o.z = xi.z + g.z * v[2]; o.w = xi.w + g.w * v[3];
        *(float4*)(xout + (size_t)row * DM + col) = o;
    }
    DEV void epi_end(const GemmCtx&, int, int, f32x4 (&)[8][4]) const {}
};

struct G2Args {
    const bf16_t* H; const bf16_t* Wt;
    bf16_t* Z; const float* rowss; const float* og;
    bf16_t* HC; const bf16_t* XC; const float* ngain; const float* skip;
};
DEV void gemm2_phase(LAS char* shm, const G2Args& g) {
    const GemmCtx c = gemm_ctx();
    int efr, efq;
    LAS float* rst = (LAS float*)(shm + 131072);
    LAS float* red = (LAS float*)(shm + 131072 + 1024);
    for (int u = blockIdx.x; u < 512; u += gridDim.x) {
        f32x4 acc[8][4];
        if (u < 256) {
            int pm, pn; tile_map(u, 4, pm, pn);
            const int brow = pm * 256, bcol = pn * 256;
            gemm_mainloop(shm, c, g.H + (long)brow * DM, g.H, 1 << 20, DM, g.Wt + (long)(1024 + bcol) * DM, DM, 16, acc);
            efr = c.fr; efq = c.fq; asm volatile("" : "+v"(efr), "+v"(efq));
            { const int tid = c.wid * 64 + c.lane;
              if (tid < 256) { float s_ = 0.f;
#pragma unroll
                  for (int p_ = 0; p_ < 16; ++p_) s_ += g.rowss[(size_t)p_ * MTOK + brow + tid];
                  rst[tid] = rsqrtf(s_ * (1.f / DM) + EPS); } }
            __syncthreads();
#pragma unroll
            for (int m = 0; m < 8; ++m) {
                SCHED();
                const int rl = c.wr * 128 + m * 16 + efr, row = brow + rl;
                const float rs = rst[rl];
#pragma unroll
                for (int n = 0; n < 4; ++n) {
                    const int col = bcol + c.wc * 64 + n * 16 + efq * 4;
                    const uint2 zv = *(const uint2*)(g.Z + (size_t)row * DM + col);
                    const float4 gn = *(const float4*)(g.og + col);
                    f32x4 o;
                    o[0] = bf2f(zv.x & 0xffff) * rs * gn.x * siluf_(acc[m][n][0]); o[1] = bf2f(zv.x >> 16) * rs * gn.y * siluf_(acc[m][n][1]);
                    o[2] = bf2f(zv.y & 0xffff) * rs * gn.z * siluf_(acc[m][n][2]); o[3] = bf2f(zv.y >> 16) * rs * gn.w * siluf_(acc[m][n][3]);
                    *(uint2*)(g.Z + (size_t)row * DM + col) = pack4(o);
                }
            }
            __syncthreads();
        } else {
            int pm, hd; tile_map(u - 256, 4, pm, hd);
            const int brow = pm * 256, bcol = hd * 256;
            gemm_mainloop(shm, c, g.H + (long)brow * DM, g.H, 1 << 20, DM, g.Wt + (long)(3072 + bcol) * DM, DM, 16, acc);
            efr = c.fr; efq = c.fq; asm volatile("" : "+v"(efr), "+v"(efq));
        #pragma unroll
            for (int m = 0; m < 8; ++m) {
                SCHED();
                const int row = brow + c.wr * 128 + m * 16 + efr;
                float s_ = 0.f;
#pragma unroll
                for (int n = 0; n < 4; ++n) {
                    const int col = bcol + c.wc * 64 + n * 16 + efq * 4;
                    const uint2 hv = *(const uint2*)(g.HC + (size_t)row * DM + col);
                    acc[m][n][0] = bf2f(hv.x & 0xffff) * sigmoidf_(acc[m][n][0]); acc[m][n][1] = bf2f(hv.x >> 16) * sigmoidf_(acc[m][n][1]);
                    acc[m][n][2] = bf2f(hv.y & 0xffff) * sigmoidf_(acc[m][n][2]); acc[m][n][3] = bf2f(hv.y >> 16) * sigmoidf_(acc[m][n][3]);
                    s_ += (acc[m][n][0] + acc[m][n][1]) + (acc[m][n][2] + acc[m][n][3]);
                }
                s_ += __shfl_xor(s_, 16); s_ += __shfl_xor(s_, 32);
                if (efq == 0) red[c.wid * 128 + m * 16 + efr] = s_;
            }
            __syncthreads();
#pragma unroll
            for (int m = 0; m < 8; ++m) {
                SCHED();
                float tot = 0.f;
#pragma unroll
                for (int w2 = 0; w2 < 4; ++w2) tot += red[(c.wr * 4 + w2) * 128 + m * 16 + efr];
                const float mu = tot * (1.f / DH);
                float s_ = 0.f;
#pragma unroll
                for (int n = 0; n < 4; ++n)
#pragma unroll
                    for (int j = 0; j < 4; ++j) { acc[m][n][j] -= mu; s_ += acc[m][n][j] * acc[m][n][j]; }
                s_ += __shfl_xor(s_, 16); s_ += __shfl_xor(s_, 32);
                if (efq == 0) red[1024 + c.wid * 128 + m * 16 + efr] = s_;
            }
            __syncthreads();
#pragma unroll
            for (int m = 0; m < 8; ++m) {
                SCHED();
                const int row = brow + c.wr * 128 + m * 16 + efr;
                float tot = 0.f;
#pragma unroll
                for (int w2 = 0; w2 < 4; ++w2) tot += red[1024 + (c.wr * 4 + w2) * 128 + m * 16 + efr];
                const float rs = rsqrtf(tot * (1.f / DH) + EPS);
#pragma unroll
                for (int n = 0; n < 4; ++n) {
                    const int col = bcol + c.wc * 64 + n * 16 + efq * 4;
                    const uint2 xv = *(const uint2*)(g.XC + (size_t)row * DM + col);
                    const float4 gn = *(const float4*)(g.ngain + col), sk = *(const float4*)(g.skip + col);
                    f32x4 o;
                    o[0] = acc[m][n][0] * rs * gn.x + sk.x * bf2f(xv.x & 0xffff); o[1] = acc[m][n][1] * rs * gn.y + sk.y * bf2f(xv.x >> 16);
                    o[2] = acc[m][n][2] * rs * gn.z + sk.z * bf2f(xv.y & 0xffff); o[3] = acc[m][n][3] * rs * gn.w + sk.w * bf2f(xv.y >> 16);
                    *(uint2*)(g.HC + (size_t)row * DM + col) = pack4(o);
                }
            }
            gemm_mainloop(shm, c, g.H + (long)brow * DM, g.H, 1 << 20, DM, g.Wt + (long)(4096 + bcol) * DM, DM, 16, acc);
            efr = c.fr; efq = c.fq; asm volatile("" : "+v"(efr), "+v"(efq));
#pragma unroll
            for (int m = 0; m < 8; ++m) {
                SCHED();
                const int row = brow + c.wr * 128 + m * 16 + efr;
#pragma unroll
                for (int n = 0; n < 4; ++n) {
                    const int col = bcol + c.wc * 64 + n * 16 + efq * 4;
                    const uint2 hv = *(const uint2*)(g.HC + (size_t)row * DM + col);
                    f32x4 o;
                    o[0] = bf2f(hv.x & 0xffff) * siluf_(acc[m][n][0]); o[1] = bf2f(hv.x >> 16) * siluf_(acc[m][n][1]);
                    o[2] = bf2f(hv.y & 0xffff) * siluf_(acc[m][n][2]); o[3] = bf2f(hv.y >> 16) * siluf_(acc[m][n][3]);
                    *(uint2*)(g.HC + (size_t)row * DM + col) = pack4(o);
                }
            }
        }
    }
}

DEV void transpose_item(const float* W, int ldw, int ncols, bf16_t* WT, int ldwt, LAS float* scr, int item, int lane) {
    const int nblk = ncols / 64, kb = item / nblk, nb = item % nblk, k0 = 64 * kb, n0 = 64 * nb;
    float4 v[16];
#pragma unroll
    for (int i = 0; i < 16; ++i) v[i] = *(const float4*)(W + (size_t)(k0 + 4 * i + (lane >> 4)) * ldw + n0 + 4 * (lane & 15));
#pragma unroll
    for (int i = 0; i < 16; ++i) { LAS float* d_ = scr + (4 * i + (lane >> 4)) * 65 + 4 * (lane & 15); d_[0] = v[i].x; d_[1] = v[i].y; d_[2] = v[i].z; d_[3] = v[i].w; }
    asm volatile("s_waitcnt lgkmcnt(0)" ::: "memory");
#pragma unroll
    for (int j = 0; j < 8; ++j) {
        const int n = (lane >> 3) + 8 * j, c = lane & 7;
        const LAS float* s_ = scr + (8 * c) * 65 + n;
        uint4 o;
        o.x = pk2(s_[0 * 65], s_[1 * 65]); o.y = pk2(s_[2 * 65], s_[3 * 65]); o.z = pk2(s_[4 * 65], s_[5 * 65]); o.w = pk2(s_[6 * 65], s_[7 * 65]);
        *(uint4*)(WT + (size_t)(n0 + n) * ldwt + k0 + 8 * c) = o;
    }
    asm volatile("s_waitcnt lgkmcnt(0)" ::: "memory");
}

typedef short s16x4 __attribute__((ext_vector_type(4)));
typedef unsigned u32x4 __attribute__((ext_vector_type(4)));
typedef unsigned u32x2 __attribute__((ext_vector_type(2)));
typedef float f32x2 __attribute__((ext_vector_type(2)));
DEV float wave_scan_add(float v, int lane) {
#pragma unroll
    for (int o = 1; o < 64; o <<= 1) { const float u = __shfl_up(v, o); if (lane >= o) v += u; }
    return v;
}
DEV float wave_scan_max(float v, int lane) {
#pragma unroll
    for (int o = 1; o < 64; o <<= 1) { const float u = __shfl_up(v, o); if (lane >= o) v = fmaxf(v, u); }
    return v;
}

DEV void mlstm_phase(LAS char* shm, const bf16_t* q, const bf16_t* k, const bf16_t* v, const float* gpart, const float* b_ig, const float* b_fg, bf16_t* hc) {
    const int tid = opaque_tid(), wid = __builtin_amdgcn_readfirstlane(tid >> 6), lane = tid & 63, fr = lane & 15, fq = lane >> 4;
    constexpr int QS = 0, KS = 33792, VT = 67584, VWT = 74496, CB = 81408, PART = 106752, TB = 120064, TA = 128256, TP = 136448, TC = 144640, RS = 528, VRS = 96, PRS = 52;
    LAS float* part = (LAS float*)(shm + PART);
    LAS float* tb = (LAS float*)(shm + TB); LAS float* ta = (LAS float*)(shm + TA); LAS float* tp = (LAS float*)(shm + TP); LAS float* tc = (LAS float*)(shm + TC);
    for (int item = blockIdx.x; item < BATCH * NH * 8; item += gridDim.x) {
        const int vs = (item >> 3) & 7, bh = (item & 7) + 8 * (item >> 6), h = bh & 3, b = bh >> 2;
        __syncthreads();
        for (int i = tid; i < (CB + 25344 - VT) / 4; i += 512) ((LAS unsigned*)(shm + VT))[i] = 0u;
        for (int j = wid; j < SEQ / CHUNK; j += 8) {
            const int m = b * SEQ + j * CHUNK + lane;
            const float* gp = gpart + (size_t)m * 8;
            const float ig = gp[h] + gp[(size_t)MTOK * 8 + h] + b_ig[h];
            const float lf = logsigmoidf_(gp[4 + h] + gp[(size_t)MTOK * 8 + 4 + h] + b_fg[h]);
            const float bc = wave_scan_add(lf, lane);
            const float a_ = ig - bc;
            const float pm = wave_scan_max(a_, lane);
            tb[j * 64 + lane] = bc; ta[j * 64 + lane] = a_; tp[j * 64 + lane] = pm;
            if (lane == 63) { tc[2 * j] = bc; tc[2 * j + 1] = pm; }
        }
        __syncthreads();
        if (tid < 64) *(LAS u32x4*)(shm + VT + tid * VRS + 64) = (u32x4){0x3F80u, 0u, 0u, 0u};
        f32x4 cacc[2][3];
#pragma unroll
        for (int i = 0; i < 2; ++i)
#pragma unroll
            for (int vt = 0; vt < 3; ++vt) cacc[i][vt] = (f32x4){0.f, 0.f, 0.f, 0.f};
        float m_prev = 0.f;
        const size_t cb0 = ((size_t)(b * SEQ)) * DM + h * DH;
        uint4 qv[4], kv[4], vv = make_uint4(0, 0, 0, 0);
#pragma unroll
        for (int i = 0; i < 4; ++i) {
            const int idx = tid + 512 * i, row = idx >> 5, c16 = idx & 31;
            qv[i] = *(const uint4*)(q + cb0 + (size_t)row * DM + c16 * 8);
            kv[i] = *(const uint4*)(k + cb0 + (size_t)row * DM + c16 * 8);
        }
        if (tid < 256) vv = *(const uint4*)(v + cb0 + (size_t)(tid >> 2) * DM + vs * 32 + (tid & 3) * 8);
#pragma nounroll
        for (int j = 0; j < SEQ / CHUNK; ++j) {
            const size_t cb = cb0 + (size_t)j * CHUNK * DM;
            const float btot = tc[2 * j], amax = tc[2 * j + 1];
            const float mxc = fmaxf(m_prev, amax);
#pragma unroll
            for (int i = 0; i < 4; ++i) {
                const int idx = tid + 512 * i, row = idx >> 5, c16 = idx & 31;
                *(LAS u32x4*)(shm + QS + row * RS + c16 * 16) = (u32x4){qv[i].x, qv[i].y, qv[i].z, qv[i].w};
                *(LAS u32x4*)(shm + KS + row * RS + c16 * 16) = (u32x4){kv[i].x, kv[i].y, kv[i].z, kv[i].w};
            }
            if (tid < 256) {
                const int s_ = tid >> 2, v0 = (tid & 3) * 8;
                const float ws = __expf(ta[j * 64 + s_] - mxc);
                float f8[8]; unpack8(vv, f8);
#pragma unroll
                for (int e = 0; e < 8; ++e) f8[e] *= ws;
                const uint4 wv = pack8(f8);
                *(LAS u32x4*)(shm + VT + s_ * VRS + v0 * 2) = (u32x4){vv.x, vv.y, vv.z, vv.w};
                *(LAS u32x4*)(shm + VWT + s_ * VRS + v0 * 2) = (u32x4){wv.x, wv.y, wv.z, wv.w};
            } else if (tid < 320) {
                const int s_ = tid - 256;
                *(LAS u32x4*)(shm + VWT + s_ * VRS + 64) = (u32x4){(unsigned)f2bf(__expf(ta[j * 64 + s_] - mxc)), 0u, 0u, 0u};
            }
            if (j + 1 < SEQ / CHUNK) {
                const size_t cn = cb + (size_t)CHUNK * DM;
#pragma unroll
                for (int i = 0; i < 4; ++i) {
                    const int idx = tid + 512 * i, row = idx >> 5, c16 = idx & 31;
                    qv[i] = *(const uint4*)(q + cn + (size_t)row * DM + c16 * 8);
                    kv[i] = *(const uint4*)(k + cn + (size_t)row * DM + c16 * 8);
                }
                if (tid < 256) vv = *(const uint4*)(v + cn + (size_t)(tid >> 2) * DM + vs * 32 + (tid & 3) * 8);
            }
            __syncthreads();
            f32x4 nacc[3];
#pragma unroll
            for (int vt = 0; vt < 3; ++vt) nacc[vt] = (f32x4){0.f, 0.f, 0.f, 0.f};
            const int tt = wid & 3;
            if (wid < 4) {
                f32x4 sacc[4];
#pragma unroll
                for (int jj = 0; jj < 4; ++jj) sacc[jj] = (f32x4){0.f, 0.f, 0.f, 0.f};
#pragma unroll
                for (int ks = 0; ks < 8; ++ks) {
                    const bf16x8 qf = *(const LAS bf16x8*)(shm + QS + (16 * tt + fr) * RS + (32 * ks + 8 * fq) * 2);
#pragma unroll
                    for (int jj = 0; jj < 4; ++jj) if (jj <= tt) {
                        const bf16x8 kf = *(const LAS bf16x8*)(shm + KS + (16 * jj + fr) * RS + (32 * ks + 8 * fq) * 2);
                        sacc[jj] = __builtin_amdgcn_mfma_f32_16x16x32_bf16(kf, qf, sacc[jj], 0, 0, 0);
                    }
                }
                const int t = 16 * tt + fr;
                const float btm = -fmaxf(m_prev, tp[j * 64 + t]);
#pragma unroll
                for (int jj = 0; jj < 4; ++jj) {
                    const f32x4 a4 = *(const LAS f32x4*)(ta + j * 64 + 16 * jj + 4 * fq);
#pragma unroll
                    for (int r = 0; r < 4; ++r) {
                        const int s_ = 16 * jj + 4 * fq + r;
                        sacc[jj][r] = (s_ <= t) ? sacc[jj][r] * __expf(btm + a4[r]) : 0.f;
                    }
                }
#pragma unroll
                for (int kk = 0; kk < 2; ++kk) if (2 * kk <= tt) {
                    bf16x8 af;
                    { const unsigned p0 = pk2(sacc[2 * kk][0], sacc[2 * kk][1]), p1 = pk2(sacc[2 * kk][2], sacc[2 * kk][3]);
                      const unsigned p2 = pk2(sacc[2 * kk + 1][0], sacc[2 * kk + 1][1]), p3 = pk2(sacc[2 * kk + 1][2], sacc[2 * kk + 1][3]);
                      const u32x4 u = (u32x4){p0, p1, p2, p3}; af = *(const bf16x8*)&u; }
#pragma unroll
                    for (int vt = 0; vt < 3; ++vt) {
                        const s16x4 lo = __builtin_amdgcn_ds_read_tr16_b64_v4i16((LAS s16x4*)(shm + VT + (32 * kk + 4 * fq + (fr >> 2)) * VRS + (16 * vt + 4 * (fr & 3)) * 2));
                        const s16x4 hi = __builtin_amdgcn_ds_read_tr16_b64_v4i16((LAS s16x4*)(shm + VT + (32 * kk + 16 + 4 * fq + (fr >> 2)) * VRS + (16 * vt + 4 * (fr & 3)) * 2));
                        bf16x8 bv8; bv8[0] = lo[0]; bv8[1] = lo[1]; bv8[2] = lo[2]; bv8[3] = lo[3]; bv8[4] = hi[0]; bv8[5] = hi[1]; bv8[6] = hi[2]; bv8[7] = hi[3];
                        nacc[vt] = __builtin_amdgcn_mfma_f32_16x16x32_bf16(af, bv8, nacc[vt], 0, 0, 0);
                    }
                }
            } else {
#pragma unroll
                for (int ks = 0; ks < 8; ++ks) {
                    const bf16x8 qf = *(const LAS bf16x8*)(shm + QS + (16 * tt + fr) * RS + (32 * ks + 8 * fq) * 2);
#pragma unroll
                    for (int vt = 0; vt < 3; ++vt) {
                        const bf16x8 cf = *(const LAS bf16x8*)(shm + CB + (16 * vt + fr) * RS + (32 * ks + 8 * fq) * 2);
                        nacc[vt] = __builtin_amdgcn_mfma_f32_16x16x32_bf16(qf, cf, nacc[vt], 0, 0, 0);
                    }
                }
                const f32x4 pm4 = *(const LAS f32x4*)(tp + j * 64 + 16 * tt + 4 * fq);
#pragma unroll
                for (int vt = 0; vt < 3; ++vt)
#pragma unroll
                    for (int r = 0; r < 4; ++r) part[(16 * tt + 4 * fq + r) * PRS + 16 * vt + fr] = __expf(m_prev - fmaxf(m_prev, pm4[r])) * nacc[vt][r];
            }
            {
                const float decay = __expf(m_prev - mxc);
#pragma unroll
                for (int i = 0; i < 2; ++i)
#pragma unroll
                    for (int vt = 0; vt < 3; ++vt) cacc[i][vt] *= decay;
                const int q_ = fr >> 2, p_ = fr & 3;
#pragma unroll
                for (int kk = 0; kk < 2; ++kk) {
                    bf16x8 bfv[3];
#pragma unroll
                    for (int vt = 0; vt < 3; ++vt) {
                        const s16x4 lo = __builtin_amdgcn_ds_read_tr16_b64_v4i16((LAS s16x4*)(shm + VWT + (32 * kk + 8 * fq + q_) * VRS + (16 * vt + 4 * p_) * 2));
                        const s16x4 hi = __builtin_amdgcn_ds_read_tr16_b64_v4i16((LAS s16x4*)(shm + VWT + (32 * kk + 8 * fq + 4 + q_) * VRS + (16 * vt + 4 * p_) * 2));
                        bfv[vt][0] = lo[0]; bfv[vt][1] = lo[1]; bfv[vt][2] = lo[2]; bfv[vt][3] = lo[3]; bfv[vt][4] = hi[0]; bfv[vt][5] = hi[1]; bfv[vt][6] = hi[2]; bfv[vt][7] = hi[3];
                    }
#pragma unroll
                    for (int i = 0; i < 2; ++i) {
                        const int dt = 2 * wid + i;
                        const s16x4 t0 = __builtin_amdgcn_ds_read_tr16_b64_v4i16((LAS s16x4*)(shm + KS + (32 * kk + 8 * fq + q_) * RS + (16 * dt + 4 * p_) * 2));
                        const s16x4 t1 = __builtin_amdgcn_ds_read_tr16_b64_v4i16((LAS s16x4*)(shm + KS + (32 * kk + 8 * fq + 4 + q_) * RS + (16 * dt + 4 * p_) * 2));
                        bf16x8 af; af[0] = t0[0]; af[1] = t0[1]; af[2] = t0[2]; af[3] = t0[3]; af[4] = t1[0]; af[5] = t1[1]; af[6] = t1[2]; af[7] = t1[3];
#pragma unroll
                        for (int vt = 0; vt < 3; ++vt) cacc[i][vt] = __builtin_amdgcn_mfma_f32_16x16x32_bf16(af, bfv[vt], cacc[i][vt], 0, 0, 0);
                    }
                }
            }
            __syncthreads();
            if (wid < 4) {
                const f32x4 pm4 = *(const LAS f32x4*)(tp + j * 64 + 16 * tt + 4 * fq);
                const f32x4 bc4 = *(const LAS f32x4*)(tb + j * 64 + 16 * tt + 4 * fq);
#pragma unroll
                for (int vt = 0; vt < 3; ++vt)
#pragma unroll
                    for (int r = 0; r < 4; ++r) nacc[vt][r] += part[(16 * tt + 4 * fq + r) * PRS + 16 * vt + fr];
#pragma unroll
                for (int r = 0; r < 4; ++r) {
                    const float den = __shfl(nacc[2][r], lane & 48);
                    const float inv = 1.f / fmaxf(fabsf(den), __expf(-(bc4[r] + fmaxf(m_prev, pm4[r]))));
                    const size_t o = cb + (size_t)(16 * tt + 4 * fq + r) * DM + vs * 32 + fr;
                    hc[o] = f2bf(nacc[0][r] * inv);
                    hc[o + 16] = f2bf(nacc[1][r] * inv);
                }
            }
#pragma unroll
            for (int i = 0; i < 2; ++i)
#pragma unroll
                for (int vt = 0; vt < 3; ++vt) {
                    u32x2 o; o[0] = pk2(cacc[i][vt][0], cacc[i][vt][1]); o[1] = pk2(cacc[i][vt][2], cacc[i][vt][3]);
                    *(LAS u32x2*)(shm + CB + (16 * vt + fr) * RS + (16 * (2 * wid + i) + 4 * fq) * 2) = o;
                }
            m_prev = btot + mxc;
        }
    }
}

constexpr int S5L = 32, S5NCH = SEQ / S5L;
constexpr size_t T_KT_OFF = 0, T_WS_OFF = 2u << 20, T_V_OFF = 10u << 20, T_AL_OFF = 18u << 20;
constexpr int KT_G = 33 * 256, WS_G = 128 * 512, V_G = 512 * 128;

DEV void s5_tables(LAS char* shm, char* tab, const float* lam_re, const float* lam_im, const float* log_dt, const float* b_re, const float* b_im,
                   const float* c_re, const float* c_im) {
    const int tid = opaque_tid();
    LAS f32x2* apw = (LAS f32x2*)shm;
    LAS f32x2* bb = (LAS f32x2*)(shm + 64 * 33 * 8);
    LAS f32x2* cc = (LAS f32x2*)(shm + 64 * 33 * 8 + 8192);
    bf16_t* KT = (bf16_t*)(tab + T_KT_OFF); bf16_t* WS = (bf16_t*)(tab + T_WS_OFF); bf16_t* VV = (bf16_t*)(tab + T_V_OFF); float2* AL = (float2*)(tab + T_AL_OFF);
    for (int it = blockIdx.x; it < 256; it += gridDim.x) {
        const int g = it & 63, qd = it >> 6;
        __syncthreads();
        if (tid < 64) {
            const int pp = tid;
            const double lr = lam_re[g * NP + pp], li = lam_im[g * NP + pp], dt = exp((double)log_dt[g]);
            const double er = exp(lr * dt);
            const double ar = er * cos(li * dt), ai = er * sin(li * dt);
            const double dr = ar - 1.0, di = ai, den = lr * lr + li * li;
            const double cr = (dr * lr + di * li) / den, ci = (di * lr - dr * li) / den;
            double pr = 1.0, pi_ = 0.0;
            for (int e = 0; e <= 32; ++e) {
                apw[pp * 33 + e] = (f32x2){(float)pr, (float)pi_};
                const double nr = pr * ar - pi_ * ai, ni = pr * ai + pi_ * ar; pr = nr; pi_ = ni;
            }
            if (qd == 0) { const f32x2 t_ = apw[pp * 33 + 32]; AL[g * NP + pp] = make_float2(t_.x, t_.y); }
            for (int c = 0; c < 16; ++c) {
                const double br = b_re[(g * NP + pp) * GC + c], bi = b_im[(g * NP + pp) * GC + c];
                bb[pp * 16 + c] = (f32x2){(float)(cr * br - ci * bi), (float)(cr * bi + ci * br)};
                cc[c * 64 + pp] = (f32x2){c_re[(g * GC + c) * NP + pp], c_im[(g * GC + c) * NP + pp]};
            }
        }
        __syncthreads();
        for (int o = tid; o < 8 * 256; o += 512) {
            const int d = 8 * qd + (o >> 8), c1 = (o >> 4) & 15, c0 = o & 15;
            float acc = 0.f;
            for (int pp = 0; pp < 64; ++pp) {
                const f32x2 a = apw[pp * 33 + d], b = bb[pp * 16 + c0], c = cc[c1 * 64 + pp];
                const float mr = a.x * b.x - a.y * b.y, mi = a.x * b.y + a.y * b.x;
                acc += c.x * mr - c.y * mi;
            }
            KT[(size_t)g * KT_G + (d + 1) * 256 + c1 * 16 + c0] = f2bf(acc);
        }
        if (qd == 0 && tid < 256) KT[(size_t)g * KT_G + tid] = 0;
        for (int o = tid; o < 2 * 16 * 64; o += 512) {
            const int mt = 2 * qd + (o >> 10), sp = (o >> 6) & 15, ln = o & 63;
            const int row = 16 * mt + (ln & 15), ri = row >> 6, pp = row & 63, s_ = 2 * sp + (ln >> 5), c0 = 8 * ((ln >> 4) & 1);
            const f32x2 a = apw[pp * 33 + 31 - s_];
            unsigned w[4];
#pragma unroll
            for (int jj = 0; jj < 8; jj += 2) {
                const f32x2 b0 = bb[pp * 16 + c0 + jj], b1 = bb[pp * 16 + c0 + jj + 1];
                const float v0 = ri ? (a.x * b0.y + a.y * b0.x) : (a.x * b0.x - a.y * b0.y);
                const float v1 = ri ? (a.x * b1.y + a.y * b1.x) : (a.x * b1.x - a.y * b1.y);
                w[jj >> 1] = pk2(v0, v1);
            }
            *(uint4*)(WS + (size_t)g * WS_G + ((size_t)(mt * 16 + sp) * 64 + ln) * 8) = make_uint4(w[0], w[1], w[2], w[3]);
        }
        for (int o = tid; o < 8 * 4 * 64; o += 512) {
            const int i = 8 * qd + (o >> 8), ks = (o >> 6) & 3, ln = o & 63;
            const int c1 = ln & 15, k0 = 32 * ks + 8 * (ln >> 4);
            unsigned w[4];
#pragma unroll
            for (int jj = 0; jj < 8; jj += 2) {
                float v[2];
#pragma unroll
                for (int e = 0; e < 2; ++e) {
                    const int kk = k0 + jj + e, ri = kk >> 6, pp = kk & 63;
                    const f32x2 a = apw[pp * 33 + i + 1], c = cc[c1 * 64 + pp];
                    v[e] = ri ? -(c.x * a.y + c.y * a.x) : (c.x * a.x - c.y * a.y);
                }
                w[jj >> 1] = pk2(v[0], v[1]);
            }
            *(uint4*)(VV + (size_t)g * V_G + ((size_t)(i * 4 + ks) * 64 + ln) * 8) = make_uint4(w[0], w[1], w[2], w[3]);
        }
    }
}

DEV void s5_phase(LAS char* shm, const bf16_t* Uin, bf16_t* Yout, const char* tab, const float* dskip) {
    const int tid = opaque_tid(), wid = __builtin_amdgcn_readfirstlane(tid >> 6), lane = tid & 63, fr = lane & 15, fq = lane >> 4;
    constexpr int PLANE = 64 * 528, KTL = 2 * PLANE, SL = KTL + 33 * 512, HB = SL + 64 * 528, SRS = 528, HRS = 272;
    const bf16_t* KT = (const bf16_t*)(tab + T_KT_OFF); const bf16_t* WS = (const bf16_t*)(tab + T_WS_OFF); const bf16_t* VV = (const bf16_t*)(tab + T_V_OFF);
    const float2* AL = (const float2*)(tab + T_AL_OFF);
    for (int item = blockIdx.x; item < BATCH * NG; item += gridDim.x) {
        const int g = item & 63, b = item >> 6;
        const bf16_t* Ub = Uin + (size_t)b * SEQ * DM + g * GC;
        bf16_t* Yb = Yout + (size_t)b * SEQ * DM + g * GC;
        __syncthreads();
#pragma unroll
        for (int i = 0; i < 8; ++i) {
            const int idx = tid + 512 * i, tok = idx >> 1, hf = idx & 1;
            const uint4 uv = *(const uint4*)(Ub + (size_t)tok * DM + hf * 8);
            *(LAS u32x4*)(shm + hf * PLANE + (tok >> 5) * 528 + (tok & 31) * 16) = (u32x4){uv.x, uv.y, uv.z, uv.w};
        }
        for (int idx = tid; idx < 33 * 32; idx += 512) {
            const uint4 kv = *(const uint4*)(KT + (size_t)g * KT_G + idx * 8);
            *(LAS u32x4*)(shm + KTL + idx * 16) = (u32x4){kv.x, kv.y, kv.z, kv.w};
        }
        __syncthreads();
        f32x4 acc[4][4], sac[4];
#pragma unroll
        for (int q = 0; q < 4; ++q)
#pragma unroll
            for (int nt = 0; nt < 4; ++nt) acc[q][nt] = (f32x4){0.f, 0.f, 0.f, 0.f};
#pragma unroll
        for (int nt = 0; nt < 4; ++nt) sac[nt] = (f32x4){0.f, 0.f, 0.f, 0.f};
        const bf16_t* wsp = WS + (size_t)g * WS_G + ((size_t)(wid * 16) * 64 + lane) * 8;
        bf16x8 wnext = *(const bf16x8*)wsp;
#pragma nounroll
        for (int sp = 0; sp < 16; ++sp) {
            const bf16x8 wcur = wnext;
            if (sp + 1 < 16) wnext = *(const bf16x8*)(wsp + (size_t)(sp + 1) * 64 * 8);
            bf16x8 bu[4];
#pragma unroll
            for (int nt = 0; nt < 4; ++nt) bu[nt] = *(const LAS bf16x8*)(shm + (fq & 1) * PLANE + (16 * nt + fr) * 528 + (2 * sp + (fq >> 1)) * 16);
#pragma unroll
            for (int nt = 0; nt < 4; ++nt) sac[nt] = __builtin_amdgcn_mfma_f32_16x16x32_bf16(wcur, bu[nt], sac[nt], 0, 0, 0);
#pragma unroll
            for (int q = 0; q < 4; ++q) {
                const int i = wid + 8 * q;
                if (i >= 2 * sp) {
                    const int d = i - 2 * sp;
                    const bf16x8 kf = *(const LAS bf16x8*)(shm + KTL + (d - (fq >> 1) + 1) * 512 + fr * 32 + (fq & 1) * 16);
#pragma unroll
                    for (int nt = 0; nt < 4; ++nt) acc[q][nt] = __builtin_amdgcn_mfma_f32_16x16x32_bf16(kf, bu[nt], acc[q][nt], 0, 0, 0);
                }
            }
        }
#pragma unroll
        for (int nt = 0; nt < 4; ++nt) *(LAS f32x4*)(shm + SL + (16 * nt + fr) * SRS + (16 * wid + 4 * fq) * 4) = sac[nt];
        __syncthreads();
        if (wid == 0) {
            const float2 al = AL[g * NP + lane];
            float hr = 0.f, hi = 0.f;
#pragma unroll 8
            for (int n = 0; n < S5NCH; ++n) {
                *(LAS bf16_t*)(shm + HB + n * HRS + lane * 2) = f2bf(hr);
                *(LAS bf16_t*)(shm + HB + n * HRS + (64 + lane) * 2) = f2bf(hi);
                const float sr = *(const LAS float*)(shm + SL + n * SRS + lane * 4), si = *(const LAS float*)(shm + SL + n * SRS + (64 + lane) * 4);
                const float nr = al.x * hr - al.y * hi + sr, ni = al.x * hi + al.y * hr + si;
                hr = nr; hi = ni;
            }
        }
        __syncthreads();
        const bf16_t* vvp = VV + (size_t)g * V_G + (size_t)lane * 8;
#pragma unroll
        for (int ks = 0; ks < 4; ++ks) {
            bf16x8 hb[4], va[4];
#pragma unroll
            for (int q = 0; q < 4; ++q) va[q] = *(const bf16x8*)(vvp + ((size_t)((wid + 8 * q) * 4 + ks) * 64) * 8);
#pragma unroll
            for (int nt = 0; nt < 4; ++nt) hb[nt] = *(const LAS bf16x8*)(shm + HB + (16 * nt + fr) * HRS + (32 * ks + 8 * fq) * 2);
#pragma unroll
            for (int q = 0; q < 4; ++q)
#pragma unroll
                for (int nt = 0; nt < 4; ++nt) acc[q][nt] = __builtin_amdgcn_mfma_f32_16x16x32_bf16(va[q], hb[nt], acc[q][nt], 0, 0, 0);
        }
        const float4 dsk = *(const float4*)(dskip + g * GC + 4 * fq);
#pragma unroll
        for (int q = 0; q < 4; ++q) {
            const int i = wid + 8 * q;
#pragma unroll
            for (int nt = 0; nt < 4; ++nt) {
                const int n = 16 * nt + fr;
                const u32x2 uu = *(const LAS u32x2*)(shm + (fq >> 1) * PLANE + n * 528 + i * 16 + ((4 * fq) & 7) * 2);
                f32x4 o;
                o[0] = geluf_(acc[q][nt][0] + dsk.x * bf2f((bf16_t)(uu[0] & 0xffff))); o[1] = geluf_(acc[q][nt][1] + dsk.y * bf2f((bf16_t)(uu[0] >> 16)));
                o[2] = geluf_(acc[q][nt][2] + dsk.z * bf2f((bf16_t)(uu[1] & 0xffff))); o[3] = geluf_(acc[q][nt][3] + dsk.w * bf2f((bf16_t)(uu[1] >> 16)));
                *(uint2*)(Yb + (size_t)(n * 32 + i) * DM + 4 * fq) = pack4(o);
            }
        }
    }
}


DEV void norm_rows(const float* x, const float* gain, const float* modl, bf16_t* h) {
    const int tid = opaque_tid(), lane = tid & 63, gw = blockIdx.x * 8 + (tid >> 6), NGW = gridDim.x * 8;
    for (int m = gw; m < MTOK; m += NGW) {
        const float4* xr = (const float4*)(x + (size_t)m * DM) + lane;
        float4 v[4]; float ss = 0.f;
#pragma unroll
        for (int j = 0; j < 4; ++j) { v[j] = xr[64 * j]; ss += v[j].x * v[j].x + v[j].y * v[j].y + v[j].z * v[j].z + v[j].w * v[j].w; }
        const float rstd = rsqrtf(wave_sum(ss) * (1.f / DM) + EPS);
        const float* shift = modl + (size_t)(m / SEQ) * 3 * DM; const float* scale = shift + DM;
#pragma unroll
        for (int j = 0; j < 4; ++j) {
            const int n = 4 * lane + 256 * j;
            const float4 g = *(const float4*)(gain + n), sc = *(const float4*)(scale + n), sh = *(const float4*)(shift + n);
            f32x4 o; o[0] = v[j].x * rstd * g.x * (1.f + sc.x) + sh.x; o[1] = v[j].y * rstd * g.y * (1.f + sc.y) + sh.y;
            o[2] = v[j].z * rstd * g.z * (1.f + sc.z) + sh.z; o[3] = v[j].w * rstd * g.w * (1.f + sc.w) + sh.w;
            *(uint2*)(h + (size_t)m * DM + n) = pack4(o);
        }
    }
}
DEV void ssm_post_rows(const bf16_t* z, bf16_t* zo, const bf16_t* sg, const float* gain) {
    const int tid = opaque_tid(), lane = tid & 63, gw = blockIdx.x * 8 + (tid >> 6), NGW = gridDim.x * 8;
    for (int m = gw; m < MTOK; m += NGW) {
        float zv[2][8], gv[2][8]; float ss = 0.f;
#pragma unroll
        for (int j = 0; j < 2; ++j) {
            unpack8(*(const uint4*)(z + (size_t)m * DM + 8 * lane + 512 * j), zv[j]);
            unpack8(*(const uint4*)(sg + (size_t)m * DM + 8 * lane + 512 * j), gv[j]);
#pragma unroll
            for (int e = 0; e < 8; ++e) ss += zv[j][e] * zv[j][e];
        }
        const float rstd = rsqrtf(wave_sum(ss) * (1.f / DM) + EPS);
#pragma unroll
        for (int j = 0; j < 2; ++j) {
            const int n = 8 * lane + 512 * j; float o[8];
#pragma unroll
            for (int e = 0; e < 8; ++e) o[e] = zv[j][e] * rstd * gain[n + e] * siluf_(gv[j][e]);
            *(uint4*)(zo + (size_t)m * DM + n) = pack8(o);
        }
    }
}
DEV void mlstm_post_rows(const bf16_t* hc, bf16_t* ho, const bf16_t* mo, const bf16_t* mg, const bf16_t* mi, const float* cw, const float* cb, const float* ngain, const float* skip) {
    const int tid = opaque_tid(), lane = tid & 63, gw = blockIdx.x * 8 + (tid >> 6), NGW = gridDim.x * 8;
    for (int m = gw; m < MTOK; m += NGW) {
        const size_t o0 = (size_t)m * DM + 16 * lane;
        float hv[16], t8[8]; float s1 = 0.f;
#pragma unroll
        for (int j = 0; j < 2; ++j) {
            unpack8(*(const uint4*)(hc + o0 + 8 * j), hv + 8 * j);
            unpack8(*(const uint4*)(mo + o0 + 8 * j), t8);
#pragma unroll
            for (int e = 0; e < 8; ++e) { hv[8 * j + e] *= sigmoidf_(t8[e]); s1 += hv[8 * j + e]; }
        }
#pragma unroll
        for (int o = 1; o < 16; o <<= 1) s1 += __shfl_xor(s1, o);
        const float mu = s1 * (1.f / DH); float s2 = 0.f;
#pragma unroll
        for (int e = 0; e < 16; ++e) { hv[e] -= mu; s2 += hv[e] * hv[e]; }
#pragma unroll
        for (int o = 1; o < 16; o <<= 1) s2 += __shfl_xor(s2, o);
        const float rstd = rsqrtf(s2 * (1.f / DH) + EPS);
#pragma unroll
        for (int j = 0; j < 2; ++j) {
            float xv[8], gv[8], ov[8], t8b[8];
            { const int n0 = 16 * lane + 8 * j, tpos = m % SEQ;
#pragma unroll
              for (int e = 0; e < 8; ++e) xv[e] = cb[n0 + e];
#pragma unroll
              for (int tap = 0; tap < 4; ++tap) if (tpos - 3 + tap >= 0) {
                  unpack8(*(const uint4*)(mi + (size_t)(m - 3 + tap) * DM + n0), t8b);
#pragma unroll
                  for (int e = 0; e < 8; ++e) xv[e] += t8b[e] * cw[tap * DM + n0 + e];
              }
#pragma unroll
              for (int e = 0; e < 8; ++e) xv[e] = siluf_(xv[e]); }
            unpack8(*(const uint4*)(mg + o0 + 8 * j), gv);
#pragma unroll
            for (int e = 0; e < 8; ++e) { const int n = 16 * lane + 8 * j + e; ov[e] = (hv[8 * j + e] * rstd * ngain[n] + skip[n] * xv[e]) * siluf_(gv[e]); }
            *(uint4*)(ho + o0 + 8 * j) = pack8(ov);
        }
    }
}
DEV void final_rows(float* x, const float* gain) {
    const int tid = opaque_tid(), lane = tid & 63, gw = blockIdx.x * 8 + (tid >> 6), NGW = gridDim.x * 8;
    for (int m = gw; m < MTOK; m += NGW) {
        float4* xr = (float4*)(x + (size_t)m * DM) + lane;
        float4 v[4]; float ss = 0.f;
#pragma unroll
        for (int j = 0; j < 4; ++j) { v[j] = xr[64 * j]; ss += v[j].x * v[j].x + v[j].y * v[j].y + v[j].z * v[j].z + v[j].w * v[j].w; }
        const float rstd = rsqrtf(wave_sum(ss) * (1.f / DM) + EPS);
#pragma unroll
        for (int j = 0; j < 4; ++j) {
            const float4 g = *(const float4*)(gain + 4 * lane + 256 * j);
            v[j].x *= rstd * g.x; v[j].y *= rstd * g.y; v[j].z *= rstd * g.z; v[j].w *= rstd * g.w;
            xr[64 * j] = v[j];
        }
    }
}
DEV void mod_phase(LAS char* shm, const float* c, const float* w_mod, const float* b_mod, float* mod) {
    const int tid = opaque_tid();
    LAS float* sc = (LAS float*)shm;
    LAS float* pr = (LAS float*)(shm + 32768);
    __syncthreads();
    for (int i = tid; i < BATCH * DM; i += 512) sc[i] = siluf_(c[i]);
    __syncthreads();
    for (int it = blockIdx.x; it < 48; it += gridDim.x) {
        const int l = it / 24, n0 = (it % 24) * 128, cq = tid & 31, kg = tid >> 5;
        const float* W = w_mod + (size_t)l * DM * 3 * DM + n0 + 4 * cq;
        float acc[BATCH][4];
#pragma unroll
        for (int b = 0; b < BATCH; ++b) { acc[b][0] = acc[b][1] = acc[b][2] = acc[b][3] = 0.f; }
        for (int k = kg * 64; k < kg * 64 + 64; ++k) {
            const float4 w = *(const float4*)(W + (size_t)k * 3 * DM);
#pragma unroll
            for (int b = 0; b < BATCH; ++b) { const float s_ = sc[b * DM + k]; acc[b][0] += s_ * w.x; acc[b][1] += s_ * w.y; acc[b][2] += s_ * w.z; acc[b][3] += s_ * w.w; }
        }
#pragma unroll
        for (int b = 0; b < BATCH; ++b) *(LAS f32x4*)(pr + (kg * 8 + b) * 128 + 4 * cq) = (f32x4){acc[b][0], acc[b][1], acc[b][2], acc[b][3]};
        __syncthreads();
        for (int o = tid; o < 8 * 128; o += 512) {
            const int b = o >> 7, n = o & 127; float s_ = 0.f;
#pragma unroll
            for (int g2 = 0; g2 < 16; ++g2) s_ += pr[(g2 * 8 + b) * 128 + n];
            mod[((size_t)l * BATCH + b) * 3 * DM + n0 + n] = s_ + b_mod[l * 3 * DM + n0 + n];
        }
        __syncthreads();
    }
}

DEV void wfold_prep(bf16_t* WfT, const float* wq, const float* wk, const float* wv, const float* wg  ) {
    const int tid = opaque_tid(), lane = tid & 63;
    for (int t = blockIdx.x * 8 + (tid >> 6); t < 2048; t += gridDim.x * 8) {
        const int which = t >> 10, ch = t & 1023, hd = ch >> 8, d = ch & 255;
        float acc[8];
#pragma unroll
        for (int j = 0; j < 8; ++j) acc[j] = 0.f;
        if (which == 0) {
            const float4 q4 = *(const float4*)(wq + ((size_t)hd * DH + d) * DH + 4 * lane);
            const float4 k4 = *(const float4*)(wk + ((size_t)hd * DH + d) * DH + 4 * lane);
            const float qv[4] = {q4.x, q4.y, q4.z, q4.w}, kv[4] = {k4.x * 0.0625f, k4.y * 0.0625f, k4.z * 0.0625f, k4.w * 0.0625f};
#pragma unroll
            for (int e = 0; e < 4; ++e) {
                const float* g1 = wg + (size_t)(hd * DH + 4 * lane + e) * 8; const float* g2 = wg + (size_t)(DM + hd * DH + 4 * lane + e) * 8;
                const float4 a0 = *(const float4*)g1, a1 = *(const float4*)(g1 + 4), b0 = *(const float4*)g2, b1 = *(const float4*)(g2 + 4);
                acc[0] += qv[e] * a0.x + kv[e] * b0.x; acc[1] += qv[e] * a0.y + kv[e] * b0.y; acc[2] += qv[e] * a0.z + kv[e] * b0.z; acc[3] += qv[e] * a0.w + kv[e] * b0.w;
                acc[4] += qv[e] * a1.x + kv[e] * b1.x; acc[5] += qv[e] * a1.y + kv[e] * b1.y; acc[6] += qv[e] * a1.z + kv[e] * b1.z; acc[7] += qv[e] * a1.w + kv[e] * b1.w;
            }
        } else {
            const float4 v4 = *(const float4*)(wv + ((size_t)hd * DH + d) * DH + 4 * lane);
            const float vv[4] = {v4.x, v4.y, v4.z, v4.w};
#pragma unroll
            for (int e = 0; e < 4; ++e) {
                const float* g1 = wg + (size_t)(2 * DM + hd * DH + 4 * lane + e) * 8;
                const float4 a0 = *(const float4*)g1, a1 = *(const float4*)(g1 + 4);
                acc[0] += vv[e] * a0.x; acc[1] += vv[e] * a0.y; acc[2] += vv[e] * a0.z; acc[3] += vv[e] * a0.w;
                acc[4] += vv[e] * a1.x; acc[5] += vv[e] * a1.y; acc[6] += vv[e] * a1.z; acc[7] += vv[e] * a1.w;
            }
        }
#pragma unroll
        for (int j = 0; j < 8; ++j) acc[j] = wave_sum(acc[j]);
        if (lane < 16) {
            float v = 0.f;
#pragma unroll
            for (int j = 0; j < 8; ++j) v = (lane == j) ? acc[j] : v;
            WfT[((size_t)which * 16 + lane) * 1024 + ch] = f2bf(v);
        }
    }
}
DEV void xc_gates_phase(LAS char* shm, const bf16_t* mi, bf16_t* xc, const bf16_t* WfT, const float* cw, const float* cb, float* gpart  ) {
    const int tid = opaque_tid(), wid = __builtin_amdgcn_readfirstlane(tid >> 6), lane = tid & 63, fr = lane & 15, fq = lane >> 4;
    constexpr int WRS = 2064, WIMG = 16 * WRS, STG = 2 * WIMG, SRS_ = 528, STG_W = 19 * SRS_;
    __syncthreads();
    for (int i = tid; i < 2 * 16 * 128; i += 512) {
        const int rowi = i >> 7, pc = i & 127;
        const uint4 v = *(const uint4*)(WfT + (size_t)rowi * 1024 + pc * 8);
        *(LAS u32x4*)(shm + rowi * WRS + pc * 16) = (u32x4){v.x, v.y, v.z, v.w};
    }
    __syncthreads();
    LAS char* stg = shm + STG + wid * STG_W;
    for (int task = blockIdx.x * 8 + wid; task < (MTOK / 16) * 2; task += gridDim.x * 8) {
        const int chalf = task & 1, m0 = (task >> 1) * 16, tpos0 = m0 % SEQ;
        f32x4 acc = (f32x4){0.f, 0.f, 0.f, 0.f};
#pragma nounroll
        for (int sl = 0; sl < 2; ++sl) {
            const int c0 = chalf * 512 + sl * 256;
            for (int i = lane; i < 19 * 32; i += 64) {
                const int row = i >> 5, pc = i & 31;
                uint4 v = make_uint4(0, 0, 0, 0);
                if (tpos0 - 3 + row >= 0) v = *(const uint4*)(mi + (size_t)(m0 - 3 + row) * DM + c0 + pc * 8);
                *(LAS u32x4*)(stg + row * SRS_ + pc * 16) = (u32x4){v.x, v.y, v.z, v.w};
            }
#pragma nounroll
            for (int ks = 0; ks < 8; ++ks) {
                const int cl = 32 * ks + 8 * fq, c = c0 + cl;
                float xv[8], t8[8], w8[8];
                { const float4 b0 = *(const float4*)(cb + c), b1 = *(const float4*)(cb + c + 4);
                  xv[0] = b0.x; xv[1] = b0.y; xv[2] = b0.z; xv[3] = b0.w; xv[4] = b1.x; xv[5] = b1.y; xv[6] = b1.z; xv[7] = b1.w; }
                u32x4 raw3;
#pragma unroll
                for (int tap = 0; tap < 4; ++tap) {
                    const u32x4 rw = *(const LAS u32x4*)(stg + (fr + tap) * SRS_ + cl * 2);
                    if (tap == 3) raw3 = rw;
                    unpack8(make_uint4(rw[0], rw[1], rw[2], rw[3]), t8);
                    const float4 w0 = *(const float4*)(cw + tap * DM + c), w1 = *(const float4*)(cw + tap * DM + c + 4);
                    w8[0] = w0.x; w8[1] = w0.y; w8[2] = w0.z; w8[3] = w0.w; w8[4] = w1.x; w8[5] = w1.y; w8[6] = w1.z; w8[7] = w1.w;
#pragma unroll
                    for (int e = 0; e < 8; ++e) xv[e] += t8[e] * w8[e];
                }
#pragma unroll
                for (int e = 0; e < 8; ++e) xv[e] = siluf_(xv[e]);
                const uint4 xp = pack8(xv);
                *(uint4*)(xc + (size_t)(m0 + fr) * DM + c) = xp;
                const u32x4 xpu = (u32x4){xp.x, xp.y, xp.z, xp.w};
                const bf16x8 bx = *(const LAS bf16x8*)(shm + fr * WRS + c * 2);
                const bf16x8 bv = *(const LAS bf16x8*)(shm + WIMG + fr * WRS + c * 2);
                acc = __builtin_amdgcn_mfma_f32_16x16x32_bf16(*(const bf16x8*)&xpu, bx, acc, 0, 0, 0);
                acc = __builtin_amdgcn_mfma_f32_16x16x32_bf16(*(const bf16x8*)&raw3, bv, acc, 0, 0, 0);
            }
        }
        if (fr < 8) {
#pragma unroll
            for (int r = 0; r < 4; ++r) gpart[((size_t)chalf * MTOK + m0 + 4 * fq + r) * 8 + fr] = acc[r];
        }
    }
}

#define XB_TMO      128
#define XB_XCNT(j)  (256  + 64 * (j))
#define XB_XSUB(j)  (1280 + 64 * (j))
#define XB_XGEN(j)  (2304 + 64 * (j))
#define XB_TOP      3328
#define XB_TOPGEN   3392
#define XCD_BAR_WORDS 3456
#define XB_SPIN_CAP (1u << 18)
DEV unsigned xb_ld(unsigned* p) { return __hip_atomic_load(p, __ATOMIC_RELAXED, __HIP_MEMORY_SCOPE_AGENT); }
DEV unsigned xb_add(unsigned* p, unsigned v) { return __hip_atomic_fetch_add(p, v, __ATOMIC_RELAXED, __HIP_MEMORY_SCOPE_AGENT); }
DEV unsigned xb_xcc_id() { return (unsigned)__builtin_amdgcn_s_getreg((3 << 11) | 20) & 0xFu; }
#define XB_SPIN(cond, bar) do { unsigned _sp = 0; while (cond) { __builtin_amdgcn_s_sleep(1); \
    if ((++_sp & 255u) == 0u) { if (xb_ld(&(bar)[XB_TMO])) break; if (_sp > XB_SPIN_CAP) { atomicAdd(&(bar)[XB_TMO], 1u); break; } } } } while (0)
struct XcdBarrier { unsigned* bar; unsigned x; volatile LAS unsigned* st; };
DEV XcdBarrier xcd_barrier_post(unsigned* bar, volatile LAS unsigned* st) {
    XcdBarrier b; b.bar = bar; b.x = xb_xcc_id(); b.st = st;
    if (threadIdx.x == 0) (void)xb_add(&bar[XB_XCNT(b.x)], 1u);
    return b;
}
DEV void xcd_barrier_complete(unsigned* bar, unsigned x, unsigned& nloc, unsigned& nx) {
    const unsigned G = gridDim.x * gridDim.y * gridDim.z;
    unsigned sum, cnt, mine, sp = 0u;
    for (;;) {
        sum = 0u; cnt = 0u; mine = 0u;
#pragma nounroll
        for (unsigned j = 0; j < 16; ++j) { const unsigned c = xb_ld(&bar[XB_XCNT(j)]); sum += c; cnt += (c > 0u) ? 1u : 0u; }
        mine = xb_ld(&bar[XB_XCNT(x)]);
        if (sum == G) break;
        __builtin_amdgcn_s_sleep(1);
        if ((++sp & 255u) == 0u) { if (xb_ld(&bar[XB_TMO])) break; if (sp > XB_SPIN_CAP) { atomicAdd(&bar[XB_TMO], 1u); break; } }
    }
    nloc = mine > 0u ? mine : 1u; nx = cnt > 0u ? cnt : 1u;
}
DEV void xcd_barrier1(const XcdBarrier& b) {
    asm volatile("s_waitcnt vmcnt(0)" ::: "memory");
    __syncthreads();
    if (threadIdx.x == 0) {
        unsigned* bar = b.bar;
        __builtin_amdgcn_s_waitcnt(0);
        unsigned nloc = b.st[0], nx = b.st[1];
        if (nloc == 0u) { xcd_barrier_complete(bar, b.x, nloc, nx); b.st[0] = nloc; b.st[1] = nx; }
        const unsigned old = xb_add(&bar[XB_XSUB(b.x)], 1u);
        const unsigned gen = old / nloc;
        if (old + 1u == (gen + 1u) * nloc) {
            __builtin_amdgcn_fence(__ATOMIC_RELEASE, "agent");
            asm volatile("s_waitcnt vmcnt(0)" ::: "memory");
            const unsigned og = xb_add(&bar[XB_TOP], 1u);
            const unsigned tg = og / nx;
            if (og + 1u == (tg + 1u) * nx) xb_add(&bar[XB_TOPGEN], 1u);
            else XB_SPIN(xb_ld(&bar[XB_TOPGEN]) == tg, bar);
            __builtin_amdgcn_fence(__ATOMIC_ACQUIRE, "agent");
            xb_add(&bar[XB_XGEN(b.x)], 1u);
            asm volatile("s_waitcnt vmcnt(0)" ::: "memory");
        } else {
            XB_SPIN(xb_ld(&bar[XB_XGEN(b.x)]) == gen, bar);
            __builtin_amdgcn_fence(__ATOMIC_ACQUIRE, "agent");
            asm volatile("s_waitcnt vmcnt(0)" ::: "memory");
        }
    }
    __syncthreads();
}

DEV void xcd_barrier(const XcdBarrier& b) { xcd_barrier1(b); if (REPMASK & 2048) xcd_barrier1(b); }
constexpr int LDS_BYTES = 148 * 1024;
DEV const void* ldptr(LAS char* shm, int i) {
    volatile LAS unsigned* pt = (volatile LAS unsigned*)(shm + LDS_BYTES - 512);
    const unsigned lo = __builtin_amdgcn_readfirstlane(pt[2 * i]), hi = __builtin_amdgcn_readfirstlane(pt[2 * i + 1]);
    return (const void*)(const __attribute__((address_space(1))) void*)(((unsigned long long)hi << 32) | lo);
}
#define PF(i) ((const float*)ldptr(shm, (i)))
struct Params {
    const float *x, *c, *norm_gain, *w_mod, *b_mod, *w_in, *lam_re, *lam_im, *log_dt, *sb_re, *sb_im, *sc_re, *sc_im, *ssm_d, *w_glu, *b_glu, *ssm_og,
        *conv_w, *conv_b, *wq, *wk, *wv, *w_gates, *b_ig, *b_fg, *m_ng, *m_skip, *w_out, *final_gain;
    float* out; char* ws;
};
constexpr int HALF_FLOATS = 56 * 1024 / 4;
constexpr size_t SLOT = (size_t)MTOK * DM * 2;
constexpr size_t W_IN_OFF = 0, W_GLU_OFF = 10485760, W_QKV_OFF = 12582912, W_OUT_OFF = 14155776, MOD_OFF = 20u << 20, IPRE_OFF = 21u << 20, LOGF_OFF = 22u << 20, BAR_OFF = 23u << 20, WF_OFF = 19u << 20, ROWSS_OFF = 24u << 20;
#define REP(bit) _Pragma("nounroll") for (int rep_ = 0; rep_ < (((REPMASK) & (bit)) ? 2 : 1); ++rep_)
#define FOR_VB(nvb) for (int vb = blockIdx.x * 2 + HALF; vb < (nvb); vb += gridDim.x * 2)

#define WSB ((char*)ldptr(shm, 30))
#define SL(i) ((bf16_t*)(WSB + SLOT * (i)))
#define S7(off) (WSB + SLOT * 7 + (off))
#define WinT ((bf16_t*)S7(W_IN_OFF))
#define WgluT ((bf16_t*)S7(W_GLU_OFF))
#define WqkvT ((bf16_t*)S7(W_QKV_OFF))
#define WoutT ((bf16_t*)S7(W_OUT_OFF))
#define mod ((float*)S7(MOD_OFF))
#define gpart ((float*)S7(IPRE_OFF))
#define WfT ((bf16_t*)S7(WF_OFF))
#define rowss ((float*)S7(ROWSS_OFF))
#define OUTP ((float*)ldptr(shm, 29))
#define H SL(0)
#define U SL(1)
#define Y SL(2)
#define Z SL(3)
#define XC SL(4)
#define MI SL(5)
#define Q SL(6)
#define Kb SL(1)
#define V SL(2)
#define HC SL(5)
template <int l>
DEV void layer_body(LAS char* shm, const XcdBarrier& gbar) {
        const int wave = opaque_tid() >> 6, lane = opaque_tid() & 63;
        const float* xin = (l == 0) ? PF(0) : OUTP;
        const float* modl = mod + (size_t)l * BATCH * 3 * DM;
        REP(1) { {
            LAS float* scr = (LAS float*)(shm + wave * 16640);
            const float* Win = PF(5) + (size_t)l * DM * INC;
            constexpr int I_IN = 16 * 80, I_GLU = 16 * 16, I_QKV = 12 * 16, I_OUT = 32 * 16;
            for (int it = blockIdx.x * 8 + wave; it < I_IN + I_GLU + I_QKV + I_OUT; it += gridDim.x * 8) {
                int r = it;
                if (r < I_IN) { transpose_item(Win, INC, INC, WinT, DM, scr, r, lane); continue; } r -= I_IN;
                if (r < I_GLU) { transpose_item(PF(14) + (size_t)l * DM * DM, DM, DM, WgluT, DM, scr, r, lane); continue; } r -= I_GLU;
                if (r < I_QKV) { const int mat = r / 16, which = mat >> 2, hd = mat & 3;
                    const float* W = sel3(which, PF(19), PF(20), PF(21)) + ((size_t)l * NH + hd) * DH * DH;
                    transpose_item(W, DH, DH, WqkvT + (size_t)mat * DH * DH, DH, scr, r % 16, lane); continue; } r -= I_QKV;
                transpose_item(PF(27) + (size_t)l * 2 * DM * DM, DM, DM, WoutT, 2 * DM, scr, r, lane);
            }
        }
        wfold_prep(WfT, PF(19) + (size_t)l * NH * DH * DH, PF(20) + (size_t)l * NH * DH * DH, PF(21) + (size_t)l * NH * DH * DH, PF(22) + (size_t)l * 3 * DM * 8);
        __syncthreads();
        s5_tables(shm, (char*)SL(3), PF(6) + l * NG * NP, PF(7) + l * NG * NP, PF(8) + l * NG, PF(9) + (size_t)l * NG * NP * GC, PF(10) + (size_t)l * NG * NP * GC,
                  PF(11) + (size_t)l * NG * GC * NP, PF(12) + (size_t)l * NG * GC * NP);
        __syncthreads();
        norm_rows(xin, PF(2) + l * DM, modl, H);
        }
        xcd_barrier(gbar);
        REP(2) { ProbG1 pb{H, WinT, U, MI, 8}; gemm_phase(shm, pb); }
        xcd_barrier(gbar);
        REP(256) s5_phase(shm, U, Y, (const char*)SL(3), PF(13) + l * DM);
        REP(8) xc_gates_phase(shm, MI, XC, WfT, PF(17) + l * 4 * DM, PF(18) + l * DM, gpart);
        xcd_barrier(gbar);
        REP(4) { ProbGlu pb{Y, WgluT, Z, PF(15) + l * DM, rowss, 4}; gemm_phase(shm, pb); }
        xcd_barrier(gbar);
        REP(16) { ProbQkv pb{XC, MI, WqkvT, Q, Kb, V, 12}; gemm_phase(shm, pb); }
        xcd_barrier(gbar);
        REP(32) mlstm_phase(shm, Q, Kb, V, gpart, PF(23) + l * 4, PF(24) + l * 4, HC);
        xcd_barrier(gbar);
        { G2Args ga{H, WinT, Z, rowss, PF(16) + l * DM, HC, XC, PF(25) + l * DM, PF(26) + l * DM}; gemm2_phase(shm, ga); }
        xcd_barrier(gbar);
        REP(l == 0 ? 128 : 0) { ProbOut pb{Z, HC, WoutT, xin, OUTP, modl + 2 * DM, 4}; gemm_phase(shm, pb); }
        xcd_barrier(gbar);
    }
__global__ void __launch_bounds__(512, 2) mega(Params Pk) {
    extern __shared__ __attribute__((aligned(16))) unsigned char lds_raw[];
    {
        volatile LAS unsigned long long* pt = (volatile LAS unsigned long long*)((LAS char*)lds_raw + LDS_BYTES - 512);
        if (threadIdx.x == 0) {
            pt[0] = (unsigned long long)Pk.x;
            pt[1] = (unsigned long long)Pk.c;
            pt[2] = (unsigned long long)Pk.norm_gain;
            pt[3] = (unsigned long long)Pk.w_mod;
            pt[4] = (unsigned long long)Pk.b_mod;
            pt[5] = (unsigned long long)Pk.w_in;
            pt[6] = (unsigned long long)Pk.lam_re;
            pt[7] = (unsigned long long)Pk.lam_im;
            pt[8] = (unsigned long long)Pk.log_dt;
            pt[9] = (unsigned long long)Pk.sb_re;
            pt[10] = (unsigned long long)Pk.sb_im;
            pt[11] = (unsigned long long)Pk.sc_re;
            pt[12] = (unsigned long long)Pk.sc_im;
            pt[13] = (unsigned long long)Pk.ssm_d;
            pt[14] = (unsigned long long)Pk.w_glu;
            pt[15] = (unsigned long long)Pk.b_glu;
            pt[16] = (unsigned long long)Pk.ssm_og;
            pt[17] = (unsigned long long)Pk.conv_w;
            pt[18] = (unsigned long long)Pk.conv_b;
            pt[19] = (unsigned long long)Pk.wq;
            pt[20] = (unsigned long long)Pk.wk;
            pt[21] = (unsigned long long)Pk.wv;
            pt[22] = (unsigned long long)Pk.w_gates;
            pt[23] = (unsigned long long)Pk.b_ig;
            pt[24] = (unsigned long long)Pk.b_fg;
            pt[25] = (unsigned long long)Pk.m_ng;
            pt[26] = (unsigned long long)Pk.m_skip;
            pt[27] = (unsigned long long)Pk.w_out;
            pt[28] = (unsigned long long)Pk.final_gain;
            pt[29] = (unsigned long long)Pk.out; pt[30] = (unsigned long long)Pk.ws;
        }
    }
    __syncthreads();
    LAS char* shm = (LAS char*)lds_raw;
    float* ldsf = (float*)lds_raw + HALF * HALF_FLOATS;
    volatile LAS unsigned* bst = (volatile LAS unsigned*)(shm + LDS_BYTES - 16);
    if (threadIdx.x < 4) bst[threadIdx.x] = 0u;
    __syncthreads();
    const XcdBarrier gbar = xcd_barrier_post((unsigned*)((char*)ldptr(shm, 30) + SLOT * 7 + BAR_OFF), bst);
    REP(4096) mod_phase(shm, PF(1), PF(3), PF(4), mod);
    xcd_barrier(gbar);
    layer_body<0>(shm, gbar);
    layer_body<1>(shm, gbar);
    final_rows(OUTP, PF(28));
}

#undef WSB
#undef SL
#undef S7
#undef WinT
#undef WgluT
#undef WqkvT
#undef WoutT
#undef mod
#undef gpart
#undef WfT
#undef rowss
#undef OUTP
#undef H
#undef U
#undef Y
#undef Z
#undef XC
#undef MI
#undef Q
#undef Kb
#undef V
#undef HC
extern "C" void kernel_launch(void* const* d_in, const int* in_sizes, int n_in, void* d_out, int out_size, void* d_ws, size_t ws_size, hipStream_t stream) {
    static int grid_blocks = 0;
    if (!grid_blocks) {
        int dev = 0, cus = 0, per_cu = 0;
        (void)hipGetDevice(&dev);
        (void)hipDeviceGetAttribute(&cus, hipDeviceAttributeMultiprocessorCount, dev);
        (void)hipFuncSetAttribute((const void*)mega, hipFuncAttributeMaxDynamicSharedMemorySize, LDS_BYTES);
        (void)hipOccupancyMaxActiveBlocksPerMultiprocessor(&per_cu, (const void*)mega, 512, LDS_BYTES);
        grid_blocks = cus;
        fprintf(stderr, "mega: cus=%d occupancy per_cu=%d grid=%d\n", cus, per_cu, grid_blocks);
    }
    (void)hipMemsetAsync((char*)d_ws + SLOT * 7 + BAR_OFF, 0, XCD_BAR_WORDS * 4, stream);
    Params P{};
    const float** pp = (const float**)&P;
    for (int i = 0; i < 29; ++i) pp[i] = (const float*)d_in[i];
    P.out = (float*)d_out; P.ws = (char*)d_ws;
    void* args[] = {&P};
    hipError_t e = hipLaunchCooperativeKernel((const void*)mega, dim3(grid_blocks), dim3(512), args, LDS_BYTES, stream);
    if (e != hipSuccess) fprintf(stderr, "cooperative launch failed: %s (grid %d)\n", hipGetErrorString(e), grid_blocks);
}
```

```cpp
#include <hip/hip_runtime.h>
#include <cstdio>
#include <cstdint>
#include <hip/hip_cooperative_groups.h>
namespace cg = cooperative_groups;

#ifndef REPMASK
#define REPMASK 0
#endif
typedef unsigned short bf16_t;
#define DEV __device__ __forceinline__

constexpr int BATCH = 8, SEQ = 2048, DM = 1024, MTOK = BATCH * SEQ;
constexpr int NG = 64, NP = 64, GC = 16, NH = 4, DH = 256, CHUNK = 64, INC = 5120;
constexpr float EPS = 1e-6f;

DEV int opaque_tid() { int t = threadIdx.x; asm volatile("" : "+v"(t)); return t; }
#define TIDH (opaque_tid() & 255)
#define HALF (opaque_tid() >> 8)
DEV float bf2f(bf16_t v) { return __uint_as_float(((unsigned)v) << 16); }
typedef __bf16 bf16n2 __attribute__((ext_vector_type(2)));
typedef float f32n2 __attribute__((ext_vector_type(2)));
DEV bf16_t f2bf(float f) { __bf16 b = (__bf16)f; return __builtin_bit_cast(unsigned short, b); }
DEV unsigned pk2(float lo, float hi) { f32n2 v = {lo, hi}; bf16n2 b = __builtin_convertvector(v, bf16n2); return __builtin_bit_cast(unsigned, b); }
DEV float sigmoidf_(float x) { return 1.f / (1.f + __expf(-x)); }
DEV float siluf_(float x) { return x / (1.f + __expf(-x)); }
DEV float geluf_(float x) { float t = 0.7978845608028654f * (x + 0.044715f * x * x * x); return 0.5f * x * (1.f + tanhf(t)); }
DEV float logsigmoidf_(float x) { return fminf(x, 0.f) - log1pf(__expf(-fabsf(x))); }

DEV float wave_sum(float v) {
#pragma unroll
    for (int o = 1; o < 64; o <<= 1) v += __shfl_xor(v, o);
    return v;
}
DEV float block_sum256(float v, float* red) {
    v = wave_sum(v);
    __syncthreads();
    if ((TIDH & 63) == 0) red[TIDH >> 6] = v;
    __syncthreads();
    return red[0] + red[1] + red[2] + red[3];
}

DEV void k_mod(int vb, float* ldsf, const float* c, const float* w_mod, const float* b_mod, float* mod) {
    float (*sc)[DM] = (float (*)[DM])ldsf;
    const int l = vb / 12, n = (vb % 12) * 256 + TIDH;
    __syncthreads();
    for (int i = TIDH; i < BATCH * DM; i += 256) sc[i / DM][i % DM] = siluf_(c[i]);
    __syncthreads();
    float acc[BATCH];
#pragma unroll
    for (int b = 0; b < BATCH; ++b) acc[b] = 0.f;
    const float* W = w_mod + (size_t)l * DM * 3 * DM;
    for (int k = 0; k < DM; ++k) {
        float w = W[(size_t)k * 3 * DM + n];
#pragma unroll
        for (int b = 0; b < BATCH; ++b) acc[b] += sc[b][k] * w;
    }
#pragma unroll
    for (int b = 0; b < BATCH; ++b) mod[((size_t)l * BATCH + b) * 3 * DM + n] = acc[b] + b_mod[l * 3 * DM + n];
}

DEV void k_norm_mod(int vb, float* red, const float* x, const float* gain, const float* mod  , bf16_t* h) {
    const int m = vb, b = m / SEQ, t = TIDH;
    const float4 v = ((const float4*)(x + (size_t)m * DM))[t];
    float ss = v.x * v.x + v.y * v.y + v.z * v.z + v.w * v.w;
    ss = block_sum256(ss, red);
    const float rstd = rsqrtf(ss * (1.f / DM) + EPS);
    const float* shift = mod + (size_t)b * 3 * DM;
    const float* scale = shift + DM;
    float xv[4] = {v.x, v.y, v.z, v.w};
#pragma unroll
    for (int i = 0; i < 4; ++i) {
        int n = t * 4 + i;
        float y = xv[i] * rstd * gain[n] * (1.f + scale[n]) + shift[n];
        h[(size_t)m * DM + n] = f2bf(y);
    }
}

DEV void k_s5(int item, float* ldsf, const bf16_t* u, bf16_t* y, const float* lam_re, const float* lam_im, const float* log_dt,
                                           const float* b_re, const float* b_im, const float* c_re, const float* c_im, const float* dskip) {
    const int tid_ = opaque_tid();
    float (*part)[17] = (float (*)[17])(ldsf + (tid_ >> 6) * 64 * 17);
    const int g = item & 63, b = item >> 6, p = tid_ & 63;
    const double lr = lam_re[g * NP + p], li = lam_im[g * NP + p], dt = exp((double)log_dt[g]);
    const double er = exp(lr * dt);
    const double ard = er * cos(li * dt), aid = er * sin(li * dt);
    const double dr = ard - 1.0, di = aid, den = lr * lr + li * li;
    const double cr = (dr * lr + di * li) / den, ci = (di * lr - dr * li) / den;
    float bbr[16], bbi[16], ccr[16], cci[16];
#pragma unroll
    for (int c = 0; c < 16; ++c) {
        const double br = b_re[(g * NP + p) * GC + c], bi = b_im[(g * NP + p) * GC + c];
        bbr[c] = (float)(cr * br - ci * bi); bbi[c] = (float)(cr * bi + ci * br);
        ccr[c] = c_re[(g * GC + c) * NP + p]; cci[c] = c_im[(g * GC + c) * NP + p];
    }
    const float ar = (float)ard, ai = (float)aid;
    const float dsk = dskip[g * GC + (p & 15)];
    float sr = 0.f, si = 0.f;
    for (int t = 0; t < SEQ; ++t) {
        const bf16_t* up = u + (size_t)(b * SEQ + t) * DM + g * GC;
        const uint4 u0 = *(const uint4*)up, u1 = *(const uint4*)(up + 8);
        float uf[16];
        uf[0] = bf2f(u0.x & 0xffff); uf[1] = bf2f(u0.x >> 16); uf[2] = bf2f(u0.y & 0xffff); uf[3] = bf2f(u0.y >> 16);
        uf[4] = bf2f(u0.z & 0xffff); uf[5] = bf2f(u0.z >> 16); uf[6] = bf2f(u0.w & 0xffff); uf[7] = bf2f(u0.w >> 16);
        uf[8] = bf2f(u1.x & 0xffff); uf[9] = bf2f(u1.x >> 16); uf[10] = bf2f(u1.y & 0xffff); uf[11] = bf2f(u1.y >> 16);
        uf[12] = bf2f(u1.z & 0xffff); uf[13] = bf2f(u1.z >> 16); uf[14] = bf2f(u1.w & 0xffff); uf[15] = bf2f(u1.w >> 16);
        float bur = 0.f, bui = 0.f;
#pragma unroll
        for (int c = 0; c < 16; ++c) { bur += bbr[c] * uf[c]; bui += bbi[c] * uf[c]; }
        const float nr = ar * sr - ai * si + bur, ni = ar * si + ai * sr + bui;
        sr = nr; si = ni;
#pragma unroll
        for (int c = 0; c < 16; ++c) part[p][c] = ccr[c] * sr - cci[c] * si;
        asm volatile("s_waitcnt lgkmcnt(0)" ::: "memory");
        float s = 0.f;
#pragma unroll
        for (int k = 0; k < 16; ++k) s += part[(p >> 4) * 16 + k][p & 15];
        s += __shfl_xor(s, 16); s += __shfl_xor(s, 32);
        if (p < 16) {
            const float yv = s + dsk * bf2f(up[p]);
            y[(size_t)(b * SEQ + t) * DM + g * GC + p] = f2bf(geluf_(yv));
        }
        asm volatile("s_waitcnt lgkmcnt(0)" ::: "memory");
    }
}

DEV void k_ssm_post(int vb, float* red, bf16_t* z, const bf16_t* sg, const float* gain) {
    const int m = vb, t = TIDH;
    float zv[4]; float ss = 0.f;
#pragma unroll
    for (int i = 0; i < 4; ++i) { zv[i] = bf2f(z[(size_t)m * DM + t * 4 + i]); ss += zv[i] * zv[i]; }
    ss = block_sum256(ss, red);
    const float rstd = rsqrtf(ss * (1.f / DM) + EPS);
#pragma unroll
    for (int i = 0; i < 4; ++i) {
        const int n = t * 4 + i;
        z[(size_t)m * DM + n] = f2bf(zv[i] * rstd * gain[n] * siluf_(bf2f(sg[(size_t)m * DM + n])));
    }
}

DEV float conv_xc(const bf16_t* mi, int m, int n, const float* cw, const float* cb) {
    const int t = m % SEQ;
    float acc = cb[n];
#pragma unroll
    for (int j = 0; j < 4; ++j) {
        const int tt = t - 3 + j;
        if (tt >= 0) acc += bf2f(mi[(size_t)(m - 3 + j) * DM + n]) * cw[j * DM + n];
    }
    return siluf_(acc);
}
DEV void k_conv(int vb, const bf16_t* mi, bf16_t* xc, const float* cw, const float* cb) {
    const size_t idx = (size_t)vb * 256 + TIDH;
    const int m = (int)(idx / DM), n = (int)(idx % DM);
    xc[idx] = f2bf(conv_xc(mi, m, n, cw, cb));
}

DEV void k_gates(int vb, float* ldsf, const bf16_t* q, const bf16_t* k, const bf16_t* v, const float* wg  , const float* bi, const float* bfg,
                                               float* ipre, float* logf) {
    float (*red)[8] = (float (*)[8])ldsf;
    const int m = vb, t = TIDH;
    __syncthreads();
    float acc[8];
#pragma unroll
    for (int j = 0; j < 8; ++j) acc[j] = 0.f;
    for (int e = t; e < 3 * DM; e += 256) {
        const bf16_t* src = (e < DM) ? q : (e < 2 * DM ? k : v);
        const float xv = bf2f(src[(size_t)m * DM + (e & (DM - 1))]);
#pragma unroll
        for (int j = 0; j < 8; ++j) acc[j] += xv * wg[e * 8 + j];
    }
#pragma unroll
    for (int j = 0; j < 8; ++j) acc[j] = wave_sum(acc[j]);
    if ((t & 63) == 0) {
#pragma unroll
        for (int j = 0; j < 8; ++j) red[t >> 6][j] = acc[j];
    }
    __syncthreads();
    if (t < 8) {
        const float s = red[0][t] + red[1][t] + red[2][t] + red[3][t];
        if (t < 4) ipre[(size_t)m * 4 + t] = s + bi[t];
        else logf[(size_t)m * 4 + (t - 4)] = logsigmoidf_(s + bfg[t - 4]);
    }
}

DEV void k_mlstm(int vb, float* ldsf, const bf16_t* q, const bf16_t* k, const bf16_t* v, const float* ipre, const float* logf, bf16_t* hc) {
    float (*Cs)[257] = (float (*)[257])ldsf;
    float (*St)[65] = (float (*)[65])(ldsf + 32 * 257);
    float* nvec = ldsf + 32 * 257 + 64 * 65;
    float* bcum = nvec + 256; float* ig = bcum + 64; float* mt = ig + 64; float* winter = mt + 64; float* ws_ = winter + 64; float* hden = ws_ + 64;
    float* sc = hden + 64;
    const int tid = TIDH;
    const int vs = vb & 7, h = (vb >> 3) & 3, b = vb >> 5;
    __syncthreads();
    for (int i = tid; i < 32 * 257; i += 256) (&Cs[0][0])[i] = 0.f;
    nvec[tid] = 0.f;
    if (tid == 0) sc[0] = 0.f;
    __syncthreads();
    const size_t base = (size_t)b * SEQ * DM + h * DH;
    for (int j = 0; j < SEQ / CHUNK; ++j) {
        const size_t cb = base + (size_t)j * CHUNK * DM;
        const int m0 = b * SEQ + j * CHUNK;
        if (tid < 64) {
            ig[tid] = ipre[(size_t)(m0 + tid) * 4 + h];
            ws_[tid] = logf[(size_t)(m0 + tid) * 4 + h];
        }
        __syncthreads();
        if (tid < 64) { float s = 0.f; for (int i = 0; i <= tid; ++i) s += ws_[i]; bcum[tid] = s; }
        __syncthreads();
        const float m_prev = sc[0];
        if (tid < 64) {
            const float m_inter = bcum[tid] + m_prev;
            float mx = -INFINITY;
            for (int s = 0; s <= tid; ++s) mx = fmaxf(mx, bcum[tid] - bcum[s] + ig[s]);
            const float m = fmaxf(m_inter, mx);
            mt[tid] = m; winter[tid] = __expf(m_inter - m);
        }
        __syncthreads();
        for (int idx = tid; idx < 4096; idx += 256) {
            const int t = idx >> 6, s = idx & 63;
            float r = 0.f;
            if (s <= t) {
                const bf16_t* qp = q + cb + (size_t)t * DM; const bf16_t* kp = k + cb + (size_t)s * DM;
                float dot = 0.f;
                for (int d = 0; d < DH; d += 8) {
                    const uint4 qa = *(const uint4*)(qp + d), ka = *(const uint4*)(kp + d);
                    dot += bf2f(qa.x & 0xffff) * bf2f(ka.x & 0xffff) + bf2f(qa.x >> 16) * bf2f(ka.x >> 16);
                    dot += bf2f(qa.y & 0xffff) * bf2f(ka.y & 0xffff) + bf2f(qa.y >> 16) * bf2f(ka.y >> 16);
                    dot += bf2f(qa.z & 0xffff) * bf2f(ka.z & 0xffff) + bf2f(qa.z >> 16) * bf2f(ka.z >> 16);
                    dot += bf2f(qa.w & 0xffff) * bf2f(ka.w & 0xffff) + bf2f(qa.w >> 16) * bf2f(ka.w >> 16);
                }
                r = dot * __expf(bcum[t] - bcum[s] + ig[s] - mt[t]);
            }
            St[t][s] = r;
        }
        __syncthreads();
        if (tid < 64) {
            const bf16_t* qp = q + cb + (size_t)tid * DM;
            float dn = 0.f;
            for (int d = 0; d < DH; ++d) dn += nvec[d] * bf2f(qp[d]);
            float sm = 0.f;
            for (int s = 0; s < 64; ++s) sm += St[tid][s];
            const float den = winter[tid] * dn + sm;
            hden[tid] = fmaxf(fabsf(den), __expf(-mt[tid]));
        }
        __syncthreads();
        for (int idx = tid; idx < 2048; idx += 256) {
            const int t = idx >> 5, vv = idx & 31;
            const bf16_t* qp = q + cb + (size_t)t * DM;
            float a = 0.f;
            for (int d = 0; d < DH; ++d) a += Cs[vv][d] * bf2f(qp[d]);
            float s2 = 0.f;
            for (int s = 0; s < 64; ++s) s2 += St[t][s] * bf2f(v[cb + (size_t)s * DM + vs * 32 + vv]);
            const float num = winter[t] * a + s2;
            hc[cb + (size_t)t * DM + vs * 32 + vv] = f2bf(num / hden[t]);
        }
        __syncthreads();
        const float b_tot = bcum[63];
        if (tid < 64) ws_[tid] = b_tot - bcum[tid] + ig[tid];
        __syncthreads();
        if (tid == 0) {
            float mx = b_tot + m_prev;
            for (int s = 0; s < 64; ++s) mx = fmaxf(mx, ws_[s]);
            sc[1] = __expf(b_tot + m_prev - mx); sc[0] = mx;
        }
        __syncthreads();
        const float m_next = sc[0], decay = sc[1];
        float myw = 0.f;
        if (tid < 64) myw = __expf(ws_[tid] - m_next);
        __syncthreads();
        if (tid < 64) ws_[tid] = myw;
        __syncthreads();
        for (int idx = tid; idx < 32 * 256; idx += 256) {
            const int vv = idx >> 8, d = idx & 255;
            float a = 0.f;
            for (int s = 0; s < 64; ++s) a += ws_[s] * bf2f(v[cb + (size_t)s * DM + vs * 32 + vv]) * bf2f(k[cb + (size_t)s * DM + d]);
            Cs[vv][d] = decay * Cs[vv][d] + a;
        }
        {
            float a = 0.f;
            for (int s = 0; s < 64; ++s) a += ws_[s] * bf2f(k[cb + (size_t)s * DM + tid]);
            nvec[tid] = decay * nvec[tid] + a;
        }
        __syncthreads();
    }
}

DEV void k_mlstm_post(int vb, bf16_t* hc, const bf16_t* mo, const bf16_t* mg, const bf16_t* mi, const float* cw, const float* cb,
                                                    const float* ngain, const float* skip) {
    const int m = vb, t = TIDH;
    float hv[4]; float s = 0.f;
#pragma unroll
    for (int i = 0; i < 4; ++i) {
        const size_t o = (size_t)m * DM + t * 4 + i;
        hv[i] = bf2f(hc[o]) * sigmoidf_(bf2f(mo[o])); s += hv[i];
    }
    const float mu = wave_sum(s) * (1.f / DH);
    float s2 = 0.f;
#pragma unroll
    for (int i = 0; i < 4; ++i) { hv[i] -= mu; s2 += hv[i] * hv[i]; }
    const float rstd = rsqrtf(wave_sum(s2) * (1.f / DH) + EPS);
#pragma unroll
    for (int i = 0; i < 4; ++i) {
        const int n = t * 4 + i; const size_t o = (size_t)m * DM + n;
        const float xc = conv_xc(mi, m, n, cw, cb);
        const float hn = hv[i] * rstd * ngain[n] + skip[n] * xc;
        hc[o] = f2bf(hn * siluf_(bf2f(mg[o])));
    }
}

DEV void k_final(int vb, float* red, float* x, const float* gain) {
    const int m = vb, t = TIDH;
    float4 v = ((float4*)(x + (size_t)m * DM))[t];
    float ss = v.x * v.x + v.y * v.y + v.z * v.z + v.w * v.w;
    ss = block_sum256(ss, red);
    const float rstd = rsqrtf(ss * (1.f / DM) + EPS);
    const float4 g = ((const float4*)gain)[t];
    v.x *= rstd * g.x; v.y *= rstd * g.y; v.z *= rstd * g.z; v.w *= rstd * g.w;
    ((float4*)(x + (size_t)m * DM))[t] = v;
}


#define LAS __attribute__((address_space(3)))
typedef short bf16x8 __attribute__((ext_vector_type(8)));
typedef float f32x4 __attribute__((ext_vector_type(4)));
typedef short s16x4 __attribute__((ext_vector_type(4)));
typedef unsigned u32x4 __attribute__((ext_vector_type(4)));
typedef unsigned u32x2 __attribute__((ext_vector_type(2)));
typedef float f32x2 __attribute__((ext_vector_type(2)));
#define WAIT_V(n) asm volatile("s_waitcnt vmcnt(" #n ")" ::: "memory")
#define WAIT_L(n) asm volatile("s_waitcnt lgkmcnt(" #n ")" ::: "memory")
#define SCHED() __builtin_amdgcn_sched_barrier(0)

DEV int lds_byte(int r, int c) { int st = (r >> 4) * 2 + (c >> 5), ob = (r & 15) * 64 + (c & 31) * 2; return st * 1024 + (ob ^ (((ob >> 9) & 1) << 5)); }
DEV void stage_rc(int b, int& R, int& C) { int st = b >> 10, sb = b & 1023, swz = sb ^ (((sb >> 9) & 1) << 5); R = (st >> 1) * 16 + swz / 64; C = (st & 1) * 32 + (swz % 64) / 2; }
template <class T> DEV T* sel3(int w, T* p0, T* p1, T* p2) { return p0 + ((w >= 1) ? (p1 - p0) : 0) + ((w >= 2) ? (p2 - p1) : 0); }
DEV void unpack8(const uint4 v, float* f) {
    f[0] = bf2f((bf16_t)(v.x & 0xffff)); f[1] = bf2f((bf16_t)(v.x >> 16)); f[2] = bf2f((bf16_t)(v.y & 0xffff)); f[3] = bf2f((bf16_t)(v.y >> 16));
    f[4] = bf2f((bf16_t)(v.z & 0xffff)); f[5] = bf2f((bf16_t)(v.z >> 16)); f[6] = bf2f((bf16_t)(v.w & 0xffff)); f[7] = bf2f((bf16_t)(v.w >> 16));
}
DEV uint4 pack8(const float* f) { return make_uint4(pk2(f[0], f[1]), pk2(f[2], f[3]), pk2(f[4], f[5]), pk2(f[6], f[7])); }
DEV uint2 pack4(f32x4 v) { uint2 r; r.x = pk2(v[0], v[1]); r.y = pk2(v[2], v[3]); return r; }

struct GemmCtx { int wid, lane, wr, wc, fr, fq; int sR[4], sC[4]; };
DEV GemmCtx gemm_ctx() {
    GemmCtx c; const int tid = opaque_tid();
    c.wid = __builtin_amdgcn_readfirstlane(tid >> 6); c.lane = tid & 63; c.wr = c.wid >> 2; c.wc = c.wid & 3; c.fr = c.lane & 15; c.fq = c.lane >> 4;
#pragma unroll
    for (int i = 0; i < 4; ++i) stage_rc(c.wid * 1024 + i * 8192 + c.lane * 16, c.sR[i], c.sC[i]);
    return c;
}
DEV void gemm_mainloop(LAS char* shm, const GemmCtx& c, const bf16_t* A1row, const bf16_t* A2row, int ktsplit, int lda, const bf16_t* Bb, int ldb, int nt, f32x4 (&acc)[8][4]) {
    constexpr int TILE_B = 256 * 64 * 2, STAGE_B = 2 * TILE_B;
    const int wid = c.wid, wr = c.wr, wc = c.wc, fr = c.fr, fq = c.fq;
    unsigned voA[4], voB[4];
#pragma unroll
    for (int i = 0; i < 4; ++i) { voA[i] = (unsigned)(c.sR[i] * lda + c.sC[i]) * 2u; voB[i] = (unsigned)(c.sR[i] * ldb + c.sC[i]) * 2u; asm volatile("" : "+v"(voA[i]), "+v"(voB[i])); }
#define GLDS_STAGE(buf, kt) do { const char* Ak_ = (const char*)(((kt) < ktsplit) ? (A1row + (kt) * 64) : (A2row + ((kt) - ktsplit) * 64)); const char* Bk_ = (const char*)(Bb + (kt) * 64); \
        _Pragma("unroll") for (int i = 0; i < 4; ++i) { \
            __builtin_amdgcn_global_load_lds((const unsigned*)(Ak_ + voA[i]), (LAS unsigned*)(shm + (buf) * STAGE_B + wid * 1024 + i * 8192), 16, 0, 0); \
            __builtin_amdgcn_global_load_lds((const unsigned*)(Bk_ + voB[i]), (LAS unsigned*)(shm + (buf) * STAGE_B + TILE_B + wid * 1024 + i * 8192), 16, 0, 0); } } while (0)
#pragma unroll
    for (int m = 0; m < 8; ++m)
#pragma unroll
        for (int n = 0; n < 4; ++n) acc[m][n] = (f32x4){0.f, 0.f, 0.f, 0.f};
    GLDS_STAGE(0, 0); WAIT_V(0); __syncthreads();
#pragma nounroll
    for (int kt = 0; kt < nt; ++kt) {
        const int cur = kt & 1;
        if (kt + 1 < nt) GLDS_STAGE(cur ^ 1, kt + 1);
#pragma unroll
        for (int ks = 0; ks < 2; ++ks) {
            bf16x8 At[8], Bf[4];
#pragma unroll
            for (int m = 0; m < 8; ++m) At[m] = *(const LAS bf16x8*)(shm + cur * STAGE_B + lds_byte(wr * 128 + m * 16 + fr, ks * 32 + fq * 8));
#pragma unroll
            for (int n = 0; n < 4; ++n) Bf[n] = *(const LAS bf16x8*)(shm + cur * STAGE_B + TILE_B + lds_byte(wc * 64 + n * 16 + fr, ks * 32 + fq * 8));
#pragma unroll
            for (int m = 0; m < 8; ++m)
#pragma unroll
                for (int n = 0; n < 4; ++n) acc[m][n] = __builtin_amdgcn_mfma_f32_16x16x32_bf16(Bf[n], At[m], acc[m][n], 0, 0, 0);
            SCHED();
        }
        WAIT_V(0); __syncthreads();
    }
#undef GLDS_STAGE
}
DEV void tile_map(int t, int nN, int& pm, int& pn) {
    const int base = t & ~255, loc = t & 255;
    const int w = base + (loc & 7) * 32 + (loc >> 3);
    const int nig = 8 * nN, gid = w / nig;
    pm = gid * 8 + (w % nig) % 8; pn = (w % nig) / 8;
}
template <class Prob>
DEV void gemm_phase(LAS char* shm, const Prob& pb) {
    const GemmCtx c = gemm_ctx();
    const int nN = pb.nN, ntiles = 64 * nN;
    for (int t = blockIdx.x; t < ntiles; t += gridDim.x) {
        int pm, pn; tile_map(t, nN, pm, pn);
        const int brow = pm * 256, bcol = pn * 256;
        f32x4 acc[8][4];
        gemm_mainloop(shm, c, pb.a1(pn) + (long)brow * Prob::lda, pb.a2(pn) + (long)brow * Prob::lda, Prob::ktsplit, Prob::lda, pb.bptr(pn), Prob::ldb, Prob::K / 64, acc);
        pb.epi_begin(shm, c, pn, brow);
#pragma unroll
        for (int m = 0; m < 8; ++m)
#pragma unroll
            for (int n = 0; n < 4; ++n) pb.epi(pn, brow + c.wr * 128 + m * 16 + c.fr, bcol + c.wc * 64 + n * 16 + c.fq * 4, acc[m][n]);
        pb.epi_end(c, pn, brow, acc);
    }
}

struct ProbG1 {
    static constexpr int K = 1024, lda = 1024, ldb = 1024, ktsplit = 1 << 20;
    const bf16_t* H; const bf16_t* Wt; bf16_t* U; bf16_t* MI; int nN;
    DEV const bf16_t* a1(int pn) const { return H; }
    DEV const bf16_t* a2(int pn) const { return H; }
    DEV const bf16_t* bptr(int pn) const { return Wt + (long)((pn < 4) ? pn * 256 : 2048 + (pn - 4) * 256) * 1024; }
    DEV void epi_begin(LAS char*, const GemmCtx&, int, int) const {}
    DEV void epi(int pn, int row, int col, f32x4 v) const { bf16_t* C = (pn < 4) ? U : MI; *(uint2*)(C + (size_t)row * DM + (col & 1023)) = pack4(v); }
    DEV void epi_end(const GemmCtx&, int, int, f32x4 (&)[8][4]) const {}
};
struct ProbGlu {
    static constexpr int K = 1024, lda = 1024, ldb = 1024, ktsplit = 1 << 20;
    const bf16_t* Y; const bf16_t* Wt; bf16_t* Z; const float* bias; float* rowss; int nN;
    DEV const bf16_t* a1(int pn) const { return Y; }
    DEV const bf16_t* a2(int pn) const { return Y; }
    DEV const bf16_t* bptr(int pn) const { return Wt + (long)pn * 256 * 1024; }
    DEV void epi_begin(LAS char*, const GemmCtx&, int, int) const {}
    DEV void epi(int pn, int row, int col, f32x4 v) const {}
    DEV void epi_end(const GemmCtx& c0, int pn, int brow, f32x4 (&acc)[8][4]) const {
        struct { int fr, fq, wr, wc; } c = {c0.fr, c0.fq, c0.wr, c0.wc};
        asm volatile("" : "+v"(c.fr), "+v"(c.fq));
#pragma unroll
        for (int m = 0; m < 8; ++m) {
            SCHED();
            const int row = brow + c.wr * 128 + m * 16 + c.fr;
            float ss = 0.f;
#pragma unroll
            for (int n = 0; n < 4; ++n) {
                const int col = pn * 256 + c.wc * 64 + n * 16 + c.fq * 4;
                const uint2 yv = *(const uint2*)(Y + (size_t)row * DM + col);
                const float4 b = *(const float4*)(bias + col);
                f32x4 o;
                o[0] = bf2f(yv.x & 0xffff) * sigmoidf_(acc[m][n][0] + b.x); o[1] = bf2f(yv.x >> 16) * sigmoidf_(acc[m][n][1] + b.y);
                o[2] = bf2f(yv.y & 0xffff) * sigmoidf_(acc[m][n][2] + b.z); o[3] = bf2f(yv.y >> 16) * sigmoidf_(acc[m][n][3] + b.w);
                const uint2 pk = pack4(o);
                *(uint2*)(Z + (size_t)row * DM + col) = pk;
                const float r0 = bf2f(pk.x & 0xffff), r1 = bf2f(pk.x >> 16), r2 = bf2f(pk.y & 0xffff), r3 = bf2f(pk.y >> 16);
                ss += r0 * r0 + r1 * r1 + r2 * r2 + r3 * r3;
            }
            ss += __shfl_xor(ss, 16); ss += __shfl_xor(ss, 32);
            if (c.fq == 0) rowss[(size_t)(pn * 4 + c.wc) * MTOK + row] = ss;
        }
    }
};
struct ProbQkv {
    static constexpr int K = 256, lda = 1024, ldb = 256, ktsplit = 1 << 20;
    const bf16_t* XC; const bf16_t* MI; const bf16_t* Wt; bf16_t* Q; bf16_t* Kk; bf16_t* V; int nN;
    DEV const bf16_t* a1(int pn) const { return ((pn >> 2) == 2 ? MI : XC) + (pn & 3) * 256; }
    DEV const bf16_t* a2(int pn) const { return a1(pn); }
    DEV const bf16_t* bptr(int pn) const { return Wt + (long)pn * 256 * 256; }
    DEV void epi_begin(LAS char*, const GemmCtx&, int, int) const {}
    DEV void epi(int pn, int row, int col, f32x4 v) const {
        const int which = pn >> 2; bf16_t* C = sel3(which, Q, Kk, V);
        if (which == 1) { v[0] *= 0.0625f; v[1] *= 0.0625f; v[2] *= 0.0625f; v[3] *= 0.0625f; }
        *(uint2*)(C + (size_t)row * DM + (col & 1023)) = pack4(v);
    }
    DEV void epi_end(const GemmCtx&, int, int, f32x4 (&)[8][4]) const {}
};
struct ProbOut {
    static constexpr int K = 2048, lda = 1024, ldb = 2048, ktsplit = 16;
    const bf16_t* A1; const bf16_t* A2; const bf16_t* Wt; const float* xin; float* xout; const float* gate; int nN;
    DEV const bf16_t* a1(int pn) const { return A1; }
    DEV const bf16_t* a2(int pn) const { return A2; }
    DEV const bf16_t* bptr(int pn) const { return Wt + (long)pn * 256 * 2048; }
    DEV void epi_begin(LAS char*, const GemmCtx&, int, int) const {}
    DEV void epi(int pn, int row, int col, f32x4 v) const {
        const int b = row / SEQ;
        const float4 xi = *(const float4*)(xin + (size_t)row * DM + col);
        const float4 g = *(const float4*)(gate + (size_t)b * 3 * DM + col);
        float4 o; o.x = xi.x + g.x * v[0]; o.y = xi.y + g.y * v[1]; o.z = xi.z + g.z * v[2]; o.w = xi.w + g.w * v[3];
        *(float4*)(xout + (size_t)row * DM + col) = o;
    }
    DEV void epi_end(const GemmCtx&, int, int, f32x4 (&)[8][4]) const {}
};

struct G2Args {
    const bf16_t* H; const bf16_t* Wt;
    bf16_t* Z; const float* rowss; const float* og;
    bf16_t* HC; const bf16_t* XC; const float* ngain; const float* skip;
};
DEV void gemm2_phase(LAS char* shm, const G2Args& g) {
    const GemmCtx c = gemm_ctx();
    int efr, efq;
    LAS float* rst = (LAS float*)(shm + 131072);
    LAS float* red = (LAS float*)(shm + 131072 + 1024);
    for (int u = blockIdx.x; u < 512; u += gridDim.x) {
        f32x4 acc[8][4];
        if (u < 256) {
            int pm, pn; tile_map(u, 4, pm, pn);
            const int brow = pm * 256, bcol = pn * 256;
            gemm_mainloop(shm, c, g.H + (long)brow * DM, g.H, 1 << 20, DM, g.Wt + (long)(1024 + bcol) * DM, DM, 16, acc);
            efr = c.fr; efq = c.fq; asm volatile("" : "+v"(efr), "+v"(efq));
            { const int tid = c.wid * 64 + c.lane;
              if (tid < 256) { float s_ = 0.f;
#pragma unroll
                  for (int p_ = 0; p_ < 16; ++p_) s_ += g.rowss[(size_t)p_ * MTOK + brow + tid];
                  rst[tid] = rsqrtf(s_ * (1.f / DM) + EPS); } }
            __syncthreads();
#pragma unroll
            for (int m = 0; m < 8; ++m) {
                SCHED();
                const int rl = c.wr * 128 + m * 16 + efr, row = brow + rl;
                const float rs = rst[rl];
#pragma unroll
                for (int n = 0; n < 4; ++n) {
                    const int col = bcol + c.wc * 64 + n * 16 + efq * 4;
                    const uint2 zv = *(const uint2*)(g.Z + (size_t)row * DM + col);
                    const float4 gn = *(const float4*)(g.og + col);
                    f32x4 o;
                    o[0] = bf2f(zv.x & 0xffff) * rs * gn.x * siluf_(acc[m][n][0]); o[1] = bf2f(zv.x >> 16) * rs * gn.y * siluf_(acc[m][n][1]);
                    o[2] = bf2f(zv.y & 0xffff) * rs * gn.z * siluf_(acc[m][n][2]); o[3] = bf2f(zv.y >> 16) * rs * gn.w * siluf_(acc[m][n][3]);
                    *(uint2*)(g.Z + (size_t)row * DM + col) = pack4(o);
                }
            }
            __syncthreads();
        } else {
            int pm, hd; tile_map(u - 256, 4, pm, hd);
            const int brow = pm * 256, bcol = hd * 256;
            gemm_mainloop(shm, c, g.H + (long)brow * DM, g.H, 1 << 20, DM, g.Wt + (long)(3072 + bcol) * DM, DM, 16, acc);
            efr = c.fr; efq = c.fq; asm volatile("" : "+v"(efr), "+v"(efq));
        #pragma unroll
            for (int m = 0; m < 8; ++m) {
                SCHED();
                const int row = brow + c.wr * 128 + m * 16 + efr;
                float s_ = 0.f;
#pragma unroll
                for (int n = 0; n < 4; ++n) {
                    const int col = bcol + c.wc * 64 + n * 16 + efq * 4;
                    const uint2 hv = *(const uint2*)(g.HC + (size_t)row * DM + col);
                    acc[m][n][0] = bf2f(hv.x & 0xffff) * sigmoidf_(acc[m][n][0]); acc[m][n][1] = bf2f(hv.x >> 16) * sigmoidf_(acc[m][n][1]);
                    acc[m][n][2] = bf2f(hv.y & 0xffff) * sigmoidf_(acc[m][n][2]); acc[m][n][3] = bf2f(hv.y >> 16) * sigmoidf_(acc[m][n][3]);
                    s_ += (acc[m][n][0] + acc[m][n][1]) + (acc[m][n][2] + acc[m][n][3]);
                }
                s_ += __shfl_xor(s_, 16); s_ += __shfl_xor(s_, 32);
                if (efq == 0) red[c.wid * 128 + m * 16 + efr] = s_;
            }
            __syncthreads();
#pragma unroll
            for (int m = 0; m < 8; ++m) {
                SCHED();
                float tot = 0.f;
#pragma unroll
                for (int w2 = 0; w2 < 4; ++w2) tot += red[(c.wr * 4 + w2) * 128 + m * 16 + efr];
                const float mu = tot * (1.f / DH);
                float s_ = 0.f;
#pragma unroll
                for (int n = 0; n < 4; ++n)
#pragma unroll
                    for (int j = 0; j < 4; ++j) { acc[m][n][j] -= mu; s_ += acc[m][n][j] * acc[m][n][j]; }
                s_ += __shfl_xor(s_, 16); s_ += __shfl_xor(s_, 32);
                if (efq == 0) red[1024 + c.wid * 128 + m * 16 + efr] = s_;
            }
            __syncthreads();
#pragma unroll
            for (int m = 0; m < 8; ++m) {
                SCHED();
                const int row = brow + c.wr * 128 + m * 16 + efr;
                float tot = 0.f;
#pragma unroll
                for (int w2 = 0; w2 < 4; ++w2) tot += red[1024 + (c.wr * 4 + w2) * 128 + m * 16 + efr];
                const float rs = rsqrtf(tot * (1.f / DH) + EPS);
#pragma unroll
                for (int n = 0; n < 4; ++n) {
                    const int col = bcol + c.wc * 64 + n * 16 + efq * 4;
                    const uint2 xv = *(const uint2*)(g.XC + (size_t)row * DM + col);
                    const float4 gn = *(const float4*)(g.ngain + col), sk = *(const float4*)(g.skip + col);
                    f32x4 o;
                    o[0] = acc[m][n][0] * rs * gn.x + sk.x * bf2f(xv.x & 0xffff); o[1] = acc[m][n][1] * rs * gn.y + sk.y * bf2f(xv.x >> 16);
                    o[2] = acc[m][n][2] * rs * gn.z + sk.z * bf2f(xv.y & 0xffff); o[3] = acc[m][n][3] * rs * gn.w + sk.w * bf2f(xv.y >> 16);
                    *(uint2*)(g.HC + (size_t)row * DM + col) = pack4(o);
                }
            }
            gemm_mainloop(shm, c, g.H + (long)brow * DM, g.H, 1 << 20, DM, g.Wt + (long)(4096 + bcol) * DM, DM, 16, acc);
            efr = c.fr; efq = c.fq; asm volatile("" : "+v"(efr), "+v"(efq));
#pragma unroll
            for (int m = 0; m < 8; ++m) {
                SCHED();
                const int row = brow + c.wr * 128 + m * 16 + efr;
#pragma unroll
                for (int n = 0; n < 4; ++n) {
                    const int col = bcol + c.wc * 64 + n * 16 + efq * 4;
                    const uint2 hv = *(const uint2*)(g.HC + (size_t)row * DM + col);
                    f32x4 o;
                    o[0] = bf2f(hv.x & 0xffff) * siluf_(acc[m][n][0]); o[1] = bf2f(hv.x >> 16) * siluf_(acc[m][n][1]);
                    o[2] = bf2f(hv.y & 0xffff) * siluf_(acc[m][n][2]); o[3] = bf2f(hv.y >> 16) * siluf_(acc[m][n][3]);
                    *(uint2*)(g.HC + (size_t)row * DM + col) = pack4(o);
                }
            }
        }
    }
}


namespace g8 {
constexpr int BK = 64, HALFT = 128, HTB = HALFT * BK * 2;
DEV int perm32(int rho) { const int n = rho >> 4, i = rho & 15; return 8 * (i >> 2) + 4 * n + (i & 3); }
struct Unit { const char* A; const char* B; int pm, pn, tag; };
template <class Epi, class Sched>
DEV void gemm_phase(LAS char* lds, const Sched& S, const Epi& E) {
    const int tid = opaque_tid(), wid = __builtin_amdgcn_readfirstlane(tid >> 6), lane = tid & 63, wr = wid >> 2, wc = wid & 3, fr = lane & 15, fq = lane >> 4;
    constexpr int lda = Sched::lda, ldb = Sched::ldb, nt = Sched::K / BK;
    unsigned voffA[2], voffB[2];
#pragma unroll
    for (int i = 0; i < 2; ++i) { int R, C; stage_rc(tid * 16 + i * 8192, R, C); const int Rb = (R & ~31) + perm32(R & 31);
        voffA[i] = (unsigned)(R * lda + C) * 2u; voffB[i] = (unsigned)(Rb * ldb + C) * 2u; asm volatile("" : "+v"(voffA[i]), "+v"(voffB[i])); }
    constexpr size_t kstep = (size_t)(BK * 2), hstepA = (size_t)HALFT * lda * 2, hstepB = (size_t)HALFT * ldb * 2;
    const unsigned ldsw = (unsigned)wid * 1024u;
    const int aoff = lds_byte(wr * 64 + fr, fq * 8), boff = lds_byte(wc * 32 + fr, fq * 8);
#define G8_SA(b, h) (((b) * 2 + (h)) * HTB)
#define G8_SB(b, h) ((4 + (b) * 2 + (h)) * HTB)
#define G8_STAGE(bufoff, gbase, voff) do { _Pragma("unroll") for (int _i = 0; _i < 2; ++_i) \
        __builtin_amdgcn_global_load_lds((const unsigned*)((const char*)(gbase) + (voff)[_i]), (LAS unsigned*)(lds + (bufoff) + ldsw + _i * 8192), 16, 0, 0); } while (0)
#define G8_LDA(dst, b, h) do { _Pragma("unroll") for (int m = 0; m < 4; ++m) _Pragma("unroll") for (int k = 0; k < 2; ++k) dst[m][k] = *(const LAS bf16x8*)(lds + G8_SA(b, h) + aoff + m * 2048 + k * 1024); } while (0)
#define G8_LDB(dst, b, h) do { _Pragma("unroll") for (int n = 0; n < 2; ++n) _Pragma("unroll") for (int k = 0; k < 2; ++k) dst[n][k] = *(const LAS bf16x8*)(lds + G8_SB(b, h) + boff + n * 2048 + k * 1024); } while (0)
#define G8_MMA(ai, bj, At, Bt) do { __builtin_amdgcn_s_setprio(1); _Pragma("unroll") for (int m = 0; m < 4; ++m) _Pragma("unroll") for (int n = 0; n < 2; ++n) _Pragma("unroll") for (int k = 0; k < 2; ++k) \
        acc[ai][bj][m][n] = __builtin_amdgcn_mfma_f32_16x16x32_bf16(Bt[n][k], At[m][k], acc[ai][bj][m][n], 0, 0, 0); __builtin_amdgcn_s_setprio(0); } while (0)
#define G8_WAIT_V(n) asm volatile("s_waitcnt vmcnt(" #n ")" ::: "memory")
#define G8_WAIT_L(n) asm volatile("s_waitcnt lgkmcnt(" #n ")" ::: "memory")
#define G8_BAR __builtin_amdgcn_s_barrier()
#define G8_SCHED __builtin_amdgcn_sched_barrier(0)
    Unit cur, nxt; int ui = 0;
    if (!S.next(0, cur)) return;
    f32x4 acc[2][2][4][2];
#pragma unroll
    for (int a = 0; a < 2; ++a)
#pragma unroll
        for (int b = 0; b < 2; ++b)
#pragma unroll
            for (int m = 0; m < 4; ++m)
#pragma unroll
                for (int n = 0; n < 2; ++n) acc[a][b][m][n] = (f32x4){0.f, 0.f, 0.f, 0.f};
    bf16x8 At[4][2], B0[2][2], B1[2][2];
    const char* cA = cur.A; const char* cB = cur.B;
    G8_STAGE(G8_SB(0, 0), cB, voffB); G8_STAGE(G8_SB(0, 1), cB + hstepB, voffB); G8_STAGE(G8_SA(0, 0), cA, voffA); G8_STAGE(G8_SA(0, 1), cA + hstepA, voffA);
    if (wr == 1) G8_BAR;
    G8_WAIT_V(2); G8_BAR;
    G8_STAGE(G8_SB(1, 0), cB + kstep, voffB); G8_STAGE(G8_SA(1, 0), cA + kstep, voffA); G8_STAGE(G8_SB(1, 1), cB + hstepB + kstep, voffB);
    G8_WAIT_V(6); G8_BAR;
    for (;;) {
        const bool has_next = S.next(ui + 1, nxt);
        const char* nA = has_next ? nxt.A : cA; const char* nB = has_next ? nxt.B : cB;
#pragma nounroll
        for (int t = 0; t < nt; t += 2) {
            const bool last = (t == nt - 2);
            const char* a1 = cA + (size_t)(t + 1) * kstep;
            const char* a2 = last ? nA : cA + (size_t)(t + 2) * kstep; const char* b2 = last ? nB : cB + (size_t)(t + 2) * kstep;
            const char* a3 = a2 + kstep; const char* b3 = b2 + kstep;
            G8_LDB(B0, 0, 0); G8_LDB(B1, 0, 1); G8_SCHED; G8_LDA(At, 0, 0); G8_STAGE(G8_SA(1, 1), a1 + hstepA, voffA);
            G8_WAIT_V(8); G8_WAIT_L(0); G8_BAR; G8_MMA(0, 0, At, B0); G8_MMA(0, 1, At, B1); G8_BAR; G8_SCHED;
            G8_LDA(At, 0, 1); G8_STAGE(G8_SB(0, 0), b2, voffB); G8_STAGE(G8_SB(0, 1), b2 + hstepB, voffB); G8_STAGE(G8_SA(0, 0), a2, voffA);
            G8_WAIT_V(8); G8_WAIT_L(0); G8_BAR; G8_MMA(1, 0, At, B0); G8_MMA(1, 1, At, B1); G8_BAR; G8_SCHED;
            G8_LDB(B0, 1, 0); G8_LDB(B1, 1, 1); G8_SCHED; G8_LDA(At, 1, 0); G8_STAGE(G8_SA(0, 1), a2 + hstepA, voffA);
            G8_WAIT_V(8); G8_WAIT_L(0); G8_BAR; G8_MMA(0, 0, At, B0); G8_MMA(0, 1, At, B1); G8_BAR; G8_SCHED;
            G8_LDA(At, 1, 1); G8_STAGE(G8_SB(1, 0), b3, voffB); G8_STAGE(G8_SB(1, 1), b3 + hstepB, voffB); G8_STAGE(G8_SA(1, 0), a3, voffA);
            G8_WAIT_V(8); G8_WAIT_L(0); G8_BAR; G8_MMA(1, 0, At, B0); G8_MMA(1, 1, At, B1); G8_BAR; G8_SCHED;
        }
        if (wr == 0) G8_BAR;
        E(lds, acc, cur, wr, wc, fr, fq, wid, lane);
        if (!has_next) break;
#pragma unroll
        for (int a = 0; a < 2; ++a)
#pragma unroll
            for (int b = 0; b < 2; ++b)
#pragma unroll
                for (int m = 0; m < 4; ++m)
#pragma unroll
                    for (int n = 0; n < 2; ++n) acc[a][b][m][n] = (f32x4){0.f, 0.f, 0.f, 0.f};
        cur = nxt; cA = nA; cB = nB; ++ui;
        if (wr == 1) G8_BAR;
    }
    G8_WAIT_V(0);
    G8_BAR;
#undef G8_SA
#undef G8_SB
#undef G8_STAGE
#undef G8_LDA
#undef G8_LDB
#undef G8_MMA
#undef G8_WAIT_V
#undef G8_WAIT_L
#undef G8_BAR
#undef G8_SCHED
}
DEV u32x4 pk8(const f32x4 a, const f32x4 b) { return (u32x4){pk2(a[0], a[1]), pk2(a[2], a[3]), pk2(b[0], b[1]), pk2(b[2], b[3])}; }
DEV void un8(const u32x4 v, float* f) { unpack8(make_uint4(v[0], v[1], v[2], v[3]), f); }
#define G8_ROWS_BEGIN _Pragma("unroll") for (int ai = 0; ai < 2; ++ai) _Pragma("unroll") for (int m = 0; m < 4; ++m) { const int rl = 128 * ai + 64 * wr + 16 * m + fr;
#define G8_ROWS_END }

struct SchedG1 { static constexpr int K = 1024, lda = 1024, ldb = 1024; const bf16_t* H; const bf16_t* Wt; int bid, G;
    DEV bool next(int i, Unit& u) const { const int t = bid + i * G; if (t >= 512) return false; int pm, pn; tile_map(t, 8, pm, pn);
        u.pm = pm; u.pn = pn; u.tag = 0; u.A = (const char*)(H + (size_t)pm * 256 * DM); u.B = (const char*)(Wt + (size_t)((pn < 4) ? pn * 256 : 2048 + (pn - 4) * 256) * DM); return true; } };
struct EpiG1 { bf16_t* U; bf16_t* MI;
    DEV void operator()(LAS char*, const f32x4 (&acc)[2][2][4][2], const Unit& u, int wr, int wc, int fr, int fq, int, int) const {
        bf16_t* C = (u.pn < 4) ? U : MI; const int c0 = (u.pn & 3) * 256 + 32 * wc + 8 * fq;
        G8_ROWS_BEGIN bf16_t* rp = C + (size_t)(u.pm * 256 + rl) * DM + c0;
#pragma unroll
            for (int bj = 0; bj < 2; ++bj) *(u32x4*)(rp + 128 * bj) = pk8(acc[ai][bj][m][0], acc[ai][bj][m][1]); G8_ROWS_END } };
struct SchedGlu { static constexpr int K = 1024, lda = 1024, ldb = 1024; const bf16_t* Y; const bf16_t* Wt; int bid, G;
    DEV bool next(int i, Unit& u) const { const int t = bid + i * G; if (t >= 256) return false; int pm, pn; tile_map(t, 4, pm, pn);
        u.pm = pm; u.pn = pn; u.tag = 0; u.A = (const char*)(Y + (size_t)pm * 256 * DM); u.B = (const char*)(Wt + (size_t)pn * 256 * DM); return true; } };
struct EpiGlu { const bf16_t* Y; bf16_t* Z; const float* bias; float* rowss;
    DEV void operator()(LAS char*, const f32x4 (&acc)[2][2][4][2], const Unit& u, int wr, int wc, int fr, int fq, int, int) const {
        const int c0 = u.pn * 256 + 32 * wc + 8 * fq;
        G8_ROWS_BEGIN const size_t ro = (size_t)(u.pm * 256 + rl) * DM + c0; float ss = 0.f;
#pragma unroll
            for (int bj = 0; bj < 2; ++bj) {
                float y8[8]; un8(*(const u32x4*)(Y + ro + 128 * bj), y8);
                const float4 b0 = *(const float4*)(bias + c0 + 128 * bj), b1 = *(const float4*)(bias + c0 + 128 * bj + 4);
                f32x4 o0, o1;
                o0[0] = y8[0] * sigmoidf_(acc[ai][bj][m][0][0] + b0.x); o0[1] = y8[1] * sigmoidf_(acc[ai][bj][m][0][1] + b0.y); o0[2] = y8[2] * sigmoidf_(acc[ai][bj][m][0][2] + b0.z); o0[3] = y8[3] * sigmoidf_(acc[ai][bj][m][0][3] + b0.w);
                o1[0] = y8[4] * sigmoidf_(acc[ai][bj][m][1][0] + b1.x); o1[1] = y8[5] * sigmoidf_(acc[ai][bj][m][1][1] + b1.y); o1[2] = y8[6] * sigmoidf_(acc[ai][bj][m][1][2] + b1.z); o1[3] = y8[7] * sigmoidf_(acc[ai][bj][m][1][3] + b1.w);
                const u32x4 pk = pk8(o0, o1); *(u32x4*)(Z + ro + 128 * bj) = pk;
                float r8[8]; un8(pk, r8);
#pragma unroll
                for (int e = 0; e < 8; ++e) ss += r8[e] * r8[e];
            }
            ss += __shfl_xor(ss, 16); ss += __shfl_xor(ss, 32);
            if (fq == 0) rowss[(size_t)(u.pn * 4 + wc) * MTOK + u.pm * 256 + rl] = ss; G8_ROWS_END } };
struct SchedQkv { static constexpr int K = 256, lda = 1024, ldb = 256; const bf16_t* XC; const bf16_t* MI; const bf16_t* Wt; int bid, G;
    DEV bool next(int i, Unit& u) const { const int t = bid + i * G; if (t >= 768) return false; int pm, pn; tile_map(t, 12, pm, pn);
        u.pm = pm; u.pn = pn; u.tag = 0; u.A = (const char*)(((pn >> 2) == 2 ? MI : XC) + (size_t)pm * 256 * DM + (pn & 3) * 256); u.B = (const char*)(Wt + (size_t)pn * 256 * 256); return true; } };
struct EpiQkv { bf16_t* Q; bf16_t* Kk; bf16_t* V;
    DEV void operator()(LAS char*, const f32x4 (&acc)[2][2][4][2], const Unit& u, int wr, int wc, int fr, int fq, int, int) const {
        const int which = u.pn >> 2; bf16_t* C = sel3(which, Q, Kk, V); const float sc = (which == 1) ? 0.0625f : 1.f;
        const int c0 = (u.pn & 3) * 256 + 32 * wc + 8 * fq;
        G8_ROWS_BEGIN bf16_t* rp = C + (size_t)(u.pm * 256 + rl) * DM + c0;
#pragma unroll
            for (int bj = 0; bj < 2; ++bj) *(u32x4*)(rp + 128 * bj) = pk8(acc[ai][bj][m][0] * sc, acc[ai][bj][m][1] * sc); G8_ROWS_END } };
struct SchedOut { static constexpr int K = 2048, lda = 2048, ldb = 2048; const bf16_t* MX; const bf16_t* Wt; int bid, G;
    DEV bool next(int i, Unit& u) const { const int t = bid + i * G; if (t >= 256) return false; int pm, pn; tile_map(t, 4, pm, pn);
        u.pm = pm; u.pn = pn; u.tag = 0; u.A = (const char*)(MX + (size_t)pm * 256 * 2048); u.B = (const char*)(Wt + (size_t)pn * 256 * 2048); return true; } };
struct EpiOut { const float* xin; float* xout; const float* gate;
    DEV void operator()(LAS char*, const f32x4 (&acc)[2][2][4][2], const Unit& u, int wr, int wc, int fr, int fq, int, int) const {
        const int c0 = u.pn * 256 + 32 * wc + 8 * fq; const float* gp = gate + (size_t)((u.pm * 256) / SEQ) * 3 * DM + c0;
        G8_ROWS_BEGIN const size_t ro = (size_t)(u.pm * 256 + rl) * DM + c0;
#pragma unroll
            for (int bj = 0; bj < 2; ++bj)
#pragma unroll
                for (int n = 0; n < 2; ++n) {
                    const float4 xi = *(const float4*)(xin + ro + 128 * bj + 4 * n), g4 = *(const float4*)(gp + 128 * bj + 4 * n);
                    float4 o; o.x = xi.x + g4.x * acc[ai][bj][m][n][0]; o.y = xi.y + g4.y * acc[ai][bj][m][n][1]; o.z = xi.z + g4.z * acc[ai][bj][m][n][2]; o.w = xi.w + g4.w * acc[ai][bj][m][n][3];
                    *(float4*)(xout + ro + 128 * bj + 4 * n) = o; } G8_ROWS_END } };
struct SchedG2s { static constexpr int K = 1024, lda = 1024, ldb = 1024; const bf16_t* H; const bf16_t* Wt; int bid;
    DEV bool next(int i, Unit& u) const { if (i >= 1) return false; int pm, pn; tile_map(bid, 4, pm, pn);
        u.pm = pm; u.pn = pn; u.tag = 0; u.A = (const char*)(H + (size_t)pm * 256 * DM); u.B = (const char*)(Wt + (size_t)(1024 + pn * 256) * DM); return true; } };
struct SchedG2m { static constexpr int K = 1024, lda = 1024, ldb = 1024; const bf16_t* H; const bf16_t* Wt; int bid;
    DEV bool next(int i, Unit& u) const { if (i >= 2) return false; int pm, pn; tile_map(bid, 4, pm, pn);
        u.pm = pm; u.pn = pn; u.tag = i + 1; u.A = (const char*)(H + (size_t)pm * 256 * DM); u.B = (const char*)(Wt + (size_t)((i == 0 ? 3072 : 4096) + pn * 256) * DM); return true; } };
struct EpiG2s { const bf16_t* Z; const float* rstd; const float* og; bf16_t* MX;
    DEV void operator()(LAS char* lds, f32x4 (&acc)[2][2][4][2], const Unit& u, int wr, int wc, int fr, int fq, int wid, int lane) const {
        asm volatile("" : "+v"(fr), "+v"(fq));
        const int c0 = u.pn * 256 + 32 * wc + 8 * fq;
        {
            G8_ROWS_BEGIN const int row = u.pm * 256 + rl; const float rs = rstd[row];
#pragma unroll
                for (int bj = 0; bj < 2; ++bj) {
                    float z8[8]; un8(*(const u32x4*)(Z + (size_t)row * DM + c0 + 128 * bj), z8);
                    const float4 g0 = *(const float4*)(og + c0 + 128 * bj), g1 = *(const float4*)(og + c0 + 128 * bj + 4);
                    f32x4 o0, o1;
                    o0[0] = z8[0] * rs * g0.x * siluf_(acc[ai][bj][m][0][0]); o0[1] = z8[1] * rs * g0.y * siluf_(acc[ai][bj][m][0][1]); o0[2] = z8[2] * rs * g0.z * siluf_(acc[ai][bj][m][0][2]); o0[3] = z8[3] * rs * g0.w * siluf_(acc[ai][bj][m][0][3]);
                    o1[0] = z8[4] * rs * g1.x * siluf_(acc[ai][bj][m][1][0]); o1[1] = z8[5] * rs * g1.y * siluf_(acc[ai][bj][m][1][1]); o1[2] = z8[6] * rs * g1.z * siluf_(acc[ai][bj][m][1][2]); o1[3] = z8[7] * rs * g1.w * siluf_(acc[ai][bj][m][1][3]);
                    *(u32x4*)(MX + (size_t)row * 2048 + c0 + 128 * bj) = pk8(o0, o1); } G8_ROWS_END
        }
    } };
struct EpiG2m { const bf16_t* HC; const bf16_t* XC; const float* ngain; const float* skip; bf16_t* MX;
    DEV void operator()(LAS char* lds, f32x4 (&acc)[2][2][4][2], const Unit& u, int wr, int wc, int fr, int fq, int wid, int lane) const {
        asm volatile("" : "+v"(fr), "+v"(fq));
        const int c0 = u.pn * 256 + 32 * wc + 8 * fq;
        if (u.tag == 1) {
            LAS float* red = (LAS float*)(lds + 131072);
            G8_ROWS_BEGIN const int row = u.pm * 256 + rl; float s1 = 0.f, s2 = 0.f;
#pragma unroll
                for (int bj = 0; bj < 2; ++bj) {
                    float h8[8]; un8(*(const u32x4*)(HC + (size_t)row * DM + c0 + 128 * bj), h8);
#pragma unroll
                    for (int n = 0; n < 2; ++n)
#pragma unroll
                        for (int j = 0; j < 4; ++j) { const float v = h8[4 * n + j] * sigmoidf_(acc[ai][bj][m][n][j]); acc[ai][bj][m][n][j] = v; s1 += v; s2 += v * v; }
                }
                s1 += __shfl_xor(s1, 16); s1 += __shfl_xor(s1, 32); s2 += __shfl_xor(s2, 16); s2 += __shfl_xor(s2, 32);
                if (fq == 0) *(LAS f32x2*)(red + ((wid * 128) + 64 * ai + 16 * m + fr) * 2) = (f32x2){s1, s2}; G8_ROWS_END
            asm volatile("s_waitcnt lgkmcnt(0)" ::: "memory"); __builtin_amdgcn_s_barrier();
            G8_ROWS_BEGIN const int row = u.pm * 256 + rl; float t1 = 0.f, t2 = 0.f;
#pragma unroll
                for (int w2 = 0; w2 < 4; ++w2) { const f32x2 p_ = *(const LAS f32x2*)(red + (((wr * 4 + w2) * 128) + 64 * ai + 16 * m + fr) * 2); t1 += p_.x; t2 += p_.y; }
                const float mu = t1 * (1.f / DH), rs = rsqrtf(fmaxf(t2 * (1.f / DH) - mu * mu, 0.f) + EPS);
#pragma unroll
                for (int bj = 0; bj < 2; ++bj) {
                    float x8[8]; un8(*(const u32x4*)(XC + (size_t)row * DM + c0 + 128 * bj), x8);
                    const float4 g0 = *(const float4*)(ngain + c0 + 128 * bj), g1 = *(const float4*)(ngain + c0 + 128 * bj + 4), k0 = *(const float4*)(skip + c0 + 128 * bj), k1 = *(const float4*)(skip + c0 + 128 * bj + 4);
                    f32x4 o0, o1;
                    o0[0] = (acc[ai][bj][m][0][0] - mu) * rs * g0.x + k0.x * x8[0]; o0[1] = (acc[ai][bj][m][0][1] - mu) * rs * g0.y + k0.y * x8[1]; o0[2] = (acc[ai][bj][m][0][2] - mu) * rs * g0.z + k0.z * x8[2]; o0[3] = (acc[ai][bj][m][0][3] - mu) * rs * g0.w + k0.w * x8[3];
                    o1[0] = (acc[ai][bj][m][1][0] - mu) * rs * g1.x + k1.x * x8[4]; o1[1] = (acc[ai][bj][m][1][1] - mu) * rs * g1.y + k1.y * x8[5]; o1[2] = (acc[ai][bj][m][1][2] - mu) * rs * g1.z + k1.z * x8[6]; o1[3] = (acc[ai][bj][m][1][3] - mu) * rs * g1.w + k1.w * x8[7];
                    *(u32x4*)(MX + (size_t)row * 2048 + 1024 + c0 + 128 * bj) = pk8(o0, o1); } G8_ROWS_END
        } else {
            G8_ROWS_BEGIN const int row = u.pm * 256 + rl;
#pragma unroll
                for (int bj = 0; bj < 2; ++bj) {
                    bf16_t* pp = MX + (size_t)row * 2048 + 1024 + c0 + 128 * bj;
                    float h8[8]; un8(*(const u32x4*)pp, h8);
                    f32x4 o0, o1;
                    o0[0] = h8[0] * siluf_(acc[ai][bj][m][0][0]); o0[1] = h8[1] * siluf_(acc[ai][bj][m][0][1]); o0[2] = h8[2] * siluf_(acc[ai][bj][m][0][2]); o0[3] = h8[3] * siluf_(acc[ai][bj][m][0][3]);
                    o1[0] = h8[4] * siluf_(acc[ai][bj][m][1][0]); o1[1] = h8[5] * siluf_(acc[ai][bj][m][1][1]); o1[2] = h8[6] * siluf_(acc[ai][bj][m][1][2]); o1[3] = h8[7] * siluf_(acc[ai][bj][m][1][3]);
                    *(u32x4*)pp = pk8(o0, o1); } G8_ROWS_END
        }
    } };
}
DEV void rstd_rows(const float* rowss, float* rstd) {
    const int tid = opaque_tid();
    for (int r = blockIdx.x * 512 + tid; r < MTOK; r += gridDim.x * 512) { float s_ = 0.f;
#pragma unroll
        for (int p_ = 0; p_ < 16; ++p_) s_ += rowss[(size_t)p_ * MTOK + r];
        rstd[r] = rsqrtf(s_ * (1.f / DM) + EPS); }
}

DEV void transpose_item(const float* W, int ldw, int ncols, bf16_t* WT, int ldwt, LAS float* scr, int item, int lane) {
    const int nblk = ncols / 64, kb = item / nblk, nb = item % nblk, k0 = 64 * kb, n0 = 64 * nb;
    float4 v[16];
#pragma unroll
    for (int i = 0; i < 16; ++i) v[i] = *(const float4*)(W + (size_t)(k0 + 4 * i + (lane >> 4)) * ldw + n0 + 4 * (lane & 15));
#pragma unroll
    for (int i = 0; i < 16; ++i) { LAS float* d_ = scr + (4 * i + (lane >> 4)) * 65 + 4 * (lane & 15); d_[0] = v[i].x; d_[1] = v[i].y; d_[2] = v[i].z; d_[3] = v[i].w; }
    asm volatile("s_waitcnt lgkmcnt(0)" ::: "memory");
#pragma unroll
    for (int j = 0; j < 8; ++j) {
        const int n = (lane >> 3) + 8 * j, c = lane & 7;
        const LAS float* s_ = scr + (8 * c) * 65 + n;
        uint4 o;
        o.x = pk2(s_[0 * 65], s_[1 * 65]); o.y = pk2(s_[2 * 65], s_[3 * 65]); o.z = pk2(s_[4 * 65], s_[5 * 65]); o.w = pk2(s_[6 * 65], s_[7 * 65]);
        *(uint4*)(WT + (size_t)(n0 + n) * ldwt + k0 + 8 * c) = o;
    }
    asm volatile("s_waitcnt lgkmcnt(0)" ::: "memory");
}

DEV float wave_scan_add(float v, int lane) {
#pragma unroll
    for (int o = 1; o < 64; o <<= 1) { const float u = __shfl_up(v, o); if (lane >= o) v += u; }
    return v;
}
DEV float wave_scan_max(float v, int lane) {
#pragma unroll
    for (int o = 1; o < 64; o <<= 1) { const float u = __shfl_up(v, o); if (lane >= o) v = fmaxf(v, u); }
    return v;
}

template <int TT>
DEV void mlstm_a_wave(LAS char* shm, int fr, int fq, float m_prev, const LAS float* tpj, const LAS float* taj, f32x4 (&nacc)[3]) {
    constexpr int QS = 0, KS = 33792, VT = 67584, RS = 528, VRS = 96, NT = TT + 1;
    const LAS char* qb = shm + QS + (16 * TT + fr) * RS + fq * 16;
    const LAS char* kb = shm + KS + fr * RS + fq * 16;
    f32x4 sacc[NT];
#pragma unroll
    for (int jj = 0; jj < NT; ++jj) sacc[jj] = (f32x4){0.f, 0.f, 0.f, 0.f};
    bf16x8 qf = *(const LAS bf16x8*)qb, kf[NT];
#pragma unroll
    for (int jj = 0; jj < NT; ++jj) kf[jj] = *(const LAS bf16x8*)(kb + jj * 16 * RS);
#pragma unroll
    for (int ks = 0; ks < 8; ++ks) {
        bf16x8 qn = qf, kn[NT];
#pragma unroll
        for (int jj = 0; jj < NT; ++jj) kn[jj] = kf[jj];
        if (ks < 7) {
            qn = *(const LAS bf16x8*)(qb + (ks + 1) * 64);
#pragma unroll
            for (int jj = 0; jj < NT; ++jj) kn[jj] = *(const LAS bf16x8*)(kb + jj * 16 * RS + (ks + 1) * 64);
        }
#pragma unroll
        for (int jj = 0; jj < NT; ++jj) sacc[jj] = __builtin_amdgcn_mfma_f32_16x16x32_bf16(kf[jj], qf, sacc[jj], 0, 0, 0);
        qf = qn;
#pragma unroll
        for (int jj = 0; jj < NT; ++jj) kf[jj] = kn[jj];
    }
    constexpr int NK = (TT >= 2) ? 2 : 1;
    s16x4 vlo[NK][3], vhi[NK][3];
#pragma unroll
    for (int kk = 0; kk < NK; ++kk)
#pragma unroll
        for (int vt = 0; vt < 3; ++vt) {
            vlo[kk][vt] = __builtin_amdgcn_ds_read_tr16_b64_v4i16((LAS s16x4*)(shm + VT + (32 * kk + 4 * fq + (fr >> 2)) * VRS + (16 * vt + 4 * (fr & 3)) * 2));
            vhi[kk][vt] = __builtin_amdgcn_ds_read_tr16_b64_v4i16((LAS s16x4*)(shm + VT + (32 * kk + 16 + 4 * fq + (fr >> 2)) * VRS + (16 * vt + 4 * (fr & 3)) * 2));
        }
    const int t = 16 * TT + fr;
    const float btm = -fmaxf(m_prev, tpj[t]);
    f32x4 sm[2 * NK];
#pragma unroll
    for (int jj = 0; jj < 2 * NK; ++jj) {
        if (jj < NT) {
            const f32x4 a4 = *(const LAS f32x4*)(taj + 16 * jj + 4 * fq);
#pragma unroll
            for (int r = 0; r < 4; ++r) {
                const int s_ = 16 * jj + 4 * fq + r;
                sm[jj][r] = (jj < TT || s_ <= t) ? sacc[jj < NT ? jj : 0][r] * __expf(btm + a4[r]) : 0.f;
            }
        } else sm[jj] = (f32x4){0.f, 0.f, 0.f, 0.f};
    }
#pragma unroll
    for (int kk = 0; kk < NK; ++kk) {
        const u32x4 u = (u32x4){pk2(sm[2 * kk][0], sm[2 * kk][1]), pk2(sm[2 * kk][2], sm[2 * kk][3]), pk2(sm[2 * kk + 1][0], sm[2 * kk + 1][1]), pk2(sm[2 * kk + 1][2], sm[2 * kk + 1][3])};
        const bf16x8 af = *(const bf16x8*)&u;
#pragma unroll
        for (int vt = 0; vt < 3; ++vt) {
            bf16x8 bv8; bv8[0] = vlo[kk][vt][0]; bv8[1] = vlo[kk][vt][1]; bv8[2] = vlo[kk][vt][2]; bv8[3] = vlo[kk][vt][3];
            bv8[4] = vhi[kk][vt][0]; bv8[5] = vhi[kk][vt][1]; bv8[6] = vhi[kk][vt][2]; bv8[7] = vhi[kk][vt][3];
            nacc[vt] = __builtin_amdgcn_mfma_f32_16x16x32_bf16(af, bv8, nacc[vt], 0, 0, 0);
        }
    }
}
DEV void mlstm_b_wave(LAS char* shm, int tt, int fr, int fq, f32x4 (&nacc)[3]) {
    constexpr int QS = 0, CB = 81408, RS = 528;
    const LAS char* qb = shm + QS + (16 * tt + fr) * RS + fq * 16;
    const LAS char* cbp = shm + CB + fr * RS + fq * 16;
    bf16x8 qf = *(const LAS bf16x8*)qb, cf[3];
#pragma unroll
    for (int vt = 0; vt < 3; ++vt) cf[vt] = *(const LAS bf16x8*)(cbp + vt * 16 * RS);
#pragma unroll
    for (int ks = 0; ks < 8; ++ks) {
        bf16x8 qn = qf, cn[3] = {cf[0], cf[1], cf[2]};
        if (ks < 7) {
            qn = *(const LAS bf16x8*)(qb + (ks + 1) * 64);
#pragma unroll
            for (int vt = 0; vt < 3; ++vt) cn[vt] = *(const LAS bf16x8*)(cbp + vt * 16 * RS + (ks + 1) * 64);
        }
#pragma unroll
        for (int vt = 0; vt < 3; ++vt) nacc[vt] = __builtin_amdgcn_mfma_f32_16x16x32_bf16(qf, cf[vt], nacc[vt], 0, 0, 0);
        qf = qn;
#pragma unroll
        for (int vt = 0; vt < 3; ++vt) cf[vt] = cn[vt];
    }
}
template <int SKIP>
DEV void mlstm_phase(LAS char* shm, const bf16_t* q, const bf16_t* k, const bf16_t* v, const float* gpart, const float* b_ig, const float* b_fg, bf16_t* hc) {
    const int tid = opaque_tid(), wid = __builtin_amdgcn_readfirstlane(tid >> 6), lane = tid & 63, fr = lane & 15, fq = lane >> 4;
    constexpr int QS = 0, KS = 33792, VT = 67584, VWT = 74496, CB = 81408, PART = 106752, TB = 120064, TA = 128256, TP = 136448, TC = 144640, HST = 144896, RS = 528, VRS = 96, PRS = 52;
    LAS float* part = (LAS float*)(shm + PART);
    LAS float* tb = (LAS float*)(shm + TB); LAS float* ta = (LAS float*)(shm + TA); LAS float* tp = (LAS float*)(shm + TP); LAS float* tc = (LAS float*)(shm + TC);
    for (int item = blockIdx.x; item < BATCH * NH * 8; item += gridDim.x) {
        const int vs = (item >> 3) & 7, bh = (item & 7) + 8 * (item >> 6), h = bh & 3, b = bh >> 2;
        __syncthreads();
        for (int i = tid; i < (CB + 25344 - VT) / 4; i += 512) ((LAS unsigned*)(shm + VT))[i] = 0u;
        for (int j = wid; j < SEQ / CHUNK; j += 8) {
            const int m = b * SEQ + j * CHUNK + lane;
            const float* gp = gpart + (size_t)m * 8;
            const float ig = gp[h] + gp[(size_t)MTOK * 8 + h] + b_ig[h];
            const float lf = logsigmoidf_(gp[4 + h] + gp[(size_t)MTOK * 8 + 4 + h] + b_fg[h]);
            const float bc = wave_scan_add(lf, lane);
            const float a_ = ig - bc;
            const float pm = wave_scan_max(a_, lane);
            tb[j * 64 + lane] = bc; ta[j * 64 + lane] = a_; tp[j * 64 + lane] = pm;
            if (lane == 63) { tc[2 * j] = bc; tc[2 * j + 1] = pm; }
        }
        __syncthreads();
        if (tid < 64) *(LAS u32x4*)(shm + VT + tid * VRS + 64) = (u32x4){0x3F80u, 0u, 0u, 0u};
        f32x4 cacc[2][3];
#pragma unroll
        for (int i = 0; i < 2; ++i)
#pragma unroll
            for (int vt = 0; vt < 3; ++vt) cacc[i][vt] = (f32x4){0.f, 0.f, 0.f, 0.f};
        float m_prev = 0.f;
        const size_t cb0 = ((size_t)(b * SEQ)) * DM + h * DH;
        uint4 qv[4], kv[4], vv = make_uint4(0, 0, 0, 0);
#pragma unroll
        for (int i = 0; i < 4; ++i) {
            const int idx = tid + 512 * i, row = idx >> 5, c16 = idx & 31;
            qv[i] = *(const uint4*)(q + cb0 + (size_t)row * DM + c16 * 8);
            kv[i] = *(const uint4*)(k + cb0 + (size_t)row * DM + c16 * 8);
        }
        if (tid < 256) vv = *(const uint4*)(v + cb0 + (size_t)(tid >> 2) * DM + vs * 32 + (tid & 3) * 8);
#pragma nounroll
        for (int j = 0; j < SEQ / CHUNK; ++j) {
            const size_t cb = cb0 + (size_t)j * CHUNK * DM;
            const float btot = tc[2 * j], amax = tc[2 * j + 1];
            const float mxc = fmaxf(m_prev, amax);
#pragma unroll
            for (int i = 0; i < ((SKIP & 8) ? 0 : 4); ++i) {
                const int idx = tid + 512 * i, row = idx >> 5, c16 = idx & 31;
                *(LAS u32x4*)(shm + QS + row * RS + c16 * 16) = (u32x4){qv[i].x, qv[i].y, qv[i].z, qv[i].w};
                *(LAS u32x4*)(shm + KS + row * RS + c16 * 16) = (u32x4){kv[i].x, kv[i].y, kv[i].z, kv[i].w};
            }
            if (tid < 256) {
                const int s_ = tid >> 2, v0 = (tid & 3) * 8;
                const float ws = __expf(ta[j * 64 + s_] - mxc);
                float f8[8]; unpack8(vv, f8);
#pragma unroll
                for (int e = 0; e < 8; ++e) f8[e] *= ws;
                const uint4 wv = pack8(f8);
                *(LAS u32x4*)(shm + VT + s_ * VRS + v0 * 2) = (u32x4){vv.x, vv.y, vv.z, vv.w};
                *(LAS u32x4*)(shm + VWT + s_ * VRS + v0 * 2) = (u32x4){wv.x, wv.y, wv.z, wv.w};
            } else if (tid < 320) {
                const int s_ = tid - 256;
                *(LAS u32x4*)(shm + VWT + s_ * VRS + 64) = (u32x4){(unsigned)f2bf(__expf(ta[j * 64 + s_] - mxc)), 0u, 0u, 0u};
            }
            if (j + 1 < SEQ / CHUNK) {
                const size_t cn = cb + (size_t)CHUNK * DM;
#pragma unroll
                for (int i = 0; i < 4; ++i) {
                    const int idx = tid + 512 * i, row = idx >> 5, c16 = idx & 31;
                    qv[i] = *(const uint4*)(q + cn + (size_t)row * DM + c16 * 8);
                    kv[i] = *(const uint4*)(k + cn + (size_t)row * DM + c16 * 8);
                }
                if (tid < 256) vv = *(const uint4*)(v + cn + (size_t)(tid >> 2) * DM + vs * 32 + (tid & 3) * 8);
            }
            __syncthreads();
            f32x4 nacc[3];
#pragma unroll
            for (int vt = 0; vt < 3; ++vt) nacc[vt] = (f32x4){0.f, 0.f, 0.f, 0.f};
            const int tt = wid & 3;
            if (wid < 4) { if (!(SKIP & 1)) {
                const LAS float* tpj = tp + j * 64; const LAS float* taj = ta + j * 64;
                if (tt == 0) mlstm_a_wave<0>(shm, fr, fq, m_prev, tpj, taj, nacc);
                else if (tt == 1) mlstm_a_wave<1>(shm, fr, fq, m_prev, tpj, taj, nacc);
                else if (tt == 2) mlstm_a_wave<2>(shm, fr, fq, m_prev, tpj, taj, nacc);
                else mlstm_a_wave<3>(shm, fr, fq, m_prev, tpj, taj, nacc);
            } } else if (!(SKIP & 2)) {
                mlstm_b_wave(shm, tt, fr, fq, nacc);
                const f32x4 pm4 = *(const LAS f32x4*)(tp + j * 64 + 16 * tt + 4 * fq);
#pragma unroll
                for (int vt = 0; vt < 3; ++vt)
#pragma unroll
                    for (int r = 0; r < 4; ++r) part[(16 * tt + 4 * fq + r) * PRS + 16 * vt + fr] = __expf(m_prev - fmaxf(m_prev, pm4[r])) * nacc[vt][r];
            }
            if (!(SKIP & 4)) {
                const float decay = __expf(m_prev - mxc);
#pragma unroll
                for (int i = 0; i < 2; ++i)
#pragma unroll
                    for (int vt = 0; vt < 3; ++vt) cacc[i][vt] *= decay;
                const int q_ = fr >> 2, p_ = fr & 3;
                s16x4 wl[2][3], wh[2][3], kl[2][2], kh[2][2];
#pragma unroll
                for (int kk = 0; kk < 2; ++kk) {
#pragma unroll
                    for (int vt = 0; vt < 3; ++vt) {
                        wl[kk][vt] = __builtin_amdgcn_ds_read_tr16_b64_v4i16((LAS s16x4*)(shm + VWT + (32 * kk + 8 * fq + q_) * VRS + (16 * vt + 4 * p_) * 2));
                        wh[kk][vt] = __builtin_amdgcn_ds_read_tr16_b64_v4i16((LAS s16x4*)(shm + VWT + (32 * kk + 8 * fq + 4 + q_) * VRS + (16 * vt + 4 * p_) * 2));
                    }
#pragma unroll
                    for (int i = 0; i < 2; ++i) {
                        const int dt = 2 * wid + i;
                        kl[kk][i] = __builtin_amdgcn_ds_read_tr16_b64_v4i16((LAS s16x4*)(shm + KS + (32 * kk + 8 * fq + q_) * RS + (16 * dt + 4 * p_) * 2));
                        kh[kk][i] = __builtin_amdgcn_ds_read_tr16_b64_v4i16((LAS s16x4*)(shm + KS + (32 * kk + 8 * fq + 4 + q_) * RS + (16 * dt + 4 * p_) * 2));
                    }
                }
#pragma unroll
                for (int kk = 0; kk < 2; ++kk) {
                    bf16x8 bfv[3];
#pragma unroll
                    for (int vt = 0; vt < 3; ++vt) { bfv[vt][0] = wl[kk][vt][0]; bfv[vt][1] = wl[kk][vt][1]; bfv[vt][2] = wl[kk][vt][2]; bfv[vt][3] = wl[kk][vt][3];
                        bfv[vt][4] = wh[kk][vt][0]; bfv[vt][5] = wh[kk][vt][1]; bfv[vt][6] = wh[kk][vt][2]; bfv[vt][7] = wh[kk][vt][3]; }
#pragma unroll
                    for (int i = 0; i < 2; ++i) {
                        bf16x8 af; af[0] = kl[kk][i][0]; af[1] = kl[kk][i][1]; af[2] = kl[kk][i][2]; af[3] = kl[kk][i][3]; af[4] = kh[kk][i][0]; af[5] = kh[kk][i][1]; af[6] = kh[kk][i][2]; af[7] = kh[kk][i][3];
#pragma unroll
                        for (int vt = 0; vt < 3; ++vt) cacc[i][vt] = __builtin_amdgcn_mfma_f32_16x16x32_bf16(af, bfv[vt], cacc[i][vt], 0, 0, 0);
                    }
                }
            }
            __syncthreads();
            if (wid < 4 && !(SKIP & 16)) {
                const f32x4 pm4 = *(const LAS f32x4*)(tp + j * 64 + 16 * tt + 4 * fq);
                const f32x4 bc4 = *(const LAS f32x4*)(tb + j * 64 + 16 * tt + 4 * fq);
#pragma unroll
                for (int vt = 0; vt < 3; ++vt)
#pragma unroll
                    for (int r = 0; r < 4; ++r) nacc[vt][r] += part[(16 * tt + 4 * fq + r) * PRS + 16 * vt + fr];
#pragma unroll
                for (int r = 0; r < 4; ++r) {
                    const float den = __shfl(nacc[2][r], lane & 48);
                    const float inv = 1.f / fmaxf(fabsf(den), __expf(-(bc4[r] + fmaxf(m_prev, pm4[r]))));
                    LAS bf16_t* hrow = (LAS bf16_t*)(shm + HST + (16 * tt + 4 * fq + r) * 80);
                    hrow[fr] = f2bf(nacc[0][r] * inv);
                    hrow[16 + fr] = f2bf(nacc[1][r] * inv);
                }
                asm volatile("s_waitcnt lgkmcnt(0)" ::: "memory");
                {
                    const int rw = 16 * tt + (lane >> 2), pc = lane & 3;
                    const u32x4 hv = *(const LAS u32x4*)(shm + HST + rw * 80 + pc * 16);
                    *(uint4*)(hc + cb + (size_t)rw * DM + vs * 32 + pc * 8) = make_uint4(hv[0], hv[1], hv[2], hv[3]);
                }
            }
#pragma unroll
            for (int i = 0; i < 2; ++i)
#pragma unroll
                for (int vt = 0; vt < 3; ++vt) {
                    u32x2 o; o[0] = pk2(cacc[i][vt][0], cacc[i][vt][1]); o[1] = pk2(cacc[i][vt][2], cacc[i][vt][3]);
                    *(LAS u32x2*)(shm + CB + (16 * vt + fr) * RS + (16 * (2 * wid + i) + 4 * fq) * 2) = o;
                }
            m_prev = btot + mxc;
        }
    }
}

constexpr int S5L = 32, S5NCH = SEQ / S5L;
constexpr size_t T_KT_OFF = 0, T_WS_OFF = 2u << 20, T_V_OFF = 10u << 20, T_AL_OFF = 18u << 20;
constexpr int KT_G = 33 * 256, WS_G = 128 * 512, V_G = 512 * 128;

DEV void s5_tables(LAS char* shm, char* tab, const float* lam_re, const float* lam_im, const float* log_dt, const float* b_re, const float* b_im,
                   const float* c_re, const float* c_im) {
    const int tid = opaque_tid();
    LAS f32x2* apw = (LAS f32x2*)shm;
    LAS f32x2* bb = (LAS f32x2*)(shm + 64 * 33 * 8);
    LAS f32x2* cc = (LAS f32x2*)(shm + 64 * 33 * 8 + 8192);
    bf16_t* KT = (bf16_t*)(tab + T_KT_OFF); bf16_t* WS = (bf16_t*)(tab + T_WS_OFF); bf16_t* VV = (bf16_t*)(tab + T_V_OFF); float2* AL = (float2*)(tab + T_AL_OFF);
    for (int it = blockIdx.x; it < 256; it += gridDim.x) {
        const int g = it & 63, qd = it >> 6;
        __syncthreads();
        if (tid < 64) {
            const int pp = tid;
            const double lr = lam_re[g * NP + pp], li = lam_im[g * NP + pp], dt = exp((double)log_dt[g]);
            const double er = exp(lr * dt);
            const double ar = er * cos(li * dt), ai = er * sin(li * dt);
            const double dr = ar - 1.0, di = ai, den = lr * lr + li * li;
            const double cr = (dr * lr + di * li) / den, ci = (di * lr - dr * li) / den;
            double pr = 1.0, pi_ = 0.0;
            for (int e = 0; e <= 32; ++e) {
                apw[pp * 33 + e] = (f32x2){(float)pr, (float)pi_};
                const double nr = pr * ar - pi_ * ai, ni = pr * ai + pi_ * ar; pr = nr; pi_ = ni;
            }
            if (qd == 0) { const f32x2 t_ = apw[pp * 33 + 32]; AL[g * NP + pp] = make_float2(t_.x, t_.y); }
            for (int c = 0; c < 16; ++c) {
                const double br = b_re[(g * NP + pp) * GC + c], bi = b_im[(g * NP + pp) * GC + c];
                bb[pp * 16 + c] = (f32x2){(float)(cr * br - ci * bi), (float)(cr * bi + ci * br)};
                cc[c * 64 + pp] = (f32x2){c_re[(g * GC + c) * NP + pp], c_im[(g * GC + c) * NP + pp]};
            }
        }
        __syncthreads();
        for (int o = tid; o < 8 * 256; o += 512) {
            const int d = 8 * qd + (o >> 8), c1 = (o >> 4) & 15, c0 = o & 15;
            float acc = 0.f;
            for (int pp = 0; pp < 64; ++pp) {
                const f32x2 a = apw[pp * 33 + d], b = bb[pp * 16 + c0], c = cc[c1 * 64 + pp];
                const float mr = a.x * b.x - a.y * b.y, mi = a.x * b.y + a.y * b.x;
                acc += c.x * mr - c.y * mi;
            }
            KT[(size_t)g * KT_G + (d + 1) * 256 + c1 * 16 + c0] = f2bf(acc);
        }
        if (qd == 0 && tid < 256) KT[(size_t)g * KT_G + tid] = 0;
        for (int o = tid; o < 2 * 16 * 64; o += 512) {
            const int mt = 2 * qd + (o >> 10), sp = (o >> 6) & 15, ln = o & 63;
            const int row = 16 * mt + (ln & 15), ri = row >> 6, pp = row & 63, s_ = 2 * sp + (ln >> 5), c0 = 8 * ((ln >> 4) & 1);
            const f32x2 a = apw[pp * 33 + 31 - s_];
            unsigned w[4];
#pragma unroll
            for (int jj = 0; jj < 8; jj += 2) {
                const f32x2 b0 = bb[pp * 16 + c0 + jj], b1 = bb[pp * 16 + c0 + jj + 1];
                const float v0 = ri ? (a.x * b0.y + a.y * b0.x) : (a.x * b0.x - a.y * b0.y);
                const float v1 = ri ? (a.x * b1.y + a.y * b1.x) : (a.x * b1.x - a.y * b1.y);
                w[jj >> 1] = pk2(v0, v1);
            }
            *(uint4*)(WS + (size_t)g * WS_G + ((size_t)(mt * 16 + sp) * 64 + ln) * 8) = make_uint4(w[0], w[1], w[2], w[3]);
        }
        for (int o = tid; o < 8 * 4 * 64; o += 512) {
            const int i = 8 * qd + (o >> 8), ks = (o >> 6) & 3, ln = o & 63;
            const int c1 = ln & 15, k0 = 32 * ks + 8 * (ln >> 4);
            unsigned w[4];
#pragma unroll
            for (int jj = 0; jj < 8; jj += 2) {
                float v[2];
#pragma unroll
                for (int e = 0; e < 2; ++e) {
                    const int kk = k0 + jj + e, ri = kk >> 6, pp = kk & 63;
                    const f32x2 a = apw[pp * 33 + i + 1], c = cc[c1 * 64 + pp];
                    v[e] = ri ? -(c.x * a.y + c.y * a.x) : (c.x * a.x - c.y * a.y);
                }
                w[jj >> 1] = pk2(v[0], v[1]);
            }
            *(uint4*)(VV + (size_t)g * V_G + ((size_t)(i * 4 + ks) * 64 + ln) * 8) = make_uint4(w[0], w[1], w[2], w[3]);
        }
    }
}

DEV void s5_phase(LAS char* shm, const bf16_t* Uin, bf16_t* Yout, const char* tab, const float* dskip) {
    const int tid = opaque_tid(), wid = __builtin_amdgcn_readfirstlane(tid >> 6), lane = tid & 63, fr = lane & 15, fq = lane >> 4;
    constexpr int PLANE = 64 * 528, KTL = 2 * PLANE, SL = KTL + 33 * 512, HB = SL + 64 * 528, SRS = 528, HRS = 272;
    const bf16_t* KT = (const bf16_t*)(tab + T_KT_OFF); const bf16_t* WS = (const bf16_t*)(tab + T_WS_OFF); const bf16_t* VV = (const bf16_t*)(tab + T_V_OFF);
    const float2* AL = (const float2*)(tab + T_AL_OFF);
    for (int item = blockIdx.x; item < BATCH * NG; item += gridDim.x) {
        const int g = item & 63, b = item >> 6;
        const bf16_t* Ub = Uin + (size_t)b * SEQ * DM + g * GC;
        bf16_t* Yb = Yout + (size_t)b * SEQ * DM + g * GC;
        __syncthreads();
#pragma unroll
        for (int i = 0; i < 8; ++i) {
            const int idx = tid + 512 * i, tok = idx >> 1, hf = idx & 1;
            const uint4 uv = *(const uint4*)(Ub + (size_t)tok * DM + hf * 8);
            *(LAS u32x4*)(shm + hf * PLANE + (tok >> 5) * 528 + (tok & 31) * 16) = (u32x4){uv.x, uv.y, uv.z, uv.w};
        }
        for (int idx = tid; idx < 33 * 32; idx += 512) {
            const uint4 kv = *(const uint4*)(KT + (size_t)g * KT_G + idx * 8);
            *(LAS u32x4*)(shm + KTL + idx * 16) = (u32x4){kv.x, kv.y, kv.z, kv.w};
        }
        __syncthreads();
        f32x4 acc[4][4], sac[4];
#pragma unroll
        for (int q = 0; q < 4; ++q)
#pragma unroll
            for (int nt = 0; nt < 4; ++nt) acc[q][nt] = (f32x4){0.f, 0.f, 0.f, 0.f};
#pragma unroll
        for (int nt = 0; nt < 4; ++nt) sac[nt] = (f32x4){0.f, 0.f, 0.f, 0.f};
        const bf16_t* wsp = WS + (size_t)g * WS_G + ((size_t)(wid * 16) * 64 + lane) * 8;
        bf16x8 wnext = *(const bf16x8*)wsp;
#pragma nounroll
        for (int sp = 0; sp < 16; ++sp) {
            const bf16x8 wcur = wnext;
            if (sp + 1 < 16) wnext = *(const bf16x8*)(wsp + (size_t)(sp + 1) * 64 * 8);
            bf16x8 bu[4];
#pragma unroll
            for (int nt = 0; nt < 4; ++nt) bu[nt] = *(const LAS bf16x8*)(shm + (fq & 1) * PLANE + (16 * nt + fr) * 528 + (2 * sp + (fq >> 1)) * 16);
#pragma unroll
            for (int nt = 0; nt < 4; ++nt) sac[nt] = __builtin_amdgcn_mfma_f32_16x16x32_bf16(wcur, bu[nt], sac[nt], 0, 0, 0);
#pragma unroll
            for (int q = 0; q < 4; ++q) {
                const int i = wid + 8 * q;
                if (i >= 2 * sp) {
                    const int d = i - 2 * sp;
                    const bf16x8 kf = *(const LAS bf16x8*)(shm + KTL + (d - (fq >> 1) + 1) * 512 + fr * 32 + (fq & 1) * 16);
#pragma unroll
                    for (int nt = 0; nt < 4; ++nt) acc[q][nt] = __builtin_amdgcn_mfma_f32_16x16x32_bf16(kf, bu[nt], acc[q][nt], 0, 0, 0);
                }
            }
        }
#pragma unroll
        for (int nt = 0; nt < 4; ++nt) *(LAS f32x4*)(shm + SL + (16 * nt + fr) * SRS + (16 * wid + 4 * fq) * 4) = sac[nt];
        __syncthreads();
        if (wid == 0) {
            const float2 al = AL[g * NP + lane];
            float hr = 0.f, hi = 0.f;
#pragma unroll 8
            for (int n = 0; n < S5NCH; ++n) {
                *(LAS bf16_t*)(shm + HB + n * HRS + lane * 2) = f2bf(hr);
                *(LAS bf16_t*)(shm + HB + n * HRS + (64 + lane) * 2) = f2bf(hi);
                const float sr = *(const LAS float*)(shm + SL + n * SRS + lane * 4), si = *(const LAS float*)(shm + SL + n * SRS + (64 + lane) * 4);
                const float nr = al.x * hr - al.y * hi + sr, ni = al.x * hi + al.y * hr + si;
                hr = nr; hi = ni;
            }
        }
        __syncthreads();
        const bf16_t* vvp = VV + (size_t)g * V_G + (size_t)lane * 8;
#pragma unroll
        for (int ks = 0; ks < 4; ++ks) {
            bf16x8 hb[4], va[4];
#pragma unroll
            for (int q = 0; q < 4; ++q) va[q] = *(const bf16x8*)(vvp + ((size_t)((wid + 8 * q) * 4 + ks) * 64) * 8);
#pragma unroll
            for (int nt = 0; nt < 4; ++nt) hb[nt] = *(const LAS bf16x8*)(shm + HB + (16 * nt + fr) * HRS + (32 * ks + 8 * fq) * 2);
#pragma unroll
            for (int q = 0; q < 4; ++q)
#pragma unroll
                for (int nt = 0; nt < 4; ++nt) acc[q][nt] = __builtin_amdgcn_mfma_f32_16x16x32_bf16(va[q], hb[nt], acc[q][nt], 0, 0, 0);
        }
        const float4 dsk = *(const float4*)(dskip + g * GC + 4 * fq);
#pragma unroll
        for (int q = 0; q < 4; ++q) {
            const int i = wid + 8 * q;
#pragma unroll
            for (int nt = 0; nt < 4; ++nt) {
                const int n = 16 * nt + fr;
                const u32x2 uu = *(const LAS u32x2*)(shm + (fq >> 1) * PLANE + n * 528 + i * 16 + ((4 * fq) & 7) * 2);
                f32x4 o;
                o[0] = geluf_(acc[q][nt][0] + dsk.x * bf2f((bf16_t)(uu[0] & 0xffff))); o[1] = geluf_(acc[q][nt][1] + dsk.y * bf2f((bf16_t)(uu[0] >> 16)));
                o[2] = geluf_(acc[q][nt][2] + dsk.z * bf2f((bf16_t)(uu[1] & 0xffff))); o[3] = geluf_(acc[q][nt][3] + dsk.w * bf2f((bf16_t)(uu[1] >> 16)));
                *(uint2*)(Yb + (size_t)(n * 32 + i) * DM + 4 * fq) = pack4(o);
            }
        }
    }
}


DEV void norm_rows(const float* x, const float* gain, const float* modl, bf16_t* h) {
    const int tid = opaque_tid(), lane = tid & 63, gw = blockIdx.x * 8 + (tid >> 6), NGW = gridDim.x * 8;
    for (int m = gw; m < MTOK; m += NGW) {
        const float4* xr = (const float4*)(x + (size_t)m * DM) + lane;
        float4 v[4]; float ss = 0.f;
#pragma unroll
        for (int j = 0; j < 4; ++j) { v[j] = xr[64 * j]; ss += v[j].x * v[j].x + v[j].y * v[j].y + v[j].z * v[j].z + v[j].w * v[j].w; }
        const float rstd = rsqrtf(wave_sum(ss) * (1.f / DM) + EPS);
        const float* shift = modl + (size_t)(m / SEQ) * 3 * DM; const float* scale = shift + DM;
#pragma unroll
        for (int j = 0; j < 4; ++j) {
            const int n = 4 * lane + 256 * j;
            const float4 g = *(const float4*)(gain + n), sc = *(const float4*)(scale + n), sh = *(const float4*)(shift + n);
            f32x4 o; o[0] = v[j].x * rstd * g.x * (1.f + sc.x) + sh.x; o[1] = v[j].y * rstd * g.y * (1.f + sc.y) + sh.y;
            o[2] = v[j].z * rstd * g.z * (1.f + sc.z) + sh.z; o[3] = v[j].w * rstd * g.w * (1.f + sc.w) + sh.w;
            *(uint2*)(h + (size_t)m * DM + n) = pack4(o);
        }
    }
}
DEV void ssm_post_rows(const bf16_t* z, bf16_t* zo, const bf16_t* sg, const float* gain) {
    const int tid = opaque_tid(), lane = tid & 63, gw = blockIdx.x * 8 + (tid >> 6), NGW = gridDim.x * 8;
    for (int m = gw; m < MTOK; m += NGW) {
        float zv[2][8], gv[2][8]; float ss = 0.f;
#pragma unroll
        for (int j = 0; j < 2; ++j) {
            unpack8(*(const uint4*)(z + (size_t)m * DM + 8 * lane + 512 * j), zv[j]);
            unpack8(*(const uint4*)(sg + (size_t)m * DM + 8 * lane + 512 * j), gv[j]);
#pragma unroll
            for (int e = 0; e < 8; ++e) ss += zv[j][e] * zv[j][e];
        }
        const float rstd = rsqrtf(wave_sum(ss) * (1.f / DM) + EPS);
#pragma unroll
        for (int j = 0; j < 2; ++j) {
            const int n = 8 * lane + 512 * j; float o[8];
#pragma unroll
            for (int e = 0; e < 8; ++e) o[e] = zv[j][e] * rstd * gain[n + e] * siluf_(gv[j][e]);
            *(uint4*)(zo + (size_t)m * DM + n) = pack8(o);
        }
    }
}
DEV void mlstm_post_rows(const bf16_t* hc, bf16_t* ho, const bf16_t* mo, const bf16_t* mg, const bf16_t* mi, const float* cw, const float* cb, const float* ngain, const float* skip) {
    const int tid = opaque_tid(), lane = tid & 63, gw = blockIdx.x * 8 + (tid >> 6), NGW = gridDim.x * 8;
    for (int m = gw; m < MTOK; m += NGW) {
        const size_t o0 = (size_t)m * DM + 16 * lane;
        float hv[16], t8[8]; float s1 = 0.f;
#pragma unroll
        for (int j = 0; j < 2; ++j) {
            unpack8(*(const uint4*)(hc + o0 + 8 * j), hv + 8 * j);
            unpack8(*(const uint4*)(mo + o0 + 8 * j), t8);
#pragma unroll
            for (int e = 0; e < 8; ++e) { hv[8 * j + e] *= sigmoidf_(t8[e]); s1 += hv[8 * j + e]; }
        }
#pragma unroll
        for (int o = 1; o < 16; o <<= 1) s1 += __shfl_xor(s1, o);
        const float mu = s1 * (1.f / DH); float s2 = 0.f;
#pragma unroll
        for (int e = 0; e < 16; ++e) { hv[e] -= mu; s2 += hv[e] * hv[e]; }
#pragma unroll
        for (int o = 1; o < 16; o <<= 1) s2 += __shfl_xor(s2, o);
        const float rstd = rsqrtf(s2 * (1.f / DH) + EPS);
#pragma unroll
        for (int j = 0; j < 2; ++j) {
            float xv[8], gv[8], ov[8], t8b[8];
            { const int n0 = 16 * lane + 8 * j, tpos = m % SEQ;
#pragma unroll
              for (int e = 0; e < 8; ++e) xv[e] = cb[n0 + e];
#pragma unroll
              for (int tap = 0; tap < 4; ++tap) if (tpos - 3 + tap >= 0) {
                  unpack8(*(const uint4*)(mi + (size_t)(m - 3 + tap) * DM + n0), t8b);
#pragma unroll
                  for (int e = 0; e < 8; ++e) xv[e] += t8b[e] * cw[tap * DM + n0 + e];
              }
#pragma unroll
              for (int e = 0; e < 8; ++e) xv[e] = siluf_(xv[e]); }
            unpack8(*(const uint4*)(mg + o0 + 8 * j), gv);
#pragma unroll
            for (int e = 0; e < 8; ++e) { const int n = 16 * lane + 8 * j + e; ov[e] = (hv[8 * j + e] * rstd * ngain[n] + skip[n] * xv[e]) * siluf_(gv[e]); }
            *(uint4*)(ho + o0 + 8 * j) = pack8(ov);
        }
    }
}
DEV void final_rows(float* x, const float* gain) {
    const int tid = opaque_tid(), lane = tid & 63, gw = blockIdx.x * 8 + (tid >> 6), NGW = gridDim.x * 8;
    for (int m = gw; m < MTOK; m += NGW) {
        float4* xr = (float4*)(x + (size_t)m * DM) + lane;
        float4 v[4]; float ss = 0.f;
#pragma unroll
        for (int j = 0; j < 4; ++j) { v[j] = xr[64 * j]; ss += v[j].x * v[j].x + v[j].y * v[j].y + v[j].z * v[j].z + v[j].w * v[j].w; }
        const float rstd = rsqrtf(wave_sum(ss) * (1.f / DM) + EPS);
#pragma unroll
        for (int j = 0; j < 4; ++j) {
            const float4 g = *(const float4*)(gain + 4 * lane + 256 * j);
            v[j].x *= rstd * g.x; v[j].y *= rstd * g.y; v[j].z *= rstd * g.z; v[j].w *= rstd * g.w;
            xr[64 * j] = v[j];
        }
    }
}
DEV void mod_phase(LAS char* shm, const float* c, const float* w_mod, const float* b_mod, float* mod) {
    const int tid = opaque_tid();
    LAS float* sc = (LAS float*)shm;
    LAS float* pr = (LAS float*)(shm + 32768);
    __syncthreads();
    for (int i = tid; i < BATCH * DM; i += 512) sc[i] = siluf_(c[i]);
    __syncthreads();
    for (int it = blockIdx.x; it < 48; it += gridDim.x) {
        const int l = it / 24, n0 = (it % 24) * 128, cq = tid & 31, kg = tid >> 5;
        const float* W = w_mod + (size_t)l * DM * 3 * DM + n0 + 4 * cq;
        float acc[BATCH][4];
#pragma unroll
        for (int b = 0; b < BATCH; ++b) { acc[b][0] = acc[b][1] = acc[b][2] = acc[b][3] = 0.f; }
        for (int k = kg * 64; k < kg * 64 + 64; ++k) {
            const float4 w = *(const float4*)(W + (size_t)k * 3 * DM);
#pragma unroll
            for (int b = 0; b < BATCH; ++b) { const float s_ = sc[b * DM + k]; acc[b][0] += s_ * w.x; acc[b][1] += s_ * w.y; acc[b][2] += s_ * w.z; acc[b][3] += s_ * w.w; }
        }
#pragma unroll
        for (int b = 0; b < BATCH; ++b) *(LAS f32x4*)(pr + (kg * 8 + b) * 128 + 4 * cq) = (f32x4){acc[b][0], acc[b][1], acc[b][2], acc[b][3]};
        __syncthreads();
        for (int o = tid; o < 8 * 128; o += 512) {
            const int b = o >> 7, n = o & 127; float s_ = 0.f;
#pragma unroll
            for (int g2 = 0; g2 < 16; ++g2) s_ += pr[(g2 * 8 + b) * 128 + n];
            mod[((size_t)l * BATCH + b) * 3 * DM + n0 + n] = s_ + b_mod[l * 3 * DM + n0 + n];
        }
        __syncthreads();
    }
}

DEV void wfold_prep(bf16_t* WfT, const float* wq, const float* wk, const float* wv, const float* wg  ) {
    const int tid = opaque_tid(), lane = tid & 63;
    for (int t = blockIdx.x * 8 + (tid >> 6); t < 2048; t += gridDim.x * 8) {
        const int which = t >> 10, ch = t & 1023, hd = ch >> 8, d = ch & 255;
        float acc[8];
#pragma unroll
        for (int j = 0; j < 8; ++j) acc[j] = 0.f;
        if (which == 0) {
            const float4 q4 = *(const float4*)(wq + ((size_t)hd * DH + d) * DH + 4 * lane);
            const float4 k4 = *(const float4*)(wk + ((size_t)hd * DH + d) * DH + 4 * lane);
            const float qv[4] = {q4.x, q4.y, q4.z, q4.w}, kv[4] = {k4.x * 0.0625f, k4.y * 0.0625f, k4.z * 0.0625f, k4.w * 0.0625f};
#pragma unroll
            for (int e = 0; e < 4; ++e) {
                const float* g1 = wg + (size_t)(hd * DH + 4 * lane + e) * 8; const float* g2 = wg + (size_t)(DM + hd * DH + 4 * lane + e) * 8;
                const float4 a0 = *(const float4*)g1, a1 = *(const float4*)(g1 + 4), b0 = *(const float4*)g2, b1 = *(const float4*)(g2 + 4);
                acc[0] += qv[e] * a0.x + kv[e] * b0.x; acc[1] += qv[e] * a0.y + kv[e] * b0.y; acc[2] += qv[e] * a0.z + kv[e] * b0.z; acc[3] += qv[e] * a0.w + kv[e] * b0.w;
                acc[4] += qv[e] * a1.x + kv[e] * b1.x; acc[5] += qv[e] * a1.y + kv[e] * b1.y; acc[6] += qv[e] * a1.z + kv[e] * b1.z; acc[7] += qv[e] * a1.w + kv[e] * b1.w;
            }
        } else {
            const float4 v4 = *(const float4*)(wv + ((size_t)hd * DH + d) * DH + 4 * lane);
            const float vv[4] = {v4.x, v4.y, v4.z, v4.w};
#pragma unroll
            for (int e = 0; e < 4; ++e) {
                const float* g1 = wg + (size_t)(2 * DM + hd * DH + 4 * lane + e) * 8;
                const float4 a0 = *(const float4*)g1, a1 = *(const float4*)(g1 + 4);
                acc[0] += vv[e] * a0.x; acc[1] += vv[e] * a0.y; acc[2] += vv[e] * a0.z; acc[3] += vv[e] * a0.w;
                acc[4] += vv[e] * a1.x; acc[5] += vv[e] * a1.y; acc[6] += vv[e] * a1.z; acc[7] += vv[e] * a1.w;
            }
        }
#pragma unroll
        for (int j = 0; j < 8; ++j) acc[j] = wave_sum(acc[j]);
        if (lane < 16) {
            float v = 0.f;
#pragma unroll
            for (int j = 0; j < 8; ++j) v = (lane == j) ? acc[j] : v;
            WfT[((size_t)which * 16 + lane) * 1024 + ch] = f2bf(v);
        }
    }
}
DEV void xc_gates_phase(LAS char* shm, const bf16_t* mi, bf16_t* xc, const bf16_t* WfT, const float* cw, const float* cb, float* gpart  ) {
    const int tid = opaque_tid(), wid = __builtin_amdgcn_readfirstlane(tid >> 6), lane = tid & 63, fr = lane & 15, fq = lane >> 4;
    constexpr int WRS = 2064, WIMG = 16 * WRS, STG = 2 * WIMG, SRS_ = 528, STG_W = 19 * SRS_;
    __syncthreads();
    for (int i = tid; i < 2 * 16 * 128; i += 512) {
        const int rowi = i >> 7, pc = i & 127;
        const uint4 v = *(const uint4*)(WfT + (size_t)rowi * 1024 + pc * 8);
        *(LAS u32x4*)(shm + rowi * WRS + pc * 16) = (u32x4){v.x, v.y, v.z, v.w};
    }
    __syncthreads();
    LAS char* stg = shm + STG + wid * STG_W;
    for (int task = blockIdx.x * 8 + wid; task < (MTOK / 16) * 2; task += gridDim.x * 8) {
        const int chalf = task & 1, m0 = (task >> 1) * 16, tpos0 = m0 % SEQ;
        f32x4 acc = (f32x4){0.f, 0.f, 0.f, 0.f};
#pragma nounroll
        for (int sl = 0; sl < 2; ++sl) {
            const int c0 = chalf * 512 + sl * 256;
            for (int i = lane; i < 19 * 32; i += 64) {
                const int row = i >> 5, pc = i & 31;
                uint4 v = make_uint4(0, 0, 0, 0);
                if (tpos0 - 3 + row >= 0) v = *(const uint4*)(mi + (size_t)(m0 - 3 + row) * DM + c0 + pc * 8);
                *(LAS u32x4*)(stg + row * SRS_ + pc * 16) = (u32x4){v.x, v.y, v.z, v.w};
            }
#pragma nounroll
            for (int ks = 0; ks < 8; ++ks) {
                const int cl = 32 * ks + 8 * fq, c = c0 + cl;
                float xv[8], t8[8], w8[8];
                { const float4 b0 = *(const float4*)(cb + c), b1 = *(const float4*)(cb + c + 4);
                  xv[0] = b0.x; xv[1] = b0.y; xv[2] = b0.z; xv[3] = b0.w; xv[4] = b1.x; xv[5] = b1.y; xv[6] = b1.z; xv[7] = b1.w; }
                u32x4 raw3;
#pragma unroll
                for (int tap = 0; tap < 4; ++tap) {
                    const u32x4 rw = *(const LAS u32x4*)(stg + (fr + tap) * SRS_ + cl * 2);
                    if (tap == 3) raw3 = rw;
                    unpack8(make_uint4(rw[0], rw[1], rw[2], rw[3]), t8);
                    const float4 w0 = *(const float4*)(cw + tap * DM + c), w1 = *(const float4*)(cw + tap * DM + c + 4);
                    w8[0] = w0.x; w8[1] = w0.y; w8[2] = w0.z; w8[3] = w0.w; w8[4] = w1.x; w8[5] = w1.y; w8[6] = w1.z; w8[7] = w1.w;
#pragma unroll
                    for (int e = 0; e < 8; ++e) xv[e] += t8[e] * w8[e];
                }
#pragma unroll
                for (int e = 0; e < 8; ++e) xv[e] = siluf_(xv[e]);
                const uint4 xp = pack8(xv);
                *(uint4*)(xc + (size_t)(m0 + fr) * DM + c) = xp;
                const u32x4 xpu = (u32x4){xp.x, xp.y, xp.z, xp.w};
                const bf16x8 bx = *(const LAS bf16x8*)(shm + fr * WRS + c * 2);
                const bf16x8 bv = *(const LAS bf16x8*)(shm + WIMG + fr * WRS + c * 2);
                acc = __builtin_amdgcn_mfma_f32_16x16x32_bf16(*(const bf16x8*)&xpu, bx, acc, 0, 0, 0);
                acc = __builtin_amdgcn_mfma_f32_16x16x32_bf16(*(const bf16x8*)&raw3, bv, acc, 0, 0, 0);
            }
        }
        if (fr < 8) {
#pragma unroll
            for (int r = 0; r < 4; ++r) gpart[((size_t)chalf * MTOK + m0 + 4 * fq + r) * 8 + fr] = acc[r];
        }
    }
}

#define XB_TMO      128
#define XB_XCNT(j)  (256  + 64 * (j))
#define XB_XSUB(j)  (1280 + 64 * (j))
#define XB_XGEN(j)  (2304 + 64 * (j))
#define XB_TOP      3328
#define XB_TOPGEN   3392
#define XCD_BAR_WORDS 3456
#define XB_SPIN_CAP (1u << 18)
DEV unsigned xb_ld(unsigned* p) { return __hip_atomic_load(p, __ATOMIC_RELAXED, __HIP_MEMORY_SCOPE_AGENT); }
DEV unsigned xb_add(unsigned* p, unsigned v) { return __hip_atomic_fetch_add(p, v, __ATOMIC_RELAXED, __HIP_MEMORY_SCOPE_AGENT); }
DEV unsigned xb_xcc_id() { return (unsigned)__builtin_amdgcn_s_getreg((3 << 11) | 20) & 0xFu; }
#define XB_SPIN(cond, bar) do { unsigned _sp = 0; while (cond) { __builtin_amdgcn_s_sleep(1); \
    if ((++_sp & 255u) == 0u) { if (xb_ld(&(bar)[XB_TMO])) break; if (_sp > XB_SPIN_CAP) { atomicAdd(&(bar)[XB_TMO], 1u); break; } } } } while (0)
struct XcdBarrier { unsigned* bar; unsigned x; volatile LAS unsigned* st; };
DEV XcdBarrier xcd_barrier_post(unsigned* bar, volatile LAS unsigned* st) {
    XcdBarrier b; b.bar = bar; b.x = xb_xcc_id(); b.st = st;
    if (threadIdx.x == 0) (void)xb_add(&bar[XB_XCNT(b.x)], 1u);
    return b;
}
DEV void xcd_barrier_complete(unsigned* bar, unsigned x, unsigned& nloc, unsigned& nx) {
    const unsigned G = gridDim.x * gridDim.y * gridDim.z;
    unsigned sum, cnt, mine, sp = 0u;
    for (;;) {
        sum = 0u; cnt = 0u; mine = 0u;
#pragma nounroll
        for (unsigned j = 0; j < 16; ++j) { const unsigned c = xb_ld(&bar[XB_XCNT(j)]); sum += c; cnt += (c > 0u) ? 1u : 0u; }
        mine = xb_ld(&bar[XB_XCNT(x)]);
        if (sum == G) break;
        __builtin_amdgcn_s_sleep(1);
        if ((++sp & 255u) == 0u) { if (xb_ld(&bar[XB_TMO])) break; if (sp > XB_SPIN_CAP) { atomicAdd(&bar[XB_TMO], 1u); break; } }
    }
    nloc = mine > 0u ? mine : 1u; nx = cnt > 0u ? cnt : 1u;
}
DEV void xcd_barrier1(const XcdBarrier& b) {
    asm volatile("s_waitcnt vmcnt(0)" ::: "memory");
    __syncthreads();
    if (threadIdx.x == 0) {
        unsigned* bar = b.bar;
        __builtin_amdgcn_s_waitcnt(0);
        unsigned nloc = b.st[0], nx = b.st[1];
        if (nloc == 0u) { xcd_barrier_complete(bar, b.x, nloc, nx); b.st[0] = nloc; b.st[1] = nx; }
        const unsigned old = xb_add(&bar[XB_XSUB(b.x)], 1u);
        const unsigned gen = old / nloc;
        if (old + 1u == (gen + 1u) * nloc) {
            __builtin_amdgcn_fence(__ATOMIC_RELEASE, "agent");
            asm volatile("s_waitcnt vmcnt(0)" ::: "memory");
            const unsigned og = xb_add(&bar[XB_TOP], 1u);
            const unsigned tg = og / nx;
            if (og + 1u == (tg + 1u) * nx) xb_add(&bar[XB_TOPGEN], 1u);
            else XB_SPIN(xb_ld(&bar[XB_TOPGEN]) == tg, bar);
            __builtin_amdgcn_fence(__ATOMIC_ACQUIRE, "agent");
            xb_add(&bar[XB_XGEN(b.x)], 1u);
            asm volatile("s_waitcnt vmcnt(0)" ::: "memory");
        } else {
            XB_SPIN(xb_ld(&bar[XB_XGEN(b.x)]) == gen, bar);
            __builtin_amdgcn_fence(__ATOMIC_ACQUIRE, "agent");
            asm volatile("s_waitcnt vmcnt(0)" ::: "memory");
        }
    }
    __syncthreads();
}

DEV void xcd_barrier(const XcdBarrier& b) { xcd_barrier1(b); if (REPMASK & 2048) xcd_barrier1(b); }
constexpr int LDS_BYTES = 148 * 1024;
DEV const void* ldptr(LAS char* shm, int i) {
    volatile LAS unsigned* pt = (volatile LAS unsigned*)(shm + LDS_BYTES - 512);
    const unsigned lo = __builtin_amdgcn_readfirstlane(pt[2 * i]), hi = __builtin_amdgcn_readfirstlane(pt[2 * i + 1]);
    return (const void*)(const __attribute__((address_space(1))) void*)(((unsigned long long)hi << 32) | lo);
}
#define PF(i) ((const float*)ldptr(shm, (i)))
struct Params {
    const float *x, *c, *norm_gain, *w_mod, *b_mod, *w_in, *lam_re, *lam_im, *log_dt, *sb_re, *sb_im, *sc_re, *sc_im, *ssm_d, *w_glu, *b_glu, *ssm_og,
        *conv_w, *conv_b, *wq, *wk, *wv, *w_gates, *b_ig, *b_fg, *m_ng, *m_skip, *w_out, *final_gain;
    float* out; char* ws;
};
constexpr int HALF_FLOATS = 56 * 1024 / 4;
constexpr size_t SLOT = (size_t)MTOK * DM * 2;
constexpr size_t W_IN_OFF = 0, W_GLU_OFF = 10485760, W_QKV_OFF = 12582912, W_OUT_OFF = 14155776, MOD_OFF = 20u << 20, IPRE_OFF = 21u << 20, LOGF_OFF = 22u << 20, BAR_OFF = 23u << 20, WF_OFF = 19u << 20, ROWSS_OFF = 24u << 20, RSTD_OFF = 25u << 20;
#define REP(bit) _Pragma("nounroll") for (int rep_ = 0; rep_ < (((REPMASK) & (bit)) ? 2 : 1); ++rep_)
#define FOR_VB(nvb) for (int vb = blockIdx.x * 2 + HALF; vb < (nvb); vb += gridDim.x * 2)

#define WSB ((char*)ldptr(shm, 30))
#define SL(i) ((bf16_t*)(WSB + SLOT * (i)))
#define S7(off) (WSB + SLOT * 7 + (off))
#define WinT ((bf16_t*)S7(W_IN_OFF))
#define WgluT ((bf16_t*)S7(W_GLU_OFF))
#define WqkvT ((bf16_t*)S7(W_QKV_OFF))
#define WoutT ((bf16_t*)S7(W_OUT_OFF))
#define mod ((float*)S7(MOD_OFF))
#define gpart ((float*)S7(IPRE_OFF))
#define WfT ((bf16_t*)S7(WF_OFF))
#define rowss ((float*)S7(ROWSS_OFF))
#define rstdv ((float*)S7(RSTD_OFF))
#define MX SL(1)
#define OUTP ((float*)ldptr(shm, 29))
#define H SL(0)
#define U SL(1)
#define Y SL(2)
#define Z SL(3)
#define XC SL(4)
#define MI SL(5)
#define Q SL(6)
#define Kb SL(1)
#define V SL(2)
#define HC SL(5)
template <int l>
DEV void layer_body(LAS char* shm, const XcdBarrier& gbar) {
        const int wave = opaque_tid() >> 6, lane = opaque_tid() & 63;
        const float* xin = (l == 0) ? PF(0) : OUTP;
        const float* modl = mod + (size_t)l * BATCH * 3 * DM;
        REP(1) { {
            LAS float* scr = (LAS float*)(shm + wave * 16640);
            const float* Win = PF(5) + (size_t)l * DM * INC;
            constexpr int I_IN = 16 * 80, I_GLU = 16 * 16, I_QKV = 12 * 16, I_OUT = 32 * 16;
            for (int it = blockIdx.x * 8 + wave; it < I_IN + I_GLU + I_QKV + I_OUT; it += gridDim.x * 8) {
                int r = it;
                if (r < I_IN) { transpose_item(Win, INC, INC, WinT, DM, scr, r, lane); continue; } r -= I_IN;
                if (r < I_GLU) { transpose_item(PF(14) + (size_t)l * DM * DM, DM, DM, WgluT, DM, scr, r, lane); continue; } r -= I_GLU;
                if (r < I_QKV) { const int mat = r / 16, which = mat >> 2, hd = mat & 3;
                    const float* W = sel3(which, PF(19), PF(20), PF(21)) + ((size_t)l * NH + hd) * DH * DH;
                    transpose_item(W, DH, DH, WqkvT + (size_t)mat * DH * DH, DH, scr, r % 16, lane); continue; } r -= I_QKV;
                transpose_item(PF(27) + (size_t)l * 2 * DM * DM, DM, DM, WoutT, 2 * DM, scr, r, lane);
            }
        }
        wfold_prep(WfT, PF(19) + (size_t)l * NH * DH * DH, PF(20) + (size_t)l * NH * DH * DH, PF(21) + (size_t)l * NH * DH * DH, PF(22) + (size_t)l * 3 * DM * 8);
        __syncthreads();
        s5_tables(shm, (char*)SL(3), PF(6) + l * NG * NP, PF(7) + l * NG * NP, PF(8) + l * NG, PF(9) + (size_t)l * NG * NP * GC, PF(10) + (size_t)l * NG * NP * GC,
                  PF(11) + (size_t)l * NG * GC * NP, PF(12) + (size_t)l * NG * GC * NP);
        __syncthreads();
        norm_rows(xin, PF(2) + l * DM, modl, H);
        }
        xcd_barrier(gbar);
        REP(2) { g8::SchedG1 S_{H, WinT, (int)blockIdx.x, (int)gridDim.x}; g8::EpiG1 E_{U, MI}; g8::gemm_phase(shm, S_, E_); }
        xcd_barrier(gbar);
        REP(256) s5_phase(shm, U, Y, (const char*)SL(3), PF(13) + l * DM);
        REP(8) xc_gates_phase(shm, MI, XC, WfT, PF(17) + l * 4 * DM, PF(18) + l * DM, gpart);
        xcd_barrier(gbar);
        REP(4) { g8::SchedGlu S_{Y, WgluT, (int)blockIdx.x, (int)gridDim.x}; g8::EpiGlu E_{Y, Z, PF(15) + l * DM, rowss}; g8::gemm_phase(shm, S_, E_); }
        xcd_barrier(gbar);
        REP(16) { g8::SchedQkv S_{XC, MI, WqkvT, (int)blockIdx.x, (int)gridDim.x}; g8::EpiQkv E_{Q, Kb, V}; g8::gemm_phase(shm, S_, E_); }
        xcd_barrier(gbar);
        rstd_rows(rowss, rstdv);
        REP(32) mlstm_phase<0>(shm, Q, Kb, V, gpart, PF(23) + l * 4, PF(24) + l * 4, HC);
#ifdef MLPROBE
        if (l == 0) mlstm_phase<MLPROBE>(shm, Q, Kb, V, gpart, PF(23) + l * 4, PF(24) + l * 4, (bf16_t*)OUTP);
#endif
        xcd_barrier(gbar);
        { g8::SchedG2s S_{H, WinT, (int)blockIdx.x}; g8::EpiG2s E_{Z, rstdv, PF(16) + l * DM, MX}; g8::gemm_phase(shm, S_, E_); }
        { g8::SchedG2m S_{H, WinT, (int)blockIdx.x}; g8::EpiG2m E_{HC, XC, PF(25) + l * DM, PF(26) + l * DM, MX}; g8::gemm_phase(shm, S_, E_); }
        xcd_barrier(gbar);
        REP(l == 0 ? 128 : 0) { g8::SchedOut S_{MX, WoutT, (int)blockIdx.x, (int)gridDim.x}; g8::EpiOut E_{xin, OUTP, modl + 2 * DM}; g8::gemm_phase(shm, S_, E_); }
        xcd_barrier(gbar);
    }
__global__ void __launch_bounds__(512, 2) mega(Params Pk) {
    extern __shared__ __attribute__((aligned(16))) unsigned char lds_raw[];
    {
        volatile LAS unsigned long long* pt = (volatile LAS unsigned long long*)((LAS char*)lds_raw + LDS_BYTES - 512);
        if (threadIdx.x == 0) {
            pt[0] = (unsigned long long)Pk.x;
            pt[1] = (unsigned long long)Pk.c;
            pt[2] = (unsigned long long)Pk.norm_gain;
            pt[3] = (unsigned long long)Pk.w_mod;
            pt[4] = (unsigned long long)Pk.b_mod;
            pt[5] = (unsigned long long)Pk.w_in;
            pt[6] = (unsigned long long)Pk.lam_re;
            pt[7] = (unsigned long long)Pk.lam_im;
            pt[8] = (unsigned long long)Pk.log_dt;
            pt[9] = (unsigned long long)Pk.sb_re;
            pt[10] = (unsigned long long)Pk.sb_im;
            pt[11] = (unsigned long long)Pk.sc_re;
            pt[12] = (unsigned long long)Pk.sc_im;
            pt[13] = (unsigned long long)Pk.ssm_d;
            pt[14] = (unsigned long long)Pk.w_glu;
            pt[15] = (unsigned long long)Pk.b_glu;
            pt[16] = (unsigned long long)Pk.ssm_og;
            pt[17] = (unsigned long long)Pk.conv_w;
            pt[18] = (unsigned long long)Pk.conv_b;
            pt[19] = (unsigned long long)Pk.wq;
            pt[20] = (unsigned long long)Pk.wk;
            pt[21] = (unsigned long long)Pk.wv;
            pt[22] = (unsigned long long)Pk.w_gates;
            pt[23] = (unsigned long long)Pk.b_ig;
            pt[24] = (unsigned long long)Pk.b_fg;
            pt[25] = (unsigned long long)Pk.m_ng;
            pt[26] = (unsigned long long)Pk.m_skip;
            pt[27] = (unsigned long long)Pk.w_out;
            pt[28] = (unsigned long long)Pk.final_gain;
            pt[29] = (unsigned long long)Pk.out; pt[30] = (unsigned long long)Pk.ws;
        }
    }
    __syncthreads();
    LAS char* shm = (LAS char*)lds_raw;
    float* ldsf = (float*)lds_raw + HALF * HALF_FLOATS;
    volatile LAS unsigned* bst = (volatile LAS unsigned*)(shm + LDS_BYTES - 16);
    if (threadIdx.x < 4) bst[threadIdx.x] = 0u;
    __syncthreads();
    const XcdBarrier gbar = xcd_barrier_post((unsigned*)((char*)ldptr(shm, 30) + SLOT * 7 + BAR_OFF), bst);
    REP(4096) mod_phase(shm, PF(1), PF(3), PF(4), mod);
    xcd_barrier(gbar);
    layer_body<0>(shm, gbar);
    layer_body<1>(shm, gbar);
    final_rows(OUTP, PF(28));
}

#undef WSB
#undef SL
#undef S7
#undef WinT
#undef WgluT
#undef WqkvT
#undef WoutT
#undef mod
#undef gpart
#undef WfT
#undef rowss
#undef rstdv
#undef MX
#undef OUTP
#undef H
#undef U
#undef Y
#undef Z
#undef XC
#undef MI
#undef Q
#undef Kb
#undef V
#undef HC
extern "C" void kernel_launch(void* const* d_in, const int* in_sizes, int n_in, void* d_out, int out_size, void* d_ws, size_t ws_size, hipStream_t stream) {
    static int grid_blocks = 0;
    if (!grid_blocks) {
        int dev = 0, cus = 0, per_cu = 0;
        (void)hipGetDevice(&dev);
        (void)hipDeviceGetAttribute(&cus, hipDeviceAttributeMultiprocessorCount, dev);
        (void)hipFuncSetAttribute((const void*)mega, hipFuncAttributeMaxDynamicSharedMemorySize, LDS_BYTES);
        (void)hipOccupancyMaxActiveBlocksPerMultiprocessor(&per_cu, (const void*)mega, 512, LDS_BYTES);
        grid_blocks = cus;
        fprintf(stderr, "mega: cus=%d occupancy per_cu=%d grid=%d\n", cus, per_cu, grid_blocks);
    }
    (void)hipMemsetAsync((char*)d_ws + SLOT * 7 + BAR_OFF, 0, XCD_BAR_WORDS * 4, stream);
    Params P{};
    const float** pp = (const float**)&P;
    for (int i = 0; i < 29; ++i) pp[i] = (const float*)d_in[i];
    P.out = (float*)d_out; P.ws = (char*)d_ws;
    void* args[] = {&P};
    hipError_t e = hipLaunchCooperativeKernel((const void*)mega, dim3(grid_blocks), dim3(512), args, LDS_BYTES, stream);
    if (e != hipSuccess) fprintf(stderr, "cooperative launch failed: %s (grid %d)\n", hipGetErrorString(e), grid_blocks);
}
```

```cpp
#include <hip/hip_runtime.h>
#include <cstdio>
#include <cstdint>
#include <hip/hip_cooperative_groups.h>
namespace cg = cooperative_groups;

#ifndef REPMASK
#define REPMASK 0
#endif
typedef unsigned short bf16_t;
#define DEV __device__ __forceinline__

constexpr int BATCH = 8, SEQ = 2048, DM = 1024, MTOK = BATCH * SEQ;
constexpr int NG = 64, NP = 64, GC = 16, NH = 4, DH = 256, CHUNK = 64, INC = 5120;
constexpr float EPS = 1e-6f;

DEV int opaque_tid() { int t = threadIdx.x; asm volatile("" : "+v"(t)); return t; }
#define TIDH (opaque_tid() & 255)
#define HALF (opaque_tid() >> 8)
DEV float bf2f(bf16_t v) { return __uint_as_float(((unsigned)v) << 16); }
typedef __bf16 bf16n2 __attribute__((ext_vector_type(2)));
typedef float f32n2 __attribute__((ext_vector_type(2)));
DEV bf16_t f2bf(float f) { __bf16 b = (__bf16)f; return __builtin_bit_cast(unsigned short, b); }
DEV unsigned pk2(float lo, float hi) { f32n2 v = {lo, hi}; bf16n2 b = __builtin_convertvector(v, bf16n2); return __builtin_bit_cast(unsigned, b); }
DEV float sigmoidf_(float x) { return 1.f / (1.f + __expf(-x)); }
DEV float siluf_(float x) { return x / (1.f + __expf(-x)); }
DEV float geluf_(float x) { const float t2 = 1.5957691216057308f * (x + 0.044715f * x * x * x); return x / (1.f + __expf(-t2)); }
DEV float logsigmoidf_(float x) { return fminf(x, 0.f) - log1pf(__expf(-fabsf(x))); }

DEV float wave_sum(float v) {
#pragma unroll
    for (int o = 1; o < 64; o <<= 1) v += __shfl_xor(v, o);
    return v;
}
DEV float block_sum256(float v, float* red) {
    v = wave_sum(v);
    __syncthreads();
    if ((TIDH & 63) == 0) red[TIDH >> 6] = v;
    __syncthreads();
    return red[0] + red[1] + red[2] + red[3];
}

DEV void k_mod(int vb, float* ldsf, const float* c, const float* w_mod, const float* b_mod, float* mod) {
    float (*sc)[DM] = (float (*)[DM])ldsf;
    const int l = vb / 12, n = (vb % 12) * 256 + TIDH;
    __syncthreads();
    for (int i = TIDH; i < BATCH * DM; i += 256) sc[i / DM][i % DM] = siluf_(c[i]);
    __syncthreads();
    float acc[BATCH];
#pragma unroll
    for (int b = 0; b < BATCH; ++b) acc[b] = 0.f;
    const float* W = w_mod + (size_t)l * DM * 3 * DM;
    for (int k = 0; k < DM; ++k) {
        float w = W[(size_t)k * 3 * DM + n];
#pragma unroll
        for (int b = 0; b < BATCH; ++b) acc[b] += sc[b][k] * w;
    }
#pragma unroll
    for (int b = 0; b < BATCH; ++b) mod[((size_t)l * BATCH + b) * 3 * DM + n] = acc[b] + b_mod[l * 3 * DM + n];
}

DEV void k_norm_mod(int vb, float* red, const float* x, const float* gain, const float* mod  , bf16_t* h) {
    const int m = vb, b = m / SEQ, t = TIDH;
    const float4 v = ((const float4*)(x + (size_t)m * DM))[t];
    float ss = v.x * v.x + v.y * v.y + v.z * v.z + v.w * v.w;
    ss = block_sum256(ss, red);
    const float rstd = rsqrtf(ss * (1.f / DM) + EPS);
    const float* shift = mod + (size_t)b * 3 * DM;
    const float* scale = shift + DM;
    float xv[4] = {v.x, v.y, v.z, v.w};
#pragma unroll
    for (int i = 0; i < 4; ++i) {
        int n = t * 4 + i;
        float y = xv[i] * rstd * gain[n] * (1.f + scale[n]) + shift[n];
        h[(size_t)m * DM + n] = f2bf(y);
    }
}

DEV void k_s5(int item, float* ldsf, const bf16_t* u, bf16_t* y, const float* lam_re, const float* lam_im, const float* log_dt,
                                           const float* b_re, const float* b_im, const float* c_re, const float* c_im, const float* dskip) {
    const int tid_ = opaque_tid();
    float (*part)[17] = (float (*)[17])(ldsf + (tid_ >> 6) * 64 * 17);
    const int g = item & 63, b = item >> 6, p = tid_ & 63;
    const double lr = lam_re[g * NP + p], li = lam_im[g * NP + p], dt = exp((double)log_dt[g]);
    const double er = exp(lr * dt);
    const double ard = er * cos(li * dt), aid = er * sin(li * dt);
    const double dr = ard - 1.0, di = aid, den = lr * lr + li * li;
    const double cr = (dr * lr + di * li) / den, ci = (di * lr - dr * li) / den;
    float bbr[16], bbi[16], ccr[16], cci[16];
#pragma unroll
    for (int c = 0; c < 16; ++c) {
        const double br = b_re[(g * NP + p) * GC + c], bi = b_im[(g * NP + p) * GC + c];
        bbr[c] = (float)(cr * br - ci * bi); bbi[c] = (float)(cr * bi + ci * br);
        ccr[c] = c_re[(g * GC + c) * NP + p]; cci[c] = c_im[(g * GC + c) * NP + p];
    }
    const float ar = (float)ard, ai = (float)aid;
    const float dsk = dskip[g * GC + (p & 15)];
    float sr = 0.f, si = 0.f;
    for (int t = 0; t < SEQ; ++t) {
        const bf16_t* up = u + (size_t)(b * SEQ + t) * DM + g * GC;
        const uint4 u0 = *(const uint4*)up, u1 = *(const uint4*)(up + 8);
        float uf[16];
        uf[0] = bf2f(u0.x & 0xffff); uf[1] = bf2f(u0.x >> 16); uf[2] = bf2f(u0.y & 0xffff); uf[3] = bf2f(u0.y >> 16);
        uf[4] = bf2f(u0.z & 0xffff); uf[5] = bf2f(u0.z >> 16); uf[6] = bf2f(u0.w & 0xffff); uf[7] = bf2f(u0.w >> 16);
        uf[8] = bf2f(u1.x & 0xffff); uf[9] = bf2f(u1.x >> 16); uf[10] = bf2f(u1.y & 0xffff); uf[11] = bf2f(u1.y >> 16);
        uf[12] = bf2f(u1.z & 0xffff); uf[13] = bf2f(u1.z >> 16); uf[14] = bf2f(u1.w & 0xffff); uf[15] = bf2f(u1.w >> 16);
        float bur = 0.f, bui = 0.f;
#pragma unroll
        for (int c = 0; c < 16; ++c) { bur += bbr[c] * uf[c]; bui += bbi[c] * uf[c]; }
        const float nr = ar * sr - ai * si + bur, ni = ar * si + ai * sr + bui;
        sr = nr; si = ni;
#pragma unroll
        for (int c = 0; c < 16; ++c) part[p][c] = ccr[c] * sr - cci[c] * si;
        asm volatile("s_waitcnt lgkmcnt(0)" ::: "memory");
        float s = 0.f;
#pragma unroll
        for (int k = 0; k < 16; ++k) s += part[(p >> 4) * 16 + k][p & 15];
        s += __shfl_xor(s, 16); s += __shfl_xor(s, 32);
        if (p < 16) {
            const float yv = s + dsk * bf2f(up[p]);
            y[(size_t)(b * SEQ + t) * DM + g * GC + p] = f2bf(geluf_(yv));
        }
        asm volatile("s_waitcnt lgkmcnt(0)" ::: "memory");
    }
}

DEV void k_ssm_post(int vb, float* red, bf16_t* z, const bf16_t* sg, const float* gain) {
    const int m = vb, t = TIDH;
    float zv[4]; float ss = 0.f;
#pragma unroll
    for (int i = 0; i < 4; ++i) { zv[i] = bf2f(z[(size_t)m * DM + t * 4 + i]); ss += zv[i] * zv[i]; }
    ss = block_sum256(ss, red);
    const float rstd = rsqrtf(ss * (1.f / DM) + EPS);
#pragma unroll
    for (int i = 0; i < 4; ++i) {
        const int n = t * 4 + i;
        z[(size_t)m * DM + n] = f2bf(zv[i] * rstd * gain[n] * siluf_(bf2f(sg[(size_t)m * DM + n])));
    }
}

DEV float conv_xc(const bf16_t* mi, int m, int n, const float* cw, const float* cb) {
    const int t = m % SEQ;
    float acc = cb[n];
#pragma unroll
    for (int j = 0; j < 4; ++j) {
        const int tt = t - 3 + j;
        if (tt >= 0) acc += bf2f(mi[(size_t)(m - 3 + j) * DM + n]) * cw[j * DM + n];
    }
    return siluf_(acc);
}
DEV void k_conv(int vb, const bf16_t* mi, bf16_t* xc, const float* cw, const float* cb) {
    const size_t idx = (size_t)vb * 256 + TIDH;
    const int m = (int)(idx / DM), n = (int)(idx % DM);
    xc[idx] = f2bf(conv_xc(mi, m, n, cw, cb));
}

DEV void k_gates(int vb, float* ldsf, const bf16_t* q, const bf16_t* k, const bf16_t* v, const float* wg  , const float* bi, const float* bfg,
                                               float* ipre, float* logf) {
    float (*red)[8] = (float (*)[8])ldsf;
    const int m = vb, t = TIDH;
    __syncthreads();
    float acc[8];
#pragma unroll
    for (int j = 0; j < 8; ++j) acc[j] = 0.f;
    for (int e = t; e < 3 * DM; e += 256) {
        const bf16_t* src = (e < DM) ? q : (e < 2 * DM ? k : v);
        const float xv = bf2f(src[(size_t)m * DM + (e & (DM - 1))]);
#pragma unroll
        for (int j = 0; j < 8; ++j) acc[j] += xv * wg[e * 8 + j];
    }
#pragma unroll
    for (int j = 0; j < 8; ++j) acc[j] = wave_sum(acc[j]);
    if ((t & 63) == 0) {
#pragma unroll
        for (int j = 0; j < 8; ++j) red[t >> 6][j] = acc[j];
    }
    __syncthreads();
    if (t < 8) {
        const float s = red[0][t] + red[1][t] + red[2][t] + red[3][t];
        if (t < 4) ipre[(size_t)m * 4 + t] = s + bi[t];
        else logf[(size_t)m * 4 + (t - 4)] = logsigmoidf_(s + bfg[t - 4]);
    }
}

DEV void k_mlstm(int vb, float* ldsf, const bf16_t* q, const bf16_t* k, const bf16_t* v, const float* ipre, const float* logf, bf16_t* hc) {
    float (*Cs)[257] = (float (*)[257])ldsf;
    float (*St)[65] = (float (*)[65])(ldsf + 32 * 257);
    float* nvec = ldsf + 32 * 257 + 64 * 65;
    float* bcum = nvec + 256; float* ig = bcum + 64; float* mt = ig + 64; float* winter = mt + 64; float* ws_ = winter + 64; float* hden = ws_ + 64;
    float* sc = hden + 64;
    const int tid = TIDH;
    const int vs = vb & 7, h = (vb >> 3) & 3, b = vb >> 5;
    __syncthreads();
    for (int i = tid; i < 32 * 257; i += 256) (&Cs[0][0])[i] = 0.f;
    nvec[tid] = 0.f;
    if (tid == 0) sc[0] = 0.f;
    __syncthreads();
    const size_t base = (size_t)b * SEQ * DM + h * DH;
    for (int j = 0; j < SEQ / CHUNK; ++j) {
        const size_t cb = base + (size_t)j * CHUNK * DM;
        const int m0 = b * SEQ + j * CHUNK;
        if (tid < 64) {
            ig[tid] = ipre[(size_t)(m0 + tid) * 4 + h];
            ws_[tid] = logf[(size_t)(m0 + tid) * 4 + h];
        }
        __syncthreads();
        if (tid < 64) { float s = 0.f; for (int i = 0; i <= tid; ++i) s += ws_[i]; bcum[tid] = s; }
        __syncthreads();
        const float m_prev = sc[0];
        if (tid < 64) {
            const float m_inter = bcum[tid] + m_prev;
            float mx = -INFINITY;
            for (int s = 0; s <= tid; ++s) mx = fmaxf(mx, bcum[tid] - bcum[s] + ig[s]);
            const float m = fmaxf(m_inter, mx);
            mt[tid] = m; winter[tid] = __expf(m_inter - m);
        }
        __syncthreads();
        for (int idx = tid; idx < 4096; idx += 256) {
            const int t = idx >> 6, s = idx & 63;
            float r = 0.f;
            if (s <= t) {
                const bf16_t* qp = q + cb + (size_t)t * DM; const bf16_t* kp = k + cb + (size_t)s * DM;
                float dot = 0.f;
                for (int d = 0; d < DH; d += 8) {
                    const uint4 qa = *(const uint4*)(qp + d), ka = *(const uint4*)(kp + d);
                    dot += bf2f(qa.x & 0xffff) * bf2f(ka.x & 0xffff) + bf2f(qa.x >> 16) * bf2f(ka.x >> 16);
                    dot += bf2f(qa.y & 0xffff) * bf2f(ka.y & 0xffff) + bf2f(qa.y >> 16) * bf2f(ka.y >> 16);
                    dot += bf2f(qa.z & 0xffff) * bf2f(ka.z & 0xffff) + bf2f(qa.z >> 16) * bf2f(ka.z >> 16);
                    dot += bf2f(qa.w & 0xffff) * bf2f(ka.w & 0xffff) + bf2f(qa.w >> 16) * bf2f(ka.w >> 16);
                }
                r = dot * __expf(bcum[t] - bcum[s] + ig[s] - mt[t]);
            }
            St[t][s] = r;
        }
        __syncthreads();
        if (tid < 64) {
            const bf16_t* qp = q + cb + (size_t)tid * DM;
            float dn = 0.f;
            for (int d = 0; d < DH; ++d) dn += nvec[d] * bf2f(qp[d]);
            float sm = 0.f;
            for (int s = 0; s < 64; ++s) sm += St[tid][s];
            const float den = winter[tid] * dn + sm;
            hden[tid] = fmaxf(fabsf(den), __expf(-mt[tid]));
        }
        __syncthreads();
        for (int idx = tid; idx < 2048; idx += 256) {
            const int t = idx >> 5, vv = idx & 31;
            const bf16_t* qp = q + cb + (size_t)t * DM;
            float a = 0.f;
            for (int d = 0; d < DH; ++d) a += Cs[vv][d] * bf2f(qp[d]);
            float s2 = 0.f;
            for (int s = 0; s < 64; ++s) s2 += St[t][s] * bf2f(v[cb + (size_t)s * DM + vs * 32 + vv]);
            const float num = winter[t] * a + s2;
            hc[cb + (size_t)t * DM + vs * 32 + vv] = f2bf(num / hden[t]);
        }
        __syncthreads();
        const float b_tot = bcum[63];
        if (tid < 64) ws_[tid] = b_tot - bcum[tid] + ig[tid];
        __syncthreads();
        if (tid == 0) {
            float mx = b_tot + m_prev;
            for (int s = 0; s < 64; ++s) mx = fmaxf(mx, ws_[s]);
            sc[1] = __expf(b_tot + m_prev - mx); sc[0] = mx;
        }
        __syncthreads();
        const float m_next = sc[0], decay = sc[1];
        float myw = 0.f;
        if (tid < 64) myw = __expf(ws_[tid] - m_next);
        __syncthreads();
        if (tid < 64) ws_[tid] = myw;
        __syncthreads();
        for (int idx = tid; idx < 32 * 256; idx += 256) {
            const int vv = idx >> 8, d = idx & 255;
            float a = 0.f;
            for (int s = 0; s < 64; ++s) a += ws_[s] * bf2f(v[cb + (size_t)s * DM + vs * 32 + vv]) * bf2f(k[cb + (size_t)s * DM + d]);
            Cs[vv][d] = decay * Cs[vv][d] + a;
        }
        {
            float a = 0.f;
            for (int s = 0; s < 64; ++s) a += ws_[s] * bf2f(k[cb + (size_t)s * DM + tid]);
            nvec[tid] = decay * nvec[tid] + a;
        }
        __syncthreads();
    }
}

DEV void k_mlstm_post(int vb, bf16_t* hc, const bf16_t* mo, const bf16_t* mg, const bf16_t* mi, const float* cw, const float* cb,
                                                    const float* ngain, const float* skip) {
    const int m = vb, t = TIDH;
    float hv[4]; float s = 0.f;
#pragma unroll
    for (int i = 0; i < 4; ++i) {
        const size_t o = (size_t)m * DM + t * 4 + i;
        hv[i] = bf2f(hc[o]) * sigmoidf_(bf2f(mo[o])); s += hv[i];
    }
    const float mu = wave_sum(s) * (1.f / DH);
    float s2 = 0.f;
#pragma unroll
    for (int i = 0; i < 4; ++i) { hv[i] -= mu; s2 += hv[i] * hv[i]; }
    const float rstd = rsqrtf(wave_sum(s2) * (1.f / DH) + EPS);
#pragma unroll
    for (int i = 0; i < 4; ++i) {
        const int n = t * 4 + i; const size_t o = (size_t)m * DM + n;
        const float xc = conv_xc(mi, m, n, cw, cb);
        const float hn = hv[i] * rstd * ngain[n] + skip[n] * xc;
        hc[o] = f2bf(hn * siluf_(bf2f(mg[o])));
    }
}

DEV void k_final(int vb, float* red, float* x, const float* gain) {
    const int m = vb, t = TIDH;
    float4 v = ((float4*)(x + (size_t)m * DM))[t];
    float ss = v.x * v.x + v.y * v.y + v.z * v.z + v.w * v.w;
    ss = block_sum256(ss, red);
    const float rstd = rsqrtf(ss * (1.f / DM) + EPS);
    const float4 g = ((const float4*)gain)[t];
    v.x *= rstd * g.x; v.y *= rstd * g.y; v.z *= rstd * g.z; v.w *= rstd * g.w;
    ((float4*)(x + (size_t)m * DM))[t] = v;
}


#define LAS __attribute__((address_space(3)))
typedef short bf16x8 __attribute__((ext_vector_type(8)));
typedef float f32x4 __attribute__((ext_vector_type(4)));
typedef short s16x4 __attribute__((ext_vector_type(4)));
typedef unsigned u32x4 __attribute__((ext_vector_type(4)));
typedef unsigned u32x2 __attribute__((ext_vector_type(2)));
typedef float f32x2 __attribute__((ext_vector_type(2)));
#define WAIT_V(n) asm volatile("s_waitcnt vmcnt(" #n ")" ::: "memory")
#define WAIT_L(n) asm volatile("s_waitcnt lgkmcnt(" #n ")" ::: "memory")
#define SCHED() __builtin_amdgcn_sched_barrier(0)

DEV int lds_byte(int r, int c) { int st = (r >> 4) * 2 + (c >> 5), ob = (r & 15) * 64 + (c & 31) * 2; return st * 1024 + (ob ^ (((ob >> 9) & 1) << 5)); }
DEV void stage_rc(int b, int& R, int& C) { int st = b >> 10, sb = b & 1023, swz = sb ^ (((sb >> 9) & 1) << 5); R = (st >> 1) * 16 + swz / 64; C = (st & 1) * 32 + (swz % 64) / 2; }
template <class T> DEV T* sel3(int w, T* p0, T* p1, T* p2) { return p0 + ((w >= 1) ? (p1 - p0) : 0) + ((w >= 2) ? (p2 - p1) : 0); }
DEV void unpack8(const uint4 v, float* f) {
    f[0] = bf2f((bf16_t)(v.x & 0xffff)); f[1] = bf2f((bf16_t)(v.x >> 16)); f[2] = bf2f((bf16_t)(v.y & 0xffff)); f[3] = bf2f((bf16_t)(v.y >> 16));
    f[4] = bf2f((bf16_t)(v.z & 0xffff)); f[5] = bf2f((bf16_t)(v.z >> 16)); f[6] = bf2f((bf16_t)(v.w & 0xffff)); f[7] = bf2f((bf16_t)(v.w >> 16));
}
DEV uint4 pack8(const float* f) { return make_uint4(pk2(f[0], f[1]), pk2(f[2], f[3]), pk2(f[4], f[5]), pk2(f[6], f[7])); }
DEV uint2 pack4(f32x4 v) { uint2 r; r.x = pk2(v[0], v[1]); r.y = pk2(v[2], v[3]); return r; }

struct GemmCtx { int wid, lane, wr, wc, fr, fq; int sR[4], sC[4]; };
DEV GemmCtx gemm_ctx() {
    GemmCtx c; const int tid = opaque_tid();
    c.wid = __builtin_amdgcn_readfirstlane(tid >> 6); c.lane = tid & 63; c.wr = c.wid >> 2; c.wc = c.wid & 3; c.fr = c.lane & 15; c.fq = c.lane >> 4;
#pragma unroll
    for (int i = 0; i < 4; ++i) stage_rc(c.wid * 1024 + i * 8192 + c.lane * 16, c.sR[i], c.sC[i]);
    return c;
}
DEV void gemm_mainloop(LAS char* shm, const GemmCtx& c, const bf16_t* A1row, const bf16_t* A2row, int ktsplit, int lda, const bf16_t* Bb, int ldb, int nt, f32x4 (&acc)[8][4]) {
    constexpr int TILE_B = 256 * 64 * 2, STAGE_B = 2 * TILE_B;
    const int wid = c.wid, wr = c.wr, wc = c.wc, fr = c.fr, fq = c.fq;
    unsigned voA[4], voB[4];
#pragma unroll
    for (int i = 0; i < 4; ++i) { voA[i] = (unsigned)(c.sR[i] * lda + c.sC[i]) * 2u; voB[i] = (unsigned)(c.sR[i] * ldb + c.sC[i]) * 2u; asm volatile("" : "+v"(voA[i]), "+v"(voB[i])); }
#define GLDS_STAGE(buf, kt) do { const char* Ak_ = (const char*)(((kt) < ktsplit) ? (A1row + (kt) * 64) : (A2row + ((kt) - ktsplit) * 64)); const char* Bk_ = (const char*)(Bb + (kt) * 64); \
        _Pragma("unroll") for (int i = 0; i < 4; ++i) { \
            __builtin_amdgcn_global_load_lds((const unsigned*)(Ak_ + voA[i]), (LAS unsigned*)(shm + (buf) * STAGE_B + wid * 1024 + i * 8192), 16, 0, 0); \
            __builtin_amdgcn_global_load_lds((const unsigned*)(Bk_ + voB[i]), (LAS unsigned*)(shm + (buf) * STAGE_B + TILE_B + wid * 1024 + i * 8192), 16, 0, 0); } } while (0)
#pragma unroll
    for (int m = 0; m < 8; ++m)
#pragma unroll
        for (int n = 0; n < 4; ++n) acc[m][n] = (f32x4){0.f, 0.f, 0.f, 0.f};
    GLDS_STAGE(0, 0); WAIT_V(0); __syncthreads();
#pragma nounroll
    for (int kt = 0; kt < nt; ++kt) {
        const int cur = kt & 1;
        if (kt + 1 < nt) GLDS_STAGE(cur ^ 1, kt + 1);
#pragma unroll
        for (int ks = 0; ks < 2; ++ks) {
            bf16x8 At[8], Bf[4];
#pragma unroll
            for (int m = 0; m < 8; ++m) At[m] = *(const LAS bf16x8*)(shm + cur * STAGE_B + lds_byte(wr * 128 + m * 16 + fr, ks * 32 + fq * 8));
#pragma unroll
            for (int n = 0; n < 4; ++n) Bf[n] = *(const LAS bf16x8*)(shm + cur * STAGE_B + TILE_B + lds_byte(wc * 64 + n * 16 + fr, ks * 32 + fq * 8));
#pragma unroll
            for (int m = 0; m < 8; ++m)
#pragma unroll
                for (int n = 0; n < 4; ++n) acc[m][n] = __builtin_amdgcn_mfma_f32_16x16x32_bf16(Bf[n], At[m], acc[m][n], 0, 0, 0);
            SCHED();
        }
        WAIT_V(0); __syncthreads();
    }
#undef GLDS_STAGE
}
DEV void tile_map(int t, int nN, int& pm, int& pn) {
    const int base = t & ~255, loc = t & 255;
    const int w = base + (loc & 7) * 32 + (loc >> 3);
    const int nig = 8 * nN, gid = w / nig;
    pm = gid * 8 + (w % nig) % 8; pn = (w % nig) / 8;
}
template <class Prob>
DEV void gemm_phase(LAS char* shm, const Prob& pb) {
    const GemmCtx c = gemm_ctx();
    const int nN = pb.nN, ntiles = 64 * nN;
    for (int t = blockIdx.x; t < ntiles; t += gridDim.x) {
        int pm, pn; tile_map(t, nN, pm, pn);
        const int brow = pm * 256, bcol = pn * 256;
        f32x4 acc[8][4];
        gemm_mainloop(shm, c, pb.a1(pn) + (long)brow * Prob::lda, pb.a2(pn) + (long)brow * Prob::lda, Prob::ktsplit, Prob::lda, pb.bptr(pn), Prob::ldb, Prob::K / 64, acc);
        pb.epi_begin(shm, c, pn, brow);
#pragma unroll
        for (int m = 0; m < 8; ++m)
#pragma unroll
            for (int n = 0; n < 4; ++n) pb.epi(pn, brow + c.wr * 128 + m * 16 + c.fr, bcol + c.wc * 64 + n * 16 + c.fq * 4, acc[m][n]);
        pb.epi_end(c, pn, brow, acc);
    }
}

struct ProbG1 {
    static constexpr int K = 1024, lda = 1024, ldb = 1024, ktsplit = 1 << 20;
    const bf16_t* H; const bf16_t* Wt; bf16_t* U; bf16_t* MI; int nN;
    DEV const bf16_t* a1(int pn) const { return H; }
    DEV const bf16_t* a2(int pn) const { return H; }
    DEV const bf16_t* bptr(int pn) const { return Wt + (long)((pn < 4) ? pn * 256 : 2048 + (pn - 4) * 256) * 1024; }
    DEV void epi_begin(LAS char*, const GemmCtx&, int, int) const {}
    DEV void epi(int pn, int row, int col, f32x4 v) const { bf16_t* C = (pn < 4) ? U : MI; *(uint2*)(C + (size_t)row * DM + (col & 1023)) = pack4(v); }
    DEV void epi_end(const GemmCtx&, int, int, f32x4 (&)[8][4]) const {}
};
struct ProbGlu {
    static constexpr int K = 1024, lda = 1024, ldb = 1024, ktsplit = 1 << 20;
    const bf16_t* Y; const bf16_t* Wt; bf16_t* Z; const float* bias; float* rowss; int nN;
    DEV const bf16_t* a1(int pn) const { return Y; }
    DEV const bf16_t* a2(int pn) const { return Y; }
    DEV const bf16_t* bptr(int pn) const { return Wt + (long)pn * 256 * 1024; }
    DEV void epi_begin(LAS char*, const GemmCtx&, int, int) const {}
    DEV void epi(int pn, int row, int col, f32x4 v) const {}
    DEV void epi_end(const GemmCtx& c0, int pn, int brow, f32x4 (&acc)[8][4]) const {
        struct { int fr, fq, wr, wc; } c = {c0.fr, c0.fq, c0.wr, c0.wc};
        asm volatile("" : "+v"(c.fr), "+v"(c.fq));
#pragma unroll
        for (int m = 0; m < 8; ++m) {
            SCHED();
            const int row = brow + c.wr * 128 + m * 16 + c.fr;
            float ss = 0.f;
#pragma unroll
            for (int n = 0; n < 4; ++n) {
                const int col = pn * 256 + c.wc * 64 + n * 16 + c.fq * 4;
                const uint2 yv = *(const uint2*)(Y + (size_t)row * DM + col);
                const float4 b = *(const float4*)(bias + col);
                f32x4 o;
                o[0] = bf2f(yv.x & 0xffff) * sigmoidf_(acc[m][n][0] + b.x); o[1] = bf2f(yv.x >> 16) * sigmoidf_(acc[m][n][1] + b.y);
                o[2] = bf2f(yv.y & 0xffff) * sigmoidf_(acc[m][n][2] + b.z); o[3] = bf2f(yv.y >> 16) * sigmoidf_(acc[m][n][3] + b.w);
                const uint2 pk = pack4(o);
                *(uint2*)(Z + (size_t)row * DM + col) = pk;
                const float r0 = bf2f(pk.x & 0xffff), r1 = bf2f(pk.x >> 16), r2 = bf2f(pk.y & 0xffff), r3 = bf2f(pk.y >> 16);
                ss += r0 * r0 + r1 * r1 + r2 * r2 + r3 * r3;
            }
            ss += __shfl_xor(ss, 16); ss += __shfl_xor(ss, 32);
            if (c.fq == 0) rowss[(size_t)(pn * 4 + c.wc) * MTOK + row] = ss;
        }
    }
};
struct ProbQkv {
    static constexpr int K = 256, lda = 1024, ldb = 256, ktsplit = 1 << 20;
    const bf16_t* XC; const bf16_t* MI; const bf16_t* Wt; bf16_t* Q; bf16_t* Kk; bf16_t* V; int nN;
    DEV const bf16_t* a1(int pn) const { return ((pn >> 2) == 2 ? MI : XC) + (pn & 3) * 256; }
    DEV const bf16_t* a2(int pn) const { return a1(pn); }
    DEV const bf16_t* bptr(int pn) const { return Wt + (long)pn * 256 * 256; }
    DEV void epi_begin(LAS char*, const GemmCtx&, int, int) const {}
    DEV void epi(int pn, int row, int col, f32x4 v) const {
        const int which = pn >> 2; bf16_t* C = sel3(which, Q, Kk, V);
        if (which == 1) { v[0] *= 0.0625f; v[1] *= 0.0625f; v[2] *= 0.0625f; v[3] *= 0.0625f; }
        *(uint2*)(C + (size_t)row * DM + (col & 1023)) = pack4(v);
    }
    DEV void epi_end(const GemmCtx&, int, int, f32x4 (&)[8][4]) const {}
};
struct ProbOut {
    static constexpr int K = 2048, lda = 1024, ldb = 2048, ktsplit = 16;
    const bf16_t* A1; const bf16_t* A2; const bf16_t* Wt; const float* xin; float* xout; const float* gate; int nN;
    DEV const bf16_t* a1(int pn) const { return A1; }
    DEV const bf16_t* a2(int pn) const { return A2; }
    DEV const bf16_t* bptr(int pn) const { return Wt + (long)pn * 256 * 2048; }
    DEV void epi_begin(LAS char*, const GemmCtx&, int, int) const {}
    DEV void epi(int pn, int row, int col, f32x4 v) const {
        const int b = row / SEQ;
        const float4 xi = *(const float4*)(xin + (size_t)row * DM + col);
        const float4 g = *(const float4*)(gate + (size_t)b * 3 * DM + col);
        float4 o; o.x = xi.x + g.x * v[0]; o.y = xi.y + g.y * v[1]; o.z = xi.z + g.z * v[2]; o.w = xi.w + g.w * v[3];
        *(float4*)(xout + (size_t)row * DM + col) = o;
    }
    DEV void epi_end(const GemmCtx&, int, int, f32x4 (&)[8][4]) const {}
};

struct G2Args {
    const bf16_t* H; const bf16_t* Wt;
    bf16_t* Z; const float* rowss; const float* og;
    bf16_t* HC; const bf16_t* XC; const float* ngain; const float* skip;
};
DEV void gemm2_phase(LAS char* shm, const G2Args& g) {
    const GemmCtx c = gemm_ctx();
    int efr, efq;
    LAS float* rst = (LAS float*)(shm + 131072);
    LAS float* red = (LAS float*)(shm + 131072 + 1024);
    for (int u = blockIdx.x; u < 512; u += gridDim.x) {
        f32x4 acc[8][4];
        if (u < 256) {
            int pm, pn; tile_map(u, 4, pm, pn);
            const int brow = pm * 256, bcol = pn * 256;
            gemm_mainloop(shm, c, g.H + (long)brow * DM, g.H, 1 << 20, DM, g.Wt + (long)(1024 + bcol) * DM, DM, 16, acc);
            efr = c.fr; efq = c.fq; asm volatile("" : "+v"(efr), "+v"(efq));
            { const int tid = c.wid * 64 + c.lane;
              if (tid < 256) { float s_ = 0.f;
#pragma unroll
                  for (int p_ = 0; p_ < 16; ++p_) s_ += g.rowss[(size_t)p_ * MTOK + brow + tid];
                  rst[tid] = rsqrtf(s_ * (1.f / DM) + EPS); } }
            __syncthreads();
#pragma unroll
            for (int m = 0; m < 8; ++m) {
                SCHED();
                const int rl = c.wr * 128 + m * 16 + efr, row = brow + rl;
                const float rs = rst[rl];
#pragma unroll
                for (int n = 0; n < 4; ++n) {
                    const int col = bcol + c.wc * 64 + n * 16 + efq * 4;
                    const uint2 zv = *(const uint2*)(g.Z + (size_t)row * DM + col);
                    const float4 gn = *(const float4*)(g.og + col);
                    f32x4 o;
                    o[0] = bf2f(zv.x & 0xffff) * rs * gn.x * siluf_(acc[m][n][0]); o[1] = bf2f(zv.x >> 16) * rs * gn.y * siluf_(acc[m][n][1]);
                    o[2] = bf2f(zv.y & 0xffff) * rs * gn.z * siluf_(acc[m][n][2]); o[3] = bf2f(zv.y >> 16) * rs * gn.w * siluf_(acc[m][n][3]);
                    *(uint2*)(g.Z + (size_t)row * DM + col) = pack4(o);
                }
            }
            __syncthreads();
        } else {
            int pm, hd; tile_map(u - 256, 4, pm, hd);
            const int brow = pm * 256, bcol = hd * 256;
            gemm_mainloop(shm, c, g.H + (long)brow * DM, g.H, 1 << 20, DM, g.Wt + (long)(3072 + bcol) * DM, DM, 16, acc);
            efr = c.fr; efq = c.fq; asm volatile("" : "+v"(efr), "+v"(efq));
        #pragma unroll
            for (int m = 0; m < 8; ++m) {
                SCHED();
                const int row = brow + c.wr * 128 + m * 16 + efr;
                float s_ = 0.f;
#pragma unroll
                for (int n = 0; n < 4; ++n) {
                    const int col = bcol + c.wc * 64 + n * 16 + efq * 4;
                    const uint2 hv = *(const uint2*)(g.HC + (size_t)row * DM + col);
                    acc[m][n][0] = bf2f(hv.x & 0xffff) * sigmoidf_(acc[m][n][0]); acc[m][n][1] = bf2f(hv.x >> 16) * sigmoidf_(acc[m][n][1]);
                    acc[m][n][2] = bf2f(hv.y & 0xffff) * sigmoidf_(acc[m][n][2]); acc[m][n][3] = bf2f(hv.y >> 16) * sigmoidf_(acc[m][n][3]);
                    s_ += (acc[m][n][0] + acc[m][n][1]) + (acc[m][n][2] + acc[m][n][3]);
                }
                s_ += __shfl_xor(s_, 16); s_ += __shfl_xor(s_, 32);
                if (efq == 0) red[c.wid * 128 + m * 16 + efr] = s_;
            }
            __syncthreads();
#pragma unroll
            for (int m = 0; m < 8; ++m) {
                SCHED();
                float tot = 0.f;
#pragma unroll
                for (int w2 = 0; w2 < 4; ++w2) tot += red[(c.wr * 4 + w2) * 128 + m * 16 + efr];
                const float mu = tot * (1.f / DH);
                float s_ = 0.f;
#pragma unroll
                for (int n = 0; n < 4; ++n)
#pragma unroll
                    for (int j = 0; j < 4; ++j) { acc[m][n][j] -= mu; s_ += acc[m][n][j] * acc[m][n][j]; }
                s_ += __shfl_xor(s_, 16); s_ += __shfl_xor(s_, 32);
                if (efq == 0) red[1024 + c.wid * 128 + m * 16 + efr] = s_;
            }
            __syncthreads();
#pragma unroll
            for (int m = 0; m < 8; ++m) {
                SCHED();
                const int row = brow + c.wr * 128 + m * 16 + efr;
                float tot = 0.f;
#pragma unroll
                for (int w2 = 0; w2 < 4; ++w2) tot += red[1024 + (c.wr * 4 + w2) * 128 + m * 16 + efr];
                const float rs = rsqrtf(tot * (1.f / DH) + EPS);
#pragma unroll
                for (int n = 0; n < 4; ++n) {
                    const int col = bcol + c.wc * 64 + n * 16 + efq * 4;
                    const uint2 xv = *(const uint2*)(g.XC + (size_t)row * DM + col);
                    const float4 gn = *(const float4*)(g.ngain + col), sk = *(const float4*)(g.skip + col);
                    f32x4 o;
                    o[0] = acc[m][n][0] * rs * gn.x + sk.x * bf2f(xv.x & 0xffff); o[1] = acc[m][n][1] * rs * gn.y + sk.y * bf2f(xv.x >> 16);
                    o[2] = acc[m][n][2] * rs * gn.z + sk.z * bf2f(xv.y & 0xffff); o[3] = acc[m][n][3] * rs * gn.w + sk.w * bf2f(xv.y >> 16);
                    *(uint2*)(g.HC + (size_t)row * DM + col) = pack4(o);
                }
            }
            gemm_mainloop(shm, c, g.H + (long)brow * DM, g.H, 1 << 20, DM, g.Wt + (long)(4096 + bcol) * DM, DM, 16, acc);
            efr = c.fr; efq = c.fq; asm volatile("" : "+v"(efr), "+v"(efq));
#pragma unroll
            for (int m = 0; m < 8; ++m) {
                SCHED();
                const int row = brow + c.wr * 128 + m * 16 + efr;
#pragma unroll
                for (int n = 0; n < 4; ++n) {
                    const int col = bcol + c.wc * 64 + n * 16 + efq * 4;
                    const uint2 hv = *(const uint2*)(g.HC + (size_t)row * DM + col);
                    f32x4 o;
                    o[0] = bf2f(hv.x & 0xffff) * siluf_(acc[m][n][0]); o[1] = bf2f(hv.x >> 16) * siluf_(acc[m][n][1]);
                    o[2] = bf2f(hv.y & 0xffff) * siluf_(acc[m][n][2]); o[3] = bf2f(hv.y >> 16) * siluf_(acc[m][n][3]);
                    *(uint2*)(g.HC + (size_t)row * DM + col) = pack4(o);
                }
            }
        }
    }
}


namespace g8 {
constexpr int BK = 64, HALFT = 128, HTB = HALFT * BK * 2;
DEV int perm32(int rho) { const int n = rho >> 4, i = rho & 15; return 8 * (i >> 2) + 4 * n + (i & 3); }
struct Unit { const char* A; const char* B; int pm, pn, tag; };
template <class Epi, class Sched>
DEV void gemm_phase(LAS char* lds, const Sched& S, const Epi& E) {
    const int tid = opaque_tid(), wid = __builtin_amdgcn_readfirstlane(tid >> 6), lane = tid & 63, wr = wid >> 2, wc = wid & 3, fr = lane & 15, fq = lane >> 4;
    constexpr int lda = Sched::lda, ldb = Sched::ldb, nt = Sched::K / BK;
    unsigned voffA[2], voffB[2];
#pragma unroll
    for (int i = 0; i < 2; ++i) { int R, C; stage_rc(tid * 16 + i * 8192, R, C); const int Rb = (R & ~31) + perm32(R & 31);
        voffA[i] = (unsigned)(R * lda + C) * 2u; voffB[i] = (unsigned)(Rb * ldb + C) * 2u; asm volatile("" : "+v"(voffA[i]), "+v"(voffB[i])); }
    constexpr size_t kstep = (size_t)(BK * 2), hstepA = (size_t)HALFT * lda * 2, hstepB = (size_t)HALFT * ldb * 2;
    const unsigned ldsw = (unsigned)wid * 1024u;
    const int aoff = lds_byte(wr * 64 + fr, fq * 8), boff = lds_byte(wc * 32 + fr, fq * 8);
#define G8_SA(b, h) (((b) * 2 + (h)) * HTB)
#define G8_SB(b, h) ((4 + (b) * 2 + (h)) * HTB)
#define G8_STAGE(bufoff, gbase, voff) do { _Pragma("unroll") for (int _i = 0; _i < 2; ++_i) \
        __builtin_amdgcn_global_load_lds((const unsigned*)((const char*)(gbase) + (voff)[_i]), (LAS unsigned*)(lds + (bufoff) + ldsw + _i * 8192), 16, 0, 0); } while (0)
#define G8_LDA(dst, b, h) do { _Pragma("unroll") for (int m = 0; m < 4; ++m) _Pragma("unroll") for (int k = 0; k < 2; ++k) dst[m][k] = *(const LAS bf16x8*)(lds + G8_SA(b, h) + aoff + m * 2048 + k * 1024); } while (0)
#define G8_LDB(dst, b, h) do { _Pragma("unroll") for (int n = 0; n < 2; ++n) _Pragma("unroll") for (int k = 0; k < 2; ++k) dst[n][k] = *(const LAS bf16x8*)(lds + G8_SB(b, h) + boff + n * 2048 + k * 1024); } while (0)
#define G8_MMA(ai, bj, At, Bt) do { __builtin_amdgcn_s_setprio(1); _Pragma("unroll") for (int m = 0; m < 4; ++m) _Pragma("unroll") for (int n = 0; n < 2; ++n) _Pragma("unroll") for (int k = 0; k < 2; ++k) \
        acc[ai][bj][m][n] = __builtin_amdgcn_mfma_f32_16x16x32_bf16(Bt[n][k], At[m][k], acc[ai][bj][m][n], 0, 0, 0); __builtin_amdgcn_s_setprio(0); } while (0)
#define G8_WAIT_V(n) asm volatile("s_waitcnt vmcnt(" #n ")" ::: "memory")
#define G8_WAIT_L(n) asm volatile("s_waitcnt lgkmcnt(" #n ")" ::: "memory")
#define G8_BAR __builtin_amdgcn_s_barrier()
#define G8_SCHED __builtin_amdgcn_sched_barrier(0)
    Unit cur, nxt; int ui = 0;
    if (!S.next(0, cur)) return;
    f32x4 acc[2][2][4][2];
#pragma unroll
    for (int a = 0; a < 2; ++a)
#pragma unroll
        for (int b = 0; b < 2; ++b)
#pragma unroll
            for (int m = 0; m < 4; ++m)
#pragma unroll
                for (int n = 0; n < 2; ++n) acc[a][b][m][n] = (f32x4){0.f, 0.f, 0.f, 0.f};
    bf16x8 At[4][2], B0[2][2], B1[2][2];
    const char* cA = cur.A; const char* cB = cur.B;
    G8_STAGE(G8_SB(0, 0), cB, voffB); G8_STAGE(G8_SB(0, 1), cB + hstepB, voffB); G8_STAGE(G8_SA(0, 0), cA, voffA); G8_STAGE(G8_SA(0, 1), cA + hstepA, voffA);
    if (wr == 1) G8_BAR;
    G8_WAIT_V(2); G8_BAR;
    G8_STAGE(G8_SB(1, 0), cB + kstep, voffB); G8_STAGE(G8_SA(1, 0), cA + kstep, voffA); G8_STAGE(G8_SB(1, 1), cB + hstepB + kstep, voffB);
    G8_WAIT_V(6); G8_BAR;
    for (;;) {
        const bool has_next = S.next(ui + 1, nxt);
        const char* nA = has_next ? nxt.A : cA; const char* nB = has_next ? nxt.B : cB;
#pragma nounroll
        for (int t = 0; t < nt; t += 2) {
            const bool last = (t == nt - 2);
            const char* a1 = cA + (size_t)(t + 1) * kstep;
            const char* a2 = last ? nA : cA + (size_t)(t + 2) * kstep; const char* b2 = last ? nB : cB + (size_t)(t + 2) * kstep;
            const char* a3 = a2 + kstep; const char* b3 = b2 + kstep;
            G8_LDB(B0, 0, 0); G8_LDB(B1, 0, 1); G8_SCHED; G8_LDA(At, 0, 0); G8_STAGE(G8_SA(1, 1), a1 + hstepA, voffA);
            G8_WAIT_V(8); G8_WAIT_L(0); G8_BAR; G8_MMA(0, 0, At, B0); G8_MMA(0, 1, At, B1); G8_BAR; G8_SCHED;
            G8_LDA(At, 0, 1); G8_STAGE(G8_SB(0, 0), b2, voffB); G8_STAGE(G8_SB(0, 1), b2 + hstepB, voffB); G8_STAGE(G8_SA(0, 0), a2, voffA);
            G8_WAIT_V(8); G8_WAIT_L(0); G8_BAR; G8_MMA(1, 0, At, B0); G8_MMA(1, 1, At, B1); G8_BAR; G8_SCHED;
            G8_LDB(B0, 1, 0); G8_LDB(B1, 1, 1); G8_SCHED; G8_LDA(At, 1, 0); G8_STAGE(G8_SA(0, 1), a2 + hstepA, voffA);
            G8_WAIT_V(8); G8_WAIT_L(0); G8_BAR; G8_MMA(0, 0, At, B0); G8_MMA(0, 1, At, B1); G8_BAR; G8_SCHED;
            G8_LDA(At, 1, 1); G8_STAGE(G8_SB(1, 0), b3, voffB); G8_STAGE(G8_SB(1, 1), b3 + hstepB, voffB); G8_STAGE(G8_SA(1, 0), a3, voffA);
            G8_WAIT_V(8); G8_WAIT_L(0); G8_BAR; G8_MMA(1, 0, At, B0); G8_MMA(1, 1, At, B1); G8_BAR; G8_SCHED;
        }
        if (wr == 0) G8_BAR;
        E(lds, acc, cur, wr, wc, fr, fq, wid, lane);
        if (!has_next) break;
#pragma unroll
        for (int a = 0; a < 2; ++a)
#pragma unroll
            for (int b = 0; b < 2; ++b)
#pragma unroll
                for (int m = 0; m < 4; ++m)
#pragma unroll
                    for (int n = 0; n < 2; ++n) acc[a][b][m][n] = (f32x4){0.f, 0.f, 0.f, 0.f};
        cur = nxt; cA = nA; cB = nB; ++ui;
        if (wr == 1) G8_BAR;
    }
    G8_WAIT_V(0);
    G8_BAR;
#undef G8_SA
#undef G8_SB
#undef G8_STAGE
#undef G8_LDA
#undef G8_LDB
#undef G8_MMA
#undef G8_WAIT_V
#undef G8_WAIT_L
#undef G8_BAR
#undef G8_SCHED
}
DEV u32x4 pk8(const f32x4 a, const f32x4 b) { return (u32x4){pk2(a[0], a[1]), pk2(a[2], a[3]), pk2(b[0], b[1]), pk2(b[2], b[3])}; }
DEV void un8(const u32x4 v, float* f) { unpack8(make_uint4(v[0], v[1], v[2], v[3]), f); }
#define G8_ROWS_BEGIN _Pragma("unroll") for (int ai = 0; ai < 2; ++ai) _Pragma("unroll") for (int m = 0; m < 4; ++m) { const int rl = 128 * ai + 64 * wr + 16 * m + fr;
#define G8_ROWS_END }

struct SchedG1 { static constexpr int K = 1024, lda = 1024, ldb = 1024; const bf16_t* H; const bf16_t* Wt; int bid, G;
    DEV bool next(int i, Unit& u) const { const int t = bid + i * G; if (t >= 512) return false; int pm, pn; tile_map(t, 8, pm, pn);
        u.pm = pm; u.pn = pn; u.tag = 0; u.A = (const char*)(H + (size_t)pm * 256 * DM); u.B = (const char*)(Wt + (size_t)((pn < 4) ? pn * 256 : 2048 + (pn - 4) * 256) * DM); return true; } };
struct EpiG1 { bf16_t* U; bf16_t* MI;
    DEV void operator()(LAS char*, const f32x4 (&acc)[2][2][4][2], const Unit& u, int wr, int wc, int fr, int fq, int, int) const {
        bf16_t* C = (u.pn < 4) ? U : MI; const int c0 = (u.pn & 3) * 256 + 32 * wc + 8 * fq;
        G8_ROWS_BEGIN bf16_t* rp = C + (size_t)(u.pm * 256 + rl) * DM + c0;
#pragma unroll
            for (int bj = 0; bj < 2; ++bj) *(u32x4*)(rp + 128 * bj) = pk8(acc[ai][bj][m][0], acc[ai][bj][m][1]); G8_ROWS_END } };
struct SchedGlu { static constexpr int K = 1024, lda = 1024, ldb = 1024; const bf16_t* Y; const bf16_t* Wt; int bid, G;
    DEV bool next(int i, Unit& u) const { const int t = bid + i * G; if (t >= 256) return false; int pm, pn; tile_map(t, 4, pm, pn);
        u.pm = pm; u.pn = pn; u.tag = 0; u.A = (const char*)(Y + (size_t)pm * 256 * DM); u.B = (const char*)(Wt + (size_t)pn * 256 * DM); return true; } };
struct EpiGlu { const bf16_t* Y; bf16_t* Z; const float* bias; float* rowss;
    DEV void operator()(LAS char*, const f32x4 (&acc)[2][2][4][2], const Unit& u, int wr, int wc, int fr, int fq, int, int) const {
        const int c0 = u.pn * 256 + 32 * wc + 8 * fq;
        G8_ROWS_BEGIN const size_t ro = (size_t)(u.pm * 256 + rl) * DM + c0; float ss = 0.f;
#pragma unroll
            for (int bj = 0; bj < 2; ++bj) {
                float y8[8]; un8(*(const u32x4*)(Y + ro + 128 * bj), y8);
                const float4 b0 = *(const float4*)(bias + c0 + 128 * bj), b1 = *(const float4*)(bias + c0 + 128 * bj + 4);
                f32x4 o0, o1;
                o0[0] = y8[0] * sigmoidf_(acc[ai][bj][m][0][0] + b0.x); o0[1] = y8[1] * sigmoidf_(acc[ai][bj][m][0][1] + b0.y); o0[2] = y8[2] * sigmoidf_(acc[ai][bj][m][0][2] + b0.z); o0[3] = y8[3] * sigmoidf_(acc[ai][bj][m][0][3] + b0.w);
                o1[0] = y8[4] * sigmoidf_(acc[ai][bj][m][1][0] + b1.x); o1[1] = y8[5] * sigmoidf_(acc[ai][bj][m][1][1] + b1.y); o1[2] = y8[6] * sigmoidf_(acc[ai][bj][m][1][2] + b1.z); o1[3] = y8[7] * sigmoidf_(acc[ai][bj][m][1][3] + b1.w);
                const u32x4 pk = pk8(o0, o1); *(u32x4*)(Z + ro + 128 * bj) = pk;
                float r8[8]; un8(pk, r8);
#pragma unroll
                for (int e = 0; e < 8; ++e) ss += r8[e] * r8[e];
            }
            ss += __shfl_xor(ss, 16); ss += __shfl_xor(ss, 32);
            if (fq == 0) rowss[(size_t)(u.pn * 4 + wc) * MTOK + u.pm * 256 + rl] = ss; G8_ROWS_END } };
struct SchedQkv { static constexpr int K = 256, lda = 1024, ldb = 256; const bf16_t* XC; const bf16_t* MI; const bf16_t* Wt; int bid, G;
    DEV bool next(int i, Unit& u) const { const int t = bid + i * G; if (t >= 768) return false; int pm, pn; tile_map(t, 12, pm, pn);
        u.pm = pm; u.pn = pn; u.tag = 0; u.A = (const char*)(((pn >> 2) == 2 ? MI : XC) + (size_t)pm * 256 * DM + (pn & 3) * 256); u.B = (const char*)(Wt + (size_t)pn * 256 * 256); return true; } };
struct EpiQkv { bf16_t* Q; bf16_t* Kk; bf16_t* V;
    DEV void operator()(LAS char*, const f32x4 (&acc)[2][2][4][2], const Unit& u, int wr, int wc, int fr, int fq, int, int) const {
        const int which = u.pn >> 2; bf16_t* C = sel3(which, Q, Kk, V); const float sc = (which == 1) ? 0.0625f : 1.f;
        const int c0 = (u.pn & 3) * 256 + 32 * wc + 8 * fq;
        G8_ROWS_BEGIN bf16_t* rp = C + (size_t)(u.pm * 256 + rl) * DM + c0;
#pragma unroll
            for (int bj = 0; bj < 2; ++bj) *(u32x4*)(rp + 128 * bj) = pk8(acc[ai][bj][m][0] * sc, acc[ai][bj][m][1] * sc); G8_ROWS_END } };
struct SchedOut { static constexpr int K = 2048, lda = 2048, ldb = 2048; const bf16_t* MX; const bf16_t* Wt; int bid, G;
    DEV bool next(int i, Unit& u) const { const int t = bid + i * G; if (t >= 256) return false; int pm, pn; tile_map(t, 4, pm, pn);
        u.pm = pm; u.pn = pn; u.tag = 0; u.A = (const char*)(MX + (size_t)pm * 256 * 2048); u.B = (const char*)(Wt + (size_t)pn * 256 * 2048); return true; } };
struct EpiOut { const float* xin; float* xout; const float* gate;
    DEV void operator()(LAS char*, const f32x4 (&acc)[2][2][4][2], const Unit& u, int wr, int wc, int fr, int fq, int, int) const {
        const int c0 = u.pn * 256 + 32 * wc + 8 * fq; const float* gp = gate + (size_t)((u.pm * 256) / SEQ) * 3 * DM + c0;
        G8_ROWS_BEGIN const size_t ro = (size_t)(u.pm * 256 + rl) * DM + c0;
#pragma unroll
            for (int bj = 0; bj < 2; ++bj)
#pragma unroll
                for (int n = 0; n < 2; ++n) {
                    const float4 xi = *(const float4*)(xin + ro + 128 * bj + 4 * n), g4 = *(const float4*)(gp + 128 * bj + 4 * n);
                    float4 o; o.x = xi.x + g4.x * acc[ai][bj][m][n][0]; o.y = xi.y + g4.y * acc[ai][bj][m][n][1]; o.z = xi.z + g4.z * acc[ai][bj][m][n][2]; o.w = xi.w + g4.w * acc[ai][bj][m][n][3];
                    *(float4*)(xout + ro + 128 * bj + 4 * n) = o; } G8_ROWS_END } };
struct SchedG2s { static constexpr int K = 1024, lda = 1024, ldb = 1024; const bf16_t* H; const bf16_t* Wt; int bid;
    DEV bool next(int i, Unit& u) const { if (i >= 1) return false; int pm, pn; tile_map(bid, 4, pm, pn);
        u.pm = pm; u.pn = pn; u.tag = 0; u.A = (const char*)(H + (size_t)pm * 256 * DM); u.B = (const char*)(Wt + (size_t)(1024 + pn * 256) * DM); return true; } };
struct SchedG2m { static constexpr int K = 1024, lda = 1024, ldb = 1024; const bf16_t* H; const bf16_t* Wt; int bid;
    DEV bool next(int i, Unit& u) const { if (i >= 2) return false; int pm, pn; tile_map(bid, 4, pm, pn);
        u.pm = pm; u.pn = pn; u.tag = i + 1; u.A = (const char*)(H + (size_t)pm * 256 * DM); u.B = (const char*)(Wt + (size_t)((i == 0 ? 3072 : 4096) + pn * 256) * DM); return true; } };
struct EpiG2s { const bf16_t* Z; const float* rstd; const float* og; bf16_t* MX;
    DEV void operator()(LAS char* lds, f32x4 (&acc)[2][2][4][2], const Unit& u, int wr, int wc, int fr, int fq, int wid, int lane) const {
        asm volatile("" : "+v"(fr), "+v"(fq));
        const int c0 = u.pn * 256 + 32 * wc + 8 * fq;
        {
            G8_ROWS_BEGIN const int row = u.pm * 256 + rl; const float rs = rstd[row];
#pragma unroll
                for (int bj = 0; bj < 2; ++bj) {
                    float z8[8]; un8(*(const u32x4*)(Z + (size_t)row * DM + c0 + 128 * bj), z8);
                    const float4 g0 = *(const float4*)(og + c0 + 128 * bj), g1 = *(const float4*)(og + c0 + 128 * bj + 4);
                    f32x4 o0, o1;
                    o0[0] = z8[0] * rs * g0.x * siluf_(acc[ai][bj][m][0][0]); o0[1] = z8[1] * rs * g0.y * siluf_(acc[ai][bj][m][0][1]); o0[2] = z8[2] * rs * g0.z * siluf_(acc[ai][bj][m][0][2]); o0[3] = z8[3] * rs * g0.w * siluf_(acc[ai][bj][m][0][3]);
                    o1[0] = z8[4] * rs * g1.x * siluf_(acc[ai][bj][m][1][0]); o1[1] = z8[5] * rs * g1.y * siluf_(acc[ai][bj][m][1][1]); o1[2] = z8[6] * rs * g1.z * siluf_(acc[ai][bj][m][1][2]); o1[3] = z8[7] * rs * g1.w * siluf_(acc[ai][bj][m][1][3]);
                    *(u32x4*)(MX + (size_t)row * 2048 + c0 + 128 * bj) = pk8(o0, o1); } G8_ROWS_END
        }
    } };
struct EpiG2m { const bf16_t* HC; const bf16_t* XC; const float* ngain; const float* skip; bf16_t* MX;
    DEV void operator()(LAS char* lds, f32x4 (&acc)[2][2][4][2], const Unit& u, int wr, int wc, int fr, int fq, int wid, int lane) const {
        asm volatile("" : "+v"(fr), "+v"(fq));
        const int c0 = u.pn * 256 + 32 * wc + 8 * fq;
        if (u.tag == 1) {
            LAS float* red = (LAS float*)(lds + 131072);
            G8_ROWS_BEGIN const int row = u.pm * 256 + rl; float s1 = 0.f, s2 = 0.f;
#pragma unroll
                for (int bj = 0; bj < 2; ++bj) {
                    float h8[8]; un8(*(const u32x4*)(HC + (size_t)row * DM + c0 + 128 * bj), h8);
#pragma unroll
                    for (int n = 0; n < 2; ++n)
#pragma unroll
                        for (int j = 0; j < 4; ++j) { const float v = h8[4 * n + j] * sigmoidf_(acc[ai][bj][m][n][j]); acc[ai][bj][m][n][j] = v; s1 += v; s2 += v * v; }
                }
                s1 += __shfl_xor(s1, 16); s1 += __shfl_xor(s1, 32); s2 += __shfl_xor(s2, 16); s2 += __shfl_xor(s2, 32);
                if (fq == 0) *(LAS f32x2*)(red + ((wid * 128) + 64 * ai + 16 * m + fr) * 2) = (f32x2){s1, s2}; G8_ROWS_END
            asm volatile("s_waitcnt lgkmcnt(0)" ::: "memory"); __builtin_amdgcn_s_barrier();
            G8_ROWS_BEGIN const int row = u.pm * 256 + rl; float t1 = 0.f, t2 = 0.f;
#pragma unroll
                for (int w2 = 0; w2 < 4; ++w2) { const f32x2 p_ = *(const LAS f32x2*)(red + (((wr * 4 + w2) * 128) + 64 * ai + 16 * m + fr) * 2); t1 += p_.x; t2 += p_.y; }
                const float mu = t1 * (1.f / DH), rs = rsqrtf(fmaxf(t2 * (1.f / DH) - mu * mu, 0.f) + EPS);
#pragma unroll
                for (int bj = 0; bj < 2; ++bj) {
                    float x8[8]; un8(*(const u32x4*)(XC + (size_t)row * DM + c0 + 128 * bj), x8);
                    const float4 g0 = *(const float4*)(ngain + c0 + 128 * bj), g1 = *(const float4*)(ngain + c0 + 128 * bj + 4), k0 = *(const float4*)(skip + c0 + 128 * bj), k1 = *(const float4*)(skip + c0 + 128 * bj + 4);
                    f32x4 o0, o1;
                    o0[0] = (acc[ai][bj][m][0][0] - mu) * rs * g0.x + k0.x * x8[0]; o0[1] = (acc[ai][bj][m][0][1] - mu) * rs * g0.y + k0.y * x8[1]; o0[2] = (acc[ai][bj][m][0][2] - mu) * rs * g0.z + k0.z * x8[2]; o0[3] = (acc[ai][bj][m][0][3] - mu) * rs * g0.w + k0.w * x8[3];
                    o1[0] = (acc[ai][bj][m][1][0] - mu) * rs * g1.x + k1.x * x8[4]; o1[1] = (acc[ai][bj][m][1][1] - mu) * rs * g1.y + k1.y * x8[5]; o1[2] = (acc[ai][bj][m][1][2] - mu) * rs * g1.z + k1.z * x8[6]; o1[3] = (acc[ai][bj][m][1][3] - mu) * rs * g1.w + k1.w * x8[7];
                    *(u32x4*)(MX + (size_t)row * 2048 + 1024 + c0 + 128 * bj) = pk8(o0, o1); } G8_ROWS_END
        } else {
            G8_ROWS_BEGIN const int row = u.pm * 256 + rl;
#pragma unroll
                for (int bj = 0; bj < 2; ++bj) {
                    bf16_t* pp = MX + (size_t)row * 2048 + 1024 + c0 + 128 * bj;
                    float h8[8]; un8(*(const u32x4*)pp, h8);
                    f32x4 o0, o1;
                    o0[0] = h8[0] * siluf_(acc[ai][bj][m][0][0]); o0[1] = h8[1] * siluf_(acc[ai][bj][m][0][1]); o0[2] = h8[2] * siluf_(acc[ai][bj][m][0][2]); o0[3] = h8[3] * siluf_(acc[ai][bj][m][0][3]);
                    o1[0] = h8[4] * siluf_(acc[ai][bj][m][1][0]); o1[1] = h8[5] * siluf_(acc[ai][bj][m][1][1]); o1[2] = h8[6] * siluf_(acc[ai][bj][m][1][2]); o1[3] = h8[7] * siluf_(acc[ai][bj][m][1][3]);
                    *(u32x4*)pp = pk8(o0, o1); } G8_ROWS_END
        }
    } };
}
DEV void rstd_rows(const float* rowss, float* rstd) {
    const int tid = opaque_tid();
    for (int r = blockIdx.x * 512 + tid; r < MTOK; r += gridDim.x * 512) { float s_ = 0.f;
#pragma unroll
        for (int p_ = 0; p_ < 16; ++p_) s_ += rowss[(size_t)p_ * MTOK + r];
        rstd[r] = rsqrtf(s_ * (1.f / DM) + EPS); }
}

DEV void transpose_item(const float* W, int ldw, int ncols, bf16_t* WT, int ldwt, LAS float* scr, int item, int lane) {
    const int nblk = ncols / 64, kb = item / nblk, nb = item % nblk, k0 = 64 * kb, n0 = 64 * nb;
    float4 v[16];
#pragma unroll
    for (int i = 0; i < 16; ++i) v[i] = *(const float4*)(W + (size_t)(k0 + 4 * i + (lane >> 4)) * ldw + n0 + 4 * (lane & 15));
#pragma unroll
    for (int i = 0; i < 16; ++i) { LAS float* d_ = scr + (4 * i + (lane >> 4)) * 65 + 4 * (lane & 15); d_[0] = v[i].x; d_[1] = v[i].y; d_[2] = v[i].z; d_[3] = v[i].w; }
    asm volatile("s_waitcnt lgkmcnt(0)" ::: "memory");
#pragma unroll
    for (int j = 0; j < 8; ++j) {
        const int n = (lane >> 3) + 8 * j, c = lane & 7;
        const LAS float* s_ = scr + (8 * c) * 65 + n;
        uint4 o;
        o.x = pk2(s_[0 * 65], s_[1 * 65]); o.y = pk2(s_[2 * 65], s_[3 * 65]); o.z = pk2(s_[4 * 65], s_[5 * 65]); o.w = pk2(s_[6 * 65], s_[7 * 65]);
        *(uint4*)(WT + (size_t)(n0 + n) * ldwt + k0 + 8 * c) = o;
    }
    asm volatile("s_waitcnt lgkmcnt(0)" ::: "memory");
}

DEV float wave_scan_add(float v, int lane) {
#pragma unroll
    for (int o = 1; o < 64; o <<= 1) { const float u = __shfl_up(v, o); if (lane >= o) v += u; }
    return v;
}
DEV float wave_scan_max(float v, int lane) {
#pragma unroll
    for (int o = 1; o < 64; o <<= 1) { const float u = __shfl_up(v, o); if (lane >= o) v = fmaxf(v, u); }
    return v;
}

template <int TT>
DEV void mlstm_a_wave(LAS char* shm, int fr, int fq, float m_prev, const LAS float* tpj, const LAS float* taj, f32x4 (&nacc)[3]) {
    constexpr int QS = 0, KS = 33792, VT = 67584, RS = 528, VRS = 96, NT = TT + 1;
    const LAS char* qb = shm + QS + (16 * TT + fr) * RS + fq * 16;
    const LAS char* kb = shm + KS + fr * RS + fq * 16;
    f32x4 sacc[NT];
#pragma unroll
    for (int jj = 0; jj < NT; ++jj) sacc[jj] = (f32x4){0.f, 0.f, 0.f, 0.f};
    bf16x8 qf = *(const LAS bf16x8*)qb, kf[NT];
#pragma unroll
    for (int jj = 0; jj < NT; ++jj) kf[jj] = *(const LAS bf16x8*)(kb + jj * 16 * RS);
#pragma unroll
    for (int ks = 0; ks < 8; ++ks) {
        bf16x8 qn = qf, kn[NT];
#pragma unroll
        for (int jj = 0; jj < NT; ++jj) kn[jj] = kf[jj];
        if (ks < 7) {
            qn = *(const LAS bf16x8*)(qb + (ks + 1) * 64);
#pragma unroll
            for (int jj = 0; jj < NT; ++jj) kn[jj] = *(const LAS bf16x8*)(kb + jj * 16 * RS + (ks + 1) * 64);
        }
#pragma unroll
        for (int jj = 0; jj < NT; ++jj) sacc[jj] = __builtin_amdgcn_mfma_f32_16x16x32_bf16(kf[jj], qf, sacc[jj], 0, 0, 0);
        qf = qn;
#pragma unroll
        for (int jj = 0; jj < NT; ++jj) kf[jj] = kn[jj];
    }
    constexpr int NK = (TT >= 2) ? 2 : 1;
    s16x4 vlo[NK][3], vhi[NK][3];
#pragma unroll
    for (int kk = 0; kk < NK; ++kk)
#pragma unroll
        for (int vt = 0; vt < 3; ++vt) {
            vlo[kk][vt] = __builtin_amdgcn_ds_read_tr16_b64_v4i16((LAS s16x4*)(shm + VT + (32 * kk + 4 * fq + (fr >> 2)) * VRS + (16 * vt + 4 * (fr & 3)) * 2));
            vhi[kk][vt] = __builtin_amdgcn_ds_read_tr16_b64_v4i16((LAS s16x4*)(shm + VT + (32 * kk + 16 + 4 * fq + (fr >> 2)) * VRS + (16 * vt + 4 * (fr & 3)) * 2));
        }
    const int t = 16 * TT + fr;
    const float btm = -fmaxf(m_prev, tpj[t]);
    f32x4 sm[2 * NK];
#pragma unroll
    for (int jj = 0; jj < 2 * NK; ++jj) {
        if (jj < NT) {
            const f32x4 a4 = *(const LAS f32x4*)(taj + 16 * jj + 4 * fq);
#pragma unroll
            for (int r = 0; r < 4; ++r) {
                const int s_ = 16 * jj + 4 * fq + r;
                sm[jj][r] = (jj < TT || s_ <= t) ? sacc[jj < NT ? jj : 0][r] * __expf(btm + a4[r]) : 0.f;
            }
        } else sm[jj] = (f32x4){0.f, 0.f, 0.f, 0.f};
    }
#pragma unroll
    for (int kk = 0; kk < NK; ++kk) {
        const u32x4 u = (u32x4){pk2(sm[2 * kk][0], sm[2 * kk][1]), pk2(sm[2 * kk][2], sm[2 * kk][3]), pk2(sm[2 * kk + 1][0], sm[2 * kk + 1][1]), pk2(sm[2 * kk + 1][2], sm[2 * kk + 1][3])};
        const bf16x8 af = *(const bf16x8*)&u;
#pragma unroll
        for (int vt = 0; vt < 3; ++vt) {
            bf16x8 bv8; bv8[0] = vlo[kk][vt][0]; bv8[1] = vlo[kk][vt][1]; bv8[2] = vlo[kk][vt][2]; bv8[3] = vlo[kk][vt][3];
            bv8[4] = vhi[kk][vt][0]; bv8[5] = vhi[kk][vt][1]; bv8[6] = vhi[kk][vt][2]; bv8[7] = vhi[kk][vt][3];
            nacc[vt] = __builtin_amdgcn_mfma_f32_16x16x32_bf16(af, bv8, nacc[vt], 0, 0, 0);
        }
    }
}
DEV void mlstm_b_wave(LAS char* shm, int tt, int fr, int fq, f32x4 (&nacc)[3]) {
    constexpr int QS = 0, CB = 81408, RS = 528;
    const LAS char* qb = shm + QS + (16 * tt + fr) * RS + fq * 16;
    const LAS char* cbp = shm + CB + fr * RS + fq * 16;
    bf16x8 qf = *(const LAS bf16x8*)qb, cf[3];
#pragma unroll
    for (int vt = 0; vt < 3; ++vt) cf[vt] = *(const LAS bf16x8*)(cbp + vt * 16 * RS);
#pragma unroll
    for (int ks = 0; ks < 8; ++ks) {
        bf16x8 qn = qf, cn[3] = {cf[0], cf[1], cf[2]};
        if (ks < 7) {
            qn = *(const LAS bf16x8*)(qb + (ks + 1) * 64);
#pragma unroll
            for (int vt = 0; vt < 3; ++vt) cn[vt] = *(const LAS bf16x8*)(cbp + vt * 16 * RS + (ks + 1) * 64);
        }
#pragma unroll
        for (int vt = 0; vt < 3; ++vt) nacc[vt] = __builtin_amdgcn_mfma_f32_16x16x32_bf16(qf, cf[vt], nacc[vt], 0, 0, 0);
        qf = qn;
#pragma unroll
        for (int vt = 0; vt < 3; ++vt) cf[vt] = cn[vt];
    }
}
template <int SKIP>
DEV void mlstm_phase(LAS char* shm, const bf16_t* q, const bf16_t* k, const bf16_t* v, const float* gpart, const float* b_ig, const float* b_fg, bf16_t* hc) {
    const int tid = opaque_tid(), wid = __builtin_amdgcn_readfirstlane(tid >> 6), lane = tid & 63, fr = lane & 15, fq = lane >> 4;
    constexpr int QS = 0, KS = 33792, VT = 67584, VWT = 74496, CB = 81408, PART = 106752, TB = 120064, TA = 128256, TP = 136448, TC = 144640, HST = 144896, RS = 528, VRS = 96, PRS = 52;
    LAS float* part = (LAS float*)(shm + PART);
    LAS float* tb = (LAS float*)(shm + TB); LAS float* ta = (LAS float*)(shm + TA); LAS float* tp = (LAS float*)(shm + TP); LAS float* tc = (LAS float*)(shm + TC);
    for (int item = blockIdx.x; item < BATCH * NH * 8; item += gridDim.x) {
        const int vs = (item >> 3) & 7, bh = (item & 7) + 8 * (item >> 6), h = bh & 3, b = bh >> 2;
        __syncthreads();
        for (int i = tid; i < (CB + 25344 - VT) / 4; i += 512) ((LAS unsigned*)(shm + VT))[i] = 0u;
        for (int j = wid; j < SEQ / CHUNK; j += 8) {
            const int m = b * SEQ + j * CHUNK + lane;
            const float* gp = gpart + (size_t)m * 8;
            const float ig = gp[h] + gp[(size_t)MTOK * 8 + h] + b_ig[h];
            const float lf = logsigmoidf_(gp[4 + h] + gp[(size_t)MTOK * 8 + 4 + h] + b_fg[h]);
            const float bc = wave_scan_add(lf, lane);
            const float a_ = ig - bc;
            const float pm = wave_scan_max(a_, lane);
            tb[j * 64 + lane] = bc; ta[j * 64 + lane] = a_; tp[j * 64 + lane] = pm;
            if (lane == 63) { tc[2 * j] = bc; tc[2 * j + 1] = pm; }
        }
        __syncthreads();
        if (tid < 64) *(LAS u32x4*)(shm + VT + tid * VRS + 64) = (u32x4){0x3F80u, 0u, 0u, 0u};
        f32x4 cacc[2][3];
#pragma unroll
        for (int i = 0; i < 2; ++i)
#pragma unroll
            for (int vt = 0; vt < 3; ++vt) cacc[i][vt] = (f32x4){0.f, 0.f, 0.f, 0.f};
        float m_prev = 0.f;
        const size_t cb0 = ((size_t)(b * SEQ)) * DM + h * DH;
        uint4 qv[4], kv[4], vv = make_uint4(0, 0, 0, 0);
#pragma unroll
        for (int i = 0; i < 4; ++i) {
            const int idx = tid + 512 * i, row = idx >> 5, c16 = idx & 31;
            qv[i] = *(const uint4*)(q + cb0 + (size_t)row * DM + c16 * 8);
            kv[i] = *(const uint4*)(k + cb0 + (size_t)row * DM + c16 * 8);
        }
        if (tid < 256) vv = *(const uint4*)(v + cb0 + (size_t)(tid >> 2) * DM + vs * 32 + (tid & 3) * 8);
#pragma nounroll
        for (int j = 0; j < SEQ / CHUNK; ++j) {
            const size_t cb = cb0 + (size_t)j * CHUNK * DM;
            const float btot = tc[2 * j], amax = tc[2 * j + 1];
            const float mxc = fmaxf(m_prev, amax);
#pragma unroll
            for (int i = 0; i < ((SKIP & 8) ? 0 : 4); ++i) {
                const int idx = tid + 512 * i, row = idx >> 5, c16 = idx & 31;
                *(LAS u32x4*)(shm + QS + row * RS + c16 * 16) = (u32x4){qv[i].x, qv[i].y, qv[i].z, qv[i].w};
                *(LAS u32x4*)(shm + KS + row * RS + c16 * 16) = (u32x4){kv[i].x, kv[i].y, kv[i].z, kv[i].w};
            }
            if (tid < 256) {
                const int s_ = tid >> 2, v0 = (tid & 3) * 8;
                const float ws = __expf(ta[j * 64 + s_] - mxc);
                float f8[8]; unpack8(vv, f8);
#pragma unroll
                for (int e = 0; e < 8; ++e) f8[e] *= ws;
                const uint4 wv = pack8(f8);
                *(LAS u32x4*)(shm + VT + s_ * VRS + v0 * 2) = (u32x4){vv.x, vv.y, vv.z, vv.w};
                *(LAS u32x4*)(shm + VWT + s_ * VRS + v0 * 2) = (u32x4){wv.x, wv.y, wv.z, wv.w};
            } else if (tid < 320) {
                const int s_ = tid - 256;
                *(LAS u32x4*)(shm + VWT + s_ * VRS + 64) = (u32x4){(unsigned)f2bf(__expf(ta[j * 64 + s_] - mxc)), 0u, 0u, 0u};
            }
            if (j + 1 < SEQ / CHUNK) {
                const size_t cn = cb + (size_t)CHUNK * DM;
#pragma unroll
                for (int i = 0; i < 4; ++i) {
                    const int idx = tid + 512 * i, row = idx >> 5, c16 = idx & 31;
                    qv[i] = *(const uint4*)(q + cn + (size_t)row * DM + c16 * 8);
                    kv[i] = *(const uint4*)(k + cn + (size_t)row * DM + c16 * 8);
                }
                if (tid < 256) vv = *(const uint4*)(v + cn + (size_t)(tid >> 2) * DM + vs * 32 + (tid & 3) * 8);
            }
            __syncthreads();
            f32x4 nacc[3];
#pragma unroll
            for (int vt = 0; vt < 3; ++vt) nacc[vt] = (f32x4){0.f, 0.f, 0.f, 0.f};
            const int tt = wid & 3;
            if (wid < 4) { if (!(SKIP & 1)) {
                const LAS float* tpj = tp + j * 64; const LAS float* taj = ta + j * 64;
                if (tt == 0) mlstm_a_wave<0>(shm, fr, fq, m_prev, tpj, taj, nacc);
                else if (tt == 1) mlstm_a_wave<1>(shm, fr, fq, m_prev, tpj, taj, nacc);
                else if (tt == 2) mlstm_a_wave<2>(shm, fr, fq, m_prev, tpj, taj, nacc);
                else mlstm_a_wave<3>(shm, fr, fq, m_prev, tpj, taj, nacc);
            } } else if (!(SKIP & 2)) {
                mlstm_b_wave(shm, tt, fr, fq, nacc);
                const f32x4 pm4 = *(const LAS f32x4*)(tp + j * 64 + 16 * tt + 4 * fq);
#pragma unroll
                for (int vt = 0; vt < 3; ++vt)
#pragma unroll
                    for (int r = 0; r < 4; ++r) part[(16 * tt + 4 * fq + r) * PRS + 16 * vt + fr] = __expf(m_prev - fmaxf(m_prev, pm4[r])) * nacc[vt][r];
            }
            if (!(SKIP & 4)) {
                const float decay = __expf(m_prev - mxc);
#pragma unroll
                for (int i = 0; i < 2; ++i)
#pragma unroll
                    for (int vt = 0; vt < 3; ++vt) cacc[i][vt] *= decay;
                const int q_ = fr >> 2, p_ = fr & 3;
                s16x4 wl[2][3], wh[2][3], kl[2][2], kh[2][2];
#pragma unroll
                for (int kk = 0; kk < 2; ++kk) {
#pragma unroll
                    for (int vt = 0; vt < 3; ++vt) {
                        wl[kk][vt] = __builtin_amdgcn_ds_read_tr16_b64_v4i16((LAS s16x4*)(shm + VWT + (32 * kk + 8 * fq + q_) * VRS + (16 * vt + 4 * p_) * 2));
                        wh[kk][vt] = __builtin_amdgcn_ds_read_tr16_b64_v4i16((LAS s16x4*)(shm + VWT + (32 * kk + 8 * fq + 4 + q_) * VRS + (16 * vt + 4 * p_) * 2));
                    }
#pragma unroll
                    for (int i = 0; i < 2; ++i) {
                        const int dt = 2 * wid + i;
                        kl[kk][i] = __builtin_amdgcn_ds_read_tr16_b64_v4i16((LAS s16x4*)(shm + KS + (32 * kk + 8 * fq + q_) * RS + (16 * dt + 4 * p_) * 2));
                        kh[kk][i] = __builtin_amdgcn_ds_read_tr16_b64_v4i16((LAS s16x4*)(shm + KS + (32 * kk + 8 * fq + 4 + q_) * RS + (16 * dt + 4 * p_) * 2));
                    }
                }
#pragma unroll
                for (int kk = 0; kk < 2; ++kk) {
                    bf16x8 bfv[3];
#pragma unroll
                    for (int vt = 0; vt < 3; ++vt) { bfv[vt][0] = wl[kk][vt][0]; bfv[vt][1] = wl[kk][vt][1]; bfv[vt][2] = wl[kk][vt][2]; bfv[vt][3] = wl[kk][vt][3];
                        bfv[vt][4] = wh[kk][vt][0]; bfv[vt][5] = wh[kk][vt][1]; bfv[vt][6] = wh[kk][vt][2]; bfv[vt][7] = wh[kk][vt][3]; }
#pragma unroll
                    for (int i = 0; i < 2; ++i) {
                        bf16x8 af; af[0] = kl[kk][i][0]; af[1] = kl[kk][i][1]; af[2] = kl[kk][i][2]; af[3] = kl[kk][i][3]; af[4] = kh[kk][i][0]; af[5] = kh[kk][i][1]; af[6] = kh[kk][i][2]; af[7] = kh[kk][i][3];
#pragma unroll
                        for (int vt = 0; vt < 3; ++vt) cacc[i][vt] = __builtin_amdgcn_mfma_f32_16x16x32_bf16(af, bfv[vt], cacc[i][vt], 0, 0, 0);
                    }
                }
            }
            __syncthreads();
            if (wid < 4 && !(SKIP & 16)) {
                const f32x4 pm4 = *(const LAS f32x4*)(tp + j * 64 + 16 * tt + 4 * fq);
                const f32x4 bc4 = *(const LAS f32x4*)(tb + j * 64 + 16 * tt + 4 * fq);
#pragma unroll
                for (int vt = 0; vt < 3; ++vt)
#pragma unroll
                    for (int r = 0; r < 4; ++r) nacc[vt][r] += part[(16 * tt + 4 * fq + r) * PRS + 16 * vt + fr];
#pragma unroll
                for (int r = 0; r < 4; ++r) {
                    const float den = __shfl(nacc[2][r], lane & 48);
                    const float inv = 1.f / fmaxf(fabsf(den), __expf(-(bc4[r] + fmaxf(m_prev, pm4[r]))));
                    LAS bf16_t* hrow = (LAS bf16_t*)(shm + HST + (16 * tt + 4 * fq + r) * 80);
                    hrow[fr] = f2bf(nacc[0][r] * inv);
                    hrow[16 + fr] = f2bf(nacc[1][r] * inv);
                }
                asm volatile("s_waitcnt lgkmcnt(0)" ::: "memory");
                {
                    const int rw = 16 * tt + (lane >> 2), pc = lane & 3;
                    const u32x4 hv = *(const LAS u32x4*)(shm + HST + rw * 80 + pc * 16);
                    *(uint4*)(hc + cb + (size_t)rw * DM + vs * 32 + pc * 8) = make_uint4(hv[0], hv[1], hv[2], hv[3]);
                }
            }
#pragma unroll
            for (int i = 0; i < 2; ++i)
#pragma unroll
                for (int vt = 0; vt < 3; ++vt) {
                    u32x2 o; o[0] = pk2(cacc[i][vt][0], cacc[i][vt][1]); o[1] = pk2(cacc[i][vt][2], cacc[i][vt][3]);
                    *(LAS u32x2*)(shm + CB + (16 * vt + fr) * RS + (16 * (2 * wid + i) + 4 * fq) * 2) = o;
                }
            m_prev = btot + mxc;
        }
    }
}

constexpr int S5L = 32, S5NCH = SEQ / S5L;
constexpr size_t T_KT_OFF = 0, T_WS_OFF = 2u << 20, T_V_OFF = 10u << 20, T_AL_OFF = 18u << 20;
constexpr int KT_G = 33 * 256, WS_G = 128 * 512, V_G = 512 * 128;

DEV void s5_tables(LAS char* shm, char* tab, const float* lam_re, const float* lam_im, const float* log_dt, const float* b_re, const float* b_im,
                   const float* c_re, const float* c_im) {
    const int tid = opaque_tid();
    LAS f32x2* apw = (LAS f32x2*)shm;
    LAS f32x2* bb = (LAS f32x2*)(shm + 64 * 33 * 8);
    LAS f32x2* cc = (LAS f32x2*)(shm + 64 * 33 * 8 + 8192);
    bf16_t* KT = (bf16_t*)(tab + T_KT_OFF); bf16_t* WS = (bf16_t*)(tab + T_WS_OFF); bf16_t* VV = (bf16_t*)(tab + T_V_OFF); float2* AL = (float2*)(tab + T_AL_OFF);
    for (int it = blockIdx.x; it < 256; it += gridDim.x) {
        const int g = it & 63, qd = it >> 6;
        __syncthreads();
        if (tid < 64) {
            const int pp = tid;
            const double lr = lam_re[g * NP + pp], li = lam_im[g * NP + pp], dt = exp((double)log_dt[g]);
            const double er = exp(lr * dt);
            const double ar = er * cos(li * dt), ai = er * sin(li * dt);
            const double dr = ar - 1.0, di = ai, den = lr * lr + li * li;
            const double cr = (dr * lr + di * li) / den, ci = (di * lr - dr * li) / den;
            double pr = 1.0, pi_ = 0.0;
            for (int e = 0; e <= 32; ++e) {
                apw[pp * 33 + e] = (f32x2){(float)pr, (float)pi_};
                const double nr = pr * ar - pi_ * ai, ni = pr * ai + pi_ * ar; pr = nr; pi_ = ni;
            }
            if (qd == 0) { const f32x2 t_ = apw[pp * 33 + 32]; AL[g * NP + pp] = make_float2(t_.x, t_.y); }
            for (int c = 0; c < 16; ++c) {
                const double br = b_re[(g * NP + pp) * GC + c], bi = b_im[(g * NP + pp) * GC + c];
                bb[pp * 16 + c] = (f32x2){(float)(cr * br - ci * bi), (float)(cr * bi + ci * br)};
                cc[c * 64 + pp] = (f32x2){c_re[(g * GC + c) * NP + pp], c_im[(g * GC + c) * NP + pp]};
            }
        }
        __syncthreads();
        for (int o = tid; o < 8 * 256; o += 512) {
            const int d = 8 * qd + (o >> 8), c1 = (o >> 4) & 15, c0 = o & 15;
            float acc = 0.f;
            for (int pp = 0; pp < 64; ++pp) {
                const f32x2 a = apw[pp * 33 + d], b = bb[pp * 16 + c0], c = cc[c1 * 64 + pp];
                const float mr = a.x * b.x - a.y * b.y, mi = a.x * b.y + a.y * b.x;
                acc += c.x * mr - c.y * mi;
            }
            KT[(size_t)g * KT_G + (d + 1) * 256 + c1 * 16 + c0] = f2bf(acc);
        }
        if (qd == 0 && tid < 256) KT[(size_t)g * KT_G + tid] = 0;
        for (int o = tid; o < 2 * 16 * 64; o += 512) {
            const int mt = 2 * qd + (o >> 10), sp = (o >> 6) & 15, ln = o & 63;
            const int row = 16 * mt + (ln & 15), ri = row >> 6, pp = row & 63, s_ = 2 * sp + (ln >> 5), c0 = 8 * ((ln >> 4) & 1);
            const f32x2 a = apw[pp * 33 + 31 - s_];
            unsigned w[4];
#pragma unroll
            for (int jj = 0; jj < 8; jj += 2) {
                const f32x2 b0 = bb[pp * 16 + c0 + jj], b1 = bb[pp * 16 + c0 + jj + 1];
                const float v0 = ri ? (a.x * b0.y + a.y * b0.x) : (a.x * b0.x - a.y * b0.y);
                const float v1 = ri ? (a.x * b1.y + a.y * b1.x) : (a.x * b1.x - a.y * b1.y);
                w[jj >> 1] = pk2(v0, v1);
            }
            *(uint4*)(WS + (size_t)g * WS_G + ((size_t)(mt * 16 + sp) * 64 + ln) * 8) = make_uint4(w[0], w[1], w[2], w[3]);
        }
        for (int o = tid; o < 8 * 4 * 64; o += 512) {
            const int i = 8 * qd + (o >> 8), ks = (o >> 6) & 3, ln = o & 63;
            const int c1 = ln & 15, k0 = 32 * ks + 8 * (ln >> 4);
            unsigned w[4];
#pragma unroll
            for (int jj = 0; jj < 8; jj += 2) {
                float v[2];
#pragma unroll
                for (int e = 0; e < 2; ++e) {
                    const int kk = k0 + jj + e, ri = kk >> 6, pp = kk & 63;
                    const f32x2 a = apw[pp * 33 + i + 1], c = cc[c1 * 64 + pp];
                    v[e] = ri ? -(c.x * a.y + c.y * a.x) : (c.x * a.x - c.y * a.y);
                }
                w[jj >> 1] = pk2(v[0], v[1]);
            }
            *(uint4*)(VV + (size_t)g * V_G + ((size_t)(i * 4 + ks) * 64 + ln) * 8) = make_uint4(w[0], w[1], w[2], w[3]);
        }
    }
}

template <int NQ>
DEV void s5_p1_range(LAS char* shm, int lo, int hi, int wid, int fr, int fq, const bf16_t* wsp, f32x4 (&acc)[4][4], f32x4 (&sac)[4]) {
    constexpr int PLANE = 64 * 528, KTL = 2 * PLANE, Q0 = 4 - NQ;
    if (lo > hi) return;
    const LAS char* ub = shm + (fq & 1) * PLANE + fr * 528 + (fq >> 1) * 16;
    const LAS char* kb = shm + KTL + (1 - (fq >> 1)) * 512 + fr * 32 + (fq & 1) * 16;
    bf16x8 bu[4], kf[NQ], wcur;
#pragma unroll
    for (int nt = 0; nt < 4; ++nt) bu[nt] = *(const LAS bf16x8*)(ub + nt * 16 * 528 + lo * 32);
#pragma unroll
    for (int q = 0; q < NQ; ++q) kf[q] = *(const LAS bf16x8*)(kb + (wid + 8 * (Q0 + q) - 2 * lo) * 512);
    wcur = *(const bf16x8*)(wsp + (size_t)lo * 64 * 8);
#pragma nounroll
    for (int sp = lo; sp <= hi; ++sp) {
        bf16x8 bn[4], kn[NQ], wn = wcur;
        const int sn = (sp < hi) ? sp + 1 : sp;
#pragma unroll
        for (int nt = 0; nt < 4; ++nt) bn[nt] = *(const LAS bf16x8*)(ub + nt * 16 * 528 + sn * 32);
#pragma unroll
        for (int q = 0; q < NQ; ++q) kn[q] = *(const LAS bf16x8*)(kb + (wid + 8 * (Q0 + q) - 2 * sn) * 512);
        wn = *(const bf16x8*)(wsp + (size_t)sn * 64 * 8);
#pragma unroll
        for (int nt = 0; nt < 4; ++nt) sac[nt] = __builtin_amdgcn_mfma_f32_16x16x32_bf16(wcur, bu[nt], sac[nt], 0, 0, 0);
#pragma unroll
        for (int q = 0; q < NQ; ++q)
#pragma unroll
            for (int nt = 0; nt < 4; ++nt) acc[Q0 + q][nt] = __builtin_amdgcn_mfma_f32_16x16x32_bf16(kf[q], bu[nt], acc[Q0 + q][nt], 0, 0, 0);
#pragma unroll
        for (int nt = 0; nt < 4; ++nt) bu[nt] = bn[nt];
#pragma unroll
        for (int q = 0; q < NQ; ++q) kf[q] = kn[q];
        wcur = wn;
    }
}
DEV void s5_phase(LAS char* shm, const bf16_t* Uin, bf16_t* Yout, const char* tab, const float* dskip) {
    const int tid = opaque_tid(), wid = __builtin_amdgcn_readfirstlane(tid >> 6), lane = tid & 63, fr = lane & 15, fq = lane >> 4;
    constexpr int PLANE = 64 * 528, KTL = 2 * PLANE, SL = KTL + 33 * 512, HB = SL + 64 * 528, SRS = 528, HRS = 272, TSEG = HB + 64 * 272;
    const bf16_t* KT = (const bf16_t*)(tab + T_KT_OFF); const bf16_t* WS = (const bf16_t*)(tab + T_WS_OFF); const bf16_t* VV = (const bf16_t*)(tab + T_V_OFF);
    const float2* AL = (const float2*)(tab + T_AL_OFF);
    for (int item = blockIdx.x; item < BATCH * NG; item += gridDim.x) {
        const int xcd_ = item & 7, j_ = (item >> 3) & 31, g = xcd_ * 8 + (j_ & 7), b = (j_ >> 3) + 4 * (item >> 8);
        const bf16_t* Ub = Uin + (size_t)b * SEQ * DM + g * GC;
        bf16_t* Yb = Yout + (size_t)b * SEQ * DM + g * GC;
        __syncthreads();
#pragma unroll
        for (int i = 0; i < 8; ++i) {
            const int idx = tid + 512 * i, tok = idx >> 1, hf = idx & 1;
            const uint4 uv = *(const uint4*)(Ub + (size_t)tok * DM + hf * 8);
            *(LAS u32x4*)(shm + hf * PLANE + (tok >> 5) * 528 + (tok & 31) * 16) = (u32x4){uv.x, uv.y, uv.z, uv.w};
        }
        for (int idx = tid; idx < 33 * 32; idx += 512) {
            const uint4 kv = *(const uint4*)(KT + (size_t)g * KT_G + idx * 8);
            *(LAS u32x4*)(shm + KTL + idx * 16) = (u32x4){kv.x, kv.y, kv.z, kv.w};
        }
        __syncthreads();
        f32x4 acc[4][4], sac[4];
#pragma unroll
        for (int q = 0; q < 4; ++q)
#pragma unroll
            for (int nt = 0; nt < 4; ++nt) acc[q][nt] = (f32x4){0.f, 0.f, 0.f, 0.f};
#pragma unroll
        for (int nt = 0; nt < 4; ++nt) sac[nt] = (f32x4){0.f, 0.f, 0.f, 0.f};
        const bf16_t* wsp = WS + (size_t)g * WS_G + ((size_t)(wid * 16) * 64 + lane) * 8;
        const int h2 = wid >> 1;
        s5_p1_range<4>(shm, 0, h2, wid, fr, fq, wsp, acc, sac);
        s5_p1_range<3>(shm, h2 + 1, 4 + h2, wid, fr, fq, wsp, acc, sac);
        s5_p1_range<2>(shm, 5 + h2, 8 + h2, wid, fr, fq, wsp, acc, sac);
        s5_p1_range<1>(shm, 9 + h2, 12 + h2, wid, fr, fq, wsp, acc, sac);
        if (13 + h2 <= 15) {
            const LAS char* ub = shm + (fq & 1) * PLANE + fr * 528 + (fq >> 1) * 16;
            for (int sp = 13 + h2; sp <= 15; ++sp) {
                const bf16x8 wcur = *(const bf16x8*)(wsp + (size_t)sp * 64 * 8);
#pragma unroll
                for (int nt = 0; nt < 4; ++nt) sac[nt] = __builtin_amdgcn_mfma_f32_16x16x32_bf16(wcur, *(const LAS bf16x8*)(ub + nt * 16 * 528 + sp * 32), sac[nt], 0, 0, 0);
            }
        }
#pragma unroll
        for (int nt = 0; nt < 4; ++nt) *(LAS f32x4*)(shm + SL + (16 * nt + fr) * SRS + (16 * wid + 4 * fq) * 4) = sac[nt];
        __syncthreads();
        {
            const float2 al = AL[g * NP + lane];
            float hr = 0.f, hi = 0.f, lr[8], li[8];
#pragma unroll
            for (int n = 0; n < 8; ++n) {
                lr[n] = hr; li[n] = hi;
                const float sr = *(const LAS float*)(shm + SL + (8 * wid + n) * SRS + lane * 4), si = *(const LAS float*)(shm + SL + (8 * wid + n) * SRS + (64 + lane) * 4);
                const float nr = al.x * hr - al.y * hi + sr, ni = al.x * hi + al.y * hr + si; hr = nr; hi = ni;
            }
            *(LAS float*)(shm + TSEG + (wid * 128 + lane) * 4) = hr; *(LAS float*)(shm + TSEG + (wid * 128 + 64 + lane) * 4) = hi;
            float pr = al.x, pi = al.y;
#pragma unroll
            for (int e = 0; e < 3; ++e) { const float nr = pr * pr - pi * pi, ni = 2.f * pr * pi; pr = nr; pi = ni; }
            __syncthreads();
            float cr = 0.f, ci = 0.f;
            for (int w2 = 0; w2 < wid; ++w2) {
                const float tr = *(const LAS float*)(shm + TSEG + (w2 * 128 + lane) * 4), ti = *(const LAS float*)(shm + TSEG + (w2 * 128 + 64 + lane) * 4);
                const float nr = pr * cr - pi * ci + tr, ni = pr * ci + pi * cr + ti; cr = nr; ci = ni;
            }
            float qr = 1.f, qi = 0.f;
#pragma unroll
            for (int n = 0; n < 8; ++n) {
                const float fr_ = lr[n] + qr * cr - qi * ci, fi_ = li[n] + qr * ci + qi * cr;
                *(LAS bf16_t*)(shm + HB + (8 * wid + n) * HRS + lane * 2) = f2bf(fr_);
                *(LAS bf16_t*)(shm + HB + (8 * wid + n) * HRS + (64 + lane) * 2) = f2bf(fi_);
                const float nr = qr * al.x - qi * al.y, ni = qr * al.y + qi * al.x; qr = nr; qi = ni;
            }
        }
        __syncthreads();
        const bf16_t* vvp = VV + (size_t)g * V_G + (size_t)lane * 8;
        bf16x8 va[4];
#pragma unroll
        for (int q = 0; q < 4; ++q) va[q] = *(const bf16x8*)(vvp + ((size_t)((wid + 8 * q) * 4 + 0) * 64) * 8);
#pragma unroll
        for (int ks = 0; ks < 4; ++ks) {
            bf16x8 hb[4], vn[4];
#pragma unroll
            for (int nt = 0; nt < 4; ++nt) hb[nt] = *(const LAS bf16x8*)(shm + HB + (16 * nt + fr) * HRS + (32 * ks + 8 * fq) * 2);
#pragma unroll
            for (int q = 0; q < 4; ++q) vn[q] = (ks < 3) ? *(const bf16x8*)(vvp + ((size_t)((wid + 8 * q) * 4 + ks + 1) * 64) * 8) : va[q];
#pragma unroll
            for (int q = 0; q < 4; ++q)
#pragma unroll
                for (int nt = 0; nt < 4; ++nt) acc[q][nt] = __builtin_amdgcn_mfma_f32_16x16x32_bf16(va[q], hb[nt], acc[q][nt], 0, 0, 0);
#pragma unroll
            for (int q = 0; q < 4; ++q) va[q] = vn[q];
        }
        const float4 dsk = *(const float4*)(dskip + g * GC + 4 * fq);
#pragma unroll
        for (int q = 0; q < 4; ++q) {
            const int i = wid + 8 * q;
#pragma unroll
            for (int nt = 0; nt < 4; ++nt) {
                const int n = 16 * nt + fr;
                const u32x2 uu = *(const LAS u32x2*)(shm + (fq >> 1) * PLANE + n * 528 + i * 16 + ((4 * fq) & 7) * 2);
                f32x4 o;
                o[0] = geluf_(acc[q][nt][0] + dsk.x * bf2f((bf16_t)(uu[0] & 0xffff))); o[1] = geluf_(acc[q][nt][1] + dsk.y * bf2f((bf16_t)(uu[0] >> 16)));
                o[2] = geluf_(acc[q][nt][2] + dsk.z * bf2f((bf16_t)(uu[1] & 0xffff))); o[3] = geluf_(acc[q][nt][3] + dsk.w * bf2f((bf16_t)(uu[1] >> 16)));
                *(uint2*)(Yb + (size_t)(n * 32 + i) * DM + 4 * fq) = pack4(o);
            }
        }
    }
}


DEV void norm_rows(const float* x, const float* gain, const float* modl, bf16_t* h) {
    const int tid = opaque_tid(), lane = tid & 63, gw = blockIdx.x * 8 + (tid >> 6), NGW = gridDim.x * 8;
    for (int m = gw; m < MTOK; m += NGW) {
        const float4* xr = (const float4*)(x + (size_t)m * DM) + lane;
        float4 v[4]; float ss = 0.f;
#pragma unroll
        for (int j = 0; j < 4; ++j) { v[j] = xr[64 * j]; ss += v[j].x * v[j].x + v[j].y * v[j].y + v[j].z * v[j].z + v[j].w * v[j].w; }
        const float rstd = rsqrtf(wave_sum(ss) * (1.f / DM) + EPS);
        const float* shift = modl + (size_t)(m / SEQ) * 3 * DM; const float* scale = shift + DM;
#pragma unroll
        for (int j = 0; j < 4; ++j) {
            const int n = 4 * lane + 256 * j;
            const float4 g = *(const float4*)(gain + n), sc = *(const float4*)(scale + n), sh = *(const float4*)(shift + n);
            f32x4 o; o[0] = v[j].x * rstd * g.x * (1.f + sc.x) + sh.x; o[1] = v[j].y * rstd * g.y * (1.f + sc.y) + sh.y;
            o[2] = v[j].z * rstd * g.z * (1.f + sc.z) + sh.z; o[3] = v[j].w * rstd * g.w * (1.f + sc.w) + sh.w;
            *(uint2*)(h + (size_t)m * DM + n) = pack4(o);
        }
    }
}
DEV void ssm_post_rows(const bf16_t* z, bf16_t* zo, const bf16_t* sg, const float* gain) {
    const int tid = opaque_tid(), lane = tid & 63, gw = blockIdx.x * 8 + (tid >> 6), NGW = gridDim.x * 8;
    for (int m = gw; m < MTOK; m += NGW) {
        float zv[2][8], gv[2][8]; float ss = 0.f;
#pragma unroll
        for (int j = 0; j < 2; ++j) {
            unpack8(*(const uint4*)(z + (size_t)m * DM + 8 * lane + 512 * j), zv[j]);
            unpack8(*(const uint4*)(sg + (size_t)m * DM + 8 * lane + 512 * j), gv[j]);
#pragma unroll
            for (int e = 0; e < 8; ++e) ss += zv[j][e] * zv[j][e];
        }
        const float rstd = rsqrtf(wave_sum(ss) * (1.f / DM) + EPS);
#pragma unroll
        for (int j = 0; j < 2; ++j) {
            const int n = 8 * lane + 512 * j; float o[8];
#pragma unroll
            for (int e = 0; e < 8; ++e) o[e] = zv[j][e] * rstd * gain[n + e] * siluf_(gv[j][e]);
            *(uint4*)(zo + (size_t)m * DM + n) = pack8(o);
        }
    }
}
DEV void mlstm_post_rows(const bf16_t* hc, bf16_t* ho, const bf16_t* mo, const bf16_t* mg, const bf16_t* mi, const float* cw, const float* cb, const float* ngain, const float* skip) {
    const int tid = opaque_tid(), lane = tid & 63, gw = blockIdx.x * 8 + (tid >> 6), NGW = gridDim.x * 8;
    for (int m = gw; m < MTOK; m += NGW) {
        const size_t o0 = (size_t)m * DM + 16 * lane;
        float hv[16], t8[8]; float s1 = 0.f;
#pragma unroll
        for (int j = 0; j < 2; ++j) {
            unpack8(*(const uint4*)(hc + o0 + 8 * j), hv + 8 * j);
            unpack8(*(const uint4*)(mo + o0 + 8 * j), t8);
#pragma unroll
            for (int e = 0; e < 8; ++e) { hv[8 * j + e] *= sigmoidf_(t8[e]); s1 += hv[8 * j + e]; }
        }
#pragma unroll
        for (int o = 1; o < 16; o <<= 1) s1 += __shfl_xor(s1, o);
        const float mu = s1 * (1.f / DH); float s2 = 0.f;
#pragma unroll
        for (int e = 0; e < 16; ++e) { hv[e] -= mu; s2 += hv[e] * hv[e]; }
#pragma unroll
        for (int o = 1; o < 16; o <<= 1) s2 += __shfl_xor(s2, o);
        const float rstd = rsqrtf(s2 * (1.f / DH) + EPS);
#pragma unroll
        for (int j = 0; j < 2; ++j) {
            float xv[8], gv[8], ov[8], t8b[8];
            { const int n0 = 16 * lane + 8 * j, tpos = m % SEQ;
#pragma unroll
              for (int e = 0; e < 8; ++e) xv[e] = cb[n0 + e];
#pragma unroll
              for (int tap = 0; tap < 4; ++tap) if (tpos - 3 + tap >= 0) {
                  unpack8(*(const uint4*)(mi + (size_t)(m - 3 + tap) * DM + n0), t8b);
#pragma unroll
                  for (int e = 0; e < 8; ++e) xv[e] += t8b[e] * cw[tap * DM + n0 + e];
              }
#pragma unroll
              for (int e = 0; e < 8; ++e) xv[e] = siluf_(xv[e]); }
            unpack8(*(const uint4*)(mg + o0 + 8 * j), gv);
#pragma unroll
            for (int e = 0; e < 8; ++e) { const int n = 16 * lane + 8 * j + e; ov[e] = (hv[8 * j + e] * rstd * ngain[n] + skip[n] * xv[e]) * siluf_(gv[e]); }
            *(uint4*)(ho + o0 + 8 * j) = pack8(ov);
        }
    }
}
DEV void final_rows(float* x, const float* gain) {
    const int tid = opaque_tid(), lane = tid & 63, gw = blockIdx.x * 8 + (tid >> 6), NGW = gridDim.x * 8;
    for (int m = gw; m < MTOK; m += NGW) {
        float4* xr = (float4*)(x + (size_t)m * DM) + lane;
        float4 v[4]; float ss = 0.f;
#pragma unroll
        for (int j = 0; j < 4; ++j) { v[j] = xr[64 * j]; ss += v[j].x * v[j].x + v[j].y * v[j].y + v[j].z * v[j].z + v[j].w * v[j].w; }
        const float rstd = rsqrtf(wave_sum(ss) * (1.f / DM) + EPS);
#pragma unroll
        for (int j = 0; j < 4; ++j) {
            const float4 g = *(const float4*)(gain + 4 * lane + 256 * j);
            v[j].x *= rstd * g.x; v[j].y *= rstd * g.y; v[j].z *= rstd * g.z; v[j].w *= rstd * g.w;
            xr[64 * j] = v[j];
        }
    }
}
DEV void mod_phase(LAS char* shm, const float* c, const float* w_mod, const float* b_mod, float* mod) {
    const int tid = opaque_tid();
    LAS float* sc = (LAS float*)shm;
    LAS float* pr = (LAS float*)(shm + 32768);
    __syncthreads();
    for (int i = tid; i < BATCH * DM; i += 512) sc[i] = siluf_(c[i]);
    __syncthreads();
    for (int it = blockIdx.x; it < 48; it += gridDim.x) {
        const int l = it / 24, n0 = (it % 24) * 128, cq = tid & 31, kg = tid >> 5;
        const float* W = w_mod + (size_t)l * DM * 3 * DM + n0 + 4 * cq;
        float acc[BATCH][4];
#pragma unroll
        for (int b = 0; b < BATCH; ++b) { acc[b][0] = acc[b][1] = acc[b][2] = acc[b][3] = 0.f; }
        for (int k = kg * 64; k < kg * 64 + 64; ++k) {
            const float4 w = *(const float4*)(W + (size_t)k * 3 * DM);
#pragma unroll
            for (int b = 0; b < BATCH; ++b) { const float s_ = sc[b * DM + k]; acc[b][0] += s_ * w.x; acc[b][1] += s_ * w.y; acc[b][2] += s_ * w.z; acc[b][3] += s_ * w.w; }
        }
#pragma unroll
        for (int b = 0; b < BATCH; ++b) *(LAS f32x4*)(pr + (kg * 8 + b) * 128 + 4 * cq) = (f32x4){acc[b][0], acc[b][1], acc[b][2], acc[b][3]};
        __syncthreads();
        for (int o = tid; o < 8 * 128; o += 512) {
            const int b = o >> 7, n = o & 127; float s_ = 0.f;
#pragma unroll
            for (int g2 = 0; g2 < 16; ++g2) s_ += pr[(g2 * 8 + b) * 128 + n];
            mod[((size_t)l * BATCH + b) * 3 * DM + n0 + n] = s_ + b_mod[l * 3 * DM + n0 + n];
        }
        __syncthreads();
    }
}

DEV void wfold_prep(bf16_t* WfT, const float* wq, const float* wk, const float* wv, const float* wg  ) {
    const int tid = opaque_tid(), lane = tid & 63;
    for (int t = blockIdx.x * 8 + (tid >> 6); t < 2048; t += gridDim.x * 8) {
        const int which = t >> 10, ch = t & 1023, hd = ch >> 8, d = ch & 255;
        float acc[8];
#pragma unroll
        for (int j = 0; j < 8; ++j) acc[j] = 0.f;
        if (which == 0) {
            const float4 q4 = *(const float4*)(wq + ((size_t)hd * DH + d) * DH + 4 * lane);
            const float4 k4 = *(const float4*)(wk + ((size_t)hd * DH + d) * DH + 4 * lane);
            const float qv[4] = {q4.x, q4.y, q4.z, q4.w}, kv[4] = {k4.x * 0.0625f, k4.y * 0.0625f, k4.z * 0.0625f, k4.w * 0.0625f};
#pragma unroll
            for (int e = 0; e < 4; ++e) {
                const float* g1 = wg + (size_t)(hd * DH + 4 * lane + e) * 8; const float* g2 = wg + (size_t)(DM + hd * DH + 4 * lane + e) * 8;
                const float4 a0 = *(const float4*)g1, a1 = *(const float4*)(g1 + 4), b0 = *(const float4*)g2, b1 = *(const float4*)(g2 + 4);
                acc[0] += qv[e] * a0.x + kv[e] * b0.x; acc[1] += qv[e] * a0.y + kv[e] * b0.y; acc[2] += qv[e] * a0.z + kv[e] * b0.z; acc[3] += qv[e] * a0.w + kv[e] * b0.w;
                acc[4] += qv[e] * a1.x + kv[e] * b1.x; acc[5] += qv[e] * a1.y + kv[e] * b1.y; acc[6] += qv[e] * a1.z + kv[e] * b1.z; acc[7] += qv[e] * a1.w + kv[e] * b1.w;
            }
        } else {
            const float4 v4 = *(const float4*)(wv + ((size_t)hd * DH + d) * DH + 4 * lane);
            const float vv[4] = {v4.x, v4.y, v4.z, v4.w};
#pragma unroll
            for (int e = 0; e < 4; ++e) {
                const float* g1 = wg + (size_t)(2 * DM + hd * DH + 4 * lane + e) * 8;
                const float4 a0 = *(const float4*)g1, a1 = *(const float4*)(g1 + 4);
                acc[0] += vv[e] * a0.x; acc[1] += vv[e] * a0.y; acc[2] += vv[e] * a0.z; acc[3] += vv[e] * a0.w;
                acc[4] += vv[e] * a1.x; acc[5] += vv[e] * a1.y; acc[6] += vv[e] * a1.z; acc[7] += vv[e] * a1.w;
            }
        }
#pragma unroll
        for (int j = 0; j < 8; ++j) acc[j] = wave_sum(acc[j]);
        if (lane < 16) {
            float v = 0.f;
#pragma unroll
            for (int j = 0; j < 8; ++j) v = (lane == j) ? acc[j] : v;
            WfT[((size_t)which * 16 + lane) * 1024 + ch] = f2bf(v);
        }
    }
}
DEV void xc_gates_phase(LAS char* shm, const bf16_t* mi, bf16_t* xc, const bf16_t* WfT, const float* cw, const float* cb, float* gpart  ) {
    const int tid = opaque_tid(), wid = __builtin_amdgcn_readfirstlane(tid >> 6), lane = tid & 63, fr = lane & 15, fq = lane >> 4;
    constexpr int WRS = 2064, WIMG = 16 * WRS, STG = 2 * WIMG, SRS_ = 528, STG_W = 19 * SRS_;
    __syncthreads();
    for (int i = tid; i < 2 * 16 * 128; i += 512) {
        const int rowi = i >> 7, pc = i & 127;
        const uint4 v = *(const uint4*)(WfT + (size_t)rowi * 1024 + pc * 8);
        *(LAS u32x4*)(shm + rowi * WRS + pc * 16) = (u32x4){v.x, v.y, v.z, v.w};
    }
    __syncthreads();
    LAS char* stg = shm + STG + wid * STG_W;
    for (int task = blockIdx.x * 8 + wid; task < (MTOK / 16) * 2; task += gridDim.x * 8) {
        const int chalf = task & 1, m0 = (task >> 1) * 16, tpos0 = m0 % SEQ;
        f32x4 acc = (f32x4){0.f, 0.f, 0.f, 0.f};
#pragma nounroll
        for (int sl = 0; sl < 2; ++sl) {
            const int c0 = chalf * 512 + sl * 256;
            for (int i = lane; i < 19 * 32; i += 64) {
                const int row = i >> 5, pc = i & 31;
                uint4 v = make_uint4(0, 0, 0, 0);
                if (tpos0 - 3 + row >= 0) v = *(const uint4*)(mi + (size_t)(m0 - 3 + row) * DM + c0 + pc * 8);
                *(LAS u32x4*)(stg + row * SRS_ + pc * 16) = (u32x4){v.x, v.y, v.z, v.w};
            }
#pragma nounroll
            for (int ks = 0; ks < 8; ++ks) {
                const int cl = 32 * ks + 8 * fq, c = c0 + cl;
                float xv[8], t8[8], w8[8];
                { const float4 b0 = *(const float4*)(cb + c), b1 = *(const float4*)(cb + c + 4);
                  xv[0] = b0.x; xv[1] = b0.y; xv[2] = b0.z; xv[3] = b0.w; xv[4] = b1.x; xv[5] = b1.y; xv[6] = b1.z; xv[7] = b1.w; }
                u32x4 raw3;
#pragma unroll
                for (int tap = 0; tap < 4; ++tap) {
                    const u32x4 rw = *(const LAS u32x4*)(stg + (fr + tap) * SRS_ + cl * 2);
                    if (tap == 3) raw3 = rw;
                    unpack8(make_uint4(rw[0], rw[1], rw[2], rw[3]), t8);
                    const float4 w0 = *(const float4*)(cw + tap * DM + c), w1 = *(const float4*)(cw + tap * DM + c + 4);
                    w8[0] = w0.x; w8[1] = w0.y; w8[2] = w0.z; w8[3] = w0.w; w8[4] = w1.x; w8[5] = w1.y; w8[6] = w1.z; w8[7] = w1.w;
#pragma unroll
                    for (int e = 0; e < 8; ++e) xv[e] += t8[e] * w8[e];
                }
#pragma unroll
                for (int e = 0; e < 8; ++e) xv[e] = siluf_(xv[e]);
                const uint4 xp = pack8(xv);
                *(uint4*)(xc + (size_t)(m0 + fr) * DM + c) = xp;
                const u32x4 xpu = (u32x4){xp.x, xp.y, xp.z, xp.w};
                const bf16x8 bx = *(const LAS bf16x8*)(shm + fr * WRS + c * 2);
                const bf16x8 bv = *(const LAS bf16x8*)(shm + WIMG + fr * WRS + c * 2);
                acc = __builtin_amdgcn_mfma_f32_16x16x32_bf16(*(const bf16x8*)&xpu, bx, acc, 0, 0, 0);
                acc = __builtin_amdgcn_mfma_f32_16x16x32_bf16(*(const bf16x8*)&raw3, bv, acc, 0, 0, 0);
            }
        }
        if (fr < 8) {
#pragma unroll
            for (int r = 0; r < 4; ++r) gpart[((size_t)chalf * MTOK + m0 + 4 * fq + r) * 8 + fr] = acc[r];
        }
    }
}

#define XB_TMO      128
#define XB_XCNT(j)  (256  + 64 * (j))
#define XB_XSUB(j)  (1280 + 64 * (j))
#define XB_XGEN(j)  (2304 + 64 * (j))
#define XB_TOP      3328
#define XB_TOPGEN   3392
#define XCD_BAR_WORDS 3456
#define XB_SPIN_CAP (1u << 18)
DEV unsigned xb_ld(unsigned* p) { return __hip_atomic_load(p, __ATOMIC_RELAXED, __HIP_MEMORY_SCOPE_AGENT); }
DEV unsigned xb_add(unsigned* p, unsigned v) { return __hip_atomic_fetch_add(p, v, __ATOMIC_RELAXED, __HIP_MEMORY_SCOPE_AGENT); }
DEV unsigned xb_xcc_id() { return (unsigned)__builtin_amdgcn_s_getreg((3 << 11) | 20) & 0xFu; }
#define XB_SPIN(cond, bar) do { unsigned _sp = 0; while (cond) { __builtin_amdgcn_s_sleep(1); \
    if ((++_sp & 255u) == 0u) { if (xb_ld(&(bar)[XB_TMO])) break; if (_sp > XB_SPIN_CAP) { atomicAdd(&(bar)[XB_TMO], 1u); break; } } } } while (0)
struct XcdBarrier { unsigned* bar; unsigned x; volatile LAS unsigned* st; };
DEV XcdBarrier xcd_barrier_post(unsigned* bar, volatile LAS unsigned* st) {
    XcdBarrier b; b.bar = bar; b.x = xb_xcc_id(); b.st = st;
    if (threadIdx.x == 0) (void)xb_add(&bar[XB_XCNT(b.x)], 1u);
    return b;
}
DEV void xcd_barrier_complete(unsigned* bar, unsigned x, unsigned& nloc, unsigned& nx) {
    const unsigned G = gridDim.x * gridDim.y * gridDim.z;
    unsigned sum, cnt, mine, sp = 0u;
    for (;;) {
        sum = 0u; cnt = 0u; mine = 0u;
#pragma nounroll
        for (unsigned j = 0; j < 16; ++j) { const unsigned c = xb_ld(&bar[XB_XCNT(j)]); sum += c; cnt += (c > 0u) ? 1u : 0u; }
        mine = xb_ld(&bar[XB_XCNT(x)]);
        if (sum == G) break;
        __builtin_amdgcn_s_sleep(1);
        if ((++sp & 255u) == 0u) { if (xb_ld(&bar[XB_TMO])) break; if (sp > XB_SPIN_CAP) { atomicAdd(&bar[XB_TMO], 1u); break; } }
    }
    nloc = mine > 0u ? mine : 1u; nx = cnt > 0u ? cnt : 1u;
}
DEV void xcd_barrier1(const XcdBarrier& b) {
    asm volatile("s_waitcnt vmcnt(0)" ::: "memory");
    __syncthreads();
    if (threadIdx.x == 0) {
        unsigned* bar = b.bar;
        __builtin_amdgcn_s_waitcnt(0);
        unsigned nloc = b.st[0], nx = b.st[1];
        if (nloc == 0u) { xcd_barrier_complete(bar, b.x, nloc, nx); b.st[0] = nloc; b.st[1] = nx; }
        const unsigned old = xb_add(&bar[XB_XSUB(b.x)], 1u);
        const unsigned gen = old / nloc;
        if (old + 1u == (gen + 1u) * nloc) {
            __builtin_amdgcn_fence(__ATOMIC_RELEASE, "agent");
            asm volatile("s_waitcnt vmcnt(0)" ::: "memory");
            const unsigned og = xb_add(&bar[XB_TOP], 1u);
            const unsigned tg = og / nx;
            if (og + 1u == (tg + 1u) * nx) xb_add(&bar[XB_TOPGEN], 1u);
            else XB_SPIN(xb_ld(&bar[XB_TOPGEN]) == tg, bar);
            __builtin_amdgcn_fence(__ATOMIC_ACQUIRE, "agent");
            xb_add(&bar[XB_XGEN(b.x)], 1u);
            asm volatile("s_waitcnt vmcnt(0)" ::: "memory");
        } else {
            XB_SPIN(xb_ld(&bar[XB_XGEN(b.x)]) == gen, bar);
            __builtin_amdgcn_fence(__ATOMIC_ACQUIRE, "agent");
            asm volatile("s_waitcnt vmcnt(0)" ::: "memory");
        }
    }
    __syncthreads();
}

DEV void xcd_barrier(const XcdBarrier& b) { xcd_barrier1(b); if (REPMASK & 2048) xcd_barrier1(b); }
constexpr int LDS_BYTES = 148 * 1024;
DEV const void* ldptr(LAS char* shm, int i) {
    volatile LAS unsigned* pt = (volatile LAS unsigned*)(shm + LDS_BYTES - 512);
    const unsigned lo = __builtin_amdgcn_readfirstlane(pt[2 * i]), hi = __builtin_amdgcn_readfirstlane(pt[2 * i + 1]);
    return (const void*)(const __attribute__((address_space(1))) void*)(((unsigned long long)hi << 32) | lo);
}
#define PF(i) ((const float*)ldptr(shm, (i)))
struct Params {
    const float *x, *c, *norm_gain, *w_mod, *b_mod, *w_in, *lam_re, *lam_im, *log_dt, *sb_re, *sb_im, *sc_re, *sc_im, *ssm_d, *w_glu, *b_glu, *ssm_og,
        *conv_w, *conv_b, *wq, *wk, *wv, *w_gates, *b_ig, *b_fg, *m_ng, *m_skip, *w_out, *final_gain;
    float* out; char* ws;
};
constexpr int HALF_FLOATS = 56 * 1024 / 4;
constexpr size_t SLOT = (size_t)MTOK * DM * 2;
constexpr size_t W_IN_OFF = 0, W_GLU_OFF = 10485760, W_QKV_OFF = 12582912, W_OUT_OFF = 14155776, MOD_OFF = 20u << 20, IPRE_OFF = 21u << 20, LOGF_OFF = 22u << 20, BAR_OFF = 23u << 20, WF_OFF = 19u << 20, ROWSS_OFF = 24u << 20, RSTD_OFF = 25u << 20;
#define REP(bit) _Pragma("nounroll") for (int rep_ = 0; rep_ < (((REPMASK) & (bit)) ? 2 : 1); ++rep_)
#define FOR_VB(nvb) for (int vb = blockIdx.x * 2 + HALF; vb < (nvb); vb += gridDim.x * 2)

#define WSB ((char*)ldptr(shm, 30))
#define SL(i) ((bf16_t*)(WSB + SLOT * (i)))
#define S7(off) (WSB + SLOT * 7 + (off))
#define WinT ((bf16_t*)S7(W_IN_OFF))
#define WgluT ((bf16_t*)S7(W_GLU_OFF))
#define WqkvT ((bf16_t*)S7(W_QKV_OFF))
#define WoutT ((bf16_t*)S7(W_OUT_OFF))
#define mod ((float*)S7(MOD_OFF))
#define gpart ((float*)S7(IPRE_OFF))
#define WfT ((bf16_t*)S7(WF_OFF))
#define rowss ((float*)S7(ROWSS_OFF))
#define rstdv ((float*)S7(RSTD_OFF))
#define MX SL(1)
#define OUTP ((float*)ldptr(shm, 29))
#define H SL(0)
#define U SL(1)
#define Y SL(2)
#define Z SL(3)
#define XC SL(4)
#define MI SL(5)
#define Q SL(6)
#define Kb SL(1)
#define V SL(2)
#define HC SL(5)
template <int l>
DEV void layer_body(LAS char* shm, const XcdBarrier& gbar) {
        const int wave = opaque_tid() >> 6, lane = opaque_tid() & 63;
        const float* xin = (l == 0) ? PF(0) : OUTP;
        const float* modl = mod + (size_t)l * BATCH * 3 * DM;
        REP(1) { {
            LAS float* scr = (LAS float*)(shm + wave * 16640);
            const float* Win = PF(5) + (size_t)l * DM * INC;
            constexpr int I_IN = 16 * 80, I_GLU = 16 * 16, I_QKV = 12 * 16, I_OUT = 32 * 16;
            for (int it = blockIdx.x * 8 + wave; it < I_IN + I_GLU + I_QKV + I_OUT; it += gridDim.x * 8) {
                int r = it;
                if (r < I_IN) { transpose_item(Win, INC, INC, WinT, DM, scr, r, lane); continue; } r -= I_IN;
                if (r < I_GLU) { transpose_item(PF(14) + (size_t)l * DM * DM, DM, DM, WgluT, DM, scr, r, lane); continue; } r -= I_GLU;
                if (r < I_QKV) { const int mat = r / 16, which = mat >> 2, hd = mat & 3;
                    const float* W = sel3(which, PF(19), PF(20), PF(21)) + ((size_t)l * NH + hd) * DH * DH;
                    transpose_item(W, DH, DH, WqkvT + (size_t)mat * DH * DH, DH, scr, r % 16, lane); continue; } r -= I_QKV;
                transpose_item(PF(27) + (size_t)l * 2 * DM * DM, DM, DM, WoutT, 2 * DM, scr, r, lane);
            }
        }
        wfold_prep(WfT, PF(19) + (size_t)l * NH * DH * DH, PF(20) + (size_t)l * NH * DH * DH, PF(21) + (size_t)l * NH * DH * DH, PF(22) + (size_t)l * 3 * DM * 8);
        __syncthreads();
        s5_tables(shm, (char*)SL(3), PF(6) + l * NG * NP, PF(7) + l * NG * NP, PF(8) + l * NG, PF(9) + (size_t)l * NG * NP * GC, PF(10) + (size_t)l * NG * NP * GC,
                  PF(11) + (size_t)l * NG * GC * NP, PF(12) + (size_t)l * NG * GC * NP);
        __syncthreads();
        norm_rows(xin, PF(2) + l * DM, modl, H);
        }
        xcd_barrier(gbar);
        REP(2) { g8::SchedG1 S_{H, WinT, (int)blockIdx.x, (int)gridDim.x}; g8::EpiG1 E_{U, MI}; g8::gemm_phase(shm, S_, E_); }
        xcd_barrier(gbar);
        REP(256) s5_phase(shm, U, Y, (const char*)SL(3), PF(13) + l * DM);
        REP(8) xc_gates_phase(shm, MI, XC, WfT, PF(17) + l * 4 * DM, PF(18) + l * DM, gpart);
        xcd_barrier(gbar);
        REP(4) { g8::SchedGlu S_{Y, WgluT, (int)blockIdx.x, (int)gridDim.x}; g8::EpiGlu E_{Y, Z, PF(15) + l * DM, rowss}; g8::gemm_phase(shm, S_, E_); }
        xcd_barrier(gbar);
        REP(16) { g8::SchedQkv S_{XC, MI, WqkvT, (int)blockIdx.x, (int)gridDim.x}; g8::EpiQkv E_{Q, Kb, V}; g8::gemm_phase(shm, S_, E_); }
        xcd_barrier(gbar);
        rstd_rows(rowss, rstdv);
        REP(32) mlstm_phase<0>(shm, Q, Kb, V, gpart, PF(23) + l * 4, PF(24) + l * 4, HC);
#ifdef MLPROBE
        if (l == 0) mlstm_phase<MLPROBE>(shm, Q, Kb, V, gpart, PF(23) + l * 4, PF(24) + l * 4, (bf16_t*)OUTP);
#endif
        xcd_barrier(gbar);
        { g8::SchedG2s S_{H, WinT, (int)blockIdx.x}; g8::EpiG2s E_{Z, rstdv, PF(16) + l * DM, MX}; g8::gemm_phase(shm, S_, E_); }
        { g8::SchedG2m S_{H, WinT, (int)blockIdx.x}; g8::EpiG2m E_{HC, XC, PF(25) + l * DM, PF(26) + l * DM, MX}; g8::gemm_phase(shm, S_, E_); }
        xcd_barrier(gbar);
        REP(l == 0 ? 128 : 0) { g8::SchedOut S_{MX, WoutT, (int)blockIdx.x, (int)gridDim.x}; g8::EpiOut E_{xin, OUTP, modl + 2 * DM}; g8::gemm_phase(shm, S_, E_); }
        xcd_barrier(gbar);
    }
__global__ void __launch_bounds__(512, 2) mega(Params Pk) {
    extern __shared__ __attribute__((aligned(16))) unsigned char lds_raw[];
    {
        volatile LAS unsigned long long* pt = (volatile LAS unsigned long long*)((LAS char*)lds_raw + LDS_BYTES - 512);
        if (threadIdx.x == 0) {
            pt[0] = (unsigned long long)Pk.x;
            pt[1] = (unsigned long long)Pk.c;
            pt[2] = (unsigned long long)Pk.norm_gain;
            pt[3] = (unsigned long long)Pk.w_mod;
            pt[4] = (unsigned long long)Pk.b_mod;
            pt[5] = (unsigned long long)Pk.w_in;
            pt[6] = (unsigned long long)Pk.lam_re;
            pt[7] = (unsigned long long)Pk.lam_im;
            pt[8] = (unsigned long long)Pk.log_dt;
            pt[9] = (unsigned long long)Pk.sb_re;
            pt[10] = (unsigned long long)Pk.sb_im;
            pt[11] = (unsigned long long)Pk.sc_re;
            pt[12] = (unsigned long long)Pk.sc_im;
            pt[13] = (unsigned long long)Pk.ssm_d;
            pt[14] = (unsigned long long)Pk.w_glu;
            pt[15] = (unsigned long long)Pk.b_glu;
            pt[16] = (unsigned long long)Pk.ssm_og;
            pt[17] = (unsigned long long)Pk.conv_w;
            pt[18] = (unsigned long long)Pk.conv_b;
            pt[19] = (unsigned long long)Pk.wq;
            pt[20] = (unsigned long long)Pk.wk;
            pt[21] = (unsigned long long)Pk.wv;
            pt[22] = (unsigned long long)Pk.w_gates;
            pt[23] = (unsigned long long)Pk.b_ig;
            pt[24] = (unsigned long long)Pk.b_fg;
            pt[25] = (unsigned long long)Pk.m_ng;
            pt[26] = (unsigned long long)Pk.m_skip;
            pt[27] = (unsigned long long)Pk.w_out;
            pt[28] = (unsigned long long)Pk.final_gain;
            pt[29] = (unsigned long long)Pk.out; pt[30] = (unsigned long long)Pk.ws;
        }
    }
    __syncthreads();
    LAS char* shm = (LAS char*)lds_raw;
    float* ldsf = (float*)lds_raw + HALF * HALF_FLOATS;
    volatile LAS unsigned* bst = (volatile LAS unsigned*)(shm + LDS_BYTES - 16);
    if (threadIdx.x < 4) bst[threadIdx.x] = 0u;
    __syncthreads();
    const XcdBarrier gbar = xcd_barrier_post((unsigned*)((char*)ldptr(shm, 30) + SLOT * 7 + BAR_OFF), bst);
    REP(4096) mod_phase(shm, PF(1), PF(3), PF(4), mod);
    xcd_barrier(gbar);
    layer_body<0>(shm, gbar);
    layer_body<1>(shm, gbar);
    final_rows(OUTP, PF(28));
}

#undef WSB
#undef SL
#undef S7
#undef WinT
#undef WgluT
#undef WqkvT
#undef WoutT
#undef mod
#undef gpart
#undef WfT
#undef rowss
#undef rstdv
#undef MX
#undef OUTP
#undef H
#undef U
#undef Y
#undef Z
#undef XC
#undef MI
#undef Q
#undef Kb
#undef V
#undef HC
extern "C" void kernel_launch(void* const* d_in, const int* in_sizes, int n_in, void* d_out, int out_size, void* d_ws, size_t ws_size, hipStream_t stream) {
    static int grid_blocks = 0;
    if (!grid_blocks) {
        int dev = 0, cus = 0, per_cu = 0;
        (void)hipGetDevice(&dev);
        (void)hipDeviceGetAttribute(&cus, hipDeviceAttributeMultiprocessorCount, dev);
        (void)hipFuncSetAttribute((const void*)mega, hipFuncAttributeMaxDynamicSharedMemorySize, LDS_BYTES);
        (void)hipOccupancyMaxActiveBlocksPerMultiprocessor(&per_cu, (const void*)mega, 512, LDS_BYTES);
        grid_blocks = cus;
        fprintf(stderr, "mega: cus=%d occupancy per_cu=%d grid=%d\n", cus, per_cu, grid_blocks);
    }
    (void)hipMemsetAsync((char*)d_ws + SLOT * 7 + BAR_OFF, 0, XCD_BAR_WORDS * 4, stream);
    Params P{};
    const float** pp = (const float**)&P;
    for (int i = 0; i < 29; ++i) pp[i] = (const float*)d_in[i];
    P.out = (float*)d_out; P.ws = (char*)d_ws;
    void* args[] = {&P};
    hipError_t e = hipLaunchCooperativeKernel((const void*)mega, dim3(grid_blocks), dim3(512), args, LDS_BYTES, stream);
    if (e != hipSuccess) fprintf(stderr, "cooperative launch failed: %s (grid %d)\n", hipGetErrorString(e), grid_blocks);
}
```

```cpp
#include <hip/hip_runtime.h>
#include <cstdio>
#include <cstdint>
#include <hip/hip_cooperative_groups.h>
namespace cg = cooperative_groups;

#ifndef REPMASK
#define REPMASK 0
#endif
typedef unsigned short bf16_t;
#define DEV __device__ __forceinline__

constexpr int BATCH = 8, SEQ = 2048, DM = 1024, MTOK = BATCH * SEQ;
constexpr int NG = 64, NP = 64, GC = 16, NH = 4, DH = 256, CHUNK = 64, INC = 5120;
constexpr float EPS = 1e-6f;

DEV int opaque_tid() { int t = threadIdx.x; asm volatile("" : "+v"(t)); return t; }
#define TIDH (opaque_tid() & 255)
#define HALF (opaque_tid() >> 8)
DEV float bf2f(bf16_t v) { return __uint_as_float(((unsigned)v) << 16); }
typedef __bf16 bf16n2 __attribute__((ext_vector_type(2)));
typedef float f32n2 __attribute__((ext_vector_type(2)));
DEV bf16_t f2bf(float f) { __bf16 b = (__bf16)f; return __builtin_bit_cast(unsigned short, b); }
DEV unsigned pk2(float lo, float hi) { f32n2 v = {lo, hi}; bf16n2 b = __builtin_convertvector(v, bf16n2); return __builtin_bit_cast(unsigned, b); }
DEV float sigmoidf_(float x) { return 1.f / (1.f + __expf(-x)); }
DEV float siluf_(float x) { return x / (1.f + __expf(-x)); }
DEV float geluf_(float x) { const float t2 = 1.5957691216057308f * (x + 0.044715f * x * x * x); return x / (1.f + __expf(-t2)); }
DEV float logsigmoidf_(float x) { return fminf(x, 0.f) - log1pf(__expf(-fabsf(x))); }

DEV float wave_sum(float v) {
#pragma unroll
    for (int o = 1; o < 64; o <<= 1) v += __shfl_xor(v, o);
    return v;
}
DEV float block_sum256(float v, float* red) {
    v = wave_sum(v);
    __syncthreads();
    if ((TIDH & 63) == 0) red[TIDH >> 6] = v;
    __syncthreads();
    return red[0] + red[1] + red[2] + red[3];
}

DEV void k_mod(int vb, float* ldsf, const float* c, const float* w_mod, const float* b_mod, float* mod) {
    float (*sc)[DM] = (float (*)[DM])ldsf;
    const int l = vb / 12, n = (vb % 12) * 256 + TIDH;
    __syncthreads();
    for (int i = TIDH; i < BATCH * DM; i += 256) sc[i / DM][i % DM] = siluf_(c[i]);
    __syncthreads();
    float acc[BATCH];
#pragma unroll
    for (int b = 0; b < BATCH; ++b) acc[b] = 0.f;
    const float* W = w_mod + (size_t)l * DM * 3 * DM;
    for (int k = 0; k < DM; ++k) {
        float w = W[(size_t)k * 3 * DM + n];
#pragma unroll
        for (int b = 0; b < BATCH; ++b) acc[b] += sc[b][k] * w;
    }
#pragma unroll
    for (int b = 0; b < BATCH; ++b) mod[((size_t)l * BATCH + b) * 3 * DM + n] = acc[b] + b_mod[l * 3 * DM + n];
}

DEV void k_norm_mod(int vb, float* red, const float* x, const float* gain, const float* mod  , bf16_t* h) {
    const int m = vb, b = m / SEQ, t = TIDH;
    const float4 v = ((const float4*)(x + (size_t)m * DM))[t];
    float ss = v.x * v.x + v.y * v.y + v.z * v.z + v.w * v.w;
    ss = block_sum256(ss, red);
    const float rstd = rsqrtf(ss * (1.f / DM) + EPS);
    const float* shift = mod + (size_t)b * 3 * DM;
    const float* scale = shift + DM;
    float xv[4] = {v.x, v.y, v.z, v.w};
#pragma unroll
    for (int i = 0; i < 4; ++i) {
        int n = t * 4 + i;
        float y = xv[i] * rstd * gain[n] * (1.f + scale[n]) + shift[n];
        h[(size_t)m * DM + n] = f2bf(y);
    }
}

DEV void k_s5(int item, float* ldsf, const bf16_t* u, bf16_t* y, const float* lam_re, const float* lam_im, const float* log_dt,
                                           const float* b_re, const float* b_im, const float* c_re, const float* c_im, const float* dskip) {
    const int tid_ = opaque_tid();
    float (*part)[17] = (float (*)[17])(ldsf + (tid_ >> 6) * 64 * 17);
    const int g = item & 63, b = item >> 6, p = tid_ & 63;
    const double lr = lam_re[g * NP + p], li = lam_im[g * NP + p], dt = exp((double)log_dt[g]);
    const double er = exp(lr * dt);
    const double ard = er * cos(li * dt), aid = er * sin(li * dt);
    const double dr = ard - 1.0, di = aid, den = lr * lr + li * li;
    const double cr = (dr * lr + di * li) / den, ci = (di * lr - dr * li) / den;
    float bbr[16], bbi[16], ccr[16], cci[16];
#pragma unroll
    for (int c = 0; c < 16; ++c) {
        const double br = b_re[(g * NP + p) * GC + c], bi = b_im[(g * NP + p) * GC + c];
        bbr[c] = (float)(cr * br - ci * bi); bbi[c] = (float)(cr * bi + ci * br);
        ccr[c] = c_re[(g * GC + c) * NP + p]; cci[c] = c_im[(g * GC + c) * NP + p];
    }
    const float ar = (float)ard, ai = (float)aid;
    const float dsk = dskip[g * GC + (p & 15)];
    float sr = 0.f, si = 0.f;
    for (int t = 0; t < SEQ; ++t) {
        const bf16_t* up = u + (size_t)(b * SEQ + t) * DM + g * GC;
        const uint4 u0 = *(const uint4*)up, u1 = *(const uint4*)(up + 8);
        float uf[16];
        uf[0] = bf2f(u0.x & 0xffff); uf[1] = bf2f(u0.x >> 16); uf[2] = bf2f(u0.y & 0xffff); uf[3] = bf2f(u0.y >> 16);
        uf[4] = bf2f(u0.z & 0xffff); uf[5] = bf2f(u0.z >> 16); uf[6] = bf2f(u0.w & 0xffff); uf[7] = bf2f(u0.w >> 16);
        uf[8] = bf2f(u1.x & 0xffff); uf[9] = bf2f(u1.x >> 16); uf[10] = bf2f(u1.y & 0xffff); uf[11] = bf2f(u1.y >> 16);
        uf[12] = bf2f(u1.z & 0xffff); uf[13] = bf2f(u1.z >> 16); uf[14] = bf2f(u1.w & 0xffff); uf[15] = bf2f(u1.w >> 16);
        float bur = 0.f, bui = 0.f;
#pragma unroll
        for (int c = 0; c < 16; ++c) { bur += bbr[c] * uf[c]; bui += bbi[c] * uf[c]; }
        const float nr = ar * sr - ai * si + bur, ni = ar * si + ai * sr + bui;
        sr = nr; si = ni;
#pragma unroll
        for (int c = 0; c < 16; ++c) part[p][c] = ccr[c] * sr - cci[c] * si;
        asm volatile("s_waitcnt lgkmcnt(0)" ::: "memory");
        float s = 0.f;
#pragma unroll
        for (int k = 0; k < 16; ++k) s += part[(p >> 4) * 16 + k][p & 15];
        s += __shfl_xor(s, 16); s += __shfl_xor(s, 32);
        if (p < 16) {
            const float yv = s + dsk * bf2f(up[p]);
            y[(size_t)(b * SEQ + t) * DM + g * GC + p] = f2bf(geluf_(yv));
        }
        asm volatile("s_waitcnt lgkmcnt(0)" ::: "memory");
    }
}

DEV void k_ssm_post(int vb, float* red, bf16_t* z, const bf16_t* sg, const float* gain) {
    const int m = vb, t = TIDH;
    float zv[4]; float ss = 0.f;
#pragma unroll
    for (int i = 0; i < 4; ++i) { zv[i] = bf2f(z[(size_t)m * DM + t * 4 + i]); ss += zv[i] * zv[i]; }
    ss = block_sum256(ss, red);
    const float rstd = rsqrtf(ss * (1.f / DM) + EPS);
#pragma unroll
    for (int i = 0; i < 4; ++i) {
        const int n = t * 4 + i;
        z[(size_t)m * DM + n] = f2bf(zv[i] * rstd * gain[n] * siluf_(bf2f(sg[(size_t)m * DM + n])));
    }
}

DEV float conv_xc(const bf16_t* mi, int m, int n, const float* cw, const float* cb) {
    const int t = m % SEQ;
    float acc = cb[n];
#pragma unroll
    for (int j = 0; j < 4; ++j) {
        const int tt = t - 3 + j;
        if (tt >= 0) acc += bf2f(mi[(size_t)(m - 3 + j) * DM + n]) * cw[j * DM + n];
    }
    return siluf_(acc);
}
DEV void k_conv(int vb, const bf16_t* mi, bf16_t* xc, const float* cw, const float* cb) {
    const size_t idx = (size_t)vb * 256 + TIDH;
    const int m = (int)(idx / DM), n = (int)(idx % DM);
    xc[idx] = f2bf(conv_xc(mi, m, n, cw, cb));
}

DEV void k_gates(int vb, float* ldsf, const bf16_t* q, const bf16_t* k, const bf16_t* v, const float* wg  , const float* bi, const float* bfg,
                                               float* ipre, float* logf) {
    float (*red)[8] = (float (*)[8])ldsf;
    const int m = vb, t = TIDH;
    __syncthreads();
    float acc[8];
#pragma unroll
    for (int j = 0; j < 8; ++j) acc[j] = 0.f;
    for (int e = t; e < 3 * DM; e += 256) {
        const bf16_t* src = (e < DM) ? q : (e < 2 * DM ? k : v);
        const float xv = bf2f(src[(size_t)m * DM + (e & (DM - 1))]);
#pragma unroll
        for (int j = 0; j < 8; ++j) acc[j] += xv * wg[e * 8 + j];
    }
#pragma unroll
    for (int j = 0; j < 8; ++j) acc[j] = wave_sum(acc[j]);
    if ((t & 63) == 0) {
#pragma unroll
        for (int j = 0; j < 8; ++j) red[t >> 6][j] = acc[j];
    }
    __syncthreads();
    if (t < 8) {
        const float s = red[0][t] + red[1][t] + red[2][t] + red[3][t];
        if (t < 4) ipre[(size_t)m * 4 + t] = s + bi[t];
        else logf[(size_t)m * 4 + (t - 4)] = logsigmoidf_(s + bfg[t - 4]);
    }
}

DEV void k_mlstm(int vb, float* ldsf, const bf16_t* q, const bf16_t* k, const bf16_t* v, const float* ipre, const float* logf, bf16_t* hc) {
    float (*Cs)[257] = (float (*)[257])ldsf;
    float (*St)[65] = (float (*)[65])(ldsf + 32 * 257);
    float* nvec = ldsf + 32 * 257 + 64 * 65;
    float* bcum = nvec + 256; float* ig = bcum + 64; float* mt = ig + 64; float* winter = mt + 64; float* ws_ = winter + 64; float* hden = ws_ + 64;
    float* sc = hden + 64;
    const int tid = TIDH;
    const int vs = vb & 7, h = (vb >> 3) & 3, b = vb >> 5;
    __syncthreads();
    for (int i = tid; i < 32 * 257; i += 256) (&Cs[0][0])[i] = 0.f;
    nvec[tid] = 0.f;
    if (tid == 0) sc[0] = 0.f;
    __syncthreads();
    const size_t base = (size_t)b * SEQ * DM + h * DH;
    for (int j = 0; j < SEQ / CHUNK; ++j) {
        const size_t cb = base + (size_t)j * CHUNK * DM;
        const int m0 = b * SEQ + j * CHUNK;
        if (tid < 64) {
            ig[tid] = ipre[(size_t)(m0 + tid) * 4 + h];
            ws_[tid] = logf[(size_t)(m0 + tid) * 4 + h];
        }
        __syncthreads();
        if (tid < 64) { float s = 0.f; for (int i = 0; i <= tid; ++i) s += ws_[i]; bcum[tid] = s; }
        __syncthreads();
        const float m_prev = sc[0];
        if (tid < 64) {
            const float m_inter = bcum[tid] + m_prev;
            float mx = -INFINITY;
            for (int s = 0; s <= tid; ++s) mx = fmaxf(mx, bcum[tid] - bcum[s] + ig[s]);
            const float m = fmaxf(m_inter, mx);
            mt[tid] = m; winter[tid] = __expf(m_inter - m);
        }
        __syncthreads();
        for (int idx = tid; idx < 4096; idx += 256) {
            const int t = idx >> 6, s = idx & 63;
            float r = 0.f;
            if (s <= t) {
                const bf16_t* qp = q + cb + (size_t)t * DM; const bf16_t* kp = k + cb + (size_t)s * DM;
                float dot = 0.f;
                for (int d = 0; d < DH; d += 8) {
                    const uint4 qa = *(const uint4*)(qp + d), ka = *(const uint4*)(kp + d);
                    dot += bf2f(qa.x & 0xffff) * bf2f(ka.x & 0xffff) + bf2f(qa.x >> 16) * bf2f(ka.x >> 16);
                    dot += bf2f(qa.y & 0xffff) * bf2f(ka.y & 0xffff) + bf2f(qa.y >> 16) * bf2f(ka.y >> 16);
                    dot += bf2f(qa.z & 0xffff) * bf2f(ka.z & 0xffff) + bf2f(qa.z >> 16) * bf2f(ka.z >> 16);
                    dot += bf2f(qa.w & 0xffff) * bf2f(ka.w & 0xffff) + bf2f(qa.w >> 16) * bf2f(ka.w >> 16);
                }
                r = dot * __expf(bcum[t] - bcum[s] + ig[s] - mt[t]);
            }
            St[t][s] = r;
        }
        __syncthreads();
        if (tid < 64) {
            const bf16_t* qp = q + cb + (size_t)tid * DM;
            float dn = 0.f;
            for (int d = 0; d < DH; ++d) dn += nvec[d] * bf2f(qp[d]);
            float sm = 0.f;
            for (int s = 0; s < 64; ++s) sm += St[tid][s];
            const float den = winter[tid] * dn + sm;
            hden[tid] = fmaxf(fabsf(den), __expf(-mt[tid]));
        }
        __syncthreads();
        for (int idx = tid; idx < 2048; idx += 256) {
            const int t = idx >> 5, vv = idx & 31;
            const bf16_t* qp = q + cb + (size_t)t * DM;
            float a = 0.f;
            for (int d = 0; d < DH; ++d) a += Cs[vv][d] * bf2f(qp[d]);
            float s2 = 0.f;
            for (int s = 0; s < 64; ++s) s2 += St[t][s] * bf2f(v[cb + (size_t)s * DM + vs * 32 + vv]);
            const float num = winter[t] * a + s2;
            hc[cb + (size_t)t * DM + vs * 32 + vv] = f2bf(num / hden[t]);
        }
        __syncthreads();
        const float b_tot = bcum[63];
        if (tid < 64) ws_[tid] = b_tot - bcum[tid] + ig[tid];
        __syncthreads();
        if (tid == 0) {
            float mx = b_tot + m_prev;
            for (int s = 0; s < 64; ++s) mx = fmaxf(mx, ws_[s]);
            sc[1] = __expf(b_tot + m_prev - mx); sc[0] = mx;
        }
        __syncthreads();
        const float m_next = sc[0], decay = sc[1];
        float myw = 0.f;
        if (tid < 64) myw = __expf(ws_[tid] - m_next);
        __syncthreads();
        if (tid < 64) ws_[tid] = myw;
        __syncthreads();
        for (int idx = tid; idx < 32 * 256; idx += 256) {
            const int vv = idx >> 8, d = idx & 255;
            float a = 0.f;
            for (int s = 0; s < 64; ++s) a += ws_[s] * bf2f(v[cb + (size_t)s * DM + vs * 32 + vv]) * bf2f(k[cb + (size_t)s * DM + d]);
            Cs[vv][d] = decay * Cs[vv][d] + a;
        }
        {
            float a = 0.f;
            for (int s = 0; s < 64; ++s) a += ws_[s] * bf2f(k[cb + (size_t)s * DM + tid]);
            nvec[tid] = decay * nvec[tid] + a;
        }
        __syncthreads();
    }
}

DEV void k_mlstm_post(int vb, bf16_t* hc, const bf16_t* mo, const bf16_t* mg, const bf16_t* mi, const float* cw, const float* cb,
                                                    const float* ngain, const float* skip) {
    const int m = vb, t = TIDH;
    float hv[4]; float s = 0.f;
#pragma unroll
    for (int i = 0; i < 4; ++i) {
        const size_t o = (size_t)m * DM + t * 4 + i;
        hv[i] = bf2f(hc[o]) * sigmoidf_(bf2f(mo[o])); s += hv[i];
    }
    const float mu = wave_sum(s) * (1.f / DH);
    float s2 = 0.f;
#pragma unroll
    for (int i = 0; i < 4; ++i) { hv[i] -= mu; s2 += hv[i] * hv[i]; }
    const float rstd = rsqrtf(wave_sum(s2) * (1.f / DH) + EPS);
#pragma unroll
    for (int i = 0; i < 4; ++i) {
        const int n = t * 4 + i; const size_t o = (size_t)m * DM + n;
        const float xc = conv_xc(mi, m, n, cw, cb);
        const float hn = hv[i] * rstd * ngain[n] + skip[n] * xc;
        hc[o] = f2bf(hn * siluf_(bf2f(mg[o])));
    }
}

DEV void k_final(int vb, float* red, float* x, const float* gain) {
    const int m = vb, t = TIDH;
    float4 v = ((float4*)(x + (size_t)m * DM))[t];
    float ss = v.x * v.x + v.y * v.y + v.z * v.z + v.w * v.w;
    ss = block_sum256(ss, red);
    const float rstd = rsqrtf(ss * (1.f / DM) + EPS);
    const float4 g = ((const float4*)gain)[t];
    v.x *= rstd * g.x; v.y *= rstd * g.y; v.z *= rstd * g.z; v.w *= rstd * g.w;
    ((float4*)(x + (size_t)m * DM))[t] = v;
}


#define LAS __attribute__((address_space(3)))
typedef short bf16x8 __attribute__((ext_vector_type(8)));
typedef float f32x4 __attribute__((ext_vector_type(4)));
typedef short s16x4 __attribute__((ext_vector_type(4)));
typedef unsigned u32x4 __attribute__((ext_vector_type(4)));
typedef unsigned u32x2 __attribute__((ext_vector_type(2)));
typedef float f32x2 __attribute__((ext_vector_type(2)));
#define WAIT_V(n) asm volatile("s_waitcnt vmcnt(" #n ")" ::: "memory")
#define WAIT_L(n) asm volatile("s_waitcnt lgkmcnt(" #n ")" ::: "memory")
#define SCHED() __builtin_amdgcn_sched_barrier(0)

DEV int lds_byte(int r, int c) { int st = (r >> 4) * 2 + (c >> 5), ob = (r & 15) * 64 + (c & 31) * 2; return st * 1024 + (ob ^ (((ob >> 9) & 1) << 5)); }
DEV void stage_rc(int b, int& R, int& C) { int st = b >> 10, sb = b & 1023, swz = sb ^ (((sb >> 9) & 1) << 5); R = (st >> 1) * 16 + swz / 64; C = (st & 1) * 32 + (swz % 64) / 2; }
template <class T> DEV T* sel3(int w, T* p0, T* p1, T* p2) { return p0 + ((w >= 1) ? (p1 - p0) : 0) + ((w >= 2) ? (p2 - p1) : 0); }
DEV void unpack8(const uint4 v, float* f) {
    f[0] = bf2f((bf16_t)(v.x & 0xffff)); f[1] = bf2f((bf16_t)(v.x >> 16)); f[2] = bf2f((bf16_t)(v.y & 0xffff)); f[3] = bf2f((bf16_t)(v.y >> 16));
    f[4] = bf2f((bf16_t)(v.z & 0xffff)); f[5] = bf2f((bf16_t)(v.z >> 16)); f[6] = bf2f((bf16_t)(v.w & 0xffff)); f[7] = bf2f((bf16_t)(v.w >> 16));
}
DEV uint4 pack8(const float* f) { return make_uint4(pk2(f[0], f[1]), pk2(f[2], f[3]), pk2(f[4], f[5]), pk2(f[6], f[7])); }
DEV uint2 pack4(f32x4 v) { uint2 r; r.x = pk2(v[0], v[1]); r.y = pk2(v[2], v[3]); return r; }

struct GemmCtx { int wid, lane, wr, wc, fr, fq; int sR[4], sC[4]; };
DEV GemmCtx gemm_ctx() {
    GemmCtx c; const int tid = opaque_tid();
    c.wid = __builtin_amdgcn_readfirstlane(tid >> 6); c.lane = tid & 63; c.wr = c.wid >> 2; c.wc = c.wid & 3; c.fr = c.lane & 15; c.fq = c.lane >> 4;
#pragma unroll
    for (int i = 0; i < 4; ++i) stage_rc(c.wid * 1024 + i * 8192 + c.lane * 16, c.sR[i], c.sC[i]);
    return c;
}
DEV void gemm_mainloop(LAS char* shm, const GemmCtx& c, const bf16_t* A1row, const bf16_t* A2row, int ktsplit, int lda, const bf16_t* Bb, int ldb, int nt, f32x4 (&acc)[8][4]) {
    constexpr int TILE_B = 256 * 64 * 2, STAGE_B = 2 * TILE_B;
    const int wid = c.wid, wr = c.wr, wc = c.wc, fr = c.fr, fq = c.fq;
    unsigned voA[4], voB[4];
#pragma unroll
    for (int i = 0; i < 4; ++i) { voA[i] = (unsigned)(c.sR[i] * lda + c.sC[i]) * 2u; voB[i] = (unsigned)(c.sR[i] * ldb + c.sC[i]) * 2u; asm volatile("" : "+v"(voA[i]), "+v"(voB[i])); }
#define GLDS_STAGE(buf, kt) do { const char* Ak_ = (const char*)(((kt) < ktsplit) ? (A1row + (kt) * 64) : (A2row + ((kt) - ktsplit) * 64)); const char* Bk_ = (const char*)(Bb + (kt) * 64); \
        _Pragma("unroll") for (int i = 0; i < 4; ++i) { \
            __builtin_amdgcn_global_load_lds((const unsigned*)(Ak_ + voA[i]), (LAS unsigned*)(shm + (buf) * STAGE_B + wid * 1024 + i * 8192), 16, 0, 0); \
            __builtin_amdgcn_global_load_lds((const unsigned*)(Bk_ + voB[i]), (LAS unsigned*)(shm + (buf) * STAGE_B + TILE_B + wid * 1024 + i * 8192), 16, 0, 0); } } while (0)
#pragma unroll
    for (int m = 0; m < 8; ++m)
#pragma unroll
        for (int n = 0; n < 4; ++n) acc[m][n] = (f32x4){0.f, 0.f, 0.f, 0.f};
    GLDS_STAGE(0, 0); WAIT_V(0); __syncthreads();
#pragma nounroll
    for (int kt = 0; kt < nt; ++kt) {
        const int cur = kt & 1;
        if (kt + 1 < nt) GLDS_STAGE(cur ^ 1, kt + 1);
#pragma unroll
        for (int ks = 0; ks < 2; ++ks) {
            bf16x8 At[8], Bf[4];
#pragma unroll
            for (int m = 0; m < 8; ++m) At[m] = *(const LAS bf16x8*)(shm + cur * STAGE_B + lds_byte(wr * 128 + m * 16 + fr, ks * 32 + fq * 8));
#pragma unroll
            for (int n = 0; n < 4; ++n) Bf[n] = *(const LAS bf16x8*)(shm + cur * STAGE_B + TILE_B + lds_byte(wc * 64 + n * 16 + fr, ks * 32 + fq * 8));
#pragma unroll
            for (int m = 0; m < 8; ++m)
#pragma unroll
                for (int n = 0; n < 4; ++n) acc[m][n] = __builtin_amdgcn_mfma_f32_16x16x32_bf16(Bf[n], At[m], acc[m][n], 0, 0, 0);
            SCHED();
        }
        WAIT_V(0); __syncthreads();
    }
#undef GLDS_STAGE
}
DEV void tile_map(int t, int nN, int& pm, int& pn) {
    const int base = t & ~255, loc = t & 255;
    const int w = base + (loc & 7) * 32 + (loc >> 3);
    const int nig = 8 * nN, gid = w / nig;
    pm = gid * 8 + (w % nig) % 8; pn = (w % nig) / 8;
}
template <class Prob>
DEV void gemm_phase(LAS char* shm, const Prob& pb) {
    const GemmCtx c = gemm_ctx();
    const int nN = pb.nN, ntiles = 64 * nN;
    for (int t = blockIdx.x; t < ntiles; t += gridDim.x) {
        int pm, pn; tile_map(t, nN, pm, pn);
        const int brow = pm * 256, bcol = pn * 256;
        f32x4 acc[8][4];
        gemm_mainloop(shm, c, pb.a1(pn) + (long)brow * Prob::lda, pb.a2(pn) + (long)brow * Prob::lda, Prob::ktsplit, Prob::lda, pb.bptr(pn), Prob::ldb, Prob::K / 64, acc);
        pb.epi_begin(shm, c, pn, brow);
#pragma unroll
        for (int m = 0; m < 8; ++m)
#pragma unroll
            for (int n = 0; n < 4; ++n) pb.epi(pn, brow + c.wr * 128 + m * 16 + c.fr, bcol + c.wc * 64 + n * 16 + c.fq * 4, acc[m][n]);
        pb.epi_end(c, pn, brow, acc);
    }
}

struct ProbG1 {
    static constexpr int K = 1024, lda = 1024, ldb = 1024, ktsplit = 1 << 20;
    const bf16_t* H; const bf16_t* Wt; bf16_t* U; bf16_t* MI; int nN;
    DEV const bf16_t* a1(int pn) const { return H; }
    DEV const bf16_t* a2(int pn) const { return H; }
    DEV const bf16_t* bptr(int pn) const { return Wt + (long)((pn < 4) ? pn * 256 : 2048 + (pn - 4) * 256) * 1024; }
    DEV void epi_begin(LAS char*, const GemmCtx&, int, int) const {}
    DEV void epi(int pn, int row, int col, f32x4 v) const { bf16_t* C = (pn < 4) ? U : MI; *(uint2*)(C + (size_t)row * DM + (col & 1023)) = pack4(v); }
    DEV void epi_end(const GemmCtx&, int, int, f32x4 (&)[8][4]) const {}
};
struct ProbGlu {
    static constexpr int K = 1024, lda = 1024, ldb = 1024, ktsplit = 1 << 20;
    const bf16_t* Y; const bf16_t* Wt; bf16_t* Z; const float* bias; float* rowss; int nN;
    DEV const bf16_t* a1(int pn) const { return Y; }
    DEV const bf16_t* a2(int pn) const { return Y; }
    DEV const bf16_t* bptr(int pn) const { return Wt + (long)pn * 256 * 1024; }
    DEV void epi_begin(LAS char*, const GemmCtx&, int, int) const {}
    DEV void epi(int pn, int row, int col, f32x4 v) const {}
    DEV void epi_end(const GemmCtx& c0, int pn, int brow, f32x4 (&acc)[8][4]) const {
        struct { int fr, fq, wr, wc; } c = {c0.fr, c0.fq, c0.wr, c0.wc};
        asm volatile("" : "+v"(c.fr), "+v"(c.fq));
#pragma unroll
        for (int m = 0; m < 8; ++m) {
            SCHED();
            const int row = brow + c.wr * 128 + m * 16 + c.fr;
            float ss = 0.f;
#pragma unroll
            for (int n = 0; n < 4; ++n) {
                const int col = pn * 256 + c.wc * 64 + n * 16 + c.fq * 4;
                const uint2 yv = *(const uint2*)(Y + (size_t)row * DM + col);
                const float4 b = *(const float4*)(bias + col);
                f32x4 o;
                o[0] = bf2f(yv.x & 0xffff) * sigmoidf_(acc[m][n][0] + b.x); o[1] = bf2f(yv.x >> 16) * sigmoidf_(acc[m][n][1] + b.y);
                o[2] = bf2f(yv.y & 0xffff) * sigmoidf_(acc[m][n][2] + b.z); o[3] = bf2f(yv.y >> 16) * sigmoidf_(acc[m][n][3] + b.w);
                const uint2 pk = pack4(o);
                *(uint2*)(Z + (size_t)row * DM + col) = pk;
                const float r0 = bf2f(pk.x & 0xffff), r1 = bf2f(pk.x >> 16), r2 = bf2f(pk.y & 0xffff), r3 = bf2f(pk.y >> 16);
                ss += r0 * r0 + r1 * r1 + r2 * r2 + r3 * r3;
            }
            ss += __shfl_xor(ss, 16); ss += __shfl_xor(ss, 32);
            if (c.fq == 0) rowss[(size_t)(pn * 4 + c.wc) * MTOK + row] = ss;
        }
    }
};
struct ProbQkv {
    static constexpr int K = 256, lda = 1024, ldb = 256, ktsplit = 1 << 20;
    const bf16_t* XC; const bf16_t* MI; const bf16_t* Wt; bf16_t* Q; bf16_t* Kk; bf16_t* V; int nN;
    DEV const bf16_t* a1(int pn) const { return ((pn >> 2) == 2 ? MI : XC) + (pn & 3) * 256; }
    DEV const bf16_t* a2(int pn) const { return a1(pn); }
    DEV const bf16_t* bptr(int pn) const { return Wt + (long)pn * 256 * 256; }
    DEV void epi_begin(LAS char*, const GemmCtx&, int, int) const {}
    DEV void epi(int pn, int row, int col, f32x4 v) const {
        const int which = pn >> 2; bf16_t* C = sel3(which, Q, Kk, V);
        if (which == 1) { v[0] *= 0.0625f; v[1] *= 0.0625f; v[2] *= 0.0625f; v[3] *= 0.0625f; }
        *(uint2*)(C + (size_t)row * DM + (col & 1023)) = pack4(v);
    }
    DEV void epi_end(const GemmCtx&, int, int, f32x4 (&)[8][4]) const {}
};
struct ProbOut {
    static constexpr int K = 2048, lda = 1024, ldb = 2048, ktsplit = 16;
    const bf16_t* A1; const bf16_t* A2; const bf16_t* Wt; const float* xin; float* xout; const float* gate; int nN;
    DEV const bf16_t* a1(int pn) const { return A1; }
    DEV const bf16_t* a2(int pn) const { return A2; }
    DEV const bf16_t* bptr(int pn) const { return Wt + (long)pn * 256 * 2048; }
    DEV void epi_begin(LAS char*, const GemmCtx&, int, int) const {}
    DEV void epi(int pn, int row, int col, f32x4 v) const {
        const int b = row / SEQ;
        const float4 xi = *(const float4*)(xin + (size_t)row * DM + col);
        const float4 g = *(const float4*)(gate + (size_t)b * 3 * DM + col);
        float4 o; o.x = xi.x + g.x * v[0]; o.y = xi.y + g.y * v[1]; o.z = xi.z + g.z * v[2]; o.w = xi.w + g.w * v[3];
        *(float4*)(xout + (size_t)row * DM + col) = o;
    }
    DEV void epi_end(const GemmCtx&, int, int, f32x4 (&)[8][4]) const {}
};

struct G2Args {
    const bf16_t* H; const bf16_t* Wt;
    bf16_t* Z; const float* rowss; const float* og;
    bf16_t* HC; const bf16_t* XC; const float* ngain; const float* skip;
};
DEV void gemm2_phase(LAS char* shm, const G2Args& g) {
    const GemmCtx c = gemm_ctx();
    int efr, efq;
    LAS float* rst = (LAS float*)(shm + 131072);
    LAS float* red = (LAS float*)(shm + 131072 + 1024);
    for (int u = blockIdx.x; u < 512; u += gridDim.x) {
        f32x4 acc[8][4];
        if (u < 256) {
            int pm, pn; tile_map(u, 4, pm, pn);
            const int brow = pm * 256, bcol = pn * 256;
            gemm_mainloop(shm, c, g.H + (long)brow * DM, g.H, 1 << 20, DM, g.Wt + (long)(1024 + bcol) * DM, DM, 16, acc);
            efr = c.fr; efq = c.fq; asm volatile("" : "+v"(efr), "+v"(efq));
            { const int tid = c.wid * 64 + c.lane;
              if (tid < 256) { float s_ = 0.f;
#pragma unroll
                  for (int p_ = 0; p_ < 16; ++p_) s_ += g.rowss[(size_t)p_ * MTOK + brow + tid];
                  rst[tid] = rsqrtf(s_ * (1.f / DM) + EPS); } }
            __syncthreads();
#pragma unroll
            for (int m = 0; m < 8; ++m) {
                SCHED();
                const int rl = c.wr * 128 + m * 16 + efr, row = brow + rl;
                const float rs = rst[rl];
#pragma unroll
                for (int n = 0; n < 4; ++n) {
                    const int col = bcol + c.wc * 64 + n * 16 + efq * 4;
                    const uint2 zv = *(const uint2*)(g.Z + (size_t)row * DM + col);
                    const float4 gn = *(const float4*)(g.og + col);
                    f32x4 o;
                    o[0] = bf2f(zv.x & 0xffff) * rs * gn.x * siluf_(acc[m][n][0]); o[1] = bf2f(zv.x >> 16) * rs * gn.y * siluf_(acc[m][n][1]);
                    o[2] = bf2f(zv.y & 0xffff) * rs * gn.z * siluf_(acc[m][n][2]); o[3] = bf2f(zv.y >> 16) * rs * gn.w * siluf_(acc[m][n][3]);
                    *(uint2*)(g.Z + (size_t)row * DM + col) = pack4(o);
                }
            }
            __syncthreads();
        } else {
            int pm, hd; tile_map(u - 256, 4, pm, hd);
            const int brow = pm * 256, bcol = hd * 256;
            gemm_mainloop(shm, c, g.H + (long)brow * DM, g.H, 1 << 20, DM, g.Wt + (long)(3072 + bcol) * DM, DM, 16, acc);
            efr = c.fr; efq = c.fq; asm volatile("" : "+v"(efr), "+v"(efq));
        #pragma unroll
            for (int m = 0; m < 8; ++m) {
                SCHED();
                const int row = brow + c.wr * 128 + m * 16 + efr;
                float s_ = 0.f;
#pragma unroll
                for (int n = 0; n < 4; ++n) {
                    const int col = bcol + c.wc * 64 + n * 16 + efq * 4;
                    const uint2 hv = *(const uint2*)(g.HC + (size_t)row * DM + col);
                    acc[m][n][0] = bf2f(hv.x & 0xffff) * sigmoidf_(acc[m][n][0]); acc[m][n][1] = bf2f(hv.x >> 16) * sigmoidf_(acc[m][n][1]);
                    acc[m][n][2] = bf2f(hv.y & 0xffff) * sigmoidf_(acc[m][n][2]); acc[m][n][3] = bf2f(hv.y >> 16) * sigmoidf_(acc[m][n][3]);
                    s_ += (acc[m][n][0] + acc[m][n][1]) + (acc[m][n][2] + acc[m][n][3]);
                }
                s_ += __shfl_xor(s_, 16); s_ += __shfl_xor(s_, 32);
                if (efq == 0) red[c.wid * 128 + m * 16 + efr] = s_;
            }
            __syncthreads();
#pragma unroll
            for (int m = 0; m < 8; ++m) {
                SCHED();
                float tot = 0.f;
#pragma unroll
                for (int w2 = 0; w2 < 4; ++w2) tot += red[(c.wr * 4 + w2) * 128 + m * 16 + efr];
                const float mu = tot * (1.f / DH);
                float s_ = 0.f;
#pragma unroll
                for (int n = 0; n < 4; ++n)
#pragma unroll
                    for (int j = 0; j < 4; ++j) { acc[m][n][j] -= mu; s_ += acc[m][n][j] * acc[m][n][j]; }
                s_ += __shfl_xor(s_, 16); s_ += __shfl_xor(s_, 32);
                if (efq == 0) red[1024 + c.wid * 128 + m * 16 + efr] = s_;
            }
            __syncthreads();
#pragma unroll
            for (int m = 0; m < 8; ++m) {
                SCHED();
                const int row = brow + c.wr * 128 + m * 16 + efr;
                float tot = 0.f;
#pragma unroll
                for (int w2 = 0; w2 < 4; ++w2) tot += red[1024 + (c.wr * 4 + w2) * 128 + m * 16 + efr];
                const float rs = rsqrtf(tot * (1.f / DH) + EPS);
#pragma unroll
                for (int n = 0; n < 4; ++n) {
                    const int col = bcol + c.wc * 64 + n * 16 + efq * 4;
                    const uint2 xv = *(const uint2*)(g.XC + (size_t)row * DM + col);
                    const float4 gn = *(const float4*)(g.ngain + col), sk = *(const float4*)(g.skip + col);
                    f32x4 o;
                    o[0] = acc[m][n][0] * rs * gn.x + sk.x * bf2f(xv.x & 0xffff); o[1] = acc[m][n][1] * rs * gn.y + sk.y * bf2f(xv.x >> 16);
                    o[2] = acc[m][n][2] * rs * gn.z + sk.z * bf2f(xv.y & 0xffff); o[3] = acc[m][n][3] * rs * gn.w + sk.w * bf2f(xv.y >> 16);
                    *(uint2*)(g.HC + (size_t)row * DM + col) = pack4(o);
                }
            }
            gemm_mainloop(shm, c, g.H + (long)brow * DM, g.H, 1 << 20, DM, g.Wt + (long)(4096 + bcol) * DM, DM, 16, acc);
            efr = c.fr; efq = c.fq; asm volatile("" : "+v"(efr), "+v"(efq));
#pragma unroll
            for (int m = 0; m < 8; ++m) {
                SCHED();
                const int row = brow + c.wr * 128 + m * 16 + efr;
#pragma unroll
                for (int n = 0; n < 4; ++n) {
                    const int col = bcol + c.wc * 64 + n * 16 + efq * 4;
                    const uint2 hv = *(const uint2*)(g.HC + (size_t)row * DM + col);
                    f32x4 o;
                    o[0] = bf2f(hv.x & 0xffff) * siluf_(acc[m][n][0]); o[1] = bf2f(hv.x >> 16) * siluf_(acc[m][n][1]);
                    o[2] = bf2f(hv.y & 0xffff) * siluf_(acc[m][n][2]); o[3] = bf2f(hv.y >> 16) * siluf_(acc[m][n][3]);
                    *(uint2*)(g.HC + (size_t)row * DM + col) = pack4(o);
                }
            }
        }
    }
}


namespace g8 {
constexpr int BK = 64, HALFT = 128, HTB = HALFT * BK * 2;
DEV int perm32(int rho) { const int n = rho >> 4, i = rho & 15; return 8 * (i >> 2) + 4 * n + (i & 3); }
struct Unit { const char* A; const char* B; int pm, pn, tag; };
template <class Epi, class Sched>
DEV void gemm_phase(LAS char* lds, const Sched& S, const Epi& E) {
    const int tid = opaque_tid(), wid = __builtin_amdgcn_readfirstlane(tid >> 6), lane = tid & 63, wr = wid >> 2, wc = wid & 3, fr = lane & 15, fq = lane >> 4;
    constexpr int lda = Sched::lda, ldb = Sched::ldb, nt = Sched::K / BK;
    unsigned voffA[2], voffB[2];
#pragma unroll
    for (int i = 0; i < 2; ++i) { int R, C; stage_rc(tid * 16 + i * 8192, R, C); const int Rb = (R & ~31) + perm32(R & 31);
        voffA[i] = (unsigned)(R * lda + C) * 2u; voffB[i] = (unsigned)(Rb * ldb + C) * 2u; asm volatile("" : "+v"(voffA[i]), "+v"(voffB[i])); }
    constexpr size_t kstep = (size_t)(BK * 2), hstepA = (size_t)HALFT * lda * 2, hstepB = (size_t)HALFT * ldb * 2;
    const unsigned ldsw = (unsigned)wid * 1024u;
    const int aoff = lds_byte(wr * 64 + fr, fq * 8), boff = lds_byte(wc * 32 + fr, fq * 8);
#define G8_SA(b, h) (((b) * 2 + (h)) * HTB)
#define G8_SB(b, h) ((4 + (b) * 2 + (h)) * HTB)
#define G8_STAGE(bufoff, gbase, voff) do { _Pragma("unroll") for (int _i = 0; _i < 2; ++_i) \
        __builtin_amdgcn_global_load_lds((const unsigned*)((const char*)(gbase) + (voff)[_i]), (LAS unsigned*)(lds + (bufoff) + ldsw + _i * 8192), 16, 0, 0); } while (0)
#define G8_LDA(dst, b, h) do { _Pragma("unroll") for (int m = 0; m < 4; ++m) _Pragma("unroll") for (int k = 0; k < 2; ++k) dst[m][k] = *(const LAS bf16x8*)(lds + G8_SA(b, h) + aoff + m * 2048 + k * 1024); } while (0)
#define G8_LDB(dst, b, h) do { _Pragma("unroll") for (int n = 0; n < 2; ++n) _Pragma("unroll") for (int k = 0; k < 2; ++k) dst[n][k] = *(const LAS bf16x8*)(lds + G8_SB(b, h) + boff + n * 2048 + k * 1024); } while (0)
#define G8_MMA(ai, bj, At, Bt) do { __builtin_amdgcn_s_setprio(1); _Pragma("unroll") for (int m = 0; m < 4; ++m) _Pragma("unroll") for (int n = 0; n < 2; ++n) _Pragma("unroll") for (int k = 0; k < 2; ++k) \
        acc[ai][bj][m][n] = __builtin_amdgcn_mfma_f32_16x16x32_bf16(Bt[n][k], At[m][k], acc[ai][bj][m][n], 0, 0, 0); __builtin_amdgcn_s_setprio(0); } while (0)
#define G8_WAIT_V(n) asm volatile("s_waitcnt vmcnt(" #n ")" ::: "memory")
#define G8_WAIT_L(n) asm volatile("s_waitcnt lgkmcnt(" #n ")" ::: "memory")
#define G8_BAR __builtin_amdgcn_s_barrier()
#define G8_SCHED __builtin_amdgcn_sched_barrier(0)
    Unit cur, nxt; int ui = 0;
    if (!S.next(0, cur)) return;
    f32x4 acc[2][2][4][2];
#pragma unroll
    for (int a = 0; a < 2; ++a)
#pragma unroll
        for (int b = 0; b < 2; ++b)
#pragma unroll
            for (int m = 0; m < 4; ++m)
#pragma unroll
                for (int n = 0; n < 2; ++n) acc[a][b][m][n] = (f32x4){0.f, 0.f, 0.f, 0.f};
    bf16x8 At[4][2], B0[2][2], B1[2][2];
    const char* cA = cur.A; const char* cB = cur.B;
    G8_STAGE(G8_SB(0, 0), cB, voffB); G8_STAGE(G8_SB(0, 1), cB + hstepB, voffB); G8_STAGE(G8_SA(0, 0), cA, voffA); G8_STAGE(G8_SA(0, 1), cA + hstepA, voffA);
    if (wr == 1) G8_BAR;
    G8_WAIT_V(2); G8_BAR;
    G8_STAGE(G8_SB(1, 0), cB + kstep, voffB); G8_STAGE(G8_SA(1, 0), cA + kstep, voffA); G8_STAGE(G8_SB(1, 1), cB + hstepB + kstep, voffB);
    G8_WAIT_V(6); G8_BAR;
    for (;;) {
        const bool has_next = S.next(ui + 1, nxt);
        const char* nA = has_next ? nxt.A : cA; const char* nB = has_next ? nxt.B : cB;
#pragma nounroll
        for (int t = 0; t < nt; t += 2) {
            const bool last = (t == nt - 2);
            const char* a1 = cA + (size_t)(t + 1) * kstep;
            const char* a2 = last ? nA : cA + (size_t)(t + 2) * kstep; const char* b2 = last ? nB : cB + (size_t)(t + 2) * kstep;
            const char* a3 = a2 + kstep; const char* b3 = b2 + kstep;
            G8_LDB(B0, 0, 0); G8_LDB(B1, 0, 1); G8_SCHED; G8_LDA(At, 0, 0); G8_STAGE(G8_SA(1, 1), a1 + hstepA, voffA);
            G8_WAIT_V(8); G8_WAIT_L(0); G8_BAR; G8_MMA(0, 0, At, B0); G8_MMA(0, 1, At, B1); G8_BAR; G8_SCHED;
            G8_LDA(At, 0, 1); G8_STAGE(G8_SB(0, 0), b2, voffB); G8_STAGE(G8_SB(0, 1), b2 + hstepB, voffB); G8_STAGE(G8_SA(0, 0), a2, voffA);
            G8_WAIT_V(8); G8_WAIT_L(0); G8_BAR; G8_MMA(1, 0, At, B0); G8_MMA(1, 1, At, B1); G8_BAR; G8_SCHED;
            G8_LDB(B0, 1, 0); G8_LDB(B1, 1, 1); G8_SCHED; G8_LDA(At, 1, 0); G8_STAGE(G8_SA(0, 1), a2 + hstepA, voffA);
            G8_WAIT_V(8); G8_WAIT_L(0); G8_BAR; G8_MMA(0, 0, At, B0); G8_MMA(0, 1, At, B1); G8_BAR; G8_SCHED;
            G8_LDA(At, 1, 1); G8_STAGE(G8_SB(1, 0), b3, voffB); G8_STAGE(G8_SB(1, 1), b3 + hstepB, voffB); G8_STAGE(G8_SA(1, 0), a3, voffA);
            G8_WAIT_V(8); G8_WAIT_L(0); G8_BAR; G8_MMA(1, 0, At, B0); G8_MMA(1, 1, At, B1); G8_BAR; G8_SCHED;
        }
        if (wr == 0) G8_BAR;
        E(lds, acc, cur, wr, wc, fr, fq, wid, lane);
        if (!has_next) break;
#pragma unroll
        for (int a = 0; a < 2; ++a)
#pragma unroll
            for (int b = 0; b < 2; ++b)
#pragma unroll
                for (int m = 0; m < 4; ++m)
#pragma unroll
                    for (int n = 0; n < 2; ++n) acc[a][b][m][n] = (f32x4){0.f, 0.f, 0.f, 0.f};
        cur = nxt; cA = nA; cB = nB; ++ui;
        if (wr == 1) G8_BAR;
    }
    G8_WAIT_V(0);
    G8_BAR;
#undef G8_SA
#undef G8_SB
#undef G8_STAGE
#undef G8_LDA
#undef G8_LDB
#undef G8_MMA
#undef G8_WAIT_V
#undef G8_WAIT_L
#undef G8_BAR
#undef G8_SCHED
}
DEV u32x4 pk8(const f32x4 a, const f32x4 b) { return (u32x4){pk2(a[0], a[1]), pk2(a[2], a[3]), pk2(b[0], b[1]), pk2(b[2], b[3])}; }
DEV void un8(const u32x4 v, float* f) { unpack8(make_uint4(v[0], v[1], v[2], v[3]), f); }
#define G8_ROWS_BEGIN _Pragma("unroll") for (int ai = 0; ai < 2; ++ai) _Pragma("unroll") for (int m = 0; m < 4; ++m) { const int rl = 128 * ai + 64 * wr + 16 * m + fr;
#define G8_ROWS_END }

struct SchedG1 { static constexpr int K = 1024, lda = 1024, ldb = 1024; const bf16_t* H; const bf16_t* Wt; int bid, G;
    DEV bool next(int i, Unit& u) const { const int t = bid + i * G; if (t >= 512) return false; int pm, pn; tile_map(t, 8, pm, pn);
        u.pm = pm; u.pn = pn; u.tag = 0; u.A = (const char*)(H + (size_t)pm * 256 * DM); u.B = (const char*)(Wt + (size_t)((pn < 4) ? pn * 256 : 2048 + (pn - 4) * 256) * DM); return true; } };
struct EpiG1 { bf16_t* U; bf16_t* MI;
    DEV void operator()(LAS char*, const f32x4 (&acc)[2][2][4][2], const Unit& u, int wr, int wc, int fr, int fq, int, int) const {
        bf16_t* C = (u.pn < 4) ? U : MI; const int c0 = (u.pn & 3) * 256 + 32 * wc + 8 * fq;
        G8_ROWS_BEGIN bf16_t* rp = C + (size_t)(u.pm * 256 + rl) * DM + c0;
#pragma unroll
            for (int bj = 0; bj < 2; ++bj) *(u32x4*)(rp + 128 * bj) = pk8(acc[ai][bj][m][0], acc[ai][bj][m][1]); G8_ROWS_END } };
struct SchedGlu { static constexpr int K = 1024, lda = 1024, ldb = 1024; const bf16_t* Y; const bf16_t* Wt; int bid, G;
    DEV bool next(int i, Unit& u) const { const int t = bid + i * G; if (t >= 256) return false; int pm, pn; tile_map(t, 4, pm, pn);
        u.pm = pm; u.pn = pn; u.tag = 0; u.A = (const char*)(Y + (size_t)pm * 256 * DM); u.B = (const char*)(Wt + (size_t)pn * 256 * DM); return true; } };
struct EpiGlu { const bf16_t* Y; bf16_t* Z; const float* bias; float* rowss;
    DEV void operator()(LAS char*, const f32x4 (&acc)[2][2][4][2], const Unit& u, int wr, int wc, int fr, int fq, int, int) const {
        const int c0 = u.pn * 256 + 32 * wc + 8 * fq;
        G8_ROWS_BEGIN const size_t ro = (size_t)(u.pm * 256 + rl) * DM + c0; float ss = 0.f;
#pragma unroll
            for (int bj = 0; bj < 2; ++bj) {
                float y8[8]; un8(*(const u32x4*)(Y + ro + 128 * bj), y8);
                const float4 b0 = *(const float4*)(bias + c0 + 128 * bj), b1 = *(const float4*)(bias + c0 + 128 * bj + 4);
                f32x4 o0, o1;
                o0[0] = y8[0] * sigmoidf_(acc[ai][bj][m][0][0] + b0.x); o0[1] = y8[1] * sigmoidf_(acc[ai][bj][m][0][1] + b0.y); o0[2] = y8[2] * sigmoidf_(acc[ai][bj][m][0][2] + b0.z); o0[3] = y8[3] * sigmoidf_(acc[ai][bj][m][0][3] + b0.w);
                o1[0] = y8[4] * sigmoidf_(acc[ai][bj][m][1][0] + b1.x); o1[1] = y8[5] * sigmoidf_(acc[ai][bj][m][1][1] + b1.y); o1[2] = y8[6] * sigmoidf_(acc[ai][bj][m][1][2] + b1.z); o1[3] = y8[7] * sigmoidf_(acc[ai][bj][m][1][3] + b1.w);
                const u32x4 pk = pk8(o0, o1); *(u32x4*)(Z + ro + 128 * bj) = pk;
                float r8[8]; un8(pk, r8);
#pragma unroll
                for (int e = 0; e < 8; ++e) ss += r8[e] * r8[e];
            }
            ss += __shfl_xor(ss, 16); ss += __shfl_xor(ss, 32);
            if (fq == 0) rowss[(size_t)(u.pn * 4 + wc) * MTOK + u.pm * 256 + rl] = ss; G8_ROWS_END } };
struct SchedQkv { static constexpr int K = 256, lda = 1024, ldb = 256; const bf16_t* XC; const bf16_t* MI; const bf16_t* Wt; int bid, G;
    DEV bool next(int i, Unit& u) const { const int t = bid + i * G; if (t >= 768) return false; int pm, pn; tile_map(t, 12, pm, pn);
        u.pm = pm; u.pn = pn; u.tag = 0; u.A = (const char*)(((pn >> 2) == 2 ? MI : XC) + (size_t)pm * 256 * DM + (pn & 3) * 256); u.B = (const char*)(Wt + (size_t)pn * 256 * 256); return true; } };
struct EpiQkv { bf16_t* Q; bf16_t* Kk; bf16_t* V;
    DEV void operator()(LAS char*, const f32x4 (&acc)[2][2][4][2], const Unit& u, int wr, int wc, int fr, int fq, int, int) const {
        const int which = u.pn >> 2; bf16_t* C = sel3(which, Q, Kk, V); const float sc = (which == 1) ? 0.0625f : 1.f;
        const int c0 = (u.pn & 3) * 256 + 32 * wc + 8 * fq;
        G8_ROWS_BEGIN bf16_t* rp = C + (size_t)(u.pm * 256 + rl) * DM + c0;
#pragma unroll
            for (int bj = 0; bj < 2; ++bj) *(u32x4*)(rp + 128 * bj) = pk8(acc[ai][bj][m][0] * sc, acc[ai][bj][m][1] * sc); G8_ROWS_END } };
struct SchedOut { static constexpr int K = 2048, lda = 2048, ldb = 2048; const bf16_t* MX; const bf16_t* Wt; int bid, G;
    DEV bool next(int i, Unit& u) const { const int t = bid + i * G; if (t >= 256) return false; int pm, pn; tile_map(t, 4, pm, pn);
        u.pm = pm; u.pn = pn; u.tag = 0; u.A = (const char*)(MX + (size_t)pm * 256 * 2048); u.B = (const char*)(Wt + (size_t)pn * 256 * 2048); return true; } };
template <bool FINAL>
struct EpiOutN { const float* xin; float* xout; const float* gate; const float* ngain; const float* modn; bf16_t* Hn; float* xss; unsigned* cnt; unsigned* tmo;
    DEV void operator()(LAS char* lds, f32x4 (&acc)[2][2][4][2], const Unit& u, int wr, int wc, int fr, int fq, int wid, int lane) const {
        asm volatile("" : "+v"(fr), "+v"(fq));
        LAS float* red = (LAS float*)(lds + 131072);
        LAS float* rst = (LAS float*)(lds + 131072 + 4096);
        const int c0 = u.pn * 256 + 32 * wc + 8 * fq, bidx = (u.pm * 256) / SEQ; const float* gp = gate + (size_t)bidx * 3 * DM + c0;
        G8_ROWS_BEGIN const size_t ro = (size_t)(u.pm * 256 + rl) * DM + c0; float ss = 0.f;
#pragma unroll
            for (int bj = 0; bj < 2; ++bj)
#pragma unroll
                for (int n = 0; n < 2; ++n) {
                    const float4 xi = *(const float4*)(xin + ro + 128 * bj + 4 * n), g4 = *(const float4*)(gp + 128 * bj + 4 * n);
                    f32x4 o; o[0] = xi.x + g4.x * acc[ai][bj][m][n][0]; o[1] = xi.y + g4.y * acc[ai][bj][m][n][1]; o[2] = xi.z + g4.z * acc[ai][bj][m][n][2]; o[3] = xi.w + g4.w * acc[ai][bj][m][n][3];
                    acc[ai][bj][m][n] = o; ss += (o[0] * o[0] + o[1] * o[1]) + (o[2] * o[2] + o[3] * o[3]);
                    if (!FINAL) *(float4*)(xout + ro + 128 * bj + 4 * n) = make_float4(o[0], o[1], o[2], o[3]); }
            ss += __shfl_xor(ss, 16); ss += __shfl_xor(ss, 32);
            if (fq == 0) red[wid * 128 + 64 * ai + 16 * m + fr] = ss; G8_ROWS_END
        asm volatile("s_waitcnt lgkmcnt(0)" ::: "memory"); __builtin_amdgcn_s_barrier();
        const int tid = wid * 64 + lane;
        if (tid < 256) {
            const int r_ = tid, w0 = (r_ >> 6) & 1, ix = (r_ & 63) + 64 * (r_ >> 7);
            const float t_ = red[(w0 * 4 + 0) * 128 + ix] + red[(w0 * 4 + 1) * 128 + ix] + red[(w0 * 4 + 2) * 128 + ix] + red[(w0 * 4 + 3) * 128 + ix];
            __hip_atomic_store(xss + ((size_t)(u.pm * 256 + r_) * 4 + u.pn), t_, __ATOMIC_RELAXED, __HIP_MEMORY_SCOPE_AGENT);
        }
        asm volatile("s_waitcnt vmcnt(0)" ::: "memory"); __builtin_amdgcn_s_barrier();
        if (tid == 0) {
            __hip_atomic_fetch_add(cnt + 64 * u.pm, 1u, __ATOMIC_RELAXED, __HIP_MEMORY_SCOPE_AGENT);
            unsigned sp_ = 0;
            while (__hip_atomic_load(cnt + 64 * u.pm, __ATOMIC_RELAXED, __HIP_MEMORY_SCOPE_AGENT) < 4u) { __builtin_amdgcn_s_sleep(1); if (++sp_ > (1u << 22)) { atomicAdd(tmo, 1u); break; } }
        }
        __builtin_amdgcn_s_barrier();
        if (tid < 256) {
            const float* xp = xss + (size_t)(u.pm * 256 + tid) * 4;
            const float t_ = __hip_atomic_load(xp, __ATOMIC_RELAXED, __HIP_MEMORY_SCOPE_AGENT) + __hip_atomic_load(xp + 1, __ATOMIC_RELAXED, __HIP_MEMORY_SCOPE_AGENT)
                           + __hip_atomic_load(xp + 2, __ATOMIC_RELAXED, __HIP_MEMORY_SCOPE_AGENT) + __hip_atomic_load(xp + 3, __ATOMIC_RELAXED, __HIP_MEMORY_SCOPE_AGENT);
            rst[tid] = rsqrtf(t_ * (1.f / DM) + EPS);
        }
        asm volatile("s_waitcnt vmcnt(0) lgkmcnt(0)" ::: "memory"); __builtin_amdgcn_s_barrier();
        const float* shp = modn + (size_t)bidx * 3 * DM + c0;
        G8_ROWS_BEGIN const size_t ro = (size_t)(u.pm * 256 + rl) * DM + c0; const float rs = rst[rl];
#pragma unroll
            for (int bj = 0; bj < 2; ++bj) {
                const float4 g0 = *(const float4*)(ngain + c0 + 128 * bj), g1 = *(const float4*)(ngain + c0 + 128 * bj + 4);
                if (FINAL) {
                    *(float4*)(xout + ro + 128 * bj) = make_float4(acc[ai][bj][m][0][0] * rs * g0.x, acc[ai][bj][m][0][1] * rs * g0.y, acc[ai][bj][m][0][2] * rs * g0.z, acc[ai][bj][m][0][3] * rs * g0.w);
                    *(float4*)(xout + ro + 128 * bj + 4) = make_float4(acc[ai][bj][m][1][0] * rs * g1.x, acc[ai][bj][m][1][1] * rs * g1.y, acc[ai][bj][m][1][2] * rs * g1.z, acc[ai][bj][m][1][3] * rs * g1.w);
                } else {
                    const float4 h0 = *(const float4*)(shp + 128 * bj), h1 = *(const float4*)(shp + 128 * bj + 4), s0 = *(const float4*)(shp + DM + 128 * bj), s1 = *(const float4*)(shp + DM + 128 * bj + 4);
                    f32x4 o0, o1;
                    o0[0] = acc[ai][bj][m][0][0] * rs * g0.x * (1.f + s0.x) + h0.x; o0[1] = acc[ai][bj][m][0][1] * rs * g0.y * (1.f + s0.y) + h0.y; o0[2] = acc[ai][bj][m][0][2] * rs * g0.z * (1.f + s0.z) + h0.z; o0[3] = acc[ai][bj][m][0][3] * rs * g0.w * (1.f + s0.w) + h0.w;
                    o1[0] = acc[ai][bj][m][1][0] * rs * g1.x * (1.f + s1.x) + h1.x; o1[1] = acc[ai][bj][m][1][1] * rs * g1.y * (1.f + s1.y) + h1.y; o1[2] = acc[ai][bj][m][1][2] * rs * g1.z * (1.f + s1.z) + h1.z; o1[3] = acc[ai][bj][m][1][3] * rs * g1.w * (1.f + s1.w) + h1.w;
                    *(u32x4*)(Hn + ro + 128 * bj) = pk8(o0, o1);
                } } G8_ROWS_END
    } };
struct SchedG2s { static constexpr int K = 1024, lda = 1024, ldb = 1024; const bf16_t* H; const bf16_t* Wt; int bid;
    DEV bool next(int i, Unit& u) const { if (i >= 1) return false; int pm, pn; tile_map(bid, 4, pm, pn);
        u.pm = pm; u.pn = pn; u.tag = 0; u.A = (const char*)(H + (size_t)pm * 256 * DM); u.B = (const char*)(Wt + (size_t)(1024 + pn * 256) * DM); return true; } };
struct SchedG2m { static constexpr int K = 1024, lda = 1024, ldb = 1024; const bf16_t* H; const bf16_t* Wt; int bid;
    DEV bool next(int i, Unit& u) const { if (i >= 2) return false; int pm, pn; tile_map(bid, 4, pm, pn);
        u.pm = pm; u.pn = pn; u.tag = i + 1; u.A = (const char*)(H + (size_t)pm * 256 * DM); u.B = (const char*)(Wt + (size_t)((i == 0 ? 3072 : 4096) + pn * 256) * DM); return true; } };
struct EpiG2s { const bf16_t* Z; const float* rstd; const float* og; bf16_t* MX;
    DEV void operator()(LAS char* lds, f32x4 (&acc)[2][2][4][2], const Unit& u, int wr, int wc, int fr, int fq, int wid, int lane) const {
        asm volatile("" : "+v"(fr), "+v"(fq));
        const int c0 = u.pn * 256 + 32 * wc + 8 * fq;
        {
            G8_ROWS_BEGIN const int row = u.pm * 256 + rl; const float rs = rstd[row];
#pragma unroll
                for (int bj = 0; bj < 2; ++bj) {
                    float z8[8]; un8(*(const u32x4*)(Z + (size_t)row * DM + c0 + 128 * bj), z8);
                    const float4 g0 = *(const float4*)(og + c0 + 128 * bj), g1 = *(const float4*)(og + c0 + 128 * bj + 4);
                    f32x4 o0, o1;
                    o0[0] = z8[0] * rs * g0.x * siluf_(acc[ai][bj][m][0][0]); o0[1] = z8[1] * rs * g0.y * siluf_(acc[ai][bj][m][0][1]); o0[2] = z8[2] * rs * g0.z * siluf_(acc[ai][bj][m][0][2]); o0[3] = z8[3] * rs * g0.w * siluf_(acc[ai][bj][m][0][3]);
                    o1[0] = z8[4] * rs * g1.x * siluf_(acc[ai][bj][m][1][0]); o1[1] = z8[5] * rs * g1.y * siluf_(acc[ai][bj][m][1][1]); o1[2] = z8[6] * rs * g1.z * siluf_(acc[ai][bj][m][1][2]); o1[3] = z8[7] * rs * g1.w * siluf_(acc[ai][bj][m][1][3]);
                    *(u32x4*)(MX + (size_t)row * 2048 + c0 + 128 * bj) = pk8(o0, o1); } G8_ROWS_END
        }
    } };
struct EpiG2m { const bf16_t* HC; const bf16_t* XC; const float* ngain; const float* skip; bf16_t* MX;
    DEV void operator()(LAS char* lds, f32x4 (&acc)[2][2][4][2], const Unit& u, int wr, int wc, int fr, int fq, int wid, int lane) const {
        asm volatile("" : "+v"(fr), "+v"(fq));
        const int c0 = u.pn * 256 + 32 * wc + 8 * fq;
        if (u.tag == 1) {
            LAS float* red = (LAS float*)(lds + 131072);
            G8_ROWS_BEGIN const int row = u.pm * 256 + rl; float s1 = 0.f, s2 = 0.f;
#pragma unroll
                for (int bj = 0; bj < 2; ++bj) {
                    float h8[8]; un8(*(const u32x4*)(HC + (size_t)row * DM + c0 + 128 * bj), h8);
#pragma unroll
                    for (int n = 0; n < 2; ++n)
#pragma unroll
                        for (int j = 0; j < 4; ++j) { const float v = h8[4 * n + j] * sigmoidf_(acc[ai][bj][m][n][j]); acc[ai][bj][m][n][j] = v; s1 += v; s2 += v * v; }
                }
                s1 += __shfl_xor(s1, 16); s1 += __shfl_xor(s1, 32); s2 += __shfl_xor(s2, 16); s2 += __shfl_xor(s2, 32);
                if (fq == 0) *(LAS f32x2*)(red + ((wid * 128) + 64 * ai + 16 * m + fr) * 2) = (f32x2){s1, s2}; G8_ROWS_END
            asm volatile("s_waitcnt lgkmcnt(0)" ::: "memory"); __builtin_amdgcn_s_barrier();
            G8_ROWS_BEGIN const int row = u.pm * 256 + rl; float t1 = 0.f, t2 = 0.f;
#pragma unroll
                for (int w2 = 0; w2 < 4; ++w2) { const f32x2 p_ = *(const LAS f32x2*)(red + (((wr * 4 + w2) * 128) + 64 * ai + 16 * m + fr) * 2); t1 += p_.x; t2 += p_.y; }
                const float mu = t1 * (1.f / DH), rs = rsqrtf(fmaxf(t2 * (1.f / DH) - mu * mu, 0.f) + EPS);
#pragma unroll
                for (int bj = 0; bj < 2; ++bj) {
                    float x8[8]; un8(*(const u32x4*)(XC + (size_t)row * DM + c0 + 128 * bj), x8);
                    const float4 g0 = *(const float4*)(ngain + c0 + 128 * bj), g1 = *(const float4*)(ngain + c0 + 128 * bj + 4), k0 = *(const float4*)(skip + c0 + 128 * bj), k1 = *(const float4*)(skip + c0 + 128 * bj + 4);
                    f32x4 o0, o1;
                    o0[0] = (acc[ai][bj][m][0][0] - mu) * rs * g0.x + k0.x * x8[0]; o0[1] = (acc[ai][bj][m][0][1] - mu) * rs * g0.y + k0.y * x8[1]; o0[2] = (acc[ai][bj][m][0][2] - mu) * rs * g0.z + k0.z * x8[2]; o0[3] = (acc[ai][bj][m][0][3] - mu) * rs * g0.w + k0.w * x8[3];
                    o1[0] = (acc[ai][bj][m][1][0] - mu) * rs * g1.x + k1.x * x8[4]; o1[1] = (acc[ai][bj][m][1][1] - mu) * rs * g1.y + k1.y * x8[5]; o1[2] = (acc[ai][bj][m][1][2] - mu) * rs * g1.z + k1.z * x8[6]; o1[3] = (acc[ai][bj][m][1][3] - mu) * rs * g1.w + k1.w * x8[7];
                    *(u32x4*)(MX + (size_t)row * 2048 + 1024 + c0 + 128 * bj) = pk8(o0, o1); } G8_ROWS_END
        } else {
            G8_ROWS_BEGIN const int row = u.pm * 256 + rl;
#pragma unroll
                for (int bj = 0; bj < 2; ++bj) {
                    bf16_t* pp = MX + (size_t)row * 2048 + 1024 + c0 + 128 * bj;
                    float h8[8]; un8(*(const u32x4*)pp, h8);
                    f32x4 o0, o1;
                    o0[0] = h8[0] * siluf_(acc[ai][bj][m][0][0]); o0[1] = h8[1] * siluf_(acc[ai][bj][m][0][1]); o0[2] = h8[2] * siluf_(acc[ai][bj][m][0][2]); o0[3] = h8[3] * siluf_(acc[ai][bj][m][0][3]);
                    o1[0] = h8[4] * siluf_(acc[ai][bj][m][1][0]); o1[1] = h8[5] * siluf_(acc[ai][bj][m][1][1]); o1[2] = h8[6] * siluf_(acc[ai][bj][m][1][2]); o1[3] = h8[7] * siluf_(acc[ai][bj][m][1][3]);
                    *(u32x4*)pp = pk8(o0, o1); } G8_ROWS_END
        }
    } };
}
DEV void rstd_rows(const float* rowss, float* rstd) {
    const int tid = opaque_tid();
    for (int r = blockIdx.x * 512 + tid; r < MTOK; r += gridDim.x * 512) { float s_ = 0.f;
#pragma unroll
        for (int p_ = 0; p_ < 16; ++p_) s_ += rowss[(size_t)p_ * MTOK + r];
        rstd[r] = rsqrtf(s_ * (1.f / DM) + EPS); }
}

DEV void transpose_item(const float* W, int ldw, int ncols, bf16_t* WT, int ldwt, LAS float* scr, int item, int lane) {
    const int nblk = ncols / 64, kb = item / nblk, nb = item % nblk, k0 = 64 * kb, n0 = 64 * nb;
    float4 v[16];
#pragma unroll
    for (int i = 0; i < 16; ++i) v[i] = *(const float4*)(W + (size_t)(k0 + 4 * i + (lane >> 4)) * ldw + n0 + 4 * (lane & 15));
#pragma unroll
    for (int i = 0; i < 16; ++i) { LAS float* d_ = scr + (4 * i + (lane >> 4)) * 65 + 4 * (lane & 15); d_[0] = v[i].x; d_[1] = v[i].y; d_[2] = v[i].z; d_[3] = v[i].w; }
    asm volatile("s_waitcnt lgkmcnt(0)" ::: "memory");
#pragma unroll
    for (int j = 0; j < 8; ++j) {
        const int n = (lane >> 3) + 8 * j, c = lane & 7;
        const LAS float* s_ = scr + (8 * c) * 65 + n;
        uint4 o;
        o.x = pk2(s_[0 * 65], s_[1 * 65]); o.y = pk2(s_[2 * 65], s_[3 * 65]); o.z = pk2(s_[4 * 65], s_[5 * 65]); o.w = pk2(s_[6 * 65], s_[7 * 65]);
        *(uint4*)(WT + (size_t)(n0 + n) * ldwt + k0 + 8 * c) = o;
    }
    asm volatile("s_waitcnt lgkmcnt(0)" ::: "memory");
}

DEV float wave_scan_add(float v, int lane) {
#pragma unroll
    for (int o = 1; o < 64; o <<= 1) { const float u = __shfl_up(v, o); if (lane >= o) v += u; }
    return v;
}
DEV float wave_scan_max(float v, int lane) {
#pragma unroll
    for (int o = 1; o < 64; o <<= 1) { const float u = __shfl_up(v, o); if (lane >= o) v = fmaxf(v, u); }
    return v;
}

template <int TT>
DEV void mlstm_a_wave(LAS char* shm, int fr, int fq, float m_prev, const LAS float* tpj, const LAS float* taj, f32x4 (&nacc)[3]) {
    constexpr int QS = 0, KS = 33792, VT = 67584, RS = 528, VRS = 96, NT = TT + 1;
    const LAS char* qb = shm + QS + (16 * TT + fr) * RS + fq * 16;
    const LAS char* kb = shm + KS + fr * RS + fq * 16;
    f32x4 sacc[NT];
#pragma unroll
    for (int jj = 0; jj < NT; ++jj) sacc[jj] = (f32x4){0.f, 0.f, 0.f, 0.f};
    bf16x8 qf = *(const LAS bf16x8*)qb, kf[NT];
#pragma unroll
    for (int jj = 0; jj < NT; ++jj) kf[jj] = *(const LAS bf16x8*)(kb + jj * 16 * RS);
#pragma unroll
    for (int ks = 0; ks < 8; ++ks) {
        bf16x8 qn = qf, kn[NT];
#pragma unroll
        for (int jj = 0; jj < NT; ++jj) kn[jj] = kf[jj];
        if (ks < 7) {
            qn = *(const LAS bf16x8*)(qb + (ks + 1) * 64);
#pragma unroll
            for (int jj = 0; jj < NT; ++jj) kn[jj] = *(const LAS bf16x8*)(kb + jj * 16 * RS + (ks + 1) * 64);
        }
#pragma unroll
        for (int jj = 0; jj < NT; ++jj) sacc[jj] = __builtin_amdgcn_mfma_f32_16x16x32_bf16(kf[jj], qf, sacc[jj], 0, 0, 0);
        qf = qn;
#pragma unroll
        for (int jj = 0; jj < NT; ++jj) kf[jj] = kn[jj];
    }
    constexpr int NK = (TT >= 2) ? 2 : 1;
    s16x4 vlo[NK][3], vhi[NK][3];
#pragma unroll
    for (int kk = 0; kk < NK; ++kk)
#pragma unroll
        for (int vt = 0; vt < 3; ++vt) {
            vlo[kk][vt] = __builtin_amdgcn_ds_read_tr16_b64_v4i16((LAS s16x4*)(shm + VT + (32 * kk + 4 * fq + (fr >> 2)) * VRS + (16 * vt + 4 * (fr & 3)) * 2));
            vhi[kk][vt] = __builtin_amdgcn_ds_read_tr16_b64_v4i16((LAS s16x4*)(shm + VT + (32 * kk + 16 + 4 * fq + (fr >> 2)) * VRS + (16 * vt + 4 * (fr & 3)) * 2));
        }
    const int t = 16 * TT + fr;
    const float btm = -fmaxf(m_prev, tpj[t]);
    f32x4 sm[2 * NK];
#pragma unroll
    for (int jj = 0; jj < 2 * NK; ++jj) {
        if (jj < NT) {
            const f32x4 a4 = *(const LAS f32x4*)(taj + 16 * jj + 4 * fq);
#pragma unroll
            for (int r = 0; r < 4; ++r) {
                const int s_ = 16 * jj + 4 * fq + r;
                sm[jj][r] = (jj < TT || s_ <= t) ? sacc[jj < NT ? jj : 0][r] * __expf(btm + a4[r]) : 0.f;
            }
        } else sm[jj] = (f32x4){0.f, 0.f, 0.f, 0.f};
    }
#pragma unroll
    for (int kk = 0; kk < NK; ++kk) {
        const u32x4 u = (u32x4){pk2(sm[2 * kk][0], sm[2 * kk][1]), pk2(sm[2 * kk][2], sm[2 * kk][3]), pk2(sm[2 * kk + 1][0], sm[2 * kk + 1][1]), pk2(sm[2 * kk + 1][2], sm[2 * kk + 1][3])};
        const bf16x8 af = *(const bf16x8*)&u;
#pragma unroll
        for (int vt = 0; vt < 3; ++vt) {
            bf16x8 bv8; bv8[0] = vlo[kk][vt][0]; bv8[1] = vlo[kk][vt][1]; bv8[2] = vlo[kk][vt][2]; bv8[3] = vlo[kk][vt][3];
            bv8[4] = vhi[kk][vt][0]; bv8[5] = vhi[kk][vt][1]; bv8[6] = vhi[kk][vt][2]; bv8[7] = vhi[kk][vt][3];
            nacc[vt] = __builtin_amdgcn_mfma_f32_16x16x32_bf16(af, bv8, nacc[vt], 0, 0, 0);
        }
    }
}
DEV void mlstm_b_wave(LAS char* shm, int tt, int fr, int fq, f32x4 (&nacc)[3]) {
    constexpr int QS = 0, CB = 81408, RS = 528;
    const LAS char* qb = shm + QS + (16 * tt + fr) * RS + fq * 16;
    const LAS char* cbp = shm + CB + fr * RS + fq * 16;
    bf16x8 qf = *(const LAS bf16x8*)qb, cf[3];
#pragma unroll
    for (int vt = 0; vt < 3; ++vt) cf[vt] = *(const LAS bf16x8*)(cbp + vt * 16 * RS);
#pragma unroll
    for (int ks = 0; ks < 8; ++ks) {
        bf16x8 qn = qf, cn[3] = {cf[0], cf[1], cf[2]};
        if (ks < 7) {
            qn = *(const LAS bf16x8*)(qb + (ks + 1) * 64);
#pragma unroll
            for (int vt = 0; vt < 3; ++vt) cn[vt] = *(const LAS bf16x8*)(cbp + vt * 16 * RS + (ks + 1) * 64);
        }
#pragma unroll
        for (int vt = 0; vt < 3; ++vt) nacc[vt] = __builtin_amdgcn_mfma_f32_16x16x32_bf16(qf, cf[vt], nacc[vt], 0, 0, 0);
        qf = qn;
#pragma unroll
        for (int vt = 0; vt < 3; ++vt) cf[vt] = cn[vt];
    }
}
template <int SKIP>
DEV void mlstm_phase(LAS char* shm, const bf16_t* q, const bf16_t* k, const bf16_t* v, const float* gpart, const float* b_ig, const float* b_fg, bf16_t* hc) {
    const int tid = opaque_tid(), wid = __builtin_amdgcn_readfirstlane(tid >> 6), lane = tid & 63, fr = lane & 15, fq = lane >> 4;
    constexpr int QS = 0, KS = 33792, VT = 67584, VWT = 74496, CB = 81408, PART = 106752, TB = 120064, TA = 128256, TP = 136448, TC = 144640, HST = 144896, RS = 528, VRS = 96, PRS = 52;
    LAS float* part = (LAS float*)(shm + PART);
    LAS float* tb = (LAS float*)(shm + TB); LAS float* ta = (LAS float*)(shm + TA); LAS float* tp = (LAS float*)(shm + TP); LAS float* tc = (LAS float*)(shm + TC);
    for (int item = blockIdx.x; item < BATCH * NH * 8; item += gridDim.x) {
        const int vs = (item >> 3) & 7, bh = (item & 7) + 8 * (item >> 6), h = bh & 3, b = bh >> 2;
        __syncthreads();
        for (int i = tid; i < (CB + 25344 - VT) / 4; i += 512) ((LAS unsigned*)(shm + VT))[i] = 0u;
        for (int j = wid; j < SEQ / CHUNK; j += 8) {
            const int m = b * SEQ + j * CHUNK + lane;
            const float* gp = gpart + (size_t)m * 8;
            const float ig = gp[h] + gp[(size_t)MTOK * 8 + h] + b_ig[h];
            const float lf = logsigmoidf_(gp[4 + h] + gp[(size_t)MTOK * 8 + 4 + h] + b_fg[h]);
            const float bc = wave_scan_add(lf, lane);
            const float a_ = ig - bc;
            const float pm = wave_scan_max(a_, lane);
            tb[j * 64 + lane] = bc; ta[j * 64 + lane] = a_; tp[j * 64 + lane] = pm;
            if (lane == 63) { tc[2 * j] = bc; tc[2 * j + 1] = pm; }
        }
        __syncthreads();
        if (tid < 64) *(LAS u32x4*)(shm + VT + tid * VRS + 64) = (u32x4){0x3F80u, 0u, 0u, 0u};
        f32x4 cacc[2][3];
#pragma unroll
        for (int i = 0; i < 2; ++i)
#pragma unroll
            for (int vt = 0; vt < 3; ++vt) cacc[i][vt] = (f32x4){0.f, 0.f, 0.f, 0.f};
        float m_prev = 0.f;
        const size_t cb0 = ((size_t)(b * SEQ)) * DM + h * DH;
        uint4 qv[4], kv[4], vv = make_uint4(0, 0, 0, 0);
#pragma unroll
        for (int i = 0; i < 4; ++i) {
            const int idx = tid + 512 * i, row = idx >> 5, c16 = idx & 31;
            qv[i] = *(const uint4*)(q + cb0 + (size_t)row * DM + c16 * 8);
            kv[i] = *(const uint4*)(k + cb0 + (size_t)row * DM + c16 * 8);
        }
        if (tid < 256) vv = *(const uint4*)(v + cb0 + (size_t)(tid >> 2) * DM + vs * 32 + (tid & 3) * 8);
#pragma nounroll
        for (int j = 0; j < SEQ / CHUNK; ++j) {
            const size_t cb = cb0 + (size_t)j * CHUNK * DM;
            const float btot = tc[2 * j], amax = tc[2 * j + 1];
            const float mxc = fmaxf(m_prev, amax);
#pragma unroll
            for (int i = 0; i < ((SKIP & 8) ? 0 : 4); ++i) {
                const int idx = tid + 512 * i, row = idx >> 5, c16 = idx & 31;
                *(LAS u32x4*)(shm + QS + row * RS + c16 * 16) = (u32x4){qv[i].x, qv[i].y, qv[i].z, qv[i].w};
                *(LAS u32x4*)(shm + KS + row * RS + c16 * 16) = (u32x4){kv[i].x, kv[i].y, kv[i].z, kv[i].w};
            }
            if (tid < 256) {
                const int s_ = tid >> 2, v0 = (tid & 3) * 8;
                const float ws = __expf(ta[j * 64 + s_] - mxc);
                float f8[8]; unpack8(vv, f8);
#pragma unroll
                for (int e = 0; e < 8; ++e) f8[e] *= ws;
                const uint4 wv = pack8(f8);
                *(LAS u32x4*)(shm + VT + s_ * VRS + v0 * 2) = (u32x4){vv.x, vv.y, vv.z, vv.w};
                *(LAS u32x4*)(shm + VWT + s_ * VRS + v0 * 2) = (u32x4){wv.x, wv.y, wv.z, wv.w};
            } else if (tid < 320) {
                const int s_ = tid - 256;
                *(LAS u32x4*)(shm + VWT + s_ * VRS + 64) = (u32x4){(unsigned)f2bf(__expf(ta[j * 64 + s_] - mxc)), 0u, 0u, 0u};
            }
            if (j + 1 < SEQ / CHUNK) {
                const size_t cn = cb + (size_t)CHUNK * DM;
#pragma unroll
                for (int i = 0; i < 4; ++i) {
                    const int idx = tid + 512 * i, row = idx >> 5, c16 = idx & 31;
                    qv[i] = *(const uint4*)(q + cn + (size_t)row * DM + c16 * 8);
                    kv[i] = *(const uint4*)(k + cn + (size_t)row * DM + c16 * 8);
                }
                if (tid < 256) vv = *(const uint4*)(v + cn + (size_t)(tid >> 2) * DM + vs * 32 + (tid & 3) * 8);
            }
            __syncthreads();
            f32x4 nacc[3];
#pragma unroll
            for (int vt = 0; vt < 3; ++vt) nacc[vt] = (f32x4){0.f, 0.f, 0.f, 0.f};
            const int tt = wid & 3;
            if (wid < 4) { if (!(SKIP & 1)) {
                const LAS float* tpj = tp + j * 64; const LAS float* taj = ta + j * 64;
                if (tt == 0) mlstm_a_wave<0>(shm, fr, fq, m_prev, tpj, taj, nacc);
                else if (tt == 1) mlstm_a_wave<1>(shm, fr, fq, m_prev, tpj, taj, nacc);
                else if (tt == 2) mlstm_a_wave<2>(shm, fr, fq, m_prev, tpj, taj, nacc);
                else mlstm_a_wave<3>(shm, fr, fq, m_prev, tpj, taj, nacc);
            } } else if (!(SKIP & 2)) {
                mlstm_b_wave(shm, tt, fr, fq, nacc);
                const f32x4 pm4 = *(const LAS f32x4*)(tp + j * 64 + 16 * tt + 4 * fq);
#pragma unroll
                for (int vt = 0; vt < 3; ++vt)
#pragma unroll
                    for (int r = 0; r < 4; ++r) part[(16 * tt + 4 * fq + r) * PRS + 16 * vt + fr] = __expf(m_prev - fmaxf(m_prev, pm4[r])) * nacc[vt][r];
            }
            if (!(SKIP & 4)) {
                const float decay = __expf(m_prev - mxc);
#pragma unroll
                for (int i = 0; i < 2; ++i)
#pragma unroll
                    for (int vt = 0; vt < 3; ++vt) cacc[i][vt] *= decay;
                const int q_ = fr >> 2, p_ = fr & 3;
                s16x4 wl[2][3], wh[2][3], kl[2][2], kh[2][2];
#pragma unroll
                for (int kk = 0; kk < 2; ++kk) {
#pragma unroll
                    for (int vt = 0; vt < 3; ++vt) {
                        wl[kk][vt] = __builtin_amdgcn_ds_read_tr16_b64_v4i16((LAS s16x4*)(shm + VWT + (32 * kk + 8 * fq + q_) * VRS + (16 * vt + 4 * p_) * 2));
                        wh[kk][vt] = __builtin_amdgcn_ds_read_tr16_b64_v4i16((LAS s16x4*)(shm + VWT + (32 * kk + 8 * fq + 4 + q_) * VRS + (16 * vt + 4 * p_) * 2));
                    }
#pragma unroll
                    for (int i = 0; i < 2; ++i) {
                        const int dt = 2 * wid + i;
                        kl[kk][i] = __builtin_amdgcn_ds_read_tr16_b64_v4i16((LAS s16x4*)(shm + KS + (32 * kk + 8 * fq + q_) * RS + (16 * dt + 4 * p_) * 2));
                        kh[kk][i] = __builtin_amdgcn_ds_read_tr16_b64_v4i16((LAS s16x4*)(shm + KS + (32 * kk + 8 * fq + 4 + q_) * RS + (16 * dt + 4 * p_) * 2));
                    }
                }
#pragma unroll
                for (int kk = 0; kk < 2; ++kk) {
                    bf16x8 bfv[3];
#pragma unroll
                    for (int vt = 0; vt < 3; ++vt) { bfv[vt][0] = wl[kk][vt][0]; bfv[vt][1] = wl[kk][vt][1]; bfv[vt][2] = wl[kk][vt][2]; bfv[vt][3] = wl[kk][vt][3];
                        bfv[vt][4] = wh[kk][vt][0]; bfv[vt][5] = wh[kk][vt][1]; bfv[vt][6] = wh[kk][vt][2]; bfv[vt][7] = wh[kk][vt][3]; }
#pragma unroll
                    for (int i = 0; i < 2; ++i) {
                        bf16x8 af; af[0] = kl[kk][i][0]; af[1] = kl[kk][i][1]; af[2] = kl[kk][i][2]; af[3] = kl[kk][i][3]; af[4] = kh[kk][i][0]; af[5] = kh[kk][i][1]; af[6] = kh[kk][i][2]; af[7] = kh[kk][i][3];
#pragma unroll
                        for (int vt = 0; vt < 3; ++vt) cacc[i][vt] = __builtin_amdgcn_mfma_f32_16x16x32_bf16(af, bfv[vt], cacc[i][vt], 0, 0, 0);
                    }
                }
            }
            __syncthreads();
            if (wid < 4 && !(SKIP & 16)) {
                const f32x4 pm4 = *(const LAS f32x4*)(tp + j * 64 + 16 * tt + 4 * fq);
                const f32x4 bc4 = *(const LAS f32x4*)(tb + j * 64 + 16 * tt + 4 * fq);
#pragma unroll
                for (int vt = 0; vt < 3; ++vt)
#pragma unroll
                    for (int r = 0; r < 4; ++r) nacc[vt][r] += part[(16 * tt + 4 * fq + r) * PRS + 16 * vt + fr];
#pragma unroll
                for (int r = 0; r < 4; ++r) {
                    const float den = __shfl(nacc[2][r], lane & 48);
                    const float inv = 1.f / fmaxf(fabsf(den), __expf(-(bc4[r] + fmaxf(m_prev, pm4[r]))));
                    LAS bf16_t* hrow = (LAS bf16_t*)(shm + HST + (16 * tt + 4 * fq + r) * 80);
                    hrow[fr] = f2bf(nacc[0][r] * inv);
                    hrow[16 + fr] = f2bf(nacc[1][r] * inv);
                }
                asm volatile("s_waitcnt lgkmcnt(0)" ::: "memory");
                {
                    const int rw = 16 * tt + (lane >> 2), pc = lane & 3;
                    const u32x4 hv = *(const LAS u32x4*)(shm + HST + rw * 80 + pc * 16);
                    *(uint4*)(hc + cb + (size_t)rw * DM + vs * 32 + pc * 8) = make_uint4(hv[0], hv[1], hv[2], hv[3]);
                }
            }
#pragma unroll
            for (int i = 0; i < 2; ++i)
#pragma unroll
                for (int vt = 0; vt < 3; ++vt) {
                    u32x2 o; o[0] = pk2(cacc[i][vt][0], cacc[i][vt][1]); o[1] = pk2(cacc[i][vt][2], cacc[i][vt][3]);
                    *(LAS u32x2*)(shm + CB + (16 * vt + fr) * RS + (16 * (2 * wid + i) + 4 * fq) * 2) = o;
                }
            m_prev = btot + mxc;
        }
    }
}

constexpr int S5L = 32, S5NCH = SEQ / S5L;
constexpr size_t T_KT_OFF = 0, T_WS_OFF = 2u << 20, T_V_OFF = 10u << 20, T_AL_OFF = 18u << 20;
constexpr int KT_G = 33 * 256, WS_G = 128 * 512, V_G = 512 * 128;

DEV void s5_tables(LAS char* shm, char* tab, const float* lam_re, const float* lam_im, const float* log_dt, const float* b_re, const float* b_im,
                   const float* c_re, const float* c_im) {
    const int tid = opaque_tid();
    LAS f32x2* apw = (LAS f32x2*)shm;
    LAS f32x2* bb = (LAS f32x2*)(shm + 64 * 33 * 8);
    LAS f32x2* cc = (LAS f32x2*)(shm + 64 * 33 * 8 + 8192);
    bf16_t* KT = (bf16_t*)(tab + T_KT_OFF); bf16_t* WS = (bf16_t*)(tab + T_WS_OFF); bf16_t* VV = (bf16_t*)(tab + T_V_OFF); float2* AL = (float2*)(tab + T_AL_OFF);
    for (int it = blockIdx.x; it < 256; it += gridDim.x) {
        const int g = it & 63, qd = it >> 6;
        __syncthreads();
        if (tid < 64) {
            const int pp = tid;
            const double lr = lam_re[g * NP + pp], li = lam_im[g * NP + pp], dt = exp((double)log_dt[g]);
            const double er = exp(lr * dt);
            const double ar = er * cos(li * dt), ai = er * sin(li * dt);
            const double dr = ar - 1.0, di = ai, den = lr * lr + li * li;
            const double cr = (dr * lr + di * li) / den, ci = (di * lr - dr * li) / den;
            double pr = 1.0, pi_ = 0.0;
            for (int e = 0; e <= 32; ++e) {
                apw[pp * 33 + e] = (f32x2){(float)pr, (float)pi_};
                const double nr = pr * ar - pi_ * ai, ni = pr * ai + pi_ * ar; pr = nr; pi_ = ni;
            }
            if (qd == 0) { const f32x2 t_ = apw[pp * 33 + 32]; AL[g * NP + pp] = make_float2(t_.x, t_.y); }
            for (int c = 0; c < 16; ++c) {
                const double br = b_re[(g * NP + pp) * GC + c], bi = b_im[(g * NP + pp) * GC + c];
                bb[pp * 16 + c] = (f32x2){(float)(cr * br - ci * bi), (float)(cr * bi + ci * br)};
                cc[c * 64 + pp] = (f32x2){c_re[(g * GC + c) * NP + pp], c_im[(g * GC + c) * NP + pp]};
            }
        }
        __syncthreads();
        for (int o = tid; o < 8 * 256; o += 512) {
            const int d = 8 * qd + (o >> 8), c1 = (o >> 4) & 15, c0 = o & 15;
            float acc = 0.f;
            for (int pp = 0; pp < 64; ++pp) {
                const f32x2 a = apw[pp * 33 + d], b = bb[pp * 16 + c0], c = cc[c1 * 64 + pp];
                const float mr = a.x * b.x - a.y * b.y, mi = a.x * b.y + a.y * b.x;
                acc += c.x * mr - c.y * mi;
            }
            KT[(size_t)g * KT_G + (d + 1) * 256 + c1 * 16 + c0] = f2bf(acc);
        }
        if (qd == 0 && tid < 256) KT[(size_t)g * KT_G + tid] = 0;
        for (int o = tid; o < 2 * 16 * 64; o += 512) {
            const int mt = 2 * qd + (o >> 10), sp = (o >> 6) & 15, ln = o & 63;
            const int row = 16 * mt + (ln & 15), ri = row >> 6, pp = row & 63, s_ = 2 * sp + (ln >> 5), c0 = 8 * ((ln >> 4) & 1);
            const f32x2 a = apw[pp * 33 + 31 - s_];
            unsigned w[4];
#pragma unroll
            for (int jj = 0; jj < 8; jj += 2) {
                const f32x2 b0 = bb[pp * 16 + c0 + jj], b1 = bb[pp * 16 + c0 + jj + 1];
                const float v0 = ri ? (a.x * b0.y + a.y * b0.x) : (a.x * b0.x - a.y * b0.y);
                const float v1 = ri ? (a.x * b1.y + a.y * b1.x) : (a.x * b1.x - a.y * b1.y);
                w[jj >> 1] = pk2(v0, v1);
            }
            *(uint4*)(WS + (size_t)g * WS_G + ((size_t)(mt * 16 + sp) * 64 + ln) * 8) = make_uint4(w[0], w[1], w[2], w[3]);
        }
        for (int o = tid; o < 8 * 4 * 64; o += 512) {
            const int i = 8 * qd + (o >> 8), ks = (o >> 6) & 3, ln = o & 63;
            const int c1 = ln & 15, k0 = 32 * ks + 8 * (ln >> 4);
            unsigned w[4];
#pragma unroll
            for (int jj = 0; jj < 8; jj += 2) {
                float v[2];
#pragma unroll
                for (int e = 0; e < 2; ++e) {
                    const int kk = k0 + jj + e, ri = kk >> 6, pp = kk & 63;
                    const f32x2 a = apw[pp * 33 + i + 1], c = cc[c1 * 64 + pp];
                    v[e] = ri ? -(c.x * a.y + c.y * a.x) : (c.x * a.x - c.y * a.y);
                }
                w[jj >> 1] = pk2(v[0], v[1]);
            }
            *(uint4*)(VV + (size_t)g * V_G + ((size_t)(i * 4 + ks) * 64 + ln) * 8) = make_uint4(w[0], w[1], w[2], w[3]);
        }
    }
}

template <int NQ>
DEV void s5_p1_range(LAS char* shm, int lo, int hi, int wid, int fr, int fq, const bf16_t* wsp, f32x4 (&acc)[4][4], f32x4 (&sac)[4]) {
    constexpr int PLANE = 64 * 528, KTL = 2 * PLANE, Q0 = 4 - NQ;
    if (lo > hi) return;
    const LAS char* ub = shm + (fq & 1) * PLANE + fr * 528 + (fq >> 1) * 16;
    const LAS char* kb = shm + KTL + (1 - (fq >> 1)) * 512 + fr * 32 + (fq & 1) * 16;
    bf16x8 bu[4], kf[NQ], wcur;
#pragma unroll
    for (int nt = 0; nt < 4; ++nt) bu[nt] = *(const LAS bf16x8*)(ub + nt * 16 * 528 + lo * 32);
#pragma unroll
    for (int q = 0; q < NQ; ++q) kf[q] = *(const LAS bf16x8*)(kb + (wid + 8 * (Q0 + q) - 2 * lo) * 512);
    wcur = *(const bf16x8*)(wsp + (size_t)lo * 64 * 8);
#pragma nounroll
    for (int sp = lo; sp <= hi; ++sp) {
        bf16x8 bn[4], kn[NQ], wn = wcur;
        const int sn = (sp < hi) ? sp + 1 : sp;
#pragma unroll
        for (int nt = 0; nt < 4; ++nt) bn[nt] = *(const LAS bf16x8*)(ub + nt * 16 * 528 + sn * 32);
#pragma unroll
        for (int q = 0; q < NQ; ++q) kn[q] = *(const LAS bf16x8*)(kb + (wid + 8 * (Q0 + q) - 2 * sn) * 512);
        wn = *(const bf16x8*)(wsp + (size_t)sn * 64 * 8);
#pragma unroll
        for (int nt = 0; nt < 4; ++nt) sac[nt] = __builtin_amdgcn_mfma_f32_16x16x32_bf16(wcur, bu[nt], sac[nt], 0, 0, 0);
#pragma unroll
        for (int q = 0; q < NQ; ++q)
#pragma unroll
            for (int nt = 0; nt < 4; ++nt) acc[Q0 + q][nt] = __builtin_amdgcn_mfma_f32_16x16x32_bf16(kf[q], bu[nt], acc[Q0 + q][nt], 0, 0, 0);
#pragma unroll
        for (int nt = 0; nt < 4; ++nt) bu[nt] = bn[nt];
#pragma unroll
        for (int q = 0; q < NQ; ++q) kf[q] = kn[q];
        wcur = wn;
    }
}
DEV void s5_phase(LAS char* shm, const bf16_t* Uin, bf16_t* Yout, const char* tab, const float* dskip) {
    const int tid = opaque_tid(), wid = __builtin_amdgcn_readfirstlane(tid >> 6), lane = tid & 63, fr = lane & 15, fq = lane >> 4;
    constexpr int PLANE = 64 * 528, KTL = 2 * PLANE, SL = KTL + 33 * 512, HB = SL + 64 * 528, SRS = 528, HRS = 272, TSEG = HB + 64 * 272;
    const bf16_t* KT = (const bf16_t*)(tab + T_KT_OFF); const bf16_t* WS = (const bf16_t*)(tab + T_WS_OFF); const bf16_t* VV = (const bf16_t*)(tab + T_V_OFF);
    const float2* AL = (const float2*)(tab + T_AL_OFF);
    for (int item = blockIdx.x; item < BATCH * NG; item += gridDim.x) {
        const int xcd_ = item & 7, j_ = (item >> 3) & 31, g = xcd_ * 8 + (j_ & 7), b = (j_ >> 3) + 4 * (item >> 8);
        const bf16_t* Ub = Uin + (size_t)b * SEQ * DM + g * GC;
        bf16_t* Yb = Yout + (size_t)b * SEQ * DM + g * GC;
        __syncthreads();
#pragma unroll
        for (int i = 0; i < 8; ++i) {
            const int idx = tid + 512 * i, tok = idx >> 1, hf = idx & 1;
            const uint4 uv = *(const uint4*)(Ub + (size_t)tok * DM + hf * 8);
            *(LAS u32x4*)(shm + hf * PLANE + (tok >> 5) * 528 + (tok & 31) * 16) = (u32x4){uv.x, uv.y, uv.z, uv.w};
        }
        for (int idx = tid; idx < 33 * 32; idx += 512) {
            const uint4 kv = *(const uint4*)(KT + (size_t)g * KT_G + idx * 8);
            *(LAS u32x4*)(shm + KTL + idx * 16) = (u32x4){kv.x, kv.y, kv.z, kv.w};
        }
        __syncthreads();
        f32x4 acc[4][4], sac[4];
#pragma unroll
        for (int q = 0; q < 4; ++q)
#pragma unroll
            for (int nt = 0; nt < 4; ++nt) acc[q][nt] = (f32x4){0.f, 0.f, 0.f, 0.f};
#pragma unroll
        for (int nt = 0; nt < 4; ++nt) sac[nt] = (f32x4){0.f, 0.f, 0.f, 0.f};
        const bf16_t* wsp = WS + (size_t)g * WS_G + ((size_t)(wid * 16) * 64 + lane) * 8;
        const int h2 = wid >> 1;
        s5_p1_range<4>(shm, 0, h2, wid, fr, fq, wsp, acc, sac);
        s5_p1_range<3>(shm, h2 + 1, 4 + h2, wid, fr, fq, wsp, acc, sac);
        s5_p1_range<2>(shm, 5 + h2, 8 + h2, wid, fr, fq, wsp, acc, sac);
        s5_p1_range<1>(shm, 9 + h2, 12 + h2, wid, fr, fq, wsp, acc, sac);
        if (13 + h2 <= 15) {
            const LAS char* ub = shm + (fq & 1) * PLANE + fr * 528 + (fq >> 1) * 16;
            for (int sp = 13 + h2; sp <= 15; ++sp) {
                const bf16x8 wcur = *(const bf16x8*)(wsp + (size_t)sp * 64 * 8);
#pragma unroll
                for (int nt = 0; nt < 4; ++nt) sac[nt] = __builtin_amdgcn_mfma_f32_16x16x32_bf16(wcur, *(const LAS bf16x8*)(ub + nt * 16 * 528 + sp * 32), sac[nt], 0, 0, 0);
            }
        }
#pragma unroll
        for (int nt = 0; nt < 4; ++nt) *(LAS f32x4*)(shm + SL + (16 * nt + fr) * SRS + (16 * wid + 4 * fq) * 4) = sac[nt];
        __syncthreads();
        {
            const float2 al = AL[g * NP + lane];
            float hr = 0.f, hi = 0.f, lr[8], li[8];
#pragma unroll
            for (int n = 0; n < 8; ++n) {
                lr[n] = hr; li[n] = hi;
                const float sr = *(const LAS float*)(shm + SL + (8 * wid + n) * SRS + lane * 4), si = *(const LAS float*)(shm + SL + (8 * wid + n) * SRS + (64 + lane) * 4);
                const float nr = al.x * hr - al.y * hi + sr, ni = al.x * hi + al.y * hr + si; hr = nr; hi = ni;
            }
            *(LAS float*)(shm + TSEG + (wid * 128 + lane) * 4) = hr; *(LAS float*)(shm + TSEG + (wid * 128 + 64 + lane) * 4) = hi;
            float pr = al.x, pi = al.y;
#pragma unroll
            for (int e = 0; e < 3; ++e) { const float nr = pr * pr - pi * pi, ni = 2.f * pr * pi; pr = nr; pi = ni; }
            __syncthreads();
            float cr = 0.f, ci = 0.f;
            for (int w2 = 0; w2 < wid; ++w2) {
                const float tr = *(const LAS float*)(shm + TSEG + (w2 * 128 + lane) * 4), ti = *(const LAS float*)(shm + TSEG + (w2 * 128 + 64 + lane) * 4);
                const float nr = pr * cr - pi * ci + tr, ni = pr * ci + pi * cr + ti; cr = nr; ci = ni;
            }
            float qr = 1.f, qi = 0.f;
#pragma unroll
            for (int n = 0; n < 8; ++n) {
                const float fr_ = lr[n] + qr * cr - qi * ci, fi_ = li[n] + qr * ci + qi * cr;
                *(LAS bf16_t*)(shm + HB + (8 * wid + n) * HRS + lane * 2) = f2bf(fr_);
                *(LAS bf16_t*)(shm + HB + (8 * wid + n) * HRS + (64 + lane) * 2) = f2bf(fi_);
                const float nr = qr * al.x - qi * al.y, ni = qr * al.y + qi * al.x; qr = nr; qi = ni;
            }
        }
        __syncthreads();
        const bf16_t* vvp = VV + (size_t)g * V_G + (size_t)lane * 8;
        bf16x8 va[4];
#pragma unroll
        for (int q = 0; q < 4; ++q) va[q] = *(const bf16x8*)(vvp + ((size_t)((wid + 8 * q) * 4 + 0) * 64) * 8);
#pragma unroll
        for (int ks = 0; ks < 4; ++ks) {
            bf16x8 hb[4], vn[4];
#pragma unroll
            for (int nt = 0; nt < 4; ++nt) hb[nt] = *(const LAS bf16x8*)(shm + HB + (16 * nt + fr) * HRS + (32 * ks + 8 * fq) * 2);
#pragma unroll
            for (int q = 0; q < 4; ++q) vn[q] = (ks < 3) ? *(const bf16x8*)(vvp + ((size_t)((wid + 8 * q) * 4 + ks + 1) * 64) * 8) : va[q];
#pragma unroll
            for (int q = 0; q < 4; ++q)
#pragma unroll
                for (int nt = 0; nt < 4; ++nt) acc[q][nt] = __builtin_amdgcn_mfma_f32_16x16x32_bf16(va[q], hb[nt], acc[q][nt], 0, 0, 0);
#pragma unroll
            for (int q = 0; q < 4; ++q) va[q] = vn[q];
        }
        const float4 dsk = *(const float4*)(dskip + g * GC + 4 * fq);
#pragma unroll
        for (int q = 0; q < 4; ++q) {
            const int i = wid + 8 * q;
#pragma unroll
            for (int nt = 0; nt < 4; ++nt) {
                const int n = 16 * nt + fr;
                const u32x2 uu = *(const LAS u32x2*)(shm + (fq >> 1) * PLANE + n * 528 + i * 16 + ((4 * fq) & 7) * 2);
                f32x4 o;
                o[0] = geluf_(acc[q][nt][0] + dsk.x * bf2f((bf16_t)(uu[0] & 0xffff))); o[1] = geluf_(acc[q][nt][1] + dsk.y * bf2f((bf16_t)(uu[0] >> 16)));
                o[2] = geluf_(acc[q][nt][2] + dsk.z * bf2f((bf16_t)(uu[1] & 0xffff))); o[3] = geluf_(acc[q][nt][3] + dsk.w * bf2f((bf16_t)(uu[1] >> 16)));
                *(uint2*)(Yb + (size_t)(n * 32 + i) * DM + 4 * fq) = pack4(o);
            }
        }
    }
}


DEV void norm_rows(const float* x, const float* gain, const float* modl, bf16_t* h) {
    const int tid = opaque_tid(), lane = tid & 63, gw = blockIdx.x * 8 + (tid >> 6), NGW = gridDim.x * 8;
    for (int m = gw; m < MTOK; m += NGW) {
        const float4* xr = (const float4*)(x + (size_t)m * DM) + lane;
        float4 v[4]; float ss = 0.f;
#pragma unroll
        for (int j = 0; j < 4; ++j) { v[j] = xr[64 * j]; ss += v[j].x * v[j].x + v[j].y * v[j].y + v[j].z * v[j].z + v[j].w * v[j].w; }
        const float rstd = rsqrtf(wave_sum(ss) * (1.f / DM) + EPS);
        const float* shift = modl + (size_t)(m / SEQ) * 3 * DM; const float* scale = shift + DM;
#pragma unroll
        for (int j = 0; j < 4; ++j) {
            const int n = 4 * lane + 256 * j;
            const float4 g = *(const float4*)(gain + n), sc = *(const float4*)(scale + n), sh = *(const float4*)(shift + n);
            f32x4 o; o[0] = v[j].x * rstd * g.x * (1.f + sc.x) + sh.x; o[1] = v[j].y * rstd * g.y * (1.f + sc.y) + sh.y;
            o[2] = v[j].z * rstd * g.z * (1.f + sc.z) + sh.z; o[3] = v[j].w * rstd * g.w * (1.f + sc.w) + sh.w;
            *(uint2*)(h + (size_t)m * DM + n) = pack4(o);
        }
    }
}
DEV void ssm_post_rows(const bf16_t* z, bf16_t* zo, const bf16_t* sg, const float* gain) {
    const int tid = opaque_tid(), lane = tid & 63, gw = blockIdx.x * 8 + (tid >> 6), NGW = gridDim.x * 8;
    for (int m = gw; m < MTOK; m += NGW) {
        float zv[2][8], gv[2][8]; float ss = 0.f;
#pragma unroll
        for (int j = 0; j < 2; ++j) {
            unpack8(*(const uint4*)(z + (size_t)m * DM + 8 * lane + 512 * j), zv[j]);
            unpack8(*(const uint4*)(sg + (size_t)m * DM + 8 * lane + 512 * j), gv[j]);
#pragma unroll
            for (int e = 0; e < 8; ++e) ss += zv[j][e] * zv[j][e];
        }
        const float rstd = rsqrtf(wave_sum(ss) * (1.f / DM) + EPS);
#pragma unroll
        for (int j = 0; j < 2; ++j) {
            const int n = 8 * lane + 512 * j; float o[8];
#pragma unroll
            for (int e = 0; e < 8; ++e) o[e] = zv[j][e] * rstd * gain[n + e] * siluf_(gv[j][e]);
            *(uint4*)(zo + (size_t)m * DM + n) = pack8(o);
        }
    }
}
DEV void mlstm_post_rows(const bf16_t* hc, bf16_t* ho, const bf16_t* mo, const bf16_t* mg, const bf16_t* mi, const float* cw, const float* cb, const float* ngain, const float* skip) {
    const int tid = opaque_tid(), lane = tid & 63, gw = blockIdx.x * 8 + (tid >> 6), NGW = gridDim.x * 8;
    for (int m = gw; m < MTOK; m += NGW) {
        const size_t o0 = (size_t)m * DM + 16 * lane;
        float hv[16], t8[8]; float s1 = 0.f;
#pragma unroll
        for (int j = 0; j < 2; ++j) {
            unpack8(*(const uint4*)(hc + o0 + 8 * j), hv + 8 * j);
            unpack8(*(const uint4*)(mo + o0 + 8 * j), t8);
#pragma unroll
            for (int e = 0; e < 8; ++e) { hv[8 * j + e] *= sigmoidf_(t8[e]); s1 += hv[8 * j + e]; }
        }
#pragma unroll
        for (int o = 1; o < 16; o <<= 1) s1 += __shfl_xor(s1, o);
        const float mu = s1 * (1.f / DH); float s2 = 0.f;
#pragma unroll
        for (int e = 0; e < 16; ++e) { hv[e] -= mu; s2 += hv[e] * hv[e]; }
#pragma unroll
        for (int o = 1; o < 16; o <<= 1) s2 += __shfl_xor(s2, o);
        const float rstd = rsqrtf(s2 * (1.f / DH) + EPS);
#pragma unroll
        for (int j = 0; j < 2; ++j) {
            float xv[8], gv[8], ov[8], t8b[8];
            { const int n0 = 16 * lane + 8 * j, tpos = m % SEQ;
#pragma unroll
              for (int e = 0; e < 8; ++e) xv[e] = cb[n0 + e];
#pragma unroll
              for (int tap = 0; tap < 4; ++tap) if (tpos - 3 + tap >= 0) {
                  unpack8(*(const uint4*)(mi + (size_t)(m - 3 + tap) * DM + n0), t8b);
#pragma unroll
                  for (int e = 0; e < 8; ++e) xv[e] += t8b[e] * cw[tap * DM + n0 + e];
              }
#pragma unroll
              for (int e = 0; e < 8; ++e) xv[e] = siluf_(xv[e]); }
            unpack8(*(const uint4*)(mg + o0 + 8 * j), gv);
#pragma unroll
            for (int e = 0; e < 8; ++e) { const int n = 16 * lane + 8 * j + e; ov[e] = (hv[8 * j + e] * rstd * ngain[n] + skip[n] * xv[e]) * siluf_(gv[e]); }
            *(uint4*)(ho + o0 + 8 * j) = pack8(ov);
        }
    }
}
DEV void final_rows(float* x, const float* gain) {
    const int tid = opaque_tid(), lane = tid & 63, gw = blockIdx.x * 8 + (tid >> 6), NGW = gridDim.x * 8;
    for (int m = gw; m < MTOK; m += NGW) {
        float4* xr = (float4*)(x + (size_t)m * DM) + lane;
        float4 v[4]; float ss = 0.f;
#pragma unroll
        for (int j = 0; j < 4; ++j) { v[j] = xr[64 * j]; ss += v[j].x * v[j].x + v[j].y * v[j].y + v[j].z * v[j].z + v[j].w * v[j].w; }
        const float rstd = rsqrtf(wave_sum(ss) * (1.f / DM) + EPS);
#pragma unroll
        for (int j = 0; j < 4; ++j) {
            const float4 g = *(const float4*)(gain + 4 * lane + 256 * j);
            v[j].x *= rstd * g.x; v[j].y *= rstd * g.y; v[j].z *= rstd * g.z; v[j].w *= rstd * g.w;
            xr[64 * j] = v[j];
        }
    }
}
DEV void mod_phase(LAS char* shm, const float* c, const float* w_mod, const float* b_mod, float* mod) {
    const int tid = opaque_tid();
    LAS float* sc = (LAS float*)shm;
    LAS float* pr = (LAS float*)(shm + 32768);
    __syncthreads();
    for (int i = tid; i < BATCH * DM; i += 512) sc[i] = siluf_(c[i]);
    __syncthreads();
    for (int it = blockIdx.x; it < 48; it += gridDim.x) {
        const int l = it / 24, n0 = (it % 24) * 128, cq = tid & 31, kg = tid >> 5;
        const float* W = w_mod + (size_t)l * DM * 3 * DM + n0 + 4 * cq;
        float acc[BATCH][4];
#pragma unroll
        for (int b = 0; b < BATCH; ++b) { acc[b][0] = acc[b][1] = acc[b][2] = acc[b][3] = 0.f; }
        for (int k = kg * 64; k < kg * 64 + 64; ++k) {
            const float4 w = *(const float4*)(W + (size_t)k * 3 * DM);
#pragma unroll
            for (int b = 0; b < BATCH; ++b) { const float s_ = sc[b * DM + k]; acc[b][0] += s_ * w.x; acc[b][1] += s_ * w.y; acc[b][2] += s_ * w.z; acc[b][3] += s_ * w.w; }
        }
#pragma unroll
        for (int b = 0; b < BATCH; ++b) *(LAS f32x4*)(pr + (kg * 8 + b) * 128 + 4 * cq) = (f32x4){acc[b][0], acc[b][1], acc[b][2], acc[b][3]};
        __syncthreads();
        for (int o = tid; o < 8 * 128; o += 512) {
            const int b = o >> 7, n = o & 127; float s_ = 0.f;
#pragma unroll
            for (int g2 = 0; g2 < 16; ++g2) s_ += pr[(g2 * 8 + b) * 128 + n];
            mod[((size_t)l * BATCH + b) * 3 * DM + n0 + n] = s_ + b_mod[l * 3 * DM + n0 + n];
        }
        __syncthreads();
    }
}

DEV void wfold_prep(bf16_t* WfT, const float* wq, const float* wk, const float* wv, const float* wg  ) {
    const int tid = opaque_tid(), lane = tid & 63;
    for (int t = blockIdx.x * 8 + (tid >> 6); t < 2048; t += gridDim.x * 8) {
        const int which = t >> 10, ch = t & 1023, hd = ch >> 8, d = ch & 255;
        float acc[8];
#pragma unroll
        for (int j = 0; j < 8; ++j) acc[j] = 0.f;
        if (which == 0) {
            const float4 q4 = *(const float4*)(wq + ((size_t)hd * DH + d) * DH + 4 * lane);
            const float4 k4 = *(const float4*)(wk + ((size_t)hd * DH + d) * DH + 4 * lane);
            const float qv[4] = {q4.x, q4.y, q4.z, q4.w}, kv[4] = {k4.x * 0.0625f, k4.y * 0.0625f, k4.z * 0.0625f, k4.w * 0.0625f};
#pragma unroll
            for (int e = 0; e < 4; ++e) {
                const float* g1 = wg + (size_t)(hd * DH + 4 * lane + e) * 8; const float* g2 = wg + (size_t)(DM + hd * DH + 4 * lane + e) * 8;
                const float4 a0 = *(const float4*)g1, a1 = *(const float4*)(g1 + 4), b0 = *(const float4*)g2, b1 = *(const float4*)(g2 + 4);
                acc[0] += qv[e] * a0.x + kv[e] * b0.x; acc[1] += qv[e] * a0.y + kv[e] * b0.y; acc[2] += qv[e] * a0.z + kv[e] * b0.z; acc[3] += qv[e] * a0.w + kv[e] * b0.w;
                acc[4] += qv[e] * a1.x + kv[e] * b1.x; acc[5] += qv[e] * a1.y + kv[e] * b1.y; acc[6] += qv[e] * a1.z + kv[e] * b1.z; acc[7] += qv[e] * a1.w + kv[e] * b1.w;
            }
        } else {
            const float4 v4 = *(const float4*)(wv + ((size_t)hd * DH + d) * DH + 4 * lane);
            const float vv[4] = {v4.x, v4.y, v4.z, v4.w};
#pragma unroll
            for (int e = 0; e < 4; ++e) {
                const float* g1 = wg + (size_t)(2 * DM + hd * DH + 4 * lane + e) * 8;
                const float4 a0 = *(const float4*)g1, a1 = *(const float4*)(g1 + 4);
                acc[0] += vv[e] * a0.x; acc[1] += vv[e] * a0.y; acc[2] += vv[e] * a0.z; acc[3] += vv[e] * a0.w;
                acc[4] += vv[e] * a1.x; acc[5] += vv[e] * a1.y; acc[6] += vv[e] * a1.z; acc[7] += vv[e] * a1.w;
            }
        }
#pragma unroll
        for (int j = 0; j < 8; ++j) acc[j] = wave_sum(acc[j]);
        if (lane < 16) {
            float v = 0.f;
#pragma unroll
            for (int j = 0; j < 8; ++j) v = (lane == j) ? acc[j] : v;
            WfT[((size_t)which * 16 + lane) * 1024 + ch] = f2bf(v);
        }
    }
}
DEV void xc_gates_phase(LAS char* shm, const bf16_t* mi, bf16_t* xc, const bf16_t* WfT, const float* cw, const float* cb, float* gpart  ) {
    const int tid = opaque_tid(), wid = __builtin_amdgcn_readfirstlane(tid >> 6), lane = tid & 63, fr = lane & 15, fq = lane >> 4;
    constexpr int WRS = 2064, WIMG = 16 * WRS, STG = 2 * WIMG, SRS_ = 528, STG_W = 19 * SRS_;
    __syncthreads();
    for (int i = tid; i < 2 * 16 * 128; i += 512) {
        const int rowi = i >> 7, pc = i & 127;
        const uint4 v = *(const uint4*)(WfT + (size_t)rowi * 1024 + pc * 8);
        *(LAS u32x4*)(shm + rowi * WRS + pc * 16) = (u32x4){v.x, v.y, v.z, v.w};
    }
    __syncthreads();
    LAS char* stg = shm + STG + wid * STG_W;
    for (int task = blockIdx.x * 8 + wid; task < (MTOK / 16) * 2; task += gridDim.x * 8) {
        const int chalf = task & 1, m0 = (task >> 1) * 16, tpos0 = m0 % SEQ;
        f32x4 acc = (f32x4){0.f, 0.f, 0.f, 0.f};
#pragma nounroll
        for (int sl = 0; sl < 2; ++sl) {
            const int c0 = chalf * 512 + sl * 256;
            for (int i = lane; i < 19 * 32; i += 64) {
                const int row = i >> 5, pc = i & 31;
                uint4 v = make_uint4(0, 0, 0, 0);
                if (tpos0 - 3 + row >= 0) v = *(const uint4*)(mi + (size_t)(m0 - 3 + row) * DM + c0 + pc * 8);
                *(LAS u32x4*)(stg + row * SRS_ + pc * 16) = (u32x4){v.x, v.y, v.z, v.w};
            }
#pragma nounroll
            for (int ks = 0; ks < 8; ++ks) {
                const int cl = 32 * ks + 8 * fq, c = c0 + cl;
                float xv[8], t8[8], w8[8];
                { const float4 b0 = *(const float4*)(cb + c), b1 = *(const float4*)(cb + c + 4);
                  xv[0] = b0.x; xv[1] = b0.y; xv[2] = b0.z; xv[3] = b0.w; xv[4] = b1.x; xv[5] = b1.y; xv[6] = b1.z; xv[7] = b1.w; }
                u32x4 raw3;
#pragma unroll
                for (int tap = 0; tap < 4; ++tap) {
                    const u32x4 rw = *(const LAS u32x4*)(stg + (fr + tap) * SRS_ + cl * 2);
                    if (tap == 3) raw3 = rw;
                    unpack8(make_uint4(rw[0], rw[1], rw[2], rw[3]), t8);
                    const float4 w0 = *(const float4*)(cw + tap * DM + c), w1 = *(const float4*)(cw + tap * DM + c + 4);
                    w8[0] = w0.x; w8[1] = w0.y; w8[2] = w0.z; w8[3] = w0.w; w8[4] = w1.x; w8[5] = w1.y; w8[6] = w1.z; w8[7] = w1.w;
#pragma unroll
                    for (int e = 0; e < 8; ++e) xv[e] += t8[e] * w8[e];
                }
#pragma unroll
                for (int e = 0; e < 8; ++e) xv[e] = siluf_(xv[e]);
                const uint4 xp = pack8(xv);
                *(uint4*)(xc + (size_t)(m0 + fr) * DM + c) = xp;
                const u32x4 xpu = (u32x4){xp.x, xp.y, xp.z, xp.w};
                const bf16x8 bx = *(const LAS bf16x8*)(shm + fr * WRS + c * 2);
                const bf16x8 bv = *(const LAS bf16x8*)(shm + WIMG + fr * WRS + c * 2);
                acc = __builtin_amdgcn_mfma_f32_16x16x32_bf16(*(const bf16x8*)&xpu, bx, acc, 0, 0, 0);
                acc = __builtin_amdgcn_mfma_f32_16x16x32_bf16(*(const bf16x8*)&raw3, bv, acc, 0, 0, 0);
            }
        }
        if (fr < 8) {
#pragma unroll
            for (int r = 0; r < 4; ++r) gpart[((size_t)chalf * MTOK + m0 + 4 * fq + r) * 8 + fr] = acc[r];
        }
    }
}

#define XB_TMO      128
#define XB_XCNT(j)  (256  + 64 * (j))
#define XB_XSUB(j)  (1280 + 64 * (j))
#define XB_XGEN(j)  (2304 + 64 * (j))
#define XB_TOP      3328
#define XB_TOPGEN   3392
#define XCD_BAR_WORDS 3456
#define XB_SPIN_CAP (1u << 18)
DEV unsigned xb_ld(unsigned* p) { return __hip_atomic_load(p, __ATOMIC_RELAXED, __HIP_MEMORY_SCOPE_AGENT); }
DEV unsigned xb_add(unsigned* p, unsigned v) { return __hip_atomic_fetch_add(p, v, __ATOMIC_RELAXED, __HIP_MEMORY_SCOPE_AGENT); }
DEV unsigned xb_xcc_id() { return (unsigned)__builtin_amdgcn_s_getreg((3 << 11) | 20) & 0xFu; }
#define XB_SPIN(cond, bar) do { unsigned _sp = 0; while (cond) { __builtin_amdgcn_s_sleep(1); \
    if ((++_sp & 255u) == 0u) { if (xb_ld(&(bar)[XB_TMO])) break; if (_sp > XB_SPIN_CAP) { atomicAdd(&(bar)[XB_TMO], 1u); break; } } } } while (0)
struct XcdBarrier { unsigned* bar; unsigned x; volatile LAS unsigned* st; };
DEV XcdBarrier xcd_barrier_post(unsigned* bar, volatile LAS unsigned* st) {
    XcdBarrier b; b.bar = bar; b.x = xb_xcc_id(); b.st = st;
    if (threadIdx.x == 0) (void)xb_add(&bar[XB_XCNT(b.x)], 1u);
    return b;
}
DEV void xcd_barrier_complete(unsigned* bar, unsigned x, unsigned& nloc, unsigned& nx) {
    const unsigned G = gridDim.x * gridDim.y * gridDim.z;
    unsigned sum, cnt, mine, sp = 0u;
    for (;;) {
        sum = 0u; cnt = 0u; mine = 0u;
#pragma nounroll
        for (unsigned j = 0; j < 16; ++j) { const unsigned c = xb_ld(&bar[XB_XCNT(j)]); sum += c; cnt += (c > 0u) ? 1u : 0u; }
        mine = xb_ld(&bar[XB_XCNT(x)]);
        if (sum == G) break;
        __builtin_amdgcn_s_sleep(1);
        if ((++sp & 255u) == 0u) { if (xb_ld(&bar[XB_TMO])) break; if (sp > XB_SPIN_CAP) { atomicAdd(&bar[XB_TMO], 1u); break; } }
    }
    nloc = mine > 0u ? mine : 1u; nx = cnt > 0u ? cnt : 1u;
}
DEV void xcd_barrier1(const XcdBarrier& b) {
    asm volatile("s_waitcnt vmcnt(0)" ::: "memory");
    __syncthreads();
    if (threadIdx.x == 0) {
        unsigned* bar = b.bar;
        __builtin_amdgcn_s_waitcnt(0);
        unsigned nloc = b.st[0], nx = b.st[1];
        if (nloc == 0u) { xcd_barrier_complete(bar, b.x, nloc, nx); b.st[0] = nloc; b.st[1] = nx; }
        const unsigned old = xb_add(&bar[XB_XSUB(b.x)], 1u);
        const unsigned gen = old / nloc;
        if (old + 1u == (gen + 1u) * nloc) {
            __builtin_amdgcn_fence(__ATOMIC_RELEASE, "agent");
            asm volatile("s_waitcnt vmcnt(0)" ::: "memory");
            const unsigned og = xb_add(&bar[XB_TOP], 1u);
            const unsigned tg = og / nx;
            if (og + 1u == (tg + 1u) * nx) xb_add(&bar[XB_TOPGEN], 1u);
            else XB_SPIN(xb_ld(&bar[XB_TOPGEN]) == tg, bar);
            __builtin_amdgcn_fence(__ATOMIC_ACQUIRE, "agent");
            xb_add(&bar[XB_XGEN(b.x)], 1u);
            asm volatile("s_waitcnt vmcnt(0)" ::: "memory");
        } else {
            XB_SPIN(xb_ld(&bar[XB_XGEN(b.x)]) == gen, bar);
            __builtin_amdgcn_fence(__ATOMIC_ACQUIRE, "agent");
            asm volatile("s_waitcnt vmcnt(0)" ::: "memory");
        }
    }
    __syncthreads();
}

DEV void xcd_barrier(const XcdBarrier& b) { xcd_barrier1(b); if (REPMASK & 2048) xcd_barrier1(b); }
constexpr int LDS_BYTES = 148 * 1024;
DEV const void* ldptr(LAS char* shm, int i) {
    volatile LAS unsigned* pt = (volatile LAS unsigned*)(shm + LDS_BYTES - 512);
    const unsigned lo = __builtin_amdgcn_readfirstlane(pt[2 * i]), hi = __builtin_amdgcn_readfirstlane(pt[2 * i + 1]);
    return (const void*)(const __attribute__((address_space(1))) void*)(((unsigned long long)hi << 32) | lo);
}
#define PF(i) ((const float*)ldptr(shm, (i)))
struct Params {
    const float *x, *c, *norm_gain, *w_mod, *b_mod, *w_in, *lam_re, *lam_im, *log_dt, *sb_re, *sb_im, *sc_re, *sc_im, *ssm_d, *w_glu, *b_glu, *ssm_og,
        *conv_w, *conv_b, *wq, *wk, *wv, *w_gates, *b_ig, *b_fg, *m_ng, *m_skip, *w_out, *final_gain;
    float* out; char* ws;
};
constexpr int HALF_FLOATS = 56 * 1024 / 4;
constexpr size_t SLOT = (size_t)MTOK * DM * 2;
constexpr size_t W_IN_OFF = 0, W_GLU_OFF = 10485760, W_QKV_OFF = 12582912, W_OUT_OFF = 14155776, MOD_OFF = 20u << 20, IPRE_OFF = 21u << 20, LOGF_OFF = 22u << 20, BAR_OFF = 23u << 20, WF_OFF = 19u << 20, ROWSS_OFF = 24u << 20, RSTD_OFF = 25u << 20, XSS_OFF = 26u << 20;
#define REP(bit) _Pragma("nounroll") for (int rep_ = 0; rep_ < (((REPMASK) & (bit)) ? 2 : 1); ++rep_)
#define FOR_VB(nvb) for (int vb = blockIdx.x * 2 + HALF; vb < (nvb); vb += gridDim.x * 2)

#define WSB ((char*)ldptr(shm, 30))
#define SL(i) ((bf16_t*)(WSB + SLOT * (i)))
#define S7(off) (WSB + SLOT * 7 + (off))
#define WinT ((bf16_t*)S7(W_IN_OFF))
#define WgluT ((bf16_t*)S7(W_GLU_OFF))
#define WqkvT ((bf16_t*)S7(W_QKV_OFF))
#define WoutT ((bf16_t*)S7(W_OUT_OFF))
#define mod ((float*)S7(MOD_OFF))
#define gpart ((float*)S7(IPRE_OFF))
#define WfT ((bf16_t*)S7(WF_OFF))
#define rowss ((float*)S7(ROWSS_OFF))
#define rstdv ((float*)S7(RSTD_OFF))
#define xssv ((float*)S7(XSS_OFF))
#define MX SL(1)
#define OUTP ((float*)ldptr(shm, 29))
#define H SL(0)
#define U SL(1)
#define Y SL(2)
#define Z SL(3)
#define XC SL(4)
#define MI SL(5)
#define Q SL(6)
#define Kb SL(1)
#define V SL(2)
#define HC SL(5)
template <int l>
DEV void layer_body(LAS char* shm, const XcdBarrier& gbar) {
        const int wave = opaque_tid() >> 6, lane = opaque_tid() & 63;
        const float* xin = (l == 0) ? PF(0) : OUTP;
        const float* modl = mod + (size_t)l * BATCH * 3 * DM;
        REP(1) { {
            LAS float* scr = (LAS float*)(shm + wave * 16640);
            const float* Win = PF(5) + (size_t)l * DM * INC;
            constexpr int I_IN = 16 * 80, I_GLU = 16 * 16, I_QKV = 12 * 16, I_OUT = 32 * 16;
            for (int it = blockIdx.x * 8 + wave; it < I_IN + I_GLU + I_QKV + I_OUT; it += gridDim.x * 8) {
                int r = it;
                if (r < I_IN) { transpose_item(Win, INC, INC, WinT, DM, scr, r, lane); continue; } r -= I_IN;
                if (r < I_GLU) { transpose_item(PF(14) + (size_t)l * DM * DM, DM, DM, WgluT, DM, scr, r, lane); continue; } r -= I_GLU;
                if (r < I_QKV) { const int mat = r / 16, which = mat >> 2, hd = mat & 3;
                    const float* W = sel3(which, PF(19), PF(20), PF(21)) + ((size_t)l * NH + hd) * DH * DH;
                    transpose_item(W, DH, DH, WqkvT + (size_t)mat * DH * DH, DH, scr, r % 16, lane); continue; } r -= I_QKV;
                transpose_item(PF(27) + (size_t)l * 2 * DM * DM, DM, DM, WoutT, 2 * DM, scr, r, lane);
            }
        }
        wfold_prep(WfT, PF(19) + (size_t)l * NH * DH * DH, PF(20) + (size_t)l * NH * DH * DH, PF(21) + (size_t)l * NH * DH * DH, PF(22) + (size_t)l * 3 * DM * 8);
        __syncthreads();
        s5_tables(shm, (char*)SL(3), PF(6) + l * NG * NP, PF(7) + l * NG * NP, PF(8) + l * NG, PF(9) + (size_t)l * NG * NP * GC, PF(10) + (size_t)l * NG * NP * GC,
                  PF(11) + (size_t)l * NG * GC * NP, PF(12) + (size_t)l * NG * GC * NP);
        __syncthreads();
        if (l == 0) norm_rows(xin, PF(2) + l * DM, modl, H);
        }
        xcd_barrier(gbar);
        REP(2) { g8::SchedG1 S_{H, WinT, (int)blockIdx.x, (int)gridDim.x}; g8::EpiG1 E_{U, MI}; g8::gemm_phase(shm, S_, E_); }
        xcd_barrier(gbar);
        REP(256) s5_phase(shm, U, Y, (const char*)SL(3), PF(13) + l * DM);
        REP(8) xc_gates_phase(shm, MI, XC, WfT, PF(17) + l * 4 * DM, PF(18) + l * DM, gpart);
        xcd_barrier(gbar);
        REP(4) { g8::SchedGlu S_{Y, WgluT, (int)blockIdx.x, (int)gridDim.x}; g8::EpiGlu E_{Y, Z, PF(15) + l * DM, rowss}; g8::gemm_phase(shm, S_, E_); }
        xcd_barrier(gbar);
        REP(16) { g8::SchedQkv S_{XC, MI, WqkvT, (int)blockIdx.x, (int)gridDim.x}; g8::EpiQkv E_{Q, Kb, V}; g8::gemm_phase(shm, S_, E_); }
        xcd_barrier(gbar);
        rstd_rows(rowss, rstdv);
        REP(32) mlstm_phase<0>(shm, Q, Kb, V, gpart, PF(23) + l * 4, PF(24) + l * 4, HC);
#ifdef MLPROBE
        if (l == 0) mlstm_phase<MLPROBE>(shm, Q, Kb, V, gpart, PF(23) + l * 4, PF(24) + l * 4, (bf16_t*)OUTP);
#endif
        xcd_barrier(gbar);
        { g8::SchedG2s S_{H, WinT, (int)blockIdx.x}; g8::EpiG2s E_{Z, rstdv, PF(16) + l * DM, MX}; g8::gemm_phase(shm, S_, E_); }
        { g8::SchedG2m S_{H, WinT, (int)blockIdx.x}; g8::EpiG2m E_{HC, XC, PF(25) + l * DM, PF(26) + l * DM, MX}; g8::gemm_phase(shm, S_, E_); }
        xcd_barrier(gbar);
        if (l == 0) { g8::SchedOut S_{MX, WoutT, (int)blockIdx.x, (int)gridDim.x};
            g8::EpiOutN<false> E_{xin, OUTP, modl + 2 * DM, PF(2) + DM, mod + (size_t)BATCH * 3 * DM, H, xssv, (unsigned*)S7(BAR_OFF) + 4096, (unsigned*)S7(BAR_OFF) + XB_TMO}; g8::gemm_phase(shm, S_, E_); }
        else { g8::SchedOut S_{MX, WoutT, (int)blockIdx.x, (int)gridDim.x};
            g8::EpiOutN<true> E_{xin, OUTP, modl + 2 * DM, PF(28), mod, H, xssv + (size_t)MTOK * 4, (unsigned*)S7(BAR_OFF) + 4096 + 4096, (unsigned*)S7(BAR_OFF) + XB_TMO}; g8::gemm_phase(shm, S_, E_); }
        xcd_barrier(gbar);
    }
__global__ void __launch_bounds__(512, 2) mega(Params Pk) {
    extern __shared__ __attribute__((aligned(16))) unsigned char lds_raw[];
    {
        volatile LAS unsigned long long* pt = (volatile LAS unsigned long long*)((LAS char*)lds_raw + LDS_BYTES - 512);
        if (threadIdx.x == 0) {
            pt[0] = (unsigned long long)Pk.x;
            pt[1] = (unsigned long long)Pk.c;
            pt[2] = (unsigned long long)Pk.norm_gain;
            pt[3] = (unsigned long long)Pk.w_mod;
            pt[4] = (unsigned long long)Pk.b_mod;
            pt[5] = (unsigned long long)Pk.w_in;
            pt[6] = (unsigned long long)Pk.lam_re;
            pt[7] = (unsigned long long)Pk.lam_im;
            pt[8] = (unsigned long long)Pk.log_dt;
            pt[9] = (unsigned long long)Pk.sb_re;
            pt[10] = (unsigned long long)Pk.sb_im;
            pt[11] = (unsigned long long)Pk.sc_re;
            pt[12] = (unsigned long long)Pk.sc_im;
            pt[13] = (unsigned long long)Pk.ssm_d;
            pt[14] = (unsigned long long)Pk.w_glu;
            pt[15] = (unsigned long long)Pk.b_glu;
            pt[16] = (unsigned long long)Pk.ssm_og;
            pt[17] = (unsigned long long)Pk.conv_w;
            pt[18] = (unsigned long long)Pk.conv_b;
            pt[19] = (unsigned long long)Pk.wq;
            pt[20] = (unsigned long long)Pk.wk;
            pt[21] = (unsigned long long)Pk.wv;
            pt[22] = (unsigned long long)Pk.w_gates;
            pt[23] = (unsigned long long)Pk.b_ig;
            pt[24] = (unsigned long long)Pk.b_fg;
            pt[25] = (unsigned long long)Pk.m_ng;
            pt[26] = (unsigned long long)Pk.m_skip;
            pt[27] = (unsigned long long)Pk.w_out;
            pt[28] = (unsigned long long)Pk.final_gain;
            pt[29] = (unsigned long long)Pk.out; pt[30] = (unsigned long long)Pk.ws;
        }
    }
    __syncthreads();
    LAS char* shm = (LAS char*)lds_raw;
    float* ldsf = (float*)lds_raw + HALF * HALF_FLOATS;
    volatile LAS unsigned* bst = (volatile LAS unsigned*)(shm + LDS_BYTES - 16);
    if (threadIdx.x < 4) bst[threadIdx.x] = 0u;
    __syncthreads();
    const XcdBarrier gbar = xcd_barrier_post((unsigned*)((char*)ldptr(shm, 30) + SLOT * 7 + BAR_OFF), bst);
    REP(4096) mod_phase(shm, PF(1), PF(3), PF(4), mod);
    xcd_barrier(gbar);
    layer_body<0>(shm, gbar);
    layer_body<1>(shm, gbar);
}

#undef WSB
#undef SL
#undef S7
#undef WinT
#undef WgluT
#undef WqkvT
#undef WoutT
#undef mod
#undef gpart
#undef WfT
#undef rowss
#undef rstdv
#undef xssv
#undef MX
#undef OUTP
#undef H
#undef U
#undef Y
#undef Z
#undef XC
#undef MI
#undef Q
#undef Kb
#undef V
#undef HC
extern "C" void kernel_launch(void* const* d_in, const int* in_sizes, int n_in, void* d_out, int out_size, void* d_ws, size_t ws_size, hipStream_t stream) {
    static int grid_blocks = 0;
    if (!grid_blocks) {
        int dev = 0, cus = 0, per_cu = 0;
        (void)hipGetDevice(&dev);
        (void)hipDeviceGetAttribute(&cus, hipDeviceAttributeMultiprocessorCount, dev);
        (void)hipFuncSetAttribute((const void*)mega, hipFuncAttributeMaxDynamicSharedMemorySize, LDS_BYTES);
        (void)hipOccupancyMaxActiveBlocksPerMultiprocessor(&per_cu, (const void*)mega, 512, LDS_BYTES);
        grid_blocks = cus;
        fprintf(stderr, "mega: cus=%d occupancy per_cu=%d grid=%d\n", cus, per_cu, grid_blocks);
    }
    (void)hipMemsetAsync((char*)d_ws + SLOT * 7 + BAR_OFF, 0, 65536, stream);
    Params P{};
    const float** pp = (const float**)&P;
    for (int i = 0; i < 29; ++i) pp[i] = (const float*)d_in[i];
    P.out = (float*)d_out; P.ws = (char*)d_ws;
    void* args[] = {&P};
    hipError_t e = hipLaunchCooperativeKernel((const void*)mega, dim3(grid_blocks), dim3(512), args, LDS_BYTES, stream);
    if (e != hipSuccess) fprintf(stderr, "cooperative launch failed: %s (grid %d)\n", hipGetErrorString(e), grid_blocks);
}
```

```cpp
#include <hip/hip_runtime.h>
#include <cstdio>
#include <cstdint>
#include <hip/hip_cooperative_groups.h>
namespace cg = cooperative_groups;

#ifndef REPMASK
#define REPMASK 0
#endif
typedef unsigned short bf16_t;
#define DEV __device__ __forceinline__

constexpr int BATCH = 8, SEQ = 2048, DM = 1024, MTOK = BATCH * SEQ;
constexpr int NG = 64, NP = 64, GC = 16, NH = 4, DH = 256, CHUNK = 64, INC = 5120;
constexpr float EPS = 1e-6f;

DEV int opaque_tid() { int t = threadIdx.x; asm volatile("" : "+v"(t)); return t; }
#define TIDH (opaque_tid() & 255)
#define HALF (opaque_tid() >> 8)
DEV float bf2f(bf16_t v) { return __uint_as_float(((unsigned)v) << 16); }
typedef __bf16 bf16n2 __attribute__((ext_vector_type(2)));
typedef float f32n2 __attribute__((ext_vector_type(2)));
DEV bf16_t f2bf(float f) { __bf16 b = (__bf16)f; return __builtin_bit_cast(unsigned short, b); }
DEV unsigned pk2(float lo, float hi) { f32n2 v = {lo, hi}; bf16n2 b = __builtin_convertvector(v, bf16n2); return __builtin_bit_cast(unsigned, b); }
DEV float sigmoidf_(float x) { return 1.f / (1.f + __expf(-x)); }
DEV float siluf_(float x) { return x / (1.f + __expf(-x)); }
DEV float geluf_(float x) { const float t2 = 1.5957691216057308f * (x + 0.044715f * x * x * x); return x / (1.f + __expf(-t2)); }
DEV float logsigmoidf_(float x) { return fminf(x, 0.f) - log1pf(__expf(-fabsf(x))); }

DEV float wave_sum(float v) {
#pragma unroll
    for (int o = 1; o < 64; o <<= 1) v += __shfl_xor(v, o);
    return v;
}
DEV float block_sum256(float v, float* red) {
    v = wave_sum(v);
    __syncthreads();
    if ((TIDH & 63) == 0) red[TIDH >> 6] = v;
    __syncthreads();
    return red[0] + red[1] + red[2] + red[3];
}

DEV void k_mod(int vb, float* ldsf, const float* c, const float* w_mod, const float* b_mod, float* mod) {
    float (*sc)[DM] = (float (*)[DM])ldsf;
    const int l = vb / 12, n = (vb % 12) * 256 + TIDH;
    __syncthreads();
    for (int i = TIDH; i < BATCH * DM; i += 256) sc[i / DM][i % DM] = siluf_(c[i]);
    __syncthreads();
    float acc[BATCH];
#pragma unroll
    for (int b = 0; b < BATCH; ++b) acc[b] = 0.f;
    const float* W = w_mod + (size_t)l * DM * 3 * DM;
    for (int k = 0; k < DM; ++k) {
        float w = W[(size_t)k * 3 * DM + n];
#pragma unroll
        for (int b = 0; b < BATCH; ++b) acc[b] += sc[b][k] * w;
    }
#pragma unroll
    for (int b = 0; b < BATCH; ++b) mod[((size_t)l * BATCH + b) * 3 * DM + n] = acc[b] + b_mod[l * 3 * DM + n];
}

DEV void k_norm_mod(int vb, float* red, const float* x, const float* gain, const float* mod  , bf16_t* h) {
    const int m = vb, b = m / SEQ, t = TIDH;
    const float4 v = ((const float4*)(x + (size_t)m * DM))[t];
    float ss = v.x * v.x + v.y * v.y + v.z * v.z + v.w * v.w;
    ss = block_sum256(ss, red);
    const float rstd = rsqrtf(ss * (1.f / DM) + EPS);
    const float* shift = mod + (size_t)b * 3 * DM;
    const float* scale = shift + DM;
    float xv[4] = {v.x, v.y, v.z, v.w};
#pragma unroll
    for (int i = 0; i < 4; ++i) {
        int n = t * 4 + i;
        float y = xv[i] * rstd * gain[n] * (1.f + scale[n]) + shift[n];
        h[(size_t)m * DM + n] = f2bf(y);
    }
}

DEV void k_s5(int item, float* ldsf, const bf16_t* u, bf16_t* y, const float* lam_re, const float* lam_im, const float* log_dt,
                                           const float* b_re, const float* b_im, const float* c_re, const float* c_im, const float* dskip) {
    const int tid_ = opaque_tid();
    float (*part)[17] = (float (*)[17])(ldsf + (tid_ >> 6) * 64 * 17);
    const int g = item & 63, b = item >> 6, p = tid_ & 63;
    const double lr = lam_re[g * NP + p], li = lam_im[g * NP + p], dt = exp((double)log_dt[g]);
    const double er = exp(lr * dt);
    const double ard = er * cos(li * dt), aid = er * sin(li * dt);
    const double dr = ard - 1.0, di = aid, den = lr * lr + li * li;
    const double cr = (dr * lr + di * li) / den, ci = (di * lr - dr * li) / den;
    float bbr[16], bbi[16], ccr[16], cci[16];
#pragma unroll
    for (int c = 0; c < 16; ++c) {
        const double br = b_re[(g * NP + p) * GC + c], bi = b_im[(g * NP + p) * GC + c];
        bbr[c] = (float)(cr * br - ci * bi); bbi[c] = (float)(cr * bi + ci * br);
        ccr[c] = c_re[(g * GC + c) * NP + p]; cci[c] = c_im[(g * GC + c) * NP + p];
    }
    const float ar = (float)ard, ai = (float)aid;
    const float dsk = dskip[g * GC + (p & 15)];
    float sr = 0.f, si = 0.f;
    for (int t = 0; t < SEQ; ++t) {
        const bf16_t* up = u + (size_t)(b * SEQ + t) * DM + g * GC;
        const uint4 u0 = *(const uint4*)up, u1 = *(const uint4*)(up + 8);
        float uf[16];
        uf[0] = bf2f(u0.x & 0xffff); uf[1] = bf2f(u0.x >> 16); uf[2] = bf2f(u0.y & 0xffff); uf[3] = bf2f(u0.y >> 16);
        uf[4] = bf2f(u0.z & 0xffff); uf[5] = bf2f(u0.z >> 16); uf[6] = bf2f(u0.w & 0xffff); uf[7] = bf2f(u0.w >> 16);
        uf[8] = bf2f(u1.x & 0xffff); uf[9] = bf2f(u1.x >> 16); uf[10] = bf2f(u1.y & 0xffff); uf[11] = bf2f(u1.y >> 16);
        uf[12] = bf2f(u1.z & 0xffff); uf[13] = bf2f(u1.z >> 16); uf[14] = bf2f(u1.w & 0xffff); uf[15] = bf2f(u1.w >> 16);
        float bur = 0.f, bui = 0.f;
#pragma unroll
        for (int c = 0; c < 16; ++c) { bur += bbr[c] * uf[c]; bui += bbi[c] * uf[c]; }
        const float nr = ar * sr - ai * si + bur, ni = ar * si + ai * sr + bui;
        sr = nr; si = ni;
#pragma unroll
        for (int c = 0; c < 16; ++c) part[p][c] = ccr[c] * sr - cci[c] * si;
        asm volatile("s_waitcnt lgkmcnt(0)" ::: "memory");
        float s = 0.f;
#pragma unroll
        for (int k = 0; k < 16; ++k) s += part[(p >> 4) * 16 + k][p & 15];
        s += __shfl_xor(s, 16); s += __shfl_xor(s, 32);
        if (p < 16) {
            const float yv = s + dsk * bf2f(up[p]);
            y[(size_t)(b * SEQ + t) * DM + g * GC + p] = f2bf(geluf_(yv));
        }
        asm volatile("s_waitcnt lgkmcnt(0)" ::: "memory");
    }
}

DEV void k_ssm_post(int vb, float* red, bf16_t* z, const bf16_t* sg, const float* gain) {
    const int m = vb, t = TIDH;
    float zv[4]; float ss = 0.f;
#pragma unroll
    for (int i = 0; i < 4; ++i) { zv[i] = bf2f(z[(size_t)m * DM + t * 4 + i]); ss += zv[i] * zv[i]; }
    ss = block_sum256(ss, red);
    const float rstd = rsqrtf(ss * (1.f / DM) + EPS);
#pragma unroll
    for (int i = 0; i < 4; ++i) {
        const int n = t * 4 + i;
        z[(size_t)m * DM + n] = f2bf(zv[i] * rstd * gain[n] * siluf_(bf2f(sg[(size_t)m * DM + n])));
    }
}

DEV float conv_xc(const bf16_t* mi, int m, int n, const float* cw, const float* cb) {
    const int t = m % SEQ;
    float acc = cb[n];
#pragma unroll
    for (int j = 0; j < 4; ++j) {
        const int tt = t - 3 + j;
        if (tt >= 0) acc += bf2f(mi[(size_t)(m - 3 + j) * DM + n]) * cw[j * DM + n];
    }
    return siluf_(acc);
}
DEV void k_conv(int vb, const bf16_t* mi, bf16_t* xc, const float* cw, const float* cb) {
    const size_t idx = (size_t)vb * 256 + TIDH;
    const int m = (int)(idx / DM), n = (int)(idx % DM);
    xc[idx] = f2bf(conv_xc(mi, m, n, cw, cb));
}

DEV void k_gates(int vb, float* ldsf, const bf16_t* q, const bf16_t* k, const bf16_t* v, const float* wg  , const float* bi, const float* bfg,
                                               float* ipre, float* logf) {
    float (*red)[8] = (float (*)[8])ldsf;
    const int m = vb, t = TIDH;
    __syncthreads();
    float acc[8];
#pragma unroll
    for (int j = 0; j < 8; ++j) acc[j] = 0.f;
    for (int e = t; e < 3 * DM; e += 256) {
        const bf16_t* src = (e < DM) ? q : (e < 2 * DM ? k : v);
        const float xv = bf2f(src[(size_t)m * DM + (e & (DM - 1))]);
#pragma unroll
        for (int j = 0; j < 8; ++j) acc[j] += xv * wg[e * 8 + j];
    }
#pragma unroll
    for (int j = 0; j < 8; ++j) acc[j] = wave_sum(acc[j]);
    if ((t & 63) == 0) {
#pragma unroll
        for (int j = 0; j < 8; ++j) red[t >> 6][j] = acc[j];
    }
    __syncthreads();
    if (t < 8) {
        const float s = red[0][t] + red[1][t] + red[2][t] + red[3][t];
        if (t < 4) ipre[(size_t)m * 4 + t] = s + bi[t];
        else logf[(size_t)m * 4 + (t - 4)] = logsigmoidf_(s + bfg[t - 4]);
    }
}

DEV void k_mlstm(int vb, float* ldsf, const bf16_t* q, const bf16_t* k, const bf16_t* v, const float* ipre, const float* logf, bf16_t* hc) {
    float (*Cs)[257] = (float (*)[257])ldsf;
    float (*St)[65] = (float (*)[65])(ldsf + 32 * 257);
    float* nvec = ldsf + 32 * 257 + 64 * 65;
    float* bcum = nvec + 256; float* ig = bcum + 64; float* mt = ig + 64; float* winter = mt + 64; float* ws_ = winter + 64; float* hden = ws_ + 64;
    float* sc = hden + 64;
    const int tid = TIDH;
    const int vs = vb & 7, h = (vb >> 3) & 3, b = vb >> 5;
    __syncthreads();
    for (int i = tid; i < 32 * 257; i += 256) (&Cs[0][0])[i] = 0.f;
    nvec[tid] = 0.f;
    if (tid == 0) sc[0] = 0.f;
    __syncthreads();
    const size_t base = (size_t)b * SEQ * DM + h * DH;
    for (int j = 0; j < SEQ / CHUNK; ++j) {
        const size_t cb = base + (size_t)j * CHUNK * DM;
        const int m0 = b * SEQ + j * CHUNK;
        if (tid < 64) {
            ig[tid] = ipre[(size_t)(m0 + tid) * 4 + h];
            ws_[tid] = logf[(size_t)(m0 + tid) * 4 + h];
        }
        __syncthreads();
        if (tid < 64) { float s = 0.f; for (int i = 0; i <= tid; ++i) s += ws_[i]; bcum[tid] = s; }
        __syncthreads();
        const float m_prev = sc[0];
        if (tid < 64) {
            const float m_inter = bcum[tid] + m_prev;
            float mx = -INFINITY;
            for (int s = 0; s <= tid; ++s) mx = fmaxf(mx, bcum[tid] - bcum[s] + ig[s]);
            const float m = fmaxf(m_inter, mx);
            mt[tid] = m; winter[tid] = __expf(m_inter - m);
        }
        __syncthreads();
        for (int idx = tid; idx < 4096; idx += 256) {
            const int t = idx >> 6, s = idx & 63;
            float r = 0.f;
            if (s <= t) {
                const bf16_t* qp = q + cb + (size_t)t * DM; const bf16_t* kp = k + cb + (size_t)s * DM;
                float dot = 0.f;
                for (int d = 0; d < DH; d += 8) {
                    const uint4 qa = *(const uint4*)(qp + d), ka = *(const uint4*)(kp + d);
                    dot += bf2f(qa.x & 0xffff) * bf2f(ka.x & 0xffff) + bf2f(qa.x >> 16) * bf2f(ka.x >> 16);
                    dot += bf2f(qa.y & 0xffff) * bf2f(ka.y & 0xffff) + bf2f(qa.y >> 16) * bf2f(ka.y >> 16);
                    dot += bf2f(qa.z & 0xffff) * bf2f(ka.z & 0xffff) + bf2f(qa.z >> 16) * bf2f(ka.z >> 16);
                    dot += bf2f(qa.w & 0xffff) * bf2f(ka.w & 0xffff) + bf2f(qa.w >> 16) * bf2f(ka.w >> 16);
                }
                r = dot * __expf(bcum[t] - bcum[s] + ig[s] - mt[t]);
            }
            St[t][s] = r;
        }
        __syncthreads();
        if (tid < 64) {
            const bf16_t* qp = q + cb + (size_t)tid * DM;
            float dn = 0.f;
            for (int d = 0; d < DH; ++d) dn += nvec[d] * bf2f(qp[d]);
            float sm = 0.f;
            for (int s = 0; s < 64; ++s) sm += St[tid][s];
            const float den = winter[tid] * dn + sm;
            hden[tid] = fmaxf(fabsf(den), __expf(-mt[tid]));
        }
        __syncthreads();
        for (int idx = tid; idx < 2048; idx += 256) {
            const int t = idx >> 5, vv = idx & 31;
            const bf16_t* qp = q + cb + (size_t)t * DM;
            float a = 0.f;
            for (int d = 0; d < DH; ++d) a += Cs[vv][d] * bf2f(qp[d]);
            float s2 = 0.f;
            for (int s = 0; s < 64; ++s) s2 += St[t][s] * bf2f(v[cb + (size_t)s * DM + vs * 32 + vv]);
            const float num = winter[t] * a + s2;
            hc[cb + (size_t)t * DM + vs * 32 + vv] = f2bf(num / hden[t]);
        }
        __syncthreads();
        const float b_tot = bcum[63];
        if (tid < 64) ws_[tid] = b_tot - bcum[tid] + ig[tid];
        __syncthreads();
        if (tid == 0) {
            float mx = b_tot + m_prev;
            for (int s = 0; s < 64; ++s) mx = fmaxf(mx, ws_[s]);
            sc[1] = __expf(b_tot + m_prev - mx); sc[0] = mx;
        }
        __syncthreads();
        const float m_next = sc[0], decay = sc[1];
        float myw = 0.f;
        if (tid < 64) myw = __expf(ws_[tid] - m_next);
        __syncthreads();
        if (tid < 64) ws_[tid] = myw;
        __syncthreads();
        for (int idx = tid; idx < 32 * 256; idx += 256) {
            const int vv = idx >> 8, d = idx & 255;
            float a = 0.f;
            for (int s = 0; s < 64; ++s) a += ws_[s] * bf2f(v[cb + (size_t)s * DM + vs * 32 + vv]) * bf2f(k[cb + (size_t)s * DM + d]);
            Cs[vv][d] = decay * Cs[vv][d] + a;
        }
        {
            float a = 0.f;
            for (int s = 0; s < 64; ++s) a += ws_[s] * bf2f(k[cb + (size_t)s * DM + tid]);
            nvec[tid] = decay * nvec[tid] + a;
        }
        __syncthreads();
    }
}

DEV void k_mlstm_post(int vb, bf16_t* hc, const bf16_t* mo, const bf16_t* mg, const bf16_t* mi, const float* cw, const float* cb,
                                                    const float* ngain, const float* skip) {
    const int m = vb, t = TIDH;
    float hv[4]; float s = 0.f;
#pragma unroll
    for (int i = 0; i < 4; ++i) {
        const size_t o = (size_t)m * DM + t * 4 + i;
        hv[i] = bf2f(hc[o]) * sigmoidf_(bf2f(mo[o])); s += hv[i];
    }
    const float mu = wave_sum(s) * (1.f / DH);
    float s2 = 0.f;
#pragma unroll
    for (int i = 0; i < 4; ++i) { hv[i] -= mu; s2 += hv[i] * hv[i]; }
    const float rstd = rsqrtf(wave_sum(s2) * (1.f / DH) + EPS);
#pragma unroll
    for (int i = 0; i < 4; ++i) {
        const int n = t * 4 + i; const size_t o = (size_t)m * DM + n;
        const float xc = conv_xc(mi, m, n, cw, cb);
        const float hn = hv[i] * rstd * ngain[n] + skip[n] * xc;
        hc[o] = f2bf(hn * siluf_(bf2f(mg[o])));
    }
}

DEV void k_final(int vb, float* red, float* x, const float* gain) {
    const int m = vb, t = TIDH;
    float4 v = ((float4*)(x + (size_t)m * DM))[t];
    float ss = v.x * v.x + v.y * v.y + v.z * v.z + v.w * v.w;
    ss = block_sum256(ss, red);
    const float rstd = rsqrtf(ss * (1.f / DM) + EPS);
    const float4 g = ((const float4*)gain)[t];
    v.x *= rstd * g.x; v.y *= rstd * g.y; v.z *= rstd * g.z; v.w *= rstd * g.w;
    ((float4*)(x + (size_t)m * DM))[t] = v;
}


#define LAS __attribute__((address_space(3)))
typedef short bf16x8 __attribute__((ext_vector_type(8)));
typedef float f32x4 __attribute__((ext_vector_type(4)));
typedef short s16x4 __attribute__((ext_vector_type(4)));
typedef unsigned u32x4 __attribute__((ext_vector_type(4)));
typedef unsigned u32x2 __attribute__((ext_vector_type(2)));
typedef float f32x2 __attribute__((ext_vector_type(2)));
#define WAIT_V(n) asm volatile("s_waitcnt vmcnt(" #n ")" ::: "memory")
#define WAIT_L(n) asm volatile("s_waitcnt lgkmcnt(" #n ")" ::: "memory")
#define SCHED() __builtin_amdgcn_sched_barrier(0)

DEV int lds_byte(int r, int c) { int st = (r >> 4) * 2 + (c >> 5), ob = (r & 15) * 64 + (c & 31) * 2; return st * 1024 + (ob ^ (((ob >> 9) & 1) << 5)); }
DEV void stage_rc(int b, int& R, int& C) { int st = b >> 10, sb = b & 1023, swz = sb ^ (((sb >> 9) & 1) << 5); R = (st >> 1) * 16 + swz / 64; C = (st & 1) * 32 + (swz % 64) / 2; }
template <class T> DEV T* sel3(int w, T* p0, T* p1, T* p2) { return p0 + ((w >= 1) ? (p1 - p0) : 0) + ((w >= 2) ? (p2 - p1) : 0); }
DEV void unpack8(const uint4 v, float* f) {
    f[0] = bf2f((bf16_t)(v.x & 0xffff)); f[1] = bf2f((bf16_t)(v.x >> 16)); f[2] = bf2f((bf16_t)(v.y & 0xffff)); f[3] = bf2f((bf16_t)(v.y >> 16));
    f[4] = bf2f((bf16_t)(v.z & 0xffff)); f[5] = bf2f((bf16_t)(v.z >> 16)); f[6] = bf2f((bf16_t)(v.w & 0xffff)); f[7] = bf2f((bf16_t)(v.w >> 16));
}
DEV uint4 pack8(const float* f) { return make_uint4(pk2(f[0], f[1]), pk2(f[2], f[3]), pk2(f[4], f[5]), pk2(f[6], f[7])); }
DEV uint2 pack4(f32x4 v) { uint2 r; r.x = pk2(v[0], v[1]); r.y = pk2(v[2], v[3]); return r; }

struct GemmCtx { int wid, lane, wr, wc, fr, fq; int sR[4], sC[4]; };
DEV GemmCtx gemm_ctx() {
    GemmCtx c; const int tid = opaque_tid();
    c.wid = __builtin_amdgcn_readfirstlane(tid >> 6); c.lane = tid & 63; c.wr = c.wid >> 2; c.wc = c.wid & 3; c.fr = c.lane & 15; c.fq = c.lane >> 4;
#pragma unroll
    for (int i = 0; i < 4; ++i) stage_rc(c.wid * 1024 + i * 8192 + c.lane * 16, c.sR[i], c.sC[i]);
    return c;
}
DEV void gemm_mainloop(LAS char* shm, const GemmCtx& c, const bf16_t* A1row, const bf16_t* A2row, int ktsplit, int lda, const bf16_t* Bb, int ldb, int nt, f32x4 (&acc)[8][4]) {
    constexpr int TILE_B = 256 * 64 * 2, STAGE_B = 2 * TILE_B;
    const int wid = c.wid, wr = c.wr, wc = c.wc, fr = c.fr, fq = c.fq;
    unsigned voA[4], voB[4];
#pragma unroll
    for (int i = 0; i < 4; ++i) { voA[i] = (unsigned)(c.sR[i] * lda + c.sC[i]) * 2u; voB[i] = (unsigned)(c.sR[i] * ldb + c.sC[i]) * 2u; asm volatile("" : "+v"(voA[i]), "+v"(voB[i])); }
#define GLDS_STAGE(buf, kt) do { const char* Ak_ = (const char*)(((kt) < ktsplit) ? (A1row + (kt) * 64) : (A2row + ((kt) - ktsplit) * 64)); const char* Bk_ = (const char*)(Bb + (kt) * 64); \
        _Pragma("unroll") for (int i = 0; i < 4; ++i) { \
            __builtin_amdgcn_global_load_lds((const unsigned*)(Ak_ + voA[i]), (LAS unsigned*)(shm + (buf) * STAGE_B + wid * 1024 + i * 8192), 16, 0, 0); \
            __builtin_amdgcn_global_load_lds((const unsigned*)(Bk_ + voB[i]), (LAS unsigned*)(shm + (buf) * STAGE_B + TILE_B + wid * 1024 + i * 8192), 16, 0, 0); } } while (0)
#pragma unroll
    for (int m = 0; m < 8; ++m)
#pragma unroll
        for (int n = 0; n < 4; ++n) acc[m][n] = (f32x4){0.f, 0.f, 0.f, 0.f};
    GLDS_STAGE(0, 0); WAIT_V(0); __syncthreads();
#pragma nounroll
    for (int kt = 0; kt < nt; ++kt) {
        const int cur = kt & 1;
        if (kt + 1 < nt) GLDS_STAGE(cur ^ 1, kt + 1);
#pragma unroll
        for (int ks = 0; ks < 2; ++ks) {
            bf16x8 At[8], Bf[4];
#pragma unroll
            for (int m = 0; m < 8; ++m) At[m] = *(const LAS bf16x8*)(shm + cur * STAGE_B + lds_byte(wr * 128 + m * 16 + fr, ks * 32 + fq * 8));
#pragma unroll
            for (int n = 0; n < 4; ++n) Bf[n] = *(const LAS bf16x8*)(shm + cur * STAGE_B + TILE_B + lds_byte(wc * 64 + n * 16 + fr, ks * 32 + fq * 8));
#pragma unroll
            for (int m = 0; m < 8; ++m)
#pragma unroll
                for (int n = 0; n < 4; ++n) acc[m][n] = __builtin_amdgcn_mfma_f32_16x16x32_bf16(Bf[n], At[m], acc[m][n], 0, 0, 0);
            SCHED();
        }
        WAIT_V(0); __syncthreads();
    }
#undef GLDS_STAGE
}
DEV void tile_map(int t, int nN, int& pm, int& pn) {
    const int base = t & ~255, loc = t & 255;
    const int w = base + (loc & 7) * 32 + (loc >> 3);
    const int nig = 8 * nN, gid = w / nig;
    pm = gid * 8 + (w % nig) % 8; pn = (w % nig) / 8;
}
template <class Prob>
DEV void gemm_phase(LAS char* shm, const Prob& pb) {
    const GemmCtx c = gemm_ctx();
    const int nN = pb.nN, ntiles = 64 * nN;
    for (int t = blockIdx.x; t < ntiles; t += gridDim.x) {
        int pm, pn; tile_map(t, nN, pm, pn);
        const int brow = pm * 256, bcol = pn * 256;
        f32x4 acc[8][4];
        gemm_mainloop(shm, c, pb.a1(pn) + (long)brow * Prob::lda, pb.a2(pn) + (long)brow * Prob::lda, Prob::ktsplit, Prob::lda, pb.bptr(pn), Prob::ldb, Prob::K / 64, acc);
        pb.epi_begin(shm, c, pn, brow);
#pragma unroll
        for (int m = 0; m < 8; ++m)
#pragma unroll
            for (int n = 0; n < 4; ++n) pb.epi(pn, brow + c.wr * 128 + m * 16 + c.fr, bcol + c.wc * 64 + n * 16 + c.fq * 4, acc[m][n]);
        pb.epi_end(c, pn, brow, acc);
    }
}

struct ProbG1 {
    static constexpr int K = 1024, lda = 1024, ldb = 1024, ktsplit = 1 << 20;
    const bf16_t* H; const bf16_t* Wt; bf16_t* U; bf16_t* MI; int nN;
    DEV const bf16_t* a1(int pn) const { return H; }
    DEV const bf16_t* a2(int pn) const { return H; }
    DEV const bf16_t* bptr(int pn) const { return Wt + (long)((pn < 4) ? pn * 256 : 2048 + (pn - 4) * 256) * 1024; }
    DEV void epi_begin(LAS char*, const GemmCtx&, int, int) const {}
    DEV void epi(int pn, int row, int col, f32x4 v) const { bf16_t* C = (pn < 4) ? U : MI; *(uint2*)(C + (size_t)row * DM + (col & 1023)) = pack4(v); }
    DEV void epi_end(const GemmCtx&, int, int, f32x4 (&)[8][4]) const {}
};
struct ProbGlu {
    static constexpr int K = 1024, lda = 1024, ldb = 1024, ktsplit = 1 << 20;
    const bf16_t* Y; const bf16_t* Wt; bf16_t* Z; const float* bias; float* rowss; int nN;
    DEV const bf16_t* a1(int pn) const { return Y; }
    DEV const bf16_t* a2(int pn) const { return Y; }
    DEV const bf16_t* bptr(int pn) const { return Wt + (long)pn * 256 * 1024; }
    DEV void epi_begin(LAS char*, const GemmCtx&, int, int) const {}
    DEV void epi(int pn, int row, int col, f32x4 v) const {}
    DEV void epi_end(const GemmCtx& c0, int pn, int brow, f32x4 (&acc)[8][4]) const {
        struct { int fr, fq, wr, wc; } c = {c0.fr, c0.fq, c0.wr, c0.wc};
        asm volatile("" : "+v"(c.fr), "+v"(c.fq));
#pragma unroll
        for (int m = 0; m < 8; ++m) {
            SCHED();
            const int row = brow + c.wr * 128 + m * 16 + c.fr;
            float ss = 0.f;
#pragma unroll
            for (int n = 0; n < 4; ++n) {
                const int col = pn * 256 + c.wc * 64 + n * 16 + c.fq * 4;
                const uint2 yv = *(const uint2*)(Y + (size_t)row * DM + col);
                const float4 b = *(const float4*)(bias + col);
                f32x4 o;
                o[0] = bf2f(yv.x & 0xffff) * sigmoidf_(acc[m][n][0] + b.x); o[1] = bf2f(yv.x >> 16) * sigmoidf_(acc[m][n][1] + b.y);
                o[2] = bf2f(yv.y & 0xffff) * sigmoidf_(acc[m][n][2] + b.z); o[3] = bf2f(yv.y >> 16) * sigmoidf_(acc[m][n][3] + b.w);
                const uint2 pk = pack4(o);
                *(uint2*)(Z + (size_t)row * DM + col) = pk;
                const float r0 = bf2f(pk.x & 0xffff), r1 = bf2f(pk.x >> 16), r2 = bf2f(pk.y & 0xffff), r3 = bf2f(pk.y >> 16);
                ss += r0 * r0 + r1 * r1 + r2 * r2 + r3 * r3;
            }
            ss += __shfl_xor(ss, 16); ss += __shfl_xor(ss, 32);
            if (c.fq == 0) rowss[(size_t)(pn * 4 + c.wc) * MTOK + row] = ss;
        }
    }
};
struct ProbQkv {
    static constexpr int K = 256, lda = 1024, ldb = 256, ktsplit = 1 << 20;
    const bf16_t* XC; const bf16_t* MI; const bf16_t* Wt; bf16_t* Q; bf16_t* Kk; bf16_t* V; int nN;
    DEV const bf16_t* a1(int pn) const { return ((pn >> 2) == 2 ? MI : XC) + (pn & 3) * 256; }
    DEV const bf16_t* a2(int pn) const { return a1(pn); }
    DEV const bf16_t* bptr(int pn) const { return Wt + (long)pn * 256 * 256; }
    DEV void epi_begin(LAS char*, const GemmCtx&, int, int) const {}
    DEV void epi(int pn, int row, int col, f32x4 v) const {
        const int which = pn >> 2; bf16_t* C = sel3(which, Q, Kk, V);
        if (which == 1) { v[0] *= 0.0625f; v[1] *= 0.0625f; v[2] *= 0.0625f; v[3] *= 0.0625f; }
        *(uint2*)(C + (size_t)row * DM + (col & 1023)) = pack4(v);
    }
    DEV void epi_end(const GemmCtx&, int, int, f32x4 (&)[8][4]) const {}
};
struct ProbOut {
    static constexpr int K = 2048, lda = 1024, ldb = 2048, ktsplit = 16;
    const bf16_t* A1; const bf16_t* A2; const bf16_t* Wt; const float* xin; float* xout; const float* gate; int nN;
    DEV const bf16_t* a1(int pn) const { return A1; }
    DEV const bf16_t* a2(int pn) const { return A2; }
    DEV const bf16_t* bptr(int pn) const { return Wt + (long)pn * 256 * 2048; }
    DEV void epi_begin(LAS char*, const GemmCtx&, int, int) const {}
    DEV void epi(int pn, int row, int col, f32x4 v) const {
        const int b = row / SEQ;
        const float4 xi = *(const float4*)(xin + (size_t)row * DM + col);
        const float4 g = *(const float4*)(gate + (size_t)b * 3 * DM + col);
        float4 o; o.x = xi.x + g.x * v[0]; o.y = xi.y + g.y * v[1]; o.z = xi.z + g.z * v[2]; o.w = xi.w + g.w * v[3];
        *(float4*)(xout + (size_t)row * DM + col) = o;
    }
    DEV void epi_end(const GemmCtx&, int, int, f32x4 (&)[8][4]) const {}
};

struct G2Args {
    const bf16_t* H; const bf16_t* Wt;
    bf16_t* Z; const float* rowss; const float* og;
    bf16_t* HC; const bf16_t* XC; const float* ngain; const float* skip;
};
DEV void gemm2_phase(LAS char* shm, const G2Args& g) {
    const GemmCtx c = gemm_ctx();
    int efr, efq;
    LAS float* rst = (LAS float*)(shm + 131072);
    LAS float* red = (LAS float*)(shm + 131072 + 1024);
    for (int u = blockIdx.x; u < 512; u += gridDim.x) {
        f32x4 acc[8][4];
        if (u < 256) {
            int pm, pn; tile_map(u, 4, pm, pn);
            const int brow = pm * 256, bcol = pn * 256;
            gemm_mainloop(shm, c, g.H + (long)brow * DM, g.H, 1 << 20, DM, g.Wt + (long)(1024 + bcol) * DM, DM, 16, acc);
            efr = c.fr; efq = c.fq; asm volatile("" : "+v"(efr), "+v"(efq));
            { const int tid = c.wid * 64 + c.lane;
              if (tid < 256) { float s_ = 0.f;
#pragma unroll
                  for (int p_ = 0; p_ < 16; ++p_) s_ += g.rowss[(size_t)p_ * MTOK + brow + tid];
                  rst[tid] = rsqrtf(s_ * (1.f / DM) + EPS); } }
            __syncthreads();
#pragma unroll
            for (int m = 0; m < 8; ++m) {
                SCHED();
                const int rl = c.wr * 128 + m * 16 + efr, row = brow + rl;
                const float rs = rst[rl];
#pragma unroll
                for (int n = 0; n < 4; ++n) {
                    const int col = bcol + c.wc * 64 + n * 16 + efq * 4;
                    const uint2 zv = *(const uint2*)(g.Z + (size_t)row * DM + col);
                    const float4 gn = *(const float4*)(g.og + col);
                    f32x4 o;
                    o[0] = bf2f(zv.x & 0xffff) * rs * gn.x * siluf_(acc[m][n][0]); o[1] = bf2f(zv.x >> 16) * rs * gn.y * siluf_(acc[m][n][1]);
                    o[2] = bf2f(zv.y & 0xffff) * rs * gn.z * siluf_(acc[m][n][2]); o[3] = bf2f(zv.y >> 16) * rs * gn.w * siluf_(acc[m][n][3]);
                    *(uint2*)(g.Z + (size_t)row * DM + col) = pack4(o);
                }
            }
            __syncthreads();
        } else {
            int pm, hd; tile_map(u - 256, 4, pm, hd);
            const int brow = pm * 256, bcol = hd * 256;
            gemm_mainloop(shm, c, g.H + (long)brow * DM, g.H, 1 << 20, DM, g.Wt + (long)(3072 + bcol) * DM, DM, 16, acc);
            efr = c.fr; efq = c.fq; asm volatile("" : "+v"(efr), "+v"(efq));
        #pragma unroll
            for (int m = 0; m < 8; ++m) {
                SCHED();
                const int row = brow + c.wr * 128 + m * 16 + efr;
                float s_ = 0.f;
#pragma unroll
                for (int n = 0; n < 4; ++n) {
                    const int col = bcol + c.wc * 64 + n * 16 + efq * 4;
                    const uint2 hv = *(const uint2*)(g.HC + (size_t)row * DM + col);
                    acc[m][n][0] = bf2f(hv.x & 0xffff) * sigmoidf_(acc[m][n][0]); acc[m][n][1] = bf2f(hv.x >> 16) * sigmoidf_(acc[m][n][1]);
                    acc[m][n][2] = bf2f(hv.y & 0xffff) * sigmoidf_(acc[m][n][2]); acc[m][n][3] = bf2f(hv.y >> 16) * sigmoidf_(acc[m][n][3]);
                    s_ += (acc[m][n][0] + acc[m][n][1]) + (acc[m][n][2] + acc[m][n][3]);
                }
                s_ += __shfl_xor(s_, 16); s_ += __shfl_xor(s_, 32);
                if (efq == 0) red[c.wid * 128 + m * 16 + efr] = s_;
            }
            __syncthreads();
#pragma unroll
            for (int m = 0; m < 8; ++m) {
                SCHED();
                float tot = 0.f;
#pragma unroll
                for (int w2 = 0; w2 < 4; ++w2) tot += red[(c.wr * 4 + w2) * 128 + m * 16 + efr];
                const float mu = tot * (1.f / DH);
                float s_ = 0.f;
#pragma unroll
                for (int n = 0; n < 4; ++n)
#pragma unroll
                    for (int j = 0; j < 4; ++j) { acc[m][n][j] -= mu; s_ += acc[m][n][j] * acc[m][n][j]; }
                s_ += __shfl_xor(s_, 16); s_ += __shfl_xor(s_, 32);
                if (efq == 0) red[1024 + c.wid * 128 + m * 16 + efr] = s_;
            }
            __syncthreads();
#pragma unroll
            for (int m = 0; m < 8; ++m) {
                SCHED();
                const int row = brow + c.wr * 128 + m * 16 + efr;
                float tot = 0.f;
#pragma unroll
                for (int w2 = 0; w2 < 4; ++w2) tot += red[1024 + (c.wr * 4 + w2) * 128 + m * 16 + efr];
                const float rs = rsqrtf(tot * (1.f / DH) + EPS);
#pragma unroll
                for (int n = 0; n < 4; ++n) {
                    const int col = bcol + c.wc * 64 + n * 16 + efq * 4;
                    const uint2 xv = *(const uint2*)(g.XC + (size_t)row * DM + col);
                    const float4 gn = *(const float4*)(g.ngain + col), sk = *(const float4*)(g.skip + col);
                    f32x4 o;
                    o[0] = acc[m][n][0] * rs * gn.x + sk.x * bf2f(xv.x & 0xffff); o[1] = acc[m][n][1] * rs * gn.y + sk.y * bf2f(xv.x >> 16);
                    o[2] = acc[m][n][2] * rs * gn.z + sk.z * bf2f(xv.y & 0xffff); o[3] = acc[m][n][3] * rs * gn.w + sk.w * bf2f(xv.y >> 16);
                    *(uint2*)(g.HC + (size_t)row * DM + col) = pack4(o);
                }
            }
            gemm_mainloop(shm, c, g.H + (long)brow * DM, g.H, 1 << 20, DM, g.Wt + (long)(4096 + bcol) * DM, DM, 16, acc);
            efr = c.fr; efq = c.fq; asm volatile("" : "+v"(efr), "+v"(efq));
#pragma unroll
            for (int m = 0; m < 8; ++m) {
                SCHED();
                const int row = brow + c.wr * 128 + m * 16 + efr;
#pragma unroll
                for (int n = 0; n < 4; ++n) {
                    const int col = bcol + c.wc * 64 + n * 16 + efq * 4;
                    const uint2 hv = *(const uint2*)(g.HC + (size_t)row * DM + col);
                    f32x4 o;
                    o[0] = bf2f(hv.x & 0xffff) * siluf_(acc[m][n][0]); o[1] = bf2f(hv.x >> 16) * siluf_(acc[m][n][1]);
                    o[2] = bf2f(hv.y & 0xffff) * siluf_(acc[m][n][2]); o[3] = bf2f(hv.y >> 16) * siluf_(acc[m][n][3]);
                    *(uint2*)(g.HC + (size_t)row * DM + col) = pack4(o);
                }
            }
        }
    }
}


namespace g8 {
constexpr int BK = 64, HALFT = 128, HTB = HALFT * BK * 2;
DEV int perm32(int rho) { const int n = rho >> 4, i = rho & 15; return 8 * (i >> 2) + 4 * n + (i & 3); }
struct Unit { const char* A; const char* B; int pm, pn, tag; };
template <class Epi, class Sched>
DEV void gemm_phase(LAS char* lds, const Sched& S, const Epi& E) {
    const int tid = opaque_tid(), wid = __builtin_amdgcn_readfirstlane(tid >> 6), lane = tid & 63, wr = wid >> 2, wc = wid & 3, fr = lane & 15, fq = lane >> 4;
    constexpr int lda = Sched::lda, ldb = Sched::ldb, nt = Sched::K / BK;
    unsigned voffA[2], voffB[2];
#pragma unroll
    for (int i = 0; i < 2; ++i) { int R, C; stage_rc(tid * 16 + i * 8192, R, C); const int Rb = (R & ~31) + perm32(R & 31);
        voffA[i] = (unsigned)(R * lda + C) * 2u; voffB[i] = (unsigned)(Rb * ldb + C) * 2u; asm volatile("" : "+v"(voffA[i]), "+v"(voffB[i])); }
    constexpr size_t kstep = (size_t)(BK * 2), hstepA = (size_t)HALFT * lda * 2, hstepB = (size_t)HALFT * ldb * 2;
    const unsigned ldsw = (unsigned)wid * 1024u;
    const int aoff = lds_byte(wr * 64 + fr, fq * 8), boff = lds_byte(wc * 32 + fr, fq * 8);
#define G8_SA(b, h) (((b) * 2 + (h)) * HTB)
#define G8_SB(b, h) ((4 + (b) * 2 + (h)) * HTB)
#define G8_STAGE(bufoff, gbase, voff) do { _Pragma("unroll") for (int _i = 0; _i < 2; ++_i) \
        __builtin_amdgcn_global_load_lds((const unsigned*)((const char*)(gbase) + (voff)[_i]), (LAS unsigned*)(lds + (bufoff) + ldsw + _i * 8192), 16, 0, 0); } while (0)
#define G8_LDA(dst, b, h) do { _Pragma("unroll") for (int m = 0; m < 4; ++m) _Pragma("unroll") for (int k = 0; k < 2; ++k) dst[m][k] = *(const LAS bf16x8*)(lds + G8_SA(b, h) + aoff + m * 2048 + k * 1024); } while (0)
#define G8_LDB(dst, b, h) do { _Pragma("unroll") for (int n = 0; n < 2; ++n) _Pragma("unroll") for (int k = 0; k < 2; ++k) dst[n][k] = *(const LAS bf16x8*)(lds + G8_SB(b, h) + boff + n * 2048 + k * 1024); } while (0)
#define G8_MMA(ai, bj, At, Bt) do { __builtin_amdgcn_s_setprio(1); _Pragma("unroll") for (int m = 0; m < 4; ++m) _Pragma("unroll") for (int n = 0; n < 2; ++n) _Pragma("unroll") for (int k = 0; k < 2; ++k) \
        acc[ai][bj][m][n] = __builtin_amdgcn_mfma_f32_16x16x32_bf16(Bt[n][k], At[m][k], acc[ai][bj][m][n], 0, 0, 0); __builtin_amdgcn_s_setprio(0); } while (0)
#define G8_WAIT_V(n) asm volatile("s_waitcnt vmcnt(" #n ")" ::: "memory")
#define G8_WAIT_L(n) asm volatile("s_waitcnt lgkmcnt(" #n ")" ::: "memory")
#define G8_BAR __builtin_amdgcn_s_barrier()
#define G8_SCHED __builtin_amdgcn_sched_barrier(0)
    Unit cur, nxt; int ui = 0;
    if (!S.next(0, cur)) return;
    f32x4 acc[2][2][4][2];
#pragma unroll
    for (int a = 0; a < 2; ++a)
#pragma unroll
        for (int b = 0; b < 2; ++b)
#pragma unroll
            for (int m = 0; m < 4; ++m)
#pragma unroll
                for (int n = 0; n < 2; ++n) acc[a][b][m][n] = (f32x4){0.f, 0.f, 0.f, 0.f};
    bf16x8 At[4][2], B0[2][2], B1[2][2];
    const char* cA = cur.A; const char* cB = cur.B;
    G8_STAGE(G8_SB(0, 0), cB, voffB); G8_STAGE(G8_SB(0, 1), cB + hstepB, voffB); G8_STAGE(G8_SA(0, 0), cA, voffA); G8_STAGE(G8_SA(0, 1), cA + hstepA, voffA);
    if (wr == 1) G8_BAR;
    G8_WAIT_V(2); G8_BAR;
    G8_STAGE(G8_SB(1, 0), cB + kstep, voffB); G8_STAGE(G8_SA(1, 0), cA + kstep, voffA); G8_STAGE(G8_SB(1, 1), cB + hstepB + kstep, voffB);
    G8_WAIT_V(6); G8_BAR;
    for (;;) {
        const bool has_next = S.next(ui + 1, nxt);
        const char* nA = has_next ? nxt.A : cA; const char* nB = has_next ? nxt.B : cB;
#pragma nounroll
        for (int t = 0; t < nt; t += 2) {
            const bool last = (t == nt - 2);
            const char* a1 = cA + (size_t)(t + 1) * kstep;
            const char* a2 = last ? nA : cA + (size_t)(t + 2) * kstep; const char* b2 = last ? nB : cB + (size_t)(t + 2) * kstep;
            const char* a3 = a2 + kstep; const char* b3 = b2 + kstep;
            G8_LDB(B0, 0, 0); G8_LDB(B1, 0, 1); G8_SCHED; G8_LDA(At, 0, 0); G8_STAGE(G8_SA(1, 1), a1 + hstepA, voffA);
            G8_WAIT_V(8); G8_WAIT_L(0); G8_BAR; G8_MMA(0, 0, At, B0); G8_MMA(0, 1, At, B1); G8_BAR; G8_SCHED;
            G8_LDA(At, 0, 1); G8_STAGE(G8_SB(0, 0), b2, voffB); G8_STAGE(G8_SB(0, 1), b2 + hstepB, voffB); G8_STAGE(G8_SA(0, 0), a2, voffA);
            G8_WAIT_V(8); G8_WAIT_L(0); G8_BAR; G8_MMA(1, 0, At, B0); G8_MMA(1, 1, At, B1); G8_BAR; G8_SCHED;
            G8_LDB(B0, 1, 0); G8_LDB(B1, 1, 1); G8_SCHED; G8_LDA(At, 1, 0); G8_STAGE(G8_SA(0, 1), a2 + hstepA, voffA);
            G8_WAIT_V(8); G8_WAIT_L(0); G8_BAR; G8_MMA(0, 0, At, B0); G8_MMA(0, 1, At, B1); G8_BAR; G8_SCHED;
            G8_LDA(At, 1, 1); G8_STAGE(G8_SB(1, 0), b3, voffB); G8_STAGE(G8_SB(1, 1), b3 + hstepB, voffB); G8_STAGE(G8_SA(1, 0), a3, voffA);
            G8_WAIT_V(8); G8_WAIT_L(0); G8_BAR; G8_MMA(1, 0, At, B0); G8_MMA(1, 1, At, B1); G8_BAR; G8_SCHED;
        }
        if (wr == 0) G8_BAR;
        E(lds, acc, cur, wr, wc, fr, fq, wid, lane);
        if (!has_next) break;
#pragma unroll
        for (int a = 0; a < 2; ++a)
#pragma unroll
            for (int b = 0; b < 2; ++b)
#pragma unroll
                for (int m = 0; m < 4; ++m)
#pragma unroll
                    for (int n = 0; n < 2; ++n) acc[a][b][m][n] = (f32x4){0.f, 0.f, 0.f, 0.f};
        cur = nxt; cA = nA; cB = nB; ++ui;
        if (wr == 1) G8_BAR;
    }
    G8_WAIT_V(0);
    G8_BAR;
#undef G8_SA
#undef G8_SB
#undef G8_STAGE
#undef G8_LDA
#undef G8_LDB
#undef G8_MMA
#undef G8_WAIT_V
#undef G8_WAIT_L
#undef G8_BAR
#undef G8_SCHED
}
DEV u32x4 pk8(const f32x4 a, const f32x4 b) { return (u32x4){pk2(a[0], a[1]), pk2(a[2], a[3]), pk2(b[0], b[1]), pk2(b[2], b[3])}; }
DEV void un8(const u32x4 v, float* f) { unpack8(make_uint4(v[0], v[1], v[2], v[3]), f); }
#define G8_ROWS_BEGIN _Pragma("unroll") for (int ai = 0; ai < 2; ++ai) _Pragma("unroll") for (int m = 0; m < 4; ++m) { const int rl = 128 * ai + 64 * wr + 16 * m + fr;
#define G8_ROWS_END }

struct SchedG1 { static constexpr int K = 1024, lda = 1024, ldb = 1024; const bf16_t* H; const bf16_t* Wt; int bid, G;
    DEV bool next(int i, Unit& u) const { const int t = bid + i * G; if (t >= 512) return false; int pm, pn; tile_map(t, 8, pm, pn);
        u.pm = pm; u.pn = pn; u.tag = 0; u.A = (const char*)(H + (size_t)pm * 256 * DM); u.B = (const char*)(Wt + (size_t)((pn < 4) ? pn * 256 : 2048 + (pn - 4) * 256) * DM); return true; } };
struct EpiG1 { bf16_t* U; bf16_t* MI;
    DEV void operator()(LAS char*, const f32x4 (&acc)[2][2][4][2], const Unit& u, int wr, int wc, int fr, int fq, int, int) const {
        bf16_t* C = (u.pn < 4) ? U : MI; const int c0 = (u.pn & 3) * 256 + 32 * wc + 8 * fq;
        G8_ROWS_BEGIN bf16_t* rp = C + (size_t)(u.pm * 256 + rl) * DM + c0;
#pragma unroll
            for (int bj = 0; bj < 2; ++bj) *(u32x4*)(rp + 128 * bj) = pk8(acc[ai][bj][m][0], acc[ai][bj][m][1]); G8_ROWS_END } };
struct SchedGlu { static constexpr int K = 1024, lda = 1024, ldb = 1024; const bf16_t* Y; const bf16_t* Wt; int bid, G;
    DEV bool next(int i, Unit& u) const { const int t = bid + i * G; if (t >= 256) return false; int pm, pn; tile_map(t, 4, pm, pn);
        u.pm = pm; u.pn = pn; u.tag = 0; u.A = (const char*)(Y + (size_t)pm * 256 * DM); u.B = (const char*)(Wt + (size_t)pn * 256 * DM); return true; } };
struct EpiGlu { const bf16_t* Y; bf16_t* Z; const float* bias; float* rowss;
    DEV void operator()(LAS char*, const f32x4 (&acc)[2][2][4][2], const Unit& u, int wr, int wc, int fr, int fq, int, int) const {
        const int c0 = u.pn * 256 + 32 * wc + 8 * fq;
        G8_ROWS_BEGIN const size_t ro = (size_t)(u.pm * 256 + rl) * DM + c0; float ss = 0.f;
#pragma unroll
            for (int bj = 0; bj < 2; ++bj) {
                float y8[8]; un8(*(const u32x4*)(Y + ro + 128 * bj), y8);
                const float4 b0 = *(const float4*)(bias + c0 + 128 * bj), b1 = *(const float4*)(bias + c0 + 128 * bj + 4);
                f32x4 o0, o1;
                o0[0] = y8[0] * sigmoidf_(acc[ai][bj][m][0][0] + b0.x); o0[1] = y8[1] * sigmoidf_(acc[ai][bj][m][0][1] + b0.y); o0[2] = y8[2] * sigmoidf_(acc[ai][bj][m][0][2] + b0.z); o0[3] = y8[3] * sigmoidf_(acc[ai][bj][m][0][3] + b0.w);
                o1[0] = y8[4] * sigmoidf_(acc[ai][bj][m][1][0] + b1.x); o1[1] = y8[5] * sigmoidf_(acc[ai][bj][m][1][1] + b1.y); o1[2] = y8[6] * sigmoidf_(acc[ai][bj][m][1][2] + b1.z); o1[3] = y8[7] * sigmoidf_(acc[ai][bj][m][1][3] + b1.w);
                const u32x4 pk = pk8(o0, o1); *(u32x4*)(Z + ro + 128 * bj) = pk;
                float r8[8]; un8(pk, r8);
#pragma unroll
                for (int e = 0; e < 8; ++e) ss += r8[e] * r8[e];
            }
            ss += __shfl_xor(ss, 16); ss += __shfl_xor(ss, 32);
            if (fq == 0) rowss[(size_t)(u.pn * 4 + wc) * MTOK + u.pm * 256 + rl] = ss; G8_ROWS_END } };
struct SchedQkv { static constexpr int K = 256, lda = 1024, ldb = 256; const bf16_t* XC; const bf16_t* MI; const bf16_t* Wt; int bid, G;
    DEV bool next(int i, Unit& u) const { const int t = bid + i * G; if (t >= 768) return false; int pm, pn; tile_map(t, 12, pm, pn);
        u.pm = pm; u.pn = pn; u.tag = 0; u.A = (const char*)(((pn >> 2) == 2 ? MI : XC) + (size_t)pm * 256 * DM + (pn & 3) * 256); u.B = (const char*)(Wt + (size_t)pn * 256 * 256); return true; } };
struct EpiQkv { bf16_t* Q; bf16_t* Kk; bf16_t* V;
    DEV void operator()(LAS char*, const f32x4 (&acc)[2][2][4][2], const Unit& u, int wr, int wc, int fr, int fq, int, int) const {
        const int which = u.pn >> 2; bf16_t* C = sel3(which, Q, Kk, V); const float sc = (which == 1) ? 0.0625f : 1.f;
        const int c0 = (u.pn & 3) * 256 + 32 * wc + 8 * fq;
        G8_ROWS_BEGIN bf16_t* rp = C + (size_t)(u.pm * 256 + rl) * DM + c0;
#pragma unroll
            for (int bj = 0; bj < 2; ++bj) *(u32x4*)(rp + 128 * bj) = pk8(acc[ai][bj][m][0] * sc, acc[ai][bj][m][1] * sc); G8_ROWS_END } };
struct SchedOut { static constexpr int K = 2048, lda = 2048, ldb = 2048; const bf16_t* MX; const bf16_t* Wt; int bid, G;
    DEV bool next(int i, Unit& u) const { const int t = bid + i * G; if (t >= 256) return false; int pm, pn; tile_map(t, 4, pm, pn);
        u.pm = pm; u.pn = pn; u.tag = 0; u.A = (const char*)(MX + (size_t)pm * 256 * 2048); u.B = (const char*)(Wt + (size_t)pn * 256 * 2048); return true; } };
template <bool FINAL>
struct EpiOutN { const float* xin; float* xout; const float* gate; const float* ngain; const float* modn; bf16_t* Hn; float* xss; unsigned* cnt; unsigned* tmo;
    DEV void operator()(LAS char* lds, f32x4 (&acc)[2][2][4][2], const Unit& u, int wr, int wc, int fr, int fq, int wid, int lane) const {
        asm volatile("" : "+v"(fr), "+v"(fq));
        LAS float* red = (LAS float*)(lds + 131072);
        LAS float* rst = (LAS float*)(lds + 131072 + 4096);
        const int c0 = u.pn * 256 + 32 * wc + 8 * fq, bidx = (u.pm * 256) / SEQ; const float* gp = gate + (size_t)bidx * 3 * DM + c0;
        G8_ROWS_BEGIN const size_t ro = (size_t)(u.pm * 256 + rl) * DM + c0; float ss = 0.f;
#pragma unroll
            for (int bj = 0; bj < 2; ++bj)
#pragma unroll
                for (int n = 0; n < 2; ++n) {
                    const float4 xi = *(const float4*)(xin + ro + 128 * bj + 4 * n), g4 = *(const float4*)(gp + 128 * bj + 4 * n);
                    f32x4 o; o[0] = xi.x + g4.x * acc[ai][bj][m][n][0]; o[1] = xi.y + g4.y * acc[ai][bj][m][n][1]; o[2] = xi.z + g4.z * acc[ai][bj][m][n][2]; o[3] = xi.w + g4.w * acc[ai][bj][m][n][3];
                    acc[ai][bj][m][n] = o; ss += (o[0] * o[0] + o[1] * o[1]) + (o[2] * o[2] + o[3] * o[3]);
                    if (!FINAL) *(float4*)(xout + ro + 128 * bj + 4 * n) = make_float4(o[0], o[1], o[2], o[3]); }
            ss += __shfl_xor(ss, 16); ss += __shfl_xor(ss, 32);
            if (fq == 0) red[wid * 128 + 64 * ai + 16 * m + fr] = ss; G8_ROWS_END
        asm volatile("s_waitcnt lgkmcnt(0)" ::: "memory"); __builtin_amdgcn_s_barrier();
        const int tid = wid * 64 + lane;
        if (tid < 256) {
            const int r_ = tid, w0 = (r_ >> 6) & 1, ix = (r_ & 63) + 64 * (r_ >> 7);
            const float t_ = red[(w0 * 4 + 0) * 128 + ix] + red[(w0 * 4 + 1) * 128 + ix] + red[(w0 * 4 + 2) * 128 + ix] + red[(w0 * 4 + 3) * 128 + ix];
            __hip_atomic_store(xss + ((size_t)(u.pm * 256 + r_) * 4 + u.pn), t_, __ATOMIC_RELAXED, __HIP_MEMORY_SCOPE_AGENT);
        }
        asm volatile("s_waitcnt vmcnt(0)" ::: "memory"); __builtin_amdgcn_s_barrier();
        if (tid == 0) {
            __hip_atomic_fetch_add(cnt + 64 * u.pm, 1u, __ATOMIC_RELAXED, __HIP_MEMORY_SCOPE_AGENT);
            unsigned sp_ = 0;
            while (__hip_atomic_load(cnt + 64 * u.pm, __ATOMIC_RELAXED, __HIP_MEMORY_SCOPE_AGENT) < 4u) { __builtin_amdgcn_s_sleep(1); if (++sp_ > (1u << 22)) { atomicAdd(tmo, 1u); break; } }
        }
        __builtin_amdgcn_s_barrier();
        if (tid < 256) {
            const float* xp = xss + (size_t)(u.pm * 256 + tid) * 4;
            const float t_ = __hip_atomic_load(xp, __ATOMIC_RELAXED, __HIP_MEMORY_SCOPE_AGENT) + __hip_atomic_load(xp + 1, __ATOMIC_RELAXED, __HIP_MEMORY_SCOPE_AGENT)
                           + __hip_atomic_load(xp + 2, __ATOMIC_RELAXED, __HIP_MEMORY_SCOPE_AGENT) + __hip_atomic_load(xp + 3, __ATOMIC_RELAXED, __HIP_MEMORY_SCOPE_AGENT);
            rst[tid] = rsqrtf(t_ * (1.f / DM) + EPS);
        }
        asm volatile("s_waitcnt vmcnt(0) lgkmcnt(0)" ::: "memory"); __builtin_amdgcn_s_barrier();
        const float* shp = modn + (size_t)bidx * 3 * DM + c0;
        G8_ROWS_BEGIN const size_t ro = (size_t)(u.pm * 256 + rl) * DM + c0; const float rs = rst[rl];
#pragma unroll
            for (int bj = 0; bj < 2; ++bj) {
                const float4 g0 = *(const float4*)(ngain + c0 + 128 * bj), g1 = *(const float4*)(ngain + c0 + 128 * bj + 4);
                if (FINAL) {
                    *(float4*)(xout + ro + 128 * bj) = make_float4(acc[ai][bj][m][0][0] * rs * g0.x, acc[ai][bj][m][0][1] * rs * g0.y, acc[ai][bj][m][0][2] * rs * g0.z, acc[ai][bj][m][0][3] * rs * g0.w);
                    *(float4*)(xout + ro + 128 * bj + 4) = make_float4(acc[ai][bj][m][1][0] * rs * g1.x, acc[ai][bj][m][1][1] * rs * g1.y, acc[ai][bj][m][1][2] * rs * g1.z, acc[ai][bj][m][1][3] * rs * g1.w);
                } else {
                    const float4 h0 = *(const float4*)(shp + 128 * bj), h1 = *(const float4*)(shp + 128 * bj + 4), s0 = *(const float4*)(shp + DM + 128 * bj), s1 = *(const float4*)(shp + DM + 128 * bj + 4);
                    f32x4 o0, o1;
                    o0[0] = acc[ai][bj][m][0][0] * rs * g0.x * (1.f + s0.x) + h0.x; o0[1] = acc[ai][bj][m][0][1] * rs * g0.y * (1.f + s0.y) + h0.y; o0[2] = acc[ai][bj][m][0][2] * rs * g0.z * (1.f + s0.z) + h0.z; o0[3] = acc[ai][bj][m][0][3] * rs * g0.w * (1.f + s0.w) + h0.w;
                    o1[0] = acc[ai][bj][m][1][0] * rs * g1.x * (1.f + s1.x) + h1.x; o1[1] = acc[ai][bj][m][1][1] * rs * g1.y * (1.f + s1.y) + h1.y; o1[2] = acc[ai][bj][m][1][2] * rs * g1.z * (1.f + s1.z) + h1.z; o1[3] = acc[ai][bj][m][1][3] * rs * g1.w * (1.f + s1.w) + h1.w;
                    *(u32x4*)(Hn + ro + 128 * bj) = pk8(o0, o1);
                } } G8_ROWS_END
    } };
struct SchedG2s { static constexpr int K = 1024, lda = 1024, ldb = 1024; const bf16_t* H; const bf16_t* Wt; int bid;
    DEV bool next(int i, Unit& u) const { if (i >= 1) return false; int pm, pn; tile_map(bid, 4, pm, pn);
        u.pm = pm; u.pn = pn; u.tag = 0; u.A = (const char*)(H + (size_t)pm * 256 * DM); u.B = (const char*)(Wt + (size_t)(1024 + pn * 256) * DM); return true; } };
struct SchedG2m { static constexpr int K = 1024, lda = 1024, ldb = 1024; const bf16_t* H; const bf16_t* Wt; int bid;
    DEV bool next(int i, Unit& u) const { if (i >= 2) return false; int pm, pn; tile_map(bid, 4, pm, pn);
        u.pm = pm; u.pn = pn; u.tag = i + 1; u.A = (const char*)(H + (size_t)pm * 256 * DM); u.B = (const char*)(Wt + (size_t)((i == 0 ? 3072 : 4096) + pn * 256) * DM); return true; } };
struct EpiG2s { const bf16_t* Z; const float* rstd; const float* og; bf16_t* MX;
    DEV void operator()(LAS char* lds, f32x4 (&acc)[2][2][4][2], const Unit& u, int wr, int wc, int fr, int fq, int wid, int lane) const {
        asm volatile("" : "+v"(fr), "+v"(fq));
        const int c0 = u.pn * 256 + 32 * wc + 8 * fq;
        {
            G8_ROWS_BEGIN const int row = u.pm * 256 + rl; const float rs = rstd[row];
#pragma unroll
                for (int bj = 0; bj < 2; ++bj) {
                    float z8[8]; un8(*(const u32x4*)(Z + (size_t)row * DM + c0 + 128 * bj), z8);
                    const float4 g0 = *(const float4*)(og + c0 + 128 * bj), g1 = *(const float4*)(og + c0 + 128 * bj + 4);
                    f32x4 o0, o1;
                    o0[0] = z8[0] * rs * g0.x * siluf_(acc[ai][bj][m][0][0]); o0[1] = z8[1] * rs * g0.y * siluf_(acc[ai][bj][m][0][1]); o0[2] = z8[2] * rs * g0.z * siluf_(acc[ai][bj][m][0][2]); o0[3] = z8[3] * rs * g0.w * siluf_(acc[ai][bj][m][0][3]);
                    o1[0] = z8[4] * rs * g1.x * siluf_(acc[ai][bj][m][1][0]); o1[1] = z8[5] * rs * g1.y * siluf_(acc[ai][bj][m][1][1]); o1[2] = z8[6] * rs * g1.z * siluf_(acc[ai][bj][m][1][2]); o1[3] = z8[7] * rs * g1.w * siluf_(acc[ai][bj][m][1][3]);
                    *(u32x4*)(MX + (size_t)row * 2048 + c0 + 128 * bj) = pk8(o0, o1); } G8_ROWS_END
        }
    } };
struct EpiG2m { const bf16_t* HC; const bf16_t* XC; const float* ngain; const float* skip; bf16_t* MX;
    DEV void operator()(LAS char* lds, f32x4 (&acc)[2][2][4][2], const Unit& u, int wr, int wc, int fr, int fq, int wid, int lane) const {
        asm volatile("" : "+v"(fr), "+v"(fq));
        const int c0 = u.pn * 256 + 32 * wc + 8 * fq;
        if (u.tag == 1) {
            LAS float* red = (LAS float*)(lds + 131072);
            G8_ROWS_BEGIN const int row = u.pm * 256 + rl; float s1 = 0.f, s2 = 0.f;
#pragma unroll
                for (int bj = 0; bj < 2; ++bj) {
                    float h8[8]; un8(*(const u32x4*)(HC + (size_t)row * DM + c0 + 128 * bj), h8);
#pragma unroll
                    for (int n = 0; n < 2; ++n)
#pragma unroll
                        for (int j = 0; j < 4; ++j) { const float v = h8[4 * n + j] * sigmoidf_(acc[ai][bj][m][n][j]); acc[ai][bj][m][n][j] = v; s1 += v; s2 += v * v; }
                }
                s1 += __shfl_xor(s1, 16); s1 += __shfl_xor(s1, 32); s2 += __shfl_xor(s2, 16); s2 += __shfl_xor(s2, 32);
                if (fq == 0) *(LAS f32x2*)(red + ((wid * 128) + 64 * ai + 16 * m + fr) * 2) = (f32x2){s1, s2}; G8_ROWS_END
            asm volatile("s_waitcnt lgkmcnt(0)" ::: "memory"); __builtin_amdgcn_s_barrier();
            G8_ROWS_BEGIN const int row = u.pm * 256 + rl; float t1 = 0.f, t2 = 0.f;
#pragma unroll
                for (int w2 = 0; w2 < 4; ++w2) { const f32x2 p_ = *(const LAS f32x2*)(red + (((wr * 4 + w2) * 128) + 64 * ai + 16 * m + fr) * 2); t1 += p_.x; t2 += p_.y; }
                const float mu = t1 * (1.f / DH), rs = rsqrtf(fmaxf(t2 * (1.f / DH) - mu * mu, 0.f) + EPS);
#pragma unroll
                for (int bj = 0; bj < 2; ++bj) {
                    float x8[8]; un8(*(const u32x4*)(XC + (size_t)row * DM + c0 + 128 * bj), x8);
                    const float4 g0 = *(const float4*)(ngain + c0 + 128 * bj), g1 = *(const float4*)(ngain + c0 + 128 * bj + 4), k0 = *(const float4*)(skip + c0 + 128 * bj), k1 = *(const float4*)(skip + c0 + 128 * bj + 4);
                    f32x4 o0, o1;
                    o0[0] = (acc[ai][bj][m][0][0] - mu) * rs * g0.x + k0.x * x8[0]; o0[1] = (acc[ai][bj][m][0][1] - mu) * rs * g0.y + k0.y * x8[1]; o0[2] = (acc[ai][bj][m][0][2] - mu) * rs * g0.z + k0.z * x8[2]; o0[3] = (acc[ai][bj][m][0][3] - mu) * rs * g0.w + k0.w * x8[3];
                    o1[0] = (acc[ai][bj][m][1][0] - mu) * rs * g1.x + k1.x * x8[4]; o1[1] = (acc[ai][bj][m][1][1] - mu) * rs * g1.y + k1.y * x8[5]; o1[2] = (acc[ai][bj][m][1][2] - mu) * rs * g1.z + k1.z * x8[6]; o1[3] = (acc[ai][bj][m][1][3] - mu) * rs * g1.w + k1.w * x8[7];
                    *(u32x4*)(MX + (size_t)row * 2048 + 1024 + c0 + 128 * bj) = pk8(o0, o1); } G8_ROWS_END
        } else {
            G8_ROWS_BEGIN const int row = u.pm * 256 + rl;
#pragma unroll
                for (int bj = 0; bj < 2; ++bj) {
                    bf16_t* pp = MX + (size_t)row * 2048 + 1024 + c0 + 128 * bj;
                    float h8[8]; un8(*(const u32x4*)pp, h8);
                    f32x4 o0, o1;
                    o0[0] = h8[0] * siluf_(acc[ai][bj][m][0][0]); o0[1] = h8[1] * siluf_(acc[ai][bj][m][0][1]); o0[2] = h8[2] * siluf_(acc[ai][bj][m][0][2]); o0[3] = h8[3] * siluf_(acc[ai][bj][m][0][3]);
                    o1[0] = h8[4] * siluf_(acc[ai][bj][m][1][0]); o1[1] = h8[5] * siluf_(acc[ai][bj][m][1][1]); o1[2] = h8[6] * siluf_(acc[ai][bj][m][1][2]); o1[3] = h8[7] * siluf_(acc[ai][bj][m][1][3]);
                    *(u32x4*)pp = pk8(o0, o1); } G8_ROWS_END
        }
    } };
}
DEV void rstd_rows(const float* rowss, float* rstd) {
    const int tid = opaque_tid();
    for (int r = blockIdx.x * 512 + tid; r < MTOK; r += gridDim.x * 512) { float s_ = 0.f;
#pragma unroll
        for (int p_ = 0; p_ < 16; ++p_) s_ += rowss[(size_t)p_ * MTOK + r];
        rstd[r] = rsqrtf(s_ * (1.f / DM) + EPS); }
}

DEV void transpose_item(const float* W, int ldw, int ncols, bf16_t* WT, int ldwt, LAS float* scr, int item, int lane) {
    const int nblk = ncols / 64, kb = item / nblk, nb = item % nblk, k0 = 64 * kb, n0 = 64 * nb;
    float4 v[16];
#pragma unroll
    for (int i = 0; i < 16; ++i) v[i] = *(const float4*)(W + (size_t)(k0 + 4 * i + (lane >> 4)) * ldw + n0 + 4 * (lane & 15));
#pragma unroll
    for (int i = 0; i < 16; ++i) { LAS float* d_ = scr + (4 * i + (lane >> 4)) * 65 + 4 * (lane & 15); d_[0] = v[i].x; d_[1] = v[i].y; d_[2] = v[i].z; d_[3] = v[i].w; }
    asm volatile("s_waitcnt lgkmcnt(0)" ::: "memory");
#pragma unroll
    for (int j = 0; j < 8; ++j) {
        const int n = (lane >> 3) + 8 * j, c = lane & 7;
        const LAS float* s_ = scr + (8 * c) * 65 + n;
        uint4 o;
        o.x = pk2(s_[0 * 65], s_[1 * 65]); o.y = pk2(s_[2 * 65], s_[3 * 65]); o.z = pk2(s_[4 * 65], s_[5 * 65]); o.w = pk2(s_[6 * 65], s_[7 * 65]);
        *(uint4*)(WT + (size_t)(n0 + n) * ldwt + k0 + 8 * c) = o;
    }
    asm volatile("s_waitcnt lgkmcnt(0)" ::: "memory");
}

DEV float wave_scan_add(float v, int lane) {
#pragma unroll
    for (int o = 1; o < 64; o <<= 1) { const float u = __shfl_up(v, o); if (lane >= o) v += u; }
    return v;
}
DEV float wave_scan_max(float v, int lane) {
#pragma unroll
    for (int o = 1; o < 64; o <<= 1) { const float u = __shfl_up(v, o); if (lane >= o) v = fmaxf(v, u); }
    return v;
}

template <int TT>
DEV void mlstm_a_wave(LAS char* shm, int fr, int fq, float m_prev, const LAS float* tpj, const LAS float* taj, f32x4 (&nacc)[3]) {
    constexpr int QS = 0, KS = 33792, VT = 67584, RS = 528, VRS = 96, NT = TT + 1;
    const LAS char* qb = shm + QS + (16 * TT + fr) * RS + fq * 16;
    const LAS char* kb = shm + KS + fr * RS + fq * 16;
    f32x4 sacc[NT];
#pragma unroll
    for (int jj = 0; jj < NT; ++jj) sacc[jj] = (f32x4){0.f, 0.f, 0.f, 0.f};
    bf16x8 qf = *(const LAS bf16x8*)qb, kf[NT];
#pragma unroll
    for (int jj = 0; jj < NT; ++jj) kf[jj] = *(const LAS bf16x8*)(kb + jj * 16 * RS);
#pragma unroll
    for (int ks = 0; ks < 8; ++ks) {
        bf16x8 qn = qf, kn[NT];
#pragma unroll
        for (int jj = 0; jj < NT; ++jj) kn[jj] = kf[jj];
        if (ks < 7) {
            qn = *(const LAS bf16x8*)(qb + (ks + 1) * 64);
#pragma unroll
            for (int jj = 0; jj < NT; ++jj) kn[jj] = *(const LAS bf16x8*)(kb + jj * 16 * RS + (ks + 1) * 64);
        }
#pragma unroll
        for (int jj = 0; jj < NT; ++jj) sacc[jj] = __builtin_amdgcn_mfma_f32_16x16x32_bf16(kf[jj], qf, sacc[jj], 0, 0, 0);
        qf = qn;
#pragma unroll
        for (int jj = 0; jj < NT; ++jj) kf[jj] = kn[jj];
    }
    constexpr int NK = (TT >= 2) ? 2 : 1;
    s16x4 vlo[NK][3], vhi[NK][3];
#pragma unroll
    for (int kk = 0; kk < NK; ++kk)
#pragma unroll
        for (int vt = 0; vt < 3; ++vt) {
            vlo[kk][vt] = __builtin_amdgcn_ds_read_tr16_b64_v4i16((LAS s16x4*)(shm + VT + (32 * kk + 4 * fq + (fr >> 2)) * VRS + (16 * vt + 4 * (fr & 3)) * 2));
            vhi[kk][vt] = __builtin_amdgcn_ds_read_tr16_b64_v4i16((LAS s16x4*)(shm + VT + (32 * kk + 16 + 4 * fq + (fr >> 2)) * VRS + (16 * vt + 4 * (fr & 3)) * 2));
        }
    const int t = 16 * TT + fr;
    const float btm = -fmaxf(m_prev, tpj[t]);
    f32x4 sm[2 * NK];
#pragma unroll
    for (int jj = 0; jj < 2 * NK; ++jj) {
        if (jj < NT) {
            const f32x4 a4 = *(const LAS f32x4*)(taj + 16 * jj + 4 * fq);
#pragma unroll
            for (int r = 0; r < 4; ++r) {
                const int s_ = 16 * jj + 4 * fq + r;
                sm[jj][r] = (jj < TT || s_ <= t) ? sacc[jj < NT ? jj : 0][r] * __expf(btm + a4[r]) : 0.f;
            }
        } else sm[jj] = (f32x4){0.f, 0.f, 0.f, 0.f};
    }
#pragma unroll
    for (int kk = 0; kk < NK; ++kk) {
        const u32x4 u = (u32x4){pk2(sm[2 * kk][0], sm[2 * kk][1]), pk2(sm[2 * kk][2], sm[2 * kk][3]), pk2(sm[2 * kk + 1][0], sm[2 * kk + 1][1]), pk2(sm[2 * kk + 1][2], sm[2 * kk + 1][3])};
        const bf16x8 af = *(const bf16x8*)&u;
#pragma unroll
        for (int vt = 0; vt < 3; ++vt) {
            bf16x8 bv8; bv8[0] = vlo[kk][vt][0]; bv8[1] = vlo[kk][vt][1]; bv8[2] = vlo[kk][vt][2]; bv8[3] = vlo[kk][vt][3];
            bv8[4] = vhi[kk][vt][0]; bv8[5] = vhi[kk][vt][1]; bv8[6] = vhi[kk][vt][2]; bv8[7] = vhi[kk][vt][3];
            nacc[vt] = __builtin_amdgcn_mfma_f32_16x16x32_bf16(af, bv8, nacc[vt], 0, 0, 0);
        }
    }
}
DEV void mlstm_b_wave(LAS char* shm, int tt, int fr, int fq, f32x4 (&nacc)[3]) {
    constexpr int QS = 0, CB = 81408, RS = 528;
    const LAS char* qb = shm + QS + (16 * tt + fr) * RS + fq * 16;
    const LAS char* cbp = shm + CB + fr * RS + fq * 16;
    bf16x8 qf = *(const LAS bf16x8*)qb, cf[3];
#pragma unroll
    for (int vt = 0; vt < 3; ++vt) cf[vt] = *(const LAS bf16x8*)(cbp + vt * 16 * RS);
#pragma unroll
    for (int ks = 0; ks < 8; ++ks) {
        bf16x8 qn = qf, cn[3] = {cf[0], cf[1], cf[2]};
        if (ks < 7) {
            qn = *(const LAS bf16x8*)(qb + (ks + 1) * 64);
#pragma unroll
            for (int vt = 0; vt < 3; ++vt) cn[vt] = *(const LAS bf16x8*)(cbp + vt * 16 * RS + (ks + 1) * 64);
        }
#pragma unroll
        for (int vt = 0; vt < 3; ++vt) nacc[vt] = __builtin_amdgcn_mfma_f32_16x16x32_bf16(qf, cf[vt], nacc[vt], 0, 0, 0);
        qf = qn;
#pragma unroll
        for (int vt = 0; vt < 3; ++vt) cf[vt] = cn[vt];
    }
}
template <int SKIP>
DEV void mlstm_phase(LAS char* shm, const bf16_t* q, const bf16_t* k, const bf16_t* v, const float* gpart, const float* b_ig, const float* b_fg, bf16_t* hc) {
    const int tid = opaque_tid(), wid = __builtin_amdgcn_readfirstlane(tid >> 6), lane = tid & 63, fr = lane & 15, fq = lane >> 4;
    constexpr int QS = 0, KS = 33792, VT = 67584, VWT = 74496, CB = 81408, PART = 106752, TB = 120064, TA = 128256, TP = 136448, TC = 144640, HST = 144896, RS = 528, VRS = 96, PRS = 52;
    LAS float* part = (LAS float*)(shm + PART);
    LAS float* tb = (LAS float*)(shm + TB); LAS float* ta = (LAS float*)(shm + TA); LAS float* tp = (LAS float*)(shm + TP); LAS float* tc = (LAS float*)(shm + TC);
    for (int item = blockIdx.x; item < BATCH * NH * 8; item += gridDim.x) {
        const int vs = (item >> 3) & 7, bh = (item & 7) + 8 * (item >> 6), h = bh & 3, b = bh >> 2;
        __syncthreads();
        for (int i = tid; i < (CB + 25344 - VT) / 4; i += 512) ((LAS unsigned*)(shm + VT))[i] = 0u;
        for (int j = wid; j < SEQ / CHUNK; j += 8) {
            const int m = b * SEQ + j * CHUNK + lane;
            const float* gp = gpart + (size_t)m * 8;
            const float ig = gp[h] + gp[(size_t)MTOK * 8 + h] + b_ig[h];
            const float lf = logsigmoidf_(gp[4 + h] + gp[(size_t)MTOK * 8 + 4 + h] + b_fg[h]);
            const float bc = wave_scan_add(lf, lane);
            const float a_ = ig - bc;
            const float pm = wave_scan_max(a_, lane);
            tb[j * 64 + lane] = bc; ta[j * 64 + lane] = a_; tp[j * 64 + lane] = pm;
            if (lane == 63) { tc[2 * j] = bc; tc[2 * j + 1] = pm; }
        }
        __syncthreads();
        if (tid < 64) *(LAS u32x4*)(shm + VT + tid * VRS + 64) = (u32x4){0x3F80u, 0u, 0u, 0u};
        f32x4 cacc[2][3];
#pragma unroll
        for (int i = 0; i < 2; ++i)
#pragma unroll
            for (int vt = 0; vt < 3; ++vt) cacc[i][vt] = (f32x4){0.f, 0.f, 0.f, 0.f};
        float m_prev = 0.f;
        const size_t cb0 = ((size_t)(b * SEQ)) * DM + h * DH;
        uint4 qv[4], kv[4], vv = make_uint4(0, 0, 0, 0);
#pragma unroll
        for (int i = 0; i < 4; ++i) {
            const int idx = tid + 512 * i, row = idx >> 5, c16 = idx & 31;
            qv[i] = *(const uint4*)(q + cb0 + (size_t)row * DM + c16 * 8);
            kv[i] = *(const uint4*)(k + cb0 + (size_t)row * DM + c16 * 8);
        }
        if (tid < 256) vv = *(const uint4*)(v + cb0 + (size_t)(tid >> 2) * DM + vs * 32 + (tid & 3) * 8);
#pragma nounroll
        for (int j = 0; j < SEQ / CHUNK; ++j) {
            const size_t cb = cb0 + (size_t)j * CHUNK * DM;
            const float btot = tc[2 * j], amax = tc[2 * j + 1];
            const float mxc = fmaxf(m_prev, amax);
#pragma unroll
            for (int i = 0; i < ((SKIP & 8) ? 0 : 4); ++i) {
                const int idx = tid + 512 * i, row = idx >> 5, c16 = idx & 31;
                *(LAS u32x4*)(shm + QS + row * RS + c16 * 16) = (u32x4){qv[i].x, qv[i].y, qv[i].z, qv[i].w};
                *(LAS u32x4*)(shm + KS + row * RS + c16 * 16) = (u32x4){kv[i].x, kv[i].y, kv[i].z, kv[i].w};
            }
            if (tid < 256) {
                const int s_ = tid >> 2, v0 = (tid & 3) * 8;
                const float ws = __expf(ta[j * 64 + s_] - mxc);
                float f8[8]; unpack8(vv, f8);
#pragma unroll
                for (int e = 0; e < 8; ++e) f8[e] *= ws;
                const uint4 wv = pack8(f8);
                *(LAS u32x4*)(shm + VT + s_ * VRS + v0 * 2) = (u32x4){vv.x, vv.y, vv.z, vv.w};
                *(LAS u32x4*)(shm + VWT + s_ * VRS + v0 * 2) = (u32x4){wv.x, wv.y, wv.z, wv.w};
            } else if (tid < 320) {
                const int s_ = tid - 256;
                *(LAS u32x4*)(shm + VWT + s_ * VRS + 64) = (u32x4){(unsigned)f2bf(__expf(ta[j * 64 + s_] - mxc)), 0u, 0u, 0u};
            }
            if (j + 1 < SEQ / CHUNK) {
                const size_t cn = cb + (size_t)CHUNK * DM;
#pragma unroll
                for (int i = 0; i < 4; ++i) {
                    const int idx = tid + 512 * i, row = idx >> 5, c16 = idx & 31;
                    qv[i] = *(const uint4*)(q + cn + (size_t)row * DM + c16 * 8);
                    kv[i] = *(const uint4*)(k + cn + (size_t)row * DM + c16 * 8);
                }
                if (tid < 256) vv = *(const uint4*)(v + cn + (size_t)(tid >> 2) * DM + vs * 32 + (tid & 3) * 8);
            }
            __syncthreads();
            f32x4 nacc[3];
#pragma unroll
            for (int vt = 0; vt < 3; ++vt) nacc[vt] = (f32x4){0.f, 0.f, 0.f, 0.f};
            const int tt = wid & 3;
            if (wid < 4) { if (!(SKIP & 1)) {
                const LAS float* tpj = tp + j * 64; const LAS float* taj = ta + j * 64;
                if (tt == 0) mlstm_a_wave<0>(shm, fr, fq, m_prev, tpj, taj, nacc);
                else if (tt == 1) mlstm_a_wave<1>(shm, fr, fq, m_prev, tpj, taj, nacc);
                else if (tt == 2) mlstm_a_wave<2>(shm, fr, fq, m_prev, tpj, taj, nacc);
                else mlstm_a_wave<3>(shm, fr, fq, m_prev, tpj, taj, nacc);
            } } else if (!(SKIP & 2)) {
                mlstm_b_wave(shm, tt, fr, fq, nacc);
                const f32x4 pm4 = *(const LAS f32x4*)(tp + j * 64 + 16 * tt + 4 * fq);
#pragma unroll
                for (int vt = 0; vt < 3; ++vt)
#pragma unroll
                    for (int r = 0; r < 4; ++r) part[(16 * tt + 4 * fq + r) * PRS + 16 * vt + fr] = __expf(m_prev - fmaxf(m_prev, pm4[r])) * nacc[vt][r];
            }
            if (!(SKIP & 4)) {
                const float decay = __expf(m_prev - mxc);
#pragma unroll
                for (int i = 0; i < 2; ++i)
#pragma unroll
                    for (int vt = 0; vt < 3; ++vt) cacc[i][vt] *= decay;
                const int q_ = fr >> 2, p_ = fr & 3;
                s16x4 wl[2][3], wh[2][3], kl[2][2], kh[2][2];
#pragma unroll
                for (int kk = 0; kk < 2; ++kk) {
#pragma unroll
                    for (int vt = 0; vt < 3; ++vt) {
                        wl[kk][vt] = __builtin_amdgcn_ds_read_tr16_b64_v4i16((LAS s16x4*)(shm + VWT + (32 * kk + 8 * fq + q_) * VRS + (16 * vt + 4 * p_) * 2));
                        wh[kk][vt] = __builtin_amdgcn_ds_read_tr16_b64_v4i16((LAS s16x4*)(shm + VWT + (32 * kk + 8 * fq + 4 + q_) * VRS + (16 * vt + 4 * p_) * 2));
                    }
#pragma unroll
                    for (int i = 0; i < 2; ++i) {
                        const int dt = 2 * wid + i;
                        kl[kk][i] = __builtin_amdgcn_ds_read_tr16_b64_v4i16((LAS s16x4*)(shm + KS + (32 * kk + 8 * fq + q_) * RS + (16 * dt + 4 * p_) * 2));
                        kh[kk][i] = __builtin_amdgcn_ds_read_tr16_b64_v4i16((LAS s16x4*)(shm + KS + (32 * kk + 8 * fq + 4 + q_) * RS + (16 * dt + 4 * p_) * 2));
                    }
                }
#pragma unroll
                for (int kk = 0; kk < 2; ++kk) {
                    bf16x8 bfv[3];
#pragma unroll
                    for (int vt = 0; vt < 3; ++vt) { bfv[vt][0] = wl[kk][vt][0]; bfv[vt][1] = wl[kk][vt][1]; bfv[vt][2] = wl[kk][vt][2]; bfv[vt][3] = wl[kk][vt][3];
                        bfv[vt][4] = wh[kk][vt][0]; bfv[vt][5] = wh[kk][vt][1]; bfv[vt][6] = wh[kk][vt][2]; bfv[vt][7] = wh[kk][vt][3]; }
#pragma unroll
                    for (int i = 0; i < 2; ++i) {
                        bf16x8 af; af[0] = kl[kk][i][0]; af[1] = kl[kk][i][1]; af[2] = kl[kk][i][2]; af[3] = kl[kk][i][3]; af[4] = kh[kk][i][0]; af[5] = kh[kk][i][1]; af[6] = kh[kk][i][2]; af[7] = kh[kk][i][3];
#pragma unroll
                        for (int vt = 0; vt < 3; ++vt) cacc[i][vt] = __builtin_amdgcn_mfma_f32_16x16x32_bf16(af, bfv[vt], cacc[i][vt], 0, 0, 0);
                    }
                }
            }
            __syncthreads();
            if (wid < 4 && !(SKIP & 16)) {
                const f32x4 pm4 = *(const LAS f32x4*)(tp + j * 64 + 16 * tt + 4 * fq);
                const f32x4 bc4 = *(const LAS f32x4*)(tb + j * 64 + 16 * tt + 4 * fq);
#pragma unroll
                for (int vt = 0; vt < 3; ++vt)
#pragma unroll
                    for (int r = 0; r < 4; ++r) nacc[vt][r] += part[(16 * tt + 4 * fq + r) * PRS + 16 * vt + fr];
#pragma unroll
                for (int r = 0; r < 4; ++r) {
                    const float den = __shfl(nacc[2][r], lane & 48);
                    const float inv = 1.f / fmaxf(fabsf(den), __expf(-(bc4[r] + fmaxf(m_prev, pm4[r]))));
                    LAS bf16_t* hrow = (LAS bf16_t*)(shm + HST + (16 * tt + 4 * fq + r) * 80);
                    hrow[fr] = f2bf(nacc[0][r] * inv);
                    hrow[16 + fr] = f2bf(nacc[1][r] * inv);
                }
                asm volatile("s_waitcnt lgkmcnt(0)" ::: "memory");
                {
                    const int rw = 16 * tt + (lane >> 2), pc = lane & 3;
                    const u32x4 hv = *(const LAS u32x4*)(shm + HST + rw * 80 + pc * 16);
                    *(uint4*)(hc + cb + (size_t)rw * DM + vs * 32 + pc * 8) = make_uint4(hv[0], hv[1], hv[2], hv[3]);
                }
            }
#pragma unroll
            for (int i = 0; i < 2; ++i)
#pragma unroll
                for (int vt = 0; vt < 3; ++vt) {
                    u32x2 o; o[0] = pk2(cacc[i][vt][0], cacc[i][vt][1]); o[1] = pk2(cacc[i][vt][2], cacc[i][vt][3]);
                    *(LAS u32x2*)(shm + CB + (16 * vt + fr) * RS + (16 * (2 * wid + i) + 4 * fq) * 2) = o;
                }
            m_prev = btot + mxc;
        }
    }
}

constexpr int S5L = 32, S5NCH = SEQ / S5L;
constexpr size_t T_KT_OFF = 0, T_WS_OFF = 2u << 20, T_V_OFF = 10u << 20, T_AL_OFF = 18u << 20;
constexpr int KT_G = 33 * 256, WS_G = 128 * 512, V_G = 512 * 128;

DEV void s5_tables(LAS char* shm, char* tab, const float* lam_re, const float* lam_im, const float* log_dt, const float* b_re, const float* b_im,
                   const float* c_re, const float* c_im) {
    const int tid = opaque_tid();
    LAS f32x2* apw = (LAS f32x2*)shm;
    LAS f32x2* bb = (LAS f32x2*)(shm + 64 * 33 * 8);
    LAS f32x2* cc = (LAS f32x2*)(shm + 64 * 33 * 8 + 8192);
    bf16_t* KT = (bf16_t*)(tab + T_KT_OFF); bf16_t* WS = (bf16_t*)(tab + T_WS_OFF); bf16_t* VV = (bf16_t*)(tab + T_V_OFF); float2* AL = (float2*)(tab + T_AL_OFF);
    for (int it = blockIdx.x; it < 256; it += gridDim.x) {
        const int g = it & 63, qd = it >> 6;
        __syncthreads();
        if (tid < 64) {
            const int pp = tid;
            const double lr = lam_re[g * NP + pp], li = lam_im[g * NP + pp], dt = exp((double)log_dt[g]);
            const double er = exp(lr * dt);
            const double ar = er * cos(li * dt), ai = er * sin(li * dt);
            const double dr = ar - 1.0, di = ai, den = lr * lr + li * li;
            const double cr = (dr * lr + di * li) / den, ci = (di * lr - dr * li) / den;
            double pr = 1.0, pi_ = 0.0;
            for (int e = 0; e <= 32; ++e) {
                apw[pp * 33 + e] = (f32x2){(float)pr, (float)pi_};
                const double nr = pr * ar - pi_ * ai, ni = pr * ai + pi_ * ar; pr = nr; pi_ = ni;
            }
            if (qd == 0) { const f32x2 t_ = apw[pp * 33 + 32]; AL[g * NP + pp] = make_float2(t_.x, t_.y); }
            for (int c = 0; c < 16; ++c) {
                const double br = b_re[(g * NP + pp) * GC + c], bi = b_im[(g * NP + pp) * GC + c];
                bb[pp * 16 + c] = (f32x2){(float)(cr * br - ci * bi), (float)(cr * bi + ci * br)};
                cc[c * 64 + pp] = (f32x2){c_re[(g * GC + c) * NP + pp], c_im[(g * GC + c) * NP + pp]};
            }
        }
        __syncthreads();
        for (int o = tid; o < 8 * 256; o += 512) {
            const int d = 8 * qd + (o >> 8), c1 = (o >> 4) & 15, c0 = o & 15;
            float acc = 0.f;
            for (int pp = 0; pp < 64; ++pp) {
                const f32x2 a = apw[pp * 33 + d], b = bb[pp * 16 + c0], c = cc[c1 * 64 + pp];
                const float mr = a.x * b.x - a.y * b.y, mi = a.x * b.y + a.y * b.x;
                acc += c.x * mr - c.y * mi;
            }
            KT[(size_t)g * KT_G + (d + 1) * 256 + c1 * 16 + c0] = f2bf(acc);
        }
        if (qd == 0 && tid < 256) KT[(size_t)g * KT_G + tid] = 0;
        for (int o = tid; o < 2 * 16 * 64; o += 512) {
            const int mt = 2 * qd + (o >> 10), sp = (o >> 6) & 15, ln = o & 63;
            const int row = 16 * mt + (ln & 15), ri = row >> 6, pp = row & 63, s_ = 2 * sp + (ln >> 5), c0 = 8 * ((ln >> 4) & 1);
            const f32x2 a = apw[pp * 33 + 31 - s_];
            unsigned w[4];
#pragma unroll
            for (int jj = 0; jj < 8; jj += 2) {
                const f32x2 b0 = bb[pp * 16 + c0 + jj], b1 = bb[pp * 16 + c0 + jj + 1];
                const float v0 = ri ? (a.x * b0.y + a.y * b0.x) : (a.x * b0.x - a.y * b0.y);
                const float v1 = ri ? (a.x * b1.y + a.y * b1.x) : (a.x * b1.x - a.y * b1.y);
                w[jj >> 1] = pk2(v0, v1);
            }
            *(uint4*)(WS + (size_t)g * WS_G + ((size_t)(mt * 16 + sp) * 64 + ln) * 8) = make_uint4(w[0], w[1], w[2], w[3]);
        }
        for (int o = tid; o < 8 * 4 * 64; o += 512) {
            const int i = 8 * qd + (o >> 8), ks = (o >> 6) & 3, ln = o & 63;
            const int c1 = ln & 15, k0 = 32 * ks + 8 * (ln >> 4);
            unsigned w[4];
#pragma unroll
            for (int jj = 0; jj < 8; jj += 2) {
                float v[2];
#pragma unroll
                for (int e = 0; e < 2; ++e) {
                    const int kk = k0 + jj + e, ri = kk >> 6, pp = kk & 63;
                    const f32x2 a = apw[pp * 33 + i + 1], c = cc[c1 * 64 + pp];
                    v[e] = ri ? -(c.x * a.y + c.y * a.x) : (c.x * a.x - c.y * a.y);
                }
                w[jj >> 1] = pk2(v[0], v[1]);
            }
            *(uint4*)(VV + (size_t)g * V_G + ((size_t)(i * 4 + ks) * 64 + ln) * 8) = make_uint4(w[0], w[1], w[2], w[3]);
        }
    }
}

template <int NQ>
DEV void s5_p1_range(LAS char* shm, int lo, int hi, int wid, int fr, int fq, const bf16_t* wsp, f32x4 (&acc)[4][4], f32x4 (&sac)[4]) {
    constexpr int PLANE = 64 * 528, KTL = 2 * PLANE, Q0 = 4 - NQ;
    if (lo > hi) return;
    const LAS char* ub = shm + (fq & 1) * PLANE + fr * 528 + (fq >> 1) * 16;
    const LAS char* kb = shm + KTL + (1 - (fq >> 1)) * 512 + fr * 32 + (fq & 1) * 16;
    bf16x8 bu[4], kf[NQ], wcur;
#pragma unroll
    for (int nt = 0; nt < 4; ++nt) bu[nt] = *(const LAS bf16x8*)(ub + nt * 16 * 528 + lo * 32);
#pragma unroll
    for (int q = 0; q < NQ; ++q) kf[q] = *(const LAS bf16x8*)(kb + (wid + 8 * (Q0 + q) - 2 * lo) * 512);
    wcur = *(const bf16x8*)(wsp + (size_t)lo * 64 * 8);
#pragma nounroll
    for (int sp = lo; sp <= hi; ++sp) {
        bf16x8 bn[4], kn[NQ], wn = wcur;
        const int sn = (sp < hi) ? sp + 1 : sp;
#pragma unroll
        for (int nt = 0; nt < 4; ++nt) bn[nt] = *(const LAS bf16x8*)(ub + nt * 16 * 528 + sn * 32);
#pragma unroll
        for (int q = 0; q < NQ; ++q) kn[q] = *(const LAS bf16x8*)(kb + (wid + 8 * (Q0 + q) - 2 * sn) * 512);
        wn = *(const bf16x8*)(wsp + (size_t)sn * 64 * 8);
#pragma unroll
        for (int nt = 0; nt < 4; ++nt) sac[nt] = __builtin_amdgcn_mfma_f32_16x16x32_bf16(wcur, bu[nt], sac[nt], 0, 0, 0);
#pragma unroll
        for (int q = 0; q < NQ; ++q)
#pragma unroll
            for (int nt = 0; nt < 4; ++nt) acc[Q0 + q][nt] = __builtin_amdgcn_mfma_f32_16x16x32_bf16(kf[q], bu[nt], acc[Q0 + q][nt], 0, 0, 0);
#pragma unroll
        for (int nt = 0; nt < 4; ++nt) bu[nt] = bn[nt];
#pragma unroll
        for (int q = 0; q < NQ; ++q) kf[q] = kn[q];
        wcur = wn;
    }
}
DEV void s5_phase(LAS char* shm, const bf16_t* Uin, bf16_t* Yout, const char* tab, const float* dskip) {
    const int tid = opaque_tid(), wid = __builtin_amdgcn_readfirstlane(tid >> 6), lane = tid & 63, fr = lane & 15, fq = lane >> 4;
    constexpr int PLANE = 64 * 528, KTL = 2 * PLANE, SL = KTL + 33 * 512, HB = SL + 64 * 528, SRS = 528, HRS = 272, TSEG = HB + 64 * 272;
    const bf16_t* KT = (const bf16_t*)(tab + T_KT_OFF); const bf16_t* WS = (const bf16_t*)(tab + T_WS_OFF); const bf16_t* VV = (const bf16_t*)(tab + T_V_OFF);
    const float2* AL = (const float2*)(tab + T_AL_OFF);
    for (int item = blockIdx.x; item < BATCH * NG; item += gridDim.x) {
        const int xcd_ = item & 7, j_ = (item >> 3) & 31, g = xcd_ * 8 + (j_ & 7), b = (j_ >> 3) + 4 * (item >> 8);
        const bf16_t* Ub = Uin + (size_t)b * SEQ * DM + g * GC;
        bf16_t* Yb = Yout + (size_t)b * SEQ * DM + g * GC;
        __syncthreads();
#pragma unroll
        for (int i = 0; i < 8; ++i) {
            const int idx = tid + 512 * i, tok = idx >> 1, hf = idx & 1;
            const uint4 uv = *(const uint4*)(Ub + (size_t)tok * DM + hf * 8);
            *(LAS u32x4*)(shm + hf * PLANE + (tok >> 5) * 528 + (tok & 31) * 16) = (u32x4){uv.x, uv.y, uv.z, uv.w};
        }
        for (int idx = tid; idx < 33 * 32; idx += 512) {
            const uint4 kv = *(const uint4*)(KT + (size_t)g * KT_G + idx * 8);
            *(LAS u32x4*)(shm + KTL + idx * 16) = (u32x4){kv.x, kv.y, kv.z, kv.w};
        }
        __syncthreads();
        f32x4 acc[4][4], sac[4];
#pragma unroll
        for (int q = 0; q < 4; ++q)
#pragma unroll
            for (int nt = 0; nt < 4; ++nt) acc[q][nt] = (f32x4){0.f, 0.f, 0.f, 0.f};
#pragma unroll
        for (int nt = 0; nt < 4; ++nt) sac[nt] = (f32x4){0.f, 0.f, 0.f, 0.f};
        const bf16_t* wsp = WS + (size_t)g * WS_G + ((size_t)(wid * 16) * 64 + lane) * 8;
        const int h2 = wid >> 1;
        s5_p1_range<4>(shm, 0, h2, wid, fr, fq, wsp, acc, sac);
        s5_p1_range<3>(shm, h2 + 1, 4 + h2, wid, fr, fq, wsp, acc, sac);
        s5_p1_range<2>(shm, 5 + h2, 8 + h2, wid, fr, fq, wsp, acc, sac);
        s5_p1_range<1>(shm, 9 + h2, 12 + h2, wid, fr, fq, wsp, acc, sac);
        if (13 + h2 <= 15) {
            const LAS char* ub = shm + (fq & 1) * PLANE + fr * 528 + (fq >> 1) * 16;
            for (int sp = 13 + h2; sp <= 15; ++sp) {
                const bf16x8 wcur = *(const bf16x8*)(wsp + (size_t)sp * 64 * 8);
#pragma unroll
                for (int nt = 0; nt < 4; ++nt) sac[nt] = __builtin_amdgcn_mfma_f32_16x16x32_bf16(wcur, *(const LAS bf16x8*)(ub + nt * 16 * 528 + sp * 32), sac[nt], 0, 0, 0);
            }
        }
#pragma unroll
        for (int nt = 0; nt < 4; ++nt) *(LAS f32x4*)(shm + SL + (16 * nt + fr) * SRS + (16 * wid + 4 * fq) * 4) = sac[nt];
        __syncthreads();
        {
            const float2 al = AL[g * NP + lane];
            float hr = 0.f, hi = 0.f, lr[8], li[8];
#pragma unroll
            for (int n = 0; n < 8; ++n) {
                lr[n] = hr; li[n] = hi;
                const float sr = *(const LAS float*)(shm + SL + (8 * wid + n) * SRS + lane * 4), si = *(const LAS float*)(shm + SL + (8 * wid + n) * SRS + (64 + lane) * 4);
                const float nr = al.x * hr - al.y * hi + sr, ni = al.x * hi + al.y * hr + si; hr = nr; hi = ni;
            }
            *(LAS float*)(shm + TSEG + (wid * 128 + lane) * 4) = hr; *(LAS float*)(shm + TSEG + (wid * 128 + 64 + lane) * 4) = hi;
            float pr = al.x, pi = al.y;
#pragma unroll
            for (int e = 0; e < 3; ++e) { const float nr = pr * pr - pi * pi, ni = 2.f * pr * pi; pr = nr; pi = ni; }
            __syncthreads();
            float cr = 0.f, ci = 0.f;
            for (int w2 = 0; w2 < wid; ++w2) {
                const float tr = *(const LAS float*)(shm + TSEG + (w2 * 128 + lane) * 4), ti = *(const LAS float*)(shm + TSEG + (w2 * 128 + 64 + lane) * 4);
                const float nr = pr * cr - pi * ci + tr, ni = pr * ci + pi * cr + ti; cr = nr; ci = ni;
            }
            float qr = 1.f, qi = 0.f;
#pragma unroll
            for (int n = 0; n < 8; ++n) {
                const float fr_ = lr[n] + qr * cr - qi * ci, fi_ = li[n] + qr * ci + qi * cr;
                *(LAS bf16_t*)(shm + HB + (8 * wid + n) * HRS + lane * 2) = f2bf(fr_);
                *(LAS bf16_t*)(shm + HB + (8 * wid + n) * HRS + (64 + lane) * 2) = f2bf(fi_);
                const float nr = qr * al.x - qi * al.y, ni = qr * al.y + qi * al.x; qr = nr; qi = ni;
            }
        }
        __syncthreads();
        const bf16_t* vvp = VV + (size_t)g * V_G + (size_t)lane * 8;
        bf16x8 va[4];
#pragma unroll
        for (int q = 0; q < 4; ++q) va[q] = *(const bf16x8*)(vvp + ((size_t)((wid + 8 * q) * 4 + 0) * 64) * 8);
#pragma unroll
        for (int ks = 0; ks < 4; ++ks) {
            bf16x8 hb[4], vn[4];
#pragma unroll
            for (int nt = 0; nt < 4; ++nt) hb[nt] = *(const LAS bf16x8*)(shm + HB + (16 * nt + fr) * HRS + (32 * ks + 8 * fq) * 2);
#pragma unroll
            for (int q = 0; q < 4; ++q) vn[q] = (ks < 3) ? *(const bf16x8*)(vvp + ((size_t)((wid + 8 * q) * 4 + ks + 1) * 64) * 8) : va[q];
#pragma unroll
            for (int q = 0; q < 4; ++q)
#pragma unroll
                for (int nt = 0; nt < 4; ++nt) acc[q][nt] = __builtin_amdgcn_mfma_f32_16x16x32_bf16(va[q], hb[nt], acc[q][nt], 0, 0, 0);
#pragma unroll
            for (int q = 0; q < 4; ++q) va[q] = vn[q];
        }
        const float4 dsk = *(const float4*)(dskip + g * GC + 4 * fq);
#pragma unroll
        for (int q = 0; q < 4; ++q) {
            const int i = wid + 8 * q;
#pragma unroll
            for (int nt = 0; nt < 4; ++nt) {
                const int n = 16 * nt + fr;
                const u32x2 uu = *(const LAS u32x2*)(shm + (fq >> 1) * PLANE + n * 528 + i * 16 + ((4 * fq) & 7) * 2);
                f32x4 o;
                o[0] = geluf_(acc[q][nt][0] + dsk.x * bf2f((bf16_t)(uu[0] & 0xffff))); o[1] = geluf_(acc[q][nt][1] + dsk.y * bf2f((bf16_t)(uu[0] >> 16)));
                o[2] = geluf_(acc[q][nt][2] + dsk.z * bf2f((bf16_t)(uu[1] & 0xffff))); o[3] = geluf_(acc[q][nt][3] + dsk.w * bf2f((bf16_t)(uu[1] >> 16)));
                *(uint2*)(Yb + (size_t)(n * 32 + i) * DM + 4 * fq) = pack4(o);
            }
        }
    }
}


DEV void norm_rows(const float* x, const float* gain, const float* modl, bf16_t* h) {
    const int tid = opaque_tid(), lane = tid & 63, gw = blockIdx.x * 8 + (tid >> 6), NGW = gridDim.x * 8;
    for (int m = gw; m < MTOK; m += NGW) {
        const float4* xr = (const float4*)(x + (size_t)m * DM) + lane;
        float4 v[4]; float ss = 0.f;
#pragma unroll
        for (int j = 0; j < 4; ++j) { v[j] = xr[64 * j]; ss += v[j].x * v[j].x + v[j].y * v[j].y + v[j].z * v[j].z + v[j].w * v[j].w; }
        const float rstd = rsqrtf(wave_sum(ss) * (1.f / DM) + EPS);
        const float* shift = modl + (size_t)(m / SEQ) * 3 * DM; const float* scale = shift + DM;
#pragma unroll
        for (int j = 0; j < 4; ++j) {
            const int n = 4 * lane + 256 * j;
            const float4 g = *(const float4*)(gain + n), sc = *(const float4*)(scale + n), sh = *(const float4*)(shift + n);
            f32x4 o; o[0] = v[j].x * rstd * g.x * (1.f + sc.x) + sh.x; o[1] = v[j].y * rstd * g.y * (1.f + sc.y) + sh.y;
            o[2] = v[j].z * rstd * g.z * (1.f + sc.z) + sh.z; o[3] = v[j].w * rstd * g.w * (1.f + sc.w) + sh.w;
            *(uint2*)(h + (size_t)m * DM + n) = pack4(o);
        }
    }
}
DEV void ssm_post_rows(const bf16_t* z, bf16_t* zo, const bf16_t* sg, const float* gain) {
    const int tid = opaque_tid(), lane = tid & 63, gw = blockIdx.x * 8 + (tid >> 6), NGW = gridDim.x * 8;
    for (int m = gw; m < MTOK; m += NGW) {
        float zv[2][8], gv[2][8]; float ss = 0.f;
#pragma unroll
        for (int j = 0; j < 2; ++j) {
            unpack8(*(const uint4*)(z + (size_t)m * DM + 8 * lane + 512 * j), zv[j]);
            unpack8(*(const uint4*)(sg + (size_t)m * DM + 8 * lane + 512 * j), gv[j]);
#pragma unroll
            for (int e = 0; e < 8; ++e) ss += zv[j][e] * zv[j][e];
        }
        const float rstd = rsqrtf(wave_sum(ss) * (1.f / DM) + EPS);
#pragma unroll
        for (int j = 0; j < 2; ++j) {
            const int n = 8 * lane + 512 * j; float o[8];
#pragma unroll
            for (int e = 0; e < 8; ++e) o[e] = zv[j][e] * rstd * gain[n + e] * siluf_(gv[j][e]);
            *(uint4*)(zo + (size_t)m * DM + n) = pack8(o);
        }
    }
}
DEV void mlstm_post_rows(const bf16_t* hc, bf16_t* ho, const bf16_t* mo, const bf16_t* mg, const bf16_t* mi, const float* cw, const float* cb, const float* ngain, const float* skip) {
    const int tid = opaque_tid(), lane = tid & 63, gw = blockIdx.x * 8 + (tid >> 6), NGW = gridDim.x * 8;
    for (int m = gw; m < MTOK; m += NGW) {
        const size_t o0 = (size_t)m * DM + 16 * lane;
        float hv[16], t8[8]; float s1 = 0.f;
#pragma unroll
        for (int j = 0; j < 2; ++j) {
            unpack8(*(const uint4*)(hc + o0 + 8 * j), hv + 8 * j);
            unpack8(*(const uint4*)(mo + o0 + 8 * j), t8);
#pragma unroll
            for (int e = 0; e < 8; ++e) { hv[8 * j + e] *= sigmoidf_(t8[e]); s1 += hv[8 * j + e]; }
        }
#pragma unroll
        for (int o = 1; o < 16; o <<= 1) s1 += __shfl_xor(s1, o);
        const float mu = s1 * (1.f / DH); float s2 = 0.f;
#pragma unroll
        for (int e = 0; e < 16; ++e) { hv[e] -= mu; s2 += hv[e] * hv[e]; }
#pragma unroll
        for (int o = 1; o < 16; o <<= 1) s2 += __shfl_xor(s2, o);
        const float rstd = rsqrtf(s2 * (1.f / DH) + EPS);
#pragma unroll
        for (int j = 0; j < 2; ++j) {
            float xv[8], gv[8], ov[8], t8b[8];
            { const int n0 = 16 * lane + 8 * j, tpos = m % SEQ;
#pragma unroll
              for (int e = 0; e < 8; ++e) xv[e] = cb[n0 + e];
#pragma unroll
              for (int tap = 0; tap < 4; ++tap) if (tpos - 3 + tap >= 0) {
                  unpack8(*(const uint4*)(mi + (size_t)(m - 3 + tap) * DM + n0), t8b);
#pragma unroll
                  for (int e = 0; e < 8; ++e) xv[e] += t8b[e] * cw[tap * DM + n0 + e];
              }
#pragma unroll
              for (int e = 0; e < 8; ++e) xv[e] = siluf_(xv[e]); }
            unpack8(*(const uint4*)(mg + o0 + 8 * j), gv);
#pragma unroll
            for (int e = 0; e < 8; ++e) { const int n = 16 * lane + 8 * j + e; ov[e] = (hv[8 * j + e] * rstd * ngain[n] + skip[n] * xv[e]) * siluf_(gv[e]); }
            *(uint4*)(ho + o0 + 8 * j) = pack8(ov);
        }
    }
}
DEV void final_rows(float* x, const float* gain) {
    const int tid = opaque_tid(), lane = tid & 63, gw = blockIdx.x * 8 + (tid >> 6), NGW = gridDim.x * 8;
    for (int m = gw; m < MTOK; m += NGW) {
        float4* xr = (float4*)(x + (size_t)m * DM) + lane;
        float4 v[4]; float ss = 0.f;
#pragma unroll
        for (int j = 0; j < 4; ++j) { v[j] = xr[64 * j]; ss += v[j].x * v[j].x + v[j].y * v[j].y + v[j].z * v[j].z + v[j].w * v[j].w; }
        const float rstd = rsqrtf(wave_sum(ss) * (1.f / DM) + EPS);
#pragma unroll
        for (int j = 0; j < 4; ++j) {
            const float4 g = *(const float4*)(gain + 4 * lane + 256 * j);
            v[j].x *= rstd * g.x; v[j].y *= rstd * g.y; v[j].z *= rstd * g.z; v[j].w *= rstd * g.w;
            xr[64 * j] = v[j];
        }
    }
}
DEV void mod_phase(LAS char* shm, const float* c, const float* w_mod, const float* b_mod, float* mod) {
    const int tid = opaque_tid();
    LAS float* sc = (LAS float*)shm;
    LAS float* pr = (LAS float*)(shm + 32768);
    __syncthreads();
    for (int i = tid; i < BATCH * DM; i += 512) sc[i] = siluf_(c[i]);
    __syncthreads();
    for (int it = blockIdx.x; it < 48; it += gridDim.x) {
        const int l = it / 24, n0 = (it % 24) * 128, cq = tid & 31, kg = tid >> 5;
        const float* W = w_mod + (size_t)l * DM * 3 * DM + n0 + 4 * cq;
        float acc[BATCH][4];
#pragma unroll
        for (int b = 0; b < BATCH; ++b) { acc[b][0] = acc[b][1] = acc[b][2] = acc[b][3] = 0.f; }
        for (int k = kg * 64; k < kg * 64 + 64; ++k) {
            const float4 w = *(const float4*)(W + (size_t)k * 3 * DM);
#pragma unroll
            for (int b = 0; b < BATCH; ++b) { const float s_ = sc[b * DM + k]; acc[b][0] += s_ * w.x; acc[b][1] += s_ * w.y; acc[b][2] += s_ * w.z; acc[b][3] += s_ * w.w; }
        }
#pragma unroll
        for (int b = 0; b < BATCH; ++b) *(LAS f32x4*)(pr + (kg * 8 + b) * 128 + 4 * cq) = (f32x4){acc[b][0], acc[b][1], acc[b][2], acc[b][3]};
        __syncthreads();
        for (int o = tid; o < 8 * 128; o += 512) {
            const int b = o >> 7, n = o & 127; float s_ = 0.f;
#pragma unroll
            for (int g2 = 0; g2 < 16; ++g2) s_ += pr[(g2 * 8 + b) * 128 + n];
            mod[((size_t)l * BATCH + b) * 3 * DM + n0 + n] = s_ + b_mod[l * 3 * DM + n0 + n];
        }
        __syncthreads();
    }
}

DEV void wfold_prep(bf16_t* WfT, const float* wq, const float* wk, const float* wv, const float* wg  ) {
    const int tid = opaque_tid(), lane = tid & 63;
    for (int t = blockIdx.x * 8 + (tid >> 6); t < 2048; t += gridDim.x * 8) {
        const int which = t >> 10, ch = t & 1023, hd = ch >> 8, d = ch & 255;
        float acc[8];
#pragma unroll
        for (int j = 0; j < 8; ++j) acc[j] = 0.f;
        if (which == 0) {
            const float4 q4 = *(const float4*)(wq + ((size_t)hd * DH + d) * DH + 4 * lane);
            const float4 k4 = *(const float4*)(wk + ((size_t)hd * DH + d) * DH + 4 * lane);
            const float qv[4] = {q4.x, q4.y, q4.z, q4.w}, kv[4] = {k4.x * 0.0625f, k4.y * 0.0625f, k4.z * 0.0625f, k4.w * 0.0625f};
#pragma unroll
            for (int e = 0; e < 4; ++e) {
                const float* g1 = wg + (size_t)(hd * DH + 4 * lane + e) * 8; const float* g2 = wg + (size_t)(DM + hd * DH + 4 * lane + e) * 8;
                const float4 a0 = *(const float4*)g1, a1 = *(const float4*)(g1 + 4), b0 = *(const float4*)g2, b1 = *(const float4*)(g2 + 4);
                acc[0] += qv[e] * a0.x + kv[e] * b0.x; acc[1] += qv[e] * a0.y + kv[e] * b0.y; acc[2] += qv[e] * a0.z + kv[e] * b0.z; acc[3] += qv[e] * a0.w + kv[e] * b0.w;
                acc[4] += qv[e] * a1.x + kv[e] * b1.x; acc[5] += qv[e] * a1.y + kv[e] * b1.y; acc[6] += qv[e] * a1.z + kv[e] * b1.z; acc[7] += qv[e] * a1.w + kv[e] * b1.w;
            }
        } else {
            const float4 v4 = *(const float4*)(wv + ((size_t)hd * DH + d) * DH + 4 * lane);
            const float vv[4] = {v4.x, v4.y, v4.z, v4.w};
#pragma unroll
            for (int e = 0; e < 4; ++e) {
                const float* g1 = wg + (size_t)(2 * DM + hd * DH + 4 * lane + e) * 8;
                const float4 a0 = *(const float4*)g1, a1 = *(const float4*)(g1 + 4);
                acc[0] += vv[e] * a0.x; acc[1] += vv[e] * a0.y; acc[2] += vv[e] * a0.z; acc[3] += vv[e] * a0.w;
                acc[4] += vv[e] * a1.x; acc[5] += vv[e] * a1.y; acc[6] += vv[e] * a1.z; acc[7] += vv[e] * a1.w;
            }
        }
#pragma unroll
        for (int j = 0; j < 8; ++j) acc[j] = wave_sum(acc[j]);
        if (lane < 16) {
            float v = 0.f;
#pragma unroll
            for (int j = 0; j < 8; ++j) v = (lane == j) ? acc[j] : v;
            WfT[((size_t)which * 16 + lane) * 1024 + ch] = f2bf(v);
        }
    }
}
DEV void xc_gates_phase(LAS char* shm, const bf16_t* mi, bf16_t* xc, const bf16_t* WfT, const float* cw, const float* cb, float* gpart  ) {
    const int tid = opaque_tid(), wid = __builtin_amdgcn_readfirstlane(tid >> 6), lane = tid & 63, fr = lane & 15, fq = lane >> 4;
    constexpr int WRS = 2064, WIMG = 8 * WRS, CWL = 2 * WIMG, STG = CWL + 5 * 4096, SRS_ = 528, STG_W = 19 * SRS_;
    __syncthreads();
    for (int i = tid; i < 2 * 8 * 128; i += 512) {
        const int rowi = i >> 7, pc = i & 127;
        const uint4 v = *(const uint4*)(WfT + (size_t)((rowi >> 3) * 16 + (rowi & 7)) * 1024 + pc * 8);
        *(LAS u32x4*)(shm + rowi * WRS + pc * 16) = (u32x4){v.x, v.y, v.z, v.w};
    }
    for (int i = tid; i < 5 * 256; i += 512) {
        const float4 v = (i < 1024) ? *(const float4*)(cw + i * 4) : *(const float4*)(cb + (i - 1024) * 4);
        *(LAS f32x4*)(shm + CWL + i * 16) = (f32x4){v.x, v.y, v.z, v.w};
    }
    __syncthreads();
    LAS char* stg = shm + STG + wid * STG_W;
    for (int task = blockIdx.x * 8 + wid; task < (MTOK / 16) * 2; task += gridDim.x * 8) {
        const int chalf = task & 1, m0 = (task >> 1) * 16, tpos0 = m0 % SEQ;
        f32x4 acc = (f32x4){0.f, 0.f, 0.f, 0.f};
        uint4 pre[10];
#pragma unroll
        for (int it = 0; it < 10; ++it) {
            const int i = lane + 64 * it, row = i >> 5, pc = i & 31;
            pre[it] = make_uint4(0, 0, 0, 0);
            if (i < 19 * 32 && tpos0 - 3 + row >= 0) pre[it] = *(const uint4*)(mi + (size_t)(m0 - 3 + row) * DM + chalf * 512 + pc * 8);
        }
#pragma nounroll
        for (int sl = 0; sl < 2; ++sl) {
            const int c0 = chalf * 512 + sl * 256;
#pragma unroll
            for (int it = 0; it < 10; ++it) {
                const int i = lane + 64 * it, row = i >> 5, pc = i & 31;
                if (i < 19 * 32) *(LAS u32x4*)(stg + row * SRS_ + pc * 16) = (u32x4){pre[it].x, pre[it].y, pre[it].z, pre[it].w};
            }
            if (sl == 0) {
#pragma unroll
                for (int it = 0; it < 10; ++it) {
                    const int i = lane + 64 * it, row = i >> 5, pc = i & 31;
                    pre[it] = make_uint4(0, 0, 0, 0);
                    if (i < 19 * 32 && tpos0 - 3 + row >= 0) pre[it] = *(const uint4*)(mi + (size_t)(m0 - 3 + row) * DM + c0 + 256 + pc * 8);
                }
            }
#pragma nounroll
            for (int ks = 0; ks < 8; ++ks) {
                const int cl = 32 * ks + 8 * fq, c = c0 + cl;
                float xv[8], t8[8];
                { const f32x4 b0 = *(const LAS f32x4*)(shm + CWL + 16384 + c * 4), b1 = *(const LAS f32x4*)(shm + CWL + 16384 + c * 4 + 16);
                  xv[0] = b0[0]; xv[1] = b0[1]; xv[2] = b0[2]; xv[3] = b0[3]; xv[4] = b1[0]; xv[5] = b1[1]; xv[6] = b1[2]; xv[7] = b1[3]; }
                u32x4 raw3;
#pragma unroll
                for (int tap = 0; tap < 4; ++tap) {
                    const u32x4 rw = *(const LAS u32x4*)(stg + (fr + tap) * SRS_ + cl * 2);
                    if (tap == 3) raw3 = rw;
                    unpack8(make_uint4(rw[0], rw[1], rw[2], rw[3]), t8);
                    const f32x4 w0 = *(const LAS f32x4*)(shm + CWL + tap * 4096 + c * 4), w1 = *(const LAS f32x4*)(shm + CWL + tap * 4096 + c * 4 + 16);
                    xv[0] += t8[0] * w0[0]; xv[1] += t8[1] * w0[1]; xv[2] += t8[2] * w0[2]; xv[3] += t8[3] * w0[3];
                    xv[4] += t8[4] * w1[0]; xv[5] += t8[5] * w1[1]; xv[6] += t8[6] * w1[2]; xv[7] += t8[7] * w1[3];
                }
#pragma unroll
                for (int e = 0; e < 8; ++e) xv[e] = siluf_(xv[e]);
                const uint4 xp = pack8(xv);
                *(uint4*)(xc + (size_t)(m0 + fr) * DM + c) = xp;
                const u32x4 xpu = (u32x4){xp.x, xp.y, xp.z, xp.w};
                const bf16x8 bx = *(const LAS bf16x8*)(shm + (fr & 7) * WRS + c * 2);
                const bf16x8 bv = *(const LAS bf16x8*)(shm + WIMG + (fr & 7) * WRS + c * 2);
                acc = __builtin_amdgcn_mfma_f32_16x16x32_bf16(*(const bf16x8*)&xpu, bx, acc, 0, 0, 0);
                acc = __builtin_amdgcn_mfma_f32_16x16x32_bf16(*(const bf16x8*)&raw3, bv, acc, 0, 0, 0);
            }
        }
        if (fr < 8) {
#pragma unroll
            for (int r = 0; r < 4; ++r) gpart[((size_t)chalf * MTOK + m0 + 4 * fq + r) * 8 + fr] = acc[r];
        }
    }
}

#define XB_TMO      128
#define XB_XCNT(j)  (256  + 64 * (j))
#define XB_XSUB(j)  (1280 + 64 * (j))
#define XB_XGEN(j)  (2304 + 64 * (j))
#define XB_TOP      3328
#define XB_TOPGEN   3392
#define XCD_BAR_WORDS 3456
#define XB_SPIN_CAP (1u << 18)
DEV unsigned xb_ld(unsigned* p) { return __hip_atomic_load(p, __ATOMIC_RELAXED, __HIP_MEMORY_SCOPE_AGENT); }
DEV unsigned xb_add(unsigned* p, unsigned v) { return __hip_atomic_fetch_add(p, v, __ATOMIC_RELAXED, __HIP_MEMORY_SCOPE_AGENT); }
DEV unsigned xb_xcc_id() { return (unsigned)__builtin_amdgcn_s_getreg((3 << 11) | 20) & 0xFu; }
#define XB_SPIN(cond, bar) do { unsigned _sp = 0; while (cond) { __builtin_amdgcn_s_sleep(1); \
    if ((++_sp & 255u) == 0u) { if (xb_ld(&(bar)[XB_TMO])) break; if (_sp > XB_SPIN_CAP) { atomicAdd(&(bar)[XB_TMO], 1u); break; } } } } while (0)
struct XcdBarrier { unsigned* bar; unsigned x; volatile LAS unsigned* st; };
DEV XcdBarrier xcd_barrier_post(unsigned* bar, volatile LAS unsigned* st) {
    XcdBarrier b; b.bar = bar; b.x = xb_xcc_id(); b.st = st;
    if (threadIdx.x == 0) (void)xb_add(&bar[XB_XCNT(b.x)], 1u);
    return b;
}
DEV void xcd_barrier_complete(unsigned* bar, unsigned x, unsigned& nloc, unsigned& nx) {
    const unsigned G = gridDim.x * gridDim.y * gridDim.z;
    unsigned sum, cnt, mine, sp = 0u;
    for (;;) {
        sum = 0u; cnt = 0u; mine = 0u;
#pragma nounroll
        for (unsigned j = 0; j < 16; ++j) { const unsigned c = xb_ld(&bar[XB_XCNT(j)]); sum += c; cnt += (c > 0u) ? 1u : 0u; }
        mine = xb_ld(&bar[XB_XCNT(x)]);
        if (sum == G) break;
        __builtin_amdgcn_s_sleep(1);
        if ((++sp & 255u) == 0u) { if (xb_ld(&bar[XB_TMO])) break; if (sp > XB_SPIN_CAP) { atomicAdd(&bar[XB_TMO], 1u); break; } }
    }
    nloc = mine > 0u ? mine : 1u; nx = cnt > 0u ? cnt : 1u;
}
DEV void xcd_barrier1(const XcdBarrier& b) {
    asm volatile("s_waitcnt vmcnt(0)" ::: "memory");
    __syncthreads();
    if (threadIdx.x == 0) {
        unsigned* bar = b.bar;
        __builtin_amdgcn_s_waitcnt(0);
        unsigned nloc = b.st[0], nx = b.st[1];
        if (nloc == 0u) { xcd_barrier_complete(bar, b.x, nloc, nx); b.st[0] = nloc; b.st[1] = nx; }
        const unsigned old = xb_add(&bar[XB_XSUB(b.x)], 1u);
        const unsigned gen = old / nloc;
        if (old + 1u == (gen + 1u) * nloc) {
            __builtin_amdgcn_fence(__ATOMIC_RELEASE, "agent");
            asm volatile("s_waitcnt vmcnt(0)" ::: "memory");
            const unsigned og = xb_add(&bar[XB_TOP], 1u);
            const unsigned tg = og / nx;
            if (og + 1u == (tg + 1u) * nx) xb_add(&bar[XB_TOPGEN], 1u);
            else XB_SPIN(xb_ld(&bar[XB_TOPGEN]) == tg, bar);
            __builtin_amdgcn_fence(__ATOMIC_ACQUIRE, "agent");
            xb_add(&bar[XB_XGEN(b.x)], 1u);
            asm volatile("s_waitcnt vmcnt(0)" ::: "memory");
        } else {
            XB_SPIN(xb_ld(&bar[XB_XGEN(b.x)]) == gen, bar);
            __builtin_amdgcn_fence(__ATOMIC_ACQUIRE, "agent");
            asm volatile("s_waitcnt vmcnt(0)" ::: "memory");
        }
    }
    __syncthreads();
}

DEV void xcd_barrier(const XcdBarrier& b) { xcd_barrier1(b); if (REPMASK & 2048) xcd_barrier1(b); }
constexpr int LDS_BYTES = 148 * 1024;
DEV const void* ldptr(LAS char* shm, int i) {
    volatile LAS unsigned* pt = (volatile LAS unsigned*)(shm + LDS_BYTES - 512);
    const unsigned lo = __builtin_amdgcn_readfirstlane(pt[2 * i]), hi = __builtin_amdgcn_readfirstlane(pt[2 * i + 1]);
    return (const void*)(const __attribute__((address_space(1))) void*)(((unsigned long long)hi << 32) | lo);
}
#define PF(i) ((const float*)ldptr(shm, (i)))
struct Params {
    const float *x, *c, *norm_gain, *w_mod, *b_mod, *w_in, *lam_re, *lam_im, *log_dt, *sb_re, *sb_im, *sc_re, *sc_im, *ssm_d, *w_glu, *b_glu, *ssm_og,
        *conv_w, *conv_b, *wq, *wk, *wv, *w_gates, *b_ig, *b_fg, *m_ng, *m_skip, *w_out, *final_gain;
    float* out; char* ws;
};
constexpr int HALF_FLOATS = 56 * 1024 / 4;
constexpr size_t SLOT = (size_t)MTOK * DM * 2;
constexpr size_t W_IN_OFF = 0, W_GLU_OFF = 10485760, W_QKV_OFF = 12582912, W_OUT_OFF = 14155776, MOD_OFF = 20u << 20, IPRE_OFF = 21u << 20, LOGF_OFF = 22u << 20, BAR_OFF = 23u << 20, WF_OFF = 19u << 20, ROWSS_OFF = 24u << 20, RSTD_OFF = 25u << 20, XSS_OFF = 26u << 20;
#define REP(bit) _Pragma("nounroll") for (int rep_ = 0; rep_ < (((REPMASK) & (bit)) ? 2 : 1); ++rep_)
#define FOR_VB(nvb) for (int vb = blockIdx.x * 2 + HALF; vb < (nvb); vb += gridDim.x * 2)

#define WSB ((char*)ldptr(shm, 30))
#define SL(i) ((bf16_t*)(WSB + SLOT * (i)))
#define S7(off) (WSB + SLOT * 7 + (off))
#define WinT ((bf16_t*)S7(W_IN_OFF))
#define WgluT ((bf16_t*)S7(W_GLU_OFF))
#define WqkvT ((bf16_t*)S7(W_QKV_OFF))
#define WoutT ((bf16_t*)S7(W_OUT_OFF))
#define mod ((float*)S7(MOD_OFF))
#define gpart ((float*)S7(IPRE_OFF))
#define WfT ((bf16_t*)S7(WF_OFF))
#define rowss ((float*)S7(ROWSS_OFF))
#define rstdv ((float*)S7(RSTD_OFF))
#define xssv ((float*)S7(XSS_OFF))
#define MX SL(1)
#define OUTP ((float*)ldptr(shm, 29))
#define H SL(0)
#define U SL(1)
#define Y SL(2)
#define Z SL(3)
#define XC SL(4)
#define MI SL(5)
#define Q SL(6)
#define Kb SL(1)
#define V SL(2)
#define HC SL(5)
template <int l, int PART>
DEV void prep_layer(LAS char* shm) {
    const int wave = opaque_tid() >> 6, lane = opaque_tid() & 63;
    __syncthreads();
    {
        LAS float* scr = (LAS float*)(shm + wave * 16640);
        const float* Win = PF(5) + (size_t)l * DM * INC;
        constexpr int I_IN = 16 * 80, I_GLU = 16 * 16, I_QKV = 12 * 16, I_OUT = 32 * 16;
        constexpr int LO = (PART & 1) ? 0 : (I_IN + I_GLU + I_QKV), HI = (PART & 2) ? (I_IN + I_GLU + I_QKV + I_OUT) : (I_IN + I_GLU + I_QKV);
        for (int it = LO + blockIdx.x * 8 + wave; it < HI; it += gridDim.x * 8) {
            int r = it;
            if (r < I_IN) { transpose_item(Win, INC, INC, WinT, DM, scr, r, lane); continue; } r -= I_IN;
            if (r < I_GLU) { transpose_item(PF(14) + (size_t)l * DM * DM, DM, DM, WgluT, DM, scr, r, lane); continue; } r -= I_GLU;
            if (r < I_QKV) { const int mat = r / 16, which = mat >> 2, hd = mat & 3;
                const float* W = sel3(which, PF(19), PF(20), PF(21)) + ((size_t)l * NH + hd) * DH * DH;
                transpose_item(W, DH, DH, WqkvT + (size_t)mat * DH * DH, DH, scr, r % 16, lane); continue; } r -= I_QKV;
            transpose_item(PF(27) + (size_t)l * 2 * DM * DM, DM, DM, WoutT, 2 * DM, scr, r, lane);
        }
    }
    if (PART & 1) {
        wfold_prep(WfT, PF(19) + (size_t)l * NH * DH * DH, PF(20) + (size_t)l * NH * DH * DH, PF(21) + (size_t)l * NH * DH * DH, PF(22) + (size_t)l * 3 * DM * 8);
        __syncthreads();
        s5_tables(shm, (char*)SL(3), PF(6) + l * NG * NP, PF(7) + l * NG * NP, PF(8) + l * NG, PF(9) + (size_t)l * NG * NP * GC, PF(10) + (size_t)l * NG * NP * GC,
                  PF(11) + (size_t)l * NG * GC * NP, PF(12) + (size_t)l * NG * GC * NP);
    }
    __syncthreads();
}
template <int l>
DEV void layer_body(LAS char* shm, const XcdBarrier& gbar) {
        const float* xin = (l == 0) ? PF(0) : OUTP;
        const float* modl = mod + (size_t)l * BATCH * 3 * DM;
        if (l == 0) { REP(1) norm_rows(xin, PF(2) + l * DM, modl, H); xcd_barrier(gbar); }
        REP(2) { g8::SchedG1 S_{H, WinT, (int)blockIdx.x, (int)gridDim.x}; g8::EpiG1 E_{U, MI}; g8::gemm_phase(shm, S_, E_); }
        if (l == 1) prep_layer<1, 2>(shm);
        xcd_barrier(gbar);
        REP(256) s5_phase(shm, U, Y, (const char*)SL(3), PF(13) + l * DM);
        REP(8) xc_gates_phase(shm, MI, XC, WfT, PF(17) + l * 4 * DM, PF(18) + l * DM, gpart);
        xcd_barrier(gbar);
        REP(4) { g8::SchedGlu S_{Y, WgluT, (int)blockIdx.x, (int)gridDim.x}; g8::EpiGlu E_{Y, Z, PF(15) + l * DM, rowss}; g8::gemm_phase(shm, S_, E_); }
        xcd_barrier(gbar);
        REP(16) { g8::SchedQkv S_{XC, MI, WqkvT, (int)blockIdx.x, (int)gridDim.x}; g8::EpiQkv E_{Q, Kb, V}; g8::gemm_phase(shm, S_, E_); }
        xcd_barrier(gbar);
        rstd_rows(rowss, rstdv);
        REP(32) mlstm_phase<0>(shm, Q, Kb, V, gpart, PF(23) + l * 4, PF(24) + l * 4, HC);
#ifdef MLPROBE
        if (l == 0) mlstm_phase<MLPROBE>(shm, Q, Kb, V, gpart, PF(23) + l * 4, PF(24) + l * 4, (bf16_t*)OUTP);
#endif
        xcd_barrier(gbar);
        { g8::SchedG2s S_{H, WinT, (int)blockIdx.x}; g8::EpiG2s E_{Z, rstdv, PF(16) + l * DM, MX}; g8::gemm_phase(shm, S_, E_); }
        { g8::SchedG2m S_{H, WinT, (int)blockIdx.x}; g8::EpiG2m E_{HC, XC, PF(25) + l * DM, PF(26) + l * DM, MX}; g8::gemm_phase(shm, S_, E_); }
        xcd_barrier(gbar);
        if (l == 0) { g8::SchedOut S_{MX, WoutT, (int)blockIdx.x, (int)gridDim.x};
            g8::EpiOutN<false> E_{xin, OUTP, modl + 2 * DM, PF(2) + DM, mod + (size_t)BATCH * 3 * DM, H, xssv, (unsigned*)S7(BAR_OFF) + 4096, (unsigned*)S7(BAR_OFF) + XB_TMO}; g8::gemm_phase(shm, S_, E_);
            prep_layer<1, 1>(shm); }
        else { g8::SchedOut S_{MX, WoutT, (int)blockIdx.x, (int)gridDim.x};
            g8::EpiOutN<true> E_{xin, OUTP, modl + 2 * DM, PF(28), mod, H, xssv + (size_t)MTOK * 4, (unsigned*)S7(BAR_OFF) + 4096 + 4096, (unsigned*)S7(BAR_OFF) + XB_TMO}; g8::gemm_phase(shm, S_, E_); }
        xcd_barrier(gbar);
    }
__global__ void __launch_bounds__(512, 2) mega(Params Pk) {
    extern __shared__ __attribute__((aligned(16))) unsigned char lds_raw[];
    {
        volatile LAS unsigned long long* pt = (volatile LAS unsigned long long*)((LAS char*)lds_raw + LDS_BYTES - 512);
        if (threadIdx.x == 0) {
            pt[0] = (unsigned long long)Pk.x;
            pt[1] = (unsigned long long)Pk.c;
            pt[2] = (unsigned long long)Pk.norm_gain;
            pt[3] = (unsigned long long)Pk.w_mod;
            pt[4] = (unsigned long long)Pk.b_mod;
            pt[5] = (unsigned long long)Pk.w_in;
            pt[6] = (unsigned long long)Pk.lam_re;
            pt[7] = (unsigned long long)Pk.lam_im;
            pt[8] = (unsigned long long)Pk.log_dt;
            pt[9] = (unsigned long long)Pk.sb_re;
            pt[10] = (unsigned long long)Pk.sb_im;
            pt[11] = (unsigned long long)Pk.sc_re;
            pt[12] = (unsigned long long)Pk.sc_im;
            pt[13] = (unsigned long long)Pk.ssm_d;
            pt[14] = (unsigned long long)Pk.w_glu;
            pt[15] = (unsigned long long)Pk.b_glu;
            pt[16] = (unsigned long long)Pk.ssm_og;
            pt[17] = (unsigned long long)Pk.conv_w;
            pt[18] = (unsigned long long)Pk.conv_b;
            pt[19] = (unsigned long long)Pk.wq;
            pt[20] = (unsigned long long)Pk.wk;
            pt[21] = (unsigned long long)Pk.wv;
            pt[22] = (unsigned long long)Pk.w_gates;
            pt[23] = (unsigned long long)Pk.b_ig;
            pt[24] = (unsigned long long)Pk.b_fg;
            pt[25] = (unsigned long long)Pk.m_ng;
            pt[26] = (unsigned long long)Pk.m_skip;
            pt[27] = (unsigned long long)Pk.w_out;
            pt[28] = (unsigned long long)Pk.final_gain;
            pt[29] = (unsigned long long)Pk.out; pt[30] = (unsigned long long)Pk.ws;
        }
    }
    __syncthreads();
    LAS char* shm = (LAS char*)lds_raw;
    float* ldsf = (float*)lds_raw + HALF * HALF_FLOATS;
    volatile LAS unsigned* bst = (volatile LAS unsigned*)(shm + LDS_BYTES - 16);
    if (threadIdx.x < 4) bst[threadIdx.x] = 0u;
    __syncthreads();
    const XcdBarrier gbar = xcd_barrier_post((unsigned*)((char*)ldptr(shm, 30) + SLOT * 7 + BAR_OFF), bst);
    REP(4096) mod_phase(shm, PF(1), PF(3), PF(4), mod);
    prep_layer<0, 3>(shm);
    xcd_barrier(gbar);
    layer_body<0>(shm, gbar);
    layer_body<1>(shm, gbar);
}

#undef WSB
#undef SL
#undef S7
#undef WinT
#undef WgluT
#undef WqkvT
#undef WoutT
#undef mod
#undef gpart
#undef WfT
#undef rowss
#undef rstdv
#undef xssv
#undef MX
#undef OUTP
#undef H
#undef U
#undef Y
#undef Z
#undef XC
#undef MI
#undef Q
#undef Kb
#undef V
#undef HC
extern "C" void kernel_launch(void* const* d_in, const int* in_sizes, int n_in, void* d_out, int out_size, void* d_ws, size_t ws_size, hipStream_t stream) {
    static int grid_blocks = 0;
    if (!grid_blocks) {
        int dev = 0, cus = 0, per_cu = 0;
        (void)hipGetDevice(&dev);
        (void)hipDeviceGetAttribute(&cus, hipDeviceAttributeMultiprocessorCount, dev);
        (void)hipFuncSetAttribute((const void*)mega, hipFuncAttributeMaxDynamicSharedMemorySize, LDS_BYTES);
        (void)hipOccupancyMaxActiveBlocksPerMultiprocessor(&per_cu, (const void*)mega, 512, LDS_BYTES);
        grid_blocks = cus;
        fprintf(stderr, "mega: cus=%d occupancy per_cu=%d grid=%d\n", cus, per_cu, grid_blocks);
    }
    (void)hipMemsetAsync((char*)d_ws + SLOT * 7 + BAR_OFF, 0, 65536, stream);
    Params P{};
    const float** pp = (const float**)&P;
    for (int i = 0; i < 29; ++i) pp[i] = (const float*)d_in[i];
    P.out = (float*)d_out; P.ws = (char*)d_ws;
    void* args[] = {&P};
    hipError_t e = hipLaunchCooperativeKernel((const void*)mega, dim3(grid_blocks), dim3(512), args, LDS_BYTES, stream);
    if (e != hipSuccess) fprintf(stderr, "cooperative launch failed: %s (grid %d)\n", hipGetErrorString(e), grid_blocks);
}
```

```cpp
#include <hip/hip_runtime.h>
#include <cstdio>
#include <cstdint>
#include <hip/hip_cooperative_groups.h>
namespace cg = cooperative_groups;

#ifndef REPMASK
#define REPMASK 0
#endif
typedef unsigned short bf16_t;
#define DEV __device__ __forceinline__

constexpr int BATCH = 8, SEQ = 2048, DM = 1024, MTOK = BATCH * SEQ;
constexpr int NG = 64, NP = 64, GC = 16, NH = 4, DH = 256, CHUNK = 64, INC = 5120;
constexpr float EPS = 1e-6f;

DEV int opaque_tid() { int t = threadIdx.x; asm volatile("" : "+v"(t)); return t; }
#define TIDH (opaque_tid() & 255)
#define HALF (opaque_tid() >> 8)
DEV float bf2f(bf16_t v) { return __uint_as_float(((unsigned)v) << 16); }
typedef __bf16 bf16n2 __attribute__((ext_vector_type(2)));
typedef float f32n2 __attribute__((ext_vector_type(2)));
DEV bf16_t f2bf(float f) { __bf16 b = (__bf16)f; return __builtin_bit_cast(unsigned short, b); }
DEV unsigned pk2(float lo, float hi) { f32n2 v = {lo, hi}; bf16n2 b = __builtin_convertvector(v, bf16n2); return __builtin_bit_cast(unsigned, b); }
DEV float sigmoidf_(float x) { return __builtin_amdgcn_rcpf(1.f + __expf(-x)); }
DEV float siluf_(float x) { return x * __builtin_amdgcn_rcpf(1.f + __expf(-x)); }
DEV float geluf_(float x) { const float t2 = 1.5957691216057308f * (x + 0.044715f * x * x * x); return x * __builtin_amdgcn_rcpf(1.f + __expf(-t2)); }
DEV float logsigmoidf_(float x) { return fminf(x, 0.f) - log1pf(__expf(-fabsf(x))); }

DEV float wave_sum(float v) {
#pragma unroll
    for (int o = 1; o < 64; o <<= 1) v += __shfl_xor(v, o);
    return v;
}
DEV float block_sum256(float v, float* red) {
    v = wave_sum(v);
    __syncthreads();
    if ((TIDH & 63) == 0) red[TIDH >> 6] = v;
    __syncthreads();
    return red[0] + red[1] + red[2] + red[3];
}

DEV void k_mod(int vb, float* ldsf, const float* c, const float* w_mod, const float* b_mod, float* mod) {
    float (*sc)[DM] = (float (*)[DM])ldsf;
    const int l = vb / 12, n = (vb % 12) * 256 + TIDH;
    __syncthreads();
    for (int i = TIDH; i < BATCH * DM; i += 256) sc[i / DM][i % DM] = siluf_(c[i]);
    __syncthreads();
    float acc[BATCH];
#pragma unroll
    for (int b = 0; b < BATCH; ++b) acc[b] = 0.f;
    const float* W = w_mod + (size_t)l * DM * 3 * DM;
    for (int k = 0; k < DM; ++k) {
        float w = W[(size_t)k * 3 * DM + n];
#pragma unroll
        for (int b = 0; b < BATCH; ++b) acc[b] += sc[b][k] * w;
    }
#pragma unroll
    for (int b = 0; b < BATCH; ++b) mod[((size_t)l * BATCH + b) * 3 * DM + n] = acc[b] + b_mod[l * 3 * DM + n];
}

DEV void k_norm_mod(int vb, float* red, const float* x, const float* gain, const float* mod  , bf16_t* h) {
    const int m = vb, b = m / SEQ, t = TIDH;
    const float4 v = ((const float4*)(x + (size_t)m * DM))[t];
    float ss = v.x * v.x + v.y * v.y + v.z * v.z + v.w * v.w;
    ss = block_sum256(ss, red);
    const float rstd = rsqrtf(ss * (1.f / DM) + EPS);
    const float* shift = mod + (size_t)b * 3 * DM;
    const float* scale = shift + DM;
    float xv[4] = {v.x, v.y, v.z, v.w};
#pragma unroll
    for (int i = 0; i < 4; ++i) {
        int n = t * 4 + i;
        float y = xv[i] * rstd * gain[n] * (1.f + scale[n]) + shift[n];
        h[(size_t)m * DM + n] = f2bf(y);
    }
}

DEV void k_s5(int item, float* ldsf, const bf16_t* u, bf16_t* y, const float* lam_re, const float* lam_im, const float* log_dt,
                                           const float* b_re, const float* b_im, const float* c_re, const float* c_im, const float* dskip) {
    const int tid_ = opaque_tid();
    float (*part)[17] = (float (*)[17])(ldsf + (tid_ >> 6) * 64 * 17);
    const int g = item & 63, b = item >> 6, p = tid_ & 63;
    const double lr = lam_re[g * NP + p], li = lam_im[g * NP + p], dt = exp((double)log_dt[g]);
    const double er = exp(lr * dt);
    const double ard = er * cos(li * dt), aid = er * sin(li * dt);
    const double dr = ard - 1.0, di = aid, den = lr * lr + li * li;
    const double cr = (dr * lr + di * li) / den, ci = (di * lr - dr * li) / den;
    float bbr[16], bbi[16], ccr[16], cci[16];
#pragma unroll
    for (int c = 0; c < 16; ++c) {
        const double br = b_re[(g * NP + p) * GC + c], bi = b_im[(g * NP + p) * GC + c];
        bbr[c] = (float)(cr * br - ci * bi); bbi[c] = (float)(cr * bi + ci * br);
        ccr[c] = c_re[(g * GC + c) * NP + p]; cci[c] = c_im[(g * GC + c) * NP + p];
    }
    const float ar = (float)ard, ai = (float)aid;
    const float dsk = dskip[g * GC + (p & 15)];
    float sr = 0.f, si = 0.f;
    for (int t = 0; t < SEQ; ++t) {
        const bf16_t* up = u + (size_t)(b * SEQ + t) * DM + g * GC;
        const uint4 u0 = *(const uint4*)up, u1 = *(const uint4*)(up + 8);
        float uf[16];
        uf[0] = bf2f(u0.x & 0xffff); uf[1] = bf2f(u0.x >> 16); uf[2] = bf2f(u0.y & 0xffff); uf[3] = bf2f(u0.y >> 16);
        uf[4] = bf2f(u0.z & 0xffff); uf[5] = bf2f(u0.z >> 16); uf[6] = bf2f(u0.w & 0xffff); uf[7] = bf2f(u0.w >> 16);
        uf[8] = bf2f(u1.x & 0xffff); uf[9] = bf2f(u1.x >> 16); uf[10] = bf2f(u1.y & 0xffff); uf[11] = bf2f(u1.y >> 16);
        uf[12] = bf2f(u1.z & 0xffff); uf[13] = bf2f(u1.z >> 16); uf[14] = bf2f(u1.w & 0xffff); uf[15] = bf2f(u1.w >> 16);
        float bur = 0.f, bui = 0.f;
#pragma unroll
        for (int c = 0; c < 16; ++c) { bur += bbr[c] * uf[c]; bui += bbi[c] * uf[c]; }
        const float nr = ar * sr - ai * si + bur, ni = ar * si + ai * sr + bui;
        sr = nr; si = ni;
#pragma unroll
        for (int c = 0; c < 16; ++c) part[p][c] = ccr[c] * sr - cci[c] * si;
        asm volatile("s_waitcnt lgkmcnt(0)" ::: "memory");
        float s = 0.f;
#pragma unroll
        for (int k = 0; k < 16; ++k) s += part[(p >> 4) * 16 + k][p & 15];
        s += __shfl_xor(s, 16); s += __shfl_xor(s, 32);
        if (p < 16) {
            const float yv = s + dsk * bf2f(up[p]);
            y[(size_t)(b * SEQ + t) * DM + g * GC + p] = f2bf(geluf_(yv));
        }
        asm volatile("s_waitcnt lgkmcnt(0)" ::: "memory");
    }
}

DEV void k_ssm_post(int vb, float* red, bf16_t* z, const bf16_t* sg, const float* gain) {
    const int m = vb, t = TIDH;
    float zv[4]; float ss = 0.f;
#pragma unroll
    for (int i = 0; i < 4; ++i) { zv[i] = bf2f(z[(size_t)m * DM + t * 4 + i]); ss += zv[i] * zv[i]; }
    ss = block_sum256(ss, red);
    const float rstd = rsqrtf(ss * (1.f / DM) + EPS);
#pragma unroll
    for (int i = 0; i < 4; ++i) {
        const int n = t * 4 + i;
        z[(size_t)m * DM + n] = f2bf(zv[i] * rstd * gain[n] * siluf_(bf2f(sg[(size_t)m * DM + n])));
    }
}

DEV float conv_xc(const bf16_t* mi, int m, int n, const float* cw, const float* cb) {
    const int t = m % SEQ;
    float acc = cb[n];
#pragma unroll
    for (int j = 0; j < 4; ++j) {
        const int tt = t - 3 + j;
        if (tt >= 0) acc += bf2f(mi[(size_t)(m - 3 + j) * DM + n]) * cw[j * DM + n];
    }
    return siluf_(acc);
}
DEV void k_conv(int vb, const bf16_t* mi, bf16_t* xc, const float* cw, const float* cb) {
    const size_t idx = (size_t)vb * 256 + TIDH;
    const int m = (int)(idx / DM), n = (int)(idx % DM);
    xc[idx] = f2bf(conv_xc(mi, m, n, cw, cb));
}

DEV void k_gates(int vb, float* ldsf, const bf16_t* q, const bf16_t* k, const bf16_t* v, const float* wg  , const float* bi, const float* bfg,
                                               float* ipre, float* logf) {
    float (*red)[8] = (float (*)[8])ldsf;
    const int m = vb, t = TIDH;
    __syncthreads();
    float acc[8];
#pragma unroll
    for (int j = 0; j < 8; ++j) acc[j] = 0.f;
    for (int e = t; e < 3 * DM; e += 256) {
        const bf16_t* src = (e < DM) ? q : (e < 2 * DM ? k : v);
        const float xv = bf2f(src[(size_t)m * DM + (e & (DM - 1))]);
#pragma unroll
        for (int j = 0; j < 8; ++j) acc[j] += xv * wg[e * 8 + j];
    }
#pragma unroll
    for (int j = 0; j < 8; ++j) acc[j] = wave_sum(acc[j]);
    if ((t & 63) == 0) {
#pragma unroll
        for (int j = 0; j < 8; ++j) red[t >> 6][j] = acc[j];
    }
    __syncthreads();
    if (t < 8) {
        const float s = red[0][t] + red[1][t] + red[2][t] + red[3][t];
        if (t < 4) ipre[(size_t)m * 4 + t] = s + bi[t];
        else logf[(size_t)m * 4 + (t - 4)] = logsigmoidf_(s + bfg[t - 4]);
    }
}

DEV void k_mlstm(int vb, float* ldsf, const bf16_t* q, const bf16_t* k, const bf16_t* v, const float* ipre, const float* logf, bf16_t* hc) {
    float (*Cs)[257] = (float (*)[257])ldsf;
    float (*St)[65] = (float (*)[65])(ldsf + 32 * 257);
    float* nvec = ldsf + 32 * 257 + 64 * 65;
    float* bcum = nvec + 256; float* ig = bcum + 64; float* mt = ig + 64; float* winter = mt + 64; float* ws_ = winter + 64; float* hden = ws_ + 64;
    float* sc = hden + 64;
    const int tid = TIDH;
    const int vs = vb & 7, h = (vb >> 3) & 3, b = vb >> 5;
    __syncthreads();
    for (int i = tid; i < 32 * 257; i += 256) (&Cs[0][0])[i] = 0.f;
    nvec[tid] = 0.f;
    if (tid == 0) sc[0] = 0.f;
    __syncthreads();
    const size_t base = (size_t)b * SEQ * DM + h * DH;
    for (int j = 0; j < SEQ / CHUNK; ++j) {
        const size_t cb = base + (size_t)j * CHUNK * DM;
        const int m0 = b * SEQ + j * CHUNK;
        if (tid < 64) {
            ig[tid] = ipre[(size_t)(m0 + tid) * 4 + h];
            ws_[tid] = logf[(size_t)(m0 + tid) * 4 + h];
        }
        __syncthreads();
        if (tid < 64) { float s = 0.f; for (int i = 0; i <= tid; ++i) s += ws_[i]; bcum[tid] = s; }
        __syncthreads();
        const float m_prev = sc[0];
        if (tid < 64) {
            const float m_inter = bcum[tid] + m_prev;
            float mx = -INFINITY;
            for (int s = 0; s <= tid; ++s) mx = fmaxf(mx, bcum[tid] - bcum[s] + ig[s]);
            const float m = fmaxf(m_inter, mx);
            mt[tid] = m; winter[tid] = __expf(m_inter - m);
        }
        __syncthreads();
        for (int idx = tid; idx < 4096; idx += 256) {
            const int t = idx >> 6, s = idx & 63;
            float r = 0.f;
            if (s <= t) {
                const bf16_t* qp = q + cb + (size_t)t * DM; const bf16_t* kp = k + cb + (size_t)s * DM;
                float dot = 0.f;
                for (int d = 0; d < DH; d += 8) {
                    const uint4 qa = *(const uint4*)(qp + d), ka = *(const uint4*)(kp + d);
                    dot += bf2f(qa.x & 0xffff) * bf2f(ka.x & 0xffff) + bf2f(qa.x >> 16) * bf2f(ka.x >> 16);
                    dot += bf2f(qa.y & 0xffff) * bf2f(ka.y & 0xffff) + bf2f(qa.y >> 16) * bf2f(ka.y >> 16);
                    dot += bf2f(qa.z & 0xffff) * bf2f(ka.z & 0xffff) + bf2f(qa.z >> 16) * bf2f(ka.z >> 16);
                    dot += bf2f(qa.w & 0xffff) * bf2f(ka.w & 0xffff) + bf2f(qa.w >> 16) * bf2f(ka.w >> 16);
                }
                r = dot * __expf(bcum[t] - bcum[s] + ig[s] - mt[t]);
            }
            St[t][s] = r;
        }
        __syncthreads();
        if (tid < 64) {
            const bf16_t* qp = q + cb + (size_t)tid * DM;
            float dn = 0.f;
            for (int d = 0; d < DH; ++d) dn += nvec[d] * bf2f(qp[d]);
            float sm = 0.f;
            for (int s = 0; s < 64; ++s) sm += St[tid][s];
            const float den = winter[tid] * dn + sm;
            hden[tid] = fmaxf(fabsf(den), __expf(-mt[tid]));
        }
        __syncthreads();
        for (int idx = tid; idx < 2048; idx += 256) {
            const int t = idx >> 5, vv = idx & 31;
            const bf16_t* qp = q + cb + (size_t)t * DM;
            float a = 0.f;
            for (int d = 0; d < DH; ++d) a += Cs[vv][d] * bf2f(qp[d]);
            float s2 = 0.f;
            for (int s = 0; s < 64; ++s) s2 += St[t][s] * bf2f(v[cb + (size_t)s * DM + vs * 32 + vv]);
            const float num = winter[t] * a + s2;
            hc[cb + (size_t)t * DM + vs * 32 + vv] = f2bf(num / hden[t]);
        }
        __syncthreads();
        const float b_tot = bcum[63];
        if (tid < 64) ws_[tid] = b_tot - bcum[tid] + ig[tid];
        __syncthreads();
        if (tid == 0) {
            float mx = b_tot + m_prev;
            for (int s = 0; s < 64; ++s) mx = fmaxf(mx, ws_[s]);
            sc[1] = __expf(b_tot + m_prev - mx); sc[0] = mx;
        }
        __syncthreads();
        const float m_next = sc[0], decay = sc[1];
        float myw = 0.f;
        if (tid < 64) myw = __expf(ws_[tid] - m_next);
        __syncthreads();
        if (tid < 64) ws_[tid] = myw;
        __syncthreads();
        for (int idx = tid; idx < 32 * 256; idx += 256) {
            const int vv = idx >> 8, d = idx & 255;
            float a = 0.f;
            for (int s = 0; s < 64; ++s) a += ws_[s] * bf2f(v[cb + (size_t)s * DM + vs * 32 + vv]) * bf2f(k[cb + (size_t)s * DM + d]);
            Cs[vv][d] = decay * Cs[vv][d] + a;
        }
        {
            float a = 0.f;
            for (int s = 0; s < 64; ++s) a += ws_[s] * bf2f(k[cb + (size_t)s * DM + tid]);
            nvec[tid] = decay * nvec[tid] + a;
        }
        __syncthreads();
    }
}

DEV void k_mlstm_post(int vb, bf16_t* hc, const bf16_t* mo, const bf16_t* mg, const bf16_t* mi, const float* cw, const float* cb,
                                                    const float* ngain, const float* skip) {
    const int m = vb, t = TIDH;
    float hv[4]; float s = 0.f;
#pragma unroll
    for (int i = 0; i < 4; ++i) {
        const size_t o = (size_t)m * DM + t * 4 + i;
        hv[i] = bf2f(hc[o]) * sigmoidf_(bf2f(mo[o])); s += hv[i];
    }
    const float mu = wave_sum(s) * (1.f / DH);
    float s2 = 0.f;
#pragma unroll
    for (int i = 0; i < 4; ++i) { hv[i] -= mu; s2 += hv[i] * hv[i]; }
    const float rstd = rsqrtf(wave_sum(s2) * (1.f / DH) + EPS);
#pragma unroll
    for (int i = 0; i < 4; ++i) {
        const int n = t * 4 + i; const size_t o = (size_t)m * DM + n;
        const float xc = conv_xc(mi, m, n, cw, cb);
        const float hn = hv[i] * rstd * ngain[n] + skip[n] * xc;
        hc[o] = f2bf(hn * siluf_(bf2f(mg[o])));
    }
}

DEV void k_final(int vb, float* red, float* x, const float* gain) {
    const int m = vb, t = TIDH;
    float4 v = ((float4*)(x + (size_t)m * DM))[t];
    float ss = v.x * v.x + v.y * v.y + v.z * v.z + v.w * v.w;
    ss = block_sum256(ss, red);
    const float rstd = rsqrtf(ss * (1.f / DM) + EPS);
    const float4 g = ((const float4*)gain)[t];
    v.x *= rstd * g.x; v.y *= rstd * g.y; v.z *= rstd * g.z; v.w *= rstd * g.w;
    ((float4*)(x + (size_t)m * DM))[t] = v;
}


#define LAS __attribute__((address_space(3)))
typedef short bf16x8 __attribute__((ext_vector_type(8)));
typedef float f32x4 __attribute__((ext_vector_type(4)));
typedef short s16x4 __attribute__((ext_vector_type(4)));
typedef unsigned u32x4 __attribute__((ext_vector_type(4)));
typedef unsigned u32x2 __attribute__((ext_vector_type(2)));
typedef float f32x2 __attribute__((ext_vector_type(2)));
#define WAIT_V(n) asm volatile("s_waitcnt vmcnt(" #n ")" ::: "memory")
#define WAIT_L(n) asm volatile("s_waitcnt lgkmcnt(" #n ")" ::: "memory")
#define SCHED() __builtin_amdgcn_sched_barrier(0)

DEV int lds_byte(int r, int c) { int st = (r >> 4) * 2 + (c >> 5), ob = (r & 15) * 64 + (c & 31) * 2; return st * 1024 + (ob ^ (((ob >> 9) & 1) << 5)); }
DEV void stage_rc(int b, int& R, int& C) { int st = b >> 10, sb = b & 1023, swz = sb ^ (((sb >> 9) & 1) << 5); R = (st >> 1) * 16 + swz / 64; C = (st & 1) * 32 + (swz % 64) / 2; }
template <class T> DEV T* sel3(int w, T* p0, T* p1, T* p2) { return p0 + ((w >= 1) ? (p1 - p0) : 0) + ((w >= 2) ? (p2 - p1) : 0); }
DEV void unpack8(const uint4 v, float* f) {
    f[0] = bf2f((bf16_t)(v.x & 0xffff)); f[1] = bf2f((bf16_t)(v.x >> 16)); f[2] = bf2f((bf16_t)(v.y & 0xffff)); f[3] = bf2f((bf16_t)(v.y >> 16));
    f[4] = bf2f((bf16_t)(v.z & 0xffff)); f[5] = bf2f((bf16_t)(v.z >> 16)); f[6] = bf2f((bf16_t)(v.w & 0xffff)); f[7] = bf2f((bf16_t)(v.w >> 16));
}
DEV uint4 pack8(const float* f) { return make_uint4(pk2(f[0], f[1]), pk2(f[2], f[3]), pk2(f[4], f[5]), pk2(f[6], f[7])); }
DEV uint2 pack4(f32x4 v) { uint2 r; r.x = pk2(v[0], v[1]); r.y = pk2(v[2], v[3]); return r; }

struct GemmCtx { int wid, lane, wr, wc, fr, fq; int sR[4], sC[4]; };
DEV GemmCtx gemm_ctx() {
    GemmCtx c; const int tid = opaque_tid();
    c.wid = __builtin_amdgcn_readfirstlane(tid >> 6); c.lane = tid & 63; c.wr = c.wid >> 2; c.wc = c.wid & 3; c.fr = c.lane & 15; c.fq = c.lane >> 4;
#pragma unroll
    for (int i = 0; i < 4; ++i) stage_rc(c.wid * 1024 + i * 8192 + c.lane * 16, c.sR[i], c.sC[i]);
    return c;
}
DEV void gemm_mainloop(LAS char* shm, const GemmCtx& c, const bf16_t* A1row, const bf16_t* A2row, int ktsplit, int lda, const bf16_t* Bb, int ldb, int nt, f32x4 (&acc)[8][4]) {
    constexpr int TILE_B = 256 * 64 * 2, STAGE_B = 2 * TILE_B;
    const int wid = c.wid, wr = c.wr, wc = c.wc, fr = c.fr, fq = c.fq;
    unsigned voA[4], voB[4];
#pragma unroll
    for (int i = 0; i < 4; ++i) { voA[i] = (unsigned)(c.sR[i] * lda + c.sC[i]) * 2u; voB[i] = (unsigned)(c.sR[i] * ldb + c.sC[i]) * 2u; asm volatile("" : "+v"(voA[i]), "+v"(voB[i])); }
#define GLDS_STAGE(buf, kt) do { const char* Ak_ = (const char*)(((kt) < ktsplit) ? (A1row + (kt) * 64) : (A2row + ((kt) - ktsplit) * 64)); const char* Bk_ = (const char*)(Bb + (kt) * 64); \
        _Pragma("unroll") for (int i = 0; i < 4; ++i) { \
            __builtin_amdgcn_global_load_lds((const unsigned*)(Ak_ + voA[i]), (LAS unsigned*)(shm + (buf) * STAGE_B + wid * 1024 + i * 8192), 16, 0, 0); \
            __builtin_amdgcn_global_load_lds((const unsigned*)(Bk_ + voB[i]), (LAS unsigned*)(shm + (buf) * STAGE_B + TILE_B + wid * 1024 + i * 8192), 16, 0, 0); } } while (0)
#pragma unroll
    for (int m = 0; m < 8; ++m)
#pragma unroll
        for (int n = 0; n < 4; ++n) acc[m][n] = (f32x4){0.f, 0.f, 0.f, 0.f};
    GLDS_STAGE(0, 0); WAIT_V(0); __syncthreads();
#pragma nounroll
    for (int kt = 0; kt < nt; ++kt) {
        const int cur = kt & 1;
        if (kt + 1 < nt) GLDS_STAGE(cur ^ 1, kt + 1);
#pragma unroll
        for (int ks = 0; ks < 2; ++ks) {
            bf16x8 At[8], Bf[4];
#pragma unroll
            for (int m = 0; m < 8; ++m) At[m] = *(const LAS bf16x8*)(shm + cur * STAGE_B + lds_byte(wr * 128 + m * 16 + fr, ks * 32 + fq * 8));
#pragma unroll
            for (int n = 0; n < 4; ++n) Bf[n] = *(const LAS bf16x8*)(shm + cur * STAGE_B + TILE_B + lds_byte(wc * 64 + n * 16 + fr, ks * 32 + fq * 8));
#pragma unroll
            for (int m = 0; m < 8; ++m)
#pragma unroll
                for (int n = 0; n < 4; ++n) acc[m][n] = __builtin_amdgcn_mfma_f32_16x16x32_bf16(Bf[n], At[m], acc[m][n], 0, 0, 0);
            SCHED();
        }
        WAIT_V(0); __syncthreads();
    }
#undef GLDS_STAGE
}
DEV void tile_map(int t, int nN, int& pm, int& pn) {
    const int base = t & ~255, loc = t & 255;
    const int w = base + (loc & 7) * 32 + (loc >> 3);
    const int nig = 8 * nN, gid = w / nig;
    pm = gid * 8 + (w % nig) % 8; pn = (w % nig) / 8;
}
template <class Prob>
DEV void gemm_phase(LAS char* shm, const Prob& pb) {
    const GemmCtx c = gemm_ctx();
    const int nN = pb.nN, ntiles = 64 * nN;
    for (int t = blockIdx.x; t < ntiles; t += gridDim.x) {
        int pm, pn; tile_map(t, nN, pm, pn);
        const int brow = pm * 256, bcol = pn * 256;
        f32x4 acc[8][4];
        gemm_mainloop(shm, c, pb.a1(pn) + (long)brow * Prob::lda, pb.a2(pn) + (long)brow * Prob::lda, Prob::ktsplit, Prob::lda, pb.bptr(pn), Prob::ldb, Prob::K / 64, acc);
        pb.epi_begin(shm, c, pn, brow);
#pragma unroll
        for (int m = 0; m < 8; ++m)
#pragma unroll
            for (int n = 0; n < 4; ++n) pb.epi(pn, brow + c.wr * 128 + m * 16 + c.fr, bcol + c.wc * 64 + n * 16 + c.fq * 4, acc[m][n]);
        pb.epi_end(c, pn, brow, acc);
    }
}

struct ProbG1 {
    static constexpr int K = 1024, lda = 1024, ldb = 1024, ktsplit = 1 << 20;
    const bf16_t* H; const bf16_t* Wt; bf16_t* U; bf16_t* MI; int nN;
    DEV const bf16_t* a1(int pn) const { return H; }
    DEV const bf16_t* a2(int pn) const { return H; }
    DEV const bf16_t* bptr(int pn) const { return Wt + (long)((pn < 4) ? pn * 256 : 2048 + (pn - 4) * 256) * 1024; }
    DEV void epi_begin(LAS char*, const GemmCtx&, int, int) const {}
    DEV void epi(int pn, int row, int col, f32x4 v) const { bf16_t* C = (pn < 4) ? U : MI; *(uint2*)(C + (size_t)row * DM + (col & 1023)) = pack4(v); }
    DEV void epi_end(const GemmCtx&, int, int, f32x4 (&)[8][4]) const {}
};
struct ProbGlu {
    static constexpr int K = 1024, lda = 1024, ldb = 1024, ktsplit = 1 << 20;
    const bf16_t* Y; const bf16_t* Wt; bf16_t* Z; const float* bias; float* rowss; int nN;
    DEV const bf16_t* a1(int pn) const { return Y; }
    DEV const bf16_t* a2(int pn) const { return Y; }
    DEV const bf16_t* bptr(int pn) const { return Wt + (long)pn * 256 * 1024; }
    DEV void epi_begin(LAS char*, const GemmCtx&, int, int) const {}
    DEV void epi(int pn, int row, int col, f32x4 v) const {}
    DEV void epi_end(const GemmCtx& c0, int pn, int brow, f32x4 (&acc)[8][4]) const {
        struct { int fr, fq, wr, wc; } c = {c0.fr, c0.fq, c0.wr, c0.wc};
        asm volatile("" : "+v"(c.fr), "+v"(c.fq));
#pragma unroll
        for (int m = 0; m < 8; ++m) {
            SCHED();
            const int row = brow + c.wr * 128 + m * 16 + c.fr;
            float ss = 0.f;
#pragma unroll
            for (int n = 0; n < 4; ++n) {
                const int col = pn * 256 + c.wc * 64 + n * 16 + c.fq * 4;
                const uint2 yv = *(const uint2*)(Y + (size_t)row * DM + col);
                const float4 b = *(const float4*)(bias + col);
                f32x4 o;
                o[0] = bf2f(yv.x & 0xffff) * sigmoidf_(acc[m][n][0] + b.x); o[1] = bf2f(yv.x >> 16) * sigmoidf_(acc[m][n][1] + b.y);
                o[2] = bf2f(yv.y & 0xffff) * sigmoidf_(acc[m][n][2] + b.z); o[3] = bf2f(yv.y >> 16) * sigmoidf_(acc[m][n][3] + b.w);
                const uint2 pk = pack4(o);
                *(uint2*)(Z + (size_t)row * DM + col) = pk;
                const float r0 = bf2f(pk.x & 0xffff), r1 = bf2f(pk.x >> 16), r2 = bf2f(pk.y & 0xffff), r3 = bf2f(pk.y >> 16);
                ss += r0 * r0 + r1 * r1 + r2 * r2 + r3 * r3;
            }
            ss += __shfl_xor(ss, 16); ss += __shfl_xor(ss, 32);
            if (c.fq == 0) rowss[(size_t)(pn * 4 + c.wc) * MTOK + row] = ss;
        }
    }
};
struct ProbQkv {
    static constexpr int K = 256, lda = 1024, ldb = 256, ktsplit = 1 << 20;
    const bf16_t* XC; const bf16_t* MI; const bf16_t* Wt; bf16_t* Q; bf16_t* Kk; bf16_t* V; int nN;
    DEV const bf16_t* a1(int pn) const { return ((pn >> 2) == 2 ? MI : XC) + (pn & 3) * 256; }
    DEV const bf16_t* a2(int pn) const { return a1(pn); }
    DEV const bf16_t* bptr(int pn) const { return Wt + (long)pn * 256 * 256; }
    DEV void epi_begin(LAS char*, const GemmCtx&, int, int) const {}
    DEV void epi(int pn, int row, int col, f32x4 v) const {
        const int which = pn >> 2; bf16_t* C = sel3(which, Q, Kk, V);
        if (which == 1) { v[0] *= 0.0625f; v[1] *= 0.0625f; v[2] *= 0.0625f; v[3] *= 0.0625f; }
        *(uint2*)(C + (size_t)row * DM + (col & 1023)) = pack4(v);
    }
    DEV void epi_end(const GemmCtx&, int, int, f32x4 (&)[8][4]) const {}
};
struct ProbOut {
    static constexpr int K = 2048, lda = 1024, ldb = 2048, ktsplit = 16;
    const bf16_t* A1; const bf16_t* A2; const bf16_t* Wt; const float* xin; float* xout; const float* gate; int nN;
    DEV const bf16_t* a1(int pn) const { return A1; }
    DEV const bf16_t* a2(int pn) const { return A2; }
    DEV const bf16_t* bptr(int pn) const { return Wt + (long)pn * 256 * 2048; }
    DEV void epi_begin(LAS char*, const GemmCtx&, int, int) const {}
    DEV void epi(int pn, int row, int col, f32x4 v) const {
        const int b = row / SEQ;
        const float4 xi = *(const float4*)(xin + (size_t)row * DM + col);
        const float4 g = *(const float4*)(gate + (size_t)b * 3 * DM + col);
        float4 o; o.x = xi.x + g.x * v[0]; o.y = xi.y + g.y * v[1]; o.z = xi.z + g.z * v[2]; o.w = xi.w + g.w * v[3];
        *(float4*)(xout + (size_t)row * DM + col) = o;
    }
    DEV void epi_end(const GemmCtx&, int, int, f32x4 (&)[8][4]) const {}
};

struct G2Args {
    const bf16_t* H; const bf16_t* Wt;
    bf16_t* Z; const float* rowss; const float* og;
    bf16_t* HC; const bf16_t* XC; const float* ngain; const float* skip;
};
DEV void gemm2_phase(LAS char* shm, const G2Args& g) {
    const GemmCtx c = gemm_ctx();
    int efr, efq;
    LAS float* rst = (LAS float*)(shm + 131072);
    LAS float* red = (LAS float*)(shm + 131072 + 1024);
    for (int u = blockIdx.x; u < 512; u += gridDim.x) {
        f32x4 acc[8][4];
        if (u < 256) {
            int pm, pn; tile_map(u, 4, pm, pn);
            const int brow = pm * 256, bcol = pn * 256;
            gemm_mainloop(shm, c, g.H + (long)brow * DM, g.H, 1 << 20, DM, g.Wt + (long)(1024 + bcol) * DM, DM, 16, acc);
            efr = c.fr; efq = c.fq; asm volatile("" : "+v"(efr), "+v"(efq));
            { const int tid = c.wid * 64 + c.lane;
              if (tid < 256) { float s_ = 0.f;
#pragma unroll
                  for (int p_ = 0; p_ < 16; ++p_) s_ += g.rowss[(size_t)p_ * MTOK + brow + tid];
                  rst[tid] = rsqrtf(s_ * (1.f / DM) + EPS); } }
            __syncthreads();
#pragma unroll
            for (int m = 0; m < 8; ++m) {
                SCHED();
                const int rl = c.wr * 128 + m * 16 + efr, row = brow + rl;
                const float rs = rst[rl];
#pragma unroll
                for (int n = 0; n < 4; ++n) {
                    const int col = bcol + c.wc * 64 + n * 16 + efq * 4;
                    const uint2 zv = *(const uint2*)(g.Z + (size_t)row * DM + col);
                    const float4 gn = *(const float4*)(g.og + col);
                    f32x4 o;
                    o[0] = bf2f(zv.x & 0xffff) * rs * gn.x * siluf_(acc[m][n][0]); o[1] = bf2f(zv.x >> 16) * rs * gn.y * siluf_(acc[m][n][1]);
                    o[2] = bf2f(zv.y & 0xffff) * rs * gn.z * siluf_(acc[m][n][2]); o[3] = bf2f(zv.y >> 16) * rs * gn.w * siluf_(acc[m][n][3]);
                    *(uint2*)(g.Z + (size_t)row * DM + col) = pack4(o);
                }
            }
            __syncthreads();
        } else {
            int pm, hd; tile_map(u - 256, 4, pm, hd);
            const int brow = pm * 256, bcol = hd * 256;
            gemm_mainloop(shm, c, g.H + (long)brow * DM, g.H, 1 << 20, DM, g.Wt + (long)(3072 + bcol) * DM, DM, 16, acc);
            efr = c.fr; efq = c.fq; asm volatile("" : "+v"(efr), "+v"(efq));
        #pragma unroll
            for (int m = 0; m < 8; ++m) {
                SCHED();
                const int row = brow + c.wr * 128 + m * 16 + efr;
                float s_ = 0.f;
#pragma unroll
                for (int n = 0; n < 4; ++n) {
                    const int col = bcol + c.wc * 64 + n * 16 + efq * 4;
                    const uint2 hv = *(const uint2*)(g.HC + (size_t)row * DM + col);
                    acc[m][n][0] = bf2f(hv.x & 0xffff) * sigmoidf_(acc[m][n][0]); acc[m][n][1] = bf2f(hv.x >> 16) * sigmoidf_(acc[m][n][1]);
                    acc[m][n][2] = bf2f(hv.y & 0xffff) * sigmoidf_(acc[m][n][2]); acc[m][n][3] = bf2f(hv.y >> 16) * sigmoidf_(acc[m][n][3]);
                    s_ += (acc[m][n][0] + acc[m][n][1]) + (acc[m][n][2] + acc[m][n][3]);
                }
                s_ += __shfl_xor(s_, 16); s_ += __shfl_xor(s_, 32);
                if (efq == 0) red[c.wid * 128 + m * 16 + efr] = s_;
            }
            __syncthreads();
#pragma unroll
            for (int m = 0; m < 8; ++m) {
                SCHED();
                float tot = 0.f;
#pragma unroll
                for (int w2 = 0; w2 < 4; ++w2) tot += red[(c.wr * 4 + w2) * 128 + m * 16 + efr];
                const float mu = tot * (1.f / DH);
                float s_ = 0.f;
#pragma unroll
                for (int n = 0; n < 4; ++n)
#pragma unroll
                    for (int j = 0; j < 4; ++j) { acc[m][n][j] -= mu; s_ += acc[m][n][j] * acc[m][n][j]; }
                s_ += __shfl_xor(s_, 16); s_ += __shfl_xor(s_, 32);
                if (efq == 0) red[1024 + c.wid * 128 + m * 16 + efr] = s_;
            }
            __syncthreads();
#pragma unroll
            for (int m = 0; m < 8; ++m) {
                SCHED();
                const int row = brow + c.wr * 128 + m * 16 + efr;
                float tot = 0.f;
#pragma unroll
                for (int w2 = 0; w2 < 4; ++w2) tot += red[1024 + (c.wr * 4 + w2) * 128 + m * 16 + efr];
                const float rs = rsqrtf(tot * (1.f / DH) + EPS);
#pragma unroll
                for (int n = 0; n < 4; ++n) {
                    const int col = bcol + c.wc * 64 + n * 16 + efq * 4;
                    const uint2 xv = *(const uint2*)(g.XC + (size_t)row * DM + col);
                    const float4 gn = *(const float4*)(g.ngain + col), sk = *(const float4*)(g.skip + col);
                    f32x4 o;
                    o[0] = acc[m][n][0] * rs * gn.x + sk.x * bf2f(xv.x & 0xffff); o[1] = acc[m][n][1] * rs * gn.y + sk.y * bf2f(xv.x >> 16);
                    o[2] = acc[m][n][2] * rs * gn.z + sk.z * bf2f(xv.y & 0xffff); o[3] = acc[m][n][3] * rs * gn.w + sk.w * bf2f(xv.y >> 16);
                    *(uint2*)(g.HC + (size_t)row * DM + col) = pack4(o);
                }
            }
            gemm_mainloop(shm, c, g.H + (long)brow * DM, g.H, 1 << 20, DM, g.Wt + (long)(4096 + bcol) * DM, DM, 16, acc);
            efr = c.fr; efq = c.fq; asm volatile("" : "+v"(efr), "+v"(efq));
#pragma unroll
            for (int m = 0; m < 8; ++m) {
                SCHED();
                const int row = brow + c.wr * 128 + m * 16 + efr;
#pragma unroll
                for (int n = 0; n < 4; ++n) {
                    const int col = bcol + c.wc * 64 + n * 16 + efq * 4;
                    const uint2 hv = *(const uint2*)(g.HC + (size_t)row * DM + col);
                    f32x4 o;
                    o[0] = bf2f(hv.x & 0xffff) * siluf_(acc[m][n][0]); o[1] = bf2f(hv.x >> 16) * siluf_(acc[m][n][1]);
                    o[2] = bf2f(hv.y & 0xffff) * siluf_(acc[m][n][2]); o[3] = bf2f(hv.y >> 16) * siluf_(acc[m][n][3]);
                    *(uint2*)(g.HC + (size_t)row * DM + col) = pack4(o);
                }
            }
        }
    }
}


namespace g8 {
constexpr int BK = 64, HALFT = 128, HTB = HALFT * BK * 2;
#define G8_A_ROWMAJOR static constexpr size_t kstepA = 128, hstepA = (size_t)128 * lda * 2; static DEV unsigned aoff(int R, int C) { return (unsigned)(R * lda + C) * 2u; }
DEV int perm32(int rho) { const int n = rho >> 4, i = rho & 15; return 8 * (i >> 2) + 4 * n + (i & 3); }
struct Unit { const char* A; const char* B; int pm, pn, tag; };
template <class Epi, class Sched>
DEV void gemm_phase(LAS char* lds, const Sched& S, const Epi& E) {
    const int tid = opaque_tid(), wid = __builtin_amdgcn_readfirstlane(tid >> 6), lane = tid & 63, wr = wid >> 2, wc = wid & 3, fr = lane & 15, fq = lane >> 4;
    constexpr int lda = Sched::lda, ldb = Sched::ldb, nt = Sched::K / BK;
    unsigned voffA[2], voffB[2];
#pragma unroll
    for (int i = 0; i < 2; ++i) { int R, C; stage_rc(tid * 16 + i * 8192, R, C); const int Rb = (R & ~31) + perm32(R & 31);
        voffA[i] = Sched::aoff(R, C); voffB[i] = (unsigned)(Rb * ldb + C) * 2u; asm volatile("" : "+v"(voffA[i]), "+v"(voffB[i])); }
    constexpr size_t kstep = (size_t)(BK * 2), kstepA = Sched::kstepA, hstepA = Sched::hstepA, hstepB = (size_t)HALFT * ldb * 2;
    const unsigned ldsw = (unsigned)wid * 1024u;
    const int aoff = lds_byte(wr * 64 + fr, fq * 8), boff = lds_byte(wc * 32 + fr, fq * 8);
#define G8_SA(b, h) (((b) * 2 + (h)) * HTB)
#define G8_SB(b, h) ((4 + (b) * 2 + (h)) * HTB)
#define G8_STAGE(bufoff, gbase, voff) do { _Pragma("unroll") for (int _i = 0; _i < 2; ++_i) \
        __builtin_amdgcn_global_load_lds((const unsigned*)((const char*)(gbase) + (voff)[_i]), (LAS unsigned*)(lds + (bufoff) + ldsw + _i * 8192), 16, 0, 0); } while (0)
#define G8_LDA(dst, b, h) do { _Pragma("unroll") for (int m = 0; m < 4; ++m) _Pragma("unroll") for (int k = 0; k < 2; ++k) dst[m][k] = *(const LAS bf16x8*)(lds + G8_SA(b, h) + aoff + m * 2048 + k * 1024); } while (0)
#define G8_LDB(dst, b, h) do { _Pragma("unroll") for (int n = 0; n < 2; ++n) _Pragma("unroll") for (int k = 0; k < 2; ++k) dst[n][k] = *(const LAS bf16x8*)(lds + G8_SB(b, h) + boff + n * 2048 + k * 1024); } while (0)
#define G8_MMA(ai, bj, At, Bt) do { __builtin_amdgcn_s_setprio(1); _Pragma("unroll") for (int m = 0; m < 4; ++m) _Pragma("unroll") for (int n = 0; n < 2; ++n) _Pragma("unroll") for (int k = 0; k < 2; ++k) \
        acc[ai][bj][m][n] = __builtin_amdgcn_mfma_f32_16x16x32_bf16(Bt[n][k], At[m][k], acc[ai][bj][m][n], 0, 0, 0); __builtin_amdgcn_s_setprio(0); } while (0)
#define G8_WAIT_V(n) asm volatile("s_waitcnt vmcnt(" #n ")" ::: "memory")
#define G8_WAIT_L(n) asm volatile("s_waitcnt lgkmcnt(" #n ")" ::: "memory")
#define G8_BAR __builtin_amdgcn_s_barrier()
#define G8_SCHED __builtin_amdgcn_sched_barrier(0)
    Unit cur, nxt; int ui = 0;
    if (!S.next(0, cur)) return;
    f32x4 acc[2][2][4][2];
#pragma unroll
    for (int a = 0; a < 2; ++a)
#pragma unroll
        for (int b = 0; b < 2; ++b)
#pragma unroll
            for (int m = 0; m < 4; ++m)
#pragma unroll
                for (int n = 0; n < 2; ++n) acc[a][b][m][n] = (f32x4){0.f, 0.f, 0.f, 0.f};
    bf16x8 At[4][2], B0[2][2], B1[2][2];
    const char* cA = cur.A; const char* cB = cur.B;
    G8_STAGE(G8_SB(0, 0), cB, voffB); G8_STAGE(G8_SB(0, 1), cB + hstepB, voffB); G8_STAGE(G8_SA(0, 0), cA, voffA); G8_STAGE(G8_SA(0, 1), cA + hstepA, voffA);
    if (wr == 1) G8_BAR;
    G8_WAIT_V(2); G8_BAR;
    G8_STAGE(G8_SB(1, 0), cB + kstep, voffB); G8_STAGE(G8_SA(1, 0), cA + kstepA, voffA); G8_STAGE(G8_SB(1, 1), cB + hstepB + kstep, voffB);
    G8_WAIT_V(6); G8_BAR;
    for (;;) {
        const bool has_next = S.next(ui + 1, nxt);
        const char* nA = has_next ? nxt.A : cA; const char* nB = has_next ? nxt.B : cB;
#pragma nounroll
        for (int t = 0; t < nt; t += 2) {
            const bool last = (t == nt - 2);
            const char* a1 = cA + (size_t)(t + 1) * kstepA;
            const char* a2 = last ? nA : cA + (size_t)(t + 2) * kstepA; const char* b2 = last ? nB : cB + (size_t)(t + 2) * kstep;
            const char* a3 = a2 + kstepA; const char* b3 = b2 + kstep;
            G8_LDB(B0, 0, 0); G8_LDB(B1, 0, 1); G8_SCHED; G8_LDA(At, 0, 0); G8_STAGE(G8_SA(1, 1), a1 + hstepA, voffA);
            G8_WAIT_V(8); G8_WAIT_L(0); G8_BAR; G8_MMA(0, 0, At, B0); G8_MMA(0, 1, At, B1); G8_BAR; G8_SCHED;
            G8_LDA(At, 0, 1); G8_STAGE(G8_SB(0, 0), b2, voffB); G8_STAGE(G8_SB(0, 1), b2 + hstepB, voffB); G8_STAGE(G8_SA(0, 0), a2, voffA);
            G8_WAIT_V(8); G8_WAIT_L(0); G8_BAR; G8_MMA(1, 0, At, B0); G8_MMA(1, 1, At, B1); G8_BAR; G8_SCHED;
            G8_LDB(B0, 1, 0); G8_LDB(B1, 1, 1); G8_SCHED; G8_LDA(At, 1, 0); G8_STAGE(G8_SA(0, 1), a2 + hstepA, voffA);
            G8_WAIT_V(8); G8_WAIT_L(0); G8_BAR; G8_MMA(0, 0, At, B0); G8_MMA(0, 1, At, B1); G8_BAR; G8_SCHED;
            G8_LDA(At, 1, 1); G8_STAGE(G8_SB(1, 0), b3, voffB); G8_STAGE(G8_SB(1, 1), b3 + hstepB, voffB); G8_STAGE(G8_SA(1, 0), a3, voffA);
            G8_WAIT_V(8); G8_WAIT_L(0); G8_BAR; G8_MMA(1, 0, At, B0); G8_MMA(1, 1, At, B1); G8_BAR; G8_SCHED;
        }
        if (wr == 0) G8_BAR;
        E(lds, acc, cur, wr, wc, fr, fq, wid, lane);
        if (!has_next) break;
#pragma unroll
        for (int a = 0; a < 2; ++a)
#pragma unroll
            for (int b = 0; b < 2; ++b)
#pragma unroll
                for (int m = 0; m < 4; ++m)
#pragma unroll
                    for (int n = 0; n < 2; ++n) acc[a][b][m][n] = (f32x4){0.f, 0.f, 0.f, 0.f};
        cur = nxt; cA = nA; cB = nB; ++ui;
        if (wr == 1) G8_BAR;
    }
    G8_WAIT_V(0);
    G8_BAR;
#undef G8_SA
#undef G8_SB
#undef G8_STAGE
#undef G8_LDA
#undef G8_LDB
#undef G8_MMA
#undef G8_WAIT_V
#undef G8_WAIT_L
#undef G8_BAR
#undef G8_SCHED
}
DEV u32x4 pk8(const f32x4 a, const f32x4 b) { return (u32x4){pk2(a[0], a[1]), pk2(a[2], a[3]), pk2(b[0], b[1]), pk2(b[2], b[3])}; }
DEV void un8(const u32x4 v, float* f) { unpack8(make_uint4(v[0], v[1], v[2], v[3]), f); }
#define G8_ROWS_BEGIN _Pragma("unroll") for (int ai = 0; ai < 2; ++ai) _Pragma("unroll") for (int m = 0; m < 4; ++m) { const int rl = 128 * ai + 64 * wr + 16 * m + fr;
#define G8_ROWS_END }

struct SchedG1 { static constexpr int K = 1024, lda = 1024, ldb = 1024; G8_A_ROWMAJOR const bf16_t* H; const bf16_t* Wt; int bid, G;
    DEV bool next(int i, Unit& u) const { const int t = bid + i * G; if (t >= 512) return false; int pm, pn; tile_map(t, 8, pm, pn);
        u.pm = pm; u.pn = pn; u.tag = 0; u.A = (const char*)(H + (size_t)pm * 256 * DM); u.B = (const char*)(Wt + (size_t)((pn < 4) ? pn * 256 : 2048 + (pn - 4) * 256) * DM); return true; } };
struct EpiG1 { bf16_t* U; bf16_t* MI;
    DEV void operator()(LAS char*, const f32x4 (&acc)[2][2][4][2], const Unit& u, int wr, int wc, int fr, int fq, int, int) const {
        const int c0 = (u.pn & 3) * 256 + 32 * wc + 8 * fq;
        if (u.pn < 4) {
            G8_ROWS_BEGIN const int row = u.pm * 256 + rl;
#pragma unroll
                for (int bj = 0; bj < 2; ++bj) { const int cc = c0 + 128 * bj; *(u32x4*)(U + (size_t)(cc >> 4) * MTOK * 16 + (size_t)row * 16 + (cc & 15)) = pk8(acc[ai][bj][m][0], acc[ai][bj][m][1]); } G8_ROWS_END
        } else {
            G8_ROWS_BEGIN bf16_t* rp = MI + (size_t)(u.pm * 256 + rl) * DM + c0;
#pragma unroll
                for (int bj = 0; bj < 2; ++bj) *(u32x4*)(rp + 128 * bj) = pk8(acc[ai][bj][m][0], acc[ai][bj][m][1]); G8_ROWS_END
        } } };
struct SchedGlu { static constexpr int K = 1024, lda = 1024, ldb = 1024; static constexpr size_t kstepA = (size_t)4 * MTOK * 32, hstepA = (size_t)128 * 32; static DEV unsigned aoff(int R, int C) { return (unsigned)((C >> 4) * (MTOK * 32) + R * 32 + (C & 15) * 2); } const bf16_t* Y; const bf16_t* Wt; int bid, G;
    DEV bool next(int i, Unit& u) const { const int t = bid + i * G; if (t >= 256) return false; int pm, pn; tile_map(t, 4, pm, pn);
        u.pm = pm; u.pn = pn; u.tag = 0; u.A = (const char*)(Y + (size_t)pm * 256 * 16); u.B = (const char*)(Wt + (size_t)pn * 256 * DM); return true; } };
struct EpiGlu { const bf16_t* Y; bf16_t* Z; const float* bias; float* rowss;
    DEV void operator()(LAS char*, const f32x4 (&acc)[2][2][4][2], const Unit& u, int wr, int wc, int fr, int fq, int, int) const {
        const int c0 = u.pn * 256 + 32 * wc + 8 * fq;
        G8_ROWS_BEGIN const size_t ro = (size_t)(u.pm * 256 + rl) * DM + c0; float ss = 0.f;
#pragma unroll
            for (int bj = 0; bj < 2; ++bj) {
                float y8[8]; { const int cc = c0 + 128 * bj; un8(*(const u32x4*)(Y + (size_t)(cc >> 4) * MTOK * 16 + (size_t)(u.pm * 256 + rl) * 16 + (cc & 15)), y8); }
                const float4 b0 = *(const float4*)(bias + c0 + 128 * bj), b1 = *(const float4*)(bias + c0 + 128 * bj + 4);
                f32x4 o0, o1;
                o0[0] = y8[0] * sigmoidf_(acc[ai][bj][m][0][0] + b0.x); o0[1] = y8[1] * sigmoidf_(acc[ai][bj][m][0][1] + b0.y); o0[2] = y8[2] * sigmoidf_(acc[ai][bj][m][0][2] + b0.z); o0[3] = y8[3] * sigmoidf_(acc[ai][bj][m][0][3] + b0.w);
                o1[0] = y8[4] * sigmoidf_(acc[ai][bj][m][1][0] + b1.x); o1[1] = y8[5] * sigmoidf_(acc[ai][bj][m][1][1] + b1.y); o1[2] = y8[6] * sigmoidf_(acc[ai][bj][m][1][2] + b1.z); o1[3] = y8[7] * sigmoidf_(acc[ai][bj][m][1][3] + b1.w);
                const u32x4 pk = pk8(o0, o1); *(u32x4*)(Z + ro + 128 * bj) = pk;
                float r8[8]; un8(pk, r8);
#pragma unroll
                for (int e = 0; e < 8; ++e) ss += r8[e] * r8[e];
            }
            ss += __shfl_xor(ss, 16); ss += __shfl_xor(ss, 32);
            if (fq == 0) rowss[(size_t)(u.pn * 4 + wc) * MTOK + u.pm * 256 + rl] = ss; G8_ROWS_END } };
struct SchedQkv { static constexpr int K = 256, lda = 1024, ldb = 256; G8_A_ROWMAJOR const bf16_t* XC; const bf16_t* MI; const bf16_t* Wt; int bid, G;
    DEV bool next(int i, Unit& u) const { const int t = bid + i * G; if (t >= 768) return false; int pm, pn; tile_map(t, 12, pm, pn);
        u.pm = pm; u.pn = pn; u.tag = 0; u.A = (const char*)(((pn >> 2) == 2 ? MI : XC) + (size_t)pm * 256 * DM + (pn & 3) * 256); u.B = (const char*)(Wt + (size_t)pn * 256 * 256); return true; } };
struct EpiQkv { bf16_t* Q; bf16_t* Kk; bf16_t* V;
    DEV void operator()(LAS char*, const f32x4 (&acc)[2][2][4][2], const Unit& u, int wr, int wc, int fr, int fq, int, int) const {
        const int which = u.pn >> 2; bf16_t* C = sel3(which, Q, Kk, V); const float sc = (which == 1) ? 0.0625f : 1.f;
        const int c0 = (u.pn & 3) * 256 + 32 * wc + 8 * fq;
        G8_ROWS_BEGIN bf16_t* rp = C + (size_t)(u.pm * 256 + rl) * DM + c0;
#pragma unroll
            for (int bj = 0; bj < 2; ++bj) *(u32x4*)(rp + 128 * bj) = pk8(acc[ai][bj][m][0] * sc, acc[ai][bj][m][1] * sc); G8_ROWS_END } };
struct SchedOut { static constexpr int K = 2048, lda = 2048, ldb = 2048; G8_A_ROWMAJOR const bf16_t* MX; const bf16_t* Wt; int bid, G;
    DEV bool next(int i, Unit& u) const { const int t = bid + i * G; if (t >= 256) return false; int pm, pn; tile_map(t, 4, pm, pn);
        u.pm = pm; u.pn = pn; u.tag = 0; u.A = (const char*)(MX + (size_t)pm * 256 * 2048); u.B = (const char*)(Wt + (size_t)pn * 256 * 2048); return true; } };
template <bool FINAL>
struct EpiOutN { const float* xin; float* xout; const float* gate; const float* ngain; const float* modn; bf16_t* Hn; float* xss; unsigned* cnt; unsigned* tmo;
    DEV void operator()(LAS char* lds, f32x4 (&acc)[2][2][4][2], const Unit& u, int wr, int wc, int fr, int fq, int wid, int lane) const {
        asm volatile("" : "+v"(fr), "+v"(fq));
        LAS float* red = (LAS float*)(lds + 131072);
        LAS float* rst = (LAS float*)(lds + 131072 + 4096);
        const int c0 = u.pn * 256 + 32 * wc + 8 * fq, bidx = (u.pm * 256) / SEQ; const float* gp = gate + (size_t)bidx * 3 * DM + c0;
        G8_ROWS_BEGIN const size_t ro = (size_t)(u.pm * 256 + rl) * DM + c0; float ss = 0.f;
#pragma unroll
            for (int bj = 0; bj < 2; ++bj)
#pragma unroll
                for (int n = 0; n < 2; ++n) {
                    const float4 xi = *(const float4*)(xin + ro + 128 * bj + 4 * n), g4 = *(const float4*)(gp + 128 * bj + 4 * n);
                    f32x4 o; o[0] = xi.x + g4.x * acc[ai][bj][m][n][0]; o[1] = xi.y + g4.y * acc[ai][bj][m][n][1]; o[2] = xi.z + g4.z * acc[ai][bj][m][n][2]; o[3] = xi.w + g4.w * acc[ai][bj][m][n][3];
                    acc[ai][bj][m][n] = o; ss += (o[0] * o[0] + o[1] * o[1]) + (o[2] * o[2] + o[3] * o[3]);
                    if (!FINAL) *(float4*)(xout + ro + 128 * bj + 4 * n) = make_float4(o[0], o[1], o[2], o[3]); }
            ss += __shfl_xor(ss, 16); ss += __shfl_xor(ss, 32);
            if (fq == 0) red[wid * 128 + 64 * ai + 16 * m + fr] = ss; G8_ROWS_END
        asm volatile("s_waitcnt lgkmcnt(0)" ::: "memory"); __builtin_amdgcn_s_barrier();
        const int tid = wid * 64 + lane;
        if (tid < 256) {
            const int r_ = tid, w0 = (r_ >> 6) & 1, ix = (r_ & 63) + 64 * (r_ >> 7);
            const float t_ = red[(w0 * 4 + 0) * 128 + ix] + red[(w0 * 4 + 1) * 128 + ix] + red[(w0 * 4 + 2) * 128 + ix] + red[(w0 * 4 + 3) * 128 + ix];
            __hip_atomic_store(xss + ((size_t)(u.pm * 256 + r_) * 4 + u.pn), t_, __ATOMIC_RELAXED, __HIP_MEMORY_SCOPE_AGENT);
        }
        asm volatile("s_waitcnt vmcnt(0)" ::: "memory"); __builtin_amdgcn_s_barrier();
        if (tid == 0) {
            __hip_atomic_fetch_add(cnt + 64 * u.pm, 1u, __ATOMIC_RELAXED, __HIP_MEMORY_SCOPE_AGENT);
            unsigned sp_ = 0;
            while (__hip_atomic_load(cnt + 64 * u.pm, __ATOMIC_RELAXED, __HIP_MEMORY_SCOPE_AGENT) < 4u) { __builtin_amdgcn_s_sleep(1); if (++sp_ > (1u << 22)) { atomicAdd(tmo, 1u); break; } }
        }
        __builtin_amdgcn_s_barrier();
        if (tid < 256) {
            const float* xp = xss + (size_t)(u.pm * 256 + tid) * 4;
            const float t_ = __hip_atomic_load(xp, __ATOMIC_RELAXED, __HIP_MEMORY_SCOPE_AGENT) + __hip_atomic_load(xp + 1, __ATOMIC_RELAXED, __HIP_MEMORY_SCOPE_AGENT)
                           + __hip_atomic_load(xp + 2, __ATOMIC_RELAXED, __HIP_MEMORY_SCOPE_AGENT) + __hip_atomic_load(xp + 3, __ATOMIC_RELAXED, __HIP_MEMORY_SCOPE_AGENT);
            rst[tid] = rsqrtf(t_ * (1.f / DM) + EPS);
        }
        asm volatile("s_waitcnt vmcnt(0) lgkmcnt(0)" ::: "memory"); __builtin_amdgcn_s_barrier();
        const float* shp = modn + (size_t)bidx * 3 * DM + c0;
        G8_ROWS_BEGIN const size_t ro = (size_t)(u.pm * 256 + rl) * DM + c0; const float rs = rst[rl];
#pragma unroll
            for (int bj = 0; bj < 2; ++bj) {
                const float4 g0 = *(const float4*)(ngain + c0 + 128 * bj), g1 = *(const float4*)(ngain + c0 + 128 * bj + 4);
                if (FINAL) {
                    *(float4*)(xout + ro + 128 * bj) = make_float4(acc[ai][bj][m][0][0] * rs * g0.x, acc[ai][bj][m][0][1] * rs * g0.y, acc[ai][bj][m][0][2] * rs * g0.z, acc[ai][bj][m][0][3] * rs * g0.w);
                    *(float4*)(xout + ro + 128 * bj + 4) = make_float4(acc[ai][bj][m][1][0] * rs * g1.x, acc[ai][bj][m][1][1] * rs * g1.y, acc[ai][bj][m][1][2] * rs * g1.z, acc[ai][bj][m][1][3] * rs * g1.w);
                } else {
                    const float4 h0 = *(const float4*)(shp + 128 * bj), h1 = *(const float4*)(shp + 128 * bj + 4), s0 = *(const float4*)(shp + DM + 128 * bj), s1 = *(const float4*)(shp + DM + 128 * bj + 4);
                    f32x4 o0, o1;
                    o0[0] = acc[ai][bj][m][0][0] * rs * g0.x * (1.f + s0.x) + h0.x; o0[1] = acc[ai][bj][m][0][1] * rs * g0.y * (1.f + s0.y) + h0.y; o0[2] = acc[ai][bj][m][0][2] * rs * g0.z * (1.f + s0.z) + h0.z; o0[3] = acc[ai][bj][m][0][3] * rs * g0.w * (1.f + s0.w) + h0.w;
                    o1[0] = acc[ai][bj][m][1][0] * rs * g1.x * (1.f + s1.x) + h1.x; o1[1] = acc[ai][bj][m][1][1] * rs * g1.y * (1.f + s1.y) + h1.y; o1[2] = acc[ai][bj][m][1][2] * rs * g1.z * (1.f + s1.z) + h1.z; o1[3] = acc[ai][bj][m][1][3] * rs * g1.w * (1.f + s1.w) + h1.w;
                    *(u32x4*)(Hn + ro + 128 * bj) = pk8(o0, o1);
                } } G8_ROWS_END
    } };
struct SchedG2s { static constexpr int K = 1024, lda = 1024, ldb = 1024; G8_A_ROWMAJOR const bf16_t* H; const bf16_t* Wt; int bid;
    DEV bool next(int i, Unit& u) const { if (i >= 1) return false; int pm, pn; tile_map(bid, 4, pm, pn);
        u.pm = pm; u.pn = pn; u.tag = 0; u.A = (const char*)(H + (size_t)pm * 256 * DM); u.B = (const char*)(Wt + (size_t)(1024 + pn * 256) * DM); return true; } };
struct SchedG2m { static constexpr int K = 1024, lda = 1024, ldb = 1024; G8_A_ROWMAJOR const bf16_t* H; const bf16_t* Wt; int bid;
    DEV bool next(int i, Unit& u) const { if (i >= 2) return false; int pm, pn; tile_map(bid, 4, pm, pn);
        u.pm = pm; u.pn = pn; u.tag = i + 1; u.A = (const char*)(H + (size_t)pm * 256 * DM); u.B = (const char*)(Wt + (size_t)((i == 0 ? 3072 : 4096) + pn * 256) * DM); return true; } };
struct EpiG2s { const bf16_t* Z; const float* rstd; const float* og; bf16_t* MX;
    DEV void operator()(LAS char* lds, f32x4 (&acc)[2][2][4][2], const Unit& u, int wr, int wc, int fr, int fq, int wid, int lane) const {
        asm volatile("" : "+v"(fr), "+v"(fq));
        const int c0 = u.pn * 256 + 32 * wc + 8 * fq;
        {
            G8_ROWS_BEGIN const int row = u.pm * 256 + rl; const float rs = rstd[row];
#pragma unroll
                for (int bj = 0; bj < 2; ++bj) {
                    float z8[8]; un8(*(const u32x4*)(Z + (size_t)row * DM + c0 + 128 * bj), z8);
                    const float4 g0 = *(const float4*)(og + c0 + 128 * bj), g1 = *(const float4*)(og + c0 + 128 * bj + 4);
                    f32x4 o0, o1;
                    o0[0] = z8[0] * rs * g0.x * siluf_(acc[ai][bj][m][0][0]); o0[1] = z8[1] * rs * g0.y * siluf_(acc[ai][bj][m][0][1]); o0[2] = z8[2] * rs * g0.z * siluf_(acc[ai][bj][m][0][2]); o0[3] = z8[3] * rs * g0.w * siluf_(acc[ai][bj][m][0][3]);
                    o1[0] = z8[4] * rs * g1.x * siluf_(acc[ai][bj][m][1][0]); o1[1] = z8[5] * rs * g1.y * siluf_(acc[ai][bj][m][1][1]); o1[2] = z8[6] * rs * g1.z * siluf_(acc[ai][bj][m][1][2]); o1[3] = z8[7] * rs * g1.w * siluf_(acc[ai][bj][m][1][3]);
                    *(u32x4*)(MX + (size_t)row * 2048 + c0 + 128 * bj) = pk8(o0, o1); } G8_ROWS_END
        }
    } };
struct EpiG2m { const bf16_t* HC; const bf16_t* XC; const float* ngain; const float* skip; bf16_t* MX;
    DEV void operator()(LAS char* lds, f32x4 (&acc)[2][2][4][2], const Unit& u, int wr, int wc, int fr, int fq, int wid, int lane) const {
        asm volatile("" : "+v"(fr), "+v"(fq));
        const int c0 = u.pn * 256 + 32 * wc + 8 * fq;
        if (u.tag == 1) {
            LAS float* red = (LAS float*)(lds + 131072);
            G8_ROWS_BEGIN const int row = u.pm * 256 + rl; float s1 = 0.f, s2 = 0.f;
#pragma unroll
                for (int bj = 0; bj < 2; ++bj) {
                    float h8[8]; un8(*(const u32x4*)(HC + (size_t)row * DM + c0 + 128 * bj), h8);
#pragma unroll
                    for (int n = 0; n < 2; ++n)
#pragma unroll
                        for (int j = 0; j < 4; ++j) { const float v = h8[4 * n + j] * sigmoidf_(acc[ai][bj][m][n][j]); acc[ai][bj][m][n][j] = v; s1 += v; s2 += v * v; }
                }
                s1 += __shfl_xor(s1, 16); s1 += __shfl_xor(s1, 32); s2 += __shfl_xor(s2, 16); s2 += __shfl_xor(s2, 32);
                if (fq == 0) *(LAS f32x2*)(red + ((wid * 128) + 64 * ai + 16 * m + fr) * 2) = (f32x2){s1, s2}; G8_ROWS_END
            asm volatile("s_waitcnt lgkmcnt(0)" ::: "memory"); __builtin_amdgcn_s_barrier();
            G8_ROWS_BEGIN const int row = u.pm * 256 + rl; float t1 = 0.f, t2 = 0.f;
#pragma unroll
                for (int w2 = 0; w2 < 4; ++w2) { const f32x2 p_ = *(const LAS f32x2*)(red + (((wr * 4 + w2) * 128) + 64 * ai + 16 * m + fr) * 2); t1 += p_.x; t2 += p_.y; }
                const float mu = t1 * (1.f / DH), rs = rsqrtf(fmaxf(t2 * (1.f / DH) - mu * mu, 0.f) + EPS);
#pragma unroll
                for (int bj = 0; bj < 2; ++bj) {
                    float x8[8]; un8(*(const u32x4*)(XC + (size_t)row * DM + c0 + 128 * bj), x8);
                    const float4 g0 = *(const float4*)(ngain + c0 + 128 * bj), g1 = *(const float4*)(ngain + c0 + 128 * bj + 4), k0 = *(const float4*)(skip + c0 + 128 * bj), k1 = *(const float4*)(skip + c0 + 128 * bj + 4);
                    f32x4 o0, o1;
                    o0[0] = (acc[ai][bj][m][0][0] - mu) * rs * g0.x + k0.x * x8[0]; o0[1] = (acc[ai][bj][m][0][1] - mu) * rs * g0.y + k0.y * x8[1]; o0[2] = (acc[ai][bj][m][0][2] - mu) * rs * g0.z + k0.z * x8[2]; o0[3] = (acc[ai][bj][m][0][3] - mu) * rs * g0.w + k0.w * x8[3];
                    o1[0] = (acc[ai][bj][m][1][0] - mu) * rs * g1.x + k1.x * x8[4]; o1[1] = (acc[ai][bj][m][1][1] - mu) * rs * g1.y + k1.y * x8[5]; o1[2] = (acc[ai][bj][m][1][2] - mu) * rs * g1.z + k1.z * x8[6]; o1[3] = (acc[ai][bj][m][1][3] - mu) * rs * g1.w + k1.w * x8[7];
                    *(u32x4*)(MX + (size_t)row * 2048 + 1024 + c0 + 128 * bj) = pk8(o0, o1); } G8_ROWS_END
        } else {
            G8_ROWS_BEGIN const int row = u.pm * 256 + rl;
#pragma unroll
                for (int bj = 0; bj < 2; ++bj) {
                    bf16_t* pp = MX + (size_t)row * 2048 + 1024 + c0 + 128 * bj;
                    float h8[8]; un8(*(const u32x4*)pp, h8);
                    f32x4 o0, o1;
                    o0[0] = h8[0] * siluf_(acc[ai][bj][m][0][0]); o0[1] = h8[1] * siluf_(acc[ai][bj][m][0][1]); o0[2] = h8[2] * siluf_(acc[ai][bj][m][0][2]); o0[3] = h8[3] * siluf_(acc[ai][bj][m][0][3]);
                    o1[0] = h8[4] * siluf_(acc[ai][bj][m][1][0]); o1[1] = h8[5] * siluf_(acc[ai][bj][m][1][1]); o1[2] = h8[6] * siluf_(acc[ai][bj][m][1][2]); o1[3] = h8[7] * siluf_(acc[ai][bj][m][1][3]);
                    *(u32x4*)pp = pk8(o0, o1); } G8_ROWS_END
        }
    } };
}
DEV void rstd_rows(const float* rowss, float* rstd) {
    const int tid = opaque_tid();
    for (int r = blockIdx.x * 512 + tid; r < MTOK; r += gridDim.x * 512) { float s_ = 0.f;
#pragma unroll
        for (int p_ = 0; p_ < 16; ++p_) s_ += rowss[(size_t)p_ * MTOK + r];
        rstd[r] = rsqrtf(s_ * (1.f / DM) + EPS); }
}

DEV void transpose_item(const float* W, int ldw, int ncols, bf16_t* WT, int ldwt, LAS float* scr, int item, int lane) {
    const int nblk = ncols / 64, kb = item / nblk, nb = item % nblk, k0 = 64 * kb, n0 = 64 * nb;
    float4 v[16];
#pragma unroll
    for (int i = 0; i < 16; ++i) v[i] = *(const float4*)(W + (size_t)(k0 + 4 * i + (lane >> 4)) * ldw + n0 + 4 * (lane & 15));
#pragma unroll
    for (int i = 0; i < 16; ++i) { LAS float* d_ = scr + (4 * i + (lane >> 4)) * 65 + 4 * (lane & 15); d_[0] = v[i].x; d_[1] = v[i].y; d_[2] = v[i].z; d_[3] = v[i].w; }
    asm volatile("s_waitcnt lgkmcnt(0)" ::: "memory");
#pragma unroll
    for (int j = 0; j < 8; ++j) {
        const int n = (lane >> 3) + 8 * j, c = lane & 7;
        const LAS float* s_ = scr + (8 * c) * 65 + n;
        uint4 o;
        o.x = pk2(s_[0 * 65], s_[1 * 65]); o.y = pk2(s_[2 * 65], s_[3 * 65]); o.z = pk2(s_[4 * 65], s_[5 * 65]); o.w = pk2(s_[6 * 65], s_[7 * 65]);
        *(uint4*)(WT + (size_t)(n0 + n) * ldwt + k0 + 8 * c) = o;
    }
    asm volatile("s_waitcnt lgkmcnt(0)" ::: "memory");
}

DEV float wave_scan_add(float v, int lane) {
#pragma unroll
    for (int o = 1; o < 64; o <<= 1) { const float u = __shfl_up(v, o); if (lane >= o) v += u; }
    return v;
}
DEV float wave_scan_max(float v, int lane) {
#pragma unroll
    for (int o = 1; o < 64; o <<= 1) { const float u = __shfl_up(v, o); if (lane >= o) v = fmaxf(v, u); }
    return v;
}

template <int TT>
DEV void mlstm_a_wave(LAS char* shm, int fr, int fq, float m_prev, const LAS float* tpj, const LAS float* taj, f32x4 (&nacc)[3]) {
    constexpr int QS = 0, KS = 33792, VT = 67584, RS = 528, VRS = 96, NT = TT + 1;
    const LAS char* qb = shm + QS + (16 * TT + fr) * RS + fq * 16;
    const LAS char* kb = shm + KS + fr * RS + fq * 16;
    f32x4 sacc[NT];
#pragma unroll
    for (int jj = 0; jj < NT; ++jj) sacc[jj] = (f32x4){0.f, 0.f, 0.f, 0.f};
    bf16x8 qf = *(const LAS bf16x8*)qb, kf[NT];
#pragma unroll
    for (int jj = 0; jj < NT; ++jj) kf[jj] = *(const LAS bf16x8*)(kb + jj * 16 * RS);
#pragma unroll
    for (int ks = 0; ks < 8; ++ks) {
        bf16x8 qn = qf, kn[NT];
#pragma unroll
        for (int jj = 0; jj < NT; ++jj) kn[jj] = kf[jj];
        if (ks < 7) {
            qn = *(const LAS bf16x8*)(qb + (ks + 1) * 64);
#pragma unroll
            for (int jj = 0; jj < NT; ++jj) kn[jj] = *(const LAS bf16x8*)(kb + jj * 16 * RS + (ks + 1) * 64);
        }
#pragma unroll
        for (int jj = 0; jj < NT; ++jj) sacc[jj] = __builtin_amdgcn_mfma_f32_16x16x32_bf16(kf[jj], qf, sacc[jj], 0, 0, 0);
        qf = qn;
#pragma unroll
        for (int jj = 0; jj < NT; ++jj) kf[jj] = kn[jj];
    }
    constexpr int NK = (TT >= 2) ? 2 : 1;
    s16x4 vlo[NK][3], vhi[NK][3];
#pragma unroll
    for (int kk = 0; kk < NK; ++kk)
#pragma unroll
        for (int vt = 0; vt < 3; ++vt) {
            vlo[kk][vt] = __builtin_amdgcn_ds_read_tr16_b64_v4i16((LAS s16x4*)(shm + VT + (32 * kk + 4 * fq + (fr >> 2)) * VRS + (16 * vt + 4 * (fr & 3)) * 2));
            vhi[kk][vt] = __builtin_amdgcn_ds_read_tr16_b64_v4i16((LAS s16x4*)(shm + VT + (32 * kk + 16 + 4 * fq + (fr >> 2)) * VRS + (16 * vt + 4 * (fr & 3)) * 2));
        }
    const int t = 16 * TT + fr;
    const float btm = -fmaxf(m_prev, tpj[t]);
    f32x4 sm[2 * NK];
#pragma unroll
    for (int jj = 0; jj < 2 * NK; ++jj) {
        if (jj < NT) {
            const f32x4 a4 = *(const LAS f32x4*)(taj + 16 * jj + 4 * fq);
#pragma unroll
            for (int r = 0; r < 4; ++r) {
                const int s_ = 16 * jj + 4 * fq + r;
                sm[jj][r] = (jj < TT || s_ <= t) ? sacc[jj < NT ? jj : 0][r] * __expf(btm + a4[r]) : 0.f;
            }
        } else sm[jj] = (f32x4){0.f, 0.f, 0.f, 0.f};
    }
#pragma unroll
    for (int kk = 0; kk < NK; ++kk) {
        const u32x4 u = (u32x4){pk2(sm[2 * kk][0], sm[2 * kk][1]), pk2(sm[2 * kk][2], sm[2 * kk][3]), pk2(sm[2 * kk + 1][0], sm[2 * kk + 1][1]), pk2(sm[2 * kk + 1][2], sm[2 * kk + 1][3])};
        const bf16x8 af = *(const bf16x8*)&u;
#pragma unroll
        for (int vt = 0; vt < 3; ++vt) {
            bf16x8 bv8; bv8[0] = vlo[kk][vt][0]; bv8[1] = vlo[kk][vt][1]; bv8[2] = vlo[kk][vt][2]; bv8[3] = vlo[kk][vt][3];
            bv8[4] = vhi[kk][vt][0]; bv8[5] = vhi[kk][vt][1]; bv8[6] = vhi[kk][vt][2]; bv8[7] = vhi[kk][vt][3];
            nacc[vt] = __builtin_amdgcn_mfma_f32_16x16x32_bf16(af, bv8, nacc[vt], 0, 0, 0);
        }
    }
}
DEV void mlstm_b_wave(LAS char* shm, int tt, int fr, int fq, f32x4 (&nacc)[3]) {
    constexpr int QS = 0, CB = 81408, RS = 528;
    const LAS char* qb = shm + QS + (16 * tt + fr) * RS + fq * 16;
    const LAS char* cbp = shm + CB + fr * RS + fq * 16;
    bf16x8 qf = *(const LAS bf16x8*)qb, cf[3];
#pragma unroll
    for (int vt = 0; vt < 3; ++vt) cf[vt] = *(const LAS bf16x8*)(cbp + vt * 16 * RS);
#pragma unroll
    for (int ks = 0; ks < 8; ++ks) {
        bf16x8 qn = qf, cn[3] = {cf[0], cf[1], cf[2]};
        if (ks < 7) {
            qn = *(const LAS bf16x8*)(qb + (ks + 1) * 64);
#pragma unroll
            for (int vt = 0; vt < 3; ++vt) cn[vt] = *(const LAS bf16x8*)(cbp + vt * 16 * RS + (ks + 1) * 64);
        }
#pragma unroll
        for (int vt = 0; vt < 3; ++vt) nacc[vt] = __builtin_amdgcn_mfma_f32_16x16x32_bf16(qf, cf[vt], nacc[vt], 0, 0, 0);
        qf = qn;
#pragma unroll
        for (int vt = 0; vt < 3; ++vt) cf[vt] = cn[vt];
    }
}
template <int SKIP>
DEV void mlstm_phase(LAS char* shm, const bf16_t* q, const bf16_t* k, const bf16_t* v, const float* gpart, const float* b_ig, const float* b_fg, bf16_t* hc) {
    const int tid = opaque_tid(), wid = __builtin_amdgcn_readfirstlane(tid >> 6), lane = tid & 63, fr = lane & 15, fq = lane >> 4;
    constexpr int QS = 0, KS = 33792, VT = 67584, VWT = 74496, CB = 81408, PART = 106752, TB = 120064, TA = 128256, TP = 136448, TC = 144640, HST = 144896, RS = 528, VRS = 96, PRS = 52;
    LAS float* part = (LAS float*)(shm + PART);
    LAS float* tb = (LAS float*)(shm + TB); LAS float* ta = (LAS float*)(shm + TA); LAS float* tp = (LAS float*)(shm + TP); LAS float* tc = (LAS float*)(shm + TC);
    for (int item = blockIdx.x; item < BATCH * NH * 8; item += gridDim.x) {
        const int vs = (item >> 3) & 7, bh = (item & 7) + 8 * (item >> 6), h = bh & 3, b = bh >> 2;
        __syncthreads();
        for (int i = tid; i < (CB + 25344 - VT) / 4; i += 512) ((LAS unsigned*)(shm + VT))[i] = 0u;
        for (int j = wid; j < SEQ / CHUNK; j += 8) {
            const int m = b * SEQ + j * CHUNK + lane;
            const float* gp = gpart + (size_t)m * 8;
            const float ig = gp[h] + gp[(size_t)MTOK * 8 + h] + b_ig[h];
            const float lf = logsigmoidf_(gp[4 + h] + gp[(size_t)MTOK * 8 + 4 + h] + b_fg[h]);
            const float bc = wave_scan_add(lf, lane);
            const float a_ = ig - bc;
            const float pm = wave_scan_max(a_, lane);
            tb[j * 64 + lane] = bc; ta[j * 64 + lane] = a_; tp[j * 64 + lane] = pm;
            if (lane == 63) { tc[2 * j] = bc; tc[2 * j + 1] = pm; }
        }
        __syncthreads();
        if (tid < 64) *(LAS u32x4*)(shm + VT + tid * VRS + 64) = (u32x4){0x3F80u, 0u, 0u, 0u};
        f32x4 cacc[2][3];
#pragma unroll
        for (int i = 0; i < 2; ++i)
#pragma unroll
            for (int vt = 0; vt < 3; ++vt) cacc[i][vt] = (f32x4){0.f, 0.f, 0.f, 0.f};
        float m_prev = 0.f;
        const size_t cb0 = ((size_t)(b * SEQ)) * DM + h * DH;
        uint4 qv[4], kv[4], vv = make_uint4(0, 0, 0, 0);
#pragma unroll
        for (int i = 0; i < 4; ++i) {
            const int idx = tid + 512 * i, row = idx >> 5, c16 = idx & 31;
            qv[i] = *(const uint4*)(q + cb0 + (size_t)row * DM + c16 * 8);
            kv[i] = *(const uint4*)(k + cb0 + (size_t)row * DM + c16 * 8);
        }
        if (tid < 256) vv = *(const uint4*)(v + cb0 + (size_t)(tid >> 2) * DM + vs * 32 + (tid & 3) * 8);
#pragma nounroll
        for (int j = 0; j < SEQ / CHUNK; ++j) {
            const size_t cb = cb0 + (size_t)j * CHUNK * DM;
            const float btot = tc[2 * j], amax = tc[2 * j + 1];
            const float mxc = fmaxf(m_prev, amax);
#pragma unroll
            for (int i = 0; i < ((SKIP & 8) ? 0 : 4); ++i) {
                const int idx = tid + 512 * i, row = idx >> 5, c16 = idx & 31;
                *(LAS u32x4*)(shm + QS + row * RS + c16 * 16) = (u32x4){qv[i].x, qv[i].y, qv[i].z, qv[i].w};
                *(LAS u32x4*)(shm + KS + row * RS + c16 * 16) = (u32x4){kv[i].x, kv[i].y, kv[i].z, kv[i].w};
            }
            if (tid < 256) {
                const int s_ = tid >> 2, v0 = (tid & 3) * 8;
                const float ws = __expf(ta[j * 64 + s_] - mxc);
                float f8[8]; unpack8(vv, f8);
#pragma unroll
                for (int e = 0; e < 8; ++e) f8[e] *= ws;
                const uint4 wv = pack8(f8);
                *(LAS u32x4*)(shm + VT + s_ * VRS + v0 * 2) = (u32x4){vv.x, vv.y, vv.z, vv.w};
                *(LAS u32x4*)(shm + VWT + s_ * VRS + v0 * 2) = (u32x4){wv.x, wv.y, wv.z, wv.w};
            } else if (tid < 320) {
                const int s_ = tid - 256;
                *(LAS u32x4*)(shm + VWT + s_ * VRS + 64) = (u32x4){(unsigned)f2bf(__expf(ta[j * 64 + s_] - mxc)), 0u, 0u, 0u};
            }
            if (j + 1 < SEQ / CHUNK) {
                const size_t cn = cb + (size_t)CHUNK * DM;
#pragma unroll
                for (int i = 0; i < 4; ++i) {
                    const int idx = tid + 512 * i, row = idx >> 5, c16 = idx & 31;
                    qv[i] = *(const uint4*)(q + cn + (size_t)row * DM + c16 * 8);
                    kv[i] = *(const uint4*)(k + cn + (size_t)row * DM + c16 * 8);
                }
                if (tid < 256) vv = *(const uint4*)(v + cn + (size_t)(tid >> 2) * DM + vs * 32 + (tid & 3) * 8);
            }
            __syncthreads();
            f32x4 nacc[3];
#pragma unroll
            for (int vt = 0; vt < 3; ++vt) nacc[vt] = (f32x4){0.f, 0.f, 0.f, 0.f};
            const int tt = wid & 3;
            if (wid < 4) { if (!(SKIP & 1)) {
                const LAS float* tpj = tp + j * 64; const LAS float* taj = ta + j * 64;
                if (tt == 0) mlstm_a_wave<0>(shm, fr, fq, m_prev, tpj, taj, nacc);
                else if (tt == 1) mlstm_a_wave<1>(shm, fr, fq, m_prev, tpj, taj, nacc);
                else if (tt == 2) mlstm_a_wave<2>(shm, fr, fq, m_prev, tpj, taj, nacc);
                else mlstm_a_wave<3>(shm, fr, fq, m_prev, tpj, taj, nacc);
            } } else if (!(SKIP & 2)) {
                mlstm_b_wave(shm, tt, fr, fq, nacc);
                const f32x4 pm4 = *(const LAS f32x4*)(tp + j * 64 + 16 * tt + 4 * fq);
#pragma unroll
                for (int vt = 0; vt < 3; ++vt)
#pragma unroll
                    for (int r = 0; r < 4; ++r) part[(16 * tt + 4 * fq + r) * PRS + 16 * vt + fr] = __expf(m_prev - fmaxf(m_prev, pm4[r])) * nacc[vt][r];
            }
            if (!(SKIP & 4)) {
                const float decay = __expf(m_prev - mxc);
#pragma unroll
                for (int i = 0; i < 2; ++i)
#pragma unroll
                    for (int vt = 0; vt < 3; ++vt) cacc[i][vt] *= decay;
                const int q_ = fr >> 2, p_ = fr & 3;
                s16x4 wl[2][3], wh[2][3], kl[2][2], kh[2][2];
#pragma unroll
                for (int kk = 0; kk < 2; ++kk) {
#pragma unroll
                    for (int vt = 0; vt < 3; ++vt) {
                        wl[kk][vt] = __builtin_amdgcn_ds_read_tr16_b64_v4i16((LAS s16x4*)(shm + VWT + (32 * kk + 8 * fq + q_) * VRS + (16 * vt + 4 * p_) * 2));
                        wh[kk][vt] = __builtin_amdgcn_ds_read_tr16_b64_v4i16((LAS s16x4*)(shm + VWT + (32 * kk + 8 * fq + 4 + q_) * VRS + (16 * vt + 4 * p_) * 2));
                    }
#pragma unroll
                    for (int i = 0; i < 2; ++i) {
                        const int dt = 2 * wid + i;
                        kl[kk][i] = __builtin_amdgcn_ds_read_tr16_b64_v4i16((LAS s16x4*)(shm + KS + (32 * kk + 8 * fq + q_) * RS + (16 * dt + 4 * p_) * 2));
                        kh[kk][i] = __builtin_amdgcn_ds_read_tr16_b64_v4i16((LAS s16x4*)(shm + KS + (32 * kk + 8 * fq + 4 + q_) * RS + (16 * dt + 4 * p_) * 2));
                    }
                }
#pragma unroll
                for (int kk = 0; kk < 2; ++kk) {
                    bf16x8 bfv[3];
#pragma unroll
                    for (int vt = 0; vt < 3; ++vt) { bfv[vt][0] = wl[kk][vt][0]; bfv[vt][1] = wl[kk][vt][1]; bfv[vt][2] = wl[kk][vt][2]; bfv[vt][3] = wl[kk][vt][3];
                        bfv[vt][4] = wh[kk][vt][0]; bfv[vt][5] = wh[kk][vt][1]; bfv[vt][6] = wh[kk][vt][2]; bfv[vt][7] = wh[kk][vt][3]; }
#pragma unroll
                    for (int i = 0; i < 2; ++i) {
                        bf16x8 af; af[0] = kl[kk][i][0]; af[1] = kl[kk][i][1]; af[2] = kl[kk][i][2]; af[3] = kl[kk][i][3]; af[4] = kh[kk][i][0]; af[5] = kh[kk][i][1]; af[6] = kh[kk][i][2]; af[7] = kh[kk][i][3];
#pragma unroll
                        for (int vt = 0; vt < 3; ++vt) cacc[i][vt] = __builtin_amdgcn_mfma_f32_16x16x32_bf16(af, bfv[vt], cacc[i][vt], 0, 0, 0);
                    }
                }
            }
            __syncthreads();
            if (wid < 4 && !(SKIP & 16)) {
                const f32x4 pm4 = *(const LAS f32x4*)(tp + j * 64 + 16 * tt + 4 * fq);
                const f32x4 bc4 = *(const LAS f32x4*)(tb + j * 64 + 16 * tt + 4 * fq);
#pragma unroll
                for (int vt = 0; vt < 3; ++vt)
#pragma unroll
                    for (int r = 0; r < 4; ++r) nacc[vt][r] += part[(16 * tt + 4 * fq + r) * PRS + 16 * vt + fr];
#pragma unroll
                for (int r = 0; r < 4; ++r) {
                    const float den = __shfl(nacc[2][r], lane & 48);
                    const float inv = __builtin_amdgcn_rcpf(fmaxf(fabsf(den), __expf(-(bc4[r] + fmaxf(m_prev, pm4[r])))));
                    LAS bf16_t* hrow = (LAS bf16_t*)(shm + HST + (16 * tt + 4 * fq + r) * 80);
                    hrow[fr] = f2bf(nacc[0][r] * inv);
                    hrow[16 + fr] = f2bf(nacc[1][r] * inv);
                }
                asm volatile("s_waitcnt lgkmcnt(0)" ::: "memory");
                {
                    const int rw = 16 * tt + (lane >> 2), pc = lane & 3;
                    const u32x4 hv = *(const LAS u32x4*)(shm + HST + rw * 80 + pc * 16);
                    *(uint4*)(hc + cb + (size_t)rw * DM + vs * 32 + pc * 8) = make_uint4(hv[0], hv[1], hv[2], hv[3]);
                }
            }
#pragma unroll
            for (int i = 0; i < 2; ++i)
#pragma unroll
                for (int vt = 0; vt < 3; ++vt) {
                    u32x2 o; o[0] = pk2(cacc[i][vt][0], cacc[i][vt][1]); o[1] = pk2(cacc[i][vt][2], cacc[i][vt][3]);
                    *(LAS u32x2*)(shm + CB + (16 * vt + fr) * RS + (16 * (2 * wid + i) + 4 * fq) * 2) = o;
                }
            m_prev = btot + mxc;
        }
    }
}

constexpr int S5L = 32, S5NCH = SEQ / S5L;
constexpr size_t T_KT_OFF = 0, T_WS_OFF = 2u << 20, T_V_OFF = 10u << 20, T_AL_OFF = 18u << 20;
constexpr int KT_G = 33 * 256, WS_G = 128 * 512, V_G = 512 * 128;

DEV void s5_tables(LAS char* shm, char* tab, const float* lam_re, const float* lam_im, const float* log_dt, const float* b_re, const float* b_im,
                   const float* c_re, const float* c_im) {
    const int tid = opaque_tid();
    LAS f32x2* apw = (LAS f32x2*)shm;
    LAS f32x2* bb = (LAS f32x2*)(shm + 64 * 33 * 8);
    LAS f32x2* cc = (LAS f32x2*)(shm + 64 * 33 * 8 + 8192);
    bf16_t* KT = (bf16_t*)(tab + T_KT_OFF); bf16_t* WS = (bf16_t*)(tab + T_WS_OFF); bf16_t* VV = (bf16_t*)(tab + T_V_OFF); float2* AL = (float2*)(tab + T_AL_OFF);
    for (int it = blockIdx.x; it < 256; it += gridDim.x) {
        const int g = it & 63, qd = it >> 6;
        __syncthreads();
        if (tid < 64) {
            const int pp = tid;
            const double lr = lam_re[g * NP + pp], li = lam_im[g * NP + pp], dt = exp((double)log_dt[g]);
            const double er = exp(lr * dt);
            const double ar = er * cos(li * dt), ai = er * sin(li * dt);
            const double dr = ar - 1.0, di = ai, den = lr * lr + li * li;
            const double cr = (dr * lr + di * li) / den, ci = (di * lr - dr * li) / den;
            double pr = 1.0, pi_ = 0.0;
            for (int e = 0; e <= 32; ++e) {
                apw[pp * 33 + e] = (f32x2){(float)pr, (float)pi_};
                const double nr = pr * ar - pi_ * ai, ni = pr * ai + pi_ * ar; pr = nr; pi_ = ni;
            }
            if (qd == 0) { const f32x2 t_ = apw[pp * 33 + 32]; AL[g * NP + pp] = make_float2(t_.x, t_.y); }
            for (int c = 0; c < 16; ++c) {
                const double br = b_re[(g * NP + pp) * GC + c], bi = b_im[(g * NP + pp) * GC + c];
                bb[pp * 16 + c] = (f32x2){(float)(cr * br - ci * bi), (float)(cr * bi + ci * br)};
                cc[c * 64 + pp] = (f32x2){c_re[(g * GC + c) * NP + pp], c_im[(g * GC + c) * NP + pp]};
            }
        }
        __syncthreads();
        for (int o = tid; o < 8 * 256; o += 512) {
            const int d = 8 * qd + (o >> 8), c1 = (o >> 4) & 15, c0 = o & 15;
            float acc = 0.f;
            for (int pp = 0; pp < 64; ++pp) {
                const f32x2 a = apw[pp * 33 + d], b = bb[pp * 16 + c0], c = cc[c1 * 64 + pp];
                const float mr = a.x * b.x - a.y * b.y, mi = a.x * b.y + a.y * b.x;
                acc += c.x * mr - c.y * mi;
            }
            KT[(size_t)g * KT_G + (d + 1) * 256 + c1 * 16 + c0] = f2bf(acc);
        }
        if (qd == 0 && tid < 256) KT[(size_t)g * KT_G + tid] = 0;
        for (int o = tid; o < 2 * 16 * 64; o += 512) {
            const int mt = 2 * qd + (o >> 10), sp = (o >> 6) & 15, ln = o & 63;
            const int row = 16 * mt + (ln & 15), ri = row >> 6, pp = row & 63, s_ = 2 * sp + (ln >> 5), c0 = 8 * ((ln >> 4) & 1);
            const f32x2 a = apw[pp * 33 + 31 - s_];
            unsigned w[4];
#pragma unroll
            for (int jj = 0; jj < 8; jj += 2) {
                const f32x2 b0 = bb[pp * 16 + c0 + jj], b1 = bb[pp * 16 + c0 + jj + 1];
                const float v0 = ri ? (a.x * b0.y + a.y * b0.x) : (a.x * b0.x - a.y * b0.y);
                const float v1 = ri ? (a.x * b1.y + a.y * b1.x) : (a.x * b1.x - a.y * b1.y);
                w[jj >> 1] = pk2(v0, v1);
            }
            *(uint4*)(WS + (size_t)g * WS_G + ((size_t)(mt * 16 + sp) * 64 + ln) * 8) = make_uint4(w[0], w[1], w[2], w[3]);
        }
        for (int o = tid; o < 8 * 4 * 64; o += 512) {
            const int i = 8 * qd + (o >> 8), ks = (o >> 6) & 3, ln = o & 63;
            const int c1 = ln & 15, k0 = 32 * ks + 8 * (ln >> 4);
            unsigned w[4];
#pragma unroll
            for (int jj = 0; jj < 8; jj += 2) {
                float v[2];
#pragma unroll
                for (int e = 0; e < 2; ++e) {
                    const int kk = k0 + jj + e, ri = kk >> 6, pp = kk & 63;
                    const f32x2 a = apw[pp * 33 + i + 1], c = cc[c1 * 64 + pp];
                    v[e] = ri ? -(c.x * a.y + c.y * a.x) : (c.x * a.x - c.y * a.y);
                }
                w[jj >> 1] = pk2(v[0], v[1]);
            }
            *(uint4*)(VV + (size_t)g * V_G + ((size_t)(i * 4 + ks) * 64 + ln) * 8) = make_uint4(w[0], w[1], w[2], w[3]);
        }
    }
}

template <int NQ>
DEV void s5_p1_range(LAS char* shm, int lo, int hi, int wid, int fr, int fq, const bf16_t* wsp, f32x4 (&acc)[4][4], f32x4 (&sac)[4]) {
    constexpr int PLANE = 64 * 528, KTL = 2 * PLANE, Q0 = 4 - NQ;
    if (lo > hi) return;
    const LAS char* ub = shm + (fq & 1) * PLANE + fr * 528 + (fq >> 1) * 16;
    const LAS char* kb = shm + KTL + (1 - (fq >> 1)) * 512 + fr * 32 + (fq & 1) * 16;
    bf16x8 bu[4], kf[NQ], wcur;
#pragma unroll
    for (int nt = 0; nt < 4; ++nt) bu[nt] = *(const LAS bf16x8*)(ub + nt * 16 * 528 + lo * 32);
#pragma unroll
    for (int q = 0; q < NQ; ++q) kf[q] = *(const LAS bf16x8*)(kb + (wid + 8 * (Q0 + q) - 2 * lo) * 512);
    wcur = *(const bf16x8*)(wsp + (size_t)lo * 64 * 8);
#pragma nounroll
    for (int sp = lo; sp <= hi; ++sp) {
        bf16x8 bn[4], kn[NQ], wn = wcur;
        const int sn = (sp < hi) ? sp + 1 : sp;
#pragma unroll
        for (int nt = 0; nt < 4; ++nt) bn[nt] = *(const LAS bf16x8*)(ub + nt * 16 * 528 + sn * 32);
#pragma unroll
        for (int q = 0; q < NQ; ++q) kn[q] = *(const LAS bf16x8*)(kb + (wid + 8 * (Q0 + q) - 2 * sn) * 512);
        wn = *(const bf16x8*)(wsp + (size_t)sn * 64 * 8);
#pragma unroll
        for (int nt = 0; nt < 4; ++nt) sac[nt] = __builtin_amdgcn_mfma_f32_16x16x32_bf16(wcur, bu[nt], sac[nt], 0, 0, 0);
#pragma unroll
        for (int q = 0; q < NQ; ++q)
#pragma unroll
            for (int nt = 0; nt < 4; ++nt) acc[Q0 + q][nt] = __builtin_amdgcn_mfma_f32_16x16x32_bf16(kf[q], bu[nt], acc[Q0 + q][nt], 0, 0, 0);
#pragma unroll
        for (int nt = 0; nt < 4; ++nt) bu[nt] = bn[nt];
#pragma unroll
        for (int q = 0; q < NQ; ++q) kf[q] = kn[q];
        wcur = wn;
    }
}
DEV void s5_phase(LAS char* shm, const bf16_t* Uin, bf16_t* Yout, const char* tab, const float* dskip) {
    const int tid = opaque_tid(), wid = __builtin_amdgcn_readfirstlane(tid >> 6), lane = tid & 63, fr = lane & 15, fq = lane >> 4;
    constexpr int PLANE = 64 * 528, KTL = 2 * PLANE, SL = KTL + 33 * 512, HB = SL + 64 * 528, SRS = 528, HRS = 272, TSEG = HB + 64 * 272;
    const bf16_t* KT = (const bf16_t*)(tab + T_KT_OFF); const bf16_t* WS = (const bf16_t*)(tab + T_WS_OFF); const bf16_t* VV = (const bf16_t*)(tab + T_V_OFF);
    const float2* AL = (const float2*)(tab + T_AL_OFF);
    for (int item = blockIdx.x; item < BATCH * NG; item += gridDim.x) {
        const int xcd_ = item & 7, j_ = (item >> 3) & 31, g = xcd_ * 8 + (j_ & 7), b = (j_ >> 3) + 4 * (item >> 8);
        const bf16_t* Ub = Uin + ((size_t)g * MTOK + (size_t)b * SEQ) * 16;
        bf16_t* Yb = Yout + ((size_t)g * MTOK + (size_t)b * SEQ) * 16;
        __syncthreads();
#pragma unroll
        for (int i = 0; i < 8; ++i) {
            const int idx = tid + 512 * i, tok = idx >> 1, hf = idx & 1;
            const uint4 uv = *(const uint4*)(Ub + (size_t)tok * 16 + hf * 8);
            *(LAS u32x4*)(shm + hf * PLANE + (tok >> 5) * 528 + (tok & 31) * 16) = (u32x4){uv.x, uv.y, uv.z, uv.w};
        }
        for (int idx = tid; idx < 33 * 32; idx += 512) {
            const uint4 kv = *(const uint4*)(KT + (size_t)g * KT_G + idx * 8);
            *(LAS u32x4*)(shm + KTL + idx * 16) = (u32x4){kv.x, kv.y, kv.z, kv.w};
        }
        __syncthreads();
        f32x4 acc[4][4], sac[4];
#pragma unroll
        for (int q = 0; q < 4; ++q)
#pragma unroll
            for (int nt = 0; nt < 4; ++nt) acc[q][nt] = (f32x4){0.f, 0.f, 0.f, 0.f};
#pragma unroll
        for (int nt = 0; nt < 4; ++nt) sac[nt] = (f32x4){0.f, 0.f, 0.f, 0.f};
        const bf16_t* wsp = WS + (size_t)g * WS_G + ((size_t)(wid * 16) * 64 + lane) * 8;
        const int h2 = wid >> 1;
        s5_p1_range<4>(shm, 0, h2, wid, fr, fq, wsp, acc, sac);
        s5_p1_range<3>(shm, h2 + 1, 4 + h2, wid, fr, fq, wsp, acc, sac);
        s5_p1_range<2>(shm, 5 + h2, 8 + h2, wid, fr, fq, wsp, acc, sac);
        s5_p1_range<1>(shm, 9 + h2, 12 + h2, wid, fr, fq, wsp, acc, sac);
        if (13 + h2 <= 15) {
            const LAS char* ub = shm + (fq & 1) * PLANE + fr * 528 + (fq >> 1) * 16;
            for (int sp = 13 + h2; sp <= 15; ++sp) {
                const bf16x8 wcur = *(const bf16x8*)(wsp + (size_t)sp * 64 * 8);
#pragma unroll
                for (int nt = 0; nt < 4; ++nt) sac[nt] = __builtin_amdgcn_mfma_f32_16x16x32_bf16(wcur, *(const LAS bf16x8*)(ub + nt * 16 * 528 + sp * 32), sac[nt], 0, 0, 0);
            }
        }
#pragma unroll
        for (int nt = 0; nt < 4; ++nt) *(LAS f32x4*)(shm + SL + (16 * nt + fr) * SRS + (16 * wid + 4 * fq) * 4) = sac[nt];
        __syncthreads();
        {
            const float2 al = AL[g * NP + lane];
            float hr = 0.f, hi = 0.f, lr[8], li[8];
#pragma unroll
            for (int n = 0; n < 8; ++n) {
                lr[n] = hr; li[n] = hi;
                const float sr = *(const LAS float*)(shm + SL + (8 * wid + n) * SRS + lane * 4), si = *(const LAS float*)(shm + SL + (8 * wid + n) * SRS + (64 + lane) * 4);
                const float nr = al.x * hr - al.y * hi + sr, ni = al.x * hi + al.y * hr + si; hr = nr; hi = ni;
            }
            *(LAS float*)(shm + TSEG + (wid * 128 + lane) * 4) = hr; *(LAS float*)(shm + TSEG + (wid * 128 + 64 + lane) * 4) = hi;
            float pr = al.x, pi = al.y;
#pragma unroll
            for (int e = 0; e < 3; ++e) { const float nr = pr * pr - pi * pi, ni = 2.f * pr * pi; pr = nr; pi = ni; }
            __syncthreads();
            float cr = 0.f, ci = 0.f;
            for (int w2 = 0; w2 < wid; ++w2) {
                const float tr = *(const LAS float*)(shm + TSEG + (w2 * 128 + lane) * 4), ti = *(const LAS float*)(shm + TSEG + (w2 * 128 + 64 + lane) * 4);
                const float nr = pr * cr - pi * ci + tr, ni = pr * ci + pi * cr + ti; cr = nr; ci = ni;
            }
            float qr = 1.f, qi = 0.f;
#pragma unroll
            for (int n = 0; n < 8; ++n) {
                const float fr_ = lr[n] + qr * cr - qi * ci, fi_ = li[n] + qr * ci + qi * cr;
                *(LAS bf16_t*)(shm + HB + (8 * wid + n) * HRS + lane * 2) = f2bf(fr_);
                *(LAS bf16_t*)(shm + HB + (8 * wid + n) * HRS + (64 + lane) * 2) = f2bf(fi_);
                const float nr = qr * al.x - qi * al.y, ni = qr * al.y + qi * al.x; qr = nr; qi = ni;
            }
        }
        __syncthreads();
        const bf16_t* vvp = VV + (size_t)g * V_G + (size_t)lane * 8;
        bf16x8 va[4];
#pragma unroll
        for (int q = 0; q < 4; ++q) va[q] = *(const bf16x8*)(vvp + ((size_t)((wid + 8 * q) * 4 + 0) * 64) * 8);
#pragma unroll
        for (int ks = 0; ks < 4; ++ks) {
            bf16x8 hb[4], vn[4];
#pragma unroll
            for (int nt = 0; nt < 4; ++nt) hb[nt] = *(const LAS bf16x8*)(shm + HB + (16 * nt + fr) * HRS + (32 * ks + 8 * fq) * 2);
#pragma unroll
            for (int q = 0; q < 4; ++q) vn[q] = (ks < 3) ? *(const bf16x8*)(vvp + ((size_t)((wid + 8 * q) * 4 + ks + 1) * 64) * 8) : va[q];
#pragma unroll
            for (int q = 0; q < 4; ++q)
#pragma unroll
                for (int nt = 0; nt < 4; ++nt) acc[q][nt] = __builtin_amdgcn_mfma_f32_16x16x32_bf16(va[q], hb[nt], acc[q][nt], 0, 0, 0);
#pragma unroll
            for (int q = 0; q < 4; ++q) va[q] = vn[q];
        }
        const float4 dsk = *(const float4*)(dskip + g * GC + 4 * fq);
#pragma unroll
        for (int q = 0; q < 4; ++q) {
            const int i = wid + 8 * q;
#pragma unroll
            for (int nt = 0; nt < 4; ++nt) {
                const int n = 16 * nt + fr;
                const u32x2 uu = *(const LAS u32x2*)(shm + (fq >> 1) * PLANE + n * 528 + i * 16 + ((4 * fq) & 7) * 2);
                f32x4 o;
                o[0] = geluf_(acc[q][nt][0] + dsk.x * bf2f((bf16_t)(uu[0] & 0xffff))); o[1] = geluf_(acc[q][nt][1] + dsk.y * bf2f((bf16_t)(uu[0] >> 16)));
                o[2] = geluf_(acc[q][nt][2] + dsk.z * bf2f((bf16_t)(uu[1] & 0xffff))); o[3] = geluf_(acc[q][nt][3] + dsk.w * bf2f((bf16_t)(uu[1] >> 16)));
                *(uint2*)(Yb + (size_t)(n * 32 + i) * 16 + 4 * fq) = pack4(o);
            }
        }
    }
}


DEV void norm_rows(const float* x, const float* gain, const float* modl, bf16_t* h) {
    const int tid = opaque_tid(), lane = tid & 63, gw = blockIdx.x * 8 + (tid >> 6), NGW = gridDim.x * 8;
    for (int m = gw; m < MTOK; m += NGW) {
        const float4* xr = (const float4*)(x + (size_t)m * DM) + lane;
        float4 v[4]; float ss = 0.f;
#pragma unroll
        for (int j = 0; j < 4; ++j) { v[j] = xr[64 * j]; ss += v[j].x * v[j].x + v[j].y * v[j].y + v[j].z * v[j].z + v[j].w * v[j].w; }
        const float rstd = rsqrtf(wave_sum(ss) * (1.f / DM) + EPS);
        const float* shift = modl + (size_t)(m / SEQ) * 3 * DM; const float* scale = shift + DM;
#pragma unroll
        for (int j = 0; j < 4; ++j) {
            const int n = 4 * lane + 256 * j;
            const float4 g = *(const float4*)(gain + n), sc = *(const float4*)(scale + n), sh = *(const float4*)(shift + n);
            f32x4 o; o[0] = v[j].x * rstd * g.x * (1.f + sc.x) + sh.x; o[1] = v[j].y * rstd * g.y * (1.f + sc.y) + sh.y;
            o[2] = v[j].z * rstd * g.z * (1.f + sc.z) + sh.z; o[3] = v[j].w * rstd * g.w * (1.f + sc.w) + sh.w;
            *(uint2*)(h + (size_t)m * DM + n) = pack4(o);
        }
    }
}
DEV void ssm_post_rows(const bf16_t* z, bf16_t* zo, const bf16_t* sg, const float* gain) {
    const int tid = opaque_tid(), lane = tid & 63, gw = blockIdx.x * 8 + (tid >> 6), NGW = gridDim.x * 8;
    for (int m = gw; m < MTOK; m += NGW) {
        float zv[2][8], gv[2][8]; float ss = 0.f;
#pragma unroll
        for (int j = 0; j < 2; ++j) {
            unpack8(*(const uint4*)(z + (size_t)m * DM + 8 * lane + 512 * j), zv[j]);
            unpack8(*(const uint4*)(sg + (size_t)m * DM + 8 * lane + 512 * j), gv[j]);
#pragma unroll
            for (int e = 0; e < 8; ++e) ss += zv[j][e] * zv[j][e];
        }
        const float rstd = rsqrtf(wave_sum(ss) * (1.f / DM) + EPS);
#pragma unroll
        for (int j = 0; j < 2; ++j) {
            const int n = 8 * lane + 512 * j; float o[8];
#pragma unroll
            for (int e = 0; e < 8; ++e) o[e] = zv[j][e] * rstd * gain[n + e] * siluf_(gv[j][e]);
            *(uint4*)(zo + (size_t)m * DM + n) = pack8(o);
        }
    }
}
DEV void mlstm_post_rows(const bf16_t* hc, bf16_t* ho, const bf16_t* mo, const bf16_t* mg, const bf16_t* mi, const float* cw, const float* cb, const float* ngain, const float* skip) {
    const int tid = opaque_tid(), lane = tid & 63, gw = blockIdx.x * 8 + (tid >> 6), NGW = gridDim.x * 8;
    for (int m = gw; m < MTOK; m += NGW) {
        const size_t o0 = (size_t)m * DM + 16 * lane;
        float hv[16], t8[8]; float s1 = 0.f;
#pragma unroll
        for (int j = 0; j < 2; ++j) {
            unpack8(*(const uint4*)(hc + o0 + 8 * j), hv + 8 * j);
            unpack8(*(const uint4*)(mo + o0 + 8 * j), t8);
#pragma unroll
            for (int e = 0; e < 8; ++e) { hv[8 * j + e] *= sigmoidf_(t8[e]); s1 += hv[8 * j + e]; }
        }
#pragma unroll
        for (int o = 1; o < 16; o <<= 1) s1 += __shfl_xor(s1, o);
        const float mu = s1 * (1.f / DH); float s2 = 0.f;
#pragma unroll
        for (int e = 0; e < 16; ++e) { hv[e] -= mu; s2 += hv[e] * hv[e]; }
#pragma unroll
        for (int o = 1; o < 16; o <<= 1) s2 += __shfl_xor(s2, o);
        const float rstd = rsqrtf(s2 * (1.f / DH) + EPS);
#pragma unroll
        for (int j = 0; j < 2; ++j) {
            float xv[8], gv[8], ov[8], t8b[8];
            { const int n0 = 16 * lane + 8 * j, tpos = m % SEQ;
#pragma unroll
              for (int e = 0; e < 8; ++e) xv[e] = cb[n0 + e];
#pragma unroll
              for (int tap = 0; tap < 4; ++tap) if (tpos - 3 + tap >= 0) {
                  unpack8(*(const uint4*)(mi + (size_t)(m - 3 + tap) * DM + n0), t8b);
#pragma unroll
                  for (int e = 0; e < 8; ++e) xv[e] += t8b[e] * cw[tap * DM + n0 + e];
              }
#pragma unroll
              for (int e = 0; e < 8; ++e) xv[e] = siluf_(xv[e]); }
            unpack8(*(const uint4*)(mg + o0 + 8 * j), gv);
#pragma unroll
            for (int e = 0; e < 8; ++e) { const int n = 16 * lane + 8 * j + e; ov[e] = (hv[8 * j + e] * rstd * ngain[n] + skip[n] * xv[e]) * siluf_(gv[e]); }
            *(uint4*)(ho + o0 + 8 * j) = pack8(ov);
        }
    }
}
DEV void final_rows(float* x, const float* gain) {
    const int tid = opaque_tid(), lane = tid & 63, gw = blockIdx.x * 8 + (tid >> 6), NGW = gridDim.x * 8;
    for (int m = gw; m < MTOK; m += NGW) {
        float4* xr = (float4*)(x + (size_t)m * DM) + lane;
        float4 v[4]; float ss = 0.f;
#pragma unroll
        for (int j = 0; j < 4; ++j) { v[j] = xr[64 * j]; ss += v[j].x * v[j].x + v[j].y * v[j].y + v[j].z * v[j].z + v[j].w * v[j].w; }
        const float rstd = rsqrtf(wave_sum(ss) * (1.f / DM) + EPS);
#pragma unroll
        for (int j = 0; j < 4; ++j) {
            const float4 g = *(const float4*)(gain + 4 * lane + 256 * j);
            v[j].x *= rstd * g.x; v[j].y *= rstd * g.y; v[j].z *= rstd * g.z; v[j].w *= rstd * g.w;
            xr[64 * j] = v[j];
        }
    }
}
DEV void mod_phase(LAS char* shm, const float* c, const float* w_mod, const float* b_mod, float* mod) {
    const int tid = opaque_tid();
    LAS float* sc = (LAS float*)shm;
    LAS float* pr = (LAS float*)(shm + 32768);
    __syncthreads();
    for (int i = tid; i < BATCH * DM; i += 512) sc[i] = siluf_(c[i]);
    __syncthreads();
    for (int it = blockIdx.x; it < 48; it += gridDim.x) {
        const int l = it / 24, n0 = (it % 24) * 128, cq = tid & 31, kg = tid >> 5;
        const float* W = w_mod + (size_t)l * DM * 3 * DM + n0 + 4 * cq;
        float acc[BATCH][4];
#pragma unroll
        for (int b = 0; b < BATCH; ++b) { acc[b][0] = acc[b][1] = acc[b][2] = acc[b][3] = 0.f; }
        for (int k = kg * 64; k < kg * 64 + 64; ++k) {
            const float4 w = *(const float4*)(W + (size_t)k * 3 * DM);
#pragma unroll
            for (int b = 0; b < BATCH; ++b) { const float s_ = sc[b * DM + k]; acc[b][0] += s_ * w.x; acc[b][1] += s_ * w.y; acc[b][2] += s_ * w.z; acc[b][3] += s_ * w.w; }
        }
#pragma unroll
        for (int b = 0; b < BATCH; ++b) *(LAS f32x4*)(pr + (kg * 8 + b) * 128 + 4 * cq) = (f32x4){acc[b][0], acc[b][1], acc[b][2], acc[b][3]};
        __syncthreads();
        for (int o = tid; o < 8 * 128; o += 512) {
            const int b = o >> 7, n = o & 127; float s_ = 0.f;
#pragma unroll
            for (int g2 = 0; g2 < 16; ++g2) s_ += pr[(g2 * 8 + b) * 128 + n];
            mod[((size_t)l * BATCH + b) * 3 * DM + n0 + n] = s_ + b_mod[l * 3 * DM + n0 + n];
        }
        __syncthreads();
    }
}

DEV void wfold_prep(bf16_t* WfT, const float* wq, const float* wk, const float* wv, const float* wg  ) {
    const int tid = opaque_tid(), lane = tid & 63;
    for (int t = blockIdx.x * 8 + (tid >> 6); t < 2048; t += gridDim.x * 8) {
        const int which = t >> 10, ch = t & 1023, hd = ch >> 8, d = ch & 255;
        float acc[8];
#pragma unroll
        for (int j = 0; j < 8; ++j) acc[j] = 0.f;
        if (which == 0) {
            const float4 q4 = *(const float4*)(wq + ((size_t)hd * DH + d) * DH + 4 * lane);
            const float4 k4 = *(const float4*)(wk + ((size_t)hd * DH + d) * DH + 4 * lane);
            const float qv[4] = {q4.x, q4.y, q4.z, q4.w}, kv[4] = {k4.x * 0.0625f, k4.y * 0.0625f, k4.z * 0.0625f, k4.w * 0.0625f};
#pragma unroll
            for (int e = 0; e < 4; ++e) {
                const float* g1 = wg + (size_t)(hd * DH + 4 * lane + e) * 8; const float* g2 = wg + (size_t)(DM + hd * DH + 4 * lane + e) * 8;
                const float4 a0 = *(const float4*)g1, a1 = *(const float4*)(g1 + 4), b0 = *(const float4*)g2, b1 = *(const float4*)(g2 + 4);
                acc[0] += qv[e] * a0.x + kv[e] * b0.x; acc[1] += qv[e] * a0.y + kv[e] * b0.y; acc[2] += qv[e] * a0.z + kv[e] * b0.z; acc[3] += qv[e] * a0.w + kv[e] * b0.w;
                acc[4] += qv[e] * a1.x + kv[e] * b1.x; acc[5] += qv[e] * a1.y + kv[e] * b1.y; acc[6] += qv[e] * a1.z + kv[e] * b1.z; acc[7] += qv[e] * a1.w + kv[e] * b1.w;
            }
        } else {
            const float4 v4 = *(const float4*)(wv + ((size_t)hd * DH + d) * DH + 4 * lane);
            const float vv[4] = {v4.x, v4.y, v4.z, v4.w};
#pragma unroll
            for (int e = 0; e < 4; ++e) {
                const float* g1 = wg + (size_t)(2 * DM + hd * DH + 4 * lane + e) * 8;
                const float4 a0 = *(const float4*)g1, a1 = *(const float4*)(g1 + 4);
                acc[0] += vv[e] * a0.x; acc[1] += vv[e] * a0.y; acc[2] += vv[e] * a0.z; acc[3] += vv[e] * a0.w;
                acc[4] += vv[e] * a1.x; acc[5] += vv[e] * a1.y; acc[6] += vv[e] * a1.z; acc[7] += vv[e] * a1.w;
            }
        }
#pragma unroll
        for (int j = 0; j < 8; ++j) acc[j] = wave_sum(acc[j]);
        if (lane < 16) {
            float v = 0.f;
#pragma unroll
            for (int j = 0; j < 8; ++j) v = (lane == j) ? acc[j] : v;
            WfT[((size_t)which * 16 + lane) * 1024 + ch] = f2bf(v);
        }
    }
}
DEV void xc_gates_phase(LAS char* shm, const bf16_t* mi, bf16_t* xc, const bf16_t* WfT, const float* cw, const float* cb, float* gpart  ) {
    const int tid = opaque_tid(), wid = __builtin_amdgcn_readfirstlane(tid >> 6), lane = tid & 63, fr = lane & 15, fq = lane >> 4;
    constexpr int WRS = 2064, WIMG = 8 * WRS, CWL = 2 * WIMG, STG = CWL + 5 * 4096, SRS_ = 528, STG_W = 19 * SRS_;
    __syncthreads();
    for (int i = tid; i < 2 * 8 * 128; i += 512) {
        const int rowi = i >> 7, pc = i & 127;
        const uint4 v = *(const uint4*)(WfT + (size_t)((rowi >> 3) * 16 + (rowi & 7)) * 1024 + pc * 8);
        *(LAS u32x4*)(shm + rowi * WRS + pc * 16) = (u32x4){v.x, v.y, v.z, v.w};
    }
    for (int i = tid; i < 5 * 256; i += 512) {
        const float4 v = (i < 1024) ? *(const float4*)(cw + i * 4) : *(const float4*)(cb + (i - 1024) * 4);
        *(LAS f32x4*)(shm + CWL + i * 16) = (f32x4){v.x, v.y, v.z, v.w};
    }
    __syncthreads();
    LAS char* stg = shm + STG + wid * STG_W;
    for (int task = blockIdx.x * 8 + wid; task < (MTOK / 16) * 2; task += gridDim.x * 8) {
        const int chalf = task & 1, m0 = (task >> 1) * 16, tpos0 = m0 % SEQ;
        f32x4 acc = (f32x4){0.f, 0.f, 0.f, 0.f};
        uint4 pre[10];
#pragma unroll
        for (int it = 0; it < 10; ++it) {
            const int i = lane + 64 * it, row = i >> 5, pc = i & 31;
            pre[it] = make_uint4(0, 0, 0, 0);
            if (i < 19 * 32 && tpos0 - 3 + row >= 0) pre[it] = *(const uint4*)(mi + (size_t)(m0 - 3 + row) * DM + chalf * 512 + pc * 8);
        }
#pragma nounroll
        for (int sl = 0; sl < 2; ++sl) {
            const int c0 = chalf * 512 + sl * 256;
#pragma unroll
            for (int it = 0; it < 10; ++it) {
                const int i = lane + 64 * it, row = i >> 5, pc = i & 31;
                if (i < 19 * 32) *(LAS u32x4*)(stg + row * SRS_ + pc * 16) = (u32x4){pre[it].x, pre[it].y, pre[it].z, pre[it].w};
            }
            if (sl == 0) {
#pragma unroll
                for (int it = 0; it < 10; ++it) {
                    const int i = lane + 64 * it, row = i >> 5, pc = i & 31;
                    pre[it] = make_uint4(0, 0, 0, 0);
                    if (i < 19 * 32 && tpos0 - 3 + row >= 0) pre[it] = *(const uint4*)(mi + (size_t)(m0 - 3 + row) * DM + c0 + 256 + pc * 8);
                }
            }
#pragma nounroll
            for (int ks = 0; ks < 8; ++ks) {
                const int cl = 32 * ks + 8 * fq, c = c0 + cl;
                float xv[8], t8[8];
                { const f32x4 b0 = *(const LAS f32x4*)(shm + CWL + 16384 + c * 4), b1 = *(const LAS f32x4*)(shm + CWL + 16384 + c * 4 + 16);
                  xv[0] = b0[0]; xv[1] = b0[1]; xv[2] = b0[2]; xv[3] = b0[3]; xv[4] = b1[0]; xv[5] = b1[1]; xv[6] = b1[2]; xv[7] = b1[3]; }
                u32x4 raw3;
#pragma unroll
                for (int tap = 0; tap < 4; ++tap) {
                    const u32x4 rw = *(const LAS u32x4*)(stg + (fr + tap) * SRS_ + cl * 2);
                    if (tap == 3) raw3 = rw;
                    unpack8(make_uint4(rw[0], rw[1], rw[2], rw[3]), t8);
                    const f32x4 w0 = *(const LAS f32x4*)(shm + CWL + tap * 4096 + c * 4), w1 = *(const LAS f32x4*)(shm + CWL + tap * 4096 + c * 4 + 16);
                    xv[0] += t8[0] * w0[0]; xv[1] += t8[1] * w0[1]; xv[2] += t8[2] * w0[2]; xv[3] += t8[3] * w0[3];
                    xv[4] += t8[4] * w1[0]; xv[5] += t8[5] * w1[1]; xv[6] += t8[6] * w1[2]; xv[7] += t8[7] * w1[3];
                }
#pragma unroll
                for (int e = 0; e < 8; ++e) xv[e] = siluf_(xv[e]);
                const uint4 xp = pack8(xv);
                *(uint4*)(xc + (size_t)(m0 + fr) * DM + c) = xp;
                const u32x4 xpu = (u32x4){xp.x, xp.y, xp.z, xp.w};
                const bf16x8 bx = *(const LAS bf16x8*)(shm + (fr & 7) * WRS + c * 2);
                const bf16x8 bv = *(const LAS bf16x8*)(shm + WIMG + (fr & 7) * WRS + c * 2);
                acc = __builtin_amdgcn_mfma_f32_16x16x32_bf16(*(const bf16x8*)&xpu, bx, acc, 0, 0, 0);
                acc = __builtin_amdgcn_mfma_f32_16x16x32_bf16(*(const bf16x8*)&raw3, bv, acc, 0, 0, 0);
            }
        }
        if (fr < 8) {
#pragma unroll
            for (int r = 0; r < 4; ++r) gpart[((size_t)chalf * MTOK + m0 + 4 * fq + r) * 8 + fr] = acc[r];
        }
    }
}

#define XB_TMO      128
#define XB_XCNT(j)  (256  + 64 * (j))
#define XB_XSUB(j)  (1280 + 64 * (j))
#define XB_XGEN(j)  (2304 + 64 * (j))
#define XB_TOP      3328
#define XB_TOPGEN   3392
#define XCD_BAR_WORDS 3456
#define XB_SPIN_CAP (1u << 18)
DEV unsigned xb_ld(unsigned* p) { return __hip_atomic_load(p, __ATOMIC_RELAXED, __HIP_MEMORY_SCOPE_AGENT); }
DEV unsigned xb_add(unsigned* p, unsigned v) { return __hip_atomic_fetch_add(p, v, __ATOMIC_RELAXED, __HIP_MEMORY_SCOPE_AGENT); }
DEV unsigned xb_xcc_id() { return (unsigned)__builtin_amdgcn_s_getreg((3 << 11) | 20) & 0xFu; }
#define XB_SPIN(cond, bar) do { unsigned _sp = 0; while (cond) { __builtin_amdgcn_s_sleep(1); \
    if ((++_sp & 255u) == 0u) { if (xb_ld(&(bar)[XB_TMO])) break; if (_sp > XB_SPIN_CAP) { atomicAdd(&(bar)[XB_TMO], 1u); break; } } } } while (0)
struct XcdBarrier { unsigned* bar; unsigned x; volatile LAS unsigned* st; };
DEV XcdBarrier xcd_barrier_post(unsigned* bar, volatile LAS unsigned* st) {
    XcdBarrier b; b.bar = bar; b.x = xb_xcc_id(); b.st = st;
    if (threadIdx.x == 0) (void)xb_add(&bar[XB_XCNT(b.x)], 1u);
    return b;
}
DEV void xcd_barrier_complete(unsigned* bar, unsigned x, unsigned& nloc, unsigned& nx) {
    const unsigned G = gridDim.x * gridDim.y * gridDim.z;
    unsigned sum, cnt, mine, sp = 0u;
    for (;;) {
        sum = 0u; cnt = 0u; mine = 0u;
#pragma nounroll
        for (unsigned j = 0; j < 16; ++j) { const unsigned c = xb_ld(&bar[XB_XCNT(j)]); sum += c; cnt += (c > 0u) ? 1u : 0u; }
        mine = xb_ld(&bar[XB_XCNT(x)]);
        if (sum == G) break;
        __builtin_amdgcn_s_sleep(1);
        if ((++sp & 255u) == 0u) { if (xb_ld(&bar[XB_TMO])) break; if (sp > XB_SPIN_CAP) { atomicAdd(&bar[XB_TMO], 1u); break; } }
    }
    nloc = mine > 0u ? mine : 1u; nx = cnt > 0u ? cnt : 1u;
}
DEV void xcd_barrier1(const XcdBarrier& b) {
    asm volatile("s_waitcnt vmcnt(0)" ::: "memory");
    __syncthreads();
    if (threadIdx.x == 0) {
        unsigned* bar = b.bar;
        __builtin_amdgcn_s_waitcnt(0);
        unsigned nloc = b.st[0], nx = b.st[1];
        if (nloc == 0u) { xcd_barrier_complete(bar, b.x, nloc, nx); b.st[0] = nloc; b.st[1] = nx; }
        const unsigned old = xb_add(&bar[XB_XSUB(b.x)], 1u);
        const unsigned gen = old / nloc;
        if (old + 1u == (gen + 1u) * nloc) {
            __builtin_amdgcn_fence(__ATOMIC_RELEASE, "agent");
            asm volatile("s_waitcnt vmcnt(0)" ::: "memory");
            const unsigned og = xb_add(&bar[XB_TOP], 1u);
            const unsigned tg = og / nx;
            if (og + 1u == (tg + 1u) * nx) xb_add(&bar[XB_TOPGEN], 1u);
            else XB_SPIN(xb_ld(&bar[XB_TOPGEN]) == tg, bar);
            __builtin_amdgcn_fence(__ATOMIC_ACQUIRE, "agent");
            xb_add(&bar[XB_XGEN(b.x)], 1u);
            asm volatile("s_waitcnt vmcnt(0)" ::: "memory");
        } else {
            XB_SPIN(xb_ld(&bar[XB_XGEN(b.x)]) == gen, bar);
            __builtin_amdgcn_fence(__ATOMIC_ACQUIRE, "agent");
            asm volatile("s_waitcnt vmcnt(0)" ::: "memory");
        }
    }
    __syncthreads();
}

DEV void xcd_barrier(const XcdBarrier& b) { xcd_barrier1(b); if (REPMASK & 2048) xcd_barrier1(b); }
constexpr int LDS_BYTES = 148 * 1024;
DEV const void* ldptr(LAS char* shm, int i) {
    volatile LAS unsigned* pt = (volatile LAS unsigned*)(shm + LDS_BYTES - 512);
    const unsigned lo = __builtin_amdgcn_readfirstlane(pt[2 * i]), hi = __builtin_amdgcn_readfirstlane(pt[2 * i + 1]);
    return (const void*)(const __attribute__((address_space(1))) void*)(((unsigned long long)hi << 32) | lo);
}
#define PF(i) ((const float*)ldptr(shm, (i)))
struct Params {
    const float *x, *c, *norm_gain, *w_mod, *b_mod, *w_in, *lam_re, *lam_im, *log_dt, *sb_re, *sb_im, *sc_re, *sc_im, *ssm_d, *w_glu, *b_glu, *ssm_og,
        *conv_w, *conv_b, *wq, *wk, *wv, *w_gates, *b_ig, *b_fg, *m_ng, *m_skip, *w_out, *final_gain;
    float* out; char* ws;
};
constexpr int HALF_FLOATS = 56 * 1024 / 4;
constexpr size_t SLOT = (size_t)MTOK * DM * 2;
constexpr size_t W_IN_OFF = 0, W_GLU_OFF = 10485760, W_QKV_OFF = 12582912, W_OUT_OFF = 14155776, MOD_OFF = 20u << 20, IPRE_OFF = 21u << 20, LOGF_OFF = 22u << 20, BAR_OFF = 23u << 20, WF_OFF = 19u << 20, ROWSS_OFF = 24u << 20, RSTD_OFF = 25u << 20, XSS_OFF = 26u << 20;
#define REP(bit) _Pragma("nounroll") for (int rep_ = 0; rep_ < (((REPMASK) & (bit)) ? 2 : 1); ++rep_)
#define FOR_VB(nvb) for (int vb = blockIdx.x * 2 + HALF; vb < (nvb); vb += gridDim.x * 2)

#define WSB ((char*)ldptr(shm, 30))
#define SL(i) ((bf16_t*)(WSB + SLOT * (i)))
#define S7(off) (WSB + SLOT * 7 + (off))
#define WinT ((bf16_t*)S7(W_IN_OFF))
#define WgluT ((bf16_t*)S7(W_GLU_OFF))
#define WqkvT ((bf16_t*)S7(W_QKV_OFF))
#define WoutT ((bf16_t*)S7(W_OUT_OFF))
#define mod ((float*)S7(MOD_OFF))
#define gpart ((float*)S7(IPRE_OFF))
#define WfT ((bf16_t*)S7(WF_OFF))
#define rowss ((float*)S7(ROWSS_OFF))
#define rstdv ((float*)S7(RSTD_OFF))
#define xssv ((float*)S7(XSS_OFF))
#define MX SL(1)
#define OUTP ((float*)ldptr(shm, 29))
#define H SL(0)
#define U SL(1)
#define Y SL(2)
#define Z SL(3)
#define XC SL(4)
#define MI SL(5)
#define Q SL(6)
#define Kb SL(1)
#define V SL(2)
#define HC SL(5)
template <int l, int PART>
DEV void prep_layer(LAS char* shm) {
    const int wave = opaque_tid() >> 6, lane = opaque_tid() & 63;
    __syncthreads();
    {
        LAS float* scr = (LAS float*)(shm + wave * 16640);
        const float* Win = PF(5) + (size_t)l * DM * INC;
        constexpr int I_IN = 16 * 80, I_GLU = 16 * 16, I_QKV = 12 * 16, I_OUT = 32 * 16;
        constexpr int LO = (PART & 1) ? 0 : (I_IN + I_GLU + I_QKV), HI = (PART & 2) ? (I_IN + I_GLU + I_QKV + I_OUT) : (I_IN + I_GLU + I_QKV);
        for (int it = LO + blockIdx.x * 8 + wave; it < HI; it += gridDim.x * 8) {
            int r = it;
            if (r < I_IN) { transpose_item(Win, INC, INC, WinT, DM, scr, r, lane); continue; } r -= I_IN;
            if (r < I_GLU) { transpose_item(PF(14) + (size_t)l * DM * DM, DM, DM, WgluT, DM, scr, r, lane); continue; } r -= I_GLU;
            if (r < I_QKV) { const int mat = r / 16, which = mat >> 2, hd = mat & 3;
                const float* W = sel3(which, PF(19), PF(20), PF(21)) + ((size_t)l * NH + hd) * DH * DH;
                transpose_item(W, DH, DH, WqkvT + (size_t)mat * DH * DH, DH, scr, r % 16, lane); continue; } r -= I_QKV;
            transpose_item(PF(27) + (size_t)l * 2 * DM * DM, DM, DM, WoutT, 2 * DM, scr, r, lane);
        }
    }
    if (PART & 1) {
        wfold_prep(WfT, PF(19) + (size_t)l * NH * DH * DH, PF(20) + (size_t)l * NH * DH * DH, PF(21) + (size_t)l * NH * DH * DH, PF(22) + (size_t)l * 3 * DM * 8);
        __syncthreads();
        s5_tables(shm, (char*)SL(3), PF(6) + l * NG * NP, PF(7) + l * NG * NP, PF(8) + l * NG, PF(9) + (size_t)l * NG * NP * GC, PF(10) + (size_t)l * NG * NP * GC,
                  PF(11) + (size_t)l * NG * GC * NP, PF(12) + (size_t)l * NG * GC * NP);
    }
    __syncthreads();
}
template <int l>
DEV void layer_body(LAS char* shm, const XcdBarrier& gbar) {
        const float* xin = (l == 0) ? PF(0) : OUTP;
        const float* modl = mod + (size_t)l * BATCH * 3 * DM;
        if (l == 0) { REP(1) norm_rows(xin, PF(2) + l * DM, modl, H); xcd_barrier(gbar); }
        REP(2) { g8::SchedG1 S_{H, WinT, (int)blockIdx.x, (int)gridDim.x}; g8::EpiG1 E_{U, MI}; g8::gemm_phase(shm, S_, E_); }
        if (l == 1) prep_layer<1, 2>(shm);
        xcd_barrier(gbar);
        REP(256) s5_phase(shm, U, Y, (const char*)SL(3), PF(13) + l * DM);
        REP(8) xc_gates_phase(shm, MI, XC, WfT, PF(17) + l * 4 * DM, PF(18) + l * DM, gpart);
        xcd_barrier(gbar);
        REP(4) { g8::SchedGlu S_{Y, WgluT, (int)blockIdx.x, (int)gridDim.x}; g8::EpiGlu E_{Y, Z, PF(15) + l * DM, rowss}; g8::gemm_phase(shm, S_, E_); }
        xcd_barrier(gbar);
        REP(16) { g8::SchedQkv S_{XC, MI, WqkvT, (int)blockIdx.x, (int)gridDim.x}; g8::EpiQkv E_{Q, Kb, V}; g8::gemm_phase(shm, S_, E_); }
        xcd_barrier(gbar);
        rstd_rows(rowss, rstdv);
        REP(32) mlstm_phase<0>(shm, Q, Kb, V, gpart, PF(23) + l * 4, PF(24) + l * 4, HC);
#ifdef MLPROBE
        if (l == 0) mlstm_phase<MLPROBE>(shm, Q, Kb, V, gpart, PF(23) + l * 4, PF(24) + l * 4, (bf16_t*)OUTP);
#endif
        xcd_barrier(gbar);
        { g8::SchedG2s S_{H, WinT, (int)blockIdx.x}; g8::EpiG2s E_{Z, rstdv, PF(16) + l * DM, MX}; g8::gemm_phase(shm, S_, E_); }
        { g8::SchedG2m S_{H, WinT, (int)blockIdx.x}; g8::EpiG2m E_{HC, XC, PF(25) + l * DM, PF(26) + l * DM, MX}; g8::gemm_phase(shm, S_, E_); }
        xcd_barrier(gbar);
        if (l == 0) { g8::SchedOut S_{MX, WoutT, (int)blockIdx.x, (int)gridDim.x};
            g8::EpiOutN<false> E_{xin, OUTP, modl + 2 * DM, PF(2) + DM, mod + (size_t)BATCH * 3 * DM, H, xssv, (unsigned*)S7(BAR_OFF) + 4096, (unsigned*)S7(BAR_OFF) + XB_TMO}; g8::gemm_phase(shm, S_, E_);
            prep_layer<1, 1>(shm); }
        else { g8::SchedOut S_{MX, WoutT, (int)blockIdx.x, (int)gridDim.x};
            g8::EpiOutN<true> E_{xin, OUTP, modl + 2 * DM, PF(28), mod, H, xssv + (size_t)MTOK * 4, (unsigned*)S7(BAR_OFF) + 4096 + 4096, (unsigned*)S7(BAR_OFF) + XB_TMO}; g8::gemm_phase(shm, S_, E_); }
        xcd_barrier(gbar);
    }
__global__ void __launch_bounds__(512, 2) mega(Params Pk) {
    extern __shared__ __attribute__((aligned(16))) unsigned char lds_raw[];
    {
        volatile LAS unsigned long long* pt = (volatile LAS unsigned long long*)((LAS char*)lds_raw + LDS_BYTES - 512);
        if (threadIdx.x == 0) {
            pt[0] = (unsigned long long)Pk.x;
            pt[1] = (unsigned long long)Pk.c;
            pt[2] = (unsigned long long)Pk.norm_gain;
            pt[3] = (unsigned long long)Pk.w_mod;
            pt[4] = (unsigned long long)Pk.b_mod;
            pt[5] = (unsigned long long)Pk.w_in;
            pt[6] = (unsigned long long)Pk.lam_re;
            pt[7] = (unsigned long long)Pk.lam_im;
            pt[8] = (unsigned long long)Pk.log_dt;
            pt[9] = (unsigned long long)Pk.sb_re;
            pt[10] = (unsigned long long)Pk.sb_im;
            pt[11] = (unsigned long long)Pk.sc_re;
            pt[12] = (unsigned long long)Pk.sc_im;
            pt[13] = (unsigned long long)Pk.ssm_d;
            pt[14] = (unsigned long long)Pk.w_glu;
            pt[15] = (unsigned long long)Pk.b_glu;
            pt[16] = (unsigned long long)Pk.ssm_og;
            pt[17] = (unsigned long long)Pk.conv_w;
            pt[18] = (unsigned long long)Pk.conv_b;
            pt[19] = (unsigned long long)Pk.wq;
            pt[20] = (unsigned long long)Pk.wk;
            pt[21] = (unsigned long long)Pk.wv;
            pt[22] = (unsigned long long)Pk.w_gates;
            pt[23] = (unsigned long long)Pk.b_ig;
            pt[24] = (unsigned long long)Pk.b_fg;
            pt[25] = (unsigned long long)Pk.m_ng;
            pt[26] = (unsigned long long)Pk.m_skip;
            pt[27] = (unsigned long long)Pk.w_out;
            pt[28] = (unsigned long long)Pk.final_gain;
            pt[29] = (unsigned long long)Pk.out; pt[30] = (unsigned long long)Pk.ws;
        }
    }
    __syncthreads();
    LAS char* shm = (LAS char*)lds_raw;
    float* ldsf = (float*)lds_raw + HALF * HALF_FLOATS;
    volatile LAS unsigned* bst = (volatile LAS unsigned*)(shm + LDS_BYTES - 16);
    if (threadIdx.x < 4) bst[threadIdx.x] = 0u;
    __syncthreads();
    const XcdBarrier gbar = xcd_barrier_post((unsigned*)((char*)ldptr(shm, 30) + SLOT * 7 + BAR_OFF), bst);
    REP(4096) mod_phase(shm, PF(1), PF(3), PF(4), mod);
    prep_layer<0, 3>(shm);
    xcd_barrier(gbar);
    layer_body<0>(shm, gbar);
    layer_body<1>(shm, gbar);
}

#undef WSB
#undef SL
#undef S7
#undef WinT
#undef WgluT
#undef WqkvT
#undef WoutT
#undef mod
#undef gpart
#undef WfT
#undef rowss
#undef rstdv
#undef xssv
#undef MX
#undef OUTP
#undef H
#undef U
#undef Y
#undef Z
#undef XC
#undef MI
#undef Q
#undef Kb
#undef V
#undef HC
extern "C" void kernel_launch(void* const* d_in, const int* in_sizes, int n_in, void* d_out, int out_size, void* d_ws, size_t ws_size, hipStream_t stream) {
    static int grid_blocks = 0;
    if (!grid_blocks) {
        int dev = 0, cus = 0, per_cu = 0;
        (void)hipGetDevice(&dev);
        (void)hipDeviceGetAttribute(&cus, hipDeviceAttributeMultiprocessorCount, dev);
        (void)hipFuncSetAttribute((const void*)mega, hipFuncAttributeMaxDynamicSharedMemorySize, LDS_BYTES);
        (void)hipOccupancyMaxActiveBlocksPerMultiprocessor(&per_cu, (const void*)mega, 512, LDS_BYTES);
        grid_blocks = cus;
        fprintf(stderr, "mega: cus=%d occupancy per_cu=%d grid=%d\n", cus, per_cu, grid_blocks);
    }
    (void)hipMemsetAsync((char*)d_ws + SLOT * 7 + BAR_OFF, 0, 65536, stream);
    Params P{};
    const float** pp = (const float**)&P;
    for (int i = 0; i < 29; ++i) pp[i] = (const float*)d_in[i];
    P.out = (float*)d_out; P.ws = (char*)d_ws;
    void* args[] = {&P};
    hipError_t e = hipLaunchCooperativeKernel((const void*)mega, dim3(grid_blocks), dim3(512), args, LDS_BYTES, stream);
    if (e != hipSuccess) fprintf(stderr, "cooperative launch failed: %s (grid %d)\n", hipGetErrorString(e), grid_blocks);
}
```

```cpp
#include <hip/hip_runtime.h>
#include <cstdio>
#include <cstdint>
#include <hip/hip_cooperative_groups.h>
namespace cg = cooperative_groups;

#ifndef REPMASK
#define REPMASK 0
#endif
typedef unsigned short bf16_t;
#define DEV __device__ __forceinline__

constexpr int BATCH = 8, SEQ = 2048, DM = 1024, MTOK = BATCH * SEQ;
constexpr int NG = 64, NP = 64, GC = 16, NH = 4, DH = 256, CHUNK = 64, INC = 5120;
constexpr float EPS = 1e-6f;

DEV int opaque_tid() { int t = threadIdx.x; asm volatile("" : "+v"(t)); return t; }
#define TIDH (opaque_tid() & 255)
#define HALF (opaque_tid() >> 8)
DEV float bf2f(bf16_t v) { return __uint_as_float(((unsigned)v) << 16); }
typedef __bf16 bf16n2 __attribute__((ext_vector_type(2)));
typedef float f32n2 __attribute__((ext_vector_type(2)));
DEV bf16_t f2bf(float f) { __bf16 b = (__bf16)f; return __builtin_bit_cast(unsigned short, b); }
DEV unsigned pk2(float lo, float hi) { f32n2 v = {lo, hi}; bf16n2 b = __builtin_convertvector(v, bf16n2); return __builtin_bit_cast(unsigned, b); }
DEV float sigmoidf_(float x) { return __builtin_amdgcn_rcpf(1.f + __expf(-x)); }
DEV float siluf_(float x) { return x * __builtin_amdgcn_rcpf(1.f + __expf(-x)); }
DEV float geluf_(float x) { const float t2 = 1.5957691216057308f * (x + 0.044715f * x * x * x); return x * __builtin_amdgcn_rcpf(1.f + __expf(-t2)); }
DEV float logsigmoidf_(float x) { return fminf(x, 0.f) - log1pf(__expf(-fabsf(x))); }

DEV float wave_sum(float v) {
#pragma unroll
    for (int o = 1; o < 64; o <<= 1) v += __shfl_xor(v, o);
    return v;
}
DEV float block_sum256(float v, float* red) {
    v = wave_sum(v);
    __syncthreads();
    if ((TIDH & 63) == 0) red[TIDH >> 6] = v;
    __syncthreads();
    return red[0] + red[1] + red[2] + red[3];
}

DEV void k_mod(int vb, float* ldsf, const float* c, const float* w_mod, const float* b_mod, float* mod) {
    float (*sc)[DM] = (float (*)[DM])ldsf;
    const int l = vb / 12, n = (vb % 12) * 256 + TIDH;
    __syncthreads();
    for (int i = TIDH; i < BATCH * DM; i += 256) sc[i / DM][i % DM] = siluf_(c[i]);
    __syncthreads();
    float acc[BATCH];
#pragma unroll
    for (int b = 0; b < BATCH; ++b) acc[b] = 0.f;
    const float* W = w_mod + (size_t)l * DM * 3 * DM;
    for (int k = 0; k < DM; ++k) {
        float w = W[(size_t)k * 3 * DM + n];
#pragma unroll
        for (int b = 0; b < BATCH; ++b) acc[b] += sc[b][k] * w;
    }
#pragma unroll
    for (int b = 0; b < BATCH; ++b) mod[((size_t)l * BATCH + b) * 3 * DM + n] = acc[b] + b_mod[l * 3 * DM + n];
}

DEV void k_norm_mod(int vb, float* red, const float* x, const float* gain, const float* mod  , bf16_t* h) {
    const int m = vb, b = m / SEQ, t = TIDH;
    const float4 v = ((const float4*)(x + (size_t)m * DM))[t];
    float ss = v.x * v.x + v.y * v.y + v.z * v.z + v.w * v.w;
    ss = block_sum256(ss, red);
    const float rstd = rsqrtf(ss * (1.f / DM) + EPS);
    const float* shift = mod + (size_t)b * 3 * DM;
    const float* scale = shift + DM;
    float xv[4] = {v.x, v.y, v.z, v.w};
#pragma unroll
    for (int i = 0; i < 4; ++i) {
        int n = t * 4 + i;
        float y = xv[i] * rstd * gain[n] * (1.f + scale[n]) + shift[n];
        h[(size_t)m * DM + n] = f2bf(y);
    }
}

DEV void k_s5(int item, float* ldsf, const bf16_t* u, bf16_t* y, const float* lam_re, const float* lam_im, const float* log_dt,
                                           const float* b_re, const float* b_im, const float* c_re, const float* c_im, const float* dskip) {
    const int tid_ = opaque_tid();
    float (*part)[17] = (float (*)[17])(ldsf + (tid_ >> 6) * 64 * 17);
    const int g = item & 63, b = item >> 6, p = tid_ & 63;
    const double lr = lam_re[g * NP + p], li = lam_im[g * NP + p], dt = exp((double)log_dt[g]);
    const double er = exp(lr * dt);
    const double ard = er * cos(li * dt), aid = er * sin(li * dt);
    const double dr = ard - 1.0, di = aid, den = lr * lr + li * li;
    const double cr = (dr * lr + di * li) / den, ci = (di * lr - dr * li) / den;
    float bbr[16], bbi[16], ccr[16], cci[16];
#pragma unroll
    for (int c = 0; c < 16; ++c) {
        const double br = b_re[(g * NP + p) * GC + c], bi = b_im[(g * NP + p) * GC + c];
        bbr[c] = (float)(cr * br - ci * bi); bbi[c] = (float)(cr * bi + ci * br);
        ccr[c] = c_re[(g * GC + c) * NP + p]; cci[c] = c_im[(g * GC + c) * NP + p];
    }
    const float ar = (float)ard, ai = (float)aid;
    const float dsk = dskip[g * GC + (p & 15)];
    float sr = 0.f, si = 0.f;
    for (int t = 0; t < SEQ; ++t) {
        const bf16_t* up = u + (size_t)(b * SEQ + t) * DM + g * GC;
        const uint4 u0 = *(const uint4*)up, u1 = *(const uint4*)(up + 8);
        float uf[16];
        uf[0] = bf2f(u0.x & 0xffff); uf[1] = bf2f(u0.x >> 16); uf[2] = bf2f(u0.y & 0xffff); uf[3] = bf2f(u0.y >> 16);
        uf[4] = bf2f(u0.z & 0xffff); uf[5] = bf2f(u0.z >> 16); uf[6] = bf2f(u0.w & 0xffff); uf[7] = bf2f(u0.w >> 16);
        uf[8] = bf2f(u1.x & 0xffff); uf[9] = bf2f(u1.x >> 16); uf[10] = bf2f(u1.y & 0xffff); uf[11] = bf2f(u1.y >> 16);
        uf[12] = bf2f(u1.z & 0xffff); uf[13] = bf2f(u1.z >> 16); uf[14] = bf2f(u1.w & 0xffff); uf[15] = bf2f(u1.w >> 16);
        float bur = 0.f, bui = 0.f;
#pragma unroll
        for (int c = 0; c < 16; ++c) { bur += bbr[c] * uf[c]; bui += bbi[c] * uf[c]; }
        const float nr = ar * sr - ai * si + bur, ni = ar * si + ai * sr + bui;
        sr = nr; si = ni;
#pragma unroll
        for (int c = 0; c < 16; ++c) part[p][c] = ccr[c] * sr - cci[c] * si;
        asm volatile("s_waitcnt lgkmcnt(0)" ::: "memory");
        float s = 0.f;
#pragma unroll
        for (int k = 0; k < 16; ++k) s += part[(p >> 4) * 16 + k][p & 15];
        s += __shfl_xor(s, 16); s += __shfl_xor(s, 32);
        if (p < 16) {
            const float yv = s + dsk * bf2f(up[p]);
            y[(size_t)(b * SEQ + t) * DM + g * GC + p] = f2bf(geluf_(yv));
        }
        asm volatile("s_waitcnt lgkmcnt(0)" ::: "memory");
    }
}

DEV void k_ssm_post(int vb, float* red, bf16_t* z, const bf16_t* sg, const float* gain) {
    const int m = vb, t = TIDH;
    float zv[4]; float ss = 0.f;
#pragma unroll
    for (int i = 0; i < 4; ++i) { zv[i] = bf2f(z[(size_t)m * DM + t * 4 + i]); ss += zv[i] * zv[i]; }
    ss = block_sum256(ss, red);
    const float rstd = rsqrtf(ss * (1.f / DM) + EPS);
#pragma unroll
    for (int i = 0; i < 4; ++i) {
        const int n = t * 4 + i;
        z[(size_t)m * DM + n] = f2bf(zv[i] * rstd * gain[n] * siluf_(bf2f(sg[(size_t)m * DM + n])));
    }
}

DEV float conv_xc(const bf16_t* mi, int m, int n, const float* cw, const float* cb) {
    const int t = m % SEQ;
    float acc = cb[n];
#pragma unroll
    for (int j = 0; j < 4; ++j) {
        const int tt = t - 3 + j;
        if (tt >= 0) acc += bf2f(mi[(size_t)(m - 3 + j) * DM + n]) * cw[j * DM + n];
    }
    return siluf_(acc);
}
DEV void k_conv(int vb, const bf16_t* mi, bf16_t* xc, const float* cw, const float* cb) {
    const size_t idx = (size_t)vb * 256 + TIDH;
    const int m = (int)(idx / DM), n = (int)(idx % DM);
    xc[idx] = f2bf(conv_xc(mi, m, n, cw, cb));
}

DEV void k_gates(int vb, float* ldsf, const bf16_t* q, const bf16_t* k, const bf16_t* v, const float* wg  , const float* bi, const float* bfg,
                                               float* ipre, float* logf) {
    float (*red)[8] = (float (*)[8])ldsf;
    const int m = vb, t = TIDH;
    __syncthreads();
    float acc[8];
#pragma unroll
    for (int j = 0; j < 8; ++j) acc[j] = 0.f;
    for (int e = t; e < 3 * DM; e += 256) {
        const bf16_t* src = (e < DM) ? q : (e < 2 * DM ? k : v);
        const float xv = bf2f(src[(size_t)m * DM + (e & (DM - 1))]);
#pragma unroll
        for (int j = 0; j < 8; ++j) acc[j] += xv * wg[e * 8 + j];
    }
#pragma unroll
    for (int j = 0; j < 8; ++j) acc[j] = wave_sum(acc[j]);
    if ((t & 63) == 0) {
#pragma unroll
        for (int j = 0; j < 8; ++j) red[t >> 6][j] = acc[j];
    }
    __syncthreads();
    if (t < 8) {
        const float s = red[0][t] + red[1][t] + red[2][t] + red[3][t];
        if (t < 4) ipre[(size_t)m * 4 + t] = s + bi[t];
        else logf[(size_t)m * 4 + (t - 4)] = logsigmoidf_(s + bfg[t - 4]);
    }
}

DEV void k_mlstm(int vb, float* ldsf, const bf16_t* q, const bf16_t* k, const bf16_t* v, const float* ipre, const float* logf, bf16_t* hc) {
    float (*Cs)[257] = (float (*)[257])ldsf;
    float (*St)[65] = (float (*)[65])(ldsf + 32 * 257);
    float* nvec = ldsf + 32 * 257 + 64 * 65;
    float* bcum = nvec + 256; float* ig = bcum + 64; float* mt = ig + 64; float* winter = mt + 64; float* ws_ = winter + 64; float* hden = ws_ + 64;
    float* sc = hden + 64;
    const int tid = TIDH;
    const int vs = vb & 7, h = (vb >> 3) & 3, b = vb >> 5;
    __syncthreads();
    for (int i = tid; i < 32 * 257; i += 256) (&Cs[0][0])[i] = 0.f;
    nvec[tid] = 0.f;
    if (tid == 0) sc[0] = 0.f;
    __syncthreads();
    const size_t base = (size_t)b * SEQ * DM + h * DH;
    for (int j = 0; j < SEQ / CHUNK; ++j) {
        const size_t cb = base + (size_t)j * CHUNK * DM;
        const int m0 = b * SEQ + j * CHUNK;
        if (tid < 64) {
            ig[tid] = ipre[(size_t)(m0 + tid) * 4 + h];
            ws_[tid] = logf[(size_t)(m0 + tid) * 4 + h];
        }
        __syncthreads();
        if (tid < 64) { float s = 0.f; for (int i = 0; i <= tid; ++i) s += ws_[i]; bcum[tid] = s; }
        __syncthreads();
        const float m_prev = sc[0];
        if (tid < 64) {
            const float m_inter = bcum[tid] + m_prev;
            float mx = -INFINITY;
            for (int s = 0; s <= tid; ++s) mx = fmaxf(mx, bcum[tid] - bcum[s] + ig[s]);
            const float m = fmaxf(m_inter, mx);
            mt[tid] = m; winter[tid] = __expf(m_inter - m);
        }
        __syncthreads();
        for (int idx = tid; idx < 4096; idx += 256) {
            const int t = idx >> 6, s = idx & 63;
            float r = 0.f;
            if (s <= t) {
                const bf16_t* qp = q + cb + (size_t)t * DM; const bf16_t* kp = k + cb + (size_t)s * DM;
                float dot = 0.f;
                for (int d = 0; d < DH; d += 8) {
                    const uint4 qa = *(const uint4*)(qp + d), ka = *(const uint4*)(kp + d);
                    dot += bf2f(qa.x & 0xffff) * bf2f(ka.x & 0xffff) + bf2f(qa.x >> 16) * bf2f(ka.x >> 16);
                    dot += bf2f(qa.y & 0xffff) * bf2f(ka.y & 0xffff) + bf2f(qa.y >> 16) * bf2f(ka.y >> 16);
                    dot += bf2f(qa.z & 0xffff) * bf2f(ka.z & 0xffff) + bf2f(qa.z >> 16) * bf2f(ka.z >> 16);
                    dot += bf2f(qa.w & 0xffff) * bf2f(ka.w & 0xffff) + bf2f(qa.w >> 16) * bf2f(ka.w >> 16);
                }
                r = dot * __expf(bcum[t] - bcum[s] + ig[s] - mt[t]);
            }
            St[t][s] = r;
        }
        __syncthreads();
        if (tid < 64) {
            const bf16_t* qp = q + cb + (size_t)tid * DM;
            float dn = 0.f;
            for (int d = 0; d < DH; ++d) dn += nvec[d] * bf2f(qp[d]);
            float sm = 0.f;
            for (int s = 0; s < 64; ++s) sm += St[tid][s];
            const float den = winter[tid] * dn + sm;
            hden[tid] = fmaxf(fabsf(den), __expf(-mt[tid]));
        }
        __syncthreads();
        for (int idx = tid; idx < 2048; idx += 256) {
            const int t = idx >> 5, vv = idx & 31;
            const bf16_t* qp = q + cb + (size_t)t * DM;
            float a = 0.f;
            for (int d = 0; d < DH; ++d) a += Cs[vv][d] * bf2f(qp[d]);
            float s2 = 0.f;
            for (int s = 0; s < 64; ++s) s2 += St[t][s] * bf2f(v[cb + (size_t)s * DM + vs * 32 + vv]);
            const float num = winter[t] * a + s2;
            hc[cb + (size_t)t * DM + vs * 32 + vv] = f2bf(num / hden[t]);
        }
        __syncthreads();
        const float b_tot = bcum[63];
        if (tid < 64) ws_[tid] = b_tot - bcum[tid] + ig[tid];
        __syncthreads();
        if (tid == 0) {
            float mx = b_tot + m_prev;
            for (int s = 0; s < 64; ++s) mx = fmaxf(mx, ws_[s]);
            sc[1] = __expf(b_tot + m_prev - mx); sc[0] = mx;
        }
        __syncthreads();
        const float m_next = sc[0], decay = sc[1];
        float myw = 0.f;
        if (tid < 64) myw = __expf(ws_[tid] - m_next);
        __syncthreads();
        if (tid < 64) ws_[tid] = myw;
        __syncthreads();
        for (int idx = tid; idx < 32 * 256; idx += 256) {
            const int vv = idx >> 8, d = idx & 255;
            float a = 0.f;
            for (int s = 0; s < 64; ++s) a += ws_[s] * bf2f(v[cb + (size_t)s * DM + vs * 32 + vv]) * bf2f(k[cb + (size_t)s * DM + d]);
            Cs[vv][d] = decay * Cs[vv][d] + a;
        }
        {
            float a = 0.f;
            for (int s = 0; s < 64; ++s) a += ws_[s] * bf2f(k[cb + (size_t)s * DM + tid]);
            nvec[tid] = decay * nvec[tid] + a;
        }
        __syncthreads();
    }
}

DEV void k_mlstm_post(int vb, bf16_t* hc, const bf16_t* mo, const bf16_t* mg, const bf16_t* mi, const float* cw, const float* cb,
                                                    const float* ngain, const float* skip) {
    const int m = vb, t = TIDH;
    float hv[4]; float s = 0.f;
#pragma unroll
    for (int i = 0; i < 4; ++i) {
        const size_t o = (size_t)m * DM + t * 4 + i;
        hv[i] = bf2f(hc[o]) * sigmoidf_(bf2f(mo[o])); s += hv[i];
    }
    const float mu = wave_sum(s) * (1.f / DH);
    float s2 = 0.f;
#pragma unroll
    for (int i = 0; i < 4; ++i) { hv[i] -= mu; s2 += hv[i] * hv[i]; }
    const float rstd = rsqrtf(wave_sum(s2) * (1.f / DH) + EPS);
#pragma unroll
    for (int i = 0; i < 4; ++i) {
        const int n = t * 4 + i; const size_t o = (size_t)m * DM + n;
        const float xc = conv_xc(mi, m, n, cw, cb);
        const float hn = hv[i] * rstd * ngain[n] + skip[n] * xc;
        hc[o] = f2bf(hn * siluf_(bf2f(mg[o])));
    }
}

DEV void k_final(int vb, float* red, float* x, const float* gain) {
    const int m = vb, t = TIDH;
    float4 v = ((float4*)(x + (size_t)m * DM))[t];
    float ss = v.x * v.x + v.y * v.y + v.z * v.z + v.w * v.w;
    ss = block_sum256(ss, red);
    const float rstd = rsqrtf(ss * (1.f / DM) + EPS);
    const float4 g = ((const float4*)gain)[t];
    v.x *= rstd * g.x; v.y *= rstd * g.y; v.z *= rstd * g.z; v.w *= rstd * g.w;
    ((float4*)(x + (size_t)m * DM))[t] = v;
}


#define LAS __attribute__((address_space(3)))
typedef short bf16x8 __attribute__((ext_vector_type(8)));
typedef float f32x4 __attribute__((ext_vector_type(4)));
typedef short s16x4 __attribute__((ext_vector_type(4)));
typedef unsigned u32x4 __attribute__((ext_vector_type(4)));
typedef unsigned u32x2 __attribute__((ext_vector_type(2)));
typedef float f32x2 __attribute__((ext_vector_type(2)));
#define WAIT_V(n) asm volatile("s_waitcnt vmcnt(" #n ")" ::: "memory")
#define WAIT_L(n) asm volatile("s_waitcnt lgkmcnt(" #n ")" ::: "memory")
#define SCHED() __builtin_amdgcn_sched_barrier(0)

DEV int lds_byte(int r, int c) { int st = (r >> 4) * 2 + (c >> 5), ob = (r & 15) * 64 + (c & 31) * 2; return st * 1024 + (ob ^ (((ob >> 9) & 1) << 5)); }
DEV void stage_rc(int b, int& R, int& C) { int st = b >> 10, sb = b & 1023, swz = sb ^ (((sb >> 9) & 1) << 5); R = (st >> 1) * 16 + swz / 64; C = (st & 1) * 32 + (swz % 64) / 2; }
template <class T> DEV T* sel3(int w, T* p0, T* p1, T* p2) { return p0 + ((w >= 1) ? (p1 - p0) : 0) + ((w >= 2) ? (p2 - p1) : 0); }
DEV void unpack8(const uint4 v, float* f) {
    f[0] = bf2f((bf16_t)(v.x & 0xffff)); f[1] = bf2f((bf16_t)(v.x >> 16)); f[2] = bf2f((bf16_t)(v.y & 0xffff)); f[3] = bf2f((bf16_t)(v.y >> 16));
    f[4] = bf2f((bf16_t)(v.z & 0xffff)); f[5] = bf2f((bf16_t)(v.z >> 16)); f[6] = bf2f((bf16_t)(v.w & 0xffff)); f[7] = bf2f((bf16_t)(v.w >> 16));
}
DEV uint4 pack8(const float* f) { return make_uint4(pk2(f[0], f[1]), pk2(f[2], f[3]), pk2(f[4], f[5]), pk2(f[6], f[7])); }
DEV uint2 pack4(f32x4 v) { uint2 r; r.x = pk2(v[0], v[1]); r.y = pk2(v[2], v[3]); return r; }

struct GemmCtx { int wid, lane, wr, wc, fr, fq; int sR[4], sC[4]; };
DEV GemmCtx gemm_ctx() {
    GemmCtx c; const int tid = opaque_tid();
    c.wid = __builtin_amdgcn_readfirstlane(tid >> 6); c.lane = tid & 63; c.wr = c.wid >> 2; c.wc = c.wid & 3; c.fr = c.lane & 15; c.fq = c.lane >> 4;
#pragma unroll
    for (int i = 0; i < 4; ++i) stage_rc(c.wid * 1024 + i * 8192 + c.lane * 16, c.sR[i], c.sC[i]);
    return c;
}
DEV void gemm_mainloop(LAS char* shm, const GemmCtx& c, const bf16_t* A1row, const bf16_t* A2row, int ktsplit, int lda, const bf16_t* Bb, int ldb, int nt, f32x4 (&acc)[8][4]) {
    constexpr int TILE_B = 256 * 64 * 2, STAGE_B = 2 * TILE_B;
    const int wid = c.wid, wr = c.wr, wc = c.wc, fr = c.fr, fq = c.fq;
    unsigned voA[4], voB[4];
#pragma unroll
    for (int i = 0; i < 4; ++i) { voA[i] = (unsigned)(c.sR[i] * lda + c.sC[i]) * 2u; voB[i] = (unsigned)(c.sR[i] * ldb + c.sC[i]) * 2u; asm volatile("" : "+v"(voA[i]), "+v"(voB[i])); }
#define GLDS_STAGE(buf, kt) do { const char* Ak_ = (const char*)(((kt) < ktsplit) ? (A1row + (kt) * 64) : (A2row + ((kt) - ktsplit) * 64)); const char* Bk_ = (const char*)(Bb + (kt) * 64); \
        _Pragma("unroll") for (int i = 0; i < 4; ++i) { \
            __builtin_amdgcn_global_load_lds((const unsigned*)(Ak_ + voA[i]), (LAS unsigned*)(shm + (buf) * STAGE_B + wid * 1024 + i * 8192), 16, 0, 0); \
            __builtin_amdgcn_global_load_lds((const unsigned*)(Bk_ + voB[i]), (LAS unsigned*)(shm + (buf) * STAGE_B + TILE_B + wid * 1024 + i * 8192), 16, 0, 0); } } while (0)
#pragma unroll
    for (int m = 0; m < 8; ++m)
#pragma unroll
        for (int n = 0; n < 4; ++n) acc[m][n] = (f32x4){0.f, 0.f, 0.f, 0.f};
    GLDS_STAGE(0, 0); WAIT_V(0); __syncthreads();
#pragma nounroll
    for (int kt = 0; kt < nt; ++kt) {
        const int cur = kt & 1;
        if (kt + 1 < nt) GLDS_STAGE(cur ^ 1, kt + 1);
#pragma unroll
        for (int ks = 0; ks < 2; ++ks) {
            bf16x8 At[8], Bf[4];
#pragma unroll
            for (int m = 0; m < 8; ++m) At[m] = *(const LAS bf16x8*)(shm + cur * STAGE_B + lds_byte(wr * 128 + m * 16 + fr, ks * 32 + fq * 8));
#pragma unroll
            for (int n = 0; n < 4; ++n) Bf[n] = *(const LAS bf16x8*)(shm + cur * STAGE_B + TILE_B + lds_byte(wc * 64 + n * 16 + fr, ks * 32 + fq * 8));
#pragma unroll
            for (int m = 0; m < 8; ++m)
#pragma unroll
                for (int n = 0; n < 4; ++n) acc[m][n] = __builtin_amdgcn_mfma_f32_16x16x32_bf16(Bf[n], At[m], acc[m][n], 0, 0, 0);
            SCHED();
        }
        WAIT_V(0); __syncthreads();
    }
#undef GLDS_STAGE
}
DEV void tile_map(int t, int nN, int& pm, int& pn) {
    const int base = t & ~255, loc = t & 255;
    const int w = base + (loc & 7) * 32 + (loc >> 3);
    const int nig = 8 * nN, gid = w / nig;
    pm = gid * 8 + (w % nig) % 8; pn = (w % nig) / 8;
}
template <class Prob>
DEV void gemm_phase(LAS char* shm, const Prob& pb) {
    const GemmCtx c = gemm_ctx();
    const int nN = pb.nN, ntiles = 64 * nN;
    for (int t = blockIdx.x; t < ntiles; t += gridDim.x) {
        int pm, pn; tile_map(t, nN, pm, pn);
        const int brow = pm * 256, bcol = pn * 256;
        f32x4 acc[8][4];
        gemm_mainloop(shm, c, pb.a1(pn) + (long)brow * Prob::lda, pb.a2(pn) + (long)brow * Prob::lda, Prob::ktsplit, Prob::lda, pb.bptr(pn), Prob::ldb, Prob::K / 64, acc);
        pb.epi_begin(shm, c, pn, brow);
#pragma unroll
        for (int m = 0; m < 8; ++m)
#pragma unroll
            for (int n = 0; n < 4; ++n) pb.epi(pn, brow + c.wr * 128 + m * 16 + c.fr, bcol + c.wc * 64 + n * 16 + c.fq * 4, acc[m][n]);
        pb.epi_end(c, pn, brow, acc);
    }
}

struct ProbG1 {
    static constexpr int K = 1024, lda = 1024, ldb = 1024, ktsplit = 1 << 20;
    const bf16_t* H; const bf16_t* Wt; bf16_t* U; bf16_t* MI; int nN;
    DEV const bf16_t* a1(int pn) const { return H; }
    DEV const bf16_t* a2(int pn) const { return H; }
    DEV const bf16_t* bptr(int pn) const { return Wt + (long)((pn < 4) ? pn * 256 : 2048 + (pn - 4) * 256) * 1024; }
    DEV void epi_begin(LAS char*, const GemmCtx&, int, int) const {}
    DEV void epi(int pn, int row, int col, f32x4 v) const { bf16_t* C = (pn < 4) ? U : MI; *(uint2*)(C + (size_t)row * DM + (col & 1023)) = pack4(v); }
    DEV void epi_end(const GemmCtx&, int, int, f32x4 (&)[8][4]) const {}
};
struct ProbGlu {
    static constexpr int K = 1024, lda = 1024, ldb = 1024, ktsplit = 1 << 20;
    const bf16_t* Y; const bf16_t* Wt; bf16_t* Z; const float* bias; float* rowss; int nN;
    DEV const bf16_t* a1(int pn) const { return Y; }
    DEV const bf16_t* a2(int pn) const { return Y; }
    DEV const bf16_t* bptr(int pn) const { return Wt + (long)pn * 256 * 1024; }
    DEV void epi_begin(LAS char*, const GemmCtx&, int, int) const {}
    DEV void epi(int pn, int row, int col, f32x4 v) const {}
    DEV void epi_end(const GemmCtx& c0, int pn, int brow, f32x4 (&acc)[8][4]) const {
        struct { int fr, fq, wr, wc; } c = {c0.fr, c0.fq, c0.wr, c0.wc};
        asm volatile("" : "+v"(c.fr), "+v"(c.fq));
#pragma unroll
        for (int m = 0; m < 8; ++m) {
            SCHED();
            const int row = brow + c.wr * 128 + m * 16 + c.fr;
            float ss = 0.f;
#pragma unroll
            for (int n = 0; n < 4; ++n) {
                const int col = pn * 256 + c.wc * 64 + n * 16 + c.fq * 4;
                const uint2 yv = *(const uint2*)(Y + (size_t)row * DM + col);
                const float4 b = *(const float4*)(bias + col);
                f32x4 o;
                o[0] = bf2f(yv.x & 0xffff) * sigmoidf_(acc[m][n][0] + b.x); o[1] = bf2f(yv.x >> 16) * sigmoidf_(acc[m][n][1] + b.y);
                o[2] = bf2f(yv.y & 0xffff) * sigmoidf_(acc[m][n][2] + b.z); o[3] = bf2f(yv.y >> 16) * sigmoidf_(acc[m][n][3] + b.w);
                const uint2 pk = pack4(o);
                *(uint2*)(Z + (size_t)row * DM + col) = pk;
                const float r0 = bf2f(pk.x & 0xffff), r1 = bf2f(pk.x >> 16), r2 = bf2f(pk.y & 0xffff), r3 = bf2f(pk.y >> 16);
                ss += r0 * r0 + r1 * r1 + r2 * r2 + r3 * r3;
            }
            ss += __shfl_xor(ss, 16); ss += __shfl_xor(ss, 32);
            if (c.fq == 0) rowss[(size_t)(pn * 4 + c.wc) * MTOK + row] = ss;
        }
    }
};
struct ProbQkv {
    static constexpr int K = 256, lda = 1024, ldb = 256, ktsplit = 1 << 20;
    const bf16_t* XC; const bf16_t* MI; const bf16_t* Wt; bf16_t* Q; bf16_t* Kk; bf16_t* V; int nN;
    DEV const bf16_t* a1(int pn) const { return ((pn >> 2) == 2 ? MI : XC) + (pn & 3) * 256; }
    DEV const bf16_t* a2(int pn) const { return a1(pn); }
    DEV const bf16_t* bptr(int pn) const { return Wt + (long)pn * 256 * 256; }
    DEV void epi_begin(LAS char*, const GemmCtx&, int, int) const {}
    DEV void epi(int pn, int row, int col, f32x4 v) const {
        const int which = pn >> 2; bf16_t* C = sel3(which, Q, Kk, V);
        if (which == 1) { v[0] *= 0.0625f; v[1] *= 0.0625f; v[2] *= 0.0625f; v[3] *= 0.0625f; }
        *(uint2*)(C + (size_t)row * DM + (col & 1023)) = pack4(v);
    }
    DEV void epi_end(const GemmCtx&, int, int, f32x4 (&)[8][4]) const {}
};
struct ProbOut {
    static constexpr int K = 2048, lda = 1024, ldb = 2048, ktsplit = 16;
    const bf16_t* A1; const bf16_t* A2; const bf16_t* Wt; const float* xin; float* xout; const float* gate; int nN;
    DEV const bf16_t* a1(int pn) const { return A1; }
    DEV const bf16_t* a2(int pn) const { return A2; }
    DEV const bf16_t* bptr(int pn) const { return Wt + (long)pn * 256 * 2048; }
    DEV void epi_begin(LAS char*, const GemmCtx&, int, int) const {}
    DEV void epi(int pn, int row, int col, f32x4 v) const {
        const int b = row / SEQ;
        const float4 xi = *(const float4*)(xin + (size_t)row * DM + col);
        const float4 g = *(const float4*)(gate + (size_t)b * 3 * DM + col);
        float4 o; o.x = xi.x + g.x * v[0]; o.y = xi.y + g.y * v[1]; o.z = xi.z + g.z * v[2]; o.w = xi.w + g.w * v[3];
        *(float4*)(xout + (size_t)row * DM + col) = o;
    }
    DEV void epi_end(const GemmCtx&, int, int, f32x4 (&)[8][4]) const {}
};

struct G2Args {
    const bf16_t* H; const bf16_t* Wt;
    bf16_t* Z; const float* rowss; const float* og;
    bf16_t* HC; const bf16_t* XC; const float* ngain; const float* skip;
};
DEV void gemm2_phase(LAS char* shm, const G2Args& g) {
    const GemmCtx c = gemm_ctx();
    int efr, efq;
    LAS float* rst = (LAS float*)(shm + 131072);
    LAS float* red = (LAS float*)(shm + 131072 + 1024);
    for (int u = blockIdx.x; u < 512; u += gridDim.x) {
        f32x4 acc[8][4];
        if (u < 256) {
            int pm, pn; tile_map(u, 4, pm, pn);
            const int brow = pm * 256, bcol = pn * 256;
            gemm_mainloop(shm, c, g.H + (long)brow * DM, g.H, 1 << 20, DM, g.Wt + (long)(1024 + bcol) * DM, DM, 16, acc);
            efr = c.fr; efq = c.fq; asm volatile("" : "+v"(efr), "+v"(efq));
            { const int tid = c.wid * 64 + c.lane;
              if (tid < 256) { float s_ = 0.f;
#pragma unroll
                  for (int p_ = 0; p_ < 16; ++p_) s_ += g.rowss[(size_t)p_ * MTOK + brow + tid];
                  rst[tid] = rsqrtf(s_ * (1.f / DM) + EPS); } }
            __syncthreads();
#pragma unroll
            for (int m = 0; m < 8; ++m) {
                SCHED();
                const int rl = c.wr * 128 + m * 16 + efr, row = brow + rl;
                const float rs = rst[rl];
#pragma unroll
                for (int n = 0; n < 4; ++n) {
                    const int col = bcol + c.wc * 64 + n * 16 + efq * 4;
                    const uint2 zv = *(const uint2*)(g.Z + (size_t)row * DM + col);
                    const float4 gn = *(const float4*)(g.og + col);
                    f32x4 o;
                    o[0] = bf2f(zv.x & 0xffff) * rs * gn.x * siluf_(acc[m][n][0]); o[1] = bf2f(zv.x >> 16) * rs * gn.y * siluf_(acc[m][n][1]);
                    o[2] = bf2f(zv.y & 0xffff) * rs * gn.z * siluf_(acc[m][n][2]); o[3] = bf2f(zv.y >> 16) * rs * gn.w * siluf_(acc[m][n][3]);
                    *(uint2*)(g.Z + (size_t)row * DM + col) = pack4(o);
                }
            }
            __syncthreads();
        } else {
            int pm, hd; tile_map(u - 256, 4, pm, hd);
            const int brow = pm * 256, bcol = hd * 256;
            gemm_mainloop(shm, c, g.H + (long)brow * DM, g.H, 1 << 20, DM, g.Wt + (long)(3072 + bcol) * DM, DM, 16, acc);
            efr = c.fr; efq = c.fq; asm volatile("" : "+v"(efr), "+v"(efq));
        #pragma unroll
            for (int m = 0; m < 8; ++m) {
                SCHED();
                const int row = brow + c.wr * 128 + m * 16 + efr;
                float s_ = 0.f;
#pragma unroll
                for (int n = 0; n < 4; ++n) {
                    const int col = bcol + c.wc * 64 + n * 16 + efq * 4;
                    const uint2 hv = *(const uint2*)(g.HC + (size_t)row * DM + col);
                    acc[m][n][0] = bf2f(hv.x & 0xffff) * sigmoidf_(acc[m][n][0]); acc[m][n][1] = bf2f(hv.x >> 16) * sigmoidf_(acc[m][n][1]);
                    acc[m][n][2] = bf2f(hv.y & 0xffff) * sigmoidf_(acc[m][n][2]); acc[m][n][3] = bf2f(hv.y >> 16) * sigmoidf_(acc[m][n][3]);
                    s_ += (acc[m][n][0] + acc[m][n][1]) + (acc[m][n][2] + acc[m][n][3]);
                }
                s_ += __shfl_xor(s_, 16); s_ += __shfl_xor(s_, 32);
                if (efq == 0) red[c.wid * 128 + m * 16 + efr] = s_;
            }
            __syncthreads();
#pragma unroll
            for (int m = 0; m < 8; ++m) {
                SCHED();
                float tot = 0.f;
#pragma unroll
                for (int w2 = 0; w2 < 4; ++w2) tot += red[(c.wr * 4 + w2) * 128 + m * 16 + efr];
                const float mu = tot * (1.f / DH);
                float s_ = 0.f;
#pragma unroll
                for (int n = 0; n < 4; ++n)
#pragma unroll
                    for (int j = 0; j < 4; ++j) { acc[m][n][j] -= mu; s_ += acc[m][n][j] * acc[m][n][j]; }
                s_ += __shfl_xor(s_, 16); s_ += __shfl_xor(s_, 32);
                if (efq == 0) red[1024 + c.wid * 128 + m * 16 + efr] = s_;
            }
            __syncthreads();
#pragma unroll
            for (int m = 0; m < 8; ++m) {
                SCHED();
                const int row = brow + c.wr * 128 + m * 16 + efr;
                float tot = 0.f;
#pragma unroll
                for (int w2 = 0; w2 < 4; ++w2) tot += red[1024 + (c.wr * 4 + w2) * 128 + m * 16 + efr];
                const float rs = rsqrtf(tot * (1.f / DH) + EPS);
#pragma unroll
                for (int n = 0; n < 4; ++n) {
                    const int col = bcol + c.wc * 64 + n * 16 + efq * 4;
                    const uint2 xv = *(const uint2*)(g.XC + (size_t)row * DM + col);
                    const float4 gn = *(const float4*)(g.ngain + col), sk = *(const float4*)(g.skip + col);
                    f32x4 o;
                    o[0] = acc[m][n][0] * rs * gn.x + sk.x * bf2f(xv.x & 0xffff); o[1] = acc[m][n][1] * rs * gn.y + sk.y * bf2f(xv.x >> 16);
                    o[2] = acc[m][n][2] * rs * gn.z + sk.z * bf2f(xv.y & 0xffff); o[3] = acc[m][n][3] * rs * gn.w + sk.w * bf2f(xv.y >> 16);
                    *(uint2*)(g.HC + (size_t)row * DM + col) = pack4(o);
                }
            }
            gemm_mainloop(shm, c, g.H + (long)brow * DM, g.H, 1 << 20, DM, g.Wt + (long)(4096 + bcol) * DM, DM, 16, acc);
            efr = c.fr; efq = c.fq; asm volatile("" : "+v"(efr), "+v"(efq));
#pragma unroll
            for (int m = 0; m < 8; ++m) {
                SCHED();
                const int row = brow + c.wr * 128 + m * 16 + efr;
#pragma unroll
                for (int n = 0; n < 4; ++n) {
                    const int col = bcol + c.wc * 64 + n * 16 + efq * 4;
                    const uint2 hv = *(const uint2*)(g.HC + (size_t)row * DM + col);
                    f32x4 o;
                    o[0] = bf2f(hv.x & 0xffff) * siluf_(acc[m][n][0]); o[1] = bf2f(hv.x >> 16) * siluf_(acc[m][n][1]);
                    o[2] = bf2f(hv.y & 0xffff) * siluf_(acc[m][n][2]); o[3] = bf2f(hv.y >> 16) * siluf_(acc[m][n][3]);
                    *(uint2*)(g.HC + (size_t)row * DM + col) = pack4(o);
                }
            }
        }
    }
}


namespace g8 {
constexpr int BK = 64, HALFT = 128, HTB = HALFT * BK * 2;
#define G8_A_ROWMAJOR static constexpr size_t kstepA = 128, hstepA = (size_t)128 * lda * 2; static DEV unsigned aoff(int R, int C) { return (unsigned)(R * lda + C) * 2u; }
DEV int perm32(int rho) { const int n = rho >> 4, i = rho & 15; return 8 * (i >> 2) + 4 * n + (i & 3); }
struct Unit { const char* A; const char* B; int pm, pn, tag; };
template <class Epi, class Sched>
DEV void gemm_phase(LAS char* lds, const Sched& S, const Epi& E) {
    const int tid = opaque_tid(), wid = __builtin_amdgcn_readfirstlane(tid >> 6), lane = tid & 63, wr = wid >> 2, wc = wid & 3, fr = lane & 15, fq = lane >> 4;
    constexpr int lda = Sched::lda, ldb = Sched::ldb, nt = Sched::K / BK;
    unsigned voffA[2], voffB[2];
#pragma unroll
    for (int i = 0; i < 2; ++i) { int R, C; stage_rc(tid * 16 + i * 8192, R, C); const int Rb = (R & ~31) + perm32(R & 31);
        voffA[i] = Sched::aoff(R, C); voffB[i] = (unsigned)(Rb * ldb + C) * 2u; asm volatile("" : "+v"(voffA[i]), "+v"(voffB[i])); }
    constexpr size_t kstep = (size_t)(BK * 2), kstepA = Sched::kstepA, hstepA = Sched::hstepA, hstepB = (size_t)HALFT * ldb * 2;
    const unsigned ldsw = (unsigned)wid * 1024u;
    const int aoff = lds_byte(wr * 64 + fr, fq * 8), boff = lds_byte(wc * 32 + fr, fq * 8);
#define G8_SA(b, h) (((b) * 2 + (h)) * HTB)
#define G8_SB(b, h) ((4 + (b) * 2 + (h)) * HTB)
#define G8_STAGE(bufoff, gbase, voff) do { _Pragma("unroll") for (int _i = 0; _i < 2; ++_i) \
        __builtin_amdgcn_global_load_lds((const unsigned*)((const char*)(gbase) + (voff)[_i]), (LAS unsigned*)(lds + (bufoff) + ldsw + _i * 8192), 16, 0, 0); } while (0)
#define G8_LDA(dst, b, h) do { _Pragma("unroll") for (int m = 0; m < 4; ++m) _Pragma("unroll") for (int k = 0; k < 2; ++k) dst[m][k] = *(const LAS bf16x8*)(lds + G8_SA(b, h) + aoff + m * 2048 + k * 1024); } while (0)
#define G8_LDB(dst, b, h) do { _Pragma("unroll") for (int n = 0; n < 2; ++n) _Pragma("unroll") for (int k = 0; k < 2; ++k) dst[n][k] = *(const LAS bf16x8*)(lds + G8_SB(b, h) + boff + n * 2048 + k * 1024); } while (0)
#define G8_MMA(ai, bj, At, Bt) do { __builtin_amdgcn_s_setprio(1); _Pragma("unroll") for (int m = 0; m < 4; ++m) _Pragma("unroll") for (int n = 0; n < 2; ++n) _Pragma("unroll") for (int k = 0; k < 2; ++k) \
        acc[ai][bj][m][n] = __builtin_amdgcn_mfma_f32_16x16x32_bf16(Bt[n][k], At[m][k], acc[ai][bj][m][n], 0, 0, 0); __builtin_amdgcn_s_setprio(0); } while (0)
#define G8_WAIT_V(n) asm volatile("s_waitcnt vmcnt(" #n ")" ::: "memory")
#define G8_WAIT_L(n) asm volatile("s_waitcnt lgkmcnt(" #n ")" ::: "memory")
#define G8_BAR __builtin_amdgcn_s_barrier()
#define G8_SCHED __builtin_amdgcn_sched_barrier(0)
    Unit cur, nxt; int ui = 0;
    if (!S.next(0, cur)) return;
    f32x4 acc[2][2][4][2];
#pragma unroll
    for (int a = 0; a < 2; ++a)
#pragma unroll
        for (int b = 0; b < 2; ++b)
#pragma unroll
            for (int m = 0; m < 4; ++m)
#pragma unroll
                for (int n = 0; n < 2; ++n) acc[a][b][m][n] = (f32x4){0.f, 0.f, 0.f, 0.f};
    bf16x8 At[4][2], B0[2][2], B1[2][2];
    const char* cA = cur.A; const char* cB = cur.B;
    G8_STAGE(G8_SB(0, 0), cB, voffB); G8_STAGE(G8_SB(0, 1), cB + hstepB, voffB); G8_STAGE(G8_SA(0, 0), cA, voffA); G8_STAGE(G8_SA(0, 1), cA + hstepA, voffA);
    if (wr == 1) G8_BAR;
    G8_WAIT_V(2); G8_BAR;
    G8_STAGE(G8_SB(1, 0), cB + kstep, voffB); G8_STAGE(G8_SA(1, 0), cA + kstepA, voffA); G8_STAGE(G8_SB(1, 1), cB + hstepB + kstep, voffB);
    G8_WAIT_V(6); G8_BAR;
    for (;;) {
        const bool has_next = S.next(ui + 1, nxt);
        const char* nA = has_next ? nxt.A : cA; const char* nB = has_next ? nxt.B : cB;
#pragma nounroll
        for (int t = 0; t < nt; t += 2) {
            const bool last = (t == nt - 2);
            const char* a1 = cA + (size_t)(t + 1) * kstepA;
            const char* a2 = last ? nA : cA + (size_t)(t + 2) * kstepA; const char* b2 = last ? nB : cB + (size_t)(t + 2) * kstep;
            const char* a3 = a2 + kstepA; const char* b3 = b2 + kstep;
            G8_LDB(B0, 0, 0); G8_LDB(B1, 0, 1); G8_SCHED; G8_LDA(At, 0, 0); G8_STAGE(G8_SA(1, 1), a1 + hstepA, voffA);
            G8_WAIT_V(8); G8_WAIT_L(0); G8_BAR; G8_MMA(0, 0, At, B0); G8_MMA(0, 1, At, B1); G8_BAR; G8_SCHED;
            G8_LDA(At, 0, 1); G8_STAGE(G8_SB(0, 0), b2, voffB); G8_STAGE(G8_SB(0, 1), b2 + hstepB, voffB); G8_STAGE(G8_SA(0, 0), a2, voffA);
            G8_WAIT_V(8); G8_WAIT_L(0); G8_BAR; G8_MMA(1, 0, At, B0); G8_MMA(1, 1, At, B1); G8_BAR; G8_SCHED;
            G8_LDB(B0, 1, 0); G8_LDB(B1, 1, 1); G8_SCHED; G8_LDA(At, 1, 0); G8_STAGE(G8_SA(0, 1), a2 + hstepA, voffA);
            G8_WAIT_V(8); G8_WAIT_L(0); G8_BAR; G8_MMA(0, 0, At, B0); G8_MMA(0, 1, At, B1); G8_BAR; G8_SCHED;
            G8_LDA(At, 1, 1); G8_STAGE(G8_SB(1, 0), b3, voffB); G8_STAGE(G8_SB(1, 1), b3 + hstepB, voffB); G8_STAGE(G8_SA(1, 0), a3, voffA);
            G8_WAIT_V(8); G8_WAIT_L(0); G8_BAR; G8_MMA(1, 0, At, B0); G8_MMA(1, 1, At, B1); G8_BAR; G8_SCHED;
        }
        if (wr == 0) G8_BAR;
        E(lds, acc, cur, wr, wc, fr, fq, wid, lane);
        if (!has_next) break;
#pragma unroll
        for (int a = 0; a < 2; ++a)
#pragma unroll
            for (int b = 0; b < 2; ++b)
#pragma unroll
                for (int m = 0; m < 4; ++m)
#pragma unroll
                    for (int n = 0; n < 2; ++n) acc[a][b][m][n] = (f32x4){0.f, 0.f, 0.f, 0.f};
        cur = nxt; cA = nA; cB = nB; ++ui;
        if (wr == 1) G8_BAR;
    }
    G8_WAIT_V(0);
    G8_BAR;
#undef G8_SA
#undef G8_SB
#undef G8_STAGE
#undef G8_LDA
#undef G8_LDB
#undef G8_MMA
#undef G8_WAIT_V
#undef G8_WAIT_L
#undef G8_BAR
#undef G8_SCHED
}
DEV u32x4 pk8(const f32x4 a, const f32x4 b) { return (u32x4){pk2(a[0], a[1]), pk2(a[2], a[3]), pk2(b[0], b[1]), pk2(b[2], b[3])}; }
DEV void un8(const u32x4 v, float* f) { unpack8(make_uint4(v[0], v[1], v[2], v[3]), f); }
#define G8_ROWS_BEGIN _Pragma("unroll") for (int ai = 0; ai < 2; ++ai) _Pragma("unroll") for (int m = 0; m < 4; ++m) { const int rl = 128 * ai + 64 * wr + 16 * m + fr;
#define G8_ROWS_END }

struct SchedG1 { static constexpr int K = 1024, lda = 1024, ldb = 1024; G8_A_ROWMAJOR const bf16_t* H; const bf16_t* Wt; int bid, G;
    DEV bool next(int i, Unit& u) const { const int t = bid + i * G; if (t >= 512) return false; int pm, pn; tile_map(t, 8, pm, pn);
        u.pm = pm; u.pn = pn; u.tag = 0; u.A = (const char*)(H + (size_t)pm * 256 * DM); u.B = (const char*)(Wt + (size_t)((pn < 4) ? pn * 256 : 2048 + (pn - 4) * 256) * DM); return true; } };
struct EpiG1 { bf16_t* U; bf16_t* MI;
    DEV void operator()(LAS char*, const f32x4 (&acc)[2][2][4][2], const Unit& u, int wr, int wc, int fr, int fq, int, int) const {
        const int c0 = (u.pn & 3) * 256 + 32 * wc + 8 * fq;
        if (u.pn < 4) {
            G8_ROWS_BEGIN const int row = u.pm * 256 + rl;
#pragma unroll
                for (int bj = 0; bj < 2; ++bj) { const int cc = c0 + 128 * bj; *(u32x4*)(U + (size_t)(cc >> 4) * MTOK * 16 + (size_t)row * 16 + (cc & 15)) = pk8(acc[ai][bj][m][0], acc[ai][bj][m][1]); } G8_ROWS_END
        } else {
            G8_ROWS_BEGIN bf16_t* rp = MI + (size_t)(u.pm * 256 + rl) * DM + c0;
#pragma unroll
                for (int bj = 0; bj < 2; ++bj) *(u32x4*)(rp + 128 * bj) = pk8(acc[ai][bj][m][0], acc[ai][bj][m][1]); G8_ROWS_END
        } } };
struct SchedGlu { static constexpr int K = 1024, lda = 1024, ldb = 1024; static constexpr size_t kstepA = (size_t)4 * MTOK * 32, hstepA = (size_t)128 * 32; static DEV unsigned aoff(int R, int C) { return (unsigned)((C >> 4) * (MTOK * 32) + R * 32 + (C & 15) * 2); } const bf16_t* Y; const bf16_t* Wt; int bid, G;
    DEV bool next(int i, Unit& u) const { const int t = bid + i * G; if (t >= 256) return false; int pm, pn; tile_map(t, 4, pm, pn);
        u.pm = pm; u.pn = pn; u.tag = 0; u.A = (const char*)(Y + (size_t)pm * 256 * 16); u.B = (const char*)(Wt + (size_t)pn * 256 * DM); return true; } };
struct EpiGlu { const bf16_t* Y; bf16_t* Z; const float* bias; float* rowss;
    DEV void operator()(LAS char*, const f32x4 (&acc)[2][2][4][2], const Unit& u, int wr, int wc, int fr, int fq, int, int) const {
        const int c0 = u.pn * 256 + 32 * wc + 8 * fq;
        G8_ROWS_BEGIN const size_t ro = (size_t)(u.pm * 256 + rl) * DM + c0; float ss = 0.f;
#pragma unroll
            for (int bj = 0; bj < 2; ++bj) {
                float y8[8]; { const int cc = c0 + 128 * bj; un8(*(const u32x4*)(Y + (size_t)(cc >> 4) * MTOK * 16 + (size_t)(u.pm * 256 + rl) * 16 + (cc & 15)), y8); }
                const float4 b0 = *(const float4*)(bias + c0 + 128 * bj), b1 = *(const float4*)(bias + c0 + 128 * bj + 4);
                f32x4 o0, o1;
                o0[0] = y8[0] * sigmoidf_(acc[ai][bj][m][0][0] + b0.x); o0[1] = y8[1] * sigmoidf_(acc[ai][bj][m][0][1] + b0.y); o0[2] = y8[2] * sigmoidf_(acc[ai][bj][m][0][2] + b0.z); o0[3] = y8[3] * sigmoidf_(acc[ai][bj][m][0][3] + b0.w);
                o1[0] = y8[4] * sigmoidf_(acc[ai][bj][m][1][0] + b1.x); o1[1] = y8[5] * sigmoidf_(acc[ai][bj][m][1][1] + b1.y); o1[2] = y8[6] * sigmoidf_(acc[ai][bj][m][1][2] + b1.z); o1[3] = y8[7] * sigmoidf_(acc[ai][bj][m][1][3] + b1.w);
                const u32x4 pk = pk8(o0, o1); *(u32x4*)(Z + ro + 128 * bj) = pk;
                float r8[8]; un8(pk, r8);
#pragma unroll
                for (int e = 0; e < 8; ++e) ss += r8[e] * r8[e];
            }
            ss += __shfl_xor(ss, 16); ss += __shfl_xor(ss, 32);
            if (fq == 0) rowss[(size_t)(u.pn * 4 + wc) * MTOK + u.pm * 256 + rl] = ss; G8_ROWS_END } };
struct SchedQkv { static constexpr int K = 256, lda = 1024, ldb = 256; G8_A_ROWMAJOR const bf16_t* XC; const bf16_t* MI; const bf16_t* Wt; int bid, G;
    DEV bool next(int i, Unit& u) const { const int t = bid + i * G; if (t >= 768) return false; int pm, pn; tile_map(t, 12, pm, pn);
        u.pm = pm; u.pn = pn; u.tag = 0; u.A = (const char*)(((pn >> 2) == 2 ? MI : XC) + (size_t)pm * 256 * DM + (pn & 3) * 256); u.B = (const char*)(Wt + (size_t)pn * 256 * 256); return true; } };
struct EpiQkv { bf16_t* Q; bf16_t* Kk; bf16_t* V;
    DEV void operator()(LAS char*, const f32x4 (&acc)[2][2][4][2], const Unit& u, int wr, int wc, int fr, int fq, int, int) const {
        const int which = u.pn >> 2; bf16_t* C = sel3(which, Q, Kk, V); const float sc = (which == 1) ? 0.0625f : 1.f;
        const int c0 = (u.pn & 3) * 256 + 32 * wc + 8 * fq;
        G8_ROWS_BEGIN bf16_t* rp = C + (size_t)(u.pm * 256 + rl) * DM + c0;
#pragma unroll
            for (int bj = 0; bj < 2; ++bj) *(u32x4*)(rp + 128 * bj) = pk8(acc[ai][bj][m][0] * sc, acc[ai][bj][m][1] * sc); G8_ROWS_END } };
struct SchedOut { static constexpr int K = 2048, lda = 2048, ldb = 2048; G8_A_ROWMAJOR const bf16_t* MX; const bf16_t* Wt; int bid, G;
    DEV bool next(int i, Unit& u) const { const int t = bid + i * G; if (t >= 256) return false; int pm, pn; tile_map(t, 4, pm, pn);
        u.pm = pm; u.pn = pn; u.tag = 0; u.A = (const char*)(MX + (size_t)pm * 256 * 2048); u.B = (const char*)(Wt + (size_t)pn * 256 * 2048); return true; } };
template <bool FINAL>
struct EpiOutN { const float* xin; float* xout; const float* gate; const float* ngain; const float* modn; bf16_t* Hn; float* xss; unsigned* cnt; unsigned* tmo;
    DEV void operator()(LAS char* lds, f32x4 (&acc)[2][2][4][2], const Unit& u, int wr, int wc, int fr, int fq, int wid, int lane) const {
        asm volatile("" : "+v"(fr), "+v"(fq));
        LAS float* red = (LAS float*)(lds + 131072);
        LAS float* rst = (LAS float*)(lds + 131072 + 4096);
        const int c0 = u.pn * 256 + 32 * wc + 8 * fq, bidx = (u.pm * 256) / SEQ; const float* gp = gate + (size_t)bidx * 3 * DM + c0;
        G8_ROWS_BEGIN const size_t ro = (size_t)(u.pm * 256 + rl) * DM + c0; float ss = 0.f;
#pragma unroll
            for (int bj = 0; bj < 2; ++bj)
#pragma unroll
                for (int n = 0; n < 2; ++n) {
                    const float4 xi = *(const float4*)(xin + ro + 128 * bj + 4 * n), g4 = *(const float4*)(gp + 128 * bj + 4 * n);
                    f32x4 o; o[0] = xi.x + g4.x * acc[ai][bj][m][n][0]; o[1] = xi.y + g4.y * acc[ai][bj][m][n][1]; o[2] = xi.z + g4.z * acc[ai][bj][m][n][2]; o[3] = xi.w + g4.w * acc[ai][bj][m][n][3];
                    acc[ai][bj][m][n] = o; ss += (o[0] * o[0] + o[1] * o[1]) + (o[2] * o[2] + o[3] * o[3]);
                    if (!FINAL) *(float4*)(xout + ro + 128 * bj + 4 * n) = make_float4(o[0], o[1], o[2], o[3]); }
            ss += __shfl_xor(ss, 16); ss += __shfl_xor(ss, 32);
            if (fq == 0) red[wid * 128 + 64 * ai + 16 * m + fr] = ss; G8_ROWS_END
        asm volatile("s_waitcnt lgkmcnt(0)" ::: "memory"); __builtin_amdgcn_s_barrier();
        const int tid = wid * 64 + lane;
        if (tid < 256) {
            const int r_ = tid, w0 = (r_ >> 6) & 1, ix = (r_ & 63) + 64 * (r_ >> 7);
            const float t_ = red[(w0 * 4 + 0) * 128 + ix] + red[(w0 * 4 + 1) * 128 + ix] + red[(w0 * 4 + 2) * 128 + ix] + red[(w0 * 4 + 3) * 128 + ix];
            __hip_atomic_store(xss + ((size_t)(u.pm * 256 + r_) * 4 + u.pn), t_, __ATOMIC_RELAXED, __HIP_MEMORY_SCOPE_AGENT);
        }
        asm volatile("s_waitcnt vmcnt(0)" ::: "memory"); __builtin_amdgcn_s_barrier();
        if (tid == 0) {
            __hip_atomic_fetch_add(cnt + 64 * u.pm, 1u, __ATOMIC_RELAXED, __HIP_MEMORY_SCOPE_AGENT);
            unsigned sp_ = 0;
            while (__hip_atomic_load(cnt + 64 * u.pm, __ATOMIC_RELAXED, __HIP_MEMORY_SCOPE_AGENT) < 4u) { __builtin_amdgcn_s_sleep(1); if (++sp_ > (1u << 22)) { atomicAdd(tmo, 1u); break; } }
        }
        __builtin_amdgcn_s_barrier();
        if (tid < 256) {
            const float* xp = xss + (size_t)(u.pm * 256 + tid) * 4;
            const float t_ = __hip_atomic_load(xp, __ATOMIC_RELAXED, __HIP_MEMORY_SCOPE_AGENT) + __hip_atomic_load(xp + 1, __ATOMIC_RELAXED, __HIP_MEMORY_SCOPE_AGENT)
                           + __hip_atomic_load(xp + 2, __ATOMIC_RELAXED, __HIP_MEMORY_SCOPE_AGENT) + __hip_atomic_load(xp + 3, __ATOMIC_RELAXED, __HIP_MEMORY_SCOPE_AGENT);
            rst[tid] = rsqrtf(t_ * (1.f / DM) + EPS);
        }
        asm volatile("s_waitcnt vmcnt(0) lgkmcnt(0)" ::: "memory"); __builtin_amdgcn_s_barrier();
        const float* shp = modn + (size_t)bidx * 3 * DM + c0;
        G8_ROWS_BEGIN const size_t ro = (size_t)(u.pm * 256 + rl) * DM + c0; const float rs = rst[rl];
#pragma unroll
            for (int bj = 0; bj < 2; ++bj) {
                const float4 g0 = *(const float4*)(ngain + c0 + 128 * bj), g1 = *(const float4*)(ngain + c0 + 128 * bj + 4);
                if (FINAL) {
                    *(float4*)(xout + ro + 128 * bj) = make_float4(acc[ai][bj][m][0][0] * rs * g0.x, acc[ai][bj][m][0][1] * rs * g0.y, acc[ai][bj][m][0][2] * rs * g0.z, acc[ai][bj][m][0][3] * rs * g0.w);
                    *(float4*)(xout + ro + 128 * bj + 4) = make_float4(acc[ai][bj][m][1][0] * rs * g1.x, acc[ai][bj][m][1][1] * rs * g1.y, acc[ai][bj][m][1][2] * rs * g1.z, acc[ai][bj][m][1][3] * rs * g1.w);
                } else {
                    const float4 h0 = *(const float4*)(shp + 128 * bj), h1 = *(const float4*)(shp + 128 * bj + 4), s0 = *(const float4*)(shp + DM + 128 * bj), s1 = *(const float4*)(shp + DM + 128 * bj + 4);
                    f32x4 o0, o1;
                    o0[0] = acc[ai][bj][m][0][0] * rs * g0.x * (1.f + s0.x) + h0.x; o0[1] = acc[ai][bj][m][0][1] * rs * g0.y * (1.f + s0.y) + h0.y; o0[2] = acc[ai][bj][m][0][2] * rs * g0.z * (1.f + s0.z) + h0.z; o0[3] = acc[ai][bj][m][0][3] * rs * g0.w * (1.f + s0.w) + h0.w;
                    o1[0] = acc[ai][bj][m][1][0] * rs * g1.x * (1.f + s1.x) + h1.x; o1[1] = acc[ai][bj][m][1][1] * rs * g1.y * (1.f + s1.y) + h1.y; o1[2] = acc[ai][bj][m][1][2] * rs * g1.z * (1.f + s1.z) + h1.z; o1[3] = acc[ai][bj][m][1][3] * rs * g1.w * (1.f + s1.w) + h1.w;
                    *(u32x4*)(Hn + ro + 128 * bj) = pk8(o0, o1);
                } } G8_ROWS_END
    } };
struct SchedG2s { static constexpr int K = 1024, lda = 1024, ldb = 1024; G8_A_ROWMAJOR const bf16_t* H; const bf16_t* Wt; int bid;
    DEV bool next(int i, Unit& u) const { if (i >= 1) return false; int pm, pn; tile_map(bid, 4, pm, pn);
        u.pm = pm; u.pn = pn; u.tag = 0; u.A = (const char*)(H + (size_t)pm * 256 * DM); u.B = (const char*)(Wt + (size_t)(1024 + pn * 256) * DM); return true; } };
struct SchedG2m { static constexpr int K = 1024, lda = 1024, ldb = 1024; G8_A_ROWMAJOR const bf16_t* H; const bf16_t* Wt; int bid;
    DEV bool next(int i, Unit& u) const { if (i >= 2) return false; int pm, pn; tile_map(bid, 4, pm, pn);
        u.pm = pm; u.pn = pn; u.tag = i + 1; u.A = (const char*)(H + (size_t)pm * 256 * DM); u.B = (const char*)(Wt + (size_t)((i == 0 ? 3072 : 4096) + pn * 256) * DM); return true; } };
struct EpiG2s { const bf16_t* Z; const float* rstd; const float* og; bf16_t* MX;
    DEV void operator()(LAS char* lds, f32x4 (&acc)[2][2][4][2], const Unit& u, int wr, int wc, int fr, int fq, int wid, int lane) const {
        asm volatile("" : "+v"(fr), "+v"(fq));
        const int c0 = u.pn * 256 + 32 * wc + 8 * fq;
        {
            G8_ROWS_BEGIN const int row = u.pm * 256 + rl; const float rs = rstd[row];
#pragma unroll
                for (int bj = 0; bj < 2; ++bj) {
                    float z8[8]; un8(*(const u32x4*)(Z + (size_t)row * DM + c0 + 128 * bj), z8);
                    const float4 g0 = *(const float4*)(og + c0 + 128 * bj), g1 = *(const float4*)(og + c0 + 128 * bj + 4);
                    f32x4 o0, o1;
                    o0[0] = z8[0] * rs * g0.x * siluf_(acc[ai][bj][m][0][0]); o0[1] = z8[1] * rs * g0.y * siluf_(acc[ai][bj][m][0][1]); o0[2] = z8[2] * rs * g0.z * siluf_(acc[ai][bj][m][0][2]); o0[3] = z8[3] * rs * g0.w * siluf_(acc[ai][bj][m][0][3]);
                    o1[0] = z8[4] * rs * g1.x * siluf_(acc[ai][bj][m][1][0]); o1[1] = z8[5] * rs * g1.y * siluf_(acc[ai][bj][m][1][1]); o1[2] = z8[6] * rs * g1.z * siluf_(acc[ai][bj][m][1][2]); o1[3] = z8[7] * rs * g1.w * siluf_(acc[ai][bj][m][1][3]);
                    *(u32x4*)(MX + (size_t)row * 2048 + c0 + 128 * bj) = pk8(o0, o1); } G8_ROWS_END
        }
    } };
struct EpiG2m { const bf16_t* HC; const bf16_t* XC; const float* ngain; const float* skip; bf16_t* MX;
    DEV void operator()(LAS char* lds, f32x4 (&acc)[2][2][4][2], const Unit& u, int wr, int wc, int fr, int fq, int wid, int lane) const {
        asm volatile("" : "+v"(fr), "+v"(fq));
        const int c0 = u.pn * 256 + 32 * wc + 8 * fq;
        if (u.tag == 1) {
            LAS float* red = (LAS float*)(lds + 131072);
            G8_ROWS_BEGIN const int row = u.pm * 256 + rl; float s1 = 0.f, s2 = 0.f;
#pragma unroll
                for (int bj = 0; bj < 2; ++bj) {
                    float h8[8]; un8(*(const u32x4*)(HC + (size_t)row * DM + c0 + 128 * bj), h8);
#pragma unroll
                    for (int n = 0; n < 2; ++n)
#pragma unroll
                        for (int j = 0; j < 4; ++j) { const float v = h8[4 * n + j] * sigmoidf_(acc[ai][bj][m][n][j]); acc[ai][bj][m][n][j] = v; s1 += v; s2 += v * v; }
                }
                s1 += __shfl_xor(s1, 16); s1 += __shfl_xor(s1, 32); s2 += __shfl_xor(s2, 16); s2 += __shfl_xor(s2, 32);
                if (fq == 0) *(LAS f32x2*)(red + ((wid * 128) + 64 * ai + 16 * m + fr) * 2) = (f32x2){s1, s2}; G8_ROWS_END
            asm volatile("s_waitcnt lgkmcnt(0)" ::: "memory"); __builtin_amdgcn_s_barrier();
            G8_ROWS_BEGIN const int row = u.pm * 256 + rl; float t1 = 0.f, t2 = 0.f;
#pragma unroll
                for (int w2 = 0; w2 < 4; ++w2) { const f32x2 p_ = *(const LAS f32x2*)(red + (((wr * 4 + w2) * 128) + 64 * ai + 16 * m + fr) * 2); t1 += p_.x; t2 += p_.y; }
                const float mu = t1 * (1.f / DH), rs = rsqrtf(fmaxf(t2 * (1.f / DH) - mu * mu, 0.f) + EPS);
#pragma unroll
                for (int bj = 0; bj < 2; ++bj) {
                    float x8[8]; un8(*(const u32x4*)(XC + (size_t)row * DM + c0 + 128 * bj), x8);
                    const float4 g0 = *(const float4*)(ngain + c0 + 128 * bj), g1 = *(const float4*)(ngain + c0 + 128 * bj + 4), k0 = *(const float4*)(skip + c0 + 128 * bj), k1 = *(const float4*)(skip + c0 + 128 * bj + 4);
                    f32x4 o0, o1;
                    o0[0] = (acc[ai][bj][m][0][0] - mu) * rs * g0.x + k0.x * x8[0]; o0[1] = (acc[ai][bj][m][0][1] - mu) * rs * g0.y + k0.y * x8[1]; o0[2] = (acc[ai][bj][m][0][2] - mu) * rs * g0.z + k0.z * x8[2]; o0[3] = (acc[ai][bj][m][0][3] - mu) * rs * g0.w + k0.w * x8[3];
                    o1[0] = (acc[ai][bj][m][1][0] - mu) * rs * g1.x + k1.x * x8[4]; o1[1] = (acc[ai][bj][m][1][1] - mu) * rs * g1.y + k1.y * x8[5]; o1[2] = (acc[ai][bj][m][1][2] - mu) * rs * g1.z + k1.z * x8[6]; o1[3] = (acc[ai][bj][m][1][3] - mu) * rs * g1.w + k1.w * x8[7];
                    *(u32x4*)(MX + (size_t)row * 2048 + 1024 + c0 + 128 * bj) = pk8(o0, o1); } G8_ROWS_END
        } else {
            G8_ROWS_BEGIN const int row = u.pm * 256 + rl;
#pragma unroll
                for (int bj = 0; bj < 2; ++bj) {
                    bf16_t* pp = MX + (size_t)row * 2048 + 1024 + c0 + 128 * bj;
                    float h8[8]; un8(*(const u32x4*)pp, h8);
                    f32x4 o0, o1;
                    o0[0] = h8[0] * siluf_(acc[ai][bj][m][0][0]); o0[1] = h8[1] * siluf_(acc[ai][bj][m][0][1]); o0[2] = h8[2] * siluf_(acc[ai][bj][m][0][2]); o0[3] = h8[3] * siluf_(acc[ai][bj][m][0][3]);
                    o1[0] = h8[4] * siluf_(acc[ai][bj][m][1][0]); o1[1] = h8[5] * siluf_(acc[ai][bj][m][1][1]); o1[2] = h8[6] * siluf_(acc[ai][bj][m][1][2]); o1[3] = h8[7] * siluf_(acc[ai][bj][m][1][3]);
                    *(u32x4*)pp = pk8(o0, o1); } G8_ROWS_END
        }
    } };
}
DEV void rstd_rows(const float* rowss, float* rstd) {
    const int tid = opaque_tid();
    for (int r = blockIdx.x * 512 + tid; r < MTOK; r += gridDim.x * 512) { float s_ = 0.f;
#pragma unroll
        for (int p_ = 0; p_ < 16; ++p_) s_ += rowss[(size_t)p_ * MTOK + r];
        rstd[r] = rsqrtf(s_ * (1.f / DM) + EPS); }
}

DEV void transpose_item(const float* W, int ldw, int ncols, bf16_t* WT, int ldwt, LAS float* scr, int item, int lane) {
    const int nblk = ncols / 64, kb = item / nblk, nb = item % nblk, k0 = 64 * kb, n0 = 64 * nb;
    float4 v[16];
#pragma unroll
    for (int i = 0; i < 16; ++i) v[i] = *(const float4*)(W + (size_t)(k0 + 4 * i + (lane >> 4)) * ldw + n0 + 4 * (lane & 15));
#pragma unroll
    for (int i = 0; i < 16; ++i) { LAS float* d_ = scr + (4 * i + (lane >> 4)) * 65 + 4 * (lane & 15); d_[0] = v[i].x; d_[1] = v[i].y; d_[2] = v[i].z; d_[3] = v[i].w; }
    asm volatile("s_waitcnt lgkmcnt(0)" ::: "memory");
#pragma unroll
    for (int j = 0; j < 8; ++j) {
        const int n = (lane >> 3) + 8 * j, c = lane & 7;
        const LAS float* s_ = scr + (8 * c) * 65 + n;
        uint4 o;
        o.x = pk2(s_[0 * 65], s_[1 * 65]); o.y = pk2(s_[2 * 65], s_[3 * 65]); o.z = pk2(s_[4 * 65], s_[5 * 65]); o.w = pk2(s_[6 * 65], s_[7 * 65]);
        *(uint4*)(WT + (size_t)(n0 + n) * ldwt + k0 + 8 * c) = o;
    }
    asm volatile("s_waitcnt lgkmcnt(0)" ::: "memory");
}

DEV float wave_scan_add(float v, int lane) {
#pragma unroll
    for (int o = 1; o < 64; o <<= 1) { const float u = __shfl_up(v, o); if (lane >= o) v += u; }
    return v;
}
DEV float wave_scan_max(float v, int lane) {
#pragma unroll
    for (int o = 1; o < 64; o <<= 1) { const float u = __shfl_up(v, o); if (lane >= o) v = fmaxf(v, u); }
    return v;
}

template <int TT>
DEV void mlstm_a_wave(LAS char* shm, int fr, int fq, float m_prev, const LAS float* tpj, const LAS float* taj, f32x4 (&nacc)[3]) {
    constexpr int QS = 0, KS = 33792, VT = 67584, RS = 528, VRS = 96, NT = TT + 1;
    const LAS char* qb = shm + QS + (16 * TT + fr) * RS + fq * 16;
    const LAS char* kb = shm + KS + fr * RS + fq * 16;
    f32x4 sacc[NT];
#pragma unroll
    for (int jj = 0; jj < NT; ++jj) sacc[jj] = (f32x4){0.f, 0.f, 0.f, 0.f};
    bf16x8 qf = *(const LAS bf16x8*)qb, kf[NT];
#pragma unroll
    for (int jj = 0; jj < NT; ++jj) kf[jj] = *(const LAS bf16x8*)(kb + jj * 16 * RS);
#pragma unroll
    for (int ks = 0; ks < 8; ++ks) {
        bf16x8 qn = qf, kn[NT];
#pragma unroll
        for (int jj = 0; jj < NT; ++jj) kn[jj] = kf[jj];
        if (ks < 7) {
            qn = *(const LAS bf16x8*)(qb + (ks + 1) * 64);
#pragma unroll
            for (int jj = 0; jj < NT; ++jj) kn[jj] = *(const LAS bf16x8*)(kb + jj * 16 * RS + (ks + 1) * 64);
        }
#pragma unroll
        for (int jj = 0; jj < NT; ++jj) sacc[jj] = __builtin_amdgcn_mfma_f32_16x16x32_bf16(kf[jj], qf, sacc[jj], 0, 0, 0);
        qf = qn;
#pragma unroll
        for (int jj = 0; jj < NT; ++jj) kf[jj] = kn[jj];
    }
    constexpr int NK = (TT >= 2) ? 2 : 1;
    s16x4 vlo[NK][3], vhi[NK][3];
#pragma unroll
    for (int kk = 0; kk < NK; ++kk)
#pragma unroll
        for (int vt = 0; vt < 3; ++vt) {
            vlo[kk][vt] = __builtin_amdgcn_ds_read_tr16_b64_v4i16((LAS s16x4*)(shm + VT + (32 * kk + 4 * fq + (fr >> 2)) * VRS + (16 * vt + 4 * (fr & 3)) * 2));
            vhi[kk][vt] = __builtin_amdgcn_ds_read_tr16_b64_v4i16((LAS s16x4*)(shm + VT + (32 * kk + 16 + 4 * fq + (fr >> 2)) * VRS + (16 * vt + 4 * (fr & 3)) * 2));
        }
    const int t = 16 * TT + fr;
    const float btm = -fmaxf(m_prev, tpj[t]);
    f32x4 sm[2 * NK];
#pragma unroll
    for (int jj = 0; jj < 2 * NK; ++jj) {
        if (jj < NT) {
            const f32x4 a4 = *(const LAS f32x4*)(taj + 16 * jj + 4 * fq);
#pragma unroll
            for (int r = 0; r < 4; ++r) {
                const int s_ = 16 * jj + 4 * fq + r;
                sm[jj][r] = (jj < TT || s_ <= t) ? sacc[jj < NT ? jj : 0][r] * __expf(btm + a4[r]) : 0.f;
            }
        } else sm[jj] = (f32x4){0.f, 0.f, 0.f, 0.f};
    }
#pragma unroll
    for (int kk = 0; kk < NK; ++kk) {
        const u32x4 u = (u32x4){pk2(sm[2 * kk][0], sm[2 * kk][1]), pk2(sm[2 * kk][2], sm[2 * kk][3]), pk2(sm[2 * kk + 1][0], sm[2 * kk + 1][1]), pk2(sm[2 * kk + 1][2], sm[2 * kk + 1][3])};
        const bf16x8 af = *(const bf16x8*)&u;
#pragma unroll
        for (int vt = 0; vt < 3; ++vt) {
            bf16x8 bv8; bv8[0] = vlo[kk][vt][0]; bv8[1] = vlo[kk][vt][1]; bv8[2] = vlo[kk][vt][2]; bv8[3] = vlo[kk][vt][3];
            bv8[4] = vhi[kk][vt][0]; bv8[5] = vhi[kk][vt][1]; bv8[6] = vhi[kk][vt][2]; bv8[7] = vhi[kk][vt][3];
            nacc[vt] = __builtin_amdgcn_mfma_f32_16x16x32_bf16(af, bv8, nacc[vt], 0, 0, 0);
        }
    }
}
DEV void mlstm_b_wave(LAS char* shm, int tt, int fr, int fq, f32x4 (&nacc)[3]) {
    constexpr int QS = 0, CB = 81408, RS = 528;
    const LAS char* qb = shm + QS + (16 * tt + fr) * RS + fq * 16;
    const LAS char* cbp = shm + CB + fr * RS + fq * 16;
    bf16x8 qf = *(const LAS bf16x8*)qb, cf[3];
#pragma unroll
    for (int vt = 0; vt < 3; ++vt) cf[vt] = *(const LAS bf16x8*)(cbp + vt * 16 * RS);
#pragma unroll
    for (int ks = 0; ks < 8; ++ks) {
        bf16x8 qn = qf, cn[3] = {cf[0], cf[1], cf[2]};
        if (ks < 7) {
            qn = *(const LAS bf16x8*)(qb + (ks + 1) * 64);
#pragma unroll
            for (int vt = 0; vt < 3; ++vt) cn[vt] = *(const LAS bf16x8*)(cbp + vt * 16 * RS + (ks + 1) * 64);
        }
#pragma unroll
        for (int vt = 0; vt < 3; ++vt) nacc[vt] = __builtin_amdgcn_mfma_f32_16x16x32_bf16(qf, cf[vt], nacc[vt], 0, 0, 0);
        qf = qn;
#pragma unroll
        for (int vt = 0; vt < 3; ++vt) cf[vt] = cn[vt];
    }
}
template <int SKIP>
DEV void mlstm_phase(LAS char* shm, const bf16_t* q, const bf16_t* k, const bf16_t* v, const float* gpart, const float* b_ig, const float* b_fg, bf16_t* hc) {
    const int tid = opaque_tid(), wid = __builtin_amdgcn_readfirstlane(tid >> 6), lane = tid & 63, fr = lane & 15, fq = lane >> 4;
    constexpr int QS = 0, KS = 33792, VT = 67584, VWT = 74496, CB = 81408, PART = 106752, TB = 120064, TA = 128256, TP = 136448, TC = 144640, HST = 144896, RS = 528, VRS = 96, PRS = 52;
    LAS float* part = (LAS float*)(shm + PART);
    LAS float* tb = (LAS float*)(shm + TB); LAS float* ta = (LAS float*)(shm + TA); LAS float* tp = (LAS float*)(shm + TP); LAS float* tc = (LAS float*)(shm + TC);
    for (int item = blockIdx.x; item < BATCH * NH * 8; item += gridDim.x) {
        const int vs = (item >> 3) & 7, bh = (item & 7) + 8 * (item >> 6), h = bh & 3, b = bh >> 2;
        __syncthreads();
        for (int i = tid; i < (CB + 25344 - VT) / 4; i += 512) ((LAS unsigned*)(shm + VT))[i] = 0u;
        for (int j = wid; j < SEQ / CHUNK; j += 8) {
            const int m = b * SEQ + j * CHUNK + lane;
            const float* gp = gpart + (size_t)m * 8;
            const float ig = gp[h] + gp[(size_t)MTOK * 8 + h] + b_ig[h];
            const float lf = logsigmoidf_(gp[4 + h] + gp[(size_t)MTOK * 8 + 4 + h] + b_fg[h]);
            const float bc = wave_scan_add(lf, lane);
            const float a_ = ig - bc;
            const float pm = wave_scan_max(a_, lane);
            tb[j * 64 + lane] = bc; ta[j * 64 + lane] = a_; tp[j * 64 + lane] = pm;
            if (lane == 63) { tc[2 * j] = bc; tc[2 * j + 1] = pm; }
        }
        __syncthreads();
        if (tid < 64) *(LAS u32x4*)(shm + VT + tid * VRS + 64) = (u32x4){0x3F80u, 0u, 0u, 0u};
        f32x4 cacc[2][3];
#pragma unroll
        for (int i = 0; i < 2; ++i)
#pragma unroll
            for (int vt = 0; vt < 3; ++vt) cacc[i][vt] = (f32x4){0.f, 0.f, 0.f, 0.f};
        float m_prev = 0.f;
        const size_t cb0 = ((size_t)(b * SEQ)) * DM + h * DH;
        uint4 qv[4], kv[4], vv = make_uint4(0, 0, 0, 0);
#pragma unroll
        for (int i = 0; i < 4; ++i) {
            const int idx = tid + 512 * i, row = idx >> 5, c16 = idx & 31;
            qv[i] = *(const uint4*)(q + cb0 + (size_t)row * DM + c16 * 8);
            kv[i] = *(const uint4*)(k + cb0 + (size_t)row * DM + c16 * 8);
        }
        if (tid < 256) vv = *(const uint4*)(v + cb0 + (size_t)(tid >> 2) * DM + vs * 32 + (tid & 3) * 8);
#pragma nounroll
        for (int j = 0; j < SEQ / CHUNK; ++j) {
            const size_t cb = cb0 + (size_t)j * CHUNK * DM;
            const float btot = tc[2 * j], amax = tc[2 * j + 1];
            const float mxc = fmaxf(m_prev, amax);
#pragma unroll
            for (int i = 0; i < ((SKIP & 8) ? 0 : 4); ++i) {
                const int idx = tid + 512 * i, row = idx >> 5, c16 = idx & 31;
                *(LAS u32x4*)(shm + QS + row * RS + c16 * 16) = (u32x4){qv[i].x, qv[i].y, qv[i].z, qv[i].w};
                *(LAS u32x4*)(shm + KS + row * RS + c16 * 16) = (u32x4){kv[i].x, kv[i].y, kv[i].z, kv[i].w};
            }
            if (tid < 256) {
                const int s_ = tid >> 2, v0 = (tid & 3) * 8;
                const float ws = __expf(ta[j * 64 + s_] - mxc);
                float f8[8]; unpack8(vv, f8);
#pragma unroll
                for (int e = 0; e < 8; ++e) f8[e] *= ws;
                const uint4 wv = pack8(f8);
                *(LAS u32x4*)(shm + VT + s_ * VRS + v0 * 2) = (u32x4){vv.x, vv.y, vv.z, vv.w};
                *(LAS u32x4*)(shm + VWT + s_ * VRS + v0 * 2) = (u32x4){wv.x, wv.y, wv.z, wv.w};
            } else if (tid < 320) {
                const int s_ = tid - 256;
                *(LAS u32x4*)(shm + VWT + s_ * VRS + 64) = (u32x4){(unsigned)f2bf(__expf(ta[j * 64 + s_] - mxc)), 0u, 0u, 0u};
            }
            if (j + 1 < SEQ / CHUNK) {
                const size_t cn = cb + (size_t)CHUNK * DM;
#pragma unroll
                for (int i = 0; i < 4; ++i) {
                    const int idx = tid + 512 * i, row = idx >> 5, c16 = idx & 31;
                    qv[i] = *(const uint4*)(q + cn + (size_t)row * DM + c16 * 8);
                    kv[i] = *(const uint4*)(k + cn + (size_t)row * DM + c16 * 8);
                }
                if (tid < 256) vv = *(const uint4*)(v + cn + (size_t)(tid >> 2) * DM + vs * 32 + (tid & 3) * 8);
            }
            __syncthreads();
            f32x4 nacc[3];
#pragma unroll
            for (int vt = 0; vt < 3; ++vt) nacc[vt] = (f32x4){0.f, 0.f, 0.f, 0.f};
            const int tt = wid & 3;
            if (wid < 4) { if (!(SKIP & 1)) {
                const LAS float* tpj = tp + j * 64; const LAS float* taj = ta + j * 64;
                if (tt == 0) mlstm_a_wave<0>(shm, fr, fq, m_prev, tpj, taj, nacc);
                else if (tt == 1) mlstm_a_wave<1>(shm, fr, fq, m_prev, tpj, taj, nacc);
                else if (tt == 2) mlstm_a_wave<2>(shm, fr, fq, m_prev, tpj, taj, nacc);
                else mlstm_a_wave<3>(shm, fr, fq, m_prev, tpj, taj, nacc);
            } } else if (!(SKIP & 2)) {
                mlstm_b_wave(shm, tt, fr, fq, nacc);
                const f32x4 pm4 = *(const LAS f32x4*)(tp + j * 64 + 16 * tt + 4 * fq);
#pragma unroll
                for (int vt = 0; vt < 3; ++vt)
#pragma unroll
                    for (int r = 0; r < 4; ++r) part[(16 * tt + 4 * fq + r) * PRS + 16 * vt + fr] = __expf(m_prev - fmaxf(m_prev, pm4[r])) * nacc[vt][r];
            }
            if (!(SKIP & 4)) {
                const float decay = __expf(m_prev - mxc);
#pragma unroll
                for (int i = 0; i < 2; ++i)
#pragma unroll
                    for (int vt = 0; vt < 3; ++vt) cacc[i][vt] *= decay;
                const int q_ = fr >> 2, p_ = fr & 3;
                s16x4 wl[2][3], wh[2][3], kl[2][2], kh[2][2];
#pragma unroll
                for (int kk = 0; kk < 2; ++kk) {
#pragma unroll
                    for (int vt = 0; vt < 3; ++vt) {
                        wl[kk][vt] = __builtin_amdgcn_ds_read_tr16_b64_v4i16((LAS s16x4*)(shm + VWT + (32 * kk + 8 * fq + q_) * VRS + (16 * vt + 4 * p_) * 2));
                        wh[kk][vt] = __builtin_amdgcn_ds_read_tr16_b64_v4i16((LAS s16x4*)(shm + VWT + (32 * kk + 8 * fq + 4 + q_) * VRS + (16 * vt + 4 * p_) * 2));
                    }
#pragma unroll
                    for (int i = 0; i < 2; ++i) {
                        const int dt = 2 * wid + i;
                        kl[kk][i] = __builtin_amdgcn_ds_read_tr16_b64_v4i16((LAS s16x4*)(shm + KS + (32 * kk + 8 * fq + q_) * RS + (16 * dt + 4 * p_) * 2));
                        kh[kk][i] = __builtin_amdgcn_ds_read_tr16_b64_v4i16((LAS s16x4*)(shm + KS + (32 * kk + 8 * fq + 4 + q_) * RS + (16 * dt + 4 * p_) * 2));
                    }
                }
#pragma unroll
                for (int kk = 0; kk < 2; ++kk) {
                    bf16x8 bfv[3];
#pragma unroll
                    for (int vt = 0; vt < 3; ++vt) { bfv[vt][0] = wl[kk][vt][0]; bfv[vt][1] = wl[kk][vt][1]; bfv[vt][2] = wl[kk][vt][2]; bfv[vt][3] = wl[kk][vt][3];
                        bfv[vt][4] = wh[kk][vt][0]; bfv[vt][5] = wh[kk][vt][1]; bfv[vt][6] = wh[kk][vt][2]; bfv[vt][7] = wh[kk][vt][3]; }
#pragma unroll
                    for (int i = 0; i < 2; ++i) {
                        bf16x8 af; af[0] = kl[kk][i][0]; af[1] = kl[kk][i][1]; af[2] = kl[kk][i][2]; af[3] = kl[kk][i][3]; af[4] = kh[kk][i][0]; af[5] = kh[kk][i][1]; af[6] = kh[kk][i][2]; af[7] = kh[kk][i][3];
#pragma unroll
                        for (int vt = 0; vt < 3; ++vt) cacc[i][vt] = __builtin_amdgcn_mfma_f32_16x16x32_bf16(af, bfv[vt], cacc[i][vt], 0, 0, 0);
                    }
                }
            }
            __syncthreads();
            if (wid < 4 && !(SKIP & 16)) {
                const f32x4 pm4 = *(const LAS f32x4*)(tp + j * 64 + 16 * tt + 4 * fq);
                const f32x4 bc4 = *(const LAS f32x4*)(tb + j * 64 + 16 * tt + 4 * fq);
#pragma unroll
                for (int vt = 0; vt < 3; ++vt)
#pragma unroll
                    for (int r = 0; r < 4; ++r) nacc[vt][r] += part[(16 * tt + 4 * fq + r) * PRS + 16 * vt + fr];
#pragma unroll
                for (int r = 0; r < 4; ++r) {
                    const float den = __shfl(nacc[2][r], lane & 48);
                    const float inv = __builtin_amdgcn_rcpf(fmaxf(fabsf(den), __expf(-(bc4[r] + fmaxf(m_prev, pm4[r])))));
                    LAS bf16_t* hrow = (LAS bf16_t*)(shm + HST + (16 * tt + 4 * fq + r) * 80);
                    hrow[fr] = f2bf(nacc[0][r] * inv);
                    hrow[16 + fr] = f2bf(nacc[1][r] * inv);
                }
                asm volatile("s_waitcnt lgkmcnt(0)" ::: "memory");
                {
                    const int rw = 16 * tt + (lane >> 2), pc = lane & 3;
                    const u32x4 hv = *(const LAS u32x4*)(shm + HST + rw * 80 + pc * 16);
                    *(uint4*)(hc + cb + (size_t)rw * DM + vs * 32 + pc * 8) = make_uint4(hv[0], hv[1], hv[2], hv[3]);
                }
            }
#pragma unroll
            for (int i = 0; i < 2; ++i)
#pragma unroll
                for (int vt = 0; vt < 3; ++vt) {
                    u32x2 o; o[0] = pk2(cacc[i][vt][0], cacc[i][vt][1]); o[1] = pk2(cacc[i][vt][2], cacc[i][vt][3]);
                    *(LAS u32x2*)(shm + CB + (16 * vt + fr) * RS + (16 * (2 * wid + i) + 4 * fq) * 2) = o;
                }
            m_prev = btot + mxc;
        }
    }
}

constexpr int S5L = 32, S5NCH = SEQ / S5L;
constexpr size_t T_KT_OFF = 0, T_WS_OFF = 2u << 20, T_V_OFF = 10u << 20, T_AL_OFF = 18u << 20;
constexpr int KT_G = 33 * 256, WS_G = 128 * 512, V_G = 512 * 128;

DEV void s5_tables(LAS char* shm, char* tab, const float* lam_re, const float* lam_im, const float* log_dt, const float* b_re, const float* b_im,
                   const float* c_re, const float* c_im) {
    const int tid = opaque_tid();
    LAS f32x2* apw = (LAS f32x2*)shm;
    LAS f32x2* bb = (LAS f32x2*)(shm + 64 * 33 * 8);
    LAS f32x2* cc = (LAS f32x2*)(shm + 64 * 33 * 8 + 8192);
    bf16_t* KT = (bf16_t*)(tab + T_KT_OFF); bf16_t* WS = (bf16_t*)(tab + T_WS_OFF); bf16_t* VV = (bf16_t*)(tab + T_V_OFF); float2* AL = (float2*)(tab + T_AL_OFF);
    for (int it = blockIdx.x; it < 256; it += gridDim.x) {
        const int g = it & 63, qd = it >> 6;
        __syncthreads();
        if (tid < 64) {
            const int pp = tid;
            const double lr = lam_re[g * NP + pp], li = lam_im[g * NP + pp], dt = exp((double)log_dt[g]);
            const double er = exp(lr * dt);
            const double ar = er * cos(li * dt), ai = er * sin(li * dt);
            const double dr = ar - 1.0, di = ai, den = lr * lr + li * li;
            const double cr = (dr * lr + di * li) / den, ci = (di * lr - dr * li) / den;
            double pr = 1.0, pi_ = 0.0;
            for (int e = 0; e <= 32; ++e) {
                apw[pp * 33 + e] = (f32x2){(float)pr, (float)pi_};
                const double nr = pr * ar - pi_ * ai, ni = pr * ai + pi_ * ar; pr = nr; pi_ = ni;
            }
            if (qd == 0) { const f32x2 t_ = apw[pp * 33 + 32]; AL[g * NP + pp] = make_float2(t_.x, t_.y); }
            for (int c = 0; c < 16; ++c) {
                const double br = b_re[(g * NP + pp) * GC + c], bi = b_im[(g * NP + pp) * GC + c];
                bb[pp * 16 + c] = (f32x2){(float)(cr * br - ci * bi), (float)(cr * bi + ci * br)};
                cc[c * 64 + pp] = (f32x2){c_re[(g * GC + c) * NP + pp], c_im[(g * GC + c) * NP + pp]};
            }
        }
        __syncthreads();
        for (int o = tid; o < 8 * 256; o += 512) {
            const int d = 8 * qd + (o >> 8), c1 = (o >> 4) & 15, c0 = o & 15;
            float acc = 0.f;
            for (int pp = 0; pp < 64; ++pp) {
                const f32x2 a = apw[pp * 33 + d], b = bb[pp * 16 + c0], c = cc[c1 * 64 + pp];
                const float mr = a.x * b.x - a.y * b.y, mi = a.x * b.y + a.y * b.x;
                acc += c.x * mr - c.y * mi;
            }
            KT[(size_t)g * KT_G + (d + 1) * 256 + c1 * 16 + c0] = f2bf(acc);
        }
        if (qd == 0 && tid < 256) KT[(size_t)g * KT_G + tid] = 0;
        for (int o = tid; o < 2 * 16 * 64; o += 512) {
            const int mt = 2 * qd + (o >> 10), sp = (o >> 6) & 15, ln = o & 63;
            const int row = 16 * mt + (ln & 15), ri = row >> 6, pp = row & 63, s_ = 2 * sp + (ln >> 5), c0 = 8 * ((ln >> 4) & 1);
            const f32x2 a = apw[pp * 33 + 31 - s_];
            unsigned w[4];
#pragma unroll
            for (int jj = 0; jj < 8; jj += 2) {
                const f32x2 b0 = bb[pp * 16 + c0 + jj], b1 = bb[pp * 16 + c0 + jj + 1];
                const float v0 = ri ? (a.x * b0.y + a.y * b0.x) : (a.x * b0.x - a.y * b0.y);
                const float v1 = ri ? (a.x * b1.y + a.y * b1.x) : (a.x * b1.x - a.y * b1.y);
                w[jj >> 1] = pk2(v0, v1);
            }
            *(uint4*)(WS + (size_t)g * WS_G + ((size_t)(mt * 16 + sp) * 64 + ln) * 8) = make_uint4(w[0], w[1], w[2], w[3]);
        }
        for (int o = tid; o < 8 * 4 * 64; o += 512) {
            const int i = 8 * qd + (o >> 8), ks = (o >> 6) & 3, ln = o & 63;
            const int c1 = ln & 15, k0 = 32 * ks + 8 * (ln >> 4);
            unsigned w[4];
#pragma unroll
            for (int jj = 0; jj < 8; jj += 2) {
                float v[2];
#pragma unroll
                for (int e = 0; e < 2; ++e) {
                    const int kk = k0 + jj + e, ri = kk >> 6, pp = kk & 63;
                    const f32x2 a = apw[pp * 33 + i + 1], c = cc[c1 * 64 + pp];
                    v[e] = ri ? -(c.x * a.y + c.y * a.x) : (c.x * a.x - c.y * a.y);
                }
                w[jj >> 1] = pk2(v[0], v[1]);
            }
            *(uint4*)(VV + (size_t)g * V_G + ((size_t)(i * 4 + ks) * 64 + ln) * 8) = make_uint4(w[0], w[1], w[2], w[3]);
        }
    }
}

template <int NQ>
DEV void s5_p1_range(LAS char* shm, int lo, int hi, int wid, int fr, int fq, const bf16_t* wsp, f32x4 (&acc)[4][4], f32x4 (&sac)[4]) {
    constexpr int PLANE = 64 * 528, KTL = 2 * PLANE, Q0 = 4 - NQ;
    if (lo > hi) return;
    const LAS char* ub = shm + (fq & 1) * PLANE + fr * 528 + (fq >> 1) * 16;
    const LAS char* kb = shm + KTL + (1 - (fq >> 1)) * 512 + fr * 32 + (fq & 1) * 16;
    bf16x8 bu[4], kf[NQ], wcur;
#pragma unroll
    for (int nt = 0; nt < 4; ++nt) bu[nt] = *(const LAS bf16x8*)(ub + nt * 16 * 528 + lo * 32);
#pragma unroll
    for (int q = 0; q < NQ; ++q) kf[q] = *(const LAS bf16x8*)(kb + (wid + 8 * (Q0 + q) - 2 * lo) * 512);
    wcur = *(const bf16x8*)(wsp + (size_t)lo * 64 * 8);
#pragma nounroll
    for (int sp = lo; sp <= hi; ++sp) {
        bf16x8 bn[4], kn[NQ], wn = wcur;
        const int sn = (sp < hi) ? sp + 1 : sp;
#pragma unroll
        for (int nt = 0; nt < 4; ++nt) bn[nt] = *(const LAS bf16x8*)(ub + nt * 16 * 528 + sn * 32);
#pragma unroll
        for (int q = 0; q < NQ; ++q) kn[q] = *(const LAS bf16x8*)(kb + (wid + 8 * (Q0 + q) - 2 * sn) * 512);
        wn = *(const bf16x8*)(wsp + (size_t)sn * 64 * 8);
#pragma unroll
        for (int nt = 0; nt < 4; ++nt) sac[nt] = __builtin_amdgcn_mfma_f32_16x16x32_bf16(wcur, bu[nt], sac[nt], 0, 0, 0);
#pragma unroll
        for (int q = 0; q < NQ; ++q)
#pragma unroll
            for (int nt = 0; nt < 4; ++nt) acc[Q0 + q][nt] = __builtin_amdgcn_mfma_f32_16x16x32_bf16(kf[q], bu[nt], acc[Q0 + q][nt], 0, 0, 0);
#pragma unroll
        for (int nt = 0; nt < 4; ++nt) bu[nt] = bn[nt];
#pragma unroll
        for (int q = 0; q < NQ; ++q) kf[q] = kn[q];
        wcur = wn;
    }
}
DEV void s5_phase(LAS char* shm, const bf16_t* Uin, bf16_t* Yout, const char* tab, const float* dskip) {
    const int tid = opaque_tid(), wid = __builtin_amdgcn_readfirstlane(tid >> 6), lane = tid & 63, fr = lane & 15, fq = lane >> 4;
    constexpr int PLANE = 64 * 528, KTL = 2 * PLANE, SL = KTL + 33 * 512, HB = SL + 64 * 528, SRS = 528, HRS = 272, TSEG = HB + 64 * 272;
    const bf16_t* KT = (const bf16_t*)(tab + T_KT_OFF); const bf16_t* WS = (const bf16_t*)(tab + T_WS_OFF); const bf16_t* VV = (const bf16_t*)(tab + T_V_OFF);
    const float2* AL = (const float2*)(tab + T_AL_OFF);
    for (int item = blockIdx.x; item < BATCH * NG; item += gridDim.x) {
        const int xcd_ = item & 7, j_ = (item >> 3) & 31, g = xcd_ * 8 + (j_ & 7), b = (j_ >> 3) + 4 * (item >> 8);
        const bf16_t* Ub = Uin + ((size_t)g * MTOK + (size_t)b * SEQ) * 16;
        bf16_t* Yb = Yout + ((size_t)g * MTOK + (size_t)b * SEQ) * 16;
        __syncthreads();
#pragma unroll
        for (int i = 0; i < 8; ++i) {
            const int idx = tid + 512 * i, tok = idx >> 1, hf = idx & 1;
            const uint4 uv = *(const uint4*)(Ub + (size_t)tok * 16 + hf * 8);
            *(LAS u32x4*)(shm + hf * PLANE + (tok >> 5) * 528 + (tok & 31) * 16) = (u32x4){uv.x, uv.y, uv.z, uv.w};
        }
        for (int idx = tid; idx < 33 * 32; idx += 512) {
            const uint4 kv = *(const uint4*)(KT + (size_t)g * KT_G + idx * 8);
            *(LAS u32x4*)(shm + KTL + idx * 16) = (u32x4){kv.x, kv.y, kv.z, kv.w};
        }
        __syncthreads();
        f32x4 acc[4][4], sac[4];
#pragma unroll
        for (int q = 0; q < 4; ++q)
#pragma unroll
            for (int nt = 0; nt < 4; ++nt) acc[q][nt] = (f32x4){0.f, 0.f, 0.f, 0.f};
#pragma unroll
        for (int nt = 0; nt < 4; ++nt) sac[nt] = (f32x4){0.f, 0.f, 0.f, 0.f};
        const bf16_t* wsp = WS + (size_t)g * WS_G + ((size_t)(wid * 16) * 64 + lane) * 8;
        const int h2 = wid >> 1;
        s5_p1_range<4>(shm, 0, h2, wid, fr, fq, wsp, acc, sac);
        s5_p1_range<3>(shm, h2 + 1, 4 + h2, wid, fr, fq, wsp, acc, sac);
        s5_p1_range<2>(shm, 5 + h2, 8 + h2, wid, fr, fq, wsp, acc, sac);
        s5_p1_range<1>(shm, 9 + h2, 12 + h2, wid, fr, fq, wsp, acc, sac);
        if (13 + h2 <= 15) {
            const LAS char* ub = shm + (fq & 1) * PLANE + fr * 528 + (fq >> 1) * 16;
            for (int sp = 13 + h2; sp <= 15; ++sp) {
                const bf16x8 wcur = *(const bf16x8*)(wsp + (size_t)sp * 64 * 8);
#pragma unroll
                for (int nt = 0; nt < 4; ++nt) sac[nt] = __builtin_amdgcn_mfma_f32_16x16x32_bf16(wcur, *(const LAS bf16x8*)(ub + nt * 16 * 528 + sp * 32), sac[nt], 0, 0, 0);
            }
        }
#pragma unroll
        for (int nt = 0; nt < 4; ++nt) *(LAS f32x4*)(shm + SL + (16 * nt + fr) * SRS + (16 * wid + 4 * fq) * 4) = sac[nt];
        __syncthreads();
        {
            const float2 al = AL[g * NP + lane];
            float hr = 0.f, hi = 0.f, lr[8], li[8];
#pragma unroll
            for (int n = 0; n < 8; ++n) {
                lr[n] = hr; li[n] = hi;
                const float sr = *(const LAS float*)(shm + SL + (8 * wid + n) * SRS + lane * 4), si = *(const LAS float*)(shm + SL + (8 * wid + n) * SRS + (64 + lane) * 4);
                const float nr = al.x * hr - al.y * hi + sr, ni = al.x * hi + al.y * hr + si; hr = nr; hi = ni;
            }
            *(LAS float*)(shm + TSEG + (wid * 128 + lane) * 4) = hr; *(LAS float*)(shm + TSEG + (wid * 128 + 64 + lane) * 4) = hi;
            float pr = al.x, pi = al.y;
#pragma unroll
            for (int e = 0; e < 3; ++e) { const float nr = pr * pr - pi * pi, ni = 2.f * pr * pi; pr = nr; pi = ni; }
            __syncthreads();
            float cr = 0.f, ci = 0.f;
            for (int w2 = 0; w2 < wid; ++w2) {
                const float tr = *(const LAS float*)(shm + TSEG + (w2 * 128 + lane) * 4), ti = *(const LAS float*)(shm + TSEG + (w2 * 128 + 64 + lane) * 4);
                const float nr = pr * cr - pi * ci + tr, ni = pr * ci + pi * cr + ti; cr = nr; ci = ni;
            }
            float qr = 1.f, qi = 0.f;
#pragma unroll
            for (int n = 0; n < 8; ++n) {
                const float fr_ = lr[n] + qr * cr - qi * ci, fi_ = li[n] + qr * ci + qi * cr;
                *(LAS bf16_t*)(shm + HB + (8 * wid + n) * HRS + lane * 2) = f2bf(fr_);
                *(LAS bf16_t*)(shm + HB + (8 * wid + n) * HRS + (64 + lane) * 2) = f2bf(fi_);
                const float nr = qr * al.x - qi * al.y, ni = qr * al.y + qi * al.x; qr = nr; qi = ni;
            }
        }
        __syncthreads();
        const bf16_t* vvp = VV + (size_t)g * V_G + (size_t)lane * 8;
        bf16x8 va[4];
#pragma unroll
        for (int q = 0; q < 4; ++q) va[q] = *(const bf16x8*)(vvp + ((size_t)((wid + 8 * q) * 4 + 0) * 64) * 8);
#pragma unroll
        for (int ks = 0; ks < 4; ++ks) {
            bf16x8 hb[4], vn[4];
#pragma unroll
            for (int nt = 0; nt < 4; ++nt) hb[nt] = *(const LAS bf16x8*)(shm + HB + (16 * nt + fr) * HRS + (32 * ks + 8 * fq) * 2);
#pragma unroll
            for (int q = 0; q < 4; ++q) vn[q] = (ks < 3) ? *(const bf16x8*)(vvp + ((size_t)((wid + 8 * q) * 4 + ks + 1) * 64) * 8) : va[q];
#pragma unroll
            for (int q = 0; q < 4; ++q)
#pragma unroll
                for (int nt = 0; nt < 4; ++nt) acc[q][nt] = __builtin_amdgcn_mfma_f32_16x16x32_bf16(va[q], hb[nt], acc[q][nt], 0, 0, 0);
#pragma unroll
            for (int q = 0; q < 4; ++q) va[q] = vn[q];
        }
        const float4 dsk = *(const float4*)(dskip + g * GC + 4 * fq);
#pragma unroll
        for (int q = 0; q < 4; ++q) {
            const int i = wid + 8 * q;
#pragma unroll
            for (int nt = 0; nt < 4; ++nt) {
                const int n = 16 * nt + fr;
                const u32x2 uu = *(const LAS u32x2*)(shm + (fq >> 1) * PLANE + n * 528 + i * 16 + ((4 * fq) & 7) * 2);
                f32x4 o;
                o[0] = geluf_(acc[q][nt][0] + dsk.x * bf2f((bf16_t)(uu[0] & 0xffff))); o[1] = geluf_(acc[q][nt][1] + dsk.y * bf2f((bf16_t)(uu[0] >> 16)));
                o[2] = geluf_(acc[q][nt][2] + dsk.z * bf2f((bf16_t)(uu[1] & 0xffff))); o[3] = geluf_(acc[q][nt][3] + dsk.w * bf2f((bf16_t)(uu[1] >> 16)));
                *(uint2*)(Yb + (size_t)(n * 32 + i) * 16 + 4 * fq) = pack4(o);
            }
        }
    }
}


DEV void norm_rows(const float* x, const float* gain, const float* modl, bf16_t* h) {
    const int tid = opaque_tid(), lane = tid & 63, gw = blockIdx.x * 8 + (tid >> 6), NGW = gridDim.x * 8;
    for (int m0 = gw * 2; m0 < MTOK; m0 += NGW * 2) {
        float4 v[2][4]; float ss[2] = {0.f, 0.f};
#pragma unroll
        for (int r = 0; r < 2; ++r) { const float4* xr = (const float4*)(x + (size_t)(m0 + r) * DM) + lane;
#pragma unroll
            for (int j = 0; j < 4; ++j) v[r][j] = xr[64 * j]; }
#pragma unroll
        for (int r = 0; r < 2; ++r) {
#pragma unroll
            for (int j = 0; j < 4; ++j) ss[r] += v[r][j].x * v[r][j].x + v[r][j].y * v[r][j].y + v[r][j].z * v[r][j].z + v[r][j].w * v[r][j].w;
            const float rstd = rsqrtf(wave_sum(ss[r]) * (1.f / DM) + EPS);
            const int m = m0 + r;
            const float* shift = modl + (size_t)(m / SEQ) * 3 * DM; const float* scale = shift + DM;
#pragma unroll
            for (int j = 0; j < 4; ++j) {
                const int n = 4 * lane + 256 * j;
                const float4 g = *(const float4*)(gain + n), sc = *(const float4*)(scale + n), sh = *(const float4*)(shift + n);
                f32x4 o; o[0] = v[r][j].x * rstd * g.x * (1.f + sc.x) + sh.x; o[1] = v[r][j].y * rstd * g.y * (1.f + sc.y) + sh.y;
                o[2] = v[r][j].z * rstd * g.z * (1.f + sc.z) + sh.z; o[3] = v[r][j].w * rstd * g.w * (1.f + sc.w) + sh.w;
                *(uint2*)(h + (size_t)m * DM + n) = pack4(o);
            }
        }
    }
}
DEV void ssm_post_rows(const bf16_t* z, bf16_t* zo, const bf16_t* sg, const float* gain) {
    const int tid = opaque_tid(), lane = tid & 63, gw = blockIdx.x * 8 + (tid >> 6), NGW = gridDim.x * 8;
    for (int m = gw; m < MTOK; m += NGW) {
        float zv[2][8], gv[2][8]; float ss = 0.f;
#pragma unroll
        for (int j = 0; j < 2; ++j) {
            unpack8(*(const uint4*)(z + (size_t)m * DM + 8 * lane + 512 * j), zv[j]);
            unpack8(*(const uint4*)(sg + (size_t)m * DM + 8 * lane + 512 * j), gv[j]);
#pragma unroll
            for (int e = 0; e < 8; ++e) ss += zv[j][e] * zv[j][e];
        }
        const float rstd = rsqrtf(wave_sum(ss) * (1.f / DM) + EPS);
#pragma unroll
        for (int j = 0; j < 2; ++j) {
            const int n = 8 * lane + 512 * j; float o[8];
#pragma unroll
            for (int e = 0; e < 8; ++e) o[e] = zv[j][e] * rstd * gain[n + e] * siluf_(gv[j][e]);
            *(uint4*)(zo + (size_t)m * DM + n) = pack8(o);
        }
    }
}
DEV void mlstm_post_rows(const bf16_t* hc, bf16_t* ho, const bf16_t* mo, const bf16_t* mg, const bf16_t* mi, const float* cw, const float* cb, const float* ngain, const float* skip) {
    const int tid = opaque_tid(), lane = tid & 63, gw = blockIdx.x * 8 + (tid >> 6), NGW = gridDim.x * 8;
    for (int m = gw; m < MTOK; m += NGW) {
        const size_t o0 = (size_t)m * DM + 16 * lane;
        float hv[16], t8[8]; float s1 = 0.f;
#pragma unroll
        for (int j = 0; j < 2; ++j) {
            unpack8(*(const uint4*)(hc + o0 + 8 * j), hv + 8 * j);
            unpack8(*(const uint4*)(mo + o0 + 8 * j), t8);
#pragma unroll
            for (int e = 0; e < 8; ++e) { hv[8 * j + e] *= sigmoidf_(t8[e]); s1 += hv[8 * j + e]; }
        }
#pragma unroll
        for (int o = 1; o < 16; o <<= 1) s1 += __shfl_xor(s1, o);
        const float mu = s1 * (1.f / DH); float s2 = 0.f;
#pragma unroll
        for (int e = 0; e < 16; ++e) { hv[e] -= mu; s2 += hv[e] * hv[e]; }
#pragma unroll
        for (int o = 1; o < 16; o <<= 1) s2 += __shfl_xor(s2, o);
        const float rstd = rsqrtf(s2 * (1.f / DH) + EPS);
#pragma unroll
        for (int j = 0; j < 2; ++j) {
            float xv[8], gv[8], ov[8], t8b[8];
            { const int n0 = 16 * lane + 8 * j, tpos = m % SEQ;
#pragma unroll
              for (int e = 0; e < 8; ++e) xv[e] = cb[n0 + e];
#pragma unroll
              for (int tap = 0; tap < 4; ++tap) if (tpos - 3 + tap >= 0) {
                  unpack8(*(const uint4*)(mi + (size_t)(m - 3 + tap) * DM + n0), t8b);
#pragma unroll
                  for (int e = 0; e < 8; ++e) xv[e] += t8b[e] * cw[tap * DM + n0 + e];
              }
#pragma unroll
              for (int e = 0; e < 8; ++e) xv[e] = siluf_(xv[e]); }
            unpack8(*(const uint4*)(mg + o0 + 8 * j), gv);
#pragma unroll
            for (int e = 0; e < 8; ++e) { const int n = 16 * lane + 8 * j + e; ov[e] = (hv[8 * j + e] * rstd * ngain[n] + skip[n] * xv[e]) * siluf_(gv[e]); }
            *(uint4*)(ho + o0 + 8 * j) = pack8(ov);
        }
    }
}
DEV void final_rows(float* x, const float* gain) {
    const int tid = opaque_tid(), lane = tid & 63, gw = blockIdx.x * 8 + (tid >> 6), NGW = gridDim.x * 8;
    for (int m = gw; m < MTOK; m += NGW) {
        float4* xr = (float4*)(x + (size_t)m * DM) + lane;
        float4 v[4]; float ss = 0.f;
#pragma unroll
        for (int j = 0; j < 4; ++j) { v[j] = xr[64 * j]; ss += v[j].x * v[j].x + v[j].y * v[j].y + v[j].z * v[j].z + v[j].w * v[j].w; }
        const float rstd = rsqrtf(wave_sum(ss) * (1.f / DM) + EPS);
#pragma unroll
        for (int j = 0; j < 4; ++j) {
            const float4 g = *(const float4*)(gain + 4 * lane + 256 * j);
            v[j].x *= rstd * g.x; v[j].y *= rstd * g.y; v[j].z *= rstd * g.z; v[j].w *= rstd * g.w;
            xr[64 * j] = v[j];
        }
    }
}
DEV void mod_phase(LAS char* shm, const float* c, const float* w_mod, const float* b_mod, float* mod) {
    const int tid = opaque_tid();
    LAS float* sc = (LAS float*)shm;
    LAS float* pr = (LAS float*)(shm + 32768);
    if ((int)blockIdx.x >= 192) return;
    __syncthreads();
    for (int i = tid; i < BATCH * DM; i += 512) sc[i] = siluf_(c[i]);
    __syncthreads();
    for (int it = blockIdx.x; it < 192; it += gridDim.x) {
        const int l = it / 96, n0 = (it % 96) * 32, cq = tid & 7, kg = tid >> 3;
        const float* W = w_mod + (size_t)l * DM * 3 * DM + n0 + 4 * cq;
        float acc[BATCH][4];
#pragma unroll
        for (int b = 0; b < BATCH; ++b) { acc[b][0] = acc[b][1] = acc[b][2] = acc[b][3] = 0.f; }
        float4 w[16];
#pragma unroll
        for (int k = 0; k < 16; ++k) w[k] = *(const float4*)(W + (size_t)(kg * 16 + k) * 3 * DM);
#pragma unroll
        for (int k = 0; k < 16; ++k) {
#pragma unroll
            for (int b = 0; b < BATCH; ++b) { const float s_ = sc[b * DM + kg * 16 + k]; acc[b][0] += s_ * w[k].x; acc[b][1] += s_ * w[k].y; acc[b][2] += s_ * w[k].z; acc[b][3] += s_ * w[k].w; }
        }
#pragma unroll
        for (int b = 0; b < BATCH; ++b) *(LAS f32x4*)(pr + (kg * 8 + b) * 32 + 4 * cq) = (f32x4){acc[b][0], acc[b][1], acc[b][2], acc[b][3]};
        __syncthreads();
        if (tid < 256) {
            const int b = tid >> 5, n = tid & 31; float s_ = 0.f;
#pragma unroll 8
            for (int g2 = 0; g2 < 64; ++g2) s_ += pr[(g2 * 8 + b) * 32 + n];
            mod[((size_t)l * BATCH + b) * 3 * DM + n0 + n] = s_ + b_mod[l * 3 * DM + n0 + n];
        }
        __syncthreads();
    }
}

DEV void wfold_prep(bf16_t* WfT, const float* wq, const float* wk, const float* wv, const float* wg  ) {
    const int tid = opaque_tid(), lane = tid & 63;
    for (int t = blockIdx.x * 8 + (tid >> 6); t < 2048; t += gridDim.x * 8) {
        const int which = t >> 10, ch = t & 1023, hd = ch >> 8, d = ch & 255;
        float acc[8];
#pragma unroll
        for (int j = 0; j < 8; ++j) acc[j] = 0.f;
        if (which == 0) {
            const float4 q4 = *(const float4*)(wq + ((size_t)hd * DH + d) * DH + 4 * lane);
            const float4 k4 = *(const float4*)(wk + ((size_t)hd * DH + d) * DH + 4 * lane);
            const float qv[4] = {q4.x, q4.y, q4.z, q4.w}, kv[4] = {k4.x * 0.0625f, k4.y * 0.0625f, k4.z * 0.0625f, k4.w * 0.0625f};
#pragma unroll
            for (int e = 0; e < 4; ++e) {
                const float* g1 = wg + (size_t)(hd * DH + 4 * lane + e) * 8; const float* g2 = wg + (size_t)(DM + hd * DH + 4 * lane + e) * 8;
                const float4 a0 = *(const float4*)g1, a1 = *(const float4*)(g1 + 4), b0 = *(const float4*)g2, b1 = *(const float4*)(g2 + 4);
                acc[0] += qv[e] * a0.x + kv[e] * b0.x; acc[1] += qv[e] * a0.y + kv[e] * b0.y; acc[2] += qv[e] * a0.z + kv[e] * b0.z; acc[3] += qv[e] * a0.w + kv[e] * b0.w;
                acc[4] += qv[e] * a1.x + kv[e] * b1.x; acc[5] += qv[e] * a1.y + kv[e] * b1.y; acc[6] += qv[e] * a1.z + kv[e] * b1.z; acc[7] += qv[e] * a1.w + kv[e] * b1.w;
            }
        } else {
            const float4 v4 = *(const float4*)(wv + ((size_t)hd * DH + d) * DH + 4 * lane);
            const float vv[4] = {v4.x, v4.y, v4.z, v4.w};
#pragma unroll
            for (int e = 0; e < 4; ++e) {
                const float* g1 = wg + (size_t)(2 * DM + hd * DH + 4 * lane + e) * 8;
                const float4 a0 = *(const float4*)g1, a1 = *(const float4*)(g1 + 4);
                acc[0] += vv[e] * a0.x; acc[1] += vv[e] * a0.y; acc[2] += vv[e] * a0.z; acc[3] += vv[e] * a0.w;
                acc[4] += vv[e] * a1.x; acc[5] += vv[e] * a1.y; acc[6] += vv[e] * a1.z; acc[7] += vv[e] * a1.w;
            }
        }
#pragma unroll
        for (int j = 0; j < 8; ++j) acc[j] = wave_sum(acc[j]);
        if (lane < 16) {
            float v = 0.f;
#pragma unroll
            for (int j = 0; j < 8; ++j) v = (lane == j) ? acc[j] : v;
            WfT[((size_t)which * 16 + lane) * 1024 + ch] = f2bf(v);
        }
    }
}
DEV void xc_gates_phase(LAS char* shm, const bf16_t* mi, bf16_t* xc, const bf16_t* WfT, const float* cw, const float* cb, float* gpart  ) {
    const int tid = opaque_tid(), wid = __builtin_amdgcn_readfirstlane(tid >> 6), lane = tid & 63, fr = lane & 15, fq = lane >> 4;
    constexpr int WRS = 2064, WIMG = 8 * WRS, CWL = 2 * WIMG, STG = CWL + 5 * 4096, SRS_ = 528, STG_W = 19 * SRS_;
    __syncthreads();
    for (int i = tid; i < 2 * 8 * 128; i += 512) {
        const int rowi = i >> 7, pc = i & 127;
        const uint4 v = *(const uint4*)(WfT + (size_t)((rowi >> 3) * 16 + (rowi & 7)) * 1024 + pc * 8);
        *(LAS u32x4*)(shm + rowi * WRS + pc * 16) = (u32x4){v.x, v.y, v.z, v.w};
    }
    for (int i = tid; i < 5 * 256; i += 512) {
        const float4 v = (i < 1024) ? *(const float4*)(cw + i * 4) : *(const float4*)(cb + (i - 1024) * 4);
        *(LAS f32x4*)(shm + CWL + i * 16) = (f32x4){v.x, v.y, v.z, v.w};
    }
    __syncthreads();
    LAS char* stg = shm + STG + wid * STG_W;
    for (int task = blockIdx.x * 8 + wid; task < (MTOK / 16) * 2; task += gridDim.x * 8) {
        const int chalf = task & 1, m0 = (task >> 1) * 16, tpos0 = m0 % SEQ;
        f32x4 acc = (f32x4){0.f, 0.f, 0.f, 0.f};
        uint4 pre[10];
#pragma unroll
        for (int it = 0; it < 10; ++it) {
            const int i = lane + 64 * it, row = i >> 5, pc = i & 31;
            pre[it] = make_uint4(0, 0, 0, 0);
            if (i < 19 * 32 && tpos0 - 3 + row >= 0) pre[it] = *(const uint4*)(mi + (size_t)(m0 - 3 + row) * DM + chalf * 512 + pc * 8);
        }
#pragma nounroll
        for (int sl = 0; sl < 2; ++sl) {
            const int c0 = chalf * 512 + sl * 256;
#pragma unroll
            for (int it = 0; it < 10; ++it) {
                const int i = lane + 64 * it, row = i >> 5, pc = i & 31;
                if (i < 19 * 32) *(LAS u32x4*)(stg + row * SRS_ + pc * 16) = (u32x4){pre[it].x, pre[it].y, pre[it].z, pre[it].w};
            }
            if (sl == 0) {
#pragma unroll
                for (int it = 0; it < 10; ++it) {
                    const int i = lane + 64 * it, row = i >> 5, pc = i & 31;
                    pre[it] = make_uint4(0, 0, 0, 0);
                    if (i < 19 * 32 && tpos0 - 3 + row >= 0) pre[it] = *(const uint4*)(mi + (size_t)(m0 - 3 + row) * DM + c0 + 256 + pc * 8);
                }
            }
#pragma nounroll
            for (int ks = 0; ks < 8; ++ks) {
                const int cl = 32 * ks + 8 * fq, c = c0 + cl;
                float xv[8], t8[8];
                { const f32x4 b0 = *(const LAS f32x4*)(shm + CWL + 16384 + c * 4), b1 = *(const LAS f32x4*)(shm + CWL + 16384 + c * 4 + 16);
                  xv[0] = b0[0]; xv[1] = b0[1]; xv[2] = b0[2]; xv[3] = b0[3]; xv[4] = b1[0]; xv[5] = b1[1]; xv[6] = b1[2]; xv[7] = b1[3]; }
                u32x4 raw3;
#pragma unroll
                for (int tap = 0; tap < 4; ++tap) {
                    const u32x4 rw = *(const LAS u32x4*)(stg + (fr + tap) * SRS_ + cl * 2);
                    if (tap == 3) raw3 = rw;
                    unpack8(make_uint4(rw[0], rw[1], rw[2], rw[3]), t8);
                    const f32x4 w0 = *(const LAS f32x4*)(shm + CWL + tap * 4096 + c * 4), w1 = *(const LAS f32x4*)(shm + CWL + tap * 4096 + c * 4 + 16);
                    xv[0] += t8[0] * w0[0]; xv[1] += t8[1] * w0[1]; xv[2] += t8[2] * w0[2]; xv[3] += t8[3] * w0[3];
                    xv[4] += t8[4] * w1[0]; xv[5] += t8[5] * w1[1]; xv[6] += t8[6] * w1[2]; xv[7] += t8[7] * w1[3];
                }
#pragma unroll
                for (int e = 0; e < 8; ++e) xv[e] = siluf_(xv[e]);
                const uint4 xp = pack8(xv);
                *(uint4*)(xc + (size_t)(m0 + fr) * DM + c) = xp;
                const u32x4 xpu = (u32x4){xp.x, xp.y, xp.z, xp.w};
                const bf16x8 bx = *(const LAS bf16x8*)(shm + (fr & 7) * WRS + c * 2);
                const bf16x8 bv = *(const LAS bf16x8*)(shm + WIMG + (fr & 7) * WRS + c * 2);
                acc = __builtin_amdgcn_mfma_f32_16x16x32_bf16(*(const bf16x8*)&xpu, bx, acc, 0, 0, 0);
                acc = __builtin_amdgcn_mfma_f32_16x16x32_bf16(*(const bf16x8*)&raw3, bv, acc, 0, 0, 0);
            }
        }
        if (fr < 8) {
#pragma unroll
            for (int r = 0; r < 4; ++r) gpart[((size_t)chalf * MTOK + m0 + 4 * fq + r) * 8 + fr] = acc[r];
        }
    }
}

#define XB_TMO      128
#define XB_XCNT(j)  (256  + 64 * (j))
#define XB_XSUB(j)  (1280 + 64 * (j))
#define XB_XGEN(j)  (2304 + 64 * (j))
#define XB_TOP      3328
#define XB_TOPGEN   3392
#define XCD_BAR_WORDS 3456
#define XB_SPIN_CAP (1u << 18)
DEV unsigned xb_ld(unsigned* p) { return __hip_atomic_load(p, __ATOMIC_RELAXED, __HIP_MEMORY_SCOPE_AGENT); }
DEV unsigned xb_add(unsigned* p, unsigned v) { return __hip_atomic_fetch_add(p, v, __ATOMIC_RELAXED, __HIP_MEMORY_SCOPE_AGENT); }
DEV unsigned xb_xcc_id() { return (unsigned)__builtin_amdgcn_s_getreg((3 << 11) | 20) & 0xFu; }
#define XB_SPIN(cond, bar) do { unsigned _sp = 0; while (cond) { __builtin_amdgcn_s_sleep(1); \
    if ((++_sp & 255u) == 0u) { if (xb_ld(&(bar)[XB_TMO])) break; if (_sp > XB_SPIN_CAP) { atomicAdd(&(bar)[XB_TMO], 1u); break; } } } } while (0)
struct XcdBarrier { unsigned* bar; unsigned x; volatile LAS unsigned* st; };
DEV XcdBarrier xcd_barrier_post(unsigned* bar, volatile LAS unsigned* st) {
    XcdBarrier b; b.bar = bar; b.x = xb_xcc_id(); b.st = st;
    if (threadIdx.x == 0) (void)xb_add(&bar[XB_XCNT(b.x)], 1u);
    return b;
}
DEV void xcd_barrier_complete(unsigned* bar, unsigned x, unsigned& nloc, unsigned& nx) {
    const unsigned G = gridDim.x * gridDim.y * gridDim.z;
    unsigned sum, cnt, mine, sp = 0u;
    for (;;) {
        sum = 0u; cnt = 0u; mine = 0u;
#pragma nounroll
        for (unsigned j = 0; j < 16; ++j) { const unsigned c = xb_ld(&bar[XB_XCNT(j)]); sum += c; cnt += (c > 0u) ? 1u : 0u; }
        mine = xb_ld(&bar[XB_XCNT(x)]);
        if (sum == G) break;
        __builtin_amdgcn_s_sleep(1);
        if ((++sp & 255u) == 0u) { if (xb_ld(&bar[XB_TMO])) break; if (sp > XB_SPIN_CAP) { atomicAdd(&bar[XB_TMO], 1u); break; } }
    }
    nloc = mine > 0u ? mine : 1u; nx = cnt > 0u ? cnt : 1u;
}
DEV void xcd_barrier1(const XcdBarrier& b) {
    asm volatile("s_waitcnt vmcnt(0)" ::: "memory");
    __syncthreads();
    if (threadIdx.x == 0) {
        unsigned* bar = b.bar;
        __builtin_amdgcn_s_waitcnt(0);
        unsigned nloc = b.st[0], nx = b.st[1];
        if (nloc == 0u) { xcd_barrier_complete(bar, b.x, nloc, nx); b.st[0] = nloc; b.st[1] = nx; }
        const unsigned old = xb_add(&bar[XB_XSUB(b.x)], 1u);
        const unsigned gen = old / nloc;
        if (old + 1u == (gen + 1u) * nloc) {
            __builtin_amdgcn_fence(__ATOMIC_RELEASE, "agent");
            asm volatile("s_waitcnt vmcnt(0)" ::: "memory");
            const unsigned og = xb_add(&bar[XB_TOP], 1u);
            const unsigned tg = og / nx;
            if (og + 1u == (tg + 1u) * nx) xb_add(&bar[XB_TOPGEN], 1u);
            else XB_SPIN(xb_ld(&bar[XB_TOPGEN]) == tg, bar);
            __builtin_amdgcn_fence(__ATOMIC_ACQUIRE, "agent");
            xb_add(&bar[XB_XGEN(b.x)], 1u);
            asm volatile("s_waitcnt vmcnt(0)" ::: "memory");
        } else {
            XB_SPIN(xb_ld(&bar[XB_XGEN(b.x)]) == gen, bar);
            __builtin_amdgcn_fence(__ATOMIC_ACQUIRE, "agent");
            asm volatile("s_waitcnt vmcnt(0)" ::: "memory");
        }
    }
    __syncthreads();
}

DEV void xcd_barrier(const XcdBarrier& b) { xcd_barrier1(b); if (REPMASK & 2048) xcd_barrier1(b); }
constexpr int LDS_BYTES = 148 * 1024;
DEV const void* ldptr(LAS char* shm, int i) {
    volatile LAS unsigned* pt = (volatile LAS unsigned*)(shm + LDS_BYTES - 512);
    const unsigned lo = __builtin_amdgcn_readfirstlane(pt[2 * i]), hi = __builtin_amdgcn_readfirstlane(pt[2 * i + 1]);
    return (const void*)(const __attribute__((address_space(1))) void*)(((unsigned long long)hi << 32) | lo);
}
#define PF(i) ((const float*)ldptr(shm, (i)))
struct Params {
    const float *x, *c, *norm_gain, *w_mod, *b_mod, *w_in, *lam_re, *lam_im, *log_dt, *sb_re, *sb_im, *sc_re, *sc_im, *ssm_d, *w_glu, *b_glu, *ssm_og,
        *conv_w, *conv_b, *wq, *wk, *wv, *w_gates, *b_ig, *b_fg, *m_ng, *m_skip, *w_out, *final_gain;
    float* out; char* ws;
};
constexpr int HALF_FLOATS = 56 * 1024 / 4;
constexpr size_t SLOT = (size_t)MTOK * DM * 2;
constexpr size_t W_IN_OFF = 0, W_GLU_OFF = 10485760, W_QKV_OFF = 12582912, W_OUT_OFF = 14155776, MOD_OFF = 20u << 20, IPRE_OFF = 21u << 20, LOGF_OFF = 22u << 20, BAR_OFF = 23u << 20, WF_OFF = 19u << 20, ROWSS_OFF = 24u << 20, RSTD_OFF = 25u << 20, XSS_OFF = 26u << 20;
#define REP(bit) _Pragma("nounroll") for (int rep_ = 0; rep_ < (((REPMASK) & (bit)) ? 2 : 1); ++rep_)
#define FOR_VB(nvb) for (int vb = blockIdx.x * 2 + HALF; vb < (nvb); vb += gridDim.x * 2)

#define WSB ((char*)ldptr(shm, 30))
#define SL(i) ((bf16_t*)(WSB + SLOT * (i)))
#define S7(off) (WSB + SLOT * 7 + (off))
#define WinT ((bf16_t*)S7(W_IN_OFF))
#define WgluT ((bf16_t*)S7(W_GLU_OFF))
#define WqkvT ((bf16_t*)S7(W_QKV_OFF))
#define WoutT ((bf16_t*)S7(W_OUT_OFF))
#define mod ((float*)S7(MOD_OFF))
#define gpart ((float*)S7(IPRE_OFF))
#define WfT ((bf16_t*)S7(WF_OFF))
#define rowss ((float*)S7(ROWSS_OFF))
#define rstdv ((float*)S7(RSTD_OFF))
#define xssv ((float*)S7(XSS_OFF))
#define MX SL(1)
#define OUTP ((float*)ldptr(shm, 29))
#define H SL(0)
#define U SL(1)
#define Y SL(2)
#define Z SL(3)
#define XC SL(4)
#define MI SL(5)
#define Q SL(6)
#define Kb SL(1)
#define V SL(2)
#define HC SL(5)
template <int l, int PART>
DEV void prep_layer(LAS char* shm) {
    const int wave = opaque_tid() >> 6, lane = opaque_tid() & 63;
    __syncthreads();
    {
        LAS float* scr = (LAS float*)(shm + wave * 16640);
        const float* Win = PF(5) + (size_t)l * DM * INC;
        constexpr int I_IN = 16 * 80, I_GLU = 16 * 16, I_QKV = 12 * 16, I_OUT = 32 * 16;
        constexpr int LO = (PART & 1) ? 0 : (I_IN + I_GLU + I_QKV), HI = (PART & 2) ? (I_IN + I_GLU + I_QKV + I_OUT) : (I_IN + I_GLU + I_QKV);
        for (int it = LO + blockIdx.x * 8 + wave; it < HI; it += gridDim.x * 8) {
            int r = it;
            if (r < I_IN) { transpose_item(Win, INC, INC, WinT, DM, scr, r, lane); continue; } r -= I_IN;
            if (r < I_GLU) { transpose_item(PF(14) + (size_t)l * DM * DM, DM, DM, WgluT, DM, scr, r, lane); continue; } r -= I_GLU;
            if (r < I_QKV) { const int mat = r / 16, which = mat >> 2, hd = mat & 3;
                const float* W = sel3(which, PF(19), PF(20), PF(21)) + ((size_t)l * NH + hd) * DH * DH;
                transpose_item(W, DH, DH, WqkvT + (size_t)mat * DH * DH, DH, scr, r % 16, lane); continue; } r -= I_QKV;
            transpose_item(PF(27) + (size_t)l * 2 * DM * DM, DM, DM, WoutT, 2 * DM, scr, r, lane);
        }
    }
    if (PART & 1) {
        wfold_prep(WfT, PF(19) + (size_t)l * NH * DH * DH, PF(20) + (size_t)l * NH * DH * DH, PF(21) + (size_t)l * NH * DH * DH, PF(22) + (size_t)l * 3 * DM * 8);
        __syncthreads();
        s5_tables(shm, (char*)SL(3), PF(6) + l * NG * NP, PF(7) + l * NG * NP, PF(8) + l * NG, PF(9) + (size_t)l * NG * NP * GC, PF(10) + (size_t)l * NG * NP * GC,
                  PF(11) + (size_t)l * NG * GC * NP, PF(12) + (size_t)l * NG * GC * NP);
    }
    __syncthreads();
}
template <int l>
DEV void layer_body(LAS char* shm, const XcdBarrier& gbar) {
        const float* xin = (l == 0) ? PF(0) : OUTP;
        const float* modl = mod + (size_t)l * BATCH * 3 * DM;
        if (l == 0) { REP(1) norm_rows(xin, PF(2) + l * DM, modl, H); xcd_barrier(gbar); }
        REP(2) { g8::SchedG1 S_{H, WinT, (int)blockIdx.x, (int)gridDim.x}; g8::EpiG1 E_{U, MI}; g8::gemm_phase(shm, S_, E_); }
        if (l == 1) prep_layer<1, 2>(shm);
        xcd_barrier(gbar);
        REP(256) s5_phase(shm, U, Y, (const char*)SL(3), PF(13) + l * DM);
        REP(8) xc_gates_phase(shm, MI, XC, WfT, PF(17) + l * 4 * DM, PF(18) + l * DM, gpart);
        xcd_barrier(gbar);
        REP(4) { g8::SchedGlu S_{Y, WgluT, (int)blockIdx.x, (int)gridDim.x}; g8::EpiGlu E_{Y, Z, PF(15) + l * DM, rowss}; g8::gemm_phase(shm, S_, E_); }
        xcd_barrier(gbar);
        REP(16) { g8::SchedQkv S_{XC, MI, WqkvT, (int)blockIdx.x, (int)gridDim.x}; g8::EpiQkv E_{Q, Kb, V}; g8::gemm_phase(shm, S_, E_); }
        xcd_barrier(gbar);
        rstd_rows(rowss, rstdv);
        REP(32) mlstm_phase<0>(shm, Q, Kb, V, gpart, PF(23) + l * 4, PF(24) + l * 4, HC);
#ifdef MLPROBE
        if (l == 0) mlstm_phase<MLPROBE>(shm, Q, Kb, V, gpart, PF(23) + l * 4, PF(24) + l * 4, (bf16_t*)OUTP);
#endif
        xcd_barrier(gbar);
        { g8::SchedG2s S_{H, WinT, (int)blockIdx.x}; g8::EpiG2s E_{Z, rstdv, PF(16) + l * DM, MX}; g8::gemm_phase(shm, S_, E_); }
        { g8::SchedG2m S_{H, WinT, (int)blockIdx.x}; g8::EpiG2m E_{HC, XC, PF(25) + l * DM, PF(26) + l * DM, MX}; g8::gemm_phase(shm, S_, E_); }
        xcd_barrier(gbar);
        if (l == 0) { g8::SchedOut S_{MX, WoutT, (int)blockIdx.x, (int)gridDim.x};
            g8::EpiOutN<false> E_{xin, OUTP, modl + 2 * DM, PF(2) + DM, mod + (size_t)BATCH * 3 * DM, H, xssv, (unsigned*)S7(BAR_OFF) + 4096, (unsigned*)S7(BAR_OFF) + XB_TMO}; g8::gemm_phase(shm, S_, E_);
            prep_layer<1, 1>(shm); }
        else { g8::SchedOut S_{MX, WoutT, (int)blockIdx.x, (int)gridDim.x};
            g8::EpiOutN<true> E_{xin, OUTP, modl + 2 * DM, PF(28), mod, H, xssv + (size_t)MTOK * 4, (unsigned*)S7(BAR_OFF) + 4096 + 4096, (unsigned*)S7(BAR_OFF) + XB_TMO}; g8::gemm_phase(shm, S_, E_); }
        xcd_barrier(gbar);
    }
__global__ void __launch_bounds__(512, 2) mega(Params Pk) {
    extern __shared__ __attribute__((aligned(16))) unsigned char lds_raw[];
    {
        volatile LAS unsigned long long* pt = (volatile LAS unsigned long long*)((LAS char*)lds_raw + LDS_BYTES - 512);
        if (threadIdx.x == 0) {
            pt[0] = (unsigned long long)Pk.x;
            pt[1] = (unsigned long long)Pk.c;
            pt[2] = (unsigned long long)Pk.norm_gain;
            pt[3] = (unsigned long long)Pk.w_mod;
            pt[4] = (unsigned long long)Pk.b_mod;
            pt[5] = (unsigned long long)Pk.w_in;
            pt[6] = (unsigned long long)Pk.lam_re;
            pt[7] = (unsigned long long)Pk.lam_im;
            pt[8] = (unsigned long long)Pk.log_dt;
            pt[9] = (unsigned long long)Pk.sb_re;
            pt[10] = (unsigned long long)Pk.sb_im;
            pt[11] = (unsigned long long)Pk.sc_re;
            pt[12] = (unsigned long long)Pk.sc_im;
            pt[13] = (unsigned long long)Pk.ssm_d;
            pt[14] = (unsigned long long)Pk.w_glu;
            pt[15] = (unsigned long long)Pk.b_glu;
            pt[16] = (unsigned long long)Pk.ssm_og;
            pt[17] = (unsigned long long)Pk.conv_w;
            pt[18] = (unsigned long long)Pk.conv_b;
            pt[19] = (unsigned long long)Pk.wq;
            pt[20] = (unsigned long long)Pk.wk;
            pt[21] = (unsigned long long)Pk.wv;
            pt[22] = (unsigned long long)Pk.w_gates;
            pt[23] = (unsigned long long)Pk.b_ig;
            pt[24] = (unsigned long long)Pk.b_fg;
            pt[25] = (unsigned long long)Pk.m_ng;
            pt[26] = (unsigned long long)Pk.m_skip;
            pt[27] = (unsigned long long)Pk.w_out;
            pt[28] = (unsigned long long)Pk.final_gain;
            pt[29] = (unsigned long long)Pk.out; pt[30] = (unsigned long long)Pk.ws;
        }
    }
    __syncthreads();
    LAS char* shm = (LAS char*)lds_raw;
    float* ldsf = (float*)lds_raw + HALF * HALF_FLOATS;
    volatile LAS unsigned* bst = (volatile LAS unsigned*)(shm + LDS_BYTES - 16);
    if (threadIdx.x < 4) bst[threadIdx.x] = 0u;
    __syncthreads();
    const XcdBarrier gbar = xcd_barrier_post((unsigned*)((char*)ldptr(shm, 30) + SLOT * 7 + BAR_OFF), bst);
    REP(4096) mod_phase(shm, PF(1), PF(3), PF(4), mod);
    prep_layer<0, 3>(shm);
    xcd_barrier(gbar);
    layer_body<0>(shm, gbar);
    layer_body<1>(shm, gbar);
}

#undef WSB
#undef SL
#undef S7
#undef WinT
#undef WgluT
#undef WqkvT
#undef WoutT
#undef mod
#undef gpart
#undef WfT
#undef rowss
#undef rstdv
#undef xssv
#undef MX
#undef OUTP
#undef H
#undef U
#undef Y
#undef Z
#undef XC
#undef MI
#undef Q
#undef Kb
#undef V
#undef HC
extern "C" void kernel_launch(void* const* d_in, const int* in_sizes, int n_in, void* d_out, int out_size, void* d_ws, size_t ws_size, hipStream_t stream) {
    static int grid_blocks = 0;
    if (!grid_blocks) {
        int dev = 0, cus = 0, per_cu = 0;
        (void)hipGetDevice(&dev);
        (void)hipDeviceGetAttribute(&cus, hipDeviceAttributeMultiprocessorCount, dev);
        (void)hipFuncSetAttribute((const void*)mega, hipFuncAttributeMaxDynamicSharedMemorySize, LDS_BYTES);
        (void)hipOccupancyMaxActiveBlocksPerMultiprocessor(&per_cu, (const void*)mega, 512, LDS_BYTES);
        grid_blocks = cus;
        fprintf(stderr, "mega: cus=%d occupancy per_cu=%d grid=%d\n", cus, per_cu, grid_blocks);
    }
    (void)hipMemsetAsync((char*)d_ws + SLOT * 7 + BAR_OFF, 0, 65536, stream);
    Params P{};
    const float** pp = (const float**)&P;
    for (int i = 0; i < 29; ++i) pp[i] = (const float*)d_in[i];
    P.out = (float*)d_out; P.ws = (char*)d_ws;
    void* args[] = {&P};
    hipError_t e = hipLaunchCooperativeKernel((const void*)mega, dim3(grid_blocks), dim3(512), args, LDS_BYTES, stream);
    if (e != hipSuccess) fprintf(stderr, "cooperative launch failed: %s (grid %d)\n", hipGetErrorString(e), grid_blocks);
}
```

```cpp
#include <hip/hip_runtime.h>
#include <cstdio>
#include <cstdint>
#include <hip/hip_cooperative_groups.h>
namespace cg = cooperative_groups;

#ifndef REPMASK
#define REPMASK 0
#endif
typedef unsigned short bf16_t;
#define DEV __device__ __forceinline__

constexpr int BATCH = 8, SEQ = 2048, DM = 1024, MTOK = BATCH * SEQ;
constexpr int NG = 64, NP = 64, GC = 16, NH = 4, DH = 256, CHUNK = 64, INC = 5120;
constexpr float EPS = 1e-6f;

DEV int opaque_tid() { int t = threadIdx.x; asm volatile("" : "+v"(t)); return t; }
#define TIDH (opaque_tid() & 255)
#define HALF (opaque_tid() >> 8)
DEV float bf2f(bf16_t v) { return __uint_as_float(((unsigned)v) << 16); }
typedef __bf16 bf16n2 __attribute__((ext_vector_type(2)));
typedef float f32n2 __attribute__((ext_vector_type(2)));
DEV bf16_t f2bf(float f) { __bf16 b = (__bf16)f; return __builtin_bit_cast(unsigned short, b); }
DEV unsigned pk2(float lo, float hi) { f32n2 v = {lo, hi}; bf16n2 b = __builtin_convertvector(v, bf16n2); return __builtin_bit_cast(unsigned, b); }
DEV float sigmoidf_(float x) { return __builtin_amdgcn_rcpf(1.f + __expf(-x)); }
DEV float siluf_(float x) { return x * __builtin_amdgcn_rcpf(1.f + __expf(-x)); }
DEV float geluf_(float x) { const float t2 = 1.5957691216057308f * (x + 0.044715f * x * x * x); return x * __builtin_amdgcn_rcpf(1.f + __expf(-t2)); }
DEV float logsigmoidf_(float x) { return fminf(x, 0.f) - log1pf(__expf(-fabsf(x))); }

DEV float wave_sum(float v) {
#pragma unroll
    for (int o = 1; o < 64; o <<= 1) v += __shfl_xor(v, o);
    return v;
}
DEV float block_sum256(float v, float* red) {
    v = wave_sum(v);
    __syncthreads();
    if ((TIDH & 63) == 0) red[TIDH >> 6] = v;
    __syncthreads();
    return red[0] + red[1] + red[2] + red[3];
}

DEV void k_mod(int vb, float* ldsf, const float* c, const float* w_mod, const float* b_mod, float* mod) {
    float (*sc)[DM] = (float (*)[DM])ldsf;
    const int l = vb / 12, n = (vb % 12) * 256 + TIDH;
    __syncthreads();
    for (int i = TIDH; i < BATCH * DM; i += 256) sc[i / DM][i % DM] = siluf_(c[i]);
    __syncthreads();
    float acc[BATCH];
#pragma unroll
    for (int b = 0; b < BATCH; ++b) acc[b] = 0.f;
    const float* W = w_mod + (size_t)l * DM * 3 * DM;
    for (int k = 0; k < DM; ++k) {
        float w = W[(size_t)k * 3 * DM + n];
#pragma unroll
        for (int b = 0; b < BATCH; ++b) acc[b] += sc[b][k] * w;
    }
#pragma unroll
    for (int b = 0; b < BATCH; ++b) mod[((size_t)l * BATCH + b) * 3 * DM + n] = acc[b] + b_mod[l * 3 * DM + n];
}

DEV void k_norm_mod(int vb, float* red, const float* x, const float* gain, const float* mod  , bf16_t* h) {
    const int m = vb, b = m / SEQ, t = TIDH;
    const float4 v = ((const float4*)(x + (size_t)m * DM))[t];
    float ss = v.x * v.x + v.y * v.y + v.z * v.z + v.w * v.w;
    ss = block_sum256(ss, red);
    const float rstd = rsqrtf(ss * (1.f / DM) + EPS);
    const float* shift = mod + (size_t)b * 3 * DM;
    const float* scale = shift + DM;
    float xv[4] = {v.x, v.y, v.z, v.w};
#pragma unroll
    for (int i = 0; i < 4; ++i) {
        int n = t * 4 + i;
        float y = xv[i] * rstd * gain[n] * (1.f + scale[n]) + shift[n];
        h[(size_t)m * DM + n] = f2bf(y);
    }
}

DEV void k_s5(int item, float* ldsf, const bf16_t* u, bf16_t* y, const float* lam_re, const float* lam_im, const float* log_dt,
                                           const float* b_re, const float* b_im, const float* c_re, const float* c_im, const float* dskip) {
    const int tid_ = opaque_tid();
    float (*part)[17] = (float (*)[17])(ldsf + (tid_ >> 6) * 64 * 17);
    const int g = item & 63, b = item >> 6, p = tid_ & 63;
    const double lr = lam_re[g * NP + p], li = lam_im[g * NP + p], dt = exp((double)log_dt[g]);
    const double er = exp(lr * dt);
    const double ard = er * cos(li * dt), aid = er * sin(li * dt);
    const double dr = ard - 1.0, di = aid, den = lr * lr + li * li;
    const double cr = (dr * lr + di * li) / den, ci = (di * lr - dr * li) / den;
    float bbr[16], bbi[16], ccr[16], cci[16];
#pragma unroll
    for (int c = 0; c < 16; ++c) {
        const double br = b_re[(g * NP + p) * GC + c], bi = b_im[(g * NP + p) * GC + c];
        bbr[c] = (float)(cr * br - ci * bi); bbi[c] = (float)(cr * bi + ci * br);
        ccr[c] = c_re[(g * GC + c) * NP + p]; cci[c] = c_im[(g * GC + c) * NP + p];
    }
    const float ar = (float)ard, ai = (float)aid;
    const float dsk = dskip[g * GC + (p & 15)];
    float sr = 0.f, si = 0.f;
    for (int t = 0; t < SEQ; ++t) {
        const bf16_t* up = u + (size_t)(b * SEQ + t) * DM + g * GC;
        const uint4 u0 = *(const uint4*)up, u1 = *(const uint4*)(up + 8);
        float uf[16];
        uf[0] = bf2f(u0.x & 0xffff); uf[1] = bf2f(u0.x >> 16); uf[2] = bf2f(u0.y & 0xffff); uf[3] = bf2f(u0.y >> 16);
        uf[4] = bf2f(u0.z & 0xffff); uf[5] = bf2f(u0.z >> 16); uf[6] = bf2f(u0.w & 0xffff); uf[7] = bf2f(u0.w >> 16);
        uf[8] = bf2f(u1.x & 0xffff); uf[9] = bf2f(u1.x >> 16); uf[10] = bf2f(u1.y & 0xffff); uf[11] = bf2f(u1.y >> 16);
        uf[12] = bf2f(u1.z & 0xffff); uf[13] = bf2f(u1.z >> 16); uf[14] = bf2f(u1.w & 0xffff); uf[15] = bf2f(u1.w >> 16);
        float bur = 0.f, bui = 0.f;
#pragma unroll
        for (int c = 0; c < 16; ++c) { bur += bbr[c] * uf[c]; bui += bbi[c] * uf[c]; }
        const float nr = ar * sr - ai * si + bur, ni = ar * si + ai * sr + bui;
        sr = nr; si = ni;
#pragma unroll
        for (int c = 0; c < 16; ++c) part[p][c] = ccr[c] * sr - cci[c] * si;
        asm volatile("s_waitcnt lgkmcnt(0)" ::: "memory");
        float s = 0.f;
#pragma unroll
        for (int k = 0; k < 16; ++k) s += part[(p >> 4) * 16 + k][p & 15];
        s += __shfl_xor(s, 16); s += __shfl_xor(s, 32);
        if (p < 16) {
            const float yv = s + dsk * bf2f(up[p]);
            y[(size_t)(b * SEQ + t) * DM + g * GC + p] = f2bf(geluf_(yv));
        }
        asm volatile("s_waitcnt lgkmcnt(0)" ::: "memory");
    }
}

DEV void k_ssm_post(int vb, float* red, bf16_t* z, const bf16_t* sg, const float* gain) {
    const int m = vb, t = TIDH;
    float zv[4]; float ss = 0.f;
#pragma unroll
    for (int i = 0; i < 4; ++i) { zv[i] = bf2f(z[(size_t)m * DM + t * 4 + i]); ss += zv[i] * zv[i]; }
    ss = block_sum256(ss, red);
    const float rstd = rsqrtf(ss * (1.f / DM) + EPS);
#pragma unroll
    for (int i = 0; i < 4; ++i) {
        const int n = t * 4 + i;
        z[(size_t)m * DM + n] = f2bf(zv[i] * rstd * gain[n] * siluf_(bf2f(sg[(size_t)m * DM + n])));
    }
}

DEV float conv_xc(const bf16_t* mi, int m, int n, const float* cw, const float* cb) {
    const int t = m % SEQ;
    float acc = cb[n];
#pragma unroll
    for (int j = 0; j < 4; ++j) {
        const int tt = t - 3 + j;
        if (tt >= 0) acc += bf2f(mi[(size_t)(m - 3 + j) * DM + n]) * cw[j * DM + n];
    }
    return siluf_(acc);
}
DEV void k_conv(int vb, const bf16_t* mi, bf16_t* xc, const float* cw, const float* cb) {
    const size_t idx = (size_t)vb * 256 + TIDH;
    const int m = (int)(idx / DM), n = (int)(idx % DM);
    xc[idx] = f2bf(conv_xc(mi, m, n, cw, cb));
}

DEV void k_gates(int vb, float* ldsf, const bf16_t* q, const bf16_t* k, const bf16_t* v, const float* wg  , const float* bi, const float* bfg,
                                               float* ipre, float* logf) {
    float (*red)[8] = (float (*)[8])ldsf;
    const int m = vb, t = TIDH;
    __syncthreads();
    float acc[8];
#pragma unroll
    for (int j = 0; j < 8; ++j) acc[j] = 0.f;
    for (int e = t; e < 3 * DM; e += 256) {
        const bf16_t* src = (e < DM) ? q : (e < 2 * DM ? k : v);
        const float xv = bf2f(src[(size_t)m * DM + (e & (DM - 1))]);
#pragma unroll
        for (int j = 0; j < 8; ++j) acc[j] += xv * wg[e * 8 + j];
    }
#pragma unroll
    for (int j = 0; j < 8; ++j) acc[j] = wave_sum(acc[j]);
    if ((t & 63) == 0) {
#pragma unroll
        for (int j = 0; j < 8; ++j) red[t >> 6][j] = acc[j];
    }
    __syncthreads();
    if (t < 8) {
        const float s = red[0][t] + red[1][t] + red[2][t] + red[3][t];
        if (t < 4) ipre[(size_t)m * 4 + t] = s + bi[t];
        else logf[(size_t)m * 4 + (t - 4)] = logsigmoidf_(s + bfg[t - 4]);
    }
}

DEV void k_mlstm(int vb, float* ldsf, const bf16_t* q, const bf16_t* k, const bf16_t* v, const float* ipre, const float* logf, bf16_t* hc) {
    float (*Cs)[257] = (float (*)[257])ldsf;
    float (*St)[65] = (float (*)[65])(ldsf + 32 * 257);
    float* nvec = ldsf + 32 * 257 + 64 * 65;
    float* bcum = nvec + 256; float* ig = bcum + 64; float* mt = ig + 64; float* winter = mt + 64; float* ws_ = winter + 64; float* hden = ws_ + 64;
    float* sc = hden + 64;
    const int tid = TIDH;
    const int vs = vb & 7, h = (vb >> 3) & 3, b = vb >> 5;
    __syncthreads();
    for (int i = tid; i < 32 * 257; i += 256) (&Cs[0][0])[i] = 0.f;
    nvec[tid] = 0.f;
    if (tid == 0) sc[0] = 0.f;
    __syncthreads();
    const size_t base = (size_t)b * SEQ * DM + h * DH;
    for (int j = 0; j < SEQ / CHUNK; ++j) {
        const size_t cb = base + (size_t)j * CHUNK * DM;
        const int m0 = b * SEQ + j * CHUNK;
        if (tid < 64) {
            ig[tid] = ipre[(size_t)(m0 + tid) * 4 + h];
            ws_[tid] = logf[(size_t)(m0 + tid) * 4 + h];
        }
        __syncthreads();
        if (tid < 64) { float s = 0.f; for (int i = 0; i <= tid; ++i) s += ws_[i]; bcum[tid] = s; }
        __syncthreads();
        const float m_prev = sc[0];
        if (tid < 64) {
            const float m_inter = bcum[tid] + m_prev;
            float mx = -INFINITY;
            for (int s = 0; s <= tid; ++s) mx = fmaxf(mx, bcum[tid] - bcum[s] + ig[s]);
            const float m = fmaxf(m_inter, mx);
            mt[tid] = m; winter[tid] = __expf(m_inter - m);
        }
        __syncthreads();
        for (int idx = tid; idx < 4096; idx += 256) {
            const int t = idx >> 6, s = idx & 63;
            float r = 0.f;
            if (s <= t) {
                const bf16_t* qp = q + cb + (size_t)t * DM; const bf16_t* kp = k + cb + (size_t)s * DM;
                float dot = 0.f;
                for (int d = 0; d < DH; d += 8) {
                    const uint4 qa = *(const uint4*)(qp + d), ka = *(const uint4*)(kp + d);
                    dot += bf2f(qa.x & 0xffff) * bf2f(ka.x & 0xffff) + bf2f(qa.x >> 16) * bf2f(ka.x >> 16);
                    dot += bf2f(qa.y & 0xffff) * bf2f(ka.y & 0xffff) + bf2f(qa.y >> 16) * bf2f(ka.y >> 16);
                    dot += bf2f(qa.z & 0xffff) * bf2f(ka.z & 0xffff) + bf2f(qa.z >> 16) * bf2f(ka.z >> 16);
                    dot += bf2f(qa.w & 0xffff) * bf2f(ka.w & 0xffff) + bf2f(qa.w >> 16) * bf2f(ka.w >> 16);
                }
                r = dot * __expf(bcum[t] - bcum[s] + ig[s] - mt[t]);
            }
            St[t][s] = r;
        }
        __syncthreads();
        if (tid < 64) {
            const bf16_t* qp = q + cb + (size_t)tid * DM;
            float dn = 0.f;
            for (int d = 0; d < DH; ++d) dn += nvec[d] * bf2f(qp[d]);
            float sm = 0.f;
            for (int s = 0; s < 64; ++s) sm += St[tid][s];
            const float den = winter[tid] * dn + sm;
            hden[tid] = fmaxf(fabsf(den), __expf(-mt[tid]));
        }
        __syncthreads();
        for (int idx = tid; idx < 2048; idx += 256) {
            const int t = idx >> 5, vv = idx & 31;
            const bf16_t* qp = q + cb + (size_t)t * DM;
            float a = 0.f;
            for (int d = 0; d < DH; ++d) a += Cs[vv][d] * bf2f(qp[d]);
            float s2 = 0.f;
            for (int s = 0; s < 64; ++s) s2 += St[t][s] * bf2f(v[cb + (size_t)s * DM + vs * 32 + vv]);
            const float num = winter[t] * a + s2;
            hc[cb + (size_t)t * DM + vs * 32 + vv] = f2bf(num / hden[t]);
        }
        __syncthreads();
        const float b_tot = bcum[63];
        if (tid < 64) ws_[tid] = b_tot - bcum[tid] + ig[tid];
        __syncthreads();
        if (tid == 0) {
            float mx = b_tot + m_prev;
            for (int s = 0; s < 64; ++s) mx = fmaxf(mx, ws_[s]);
            sc[1] = __expf(b_tot + m_prev - mx); sc[0] = mx;
        }
        __syncthreads();
        const float m_next = sc[0], decay = sc[1];
        float myw = 0.f;
        if (tid < 64) myw = __expf(ws_[tid] - m_next);
        __syncthreads();
        if (tid < 64) ws_[tid] = myw;
        __syncthreads();
        for (int idx = tid; idx < 32 * 256; idx += 256) {
            const int vv = idx >> 8, d = idx & 255;
            float a = 0.f;
            for (int s = 0; s < 64; ++s) a += ws_[s] * bf2f(v[cb + (size_t)s * DM + vs * 32 + vv]) * bf2f(k[cb + (size_t)s * DM + d]);
            Cs[vv][d] = decay * Cs[vv][d] + a;
        }
        {
            float a = 0.f;
            for (int s = 0; s < 64; ++s) a += ws_[s] * bf2f(k[cb + (size_t)s * DM + tid]);
            nvec[tid] = decay * nvec[tid] + a;
        }
        __syncthreads();
    }
}

DEV void k_mlstm_post(int vb, bf16_t* hc, const bf16_t* mo, const bf16_t* mg, const bf16_t* mi, const float* cw, const float* cb,
                                                    const float* ngain, const float* skip) {
    const int m = vb, t = TIDH;
    float hv[4]; float s = 0.f;
#pragma unroll
    for (int i = 0; i < 4; ++i) {
        const size_t o = (size_t)m * DM + t * 4 + i;
        hv[i] = bf2f(hc[o]) * sigmoidf_(bf2f(mo[o])); s += hv[i];
    }
    const float mu = wave_sum(s) * (1.f / DH);
    float s2 = 0.f;
#pragma unroll
    for (int i = 0; i < 4; ++i) { hv[i] -= mu; s2 += hv[i] * hv[i]; }
    const float rstd = rsqrtf(wave_sum(s2) * (1.f / DH) + EPS);
#pragma unroll
    for (int i = 0; i < 4; ++i) {
        const int n = t * 4 + i; const size_t o = (size_t)m * DM + n;
        const float xc = conv_xc(mi, m, n, cw, cb);
        const float hn = hv[i] * rstd * ngain[n] + skip[n] * xc;
        hc[o] = f2bf(hn * siluf_(bf2f(mg[o])));
    }
}

DEV void k_final(int vb, float* red, float* x, const float* gain) {
    const int m = vb, t = TIDH;
    float4 v = ((float4*)(x + (size_t)m * DM))[t];
    float ss = v.x * v.x + v.y * v.y + v.z * v.z + v.w * v.w;
    ss = block_sum256(ss, red);
    const float rstd = rsqrtf(ss * (1.f / DM) + EPS);
    const float4 g = ((const float4*)gain)[t];
    v.x *= rstd * g.x; v.y *= rstd * g.y; v.z *= rstd * g.z; v.w *= rstd * g.w;
    ((float4*)(x + (size_t)m * DM))[t] = v;
}


#define LAS __attribute__((address_space(3)))
typedef short bf16x8 __attribute__((ext_vector_type(8)));
typedef float f32x4 __attribute__((ext_vector_type(4)));
typedef short s16x4 __attribute__((ext_vector_type(4)));
typedef unsigned u32x4 __attribute__((ext_vector_type(4)));
typedef unsigned u32x2 __attribute__((ext_vector_type(2)));
typedef float f32x2 __attribute__((ext_vector_type(2)));
#define WAIT_V(n) asm volatile("s_waitcnt vmcnt(" #n ")" ::: "memory")
#define WAIT_L(n) asm volatile("s_waitcnt lgkmcnt(" #n ")" ::: "memory")
#define SCHED() __builtin_amdgcn_sched_barrier(0)

DEV int lds_byte(int r, int c) { int st = (r >> 4) * 2 + (c >> 5), ob = (r & 15) * 64 + (c & 31) * 2; return st * 1024 + (ob ^ (((ob >> 9) & 1) << 5)); }
DEV void stage_rc(int b, int& R, int& C) { int st = b >> 10, sb = b & 1023, swz = sb ^ (((sb >> 9) & 1) << 5); R = (st >> 1) * 16 + swz / 64; C = (st & 1) * 32 + (swz % 64) / 2; }
template <class T> DEV T* sel3(int w, T* p0, T* p1, T* p2) { return p0 + ((w >= 1) ? (p1 - p0) : 0) + ((w >= 2) ? (p2 - p1) : 0); }
DEV void unpack8(const uint4 v, float* f) {
    f[0] = bf2f((bf16_t)(v.x & 0xffff)); f[1] = bf2f((bf16_t)(v.x >> 16)); f[2] = bf2f((bf16_t)(v.y & 0xffff)); f[3] = bf2f((bf16_t)(v.y >> 16));
    f[4] = bf2f((bf16_t)(v.z & 0xffff)); f[5] = bf2f((bf16_t)(v.z >> 16)); f[6] = bf2f((bf16_t)(v.w & 0xffff)); f[7] = bf2f((bf16_t)(v.w >> 16));
}
DEV uint4 pack8(const float* f) { return make_uint4(pk2(f[0], f[1]), pk2(f[2], f[3]), pk2(f[4], f[5]), pk2(f[6], f[7])); }
DEV uint2 pack4(f32x4 v) { uint2 r; r.x = pk2(v[0], v[1]); r.y = pk2(v[2], v[3]); return r; }

struct GemmCtx { int wid, lane, wr, wc, fr, fq; int sR[4], sC[4]; };
DEV GemmCtx gemm_ctx() {
    GemmCtx c; const int tid = opaque_tid();
    c.wid = __builtin_amdgcn_readfirstlane(tid >> 6); c.lane = tid & 63; c.wr = c.wid >> 2; c.wc = c.wid & 3; c.fr = c.lane & 15; c.fq = c.lane >> 4;
#pragma unroll
    for (int i = 0; i < 4; ++i) stage_rc(c.wid * 1024 + i * 8192 + c.lane * 16, c.sR[i], c.sC[i]);
    return c;
}
DEV void gemm_mainloop(LAS char* shm, const GemmCtx& c, const bf16_t* A1row, const bf16_t* A2row, int ktsplit, int lda, const bf16_t* Bb, int ldb, int nt, f32x4 (&acc)[8][4]) {
    constexpr int TILE_B = 256 * 64 * 2, STAGE_B = 2 * TILE_B;
    const int wid = c.wid, wr = c.wr, wc = c.wc, fr = c.fr, fq = c.fq;
    unsigned voA[4], voB[4];
#pragma unroll
    for (int i = 0; i < 4; ++i) { voA[i] = (unsigned)(c.sR[i] * lda + c.sC[i]) * 2u; voB[i] = (unsigned)(c.sR[i] * ldb + c.sC[i]) * 2u; asm volatile("" : "+v"(voA[i]), "+v"(voB[i])); }
#define GLDS_STAGE(buf, kt) do { const char* Ak_ = (const char*)(((kt) < ktsplit) ? (A1row + (kt) * 64) : (A2row + ((kt) - ktsplit) * 64)); const char* Bk_ = (const char*)(Bb + (kt) * 64); \
        _Pragma("unroll") for (int i = 0; i < 4; ++i) { \
            __builtin_amdgcn_global_load_lds((const unsigned*)(Ak_ + voA[i]), (LAS unsigned*)(shm + (buf) * STAGE_B + wid * 1024 + i * 8192), 16, 0, 0); \
            __builtin_amdgcn_global_load_lds((const unsigned*)(Bk_ + voB[i]), (LAS unsigned*)(shm + (buf) * STAGE_B + TILE_B + wid * 1024 + i * 8192), 16, 0, 0); } } while (0)
#pragma unroll
    for (int m = 0; m < 8; ++m)
#pragma unroll
        for (int n = 0; n < 4; ++n) acc[m][n] = (f32x4){0.f, 0.f, 0.f, 0.f};
    GLDS_STAGE(0, 0); WAIT_V(0); __syncthreads();
#pragma nounroll
    for (int kt = 0; kt < nt; ++kt) {
        const int cur = kt & 1;
        if (kt + 1 < nt) GLDS_STAGE(cur ^ 1, kt + 1);
#pragma unroll
        for (int ks = 0; ks < 2; ++ks) {
            bf16x8 At[8], Bf[4];
#pragma unroll
            for (int m = 0; m < 8; ++m) At[m] = *(const LAS bf16x8*)(shm + cur * STAGE_B + lds_byte(wr * 128 + m * 16 + fr, ks * 32 + fq * 8));
#pragma unroll
            for (int n = 0; n < 4; ++n) Bf[n] = *(const LAS bf16x8*)(shm + cur * STAGE_B + TILE_B + lds_byte(wc * 64 + n * 16 + fr, ks * 32 + fq * 8));
#pragma unroll
            for (int m = 0; m < 8; ++m)
#pragma unroll
                for (int n = 0; n < 4; ++n) acc[m][n] = __builtin_amdgcn_mfma_f32_16x16x32_bf16(Bf[n], At[m], acc[m][n], 0, 0, 0);
            SCHED();
        }
        WAIT_V(0); __syncthreads();
    }
#undef GLDS_STAGE
}
DEV void tile_map(int t, int nN, int& pm, int& pn) {
    const int base = t & ~255, loc = t & 255;
    const int w = base + (loc & 7) * 32 + (loc >> 3);
    const int nig = 8 * nN, gid = w / nig;
    pm = gid * 8 + (w % nig) % 8; pn = (w % nig) / 8;
}
template <class Prob>
DEV void gemm_phase(LAS char* shm, const Prob& pb) {
    const GemmCtx c = gemm_ctx();
    const int nN = pb.nN, ntiles = 64 * nN;
    for (int t = blockIdx.x; t < ntiles; t += gridDim.x) {
        int pm, pn; tile_map(t, nN, pm, pn);
        const int brow = pm * 256, bcol = pn * 256;
        f32x4 acc[8][4];
        gemm_mainloop(shm, c, pb.a1(pn) + (long)brow * Prob::lda, pb.a2(pn) + (long)brow * Prob::lda, Prob::ktsplit, Prob::lda, pb.bptr(pn), Prob::ldb, Prob::K / 64, acc);
        pb.epi_begin(shm, c, pn, brow);
#pragma unroll
        for (int m = 0; m < 8; ++m)
#pragma unroll
            for (int n = 0; n < 4; ++n) pb.epi(pn, brow + c.wr * 128 + m * 16 + c.fr, bcol + c.wc * 64 + n * 16 + c.fq * 4, acc[m][n]);
        pb.epi_end(c, pn, brow, acc);
    }
}

struct ProbG1 {
    static constexpr int K = 1024, lda = 1024, ldb = 1024, ktsplit = 1 << 20;
    const bf16_t* H; const bf16_t* Wt; bf16_t* U; bf16_t* MI; int nN;
    DEV const bf16_t* a1(int pn) const { return H; }
    DEV const bf16_t* a2(int pn) const { return H; }
    DEV const bf16_t* bptr(int pn) const { return Wt + (long)((pn < 4) ? pn * 256 : 2048 + (pn - 4) * 256) * 1024; }
    DEV void epi_begin(LAS char*, const GemmCtx&, int, int) const {}
    DEV void epi(int pn, int row, int col, f32x4 v) const { bf16_t* C = (pn < 4) ? U : MI; *(uint2*)(C + (size_t)row * DM + (col & 1023)) = pack4(v); }
    DEV void epi_end(const GemmCtx&, int, int, f32x4 (&)[8][4]) const {}
};
struct ProbGlu {
    static constexpr int K = 1024, lda = 1024, ldb = 1024, ktsplit = 1 << 20;
    const bf16_t* Y; const bf16_t* Wt; bf16_t* Z; const float* bias; float* rowss; int nN;
    DEV const bf16_t* a1(int pn) const { return Y; }
    DEV const bf16_t* a2(int pn) const { return Y; }
    DEV const bf16_t* bptr(int pn) const { return Wt + (long)pn * 256 * 1024; }
    DEV void epi_begin(LAS char*, const GemmCtx&, int, int) const {}
    DEV void epi(int pn, int row, int col, f32x4 v) const {}
    DEV void epi_end(const GemmCtx& c0, int pn, int brow, f32x4 (&acc)[8][4]) const {
        struct { int fr, fq, wr, wc; } c = {c0.fr, c0.fq, c0.wr, c0.wc};
        asm volatile("" : "+v"(c.fr), "+v"(c.fq));
#pragma unroll
        for (int m = 0; m < 8; ++m) {
            SCHED();
            const int row = brow + c.wr * 128 + m * 16 + c.fr;
            float ss = 0.f;
#pragma unroll
            for (int n = 0; n < 4; ++n) {
                const int col = pn * 256 + c.wc * 64 + n * 16 + c.fq * 4;
                const uint2 yv = *(const uint2*)(Y + (size_t)row * DM + col);
                const float4 b = *(const float4*)(bias + col);
                f32x4 o;
                o[0] = bf2f(yv.x & 0xffff) * sigmoidf_(acc[m][n][0] + b.x); o[1] = bf2f(yv.x >> 16) * sigmoidf_(acc[m][n][1] + b.y);
                o[2] = bf2f(yv.y & 0xffff) * sigmoidf_(acc[m][n][2] + b.z); o[3] = bf2f(yv.y >> 16) * sigmoidf_(acc[m][n][3] + b.w);
                const uint2 pk = pack4(o);
                *(uint2*)(Z + (size_t)row * DM + col) = pk;
                const float r0 = bf2f(pk.x & 0xffff), r1 = bf2f(pk.x >> 16), r2 = bf2f(pk.y & 0xffff), r3 = bf2f(pk.y >> 16);
                ss += r0 * r0 + r1 * r1 + r2 * r2 + r3 * r3;
            }
            ss += __shfl_xor(ss, 16); ss += __shfl_xor(ss, 32);
            if (c.fq == 0) rowss[(size_t)(pn * 4 + c.wc) * MTOK + row] = ss;
        }
    }
};
struct ProbQkv {
    static constexpr int K = 256, lda = 1024, ldb = 256, ktsplit = 1 << 20;
    const bf16_t* XC; const bf16_t* MI; const bf16_t* Wt; bf16_t* Q; bf16_t* Kk; bf16_t* V; int nN;
    DEV const bf16_t* a1(int pn) const { return ((pn >> 2) == 2 ? MI : XC) + (pn & 3) * 256; }
    DEV const bf16_t* a2(int pn) const { return a1(pn); }
    DEV const bf16_t* bptr(int pn) const { return Wt + (long)pn * 256 * 256; }
    DEV void epi_begin(LAS char*, const GemmCtx&, int, int) const {}
    DEV void epi(int pn, int row, int col, f32x4 v) const {
        const int which = pn >> 2; bf16_t* C = sel3(which, Q, Kk, V);
        if (which == 1) { v[0] *= 0.0625f; v[1] *= 0.0625f; v[2] *= 0.0625f; v[3] *= 0.0625f; }
        *(uint2*)(C + (size_t)row * DM + (col & 1023)) = pack4(v);
    }
    DEV void epi_end(const GemmCtx&, int, int, f32x4 (&)[8][4]) const {}
};
struct ProbOut {
    static constexpr int K = 2048, lda = 1024, ldb = 2048, ktsplit = 16;
    const bf16_t* A1; const bf16_t* A2; const bf16_t* Wt; const float* xin; float* xout; const float* gate; int nN;
    DEV const bf16_t* a1(int pn) const { return A1; }
    DEV const bf16_t* a2(int pn) const { return A2; }
    DEV const bf16_t* bptr(int pn) const { return Wt + (long)pn * 256 * 2048; }
    DEV void epi_begin(LAS char*, const GemmCtx&, int, int) const {}
    DEV void epi(int pn, int row, int col, f32x4 v) const {
        const int b = row / SEQ;
        const float4 xi = *(const float4*)(xin + (size_t)row * DM + col);
        const float4 g = *(const float4*)(gate + (size_t)b * 3 * DM + col);
        float4 o; o.x = xi.x + g.x * v[0]; o.y = xi.y + g.y * v[1]; o.z = xi.z + g.z * v[2]; o.w = xi.w + g.w * v[3];
        *(float4*)(xout + (size_t)row * DM + col) = o;
    }
    DEV void epi_end(const GemmCtx&, int, int, f32x4 (&)[8][4]) const {}
};

struct G2Args {
    const bf16_t* H; const bf16_t* Wt;
    bf16_t* Z; const float* rowss; const float* og;
    bf16_t* HC; const bf16_t* XC; const float* ngain; const float* skip;
};
DEV void gemm2_phase(LAS char* shm, const G2Args& g) {
    const GemmCtx c = gemm_ctx();
    int efr, efq;
    LAS float* rst = (LAS float*)(shm + 131072);
    LAS float* red = (LAS float*)(shm + 131072 + 1024);
    for (int u = blockIdx.x; u < 512; u += gridDim.x) {
        f32x4 acc[8][4];
        if (u < 256) {
            int pm, pn; tile_map(u, 4, pm, pn);
            const int brow = pm * 256, bcol = pn * 256;
            gemm_mainloop(shm, c, g.H + (long)brow * DM, g.H, 1 << 20, DM, g.Wt + (long)(1024 + bcol) * DM, DM, 16, acc);
            efr = c.fr; efq = c.fq; asm volatile("" : "+v"(efr), "+v"(efq));
            { const int tid = c.wid * 64 + c.lane;
              if (tid < 256) { float s_ = 0.f;
#pragma unroll
                  for (int p_ = 0; p_ < 16; ++p_) s_ += g.rowss[(size_t)p_ * MTOK + brow + tid];
                  rst[tid] = rsqrtf(s_ * (1.f / DM) + EPS); } }
            __syncthreads();
#pragma unroll
            for (int m = 0; m < 8; ++m) {
                SCHED();
                const int rl = c.wr * 128 + m * 16 + efr, row = brow + rl;
                const float rs = rst[rl];
#pragma unroll
                for (int n = 0; n < 4; ++n) {
                    const int col = bcol + c.wc * 64 + n * 16 + efq * 4;
                    const uint2 zv = *(const uint2*)(g.Z + (size_t)row * DM + col);
                    const float4 gn = *(const float4*)(g.og + col);
                    f32x4 o;
                    o[0] = bf2f(zv.x & 0xffff) * rs * gn.x * siluf_(acc[m][n][0]); o[1] = bf2f(zv.x >> 16) * rs * gn.y * siluf_(acc[m][n][1]);
                    o[2] = bf2f(zv.y & 0xffff) * rs * gn.z * siluf_(acc[m][n][2]); o[3] = bf2f(zv.y >> 16) * rs * gn.w * siluf_(acc[m][n][3]);
                    *(uint2*)(g.Z + (size_t)row * DM + col) = pack4(o);
                }
            }
            __syncthreads();
        } else {
            int pm, hd; tile_map(u - 256, 4, pm, hd);
            const int brow = pm * 256, bcol = hd * 256;
            gemm_mainloop(shm, c, g.H + (long)brow * DM, g.H, 1 << 20, DM, g.Wt + (long)(3072 + bcol) * DM, DM, 16, acc);
            efr = c.fr; efq = c.fq; asm volatile("" : "+v"(efr), "+v"(efq));
        #pragma unroll
            for (int m = 0; m < 8; ++m) {
                SCHED();
                const int row = brow + c.wr * 128 + m * 16 + efr;
                float s_ = 0.f;
#pragma unroll
                for (int n = 0; n < 4; ++n) {
                    const int col = bcol + c.wc * 64 + n * 16 + efq * 4;
                    const uint2 hv = *(const uint2*)(g.HC + (size_t)row * DM + col);
                    acc[m][n][0] = bf2f(hv.x & 0xffff) * sigmoidf_(acc[m][n][0]); acc[m][n][1] = bf2f(hv.x >> 16) * sigmoidf_(acc[m][n][1]);
                    acc[m][n][2] = bf2f(hv.y & 0xffff) * sigmoidf_(acc[m][n][2]); acc[m][n][3] = bf2f(hv.y >> 16) * sigmoidf_(acc[m][n][3]);
                    s_ += (acc[m][n][0] + acc[m][n][1]) + (acc[m][n][2] + acc[m][n][3]);
                }
                s_ += __shfl_xor(s_, 16); s_ += __shfl_xor(s_, 32);
                if (efq == 0) red[c.wid * 128 + m * 16 + efr] = s_;
            }
            __syncthreads();
#pragma unroll
            for (int m = 0; m < 8; ++m) {
                SCHED();
                float tot = 0.f;
#pragma unroll
                for (int w2 = 0; w2 < 4; ++w2) tot += red[(c.wr * 4 + w2) * 128 + m * 16 + efr];
                const float mu = tot * (1.f / DH);
                float s_ = 0.f;
#pragma unroll
                for (int n = 0; n < 4; ++n)
#pragma unroll
                    for (int j = 0; j < 4; ++j) { acc[m][n][j] -= mu; s_ += acc[m][n][j] * acc[m][n][j]; }
                s_ += __shfl_xor(s_, 16); s_ += __shfl_xor(s_, 32);
                if (efq == 0) red[1024 + c.wid * 128 + m * 16 + efr] = s_;
            }
            __syncthreads();
#pragma unroll
            for (int m = 0; m < 8; ++m) {
                SCHED();
                const int row = brow + c.wr * 128 + m * 16 + efr;
                float tot = 0.f;
#pragma unroll
                for (int w2 = 0; w2 < 4; ++w2) tot += red[1024 + (c.wr * 4 + w2) * 128 + m * 16 + efr];
                const float rs = rsqrtf(tot * (1.f / DH) + EPS);
#pragma unroll
                for (int n = 0; n < 4; ++n) {
                    const int col = bcol + c.wc * 64 + n * 16 + efq * 4;
                    const uint2 xv = *(const uint2*)(g.XC + (size_t)row * DM + col);
                    const float4 gn = *(const float4*)(g.ngain + col), sk = *(const float4*)(g.skip + col);
                    f32x4 o;
                    o[0] = acc[m][n][0] * rs * gn.x + sk.x * bf2f(xv.x & 0xffff); o[1] = acc[m][n][1] * rs * gn.y + sk.y * bf2f(xv.x >> 16);
                    o[2] = acc[m][n][2] * rs * gn.z + sk.z * bf2f(xv.y & 0xffff); o[3] = acc[m][n][3] * rs * gn.w + sk.w * bf2f(xv.y >> 16);
                    *(uint2*)(g.HC + (size_t)row * DM + col) = pack4(o);
                }
            }
            gemm_mainloop(shm, c, g.H + (long)brow * DM, g.H, 1 << 20, DM, g.Wt + (long)(4096 + bcol) * DM, DM, 16, acc);
            efr = c.fr; efq = c.fq; asm volatile("" : "+v"(efr), "+v"(efq));
#pragma unroll
            for (int m = 0; m < 8; ++m) {
                SCHED();
                const int row = brow + c.wr * 128 + m * 16 + efr;
#pragma unroll
                for (int n = 0; n < 4; ++n) {
                    const int col = bcol + c.wc * 64 + n * 16 + efq * 4;
                    const uint2 hv = *(const uint2*)(g.HC + (size_t)row * DM + col);
                    f32x4 o;
                    o[0] = bf2f(hv.x & 0xffff) * siluf_(acc[m][n][0]); o[1] = bf2f(hv.x >> 16) * siluf_(acc[m][n][1]);
                    o[2] = bf2f(hv.y & 0xffff) * siluf_(acc[m][n][2]); o[3] = bf2f(hv.y >> 16) * siluf_(acc[m][n][3]);
                    *(uint2*)(g.HC + (size_t)row * DM + col) = pack4(o);
                }
            }
        }
    }
}


namespace g8 {
constexpr int BK = 64, HALFT = 128, HTB = HALFT * BK * 2;
#define G8_A_ROWMAJOR static constexpr int ksplit = 1 << 20; static constexpr size_t kstepA = 128, hstepA = (size_t)128 * lda * 2; static DEV unsigned aoff(int R, int C) { return (unsigned)(R * lda + C) * 2u; }
DEV int perm32(int rho) { const int n = rho >> 4, i = rho & 15; return 8 * (i >> 2) + 4 * n + (i & 3); }
struct Unit { const char* A; const char* A2; const char* B; int pm, pn, tag; };
template <class Epi, class Sched>
DEV void gemm_phase(LAS char* lds, const Sched& S, const Epi& E) {
    const int tid = opaque_tid(), wid = __builtin_amdgcn_readfirstlane(tid >> 6), lane = tid & 63, wr = wid >> 2, wc = wid & 3, fr = lane & 15, fq = lane >> 4;
    constexpr int lda = Sched::lda, ldb = Sched::ldb, nt = Sched::K / BK;
    unsigned voffA[2], voffB[2];
#pragma unroll
    for (int i = 0; i < 2; ++i) { int R, C; stage_rc(tid * 16 + i * 8192, R, C); const int Rb = (R & ~31) + perm32(R & 31);
        voffA[i] = Sched::aoff(R, C); voffB[i] = (unsigned)(Rb * ldb + C) * 2u; asm volatile("" : "+v"(voffA[i]), "+v"(voffB[i])); }
    constexpr size_t kstep = (size_t)(BK * 2), kstepA = Sched::kstepA, hstepA = Sched::hstepA, hstepB = (size_t)HALFT * ldb * 2;
    const unsigned ldsw = (unsigned)wid * 1024u;
    const int aoff = lds_byte(wr * 64 + fr, fq * 8), boff = lds_byte(wc * 32 + fr, fq * 8);
#define G8_SA(b, h) (((b) * 2 + (h)) * HTB)
#define G8_SB(b, h) ((4 + (b) * 2 + (h)) * HTB)
#define G8_STAGE(bufoff, gbase, voff) do { _Pragma("unroll") for (int _i = 0; _i < 2; ++_i) \
        __builtin_amdgcn_global_load_lds((const unsigned*)((const char*)(gbase) + (voff)[_i]), (LAS unsigned*)(lds + (bufoff) + ldsw + _i * 8192), 16, 0, 0); } while (0)
#define G8_LDA(dst, b, h) do { _Pragma("unroll") for (int m = 0; m < 4; ++m) _Pragma("unroll") for (int k = 0; k < 2; ++k) dst[m][k] = *(const LAS bf16x8*)(lds + G8_SA(b, h) + aoff + m * 2048 + k * 1024); } while (0)
#define G8_LDB(dst, b, h) do { _Pragma("unroll") for (int n = 0; n < 2; ++n) _Pragma("unroll") for (int k = 0; k < 2; ++k) dst[n][k] = *(const LAS bf16x8*)(lds + G8_SB(b, h) + boff + n * 2048 + k * 1024); } while (0)
#define G8_MMA(ai, bj, At, Bt) do { __builtin_amdgcn_s_setprio(1); _Pragma("unroll") for (int m = 0; m < 4; ++m) _Pragma("unroll") for (int n = 0; n < 2; ++n) _Pragma("unroll") for (int k = 0; k < 2; ++k) \
        acc[ai][bj][m][n] = __builtin_amdgcn_mfma_f32_16x16x32_bf16(Bt[n][k], At[m][k], acc[ai][bj][m][n], 0, 0, 0); __builtin_amdgcn_s_setprio(0); } while (0)
#define G8_WAIT_V(n) asm volatile("s_waitcnt vmcnt(" #n ")" ::: "memory")
#define G8_WAIT_L(n) asm volatile("s_waitcnt lgkmcnt(" #n ")" ::: "memory")
#define G8_BAR __builtin_amdgcn_s_barrier()
#define G8_SCHED __builtin_amdgcn_sched_barrier(0)
    Unit cur, nxt; int ui = 0;
    if (!S.next(0, cur)) return;
    f32x4 acc[2][2][4][2];
#pragma unroll
    for (int a = 0; a < 2; ++a)
#pragma unroll
        for (int b = 0; b < 2; ++b)
#pragma unroll
            for (int m = 0; m < 4; ++m)
#pragma unroll
                for (int n = 0; n < 2; ++n) acc[a][b][m][n] = (f32x4){0.f, 0.f, 0.f, 0.f};
    bf16x8 At[4][2], B0[2][2], B1[2][2];
    const char* cA = cur.A; const char* cA2 = cur.A2; const char* cB = cur.B;
    constexpr int KSP = Sched::ksplit;
#define G8_AK(t_) (((t_) < KSP) ? cA + (size_t)(t_) * kstepA : cA2 + (size_t)((t_) - KSP) * kstepA)
    G8_STAGE(G8_SB(0, 0), cB, voffB); G8_STAGE(G8_SB(0, 1), cB + hstepB, voffB); G8_STAGE(G8_SA(0, 0), cA, voffA); G8_STAGE(G8_SA(0, 1), cA + hstepA, voffA);
    if (wr == 1) G8_BAR;
    G8_WAIT_V(2); G8_BAR;
    G8_STAGE(G8_SB(1, 0), cB + kstep, voffB); G8_STAGE(G8_SA(1, 0), cA + kstepA, voffA); G8_STAGE(G8_SB(1, 1), cB + hstepB + kstep, voffB);
    G8_WAIT_V(6); G8_BAR;
    for (;;) {
        const bool has_next = S.next(ui + 1, nxt);
        const char* nA = has_next ? nxt.A : cA; const char* nB = has_next ? nxt.B : cB;
#pragma nounroll
        for (int t = 0; t < nt; t += 2) {
            const bool last = (t == nt - 2);
            const char* a1 = G8_AK(t + 1);
            const char* a2 = last ? nA : G8_AK(t + 2); const char* b2 = last ? nB : cB + (size_t)(t + 2) * kstep;
            const char* a3 = last ? nA + kstepA : G8_AK(t + 3); const char* b3 = b2 + kstep;
            G8_LDB(B0, 0, 0); G8_LDB(B1, 0, 1); G8_SCHED; G8_LDA(At, 0, 0); G8_STAGE(G8_SA(1, 1), a1 + hstepA, voffA);
            G8_WAIT_V(8); G8_WAIT_L(0); G8_BAR; G8_MMA(0, 0, At, B0); G8_MMA(0, 1, At, B1); G8_BAR; G8_SCHED;
            G8_LDA(At, 0, 1); G8_STAGE(G8_SB(0, 0), b2, voffB); G8_STAGE(G8_SB(0, 1), b2 + hstepB, voffB); G8_STAGE(G8_SA(0, 0), a2, voffA);
            G8_WAIT_V(8); G8_WAIT_L(0); G8_BAR; G8_MMA(1, 0, At, B0); G8_MMA(1, 1, At, B1); G8_BAR; G8_SCHED;
            G8_LDB(B0, 1, 0); G8_LDB(B1, 1, 1); G8_SCHED; G8_LDA(At, 1, 0); G8_STAGE(G8_SA(0, 1), a2 + hstepA, voffA);
            G8_WAIT_V(8); G8_WAIT_L(0); G8_BAR; G8_MMA(0, 0, At, B0); G8_MMA(0, 1, At, B1); G8_BAR; G8_SCHED;
            G8_LDA(At, 1, 1); G8_STAGE(G8_SB(1, 0), b3, voffB); G8_STAGE(G8_SB(1, 1), b3 + hstepB, voffB); G8_STAGE(G8_SA(1, 0), a3, voffA);
            G8_WAIT_V(8); G8_WAIT_L(0); G8_BAR; G8_MMA(1, 0, At, B0); G8_MMA(1, 1, At, B1); G8_BAR; G8_SCHED;
        }
        if (wr == 0) G8_BAR;
        E(lds, acc, cur, wr, wc, fr, fq, wid, lane);
        if (!has_next) break;
#pragma unroll
        for (int a = 0; a < 2; ++a)
#pragma unroll
            for (int b = 0; b < 2; ++b)
#pragma unroll
                for (int m = 0; m < 4; ++m)
#pragma unroll
                    for (int n = 0; n < 2; ++n) acc[a][b][m][n] = (f32x4){0.f, 0.f, 0.f, 0.f};
        cur = nxt; cA = nA; cA2 = nxt.A2; cB = nB; ++ui;
        if (wr == 1) G8_BAR;
    }
    G8_WAIT_V(0);
    G8_BAR;
#undef G8_AK
#undef G8_SA
#undef G8_SB
#undef G8_STAGE
#undef G8_LDA
#undef G8_LDB
#undef G8_MMA
#undef G8_WAIT_V
#undef G8_WAIT_L
#undef G8_BAR
#undef G8_SCHED
}
DEV u32x4 pk8(const f32x4 a, const f32x4 b) { return (u32x4){pk2(a[0], a[1]), pk2(a[2], a[3]), pk2(b[0], b[1]), pk2(b[2], b[3])}; }
DEV void un8(const u32x4 v, float* f) { unpack8(make_uint4(v[0], v[1], v[2], v[3]), f); }
#define G8_ROWS_BEGIN _Pragma("unroll") for (int ai = 0; ai < 2; ++ai) _Pragma("unroll") for (int m = 0; m < 4; ++m) { const int rl = 128 * ai + 64 * wr + 16 * m + fr;
#define G8_ROWS_END }

struct SchedG1 { static constexpr int K = 1024, lda = 1024, ldb = 1024; G8_A_ROWMAJOR const bf16_t* H; const bf16_t* Wt; int bid, G;
    DEV bool next(int i, Unit& u) const { const int t = bid + i * G; if (t >= 512) return false; int pm, pn; tile_map(t, 8, pm, pn);
        u.pm = pm; u.pn = pn; u.tag = 0; u.A = (const char*)(H + (size_t)pm * 256 * DM); u.A2 = u.A; u.B = (const char*)(Wt + (size_t)((pn < 4) ? pn * 256 : 2048 + (pn - 4) * 256) * DM); return true; } };
struct EpiG1 { bf16_t* U; bf16_t* MI;
    DEV void operator()(LAS char*, const f32x4 (&acc)[2][2][4][2], const Unit& u, int wr, int wc, int fr, int fq, int, int) const {
        const int c0 = (u.pn & 3) * 256 + 32 * wc + 8 * fq;
        if (u.pn < 4) {
            G8_ROWS_BEGIN const int row = u.pm * 256 + rl;
#pragma unroll
                for (int bj = 0; bj < 2; ++bj) { const int cc = c0 + 128 * bj; *(u32x4*)(U + (size_t)(cc >> 4) * MTOK * 16 + (size_t)row * 16 + (cc & 15)) = pk8(acc[ai][bj][m][0], acc[ai][bj][m][1]); } G8_ROWS_END
        } else {
            G8_ROWS_BEGIN bf16_t* rp = MI + (size_t)(u.pm * 256 + rl) * DM + c0;
#pragma unroll
                for (int bj = 0; bj < 2; ++bj) *(u32x4*)(rp + 128 * bj) = pk8(acc[ai][bj][m][0], acc[ai][bj][m][1]); G8_ROWS_END
        } } };
struct SchedGlu { static constexpr int K = 1024, lda = 1024, ldb = 1024; static constexpr int ksplit = 1 << 20; static constexpr size_t kstepA = (size_t)4 * MTOK * 32, hstepA = (size_t)128 * 32; static DEV unsigned aoff(int R, int C) { return (unsigned)((C >> 4) * (MTOK * 32) + R * 32 + (C & 15) * 2); } const bf16_t* Y; const bf16_t* Wt; int bid, G;
    DEV bool next(int i, Unit& u) const { const int t = bid + i * G; if (t >= 256) return false; int pm, pn; tile_map(t, 4, pm, pn);
        u.pm = pm; u.pn = pn; u.tag = 0; u.A = (const char*)(Y + (size_t)pm * 256 * 16); u.A2 = u.A; u.B = (const char*)(Wt + (size_t)pn * 256 * DM); return true; } };
struct EpiGlu { const bf16_t* Y; bf16_t* Z; const float* bias; float* rowss;
    DEV void operator()(LAS char*, const f32x4 (&acc)[2][2][4][2], const Unit& u, int wr, int wc, int fr, int fq, int, int) const {
        const int c0 = u.pn * 256 + 32 * wc + 8 * fq;
        G8_ROWS_BEGIN const size_t ro = (size_t)(u.pm * 256 + rl) * DM + c0; float ss = 0.f;
#pragma unroll
            for (int bj = 0; bj < 2; ++bj) {
                float y8[8]; { const int cc = c0 + 128 * bj; un8(*(const u32x4*)(Y + (size_t)(cc >> 4) * MTOK * 16 + (size_t)(u.pm * 256 + rl) * 16 + (cc & 15)), y8); }
                const float4 b0 = *(const float4*)(bias + c0 + 128 * bj), b1 = *(const float4*)(bias + c0 + 128 * bj + 4);
                f32x4 o0, o1;
                o0[0] = y8[0] * sigmoidf_(acc[ai][bj][m][0][0] + b0.x); o0[1] = y8[1] * sigmoidf_(acc[ai][bj][m][0][1] + b0.y); o0[2] = y8[2] * sigmoidf_(acc[ai][bj][m][0][2] + b0.z); o0[3] = y8[3] * sigmoidf_(acc[ai][bj][m][0][3] + b0.w);
                o1[0] = y8[4] * sigmoidf_(acc[ai][bj][m][1][0] + b1.x); o1[1] = y8[5] * sigmoidf_(acc[ai][bj][m][1][1] + b1.y); o1[2] = y8[6] * sigmoidf_(acc[ai][bj][m][1][2] + b1.z); o1[3] = y8[7] * sigmoidf_(acc[ai][bj][m][1][3] + b1.w);
                const u32x4 pk = pk8(o0, o1); *(u32x4*)(Z + ro + 128 * bj) = pk;
                float r8[8]; un8(pk, r8);
#pragma unroll
                for (int e = 0; e < 8; ++e) ss += r8[e] * r8[e];
            }
            ss += __shfl_xor(ss, 16); ss += __shfl_xor(ss, 32);
            if (fq == 0) rowss[(size_t)(u.pn * 4 + wc) * MTOK + u.pm * 256 + rl] = ss; G8_ROWS_END } };
struct SchedQkv { static constexpr int K = 256, lda = 1024, ldb = 256; G8_A_ROWMAJOR const bf16_t* XC; const bf16_t* MI; const bf16_t* Wt; int bid, G;
    DEV bool next(int i, Unit& u) const { const int t = bid + i * G; if (t >= 768) return false; int pm, pn; tile_map(t, 12, pm, pn);
        u.pm = pm; u.pn = pn; u.tag = 0; u.A = (const char*)(((pn >> 2) == 2 ? MI : XC) + (size_t)pm * 256 * DM + (pn & 3) * 256); u.A2 = u.A; u.B = (const char*)(Wt + (size_t)pn * 256 * 256); return true; } };
struct EpiQkv { bf16_t* Q; bf16_t* Kk; bf16_t* V;
    DEV void operator()(LAS char*, const f32x4 (&acc)[2][2][4][2], const Unit& u, int wr, int wc, int fr, int fq, int, int) const {
        const int which = u.pn >> 2; bf16_t* C = sel3(which, Q, Kk, V); const float sc = (which == 1) ? 0.0625f : 1.f;
        const int c0 = (u.pn & 3) * 256 + 32 * wc + 8 * fq;
        G8_ROWS_BEGIN bf16_t* rp = C + (size_t)(u.pm * 256 + rl) * DM + c0;
#pragma unroll
            for (int bj = 0; bj < 2; ++bj) *(u32x4*)(rp + 128 * bj) = pk8(acc[ai][bj][m][0] * sc, acc[ai][bj][m][1] * sc); G8_ROWS_END } };
struct SchedOut { static constexpr int K = 2048, lda = 1024, ldb = 2048, ksplit = 16; static constexpr size_t kstepA = 128, hstepA = (size_t)128 * lda * 2; static DEV unsigned aoff(int R, int C) { return (unsigned)(R * lda + C) * 2u; }
    const bf16_t* MS; const bf16_t* MM; const bf16_t* Wt; int bid, G;
    DEV bool next(int i, Unit& u) const { const int t = bid + i * G; if (t >= 256) return false; int pm, pn; tile_map(t, 4, pm, pn);
        u.pm = pm; u.pn = pn; u.tag = 0; u.A = (const char*)(MS + (size_t)pm * 256 * DM); u.A2 = (const char*)(MM + (size_t)pm * 256 * DM); u.B = (const char*)(Wt + (size_t)pn * 256 * 2048); return true; } };
template <bool FINAL>
struct EpiOutN { const float* xin; float* xout; const float* gate; const float* ngain; const float* modn; bf16_t* Hn; float* xss; unsigned* cnt; unsigned* tmo;
    DEV void operator()(LAS char* lds, f32x4 (&acc)[2][2][4][2], const Unit& u, int wr, int wc, int fr, int fq, int wid, int lane) const {
        asm volatile("" : "+v"(fr), "+v"(fq));
        LAS float* red = (LAS float*)(lds + 131072);
        LAS float* rst = (LAS float*)(lds + 131072 + 4096);
        const int c0 = u.pn * 256 + 32 * wc + 8 * fq, bidx = (u.pm * 256) / SEQ; const float* gp = gate + (size_t)bidx * 3 * DM + c0;
        G8_ROWS_BEGIN const size_t ro = (size_t)(u.pm * 256 + rl) * DM + c0; float ss = 0.f;
#pragma unroll
            for (int bj = 0; bj < 2; ++bj)
#pragma unroll
                for (int n = 0; n < 2; ++n) {
                    const float4 xi = *(const float4*)(xin + ro + 128 * bj + 4 * n), g4 = *(const float4*)(gp + 128 * bj + 4 * n);
                    f32x4 o; o[0] = xi.x + g4.x * acc[ai][bj][m][n][0]; o[1] = xi.y + g4.y * acc[ai][bj][m][n][1]; o[2] = xi.z + g4.z * acc[ai][bj][m][n][2]; o[3] = xi.w + g4.w * acc[ai][bj][m][n][3];
                    acc[ai][bj][m][n] = o; ss += (o[0] * o[0] + o[1] * o[1]) + (o[2] * o[2] + o[3] * o[3]);
                    if (!FINAL) *(float4*)(xout + ro + 128 * bj + 4 * n) = make_float4(o[0], o[1], o[2], o[3]); }
            ss += __shfl_xor(ss, 16); ss += __shfl_xor(ss, 32);
            if (fq == 0) red[wid * 128 + 64 * ai + 16 * m + fr] = ss; G8_ROWS_END
        asm volatile("s_waitcnt lgkmcnt(0)" ::: "memory"); __builtin_amdgcn_s_barrier();
        const int tid = wid * 64 + lane;
        if (tid < 256) {
            const int r_ = tid, w0 = (r_ >> 6) & 1, ix = (r_ & 63) + 64 * (r_ >> 7);
            const float t_ = red[(w0 * 4 + 0) * 128 + ix] + red[(w0 * 4 + 1) * 128 + ix] + red[(w0 * 4 + 2) * 128 + ix] + red[(w0 * 4 + 3) * 128 + ix];
            __hip_atomic_store(xss + ((size_t)(u.pm * 256 + r_) * 4 + u.pn), t_, __ATOMIC_RELAXED, __HIP_MEMORY_SCOPE_AGENT);
        }
        asm volatile("s_waitcnt vmcnt(0)" ::: "memory"); __builtin_amdgcn_s_barrier();
        if (tid == 0) {
            __hip_atomic_fetch_add(cnt + 64 * u.pm, 1u, __ATOMIC_RELAXED, __HIP_MEMORY_SCOPE_AGENT);
            unsigned sp_ = 0;
            while (__hip_atomic_load(cnt + 64 * u.pm, __ATOMIC_RELAXED, __HIP_MEMORY_SCOPE_AGENT) < 4u) { __builtin_amdgcn_s_sleep(1); if (++sp_ > (1u << 22)) { atomicAdd(tmo, 1u); break; } }
        }
        __builtin_amdgcn_s_barrier();
        if (tid < 256) {
            const float* xp = xss + (size_t)(u.pm * 256 + tid) * 4;
            const float t_ = __hip_atomic_load(xp, __ATOMIC_RELAXED, __HIP_MEMORY_SCOPE_AGENT) + __hip_atomic_load(xp + 1, __ATOMIC_RELAXED, __HIP_MEMORY_SCOPE_AGENT)
                           + __hip_atomic_load(xp + 2, __ATOMIC_RELAXED, __HIP_MEMORY_SCOPE_AGENT) + __hip_atomic_load(xp + 3, __ATOMIC_RELAXED, __HIP_MEMORY_SCOPE_AGENT);
            rst[tid] = rsqrtf(t_ * (1.f / DM) + EPS);
        }
        asm volatile("s_waitcnt vmcnt(0) lgkmcnt(0)" ::: "memory"); __builtin_amdgcn_s_barrier();
        const float* shp = modn + (size_t)bidx * 3 * DM + c0;
        G8_ROWS_BEGIN const size_t ro = (size_t)(u.pm * 256 + rl) * DM + c0; const float rs = rst[rl];
#pragma unroll
            for (int bj = 0; bj < 2; ++bj) {
                const float4 g0 = *(const float4*)(ngain + c0 + 128 * bj), g1 = *(const float4*)(ngain + c0 + 128 * bj + 4);
                if (FINAL) {
                    *(float4*)(xout + ro + 128 * bj) = make_float4(acc[ai][bj][m][0][0] * rs * g0.x, acc[ai][bj][m][0][1] * rs * g0.y, acc[ai][bj][m][0][2] * rs * g0.z, acc[ai][bj][m][0][3] * rs * g0.w);
                    *(float4*)(xout + ro + 128 * bj + 4) = make_float4(acc[ai][bj][m][1][0] * rs * g1.x, acc[ai][bj][m][1][1] * rs * g1.y, acc[ai][bj][m][1][2] * rs * g1.z, acc[ai][bj][m][1][3] * rs * g1.w);
                } else {
                    const float4 h0 = *(const float4*)(shp + 128 * bj), h1 = *(const float4*)(shp + 128 * bj + 4), s0 = *(const float4*)(shp + DM + 128 * bj), s1 = *(const float4*)(shp + DM + 128 * bj + 4);
                    f32x4 o0, o1;
                    o0[0] = acc[ai][bj][m][0][0] * rs * g0.x * (1.f + s0.x) + h0.x; o0[1] = acc[ai][bj][m][0][1] * rs * g0.y * (1.f + s0.y) + h0.y; o0[2] = acc[ai][bj][m][0][2] * rs * g0.z * (1.f + s0.z) + h0.z; o0[3] = acc[ai][bj][m][0][3] * rs * g0.w * (1.f + s0.w) + h0.w;
                    o1[0] = acc[ai][bj][m][1][0] * rs * g1.x * (1.f + s1.x) + h1.x; o1[1] = acc[ai][bj][m][1][1] * rs * g1.y * (1.f + s1.y) + h1.y; o1[2] = acc[ai][bj][m][1][2] * rs * g1.z * (1.f + s1.z) + h1.z; o1[3] = acc[ai][bj][m][1][3] * rs * g1.w * (1.f + s1.w) + h1.w;
                    *(u32x4*)(Hn + ro + 128 * bj) = pk8(o0, o1);
                } } G8_ROWS_END
    } };
struct SchedG2s { static constexpr int K = 1024, lda = 1024, ldb = 1024; G8_A_ROWMAJOR const bf16_t* H; const bf16_t* Wt; int bid;
    DEV bool next(int i, Unit& u) const { if (i >= 1) return false; int pm, pn; tile_map(bid, 4, pm, pn);
        u.pm = pm; u.pn = pn; u.tag = 0; u.A = (const char*)(H + (size_t)pm * 256 * DM); u.A2 = u.A; u.B = (const char*)(Wt + (size_t)(1024 + pn * 256) * DM); return true; } };
struct SchedG2m { static constexpr int K = 1024, lda = 1024, ldb = 1024; G8_A_ROWMAJOR const bf16_t* H; const bf16_t* Wt; int bid;
    DEV bool next(int i, Unit& u) const { if (i >= 2) return false; int pm, pn; tile_map(bid, 4, pm, pn);
        u.pm = pm; u.pn = pn; u.tag = i + 1; u.A = (const char*)(H + (size_t)pm * 256 * DM); u.A2 = u.A; u.B = (const char*)(Wt + (size_t)((i == 0 ? 3072 : 4096) + pn * 256) * DM); return true; } };
struct EpiG2s { bf16_t* Z; const float* rstd; const float* og;
    DEV void operator()(LAS char* lds, f32x4 (&acc)[2][2][4][2], const Unit& u, int wr, int wc, int fr, int fq, int wid, int lane) const {
        asm volatile("" : "+v"(fr), "+v"(fq));
        const int c0 = u.pn * 256 + 32 * wc + 8 * fq;
        {
            G8_ROWS_BEGIN const int row = u.pm * 256 + rl; const float rs = rstd[row];
#pragma unroll
                for (int bj = 0; bj < 2; ++bj) {
                    float z8[8]; un8(*(const u32x4*)(Z + (size_t)row * DM + c0 + 128 * bj), z8);
                    const float4 g0 = *(const float4*)(og + c0 + 128 * bj), g1 = *(const float4*)(og + c0 + 128 * bj + 4);
                    f32x4 o0, o1;
                    o0[0] = z8[0] * rs * g0.x * siluf_(acc[ai][bj][m][0][0]); o0[1] = z8[1] * rs * g0.y * siluf_(acc[ai][bj][m][0][1]); o0[2] = z8[2] * rs * g0.z * siluf_(acc[ai][bj][m][0][2]); o0[3] = z8[3] * rs * g0.w * siluf_(acc[ai][bj][m][0][3]);
                    o1[0] = z8[4] * rs * g1.x * siluf_(acc[ai][bj][m][1][0]); o1[1] = z8[5] * rs * g1.y * siluf_(acc[ai][bj][m][1][1]); o1[2] = z8[6] * rs * g1.z * siluf_(acc[ai][bj][m][1][2]); o1[3] = z8[7] * rs * g1.w * siluf_(acc[ai][bj][m][1][3]);
                    *(u32x4*)(Z + (size_t)row * DM + c0 + 128 * bj) = pk8(o0, o1); } G8_ROWS_END
        }
    } };
struct EpiG2m { bf16_t* HC; const bf16_t* XC; const float* ngain; const float* skip;
    DEV void operator()(LAS char* lds, f32x4 (&acc)[2][2][4][2], const Unit& u, int wr, int wc, int fr, int fq, int wid, int lane) const {
        asm volatile("" : "+v"(fr), "+v"(fq));
        const int c0 = u.pn * 256 + 32 * wc + 8 * fq;
        if (u.tag == 1) {
            LAS float* red = (LAS float*)(lds + 131072);
            G8_ROWS_BEGIN const int row = u.pm * 256 + rl; float s1 = 0.f, s2 = 0.f;
#pragma unroll
                for (int bj = 0; bj < 2; ++bj) {
                    float h8[8]; un8(*(const u32x4*)(HC + (size_t)row * DM + c0 + 128 * bj), h8);
#pragma unroll
                    for (int n = 0; n < 2; ++n)
#pragma unroll
                        for (int j = 0; j < 4; ++j) { const float v = h8[4 * n + j] * sigmoidf_(acc[ai][bj][m][n][j]); acc[ai][bj][m][n][j] = v; s1 += v; s2 += v * v; }
                }
                s1 += __shfl_xor(s1, 16); s1 += __shfl_xor(s1, 32); s2 += __shfl_xor(s2, 16); s2 += __shfl_xor(s2, 32);
                if (fq == 0) *(LAS f32x2*)(red + ((wid * 128) + 64 * ai + 16 * m + fr) * 2) = (f32x2){s1, s2}; G8_ROWS_END
            asm volatile("s_waitcnt lgkmcnt(0)" ::: "memory"); __builtin_amdgcn_s_barrier();
            G8_ROWS_BEGIN const int row = u.pm * 256 + rl; float t1 = 0.f, t2 = 0.f;
#pragma unroll
                for (int w2 = 0; w2 < 4; ++w2) { const f32x2 p_ = *(const LAS f32x2*)(red + (((wr * 4 + w2) * 128) + 64 * ai + 16 * m + fr) * 2); t1 += p_.x; t2 += p_.y; }
                const float mu = t1 * (1.f / DH), rs = rsqrtf(fmaxf(t2 * (1.f / DH) - mu * mu, 0.f) + EPS);
#pragma unroll
                for (int bj = 0; bj < 2; ++bj) {
                    float x8[8]; un8(*(const u32x4*)(XC + (size_t)row * DM + c0 + 128 * bj), x8);
                    const float4 g0 = *(const float4*)(ngain + c0 + 128 * bj), g1 = *(const float4*)(ngain + c0 + 128 * bj + 4), k0 = *(const float4*)(skip + c0 + 128 * bj), k1 = *(const float4*)(skip + c0 + 128 * bj + 4);
                    f32x4 o0, o1;
                    o0[0] = (acc[ai][bj][m][0][0] - mu) * rs * g0.x + k0.x * x8[0]; o0[1] = (acc[ai][bj][m][0][1] - mu) * rs * g0.y + k0.y * x8[1]; o0[2] = (acc[ai][bj][m][0][2] - mu) * rs * g0.z + k0.z * x8[2]; o0[3] = (acc[ai][bj][m][0][3] - mu) * rs * g0.w + k0.w * x8[3];
                    o1[0] = (acc[ai][bj][m][1][0] - mu) * rs * g1.x + k1.x * x8[4]; o1[1] = (acc[ai][bj][m][1][1] - mu) * rs * g1.y + k1.y * x8[5]; o1[2] = (acc[ai][bj][m][1][2] - mu) * rs * g1.z + k1.z * x8[6]; o1[3] = (acc[ai][bj][m][1][3] - mu) * rs * g1.w + k1.w * x8[7];
                    *(u32x4*)(HC + (size_t)row * DM + c0 + 128 * bj) = pk8(o0, o1); } G8_ROWS_END
        } else {
            G8_ROWS_BEGIN const int row = u.pm * 256 + rl;
#pragma unroll
                for (int bj = 0; bj < 2; ++bj) {
                    bf16_t* pp = HC + (size_t)row * DM + c0 + 128 * bj;
                    float h8[8]; un8(*(const u32x4*)pp, h8);
                    f32x4 o0, o1;
                    o0[0] = h8[0] * siluf_(acc[ai][bj][m][0][0]); o0[1] = h8[1] * siluf_(acc[ai][bj][m][0][1]); o0[2] = h8[2] * siluf_(acc[ai][bj][m][0][2]); o0[3] = h8[3] * siluf_(acc[ai][bj][m][0][3]);
                    o1[0] = h8[4] * siluf_(acc[ai][bj][m][1][0]); o1[1] = h8[5] * siluf_(acc[ai][bj][m][1][1]); o1[2] = h8[6] * siluf_(acc[ai][bj][m][1][2]); o1[3] = h8[7] * siluf_(acc[ai][bj][m][1][3]);
                    *(u32x4*)pp = pk8(o0, o1); } G8_ROWS_END
        }
    } };
}
DEV void rstd_rows(const float* rowss, float* rstd) {
    const int tid = opaque_tid();
    for (int r = blockIdx.x * 512 + tid; r < MTOK; r += gridDim.x * 512) { float s_ = 0.f;
#pragma unroll
        for (int p_ = 0; p_ < 16; ++p_) s_ += rowss[(size_t)p_ * MTOK + r];
        rstd[r] = rsqrtf(s_ * (1.f / DM) + EPS); }
}

DEV void transpose_item(const float* W, int ldw, int ncols, bf16_t* WT, int ldwt, LAS float* scr, int item, int lane) {
    const int nblk = ncols / 64, kb = item / nblk, nb = item % nblk, k0 = 64 * kb, n0 = 64 * nb;
    float4 v[16];
#pragma unroll
    for (int i = 0; i < 16; ++i) v[i] = *(const float4*)(W + (size_t)(k0 + 4 * i + (lane >> 4)) * ldw + n0 + 4 * (lane & 15));
#pragma unroll
    for (int i = 0; i < 16; ++i) { LAS float* d_ = scr + (4 * i + (lane >> 4)) * 65 + 4 * (lane & 15); d_[0] = v[i].x; d_[1] = v[i].y; d_[2] = v[i].z; d_[3] = v[i].w; }
    asm volatile("s_waitcnt lgkmcnt(0)" ::: "memory");
#pragma unroll
    for (int j = 0; j < 8; ++j) {
        const int n = (lane >> 3) + 8 * j, c = lane & 7;
        const LAS float* s_ = scr + (8 * c) * 65 + n;
        uint4 o;
        o.x = pk2(s_[0 * 65], s_[1 * 65]); o.y = pk2(s_[2 * 65], s_[3 * 65]); o.z = pk2(s_[4 * 65], s_[5 * 65]); o.w = pk2(s_[6 * 65], s_[7 * 65]);
        *(uint4*)(WT + (size_t)(n0 + n) * ldwt + k0 + 8 * c) = o;
    }
    asm volatile("s_waitcnt lgkmcnt(0)" ::: "memory");
}

DEV float wave_scan_add(float v, int lane) {
#pragma unroll
    for (int o = 1; o < 64; o <<= 1) { const float u = __shfl_up(v, o); if (lane >= o) v += u; }
    return v;
}
DEV float wave_scan_max(float v, int lane) {
#pragma unroll
    for (int o = 1; o < 64; o <<= 1) { const float u = __shfl_up(v, o); if (lane >= o) v = fmaxf(v, u); }
    return v;
}

template <int TT>
DEV void mlstm_a_wave(LAS char* shm, int fr, int fq, float m_prev, const LAS float* tpj, const LAS float* taj, f32x4 (&nacc)[3]) {
    constexpr int QS = 0, KS = 33792, VT = 67584, RS = 528, VRS = 96, NT = TT + 1;
    const LAS char* qb = shm + QS + (16 * TT + fr) * RS + fq * 16;
    const LAS char* kb = shm + KS + fr * RS + fq * 16;
    f32x4 sacc[NT];
#pragma unroll
    for (int jj = 0; jj < NT; ++jj) sacc[jj] = (f32x4){0.f, 0.f, 0.f, 0.f};
    bf16x8 qf = *(const LAS bf16x8*)qb, kf[NT];
#pragma unroll
    for (int jj = 0; jj < NT; ++jj) kf[jj] = *(const LAS bf16x8*)(kb + jj * 16 * RS);
#pragma unroll
    for (int ks = 0; ks < 8; ++ks) {
        bf16x8 qn = qf, kn[NT];
#pragma unroll
        for (int jj = 0; jj < NT; ++jj) kn[jj] = kf[jj];
        if (ks < 7) {
            qn = *(const LAS bf16x8*)(qb + (ks + 1) * 64);
#pragma unroll
            for (int jj = 0; jj < NT; ++jj) kn[jj] = *(const LAS bf16x8*)(kb + jj * 16 * RS + (ks + 1) * 64);
        }
#pragma unroll
        for (int jj = 0; jj < NT; ++jj) sacc[jj] = __builtin_amdgcn_mfma_f32_16x16x32_bf16(kf[jj], qf, sacc[jj], 0, 0, 0);
        qf = qn;
#pragma unroll
        for (int jj = 0; jj < NT; ++jj) kf[jj] = kn[jj];
    }
    constexpr int NK = (TT >= 2) ? 2 : 1;
    s16x4 vlo[NK][3], vhi[NK][3];
#pragma unroll
    for (int kk = 0; kk < NK; ++kk)
#pragma unroll
        for (int vt = 0; vt < 3; ++vt) {
            vlo[kk][vt] = __builtin_amdgcn_ds_read_tr16_b64_v4i16((LAS s16x4*)(shm + VT + (32 * kk + 4 * fq + (fr >> 2)) * VRS + (16 * vt + 4 * (fr & 3)) * 2));
            vhi[kk][vt] = __builtin_amdgcn_ds_read_tr16_b64_v4i16((LAS s16x4*)(shm + VT + (32 * kk + 16 + 4 * fq + (fr >> 2)) * VRS + (16 * vt + 4 * (fr & 3)) * 2));
        }
    const int t = 16 * TT + fr;
    const float btm = -fmaxf(m_prev, tpj[t]);
    f32x4 sm[2 * NK];
#pragma unroll
    for (int jj = 0; jj < 2 * NK; ++jj) {
        if (jj < NT) {
            const f32x4 a4 = *(const LAS f32x4*)(taj + 16 * jj + 4 * fq);
#pragma unroll
            for (int r = 0; r < 4; ++r) {
                const int s_ = 16 * jj + 4 * fq + r;
                sm[jj][r] = (jj < TT || s_ <= t) ? sacc[jj < NT ? jj : 0][r] * __expf(btm + a4[r]) : 0.f;
            }
        } else sm[jj] = (f32x4){0.f, 0.f, 0.f, 0.f};
    }
#pragma unroll
    for (int kk = 0; kk < NK; ++kk) {
        const u32x4 u = (u32x4){pk2(sm[2 * kk][0], sm[2 * kk][1]), pk2(sm[2 * kk][2], sm[2 * kk][3]), pk2(sm[2 * kk + 1][0], sm[2 * kk + 1][1]), pk2(sm[2 * kk + 1][2], sm[2 * kk + 1][3])};
        const bf16x8 af = *(const bf16x8*)&u;
#pragma unroll
        for (int vt = 0; vt < 3; ++vt) {
            bf16x8 bv8; bv8[0] = vlo[kk][vt][0]; bv8[1] = vlo[kk][vt][1]; bv8[2] = vlo[kk][vt][2]; bv8[3] = vlo[kk][vt][3];
            bv8[4] = vhi[kk][vt][0]; bv8[5] = vhi[kk][vt][1]; bv8[6] = vhi[kk][vt][2]; bv8[7] = vhi[kk][vt][3];
            nacc[vt] = __builtin_amdgcn_mfma_f32_16x16x32_bf16(af, bv8, nacc[vt], 0, 0, 0);
        }
    }
}
DEV void mlstm_b_wave(LAS char* shm, int tt, int fr, int fq, f32x4 (&nacc)[3]) {
    constexpr int QS = 0, CB = 81408, RS = 528;
    const LAS char* qb = shm + QS + (16 * tt + fr) * RS + fq * 16;
    const LAS char* cbp = shm + CB + fr * RS + fq * 16;
    bf16x8 qf = *(const LAS bf16x8*)qb, cf[3];
#pragma unroll
    for (int vt = 0; vt < 3; ++vt) cf[vt] = *(const LAS bf16x8*)(cbp + vt * 16 * RS);
#pragma unroll
    for (int ks = 0; ks < 8; ++ks) {
        bf16x8 qn = qf, cn[3] = {cf[0], cf[1], cf[2]};
        if (ks < 7) {
            qn = *(const LAS bf16x8*)(qb + (ks + 1) * 64);
#pragma unroll
            for (int vt = 0; vt < 3; ++vt) cn[vt] = *(const LAS bf16x8*)(cbp + vt * 16 * RS + (ks + 1) * 64);
        }
#pragma unroll
        for (int vt = 0; vt < 3; ++vt) nacc[vt] = __builtin_amdgcn_mfma_f32_16x16x32_bf16(qf, cf[vt], nacc[vt], 0, 0, 0);
        qf = qn;
#pragma unroll
        for (int vt = 0; vt < 3; ++vt) cf[vt] = cn[vt];
    }
}
template <int SKIP>
DEV void mlstm_phase(LAS char* shm, const bf16_t* q, const bf16_t* k, const bf16_t* v, const float* gpart, const float* b_ig, const float* b_fg, bf16_t* hc) {
    const int tid = opaque_tid(), wid = __builtin_amdgcn_readfirstlane(tid >> 6), lane = tid & 63, fr = lane & 15, fq = lane >> 4;
    constexpr int QS = 0, KS = 33792, VT = 67584, VWT = 74496, CB = 81408, PART = 106752, TB = 120064, TA = 128256, TP = 136448, TC = 144640, HST = 144896, RS = 528, VRS = 96, PRS = 52;
    LAS float* part = (LAS float*)(shm + PART);
    LAS float* tb = (LAS float*)(shm + TB); LAS float* ta = (LAS float*)(shm + TA); LAS float* tp = (LAS float*)(shm + TP); LAS float* tc = (LAS float*)(shm + TC);
    for (int item = blockIdx.x; item < BATCH * NH * 8; item += gridDim.x) {
        const int vs = (item >> 3) & 7, bh = (item & 7) + 8 * (item >> 6), h = bh & 3, b = bh >> 2;
        __syncthreads();
        for (int i = tid; i < (CB + 25344 - VT) / 4; i += 512) ((LAS unsigned*)(shm + VT))[i] = 0u;
        for (int j = wid; j < SEQ / CHUNK; j += 8) {
            const int m = b * SEQ + j * CHUNK + lane;
            const float* gp = gpart + (size_t)m * 8;
            const float ig = gp[h] + gp[(size_t)MTOK * 8 + h] + b_ig[h];
            const float lf = logsigmoidf_(gp[4 + h] + gp[(size_t)MTOK * 8 + 4 + h] + b_fg[h]);
            const float bc = wave_scan_add(lf, lane);
            const float a_ = ig - bc;
            const float pm = wave_scan_max(a_, lane);
            tb[j * 64 + lane] = bc; ta[j * 64 + lane] = a_; tp[j * 64 + lane] = pm;
            if (lane == 63) { tc[2 * j] = bc; tc[2 * j + 1] = pm; }
        }
        __syncthreads();
        if (tid < 64) *(LAS u32x4*)(shm + VT + tid * VRS + 64) = (u32x4){0x3F80u, 0u, 0u, 0u};
        f32x4 cacc[2][3];
#pragma unroll
        for (int i = 0; i < 2; ++i)
#pragma unroll
            for (int vt = 0; vt < 3; ++vt) cacc[i][vt] = (f32x4){0.f, 0.f, 0.f, 0.f};
        float m_prev = 0.f;
        const size_t cb0 = ((size_t)(b * SEQ)) * DM + h * DH;
        uint4 qv[4], kv[4], vv = make_uint4(0, 0, 0, 0);
#pragma unroll
        for (int i = 0; i < 4; ++i) {
            const int idx = tid + 512 * i, row = idx >> 5, c16 = idx & 31;
            qv[i] = *(const uint4*)(q + cb0 + (size_t)row * DM + c16 * 8);
            kv[i] = *(const uint4*)(k + cb0 + (size_t)row * DM + c16 * 8);
        }
        if (tid < 256) vv = *(const uint4*)(v + cb0 + (size_t)(tid >> 2) * DM + vs * 32 + (tid & 3) * 8);
#pragma nounroll
        for (int j = 0; j < SEQ / CHUNK; ++j) {
            const size_t cb = cb0 + (size_t)j * CHUNK * DM;
            const float btot = tc[2 * j], amax = tc[2 * j + 1];
            const float mxc = fmaxf(m_prev, amax);
#pragma unroll
            for (int i = 0; i < ((SKIP & 8) ? 0 : 4); ++i) {
                const int idx = tid + 512 * i, row = idx >> 5, c16 = idx & 31;
                *(LAS u32x4*)(shm + QS + row * RS + c16 * 16) = (u32x4){qv[i].x, qv[i].y, qv[i].z, qv[i].w};
                *(LAS u32x4*)(shm + KS + row * RS + c16 * 16) = (u32x4){kv[i].x, kv[i].y, kv[i].z, kv[i].w};
            }
            if (tid < 256) {
                const int s_ = tid >> 2, v0 = (tid & 3) * 8;
                const float ws = __expf(ta[j * 64 + s_] - mxc);
                float f8[8]; unpack8(vv, f8);
#pragma unroll
                for (int e = 0; e < 8; ++e) f8[e] *= ws;
                const uint4 wv = pack8(f8);
                *(LAS u32x4*)(shm + VT + s_ * VRS + v0 * 2) = (u32x4){vv.x, vv.y, vv.z, vv.w};
                *(LAS u32x4*)(shm + VWT + s_ * VRS + v0 * 2) = (u32x4){wv.x, wv.y, wv.z, wv.w};
            } else if (tid < 320) {
                const int s_ = tid - 256;
                *(LAS u32x4*)(shm + VWT + s_ * VRS + 64) = (u32x4){(unsigned)f2bf(__expf(ta[j * 64 + s_] - mxc)), 0u, 0u, 0u};
            }
            if (j + 1 < SEQ / CHUNK) {
                const size_t cn = cb + (size_t)CHUNK * DM;
#pragma unroll
                for (int i = 0; i < 4; ++i) {
                    const int idx = tid + 512 * i, row = idx >> 5, c16 = idx & 31;
                    qv[i] = *(const uint4*)(q + cn + (size_t)row * DM + c16 * 8);
                    kv[i] = *(const uint4*)(k + cn + (size_t)row * DM + c16 * 8);
                }
                if (tid < 256) vv = *(const uint4*)(v + cn + (size_t)(tid >> 2) * DM + vs * 32 + (tid & 3) * 8);
            }
            __syncthreads();
            f32x4 nacc[3];
#pragma unroll
            for (int vt = 0; vt < 3; ++vt) nacc[vt] = (f32x4){0.f, 0.f, 0.f, 0.f};
            const int tt = wid & 3;
            if (wid < 4) { if (!(SKIP & 1)) {
                const LAS float* tpj = tp + j * 64; const LAS float* taj = ta + j * 64;
                if (tt == 0) mlstm_a_wave<0>(shm, fr, fq, m_prev, tpj, taj, nacc);
                else if (tt == 1) mlstm_a_wave<1>(shm, fr, fq, m_prev, tpj, taj, nacc);
                else if (tt == 2) mlstm_a_wave<2>(shm, fr, fq, m_prev, tpj, taj, nacc);
                else mlstm_a_wave<3>(shm, fr, fq, m_prev, tpj, taj, nacc);
            } } else if (!(SKIP & 2)) {
                mlstm_b_wave(shm, tt, fr, fq, nacc);
                const f32x4 pm4 = *(const LAS f32x4*)(tp + j * 64 + 16 * tt + 4 * fq);
#pragma unroll
                for (int vt = 0; vt < 3; ++vt)
#pragma unroll
                    for (int r = 0; r < 4; ++r) part[(16 * tt + 4 * fq + r) * PRS + 16 * vt + fr] = __expf(m_prev - fmaxf(m_prev, pm4[r])) * nacc[vt][r];
            }
            if (!(SKIP & 4)) {
                const float decay = __expf(m_prev - mxc);
#pragma unroll
                for (int i = 0; i < 2; ++i)
#pragma unroll
                    for (int vt = 0; vt < 3; ++vt) cacc[i][vt] *= decay;
                const int q_ = fr >> 2, p_ = fr & 3;
                s16x4 wl[2][3], wh[2][3], kl[2][2], kh[2][2];
#pragma unroll
                for (int kk = 0; kk < 2; ++kk) {
#pragma unroll
                    for (int vt = 0; vt < 3; ++vt) {
                        wl[kk][vt] = __builtin_amdgcn_ds_read_tr16_b64_v4i16((LAS s16x4*)(shm + VWT + (32 * kk + 8 * fq + q_) * VRS + (16 * vt + 4 * p_) * 2));
                        wh[kk][vt] = __builtin_amdgcn_ds_read_tr16_b64_v4i16((LAS s16x4*)(shm + VWT + (32 * kk + 8 * fq + 4 + q_) * VRS + (16 * vt + 4 * p_) * 2));
                    }
#pragma unroll
                    for (int i = 0; i < 2; ++i) {
                        const int dt = 2 * wid + i;
                        kl[kk][i] = __builtin_amdgcn_ds_read_tr16_b64_v4i16((LAS s16x4*)(shm + KS + (32 * kk + 8 * fq + q_) * RS + (16 * dt + 4 * p_) * 2));
                        kh[kk][i] = __builtin_amdgcn_ds_read_tr16_b64_v4i16((LAS s16x4*)(shm + KS + (32 * kk + 8 * fq + 4 + q_) * RS + (16 * dt + 4 * p_) * 2));
                    }
                }
#pragma unroll
                for (int kk = 0; kk < 2; ++kk) {
                    bf16x8 bfv[3];
#pragma unroll
                    for (int vt = 0; vt < 3; ++vt) { bfv[vt][0] = wl[kk][vt][0]; bfv[vt][1] = wl[kk][vt][1]; bfv[vt][2] = wl[kk][vt][2]; bfv[vt][3] = wl[kk][vt][3];
                        bfv[vt][4] = wh[kk][vt][0]; bfv[vt][5] = wh[kk][vt][1]; bfv[vt][6] = wh[kk][vt][2]; bfv[vt][7] = wh[kk][vt][3]; }
#pragma unroll
                    for (int i = 0; i < 2; ++i) {
                        bf16x8 af; af[0] = kl[kk][i][0]; af[1] = kl[kk][i][1]; af[2] = kl[kk][i][2]; af[3] = kl[kk][i][3]; af[4] = kh[kk][i][0]; af[5] = kh[kk][i][1]; af[6] = kh[kk][i][2]; af[7] = kh[kk][i][3];
#pragma unroll
                        for (int vt = 0; vt < 3; ++vt) cacc[i][vt] = __builtin_amdgcn_mfma_f32_16x16x32_bf16(af, bfv[vt], cacc[i][vt], 0, 0, 0);
                    }
                }
            }
            __syncthreads();
            if (wid < 4 && !(SKIP & 16)) {
                const f32x4 pm4 = *(const LAS f32x4*)(tp + j * 64 + 16 * tt + 4 * fq);
                const f32x4 bc4 = *(const LAS f32x4*)(tb + j * 64 + 16 * tt + 4 * fq);
#pragma unroll
                for (int vt = 0; vt < 3; ++vt)
#pragma unroll
                    for (int r = 0; r < 4; ++r) nacc[vt][r] += part[(16 * tt + 4 * fq + r) * PRS + 16 * vt + fr];
#pragma unroll
                for (int r = 0; r < 4; ++r) {
                    const float den = __shfl(nacc[2][r], lane & 48);
                    const float inv = __builtin_amdgcn_rcpf(fmaxf(fabsf(den), __expf(-(bc4[r] + fmaxf(m_prev, pm4[r])))));
                    LAS bf16_t* hrow = (LAS bf16_t*)(shm + HST + (16 * tt + 4 * fq + r) * 80);
                    hrow[fr] = f2bf(nacc[0][r] * inv);
                    hrow[16 + fr] = f2bf(nacc[1][r] * inv);
                }
                asm volatile("s_waitcnt lgkmcnt(0)" ::: "memory");
                {
                    const int rw = 16 * tt + (lane >> 2), pc = lane & 3;
                    const u32x4 hv = *(const LAS u32x4*)(shm + HST + rw * 80 + pc * 16);
                    *(uint4*)(hc + cb + (size_t)rw * DM + vs * 32 + pc * 8) = make_uint4(hv[0], hv[1], hv[2], hv[3]);
                }
            }
#pragma unroll
            for (int i = 0; i < 2; ++i)
#pragma unroll
                for (int vt = 0; vt < 3; ++vt) {
                    u32x2 o; o[0] = pk2(cacc[i][vt][0], cacc[i][vt][1]); o[1] = pk2(cacc[i][vt][2], cacc[i][vt][3]);
                    *(LAS u32x2*)(shm + CB + (16 * vt + fr) * RS + (16 * (2 * wid + i) + 4 * fq) * 2) = o;
                }
            m_prev = btot + mxc;
        }
    }
}

constexpr int S5L = 32, S5NCH = SEQ / S5L;
constexpr size_t T_KT_OFF = 0, T_WS_OFF = 2u << 20, T_V_OFF = 10u << 20, T_AL_OFF = 18u << 20;
constexpr int KT_G = 33 * 256, WS_G = 128 * 512, V_G = 512 * 128;

DEV void s5_tables(LAS char* shm, char* tab, const float* lam_re, const float* lam_im, const float* log_dt, const float* b_re, const float* b_im,
                   const float* c_re, const float* c_im) {
    const int tid = opaque_tid();
    LAS f32x2* apw = (LAS f32x2*)shm;
    LAS f32x2* bb = (LAS f32x2*)(shm + 64 * 33 * 8);
    LAS f32x2* cc = (LAS f32x2*)(shm + 64 * 33 * 8 + 8192);
    bf16_t* KT = (bf16_t*)(tab + T_KT_OFF); bf16_t* WS = (bf16_t*)(tab + T_WS_OFF); bf16_t* VV = (bf16_t*)(tab + T_V_OFF); float2* AL = (float2*)(tab + T_AL_OFF);
    for (int it = blockIdx.x; it < 256; it += gridDim.x) {
        const int g = it & 63, qd = it >> 6;
        __syncthreads();
        if (tid < 64) {
            const int pp = tid;
            const double lr = lam_re[g * NP + pp], li = lam_im[g * NP + pp], dt = exp((double)log_dt[g]);
            const double er = exp(lr * dt);
            const double ar = er * cos(li * dt), ai = er * sin(li * dt);
            const double dr = ar - 1.0, di = ai, den = lr * lr + li * li;
            const double cr = (dr * lr + di * li) / den, ci = (di * lr - dr * li) / den;
            double pr = 1.0, pi_ = 0.0;
            for (int e = 0; e <= 32; ++e) {
                apw[pp * 33 + e] = (f32x2){(float)pr, (float)pi_};
                const double nr = pr * ar - pi_ * ai, ni = pr * ai + pi_ * ar; pr = nr; pi_ = ni;
            }
            if (qd == 0) { const f32x2 t_ = apw[pp * 33 + 32]; AL[g * NP + pp] = make_float2(t_.x, t_.y); }
            for (int c = 0; c < 16; ++c) {
                const double br = b_re[(g * NP + pp) * GC + c], bi = b_im[(g * NP + pp) * GC + c];
                bb[pp * 16 + c] = (f32x2){(float)(cr * br - ci * bi), (float)(cr * bi + ci * br)};
                cc[c * 64 + pp] = (f32x2){c_re[(g * GC + c) * NP + pp], c_im[(g * GC + c) * NP + pp]};
            }
        }
        __syncthreads();
        for (int o = tid; o < 8 * 256; o += 512) {
            const int d = 8 * qd + (o >> 8), c1 = (o >> 4) & 15, c0 = o & 15;
            float acc = 0.f;
            for (int pp = 0; pp < 64; ++pp) {
                const f32x2 a = apw[pp * 33 + d], b = bb[pp * 16 + c0], c = cc[c1 * 64 + pp];
                const float mr = a.x * b.x - a.y * b.y, mi = a.x * b.y + a.y * b.x;
                acc += c.x * mr - c.y * mi;
            }
            KT[(size_t)g * KT_G + (d + 1) * 256 + c1 * 16 + c0] = f2bf(acc);
        }
        if (qd == 0 && tid < 256) KT[(size_t)g * KT_G + tid] = 0;
        for (int o = tid; o < 2 * 16 * 64; o += 512) {
            const int mt = 2 * qd + (o >> 10), sp = (o >> 6) & 15, ln = o & 63;
            const int row = 16 * mt + (ln & 15), ri = row >> 6, pp = row & 63, s_ = 2 * sp + (ln >> 5), c0 = 8 * ((ln >> 4) & 1);
            const f32x2 a = apw[pp * 33 + 31 - s_];
            unsigned w[4];
#pragma unroll
            for (int jj = 0; jj < 8; jj += 2) {
                const f32x2 b0 = bb[pp * 16 + c0 + jj], b1 = bb[pp * 16 + c0 + jj + 1];
                const float v0 = ri ? (a.x * b0.y + a.y * b0.x) : (a.x * b0.x - a.y * b0.y);
                const float v1 = ri ? (a.x * b1.y + a.y * b1.x) : (a.x * b1.x - a.y * b1.y);
                w[jj >> 1] = pk2(v0, v1);
            }
            *(uint4*)(WS + (size_t)g * WS_G + ((size_t)(mt * 16 + sp) * 64 + ln) * 8) = make_uint4(w[0], w[1], w[2], w[3]);
        }
        for (int o = tid; o < 8 * 4 * 64; o += 512) {
            const int i = 8 * qd + (o >> 8), ks = (o >> 6) & 3, ln = o & 63;
            const int c1 = ln & 15, k0 = 32 * ks + 8 * (ln >> 4);
            unsigned w[4];
#pragma unroll
            for (int jj = 0; jj < 8; jj += 2) {
                float v[2];
#pragma unroll
                for (int e = 0; e < 2; ++e) {
                    const int kk = k0 + jj + e, ri = kk >> 6, pp = kk & 63;
                    const f32x2 a = apw[pp * 33 + i + 1], c = cc[c1 * 64 + pp];
                    v[e] = ri ? -(c.x * a.y + c.y * a.x) : (c.x * a.x - c.y * a.y);
                }
                w[jj >> 1] = pk2(v[0], v[1]);
            }
            *(uint4*)(VV + (size_t)g * V_G + ((size_t)(i * 4 + ks) * 64 + ln) * 8) = make_uint4(w[0], w[1], w[2], w[3]);
        }
    }
}

template <int NQ>
DEV void s5_p1_range(LAS char* shm, int lo, int hi, int wid, int fr, int fq, const bf16_t* wsp, f32x4 (&acc)[4][4], f32x4 (&sac)[4]) {
    constexpr int PLANE = 64 * 528, KTL = 2 * PLANE, Q0 = 4 - NQ;
    if (lo > hi) return;
    const LAS char* ub = shm + (fq & 1) * PLANE + fr * 528 + (fq >> 1) * 16;
    const LAS char* kb = shm + KTL + (1 - (fq >> 1)) * 512 + fr * 32 + (fq & 1) * 16;
    bf16x8 bu[4], kf[NQ], wcur;
#pragma unroll
    for (int nt = 0; nt < 4; ++nt) bu[nt] = *(const LAS bf16x8*)(ub + nt * 16 * 528 + lo * 32);
#pragma unroll
    for (int q = 0; q < NQ; ++q) kf[q] = *(const LAS bf16x8*)(kb + (wid + 8 * (Q0 + q) - 2 * lo) * 512);
    wcur = *(const bf16x8*)(wsp + (size_t)lo * 64 * 8);
#pragma nounroll
    for (int sp = lo; sp <= hi; ++sp) {
        bf16x8 bn[4], kn[NQ], wn = wcur;
        const int sn = (sp < hi) ? sp + 1 : sp;
#pragma unroll
        for (int nt = 0; nt < 4; ++nt) bn[nt] = *(const LAS bf16x8*)(ub + nt * 16 * 528 + sn * 32);
#pragma unroll
        for (int q = 0; q < NQ; ++q) kn[q] = *(const LAS bf16x8*)(kb + (wid + 8 * (Q0 + q) - 2 * sn) * 512);
        wn = *(const bf16x8*)(wsp + (size_t)sn * 64 * 8);
#pragma unroll
        for (int nt = 0; nt < 4; ++nt) sac[nt] = __builtin_amdgcn_mfma_f32_16x16x32_bf16(wcur, bu[nt], sac[nt], 0, 0, 0);
#pragma unroll
        for (int q = 0; q < NQ; ++q)
#pragma unroll
            for (int nt = 0; nt < 4; ++nt) acc[Q0 + q][nt] = __builtin_amdgcn_mfma_f32_16x16x32_bf16(kf[q], bu[nt], acc[Q0 + q][nt], 0, 0, 0);
#pragma unroll
        for (int nt = 0; nt < 4; ++nt) bu[nt] = bn[nt];
#pragma unroll
        for (int q = 0; q < NQ; ++q) kf[q] = kn[q];
        wcur = wn;
    }
}
DEV void s5_phase(LAS char* shm, const bf16_t* Uin, bf16_t* Yout, const char* tab, const float* dskip) {
    const int tid = opaque_tid(), wid = __builtin_amdgcn_readfirstlane(tid >> 6), lane = tid & 63, fr = lane & 15, fq = lane >> 4;
    constexpr int PLANE = 64 * 528, KTL = 2 * PLANE, SL = KTL + 33 * 512, HB = SL + 64 * 528, SRS = 528, HRS = 272, TSEG = HB + 64 * 272;
    const bf16_t* KT = (const bf16_t*)(tab + T_KT_OFF); const bf16_t* WS = (const bf16_t*)(tab + T_WS_OFF); const bf16_t* VV = (const bf16_t*)(tab + T_V_OFF);
    const float2* AL = (const float2*)(tab + T_AL_OFF);
    for (int item = blockIdx.x; item < BATCH * NG; item += gridDim.x) {
        const int xcd_ = item & 7, j_ = (item >> 3) & 31, g = xcd_ * 8 + (j_ & 7), b = (j_ >> 3) + 4 * (item >> 8);
        const bf16_t* Ub = Uin + ((size_t)g * MTOK + (size_t)b * SEQ) * 16;
        bf16_t* Yb = Yout + ((size_t)g * MTOK + (size_t)b * SEQ) * 16;
        __syncthreads();
#pragma unroll
        for (int i = 0; i < 8; ++i) {
            const int idx = tid + 512 * i, tok = idx >> 1, hf = idx & 1;
            const uint4 uv = *(const uint4*)(Ub + (size_t)tok * 16 + hf * 8);
            *(LAS u32x4*)(shm + hf * PLANE + (tok >> 5) * 528 + (tok & 31) * 16) = (u32x4){uv.x, uv.y, uv.z, uv.w};
        }
        for (int idx = tid; idx < 33 * 32; idx += 512) {
            const uint4 kv = *(const uint4*)(KT + (size_t)g * KT_G + idx * 8);
            *(LAS u32x4*)(shm + KTL + idx * 16) = (u32x4){kv.x, kv.y, kv.z, kv.w};
        }
        __syncthreads();
        f32x4 acc[4][4], sac[4];
#pragma unroll
        for (int q = 0; q < 4; ++q)
#pragma unroll
            for (int nt = 0; nt < 4; ++nt) acc[q][nt] = (f32x4){0.f, 0.f, 0.f, 0.f};
#pragma unroll
        for (int nt = 0; nt < 4; ++nt) sac[nt] = (f32x4){0.f, 0.f, 0.f, 0.f};
        const bf16_t* wsp = WS + (size_t)g * WS_G + ((size_t)(wid * 16) * 64 + lane) * 8;
        const int h2 = wid >> 1;
        s5_p1_range<4>(shm, 0, h2, wid, fr, fq, wsp, acc, sac);
        s5_p1_range<3>(shm, h2 + 1, 4 + h2, wid, fr, fq, wsp, acc, sac);
        s5_p1_range<2>(shm, 5 + h2, 8 + h2, wid, fr, fq, wsp, acc, sac);
        s5_p1_range<1>(shm, 9 + h2, 12 + h2, wid, fr, fq, wsp, acc, sac);
        if (13 + h2 <= 15) {
            const LAS char* ub = shm + (fq & 1) * PLANE + fr * 528 + (fq >> 1) * 16;
            for (int sp = 13 + h2; sp <= 15; ++sp) {
                const bf16x8 wcur = *(const bf16x8*)(wsp + (size_t)sp * 64 * 8);
#pragma unroll
                for (int nt = 0; nt < 4; ++nt) sac[nt] = __builtin_amdgcn_mfma_f32_16x16x32_bf16(wcur, *(const LAS bf16x8*)(ub + nt * 16 * 528 + sp * 32), sac[nt], 0, 0, 0);
            }
        }
#pragma unroll
        for (int nt = 0; nt < 4; ++nt) *(LAS f32x4*)(shm + SL + (16 * nt + fr) * SRS + (16 * wid + 4 * fq) * 4) = sac[nt];
        __syncthreads();
        {
            const float2 al = AL[g * NP + lane];
            float hr = 0.f, hi = 0.f, lr[8], li[8];
#pragma unroll
            for (int n = 0; n < 8; ++n) {
                lr[n] = hr; li[n] = hi;
                const float sr = *(const LAS float*)(shm + SL + (8 * wid + n) * SRS + lane * 4), si = *(const LAS float*)(shm + SL + (8 * wid + n) * SRS + (64 + lane) * 4);
                const float nr = al.x * hr - al.y * hi + sr, ni = al.x * hi + al.y * hr + si; hr = nr; hi = ni;
            }
            *(LAS float*)(shm + TSEG + (wid * 128 + lane) * 4) = hr; *(LAS float*)(shm + TSEG + (wid * 128 + 64 + lane) * 4) = hi;
            float pr = al.x, pi = al.y;
#pragma unroll
            for (int e = 0; e < 3; ++e) { const float nr = pr * pr - pi * pi, ni = 2.f * pr * pi; pr = nr; pi = ni; }
            __syncthreads();
            float cr = 0.f, ci = 0.f;
            for (int w2 = 0; w2 < wid; ++w2) {
                const float tr = *(const LAS float*)(shm + TSEG + (w2 * 128 + lane) * 4), ti = *(const LAS float*)(shm + TSEG + (w2 * 128 + 64 + lane) * 4);
                const float nr = pr * cr - pi * ci + tr, ni = pr * ci + pi * cr + ti; cr = nr; ci = ni;
            }
            float qr = 1.f, qi = 0.f;
#pragma unroll
            for (int n = 0; n < 8; ++n) {
                const float fr_ = lr[n] + qr * cr - qi * ci, fi_ = li[n] + qr * ci + qi * cr;
                *(LAS bf16_t*)(shm + HB + (8 * wid + n) * HRS + lane * 2) = f2bf(fr_);
                *(LAS bf16_t*)(shm + HB + (8 * wid + n) * HRS + (64 + lane) * 2) = f2bf(fi_);
                const float nr = qr * al.x - qi * al.y, ni = qr * al.y + qi * al.x; qr = nr; qi = ni;
            }
        }
        __syncthreads();
        const bf16_t* vvp = VV + (size_t)g * V_G + (size_t)lane * 8;
        bf16x8 va[4];
#pragma unroll
        for (int q = 0; q < 4; ++q) va[q] = *(const bf16x8*)(vvp + ((size_t)((wid + 8 * q) * 4 + 0) * 64) * 8);
#pragma unroll
        for (int ks = 0; ks < 4; ++ks) {
            bf16x8 hb[4], vn[4];
#pragma unroll
            for (int nt = 0; nt < 4; ++nt) hb[nt] = *(const LAS bf16x8*)(shm + HB + (16 * nt + fr) * HRS + (32 * ks + 8 * fq) * 2);
#pragma unroll
            for (int q = 0; q < 4; ++q) vn[q] = (ks < 3) ? *(const bf16x8*)(vvp + ((size_t)((wid + 8 * q) * 4 + ks + 1) * 64) * 8) : va[q];
#pragma unroll
            for (int q = 0; q < 4; ++q)
#pragma unroll
                for (int nt = 0; nt < 4; ++nt) acc[q][nt] = __builtin_amdgcn_mfma_f32_16x16x32_bf16(va[q], hb[nt], acc[q][nt], 0, 0, 0);
#pragma unroll
            for (int q = 0; q < 4; ++q) va[q] = vn[q];
        }
        const float4 dsk = *(const float4*)(dskip + g * GC + 4 * fq);
#pragma unroll
        for (int q = 0; q < 4; ++q) {
            const int i = wid + 8 * q;
#pragma unroll
            for (int nt = 0; nt < 4; ++nt) {
                const int n = 16 * nt + fr;
                const u32x2 uu = *(const LAS u32x2*)(shm + (fq >> 1) * PLANE + n * 528 + i * 16 + ((4 * fq) & 7) * 2);
                f32x4 o;
                o[0] = geluf_(acc[q][nt][0] + dsk.x * bf2f((bf16_t)(uu[0] & 0xffff))); o[1] = geluf_(acc[q][nt][1] + dsk.y * bf2f((bf16_t)(uu[0] >> 16)));
                o[2] = geluf_(acc[q][nt][2] + dsk.z * bf2f((bf16_t)(uu[1] & 0xffff))); o[3] = geluf_(acc[q][nt][3] + dsk.w * bf2f((bf16_t)(uu[1] >> 16)));
                *(uint2*)(Yb + (size_t)(n * 32 + i) * 16 + 4 * fq) = pack4(o);
            }
        }
    }
}


DEV void norm_rows(const float* x, const float* gain, const float* modl, bf16_t* h) {
    const int tid = opaque_tid(), lane = tid & 63, gw = blockIdx.x * 8 + (tid >> 6), NGW = gridDim.x * 8;
    for (int m0 = gw * 2; m0 < MTOK; m0 += NGW * 2) {
        float4 v[2][4]; float ss[2] = {0.f, 0.f};
#pragma unroll
        for (int r = 0; r < 2; ++r) { const float4* xr = (const float4*)(x + (size_t)(m0 + r) * DM) + lane;
#pragma unroll
            for (int j = 0; j < 4; ++j) v[r][j] = xr[64 * j]; }
#pragma unroll
        for (int r = 0; r < 2; ++r) {
#pragma unroll
            for (int j = 0; j < 4; ++j) ss[r] += v[r][j].x * v[r][j].x + v[r][j].y * v[r][j].y + v[r][j].z * v[r][j].z + v[r][j].w * v[r][j].w;
            const float rstd = rsqrtf(wave_sum(ss[r]) * (1.f / DM) + EPS);
            const int m = m0 + r;
            const float* shift = modl + (size_t)(m / SEQ) * 3 * DM; const float* scale = shift + DM;
#pragma unroll
            for (int j = 0; j < 4; ++j) {
                const int n = 4 * lane + 256 * j;
                const float4 g = *(const float4*)(gain + n), sc = *(const float4*)(scale + n), sh = *(const float4*)(shift + n);
                f32x4 o; o[0] = v[r][j].x * rstd * g.x * (1.f + sc.x) + sh.x; o[1] = v[r][j].y * rstd * g.y * (1.f + sc.y) + sh.y;
                o[2] = v[r][j].z * rstd * g.z * (1.f + sc.z) + sh.z; o[3] = v[r][j].w * rstd * g.w * (1.f + sc.w) + sh.w;
                *(uint2*)(h + (size_t)m * DM + n) = pack4(o);
            }
        }
    }
}
DEV void ssm_post_rows(const bf16_t* z, bf16_t* zo, const bf16_t* sg, const float* gain) {
    const int tid = opaque_tid(), lane = tid & 63, gw = blockIdx.x * 8 + (tid >> 6), NGW = gridDim.x * 8;
    for (int m = gw; m < MTOK; m += NGW) {
        float zv[2][8], gv[2][8]; float ss = 0.f;
#pragma unroll
        for (int j = 0; j < 2; ++j) {
            unpack8(*(const uint4*)(z + (size_t)m * DM + 8 * lane + 512 * j), zv[j]);
            unpack8(*(const uint4*)(sg + (size_t)m * DM + 8 * lane + 512 * j), gv[j]);
#pragma unroll
            for (int e = 0; e < 8; ++e) ss += zv[j][e] * zv[j][e];
        }
        const float rstd = rsqrtf(wave_sum(ss) * (1.f / DM) + EPS);
#pragma unroll
        for (int j = 0; j < 2; ++j) {
            const int n = 8 * lane + 512 * j; float o[8];
#pragma unroll
            for (int e = 0; e < 8; ++e) o[e] = zv[j][e] * rstd * gain[n + e] * siluf_(gv[j][e]);
            *(uint4*)(zo + (size_t)m * DM + n) = pack8(o);
        }
    }
}
DEV void mlstm_post_rows(const bf16_t* hc, bf16_t* ho, const bf16_t* mo, const bf16_t* mg, const bf16_t* mi, const float* cw, const float* cb, const float* ngain, const float* skip) {
    const int tid = opaque_tid(), lane = tid & 63, gw = blockIdx.x * 8 + (tid >> 6), NGW = gridDim.x * 8;
    for (int m = gw; m < MTOK; m += NGW) {
        const size_t o0 = (size_t)m * DM + 16 * lane;
        float hv[16], t8[8]; float s1 = 0.f;
#pragma unroll
        for (int j = 0; j < 2; ++j) {
            unpack8(*(const uint4*)(hc + o0 + 8 * j), hv + 8 * j);
            unpack8(*(const uint4*)(mo + o0 + 8 * j), t8);
#pragma unroll
            for (int e = 0; e < 8; ++e) { hv[8 * j + e] *= sigmoidf_(t8[e]); s1 += hv[8 * j + e]; }
        }
#pragma unroll
        for (int o = 1; o < 16; o <<= 1) s1 += __shfl_xor(s1, o);
        const float mu = s1 * (1.f / DH); float s2 = 0.f;
#pragma unroll
        for (int e = 0; e < 16; ++e) { hv[e] -= mu; s2 += hv[e] * hv[e]; }
#pragma unroll
        for (int o = 1; o < 16; o <<= 1) s2 += __shfl_xor(s2, o);
        const float rstd = rsqrtf(s2 * (1.f / DH) + EPS);
#pragma unroll
        for (int j = 0; j < 2; ++j) {
            float xv[8], gv[8], ov[8], t8b[8];
            { const int n0 = 16 * lane + 8 * j, tpos = m % SEQ;
#pragma unroll
              for (int e = 0; e < 8; ++e) xv[e] = cb[n0 + e];
#pragma unroll
              for (int tap = 0; tap < 4; ++tap) if (tpos - 3 + tap >= 0) {
                  unpack8(*(const uint4*)(mi + (size_t)(m - 3 + tap) * DM + n0), t8b);
#pragma unroll
                  for (int e = 0; e < 8; ++e) xv[e] += t8b[e] * cw[tap * DM + n0 + e];
              }
#pragma unroll
              for (int e = 0; e < 8; ++e) xv[e] = siluf_(xv[e]); }
            unpack8(*(const uint4*)(mg + o0 + 8 * j), gv);
#pragma unroll
            for (int e = 0; e < 8; ++e) { const int n = 16 * lane + 8 * j + e; ov[e] = (hv[8 * j + e] * rstd * ngain[n] + skip[n] * xv[e]) * siluf_(gv[e]); }
            *(uint4*)(ho + o0 + 8 * j) = pack8(ov);
        }
    }
}
DEV void final_rows(float* x, const float* gain) {
    const int tid = opaque_tid(), lane = tid & 63, gw = blockIdx.x * 8 + (tid >> 6), NGW = gridDim.x * 8;
    for (int m = gw; m < MTOK; m += NGW) {
        float4* xr = (float4*)(x + (size_t)m * DM) + lane;
        float4 v[4]; float ss = 0.f;
#pragma unroll
        for (int j = 0; j < 4; ++j) { v[j] = xr[64 * j]; ss += v[j].x * v[j].x + v[j].y * v[j].y + v[j].z * v[j].z + v[j].w * v[j].w; }
        const float rstd = rsqrtf(wave_sum(ss) * (1.f / DM) + EPS);
#pragma unroll
        for (int j = 0; j < 4; ++j) {
            const float4 g = *(const float4*)(gain + 4 * lane + 256 * j);
            v[j].x *= rstd * g.x; v[j].y *= rstd * g.y; v[j].z *= rstd * g.z; v[j].w *= rstd * g.w;
            xr[64 * j] = v[j];
        }
    }
}
DEV void mod_phase(LAS char* shm, const float* c, const float* w_mod, const float* b_mod, float* mod) {
    const int tid = opaque_tid();
    LAS float* sc = (LAS float*)shm;
    LAS float* pr = (LAS float*)(shm + 32768);
    if ((int)blockIdx.x >= 192) return;
    __syncthreads();
    for (int i = tid; i < BATCH * DM; i += 512) sc[i] = siluf_(c[i]);
    __syncthreads();
    for (int it = blockIdx.x; it < 192; it += gridDim.x) {
        const int l = it / 96, n0 = (it % 96) * 32, cq = tid & 7, kg = tid >> 3;
        const float* W = w_mod + (size_t)l * DM * 3 * DM + n0 + 4 * cq;
        float acc[BATCH][4];
#pragma unroll
        for (int b = 0; b < BATCH; ++b) { acc[b][0] = acc[b][1] = acc[b][2] = acc[b][3] = 0.f; }
        float4 w[16];
#pragma unroll
        for (int k = 0; k < 16; ++k) w[k] = *(const float4*)(W + (size_t)(kg * 16 + k) * 3 * DM);
#pragma unroll
        for (int k = 0; k < 16; ++k) {
#pragma unroll
            for (int b = 0; b < BATCH; ++b) { const float s_ = sc[b * DM + kg * 16 + k]; acc[b][0] += s_ * w[k].x; acc[b][1] += s_ * w[k].y; acc[b][2] += s_ * w[k].z; acc[b][3] += s_ * w[k].w; }
        }
#pragma unroll
        for (int b = 0; b < BATCH; ++b) *(LAS f32x4*)(pr + (kg * 8 + b) * 32 + 4 * cq) = (f32x4){acc[b][0], acc[b][1], acc[b][2], acc[b][3]};
        __syncthreads();
        if (tid < 256) {
            const int b = tid >> 5, n = tid & 31; float s_ = 0.f;
#pragma unroll 8
            for (int g2 = 0; g2 < 64; ++g2) s_ += pr[(g2 * 8 + b) * 32 + n];
            mod[((size_t)l * BATCH + b) * 3 * DM + n0 + n] = s_ + b_mod[l * 3 * DM + n0 + n];
        }
        __syncthreads();
    }
}

DEV void wfold_prep(bf16_t* WfT, const float* wq, const float* wk, const float* wv, const float* wg  ) {
    const int tid = opaque_tid(), lane = tid & 63;
    for (int t = blockIdx.x * 8 + (tid >> 6); t < 2048; t += gridDim.x * 8) {
        const int which = t >> 10, ch = t & 1023, hd = ch >> 8, d = ch & 255;
        float acc[8];
#pragma unroll
        for (int j = 0; j < 8; ++j) acc[j] = 0.f;
        if (which == 0) {
            const float4 q4 = *(const float4*)(wq + ((size_t)hd * DH + d) * DH + 4 * lane);
            const float4 k4 = *(const float4*)(wk + ((size_t)hd * DH + d) * DH + 4 * lane);
            const float qv[4] = {q4.x, q4.y, q4.z, q4.w}, kv[4] = {k4.x * 0.0625f, k4.y * 0.0625f, k4.z * 0.0625f, k4.w * 0.0625f};
#pragma unroll
            for (int e = 0; e < 4; ++e) {
                const float* g1 = wg + (size_t)(hd * DH + 4 * lane + e) * 8; const float* g2 = wg + (size_t)(DM + hd * DH + 4 * lane + e) * 8;
                const float4 a0 = *(const float4*)g1, a1 = *(const float4*)(g1 + 4), b0 = *(const float4*)g2, b1 = *(const float4*)(g2 + 4);
                acc[0] += qv[e] * a0.x + kv[e] * b0.x; acc[1] += qv[e] * a0.y + kv[e] * b0.y; acc[2] += qv[e] * a0.z + kv[e] * b0.z; acc[3] += qv[e] * a0.w + kv[e] * b0.w;
                acc[4] += qv[e] * a1.x + kv[e] * b1.x; acc[5] += qv[e] * a1.y + kv[e] * b1.y; acc[6] += qv[e] * a1.z + kv[e] * b1.z; acc[7] += qv[e] * a1.w + kv[e] * b1.w;
            }
        } else {
            const float4 v4 = *(const float4*)(wv + ((size_t)hd * DH + d) * DH + 4 * lane);
            const float vv[4] = {v4.x, v4.y, v4.z, v4.w};
#pragma unroll
            for (int e = 0; e < 4; ++e) {
                const float* g1 = wg + (size_t)(2 * DM + hd * DH + 4 * lane + e) * 8;
                const float4 a0 = *(const float4*)g1, a1 = *(const float4*)(g1 + 4);
                acc[0] += vv[e] * a0.x; acc[1] += vv[e] * a0.y; acc[2] += vv[e] * a0.z; acc[3] += vv[e] * a0.w;
                acc[4] += vv[e] * a1.x; acc[5] += vv[e] * a1.y; acc[6] += vv[e] * a1.z; acc[7] += vv[e] * a1.w;
            }
        }
#pragma unroll
        for (int j = 0; j < 8; ++j) acc[j] = wave_sum(acc[j]);
        if (lane < 16) {
            float v = 0.f;
#pragma unroll
            for (int j = 0; j < 8; ++j) v = (lane == j) ? acc[j] : v;
            WfT[((size_t)which * 16 + lane) * 1024 + ch] = f2bf(v);
        }
    }
}
DEV void xc_gates_phase(LAS char* shm, const bf16_t* mi, bf16_t* xc, const bf16_t* WfT, const float* cw, const float* cb, float* gpart  ) {
    const int tid = opaque_tid(), wid = __builtin_amdgcn_readfirstlane(tid >> 6), lane = tid & 63, fr = lane & 15, fq = lane >> 4;
    constexpr int WRS = 2064, WIMG = 8 * WRS, CWL = 2 * WIMG, STG = CWL + 5 * 4096, SRS_ = 528, STG_W = 19 * SRS_;
    __syncthreads();
    for (int i = tid; i < 2 * 8 * 128; i += 512) {
        const int rowi = i >> 7, pc = i & 127;
        const uint4 v = *(const uint4*)(WfT + (size_t)((rowi >> 3) * 16 + (rowi & 7)) * 1024 + pc * 8);
        *(LAS u32x4*)(shm + rowi * WRS + pc * 16) = (u32x4){v.x, v.y, v.z, v.w};
    }
    for (int i = tid; i < 5 * 256; i += 512) {
        const float4 v = (i < 1024) ? *(const float4*)(cw + i * 4) : *(const float4*)(cb + (i - 1024) * 4);
        *(LAS f32x4*)(shm + CWL + i * 16) = (f32x4){v.x, v.y, v.z, v.w};
    }
    __syncthreads();
    LAS char* stg = shm + STG + wid * STG_W;
    for (int task = blockIdx.x * 8 + wid; task < (MTOK / 16) * 2; task += gridDim.x * 8) {
        const int chalf = task & 1, m0 = (task >> 1) * 16, tpos0 = m0 % SEQ;
        f32x4 acc = (f32x4){0.f, 0.f, 0.f, 0.f};
        uint4 pre[10];
#pragma unroll
        for (int it = 0; it < 10; ++it) {
            const int i = lane + 64 * it, row = i >> 5, pc = i & 31;
            pre[it] = make_uint4(0, 0, 0, 0);
            if (i < 19 * 32 && tpos0 - 3 + row >= 0) pre[it] = *(const uint4*)(mi + (size_t)(m0 - 3 + row) * DM + chalf * 512 + pc * 8);
        }
#pragma nounroll
        for (int sl = 0; sl < 2; ++sl) {
            const int c0 = chalf * 512 + sl * 256;
#pragma unroll
            for (int it = 0; it < 10; ++it) {
                const int i = lane + 64 * it, row = i >> 5, pc = i & 31;
                if (i < 19 * 32) *(LAS u32x4*)(stg + row * SRS_ + pc * 16) = (u32x4){pre[it].x, pre[it].y, pre[it].z, pre[it].w};
            }
            if (sl == 0) {
#pragma unroll
                for (int it = 0; it < 10; ++it) {
                    const int i = lane + 64 * it, row = i >> 5, pc = i & 31;
                    pre[it] = make_uint4(0, 0, 0, 0);
                    if (i < 19 * 32 && tpos0 - 3 + row >= 0) pre[it] = *(const uint4*)(mi + (size_t)(m0 - 3 + row) * DM + c0 + 256 + pc * 8);
                }
            }
#pragma nounroll
            for (int ks = 0; ks < 8; ++ks) {
                const int cl = 32 * ks + 8 * fq, c = c0 + cl;
                float xv[8], t8[8];
                { const f32x4 b0 = *(const LAS f32x4*)(shm + CWL + 16384 + c * 4), b1 = *(const LAS f32x4*)(shm + CWL + 16384 + c * 4 + 16);
                  xv[0] = b0[0]; xv[1] = b0[1]; xv[2] = b0[2]; xv[3] = b0[3]; xv[4] = b1[0]; xv[5] = b1[1]; xv[6] = b1[2]; xv[7] = b1[3]; }
                u32x4 raw3;
#pragma unroll
                for (int tap = 0; tap < 4; ++tap) {
                    const u32x4 rw = *(const LAS u32x4*)(stg + (fr + tap) * SRS_ + cl * 2);
                    if (tap == 3) raw3 = rw;
                    unpack8(make_uint4(rw[0], rw[1], rw[2], rw[3]), t8);
                    const f32x4 w0 = *(const LAS f32x4*)(shm + CWL + tap * 4096 + c * 4), w1 = *(const LAS f32x4*)(shm + CWL + tap * 4096 + c * 4 + 16);
                    xv[0] += t8[0] * w0[0]; xv[1] += t8[1] * w0[1]; xv[2] += t8[2] * w0[2]; xv[3] += t8[3] * w0[3];
                    xv[4] += t8[4] * w1[0]; xv[5] += t8[5] * w1[1]; xv[6] += t8[6] * w1[2]; xv[7] += t8[7] * w1[3];
                }
#pragma unroll
                for (int e = 0; e < 8; ++e) xv[e] = siluf_(xv[e]);
                const uint4 xp = pack8(xv);
                *(uint4*)(xc + (size_t)(m0 + fr) * DM + c) = xp;
                const u32x4 xpu = (u32x4){xp.x, xp.y, xp.z, xp.w};
                const bf16x8 bx = *(const LAS bf16x8*)(shm + (fr & 7) * WRS + c * 2);
                const bf16x8 bv = *(const LAS bf16x8*)(shm + WIMG + (fr & 7) * WRS + c * 2);
                acc = __builtin_amdgcn_mfma_f32_16x16x32_bf16(*(const bf16x8*)&xpu, bx, acc, 0, 0, 0);
                acc = __builtin_amdgcn_mfma_f32_16x16x32_bf16(*(const bf16x8*)&raw3, bv, acc, 0, 0, 0);
            }
        }
        if (fr < 8) {
#pragma unroll
            for (int r = 0; r < 4; ++r) gpart[((size_t)chalf * MTOK + m0 + 4 * fq + r) * 8 + fr] = acc[r];
        }
    }
}

#define XB_TMO      128
#define XB_XCNT(j)  (256  + 64 * (j))
#define XB_XSUB(j)  (1280 + 64 * (j))
#define XB_XGEN(j)  (2304 + 64 * (j))
#define XB_TOP      3328
#define XB_TOPGEN   3392
#define XCD_BAR_WORDS 3456
#define XB_SPIN_CAP (1u << 18)
DEV unsigned xb_ld(unsigned* p) { return __hip_atomic_load(p, __ATOMIC_RELAXED, __HIP_MEMORY_SCOPE_AGENT); }
DEV unsigned xb_add(unsigned* p, unsigned v) { return __hip_atomic_fetch_add(p, v, __ATOMIC_RELAXED, __HIP_MEMORY_SCOPE_AGENT); }
DEV unsigned xb_xcc_id() { return (unsigned)__builtin_amdgcn_s_getreg((3 << 11) | 20) & 0xFu; }
#define XB_SPIN(cond, bar) do { unsigned _sp = 0; while (cond) { __builtin_amdgcn_s_sleep(1); \
    if ((++_sp & 255u) == 0u) { if (xb_ld(&(bar)[XB_TMO])) break; if (_sp > XB_SPIN_CAP) { atomicAdd(&(bar)[XB_TMO], 1u); break; } } } } while (0)
struct XcdBarrier { unsigned* bar; unsigned x; volatile LAS unsigned* st; };
DEV XcdBarrier xcd_barrier_post(unsigned* bar, volatile LAS unsigned* st) {
    XcdBarrier b; b.bar = bar; b.x = xb_xcc_id(); b.st = st;
    if (threadIdx.x == 0) (void)xb_add(&bar[XB_XCNT(b.x)], 1u);
    return b;
}
DEV void xcd_barrier_complete(unsigned* bar, unsigned x, unsigned& nloc, unsigned& nx) {
    const unsigned G = gridDim.x * gridDim.y * gridDim.z;
    unsigned sum, cnt, mine, sp = 0u;
    for (;;) {
        sum = 0u; cnt = 0u; mine = 0u;
#pragma nounroll
        for (unsigned j = 0; j < 16; ++j) { const unsigned c = xb_ld(&bar[XB_XCNT(j)]); sum += c; cnt += (c > 0u) ? 1u : 0u; }
        mine = xb_ld(&bar[XB_XCNT(x)]);
        if (sum == G) break;
        __builtin_amdgcn_s_sleep(1);
        if ((++sp & 255u) == 0u) { if (xb_ld(&bar[XB_TMO])) break; if (sp > XB_SPIN_CAP) { atomicAdd(&bar[XB_TMO], 1u); break; } }
    }
    nloc = mine > 0u ? mine : 1u; nx = cnt > 0u ? cnt : 1u;
}
DEV void xcd_barrier1(const XcdBarrier& b) {
    asm volatile("s_waitcnt vmcnt(0)" ::: "memory");
    __syncthreads();
    if (threadIdx.x == 0) {
        unsigned* bar = b.bar;
        __builtin_amdgcn_s_waitcnt(0);
        unsigned nloc = b.st[0], nx = b.st[1];
        if (nloc == 0u) { xcd_barrier_complete(bar, b.x, nloc, nx); b.st[0] = nloc; b.st[1] = nx; }
        const unsigned old = xb_add(&bar[XB_XSUB(b.x)], 1u);
        const unsigned gen = old / nloc;
        if (old + 1u == (gen + 1u) * nloc) {
            __builtin_amdgcn_fence(__ATOMIC_RELEASE, "agent");
            asm volatile("s_waitcnt vmcnt(0)" ::: "memory");
            const unsigned og = xb_add(&bar[XB_TOP], 1u);
            const unsigned tg = og / nx;
            if (og + 1u == (tg + 1u) * nx) xb_add(&bar[XB_TOPGEN], 1u);
            else XB_SPIN(xb_ld(&bar[XB_TOPGEN]) == tg, bar);
            __builtin_amdgcn_fence(__ATOMIC_ACQUIRE, "agent");
            xb_add(&bar[XB_XGEN(b.x)], 1u);
            asm volatile("s_waitcnt vmcnt(0)" ::: "memory");
        } else {
            XB_SPIN(xb_ld(&bar[XB_XGEN(b.x)]) == gen, bar);
            __builtin_amdgcn_fence(__ATOMIC_ACQUIRE, "agent");
            asm volatile("s_waitcnt vmcnt(0)" ::: "memory");
        }
    }
    __syncthreads();
}

DEV void xcd_barrier(const XcdBarrier& b) { xcd_barrier1(b); if (REPMASK & 2048) xcd_barrier1(b); }
constexpr int LDS_BYTES = 148 * 1024;
DEV const void* ldptr(LAS char* shm, int i) {
    volatile LAS unsigned* pt = (volatile LAS unsigned*)(shm + LDS_BYTES - 512);
    const unsigned lo = __builtin_amdgcn_readfirstlane(pt[2 * i]), hi = __builtin_amdgcn_readfirstlane(pt[2 * i + 1]);
    return (const void*)(const __attribute__((address_space(1))) void*)(((unsigned long long)hi << 32) | lo);
}
#define PF(i) ((const float*)ldptr(shm, (i)))
struct Params {
    const float *x, *c, *norm_gain, *w_mod, *b_mod, *w_in, *lam_re, *lam_im, *log_dt, *sb_re, *sb_im, *sc_re, *sc_im, *ssm_d, *w_glu, *b_glu, *ssm_og,
        *conv_w, *conv_b, *wq, *wk, *wv, *w_gates, *b_ig, *b_fg, *m_ng, *m_skip, *w_out, *final_gain;
    float* out; char* ws;
};
constexpr int HALF_FLOATS = 56 * 1024 / 4;
constexpr size_t SLOT = (size_t)MTOK * DM * 2;
constexpr size_t W_IN_OFF = 0, W_GLU_OFF = 10485760, W_QKV_OFF = 12582912, W_OUT_OFF = 14155776, MOD_OFF = 20u << 20, IPRE_OFF = 21u << 20, LOGF_OFF = 22u << 20, BAR_OFF = 23u << 20, WF_OFF = 19u << 20, ROWSS_OFF = 24u << 20, RSTD_OFF = 25u << 20, XSS_OFF = 26u << 20;
#define REP(bit) _Pragma("nounroll") for (int rep_ = 0; rep_ < (((REPMASK) & (bit)) ? 2 : 1); ++rep_)
#define FOR_VB(nvb) for (int vb = blockIdx.x * 2 + HALF; vb < (nvb); vb += gridDim.x * 2)

#define WSB ((char*)ldptr(shm, 30))
#define SL(i) ((bf16_t*)(WSB + SLOT * (i)))
#define S7(off) (WSB + SLOT * 7 + (off))
#define WinT ((bf16_t*)S7(W_IN_OFF))
#define WgluT ((bf16_t*)S7(W_GLU_OFF))
#define WqkvT ((bf16_t*)S7(W_QKV_OFF))
#define WoutT ((bf16_t*)S7(W_OUT_OFF))
#define mod ((float*)S7(MOD_OFF))
#define gpart ((float*)S7(IPRE_OFF))
#define WfT ((bf16_t*)S7(WF_OFF))
#define rowss ((float*)S7(ROWSS_OFF))
#define rstdv ((float*)S7(RSTD_OFF))
#define xssv ((float*)S7(XSS_OFF))
#define MX SL(1)
#define OUTP ((float*)ldptr(shm, 29))
#define H SL(0)
#define U SL(1)
#define Y SL(2)
#define Z SL(3)
#define XC SL(4)
#define MI SL(5)
#define Q SL(6)
#define Kb SL(1)
#define V SL(2)
#define HC SL(5)
template <int l, int PART>
DEV void prep_layer(LAS char* shm) {
    const int wave = opaque_tid() >> 6, lane = opaque_tid() & 63;
    __syncthreads();
    {
        LAS float* scr = (LAS float*)(shm + wave * 16640);
        const float* Win = PF(5) + (size_t)l * DM * INC;
        constexpr int I_IN = 16 * 80, I_GLU = 16 * 16, I_QKV = 12 * 16, I_OUT = 32 * 16;
        constexpr int LO = (PART & 1) ? 0 : (I_IN + I_GLU + I_QKV), HI = (PART & 2) ? (I_IN + I_GLU + I_QKV + I_OUT) : (I_IN + I_GLU + I_QKV);
        for (int it = LO + blockIdx.x * 8 + wave; it < HI; it += gridDim.x * 8) {
            int r = it;
            if (r < I_IN) { transpose_item(Win, INC, INC, WinT, DM, scr, r, lane); continue; } r -= I_IN;
            if (r < I_GLU) { transpose_item(PF(14) + (size_t)l * DM * DM, DM, DM, WgluT, DM, scr, r, lane); continue; } r -= I_GLU;
            if (r < I_QKV) { const int mat = r / 16, which = mat >> 2, hd = mat & 3;
                const float* W = sel3(which, PF(19), PF(20), PF(21)) + ((size_t)l * NH + hd) * DH * DH;
                transpose_item(W, DH, DH, WqkvT + (size_t)mat * DH * DH, DH, scr, r % 16, lane); continue; } r -= I_QKV;
            transpose_item(PF(27) + (size_t)l * 2 * DM * DM, DM, DM, WoutT, 2 * DM, scr, r, lane);
        }
    }
    if (PART & 1) {
        wfold_prep(WfT, PF(19) + (size_t)l * NH * DH * DH, PF(20) + (size_t)l * NH * DH * DH, PF(21) + (size_t)l * NH * DH * DH, PF(22) + (size_t)l * 3 * DM * 8);
        __syncthreads();
        s5_tables(shm, (char*)SL(3), PF(6) + l * NG * NP, PF(7) + l * NG * NP, PF(8) + l * NG, PF(9) + (size_t)l * NG * NP * GC, PF(10) + (size_t)l * NG * NP * GC,
                  PF(11) + (size_t)l * NG * GC * NP, PF(12) + (size_t)l * NG * GC * NP);
    }
    __syncthreads();
}
template <int l>
DEV void layer_body(LAS char* shm, const XcdBarrier& gbar) {
        const float* xin = (l == 0) ? PF(0) : OUTP;
        const float* modl = mod + (size_t)l * BATCH * 3 * DM;
        if (l == 0) { REP(1) norm_rows(xin, PF(2) + l * DM, modl, H); xcd_barrier(gbar); }
        REP(2) { g8::SchedG1 S_{H, WinT, (int)blockIdx.x, (int)gridDim.x}; g8::EpiG1 E_{U, MI}; g8::gemm_phase(shm, S_, E_); }
        if (l == 1) prep_layer<1, 2>(shm);
        xcd_barrier(gbar);
        REP(256) s5_phase(shm, U, Y, (const char*)SL(3), PF(13) + l * DM);
        REP(8) xc_gates_phase(shm, MI, XC, WfT, PF(17) + l * 4 * DM, PF(18) + l * DM, gpart);
        xcd_barrier(gbar);
        REP(4) { g8::SchedGlu S_{Y, WgluT, (int)blockIdx.x, (int)gridDim.x}; g8::EpiGlu E_{Y, Z, PF(15) + l * DM, rowss}; g8::gemm_phase(shm, S_, E_); }
        xcd_barrier(gbar);
        REP(16) { g8::SchedQkv S_{XC, MI, WqkvT, (int)blockIdx.x, (int)gridDim.x}; g8::EpiQkv E_{Q, Kb, V}; g8::gemm_phase(shm, S_, E_); }
        xcd_barrier(gbar);
        rstd_rows(rowss, rstdv);
        REP(32) mlstm_phase<0>(shm, Q, Kb, V, gpart, PF(23) + l * 4, PF(24) + l * 4, HC);
#ifdef MLPROBE
        if (l == 0) mlstm_phase<MLPROBE>(shm, Q, Kb, V, gpart, PF(23) + l * 4, PF(24) + l * 4, (bf16_t*)OUTP);
#endif
        xcd_barrier(gbar);
        { g8::SchedG2s S_{H, WinT, (int)blockIdx.x}; g8::EpiG2s E_{Z, rstdv, PF(16) + l * DM}; g8::gemm_phase(shm, S_, E_); }
        { g8::SchedG2m S_{H, WinT, (int)blockIdx.x}; g8::EpiG2m E_{HC, XC, PF(25) + l * DM, PF(26) + l * DM}; g8::gemm_phase(shm, S_, E_); }
        xcd_barrier(gbar);
        if (l == 0) { g8::SchedOut S_{Z, HC, WoutT, (int)blockIdx.x, (int)gridDim.x};
            g8::EpiOutN<false> E_{xin, OUTP, modl + 2 * DM, PF(2) + DM, mod + (size_t)BATCH * 3 * DM, H, xssv, (unsigned*)S7(BAR_OFF) + 4096, (unsigned*)S7(BAR_OFF) + XB_TMO}; g8::gemm_phase(shm, S_, E_);
            prep_layer<1, 1>(shm); }
        else { g8::SchedOut S_{Z, HC, WoutT, (int)blockIdx.x, (int)gridDim.x};
            g8::EpiOutN<true> E_{xin, OUTP, modl + 2 * DM, PF(28), mod, H, xssv + (size_t)MTOK * 4, (unsigned*)S7(BAR_OFF) + 4096 + 4096, (unsigned*)S7(BAR_OFF) + XB_TMO}; g8::gemm_phase(shm, S_, E_); }
        xcd_barrier(gbar);
    }
__global__ void __launch_bounds__(512, 2) mega(Params Pk) {
    extern __shared__ __attribute__((aligned(16))) unsigned char lds_raw[];
    {
        volatile LAS unsigned long long* pt = (volatile LAS unsigned long long*)((LAS char*)lds_raw + LDS_BYTES - 512);
        if (threadIdx.x == 0) {
            pt[0] = (unsigned long long)Pk.x;
            pt[1] = (unsigned long long)Pk.c;
            pt[2] = (unsigned long long)Pk.norm_gain;
            pt[3] = (unsigned long long)Pk.w_mod;
            pt[4] = (unsigned long long)Pk.b_mod;
            pt[5] = (unsigned long long)Pk.w_in;
            pt[6] = (unsigned long long)Pk.lam_re;
            pt[7] = (unsigned long long)Pk.lam_im;
            pt[8] = (unsigned long long)Pk.log_dt;
            pt[9] = (unsigned long long)Pk.sb_re;
            pt[10] = (unsigned long long)Pk.sb_im;
            pt[11] = (unsigned long long)Pk.sc_re;
            pt[12] = (unsigned long long)Pk.sc_im;
            pt[13] = (unsigned long long)Pk.ssm_d;
            pt[14] = (unsigned long long)Pk.w_glu;
            pt[15] = (unsigned long long)Pk.b_glu;
            pt[16] = (unsigned long long)Pk.ssm_og;
            pt[17] = (unsigned long long)Pk.conv_w;
            pt[18] = (unsigned long long)Pk.conv_b;
            pt[19] = (unsigned long long)Pk.wq;
            pt[20] = (unsigned long long)Pk.wk;
            pt[21] = (unsigned long long)Pk.wv;
            pt[22] = (unsigned long long)Pk.w_gates;
            pt[23] = (unsigned long long)Pk.b_ig;
            pt[24] = (unsigned long long)Pk.b_fg;
            pt[25] = (unsigned long long)Pk.m_ng;
            pt[26] = (unsigned long long)Pk.m_skip;
            pt[27] = (unsigned long long)Pk.w_out;
            pt[28] = (unsigned long long)Pk.final_gain;
            pt[29] = (unsigned long long)Pk.out; pt[30] = (unsigned long long)Pk.ws;
        }
    }
    __syncthreads();
    LAS char* shm = (LAS char*)lds_raw;
    float* ldsf = (float*)lds_raw + HALF * HALF_FLOATS;
    volatile LAS unsigned* bst = (volatile LAS unsigned*)(shm + LDS_BYTES - 16);
    if (threadIdx.x < 4) bst[threadIdx.x] = 0u;
    __syncthreads();
    const XcdBarrier gbar = xcd_barrier_post((unsigned*)((char*)ldptr(shm, 30) + SLOT * 7 + BAR_OFF), bst);
    REP(4096) mod_phase(shm, PF(1), PF(3), PF(4), mod);
    prep_layer<0, 3>(shm);
    xcd_barrier(gbar);
    layer_body<0>(shm, gbar);
    layer_body<1>(shm, gbar);
}

#undef WSB
#undef SL
#undef S7
#undef WinT
#undef WgluT
#undef WqkvT
#undef WoutT
#undef mod
#undef gpart
#undef WfT
#undef rowss
#undef rstdv
#undef xssv
#undef MX
#undef OUTP
#undef H
#undef U
#undef Y
#undef Z
#undef XC
#undef MI
#undef Q
#undef Kb
#undef V
#undef HC
extern "C" void kernel_launch(void* const* d_in, const int* in_sizes, int n_in, void* d_out, int out_size, void* d_ws, size_t ws_size, hipStream_t stream) {
    static int grid_blocks = 0;
    if (!grid_blocks) {
        int dev = 0, cus = 0, per_cu = 0;
        (void)hipGetDevice(&dev);
        (void)hipDeviceGetAttribute(&cus, hipDeviceAttributeMultiprocessorCount, dev);
        (void)hipFuncSetAttribute((const void*)mega, hipFuncAttributeMaxDynamicSharedMemorySize, LDS_BYTES);
        (void)hipOccupancyMaxActiveBlocksPerMultiprocessor(&per_cu, (const void*)mega, 512, LDS_BYTES);
        grid_blocks = cus;
        fprintf(stderr, "mega: cus=%d occupancy per_cu=%d grid=%d\n", cus, per_cu, grid_blocks);
    }
    (void)hipMemsetAsync((char*)d_ws + SLOT * 7 + BAR_OFF, 0, 65536, stream);
    Params P{};
    const float** pp = (const float**)&P;
    for (int i = 0; i < 29; ++i) pp[i] = (const float*)d_in[i];
    P.out = (float*)d_out; P.ws = (char*)d_ws;
    void* args[] = {&P};
    hipError_t e = hipLaunchCooperativeKernel((const void*)mega, dim3(grid_blocks), dim3(512), args, LDS_BYTES, stream);
    if (e != hipSuccess) fprintf(stderr, "cooperative launch failed: %s (grid %d)\n", hipGetErrorString(e), grid_blocks);
}
```

```cpp
#include <hip/hip_runtime.h>
#include <cstdio>
#include <cstdint>

#ifndef REPMASK
#define REPMASK 0
#endif
typedef unsigned short bf16_t;
#define DEV __device__ __forceinline__

constexpr int BATCH = 8, SEQ = 2048, DM = 1024, MTOK = BATCH * SEQ;
constexpr int NG = 64, NP = 64, GC = 16, NH = 4, DH = 256, CHUNK = 64, INC = 5120;
constexpr float EPS = 1e-6f;

DEV int opaque_tid() { int t = threadIdx.x; asm volatile("" : "+v"(t)); return t; }
DEV float bf2f(bf16_t v) { return __uint_as_float(((unsigned)v) << 16); }
typedef __bf16 bf16n2 __attribute__((ext_vector_type(2)));
typedef float f32n2 __attribute__((ext_vector_type(2)));
DEV bf16_t f2bf(float f) { __bf16 b = (__bf16)f; return __builtin_bit_cast(unsigned short, b); }
DEV unsigned pk2(float lo, float hi) { f32n2 v = {lo, hi}; bf16n2 b = __builtin_convertvector(v, bf16n2); return __builtin_bit_cast(unsigned, b); }
DEV float sigmoidf_(float x) { return __builtin_amdgcn_rcpf(1.f + __expf(-x)); }
DEV float siluf_(float x) { return x * __builtin_amdgcn_rcpf(1.f + __expf(-x)); }
DEV float geluf_(float x) { const float t2 = 1.5957691216057308f * (x + 0.044715f * x * x * x); return x * __builtin_amdgcn_rcpf(1.f + __expf(-t2)); }
DEV float logsigmoidf_(float x) { return fminf(x, 0.f) - log1pf(__expf(-fabsf(x))); }

DEV float wave_sum(float v) {
#pragma unroll
    for (int o = 1; o < 64; o <<= 1) v += __shfl_xor(v, o);
    return v;
}
#define LAS __attribute__((address_space(3)))
typedef short bf16x8 __attribute__((ext_vector_type(8)));
typedef float f32x4 __attribute__((ext_vector_type(4)));
typedef short s16x4 __attribute__((ext_vector_type(4)));
typedef unsigned u32x4 __attribute__((ext_vector_type(4)));
typedef unsigned u32x2 __attribute__((ext_vector_type(2)));
typedef float f32x2 __attribute__((ext_vector_type(2)));
#define WAIT_V(n) asm volatile("s_waitcnt vmcnt(" #n ")" ::: "memory")
#define WAIT_L(n) asm volatile("s_waitcnt lgkmcnt(" #n ")" ::: "memory")
#define SCHED() __builtin_amdgcn_sched_barrier(0)

DEV int lds_byte(int r, int c) { int st = (r >> 4) * 2 + (c >> 5), ob = (r & 15) * 64 + (c & 31) * 2; return st * 1024 + (ob ^ (((ob >> 9) & 1) << 5)); }
DEV void stage_rc(int b, int& R, int& C) { int st = b >> 10, sb = b & 1023, swz = sb ^ (((sb >> 9) & 1) << 5); R = (st >> 1) * 16 + swz / 64; C = (st & 1) * 32 + (swz % 64) / 2; }
template <class T> DEV T* sel3(int w, T* p0, T* p1, T* p2) { return p0 + ((w >= 1) ? (p1 - p0) : 0) + ((w >= 2) ? (p2 - p1) : 0); }
DEV void unpack8(const uint4 v, float* f) {
    f[0] = bf2f((bf16_t)(v.x & 0xffff)); f[1] = bf2f((bf16_t)(v.x >> 16)); f[2] = bf2f((bf16_t)(v.y & 0xffff)); f[3] = bf2f((bf16_t)(v.y >> 16));
    f[4] = bf2f((bf16_t)(v.z & 0xffff)); f[5] = bf2f((bf16_t)(v.z >> 16)); f[6] = bf2f((bf16_t)(v.w & 0xffff)); f[7] = bf2f((bf16_t)(v.w >> 16));
}
DEV uint4 pack8(const float* f) { return make_uint4(pk2(f[0], f[1]), pk2(f[2], f[3]), pk2(f[4], f[5]), pk2(f[6], f[7])); }
DEV uint2 pack4(f32x4 v) { uint2 r; r.x = pk2(v[0], v[1]); r.y = pk2(v[2], v[3]); return r; }

DEV void tile_map(int t, int nN, int& pm, int& pn) {
    const int base = t & ~255, loc = t & 255;
    const int w = base + (loc & 7) * 32 + (loc >> 3);
    const int nig = 8 * nN, gid = w / nig;
    pm = gid * 8 + (w % nig) % 8; pn = (w % nig) / 8;
}
namespace g8 {
constexpr int BK = 64, HALFT = 128, HTB = HALFT * BK * 2;
#define G8_A_ROWMAJOR static constexpr int ksplit = 1 << 20; static constexpr size_t kstepA = 128, hstepA = (size_t)128 * lda * 2; static DEV unsigned aoff(int R, int C) { return (unsigned)(R * lda + C) * 2u; }
DEV int perm32(int rho) { const int n = rho >> 4, i = rho & 15; return 8 * (i >> 2) + 4 * n + (i & 3); }
struct Unit { const char* A; const char* A2; const char* B; int pm, pn, tag; };
template <class Epi, class Sched>
DEV void gemm_phase(LAS char* lds, const Sched& S, const Epi& E) {
    const int tid = opaque_tid(), wid = __builtin_amdgcn_readfirstlane(tid >> 6), lane = tid & 63, wr = wid >> 2, wc = wid & 3, fr = lane & 15, fq = lane >> 4;
    constexpr int lda = Sched::lda, ldb = Sched::ldb, nt = Sched::K / BK;
    unsigned voffA[2], voffB[2];
#pragma unroll
    for (int i = 0; i < 2; ++i) { int R, C; stage_rc(tid * 16 + i * 8192, R, C); const int Rb = (R & ~31) + perm32(R & 31);
        voffA[i] = Sched::aoff(R, C); voffB[i] = (unsigned)(Rb * ldb + C) * 2u; asm volatile("" : "+v"(voffA[i]), "+v"(voffB[i])); }
    constexpr size_t kstep = (size_t)(BK * 2), kstepA = Sched::kstepA, hstepA = Sched::hstepA, hstepB = (size_t)HALFT * ldb * 2;
    const unsigned ldsw = (unsigned)wid * 1024u;
    const int aoff = lds_byte(wr * 64 + fr, fq * 8), boff = lds_byte(wc * 32 + fr, fq * 8);
#define G8_SA(b, h) (((b) * 2 + (h)) * HTB)
#define G8_SB(b, h) ((4 + (b) * 2 + (h)) * HTB)
#define G8_STAGE(bufoff, gbase, voff) do { _Pragma("unroll") for (int _i = 0; _i < 2; ++_i) \
        __builtin_amdgcn_global_load_lds((const unsigned*)((const char*)(gbase) + (voff)[_i]), (LAS unsigned*)(lds + (bufoff) + ldsw + _i * 8192), 16, 0, 0); } while (0)
#define G8_LDA(dst, b, h) do { _Pragma("unroll") for (int m = 0; m < 4; ++m) _Pragma("unroll") for (int k = 0; k < 2; ++k) dst[m][k] = *(const LAS bf16x8*)(lds + G8_SA(b, h) + aoff + m * 2048 + k * 1024); } while (0)
#define G8_LDB(dst, b, h) do { _Pragma("unroll") for (int n = 0; n < 2; ++n) _Pragma("unroll") for (int k = 0; k < 2; ++k) dst[n][k] = *(const LAS bf16x8*)(lds + G8_SB(b, h) + boff + n * 2048 + k * 1024); } while (0)
#define G8_MMA(ai, bj, At, Bt) do { __builtin_amdgcn_s_setprio(1); _Pragma("unroll") for (int m = 0; m < 4; ++m) _Pragma("unroll") for (int n = 0; n < 2; ++n) _Pragma("unroll") for (int k = 0; k < 2; ++k) \
        acc[ai][bj][m][n] = __builtin_amdgcn_mfma_f32_16x16x32_bf16(Bt[n][k], At[m][k], acc[ai][bj][m][n], 0, 0, 0); __builtin_amdgcn_s_setprio(0); } while (0)
#define G8_WAIT_V(n) asm volatile("s_waitcnt vmcnt(" #n ")" ::: "memory")
#define G8_WAIT_L(n) asm volatile("s_waitcnt lgkmcnt(" #n ")" ::: "memory")
#define G8_BAR __builtin_amdgcn_s_barrier()
#define G8_SCHED __builtin_amdgcn_sched_barrier(0)
    Unit cur, nxt; int ui = 0;
    if (!S.next(0, cur)) return;
    f32x4 acc[2][2][4][2];
#pragma unroll
    for (int a = 0; a < 2; ++a)
#pragma unroll
        for (int b = 0; b < 2; ++b)
#pragma unroll
            for (int m = 0; m < 4; ++m)
#pragma unroll
                for (int n = 0; n < 2; ++n) acc[a][b][m][n] = (f32x4){0.f, 0.f, 0.f, 0.f};
    bf16x8 At[4][2], B0[2][2], B1[2][2];
    const char* cA = cur.A; const char* cA2 = cur.A2; const char* cB = cur.B;
    constexpr int KSP = Sched::ksplit;
#define G8_AK(t_) (((t_) < KSP) ? cA + (size_t)(t_) * kstepA : cA2 + (size_t)((t_) - KSP) * kstepA)
    G8_STAGE(G8_SB(0, 0), cB, voffB); G8_STAGE(G8_SB(0, 1), cB + hstepB, voffB); G8_STAGE(G8_SA(0, 0), cA, voffA); G8_STAGE(G8_SA(0, 1), cA + hstepA, voffA);
    if (wr == 1) G8_BAR;
    G8_WAIT_V(2); G8_BAR;
    G8_STAGE(G8_SB(1, 0), cB + kstep, voffB); G8_STAGE(G8_SA(1, 0), cA + kstepA, voffA); G8_STAGE(G8_SB(1, 1), cB + hstepB + kstep, voffB);
    G8_WAIT_V(6); G8_BAR;
    for (;;) {
        const bool has_next = S.next(ui + 1, nxt);
        const char* nA = has_next ? nxt.A : cA; const char* nB = has_next ? nxt.B : cB;
#pragma nounroll
        for (int t = 0; t < nt; t += 2) {
            const bool last = (t == nt - 2);
            const char* a1 = G8_AK(t + 1);
            const char* a2 = last ? nA : G8_AK(t + 2); const char* b2 = last ? nB : cB + (size_t)(t + 2) * kstep;
            const char* a3 = last ? nA + kstepA : G8_AK(t + 3); const char* b3 = b2 + kstep;
            G8_LDB(B0, 0, 0); G8_LDB(B1, 0, 1); G8_SCHED; G8_LDA(At, 0, 0); G8_STAGE(G8_SA(1, 1), a1 + hstepA, voffA);
            G8_WAIT_V(8); G8_WAIT_L(0); G8_BAR; G8_MMA(0, 0, At, B0); G8_MMA(0, 1, At, B1); G8_BAR; G8_SCHED;
            G8_LDA(At, 0, 1); G8_STAGE(G8_SB(0, 0), b2, voffB); G8_STAGE(G8_SB(0, 1), b2 + hstepB, voffB); G8_STAGE(G8_SA(0, 0), a2, voffA);
            G8_WAIT_V(8); G8_WAIT_L(0); G8_BAR; G8_MMA(1, 0, At, B0); G8_MMA(1, 1, At, B1); G8_BAR; G8_SCHED;
            G8_LDB(B0, 1, 0); G8_LDB(B1, 1, 1); G8_SCHED; G8_LDA(At, 1, 0); G8_STAGE(G8_SA(0, 1), a2 + hstepA, voffA);
            G8_WAIT_V(8); G8_WAIT_L(0); G8_BAR; G8_MMA(0, 0, At, B0); G8_MMA(0, 1, At, B1); G8_BAR; G8_SCHED;
            G8_LDA(At, 1, 1); G8_STAGE(G8_SB(1, 0), b3, voffB); G8_STAGE(G8_SB(1, 1), b3 + hstepB, voffB); G8_STAGE(G8_SA(1, 0), a3, voffA);
            G8_WAIT_V(8); G8_WAIT_L(0); G8_BAR; G8_MMA(1, 0, At, B0); G8_MMA(1, 1, At, B1); G8_BAR; G8_SCHED;
        }
        if (wr == 0) G8_BAR;
        E(lds, acc, cur, wr, wc, fr, fq, wid, lane);
        if (!has_next) break;
#pragma unroll
        for (int a = 0; a < 2; ++a)
#pragma unroll
            for (int b = 0; b < 2; ++b)
#pragma unroll
                for (int m = 0; m < 4; ++m)
#pragma unroll
                    for (int n = 0; n < 2; ++n) acc[a][b][m][n] = (f32x4){0.f, 0.f, 0.f, 0.f};
        cur = nxt; cA = nA; cA2 = nxt.A2; cB = nB; ++ui;
        if (wr == 1) G8_BAR;
    }
    G8_WAIT_V(0);
    G8_BAR;
#undef G8_AK
#undef G8_SA
#undef G8_SB
#undef G8_STAGE
#undef G8_LDA
#undef G8_LDB
#undef G8_MMA
#undef G8_WAIT_V
#undef G8_WAIT_L
#undef G8_BAR
#undef G8_SCHED
}
DEV u32x4 pk8(const f32x4 a, const f32x4 b) { return (u32x4){pk2(a[0], a[1]), pk2(a[2], a[3]), pk2(b[0], b[1]), pk2(b[2], b[3])}; }
DEV void un8(const u32x4 v, float* f) { unpack8(make_uint4(v[0], v[1], v[2], v[3]), f); }
#define G8_ROWS_BEGIN _Pragma("unroll") for (int ai = 0; ai < 2; ++ai) _Pragma("unroll") for (int m = 0; m < 4; ++m) { const int rl = 128 * ai + 64 * wr + 16 * m + fr;
#define G8_ROWS_END }

struct SchedG1 { static constexpr int K = 1024, lda = 1024, ldb = 1024; G8_A_ROWMAJOR const bf16_t* H; const bf16_t* Wt; int bid, G;
    DEV bool next(int i, Unit& u) const { const int t = bid + i * G; if (t >= 512) return false; int pm, pn; tile_map(t, 8, pm, pn);
        u.pm = pm; u.pn = pn; u.tag = 0; u.A = (const char*)(H + (size_t)pm * 256 * DM); u.A2 = u.A; u.B = (const char*)(Wt + (size_t)((pn < 4) ? pn * 256 : 2048 + (pn - 4) * 256) * DM); return true; } };
struct EpiG1 { bf16_t* U; bf16_t* MI;
    DEV void operator()(LAS char*, const f32x4 (&acc)[2][2][4][2], const Unit& u, int wr, int wc, int fr, int fq, int, int) const {
        const int c0 = (u.pn & 3) * 256 + 32 * wc + 8 * fq;
        if (u.pn < 4) {
            G8_ROWS_BEGIN const int row = u.pm * 256 + rl;
#pragma unroll
                for (int bj = 0; bj < 2; ++bj) { const int cc = c0 + 128 * bj; *(u32x4*)(U + (size_t)(cc >> 4) * MTOK * 16 + (size_t)row * 16 + (cc & 15)) = pk8(acc[ai][bj][m][0], acc[ai][bj][m][1]); } G8_ROWS_END
        } else {
            G8_ROWS_BEGIN bf16_t* rp = MI + (size_t)(u.pm * 256 + rl) * DM + c0;
#pragma unroll
                for (int bj = 0; bj < 2; ++bj) *(u32x4*)(rp + 128 * bj) = pk8(acc[ai][bj][m][0], acc[ai][bj][m][1]); G8_ROWS_END
        } } };
struct SchedGlu { static constexpr int K = 1024, lda = 1024, ldb = 1024; static constexpr int ksplit = 1 << 20; static constexpr size_t kstepA = (size_t)4 * MTOK * 32, hstepA = (size_t)128 * 32; static DEV unsigned aoff(int R, int C) { return (unsigned)((C >> 4) * (MTOK * 32) + R * 32 + (C & 15) * 2); } const bf16_t* Y; const bf16_t* Wt; int bid, G;
    DEV bool next(int i, Unit& u) const { const int t = bid + i * G; if (t >= 256) return false; int pm, pn; tile_map(t, 4, pm, pn);
        u.pm = pm; u.pn = pn; u.tag = 0; u.A = (const char*)(Y + (size_t)pm * 256 * 16); u.A2 = u.A; u.B = (const char*)(Wt + (size_t)pn * 256 * DM); return true; } };
struct EpiGlu { const bf16_t* Y; bf16_t* Z; const float* bias; float* rowss;
    DEV void operator()(LAS char*, const f32x4 (&acc)[2][2][4][2], const Unit& u, int wr, int wc, int fr, int fq, int, int) const {
        const int c0 = u.pn * 256 + 32 * wc + 8 * fq;
        G8_ROWS_BEGIN const size_t ro = (size_t)(u.pm * 256 + rl) * DM + c0; float ss = 0.f;
#pragma unroll
            for (int bj = 0; bj < 2; ++bj) {
                float y8[8]; { const int cc = c0 + 128 * bj; un8(*(const u32x4*)(Y + (size_t)(cc >> 4) * MTOK * 16 + (size_t)(u.pm * 256 + rl) * 16 + (cc & 15)), y8); }
                const float4 b0 = *(const float4*)(bias + c0 + 128 * bj), b1 = *(const float4*)(bias + c0 + 128 * bj + 4);
                f32x4 o0, o1;
                o0[0] = y8[0] * sigmoidf_(acc[ai][bj][m][0][0] + b0.x); o0[1] = y8[1] * sigmoidf_(acc[ai][bj][m][0][1] + b0.y); o0[2] = y8[2] * sigmoidf_(acc[ai][bj][m][0][2] + b0.z); o0[3] = y8[3] * sigmoidf_(acc[ai][bj][m][0][3] + b0.w);
                o1[0] = y8[4] * sigmoidf_(acc[ai][bj][m][1][0] + b1.x); o1[1] = y8[5] * sigmoidf_(acc[ai][bj][m][1][1] + b1.y); o1[2] = y8[6] * sigmoidf_(acc[ai][bj][m][1][2] + b1.z); o1[3] = y8[7] * sigmoidf_(acc[ai][bj][m][1][3] + b1.w);
                const u32x4 pk = pk8(o0, o1); *(u32x4*)(Z + ro + 128 * bj) = pk;
                float r8[8]; un8(pk, r8);
#pragma unroll
                for (int e = 0; e < 8; ++e) ss += r8[e] * r8[e];
            }
            ss += __shfl_xor(ss, 16); ss += __shfl_xor(ss, 32);
            if (fq == 0) rowss[(size_t)(u.pn * 4 + wc) * MTOK + u.pm * 256 + rl] = ss; G8_ROWS_END } };
struct SchedQkv { static constexpr int K = 256, lda = 1024, ldb = 256; G8_A_ROWMAJOR const bf16_t* XC; const bf16_t* MI; const bf16_t* Wt; int bid, G;
    DEV bool next(int i, Unit& u) const { const int t = bid + i * G; if (t >= 768) return false; int pm, pn; tile_map(t, 12, pm, pn);
        u.pm = pm; u.pn = pn; u.tag = 0; u.A = (const char*)(((pn >> 2) == 2 ? MI : XC) + (size_t)pm * 256 * DM + (pn & 3) * 256); u.A2 = u.A; u.B = (const char*)(Wt + (size_t)pn * 256 * 256); return true; } };
struct EpiQkv { bf16_t* Q; bf16_t* Kk; bf16_t* V;
    DEV void operator()(LAS char*, const f32x4 (&acc)[2][2][4][2], const Unit& u, int wr, int wc, int fr, int fq, int, int) const {
        const int which = u.pn >> 2; bf16_t* C = sel3(which, Q, Kk, V); const float sc = (which == 1) ? 0.0625f : 1.f;
        const int c0 = (u.pn & 3) * 256 + 32 * wc + 8 * fq;
        G8_ROWS_BEGIN bf16_t* rp = C + (size_t)(u.pm * 256 + rl) * DM + c0;
#pragma unroll
            for (int bj = 0; bj < 2; ++bj) *(u32x4*)(rp + 128 * bj) = pk8(acc[ai][bj][m][0] * sc, acc[ai][bj][m][1] * sc); G8_ROWS_END } };
struct SchedOut { static constexpr int K = 2048, lda = 1024, ldb = 2048, ksplit = 16; static constexpr size_t kstepA = 128, hstepA = (size_t)128 * lda * 2; static DEV unsigned aoff(int R, int C) { return (unsigned)(R * lda + C) * 2u; }
    const bf16_t* MS; const bf16_t* MM; const bf16_t* Wt; int bid, G;
    DEV bool next(int i, Unit& u) const { const int t = bid + i * G; if (t >= 256) return false; int pm, pn; tile_map(t, 4, pm, pn);
        u.pm = pm; u.pn = pn; u.tag = 0; u.A = (const char*)(MS + (size_t)pm * 256 * DM); u.A2 = (const char*)(MM + (size_t)pm * 256 * DM); u.B = (const char*)(Wt + (size_t)pn * 256 * 2048); return true; } };
template <bool FINAL>
struct EpiOutN { const float* xin; float* xout; const float* gate; const float* ngain; const float* modn; bf16_t* Hn; float* xss; unsigned* cnt; unsigned* tmo;
    DEV void operator()(LAS char* lds, f32x4 (&acc)[2][2][4][2], const Unit& u, int wr, int wc, int fr, int fq, int wid, int lane) const {
        asm volatile("" : "+v"(fr), "+v"(fq));
        LAS float* red = (LAS float*)(lds + 131072);
        LAS float* rst = (LAS float*)(lds + 131072 + 4096);
        const int c0 = u.pn * 256 + 32 * wc + 8 * fq, bidx = (u.pm * 256) / SEQ; const float* gp = gate + (size_t)bidx * 3 * DM + c0;
        G8_ROWS_BEGIN const size_t ro = (size_t)(u.pm * 256 + rl) * DM + c0; float ss = 0.f;
#pragma unroll
            for (int bj = 0; bj < 2; ++bj)
#pragma unroll
                for (int n = 0; n < 2; ++n) {
                    const float4 xi = *(const float4*)(xin + ro + 128 * bj + 4 * n), g4 = *(const float4*)(gp + 128 * bj + 4 * n);
                    f32x4 o; o[0] = xi.x + g4.x * acc[ai][bj][m][n][0]; o[1] = xi.y + g4.y * acc[ai][bj][m][n][1]; o[2] = xi.z + g4.z * acc[ai][bj][m][n][2]; o[3] = xi.w + g4.w * acc[ai][bj][m][n][3];
                    acc[ai][bj][m][n] = o; ss += (o[0] * o[0] + o[1] * o[1]) + (o[2] * o[2] + o[3] * o[3]);
                    if (!FINAL) *(float4*)(xout + ro + 128 * bj + 4 * n) = make_float4(o[0], o[1], o[2], o[3]); }
            ss += __shfl_xor(ss, 16); ss += __shfl_xor(ss, 32);
            if (fq == 0) red[wid * 128 + 64 * ai + 16 * m + fr] = ss; G8_ROWS_END
        asm volatile("s_waitcnt lgkmcnt(0)" ::: "memory"); __builtin_amdgcn_s_barrier();
        const int tid = wid * 64 + lane;
        if (tid < 256) {
            const int r_ = tid, w0 = (r_ >> 6) & 1, ix = (r_ & 63) + 64 * (r_ >> 7);
            const float t_ = red[(w0 * 4 + 0) * 128 + ix] + red[(w0 * 4 + 1) * 128 + ix] + red[(w0 * 4 + 2) * 128 + ix] + red[(w0 * 4 + 3) * 128 + ix];
            __hip_atomic_store(xss + ((size_t)(u.pm * 256 + r_) * 4 + u.pn), t_, __ATOMIC_RELAXED, __HIP_MEMORY_SCOPE_AGENT);
        }
        asm volatile("s_waitcnt vmcnt(0)" ::: "memory"); __builtin_amdgcn_s_barrier();
        if (tid == 0) {
            __hip_atomic_fetch_add(cnt + 64 * u.pm, 1u, __ATOMIC_RELAXED, __HIP_MEMORY_SCOPE_AGENT);
            unsigned sp_ = 0;
            while (__hip_atomic_load(cnt + 64 * u.pm, __ATOMIC_RELAXED, __HIP_MEMORY_SCOPE_AGENT) < 4u) { __builtin_amdgcn_s_sleep(1); if (++sp_ > (1u << 22)) { atomicAdd(tmo, 1u); break; } }
        }
        __builtin_amdgcn_s_barrier();
        if (tid < 256) {
            const float* xp = xss + (size_t)(u.pm * 256 + tid) * 4;
            const float t_ = __hip_atomic_load(xp, __ATOMIC_RELAXED, __HIP_MEMORY_SCOPE_AGENT) + __hip_atomic_load(xp + 1, __ATOMIC_RELAXED, __HIP_MEMORY_SCOPE_AGENT)
                           + __hip_atomic_load(xp + 2, __ATOMIC_RELAXED, __HIP_MEMORY_SCOPE_AGENT) + __hip_atomic_load(xp + 3, __ATOMIC_RELAXED, __HIP_MEMORY_SCOPE_AGENT);
            rst[tid] = rsqrtf(t_ * (1.f / DM) + EPS);
        }
        asm volatile("s_waitcnt vmcnt(0) lgkmcnt(0)" ::: "memory"); __builtin_amdgcn_s_barrier();
        const float* shp = modn + (size_t)bidx * 3 * DM + c0;
        G8_ROWS_BEGIN const size_t ro = (size_t)(u.pm * 256 + rl) * DM + c0; const float rs = rst[rl];
#pragma unroll
            for (int bj = 0; bj < 2; ++bj) {
                const float4 g0 = *(const float4*)(ngain + c0 + 128 * bj), g1 = *(const float4*)(ngain + c0 + 128 * bj + 4);
                if (FINAL) {
                    *(float4*)(xout + ro + 128 * bj) = make_float4(acc[ai][bj][m][0][0] * rs * g0.x, acc[ai][bj][m][0][1] * rs * g0.y, acc[ai][bj][m][0][2] * rs * g0.z, acc[ai][bj][m][0][3] * rs * g0.w);
                    *(float4*)(xout + ro + 128 * bj + 4) = make_float4(acc[ai][bj][m][1][0] * rs * g1.x, acc[ai][bj][m][1][1] * rs * g1.y, acc[ai][bj][m][1][2] * rs * g1.z, acc[ai][bj][m][1][3] * rs * g1.w);
                } else {
                    const float4 h0 = *(const float4*)(shp + 128 * bj), h1 = *(const float4*)(shp + 128 * bj + 4), s0 = *(const float4*)(shp + DM + 128 * bj), s1 = *(const float4*)(shp + DM + 128 * bj + 4);
                    f32x4 o0, o1;
                    o0[0] = acc[ai][bj][m][0][0] * rs * g0.x * (1.f + s0.x) + h0.x; o0[1] = acc[ai][bj][m][0][1] * rs * g0.y * (1.f + s0.y) + h0.y; o0[2] = acc[ai][bj][m][0][2] * rs * g0.z * (1.f + s0.z) + h0.z; o0[3] = acc[ai][bj][m][0][3] * rs * g0.w * (1.f + s0.w) + h0.w;
                    o1[0] = acc[ai][bj][m][1][0] * rs * g1.x * (1.f + s1.x) + h1.x; o1[1] = acc[ai][bj][m][1][1] * rs * g1.y * (1.f + s1.y) + h1.y; o1[2] = acc[ai][bj][m][1][2] * rs * g1.z * (1.f + s1.z) + h1.z; o1[3] = acc[ai][bj][m][1][3] * rs * g1.w * (1.f + s1.w) + h1.w;
                    *(u32x4*)(Hn + ro + 128 * bj) = pk8(o0, o1);
                } } G8_ROWS_END
    } };
struct SchedG2s { static constexpr int K = 1024, lda = 1024, ldb = 1024; G8_A_ROWMAJOR const bf16_t* H; const bf16_t* Wt; int bid;
    DEV bool next(int i, Unit& u) const { if (i >= 1) return false; int pm, pn; tile_map(bid, 4, pm, pn);
        u.pm = pm; u.pn = pn; u.tag = 0; u.A = (const char*)(H + (size_t)pm * 256 * DM); u.A2 = u.A; u.B = (const char*)(Wt + (size_t)(1024 + pn * 256) * DM); return true; } };
struct SchedG2m { static constexpr int K = 1024, lda = 1024, ldb = 1024; G8_A_ROWMAJOR const bf16_t* H; const bf16_t* Wt; int bid;
    DEV bool next(int i, Unit& u) const { if (i >= 2) return false; int pm, pn; tile_map(bid, 4, pm, pn);
        u.pm = pm; u.pn = pn; u.tag = i + 1; u.A = (const char*)(H + (size_t)pm * 256 * DM); u.A2 = u.A; u.B = (const char*)(Wt + (size_t)((i == 0 ? 3072 : 4096) + pn * 256) * DM); return true; } };
struct EpiG2s { bf16_t* Z; const float* rstd; const float* og;
    DEV void operator()(LAS char* lds, f32x4 (&acc)[2][2][4][2], const Unit& u, int wr, int wc, int fr, int fq, int wid, int lane) const {
        asm volatile("" : "+v"(fr), "+v"(fq));
        const int c0 = u.pn * 256 + 32 * wc + 8 * fq;
        {
            G8_ROWS_BEGIN const int row = u.pm * 256 + rl; const float rs = rstd[row];
#pragma unroll
                for (int bj = 0; bj < 2; ++bj) {
                    float z8[8]; un8(*(const u32x4*)(Z + (size_t)row * DM + c0 + 128 * bj), z8);
                    const float4 g0 = *(const float4*)(og + c0 + 128 * bj), g1 = *(const float4*)(og + c0 + 128 * bj + 4);
                    f32x4 o0, o1;
                    o0[0] = z8[0] * rs * g0.x * siluf_(acc[ai][bj][m][0][0]); o0[1] = z8[1] * rs * g0.y * siluf_(acc[ai][bj][m][0][1]); o0[2] = z8[2] * rs * g0.z * siluf_(acc[ai][bj][m][0][2]); o0[3] = z8[3] * rs * g0.w * siluf_(acc[ai][bj][m][0][3]);
                    o1[0] = z8[4] * rs * g1.x * siluf_(acc[ai][bj][m][1][0]); o1[1] = z8[5] * rs * g1.y * siluf_(acc[ai][bj][m][1][1]); o1[2] = z8[6] * rs * g1.z * siluf_(acc[ai][bj][m][1][2]); o1[3] = z8[7] * rs * g1.w * siluf_(acc[ai][bj][m][1][3]);
                    *(u32x4*)(Z + (size_t)row * DM + c0 + 128 * bj) = pk8(o0, o1); } G8_ROWS_END
        }
    } };
struct EpiG2m { bf16_t* HC; const bf16_t* XC; const float* ngain; const float* skip;
    DEV void operator()(LAS char* lds, f32x4 (&acc)[2][2][4][2], const Unit& u, int wr, int wc, int fr, int fq, int wid, int lane) const {
        asm volatile("" : "+v"(fr), "+v"(fq));
        const int c0 = u.pn * 256 + 32 * wc + 8 * fq;
        if (u.tag == 1) {
            LAS float* red = (LAS float*)(lds + 131072);
            G8_ROWS_BEGIN const int row = u.pm * 256 + rl; float s1 = 0.f, s2 = 0.f;
#pragma unroll
                for (int bj = 0; bj < 2; ++bj) {
                    float h8[8]; un8(*(const u32x4*)(HC + (size_t)row * DM + c0 + 128 * bj), h8);
#pragma unroll
                    for (int n = 0; n < 2; ++n)
#pragma unroll
                        for (int j = 0; j < 4; ++j) { const float v = h8[4 * n + j] * sigmoidf_(acc[ai][bj][m][n][j]); acc[ai][bj][m][n][j] = v; s1 += v; s2 += v * v; }
                }
                s1 += __shfl_xor(s1, 16); s1 += __shfl_xor(s1, 32); s2 += __shfl_xor(s2, 16); s2 += __shfl_xor(s2, 32);
                if (fq == 0) *(LAS f32x2*)(red + ((wid * 128) + 64 * ai + 16 * m + fr) * 2) = (f32x2){s1, s2}; G8_ROWS_END
            asm volatile("s_waitcnt lgkmcnt(0)" ::: "memory"); __builtin_amdgcn_s_barrier();
            G8_ROWS_BEGIN const int row = u.pm * 256 + rl; float t1 = 0.f, t2 = 0.f;
#pragma unroll
                for (int w2 = 0; w2 < 4; ++w2) { const f32x2 p_ = *(const LAS f32x2*)(red + (((wr * 4 + w2) * 128) + 64 * ai + 16 * m + fr) * 2); t1 += p_.x; t2 += p_.y; }
                const float mu = t1 * (1.f / DH), rs = rsqrtf(fmaxf(t2 * (1.f / DH) - mu * mu, 0.f) + EPS);
#pragma unroll
                for (int bj = 0; bj < 2; ++bj) {
                    float x8[8]; un8(*(const u32x4*)(XC + (size_t)row * DM + c0 + 128 * bj), x8);
                    const float4 g0 = *(const float4*)(ngain + c0 + 128 * bj), g1 = *(const float4*)(ngain + c0 + 128 * bj + 4), k0 = *(const float4*)(skip + c0 + 128 * bj), k1 = *(const float4*)(skip + c0 + 128 * bj + 4);
                    f32x4 o0, o1;
                    o0[0] = (acc[ai][bj][m][0][0] - mu) * rs * g0.x + k0.x * x8[0]; o0[1] = (acc[ai][bj][m][0][1] - mu) * rs * g0.y + k0.y * x8[1]; o0[2] = (acc[ai][bj][m][0][2] - mu) * rs * g0.z + k0.z * x8[2]; o0[3] = (acc[ai][bj][m][0][3] - mu) * rs * g0.w + k0.w * x8[3];
                    o1[0] = (acc[ai][bj][m][1][0] - mu) * rs * g1.x + k1.x * x8[4]; o1[1] = (acc[ai][bj][m][1][1] - mu) * rs * g1.y + k1.y * x8[5]; o1[2] = (acc[ai][bj][m][1][2] - mu) * rs * g1.z + k1.z * x8[6]; o1[3] = (acc[ai][bj][m][1][3] - mu) * rs * g1.w + k1.w * x8[7];
                    *(u32x4*)(HC + (size_t)row * DM + c0 + 128 * bj) = pk8(o0, o1); } G8_ROWS_END
        } else {
            G8_ROWS_BEGIN const int row = u.pm * 256 + rl;
#pragma unroll
                for (int bj = 0; bj < 2; ++bj) {
                    bf16_t* pp = HC + (size_t)row * DM + c0 + 128 * bj;
                    float h8[8]; un8(*(const u32x4*)pp, h8);
                    f32x4 o0, o1;
                    o0[0] = h8[0] * siluf_(acc[ai][bj][m][0][0]); o0[1] = h8[1] * siluf_(acc[ai][bj][m][0][1]); o0[2] = h8[2] * siluf_(acc[ai][bj][m][0][2]); o0[3] = h8[3] * siluf_(acc[ai][bj][m][0][3]);
                    o1[0] = h8[4] * siluf_(acc[ai][bj][m][1][0]); o1[1] = h8[5] * siluf_(acc[ai][bj][m][1][1]); o1[2] = h8[6] * siluf_(acc[ai][bj][m][1][2]); o1[3] = h8[7] * siluf_(acc[ai][bj][m][1][3]);
                    *(u32x4*)pp = pk8(o0, o1); } G8_ROWS_END
        }
    } };
}
DEV void rstd_rows(const float* rowss, float* rstd) {
    const int tid = opaque_tid();
    for (int r = blockIdx.x * 512 + tid; r < MTOK; r += gridDim.x * 512) { float s_ = 0.f;
#pragma unroll
        for (int p_ = 0; p_ < 16; ++p_) s_ += rowss[(size_t)p_ * MTOK + r];
        rstd[r] = rsqrtf(s_ * (1.f / DM) + EPS); }
}

DEV void transpose_item(const float* W, int ldw, int ncols, bf16_t* WT, int ldwt, LAS float* scr, int item, int lane) {
    const int nblk = ncols / 64, kb = item / nblk, nb = item % nblk, k0 = 64 * kb, n0 = 64 * nb;
    float4 v[16];
#pragma unroll
    for (int i = 0; i < 16; ++i) v[i] = *(const float4*)(W + (size_t)(k0 + 4 * i + (lane >> 4)) * ldw + n0 + 4 * (lane & 15));
#pragma unroll
    for (int i = 0; i < 16; ++i) { LAS float* d_ = scr + (4 * i + (lane >> 4)) * 65 + 4 * (lane & 15); d_[0] = v[i].x; d_[1] = v[i].y; d_[2] = v[i].z; d_[3] = v[i].w; }
    asm volatile("s_waitcnt lgkmcnt(0)" ::: "memory");
#pragma unroll
    for (int j = 0; j < 8; ++j) {
        const int n = (lane >> 3) + 8 * j, c = lane & 7;
        const LAS float* s_ = scr + (8 * c) * 65 + n;
        uint4 o;
        o.x = pk2(s_[0 * 65], s_[1 * 65]); o.y = pk2(s_[2 * 65], s_[3 * 65]); o.z = pk2(s_[4 * 65], s_[5 * 65]); o.w = pk2(s_[6 * 65], s_[7 * 65]);
        *(uint4*)(WT + (size_t)(n0 + n) * ldwt + k0 + 8 * c) = o;
    }
    asm volatile("s_waitcnt lgkmcnt(0)" ::: "memory");
}

DEV float wave_scan_add(float v, int lane) {
#pragma unroll
    for (int o = 1; o < 64; o <<= 1) { const float u = __shfl_up(v, o); if (lane >= o) v += u; }
    return v;
}
DEV float wave_scan_max(float v, int lane) {
#pragma unroll
    for (int o = 1; o < 64; o <<= 1) { const float u = __shfl_up(v, o); if (lane >= o) v = fmaxf(v, u); }
    return v;
}

template <int TT>
DEV void mlstm_a_wave(LAS char* shm, int fr, int fq, float m_prev, const LAS float* tpj, const LAS float* taj, f32x4 (&nacc)[3]) {
    constexpr int QS = 0, KS = 33792, VT = 67584, RS = 528, VRS = 96, NT = TT + 1;
    const LAS char* qb = shm + QS + (16 * TT + fr) * RS + fq * 16;
    const LAS char* kb = shm + KS + fr * RS + fq * 16;
    f32x4 sacc[NT];
#pragma unroll
    for (int jj = 0; jj < NT; ++jj) sacc[jj] = (f32x4){0.f, 0.f, 0.f, 0.f};
    bf16x8 qf = *(const LAS bf16x8*)qb, kf[NT];
#pragma unroll
    for (int jj = 0; jj < NT; ++jj) kf[jj] = *(const LAS bf16x8*)(kb + jj * 16 * RS);
#pragma unroll
    for (int ks = 0; ks < 8; ++ks) {
        bf16x8 qn = qf, kn[NT];
#pragma unroll
        for (int jj = 0; jj < NT; ++jj) kn[jj] = kf[jj];
        if (ks < 7) {
            qn = *(const LAS bf16x8*)(qb + (ks + 1) * 64);
#pragma unroll
            for (int jj = 0; jj < NT; ++jj) kn[jj] = *(const LAS bf16x8*)(kb + jj * 16 * RS + (ks + 1) * 64);
        }
#pragma unroll
        for (int jj = 0; jj < NT; ++jj) sacc[jj] = __builtin_amdgcn_mfma_f32_16x16x32_bf16(kf[jj], qf, sacc[jj], 0, 0, 0);
        qf = qn;
#pragma unroll
        for (int jj = 0; jj < NT; ++jj) kf[jj] = kn[jj];
    }
    constexpr int NK = (TT >= 2) ? 2 : 1;
    s16x4 vlo[NK][3], vhi[NK][3];
#pragma unroll
    for (int kk = 0; kk < NK; ++kk)
#pragma unroll
        for (int vt = 0; vt < 3; ++vt) {
            vlo[kk][vt] = __builtin_amdgcn_ds_read_tr16_b64_v4i16((LAS s16x4*)(shm + VT + (32 * kk + 4 * fq + (fr >> 2)) * VRS + (16 * vt + 4 * (fr & 3)) * 2));
            vhi[kk][vt] = __builtin_amdgcn_ds_read_tr16_b64_v4i16((LAS s16x4*)(shm + VT + (32 * kk + 16 + 4 * fq + (fr >> 2)) * VRS + (16 * vt + 4 * (fr & 3)) * 2));
        }
    const int t = 16 * TT + fr;
    const float btm = -fmaxf(m_prev, tpj[t]);
    f32x4 sm[2 * NK];
#pragma unroll
    for (int jj = 0; jj < 2 * NK; ++jj) {
        if (jj < NT) {
            const f32x4 a4 = *(const LAS f32x4*)(taj + 16 * jj + 4 * fq);
#pragma unroll
            for (int r = 0; r < 4; ++r) {
                const int s_ = 16 * jj + 4 * fq + r;
                sm[jj][r] = (jj < TT || s_ <= t) ? sacc[jj < NT ? jj : 0][r] * __expf(btm + a4[r]) : 0.f;
            }
        } else sm[jj] = (f32x4){0.f, 0.f, 0.f, 0.f};
    }
#pragma unroll
    for (int kk = 0; kk < NK; ++kk) {
        const u32x4 u = (u32x4){pk2(sm[2 * kk][0], sm[2 * kk][1]), pk2(sm[2 * kk][2], sm[2 * kk][3]), pk2(sm[2 * kk + 1][0], sm[2 * kk + 1][1]), pk2(sm[2 * kk + 1][2], sm[2 * kk + 1][3])};
        const bf16x8 af = *(const bf16x8*)&u;
#pragma unroll
        for (int vt = 0; vt < 3; ++vt) {
            bf16x8 bv8; bv8[0] = vlo[kk][vt][0]; bv8[1] = vlo[kk][vt][1]; bv8[2] = vlo[kk][vt][2]; bv8[3] = vlo[kk][vt][3];
            bv8[4] = vhi[kk][vt][0]; bv8[5] = vhi[kk][vt][1]; bv8[6] = vhi[kk][vt][2]; bv8[7] = vhi[kk][vt][3];
            nacc[vt] = __builtin_amdgcn_mfma_f32_16x16x32_bf16(af, bv8, nacc[vt], 0, 0, 0);
        }
    }
}
DEV void mlstm_b_wave(LAS char* shm, int tt, int fr, int fq, f32x4 (&nacc)[3]) {
    constexpr int QS = 0, CB = 81408, RS = 528;
    const LAS char* qb = shm + QS + (16 * tt + fr) * RS + fq * 16;
    const LAS char* cbp = shm + CB + fr * RS + fq * 16;
    bf16x8 qf = *(const LAS bf16x8*)qb, cf[3];
#pragma unroll
    for (int vt = 0; vt < 3; ++vt) cf[vt] = *(const LAS bf16x8*)(cbp + vt * 16 * RS);
#pragma unroll
    for (int ks = 0; ks < 8; ++ks) {
        bf16x8 qn = qf, cn[3] = {cf[0], cf[1], cf[2]};
        if (ks < 7) {
            qn = *(const LAS bf16x8*)(qb + (ks + 1) * 64);
#pragma unroll
            for (int vt = 0; vt < 3; ++vt) cn[vt] = *(const LAS bf16x8*)(cbp + vt * 16 * RS + (ks + 1) * 64);
        }
#pragma unroll
        for (int vt = 0; vt < 3; ++vt) nacc[vt] = __builtin_amdgcn_mfma_f32_16x16x32_bf16(qf, cf[vt], nacc[vt], 0, 0, 0);
        qf = qn;
#pragma unroll
        for (int vt = 0; vt < 3; ++vt) cf[vt] = cn[vt];
    }
}
template <int SKIP>
DEV void mlstm_phase(LAS char* shm, const bf16_t* q, const bf16_t* k, const bf16_t* v, const float* gpart, const float* b_ig, const float* b_fg, bf16_t* hc) {
    const int tid = opaque_tid(), wid = __builtin_amdgcn_readfirstlane(tid >> 6), lane = tid & 63, fr = lane & 15, fq = lane >> 4;
    constexpr int QS = 0, KS = 33792, VT = 67584, VWT = 74496, CB = 81408, PART = 106752, TB = 120064, TA = 128256, TP = 136448, TC = 144640, HST = 144896, RS = 528, VRS = 96, PRS = 52;
    LAS float* part = (LAS float*)(shm + PART);
    LAS float* tb = (LAS float*)(shm + TB); LAS float* ta = (LAS float*)(shm + TA); LAS float* tp = (LAS float*)(shm + TP); LAS float* tc = (LAS float*)(shm + TC);
    for (int item = blockIdx.x; item < BATCH * NH * 8; item += gridDim.x) {
        const int vs = (item >> 3) & 7, bh = (item & 7) + 8 * (item >> 6), h = bh & 3, b = bh >> 2;
        __syncthreads();
        for (int i = tid; i < (CB + 25344 - VT) / 4; i += 512) ((LAS unsigned*)(shm + VT))[i] = 0u;
        for (int j = wid; j < SEQ / CHUNK; j += 8) {
            const int m = b * SEQ + j * CHUNK + lane;
            const float* gp = gpart + (size_t)m * 8;
            const float ig = gp[h] + gp[(size_t)MTOK * 8 + h] + b_ig[h];
            const float lf = logsigmoidf_(gp[4 + h] + gp[(size_t)MTOK * 8 + 4 + h] + b_fg[h]);
            const float bc = wave_scan_add(lf, lane);
            const float a_ = ig - bc;
            const float pm = wave_scan_max(a_, lane);
            tb[j * 64 + lane] = bc; ta[j * 64 + lane] = a_; tp[j * 64 + lane] = pm;
            if (lane == 63) { tc[2 * j] = bc; tc[2 * j + 1] = pm; }
        }
        __syncthreads();
        if (tid < 64) *(LAS u32x4*)(shm + VT + tid * VRS + 64) = (u32x4){0x3F80u, 0u, 0u, 0u};
        f32x4 cacc[2][3];
#pragma unroll
        for (int i = 0; i < 2; ++i)
#pragma unroll
            for (int vt = 0; vt < 3; ++vt) cacc[i][vt] = (f32x4){0.f, 0.f, 0.f, 0.f};
        float m_prev = 0.f;
        const size_t cb0 = ((size_t)(b * SEQ)) * DM + h * DH;
        uint4 qv[4], kv[4], vv = make_uint4(0, 0, 0, 0);
#pragma unroll
        for (int i = 0; i < 4; ++i) {
            const int idx = tid + 512 * i, row = idx >> 5, c16 = idx & 31;
            qv[i] = *(const uint4*)(q + cb0 + (size_t)row * DM + c16 * 8);
            kv[i] = *(const uint4*)(k + cb0 + (size_t)row * DM + c16 * 8);
        }
        if (tid < 256) vv = *(const uint4*)(v + cb0 + (size_t)(tid >> 2) * DM + vs * 32 + (tid & 3) * 8);
#pragma nounroll
        for (int j = 0; j < SEQ / CHUNK; ++j) {
            const size_t cb = cb0 + (size_t)j * CHUNK * DM;
            const float btot = tc[2 * j], amax = tc[2 * j + 1];
            const float mxc = fmaxf(m_prev, amax);
#pragma unroll
            for (int i = 0; i < ((SKIP & 8) ? 0 : 4); ++i) {
                const int idx = tid + 512 * i, row = idx >> 5, c16 = idx & 31;
                *(LAS u32x4*)(shm + QS + row * RS + c16 * 16) = (u32x4){qv[i].x, qv[i].y, qv[i].z, qv[i].w};
                *(LAS u32x4*)(shm + KS + row * RS + c16 * 16) = (u32x4){kv[i].x, kv[i].y, kv[i].z, kv[i].w};
            }
            if (tid < 256) {
                const int s_ = tid >> 2, v0 = (tid & 3) * 8;
                const float ws = __expf(ta[j * 64 + s_] - mxc);
                float f8[8]; unpack8(vv, f8);
#pragma unroll
                for (int e = 0; e < 8; ++e) f8[e] *= ws;
                const uint4 wv = pack8(f8);
                *(LAS u32x4*)(shm + VT + s_ * VRS + v0 * 2) = (u32x4){vv.x, vv.y, vv.z, vv.w};
                *(LAS u32x4*)(shm + VWT + s_ * VRS + v0 * 2) = (u32x4){wv.x, wv.y, wv.z, wv.w};
            } else if (tid < 320) {
                const int s_ = tid - 256;
                *(LAS u32x4*)(shm + VWT + s_ * VRS + 64) = (u32x4){(unsigned)f2bf(__expf(ta[j * 64 + s_] - mxc)), 0u, 0u, 0u};
            }
            if (j + 1 < SEQ / CHUNK) {
                const size_t cn = cb + (size_t)CHUNK * DM;
#pragma unroll
                for (int i = 0; i < 4; ++i) {
                    const int idx = tid + 512 * i, row = idx >> 5, c16 = idx & 31;
                    qv[i] = *(const uint4*)(q + cn + (size_t)row * DM + c16 * 8);
                    kv[i] = *(const uint4*)(k + cn + (size_t)row * DM + c16 * 8);
                }
                if (tid < 256) vv = *(const uint4*)(v + cn + (size_t)(tid >> 2) * DM + vs * 32 + (tid & 3) * 8);
            }
            __syncthreads();
            f32x4 nacc[3];
#pragma unroll
            for (int vt = 0; vt < 3; ++vt) nacc[vt] = (f32x4){0.f, 0.f, 0.f, 0.f};
            const int tt = wid & 3;
            if (wid < 4) { if (!(SKIP & 1)) {
                const LAS float* tpj = tp + j * 64; const LAS float* taj = ta + j * 64;
                if (tt == 0) mlstm_a_wave<0>(shm, fr, fq, m_prev, tpj, taj, nacc);
                else if (tt == 1) mlstm_a_wave<1>(shm, fr, fq, m_prev, tpj, taj, nacc);
                else if (tt == 2) mlstm_a_wave<2>(shm, fr, fq, m_prev, tpj, taj, nacc);
                else mlstm_a_wave<3>(shm, fr, fq, m_prev, tpj, taj, nacc);
            } } else if (!(SKIP & 2)) {
                mlstm_b_wave(shm, tt, fr, fq, nacc);
                const f32x4 pm4 = *(const LAS f32x4*)(tp + j * 64 + 16 * tt + 4 * fq);
#pragma unroll
                for (int vt = 0; vt < 3; ++vt)
#pragma unroll
                    for (int r = 0; r < 4; ++r) part[(16 * tt + 4 * fq + r) * PRS + 16 * vt + fr] = __expf(m_prev - fmaxf(m_prev, pm4[r])) * nacc[vt][r];
            }
            if (!(SKIP & 4)) {
                const float decay = __expf(m_prev - mxc);
#pragma unroll
                for (int i = 0; i < 2; ++i)
#pragma unroll
                    for (int vt = 0; vt < 3; ++vt) cacc[i][vt] *= decay;
                const int q_ = fr >> 2, p_ = fr & 3;
                s16x4 wl[2][3], wh[2][3], kl[2][2], kh[2][2];
#pragma unroll
                for (int kk = 0; kk < 2; ++kk) {
#pragma unroll
                    for (int vt = 0; vt < 3; ++vt) {
                        wl[kk][vt] = __builtin_amdgcn_ds_read_tr16_b64_v4i16((LAS s16x4*)(shm + VWT + (32 * kk + 8 * fq + q_) * VRS + (16 * vt + 4 * p_) * 2));
                        wh[kk][vt] = __builtin_amdgcn_ds_read_tr16_b64_v4i16((LAS s16x4*)(shm + VWT + (32 * kk + 8 * fq + 4 + q_) * VRS + (16 * vt + 4 * p_) * 2));
                    }
#pragma unroll
                    for (int i = 0; i < 2; ++i) {
                        const int dt = 2 * wid + i;
                        kl[kk][i] = __builtin_amdgcn_ds_read_tr16_b64_v4i16((LAS s16x4*)(shm + KS + (32 * kk + 8 * fq + q_) * RS + (16 * dt + 4 * p_) * 2));
                        kh[kk][i] = __builtin_amdgcn_ds_read_tr16_b64_v4i16((LAS s16x4*)(shm + KS + (32 * kk + 8 * fq + 4 + q_) * RS + (16 * dt + 4 * p_) * 2));
                    }
                }
#pragma unroll
                for (int kk = 0; kk < 2; ++kk) {
                    bf16x8 bfv[3];
#pragma unroll
                    for (int vt = 0; vt < 3; ++vt) { bfv[vt][0] = wl[kk][vt][0]; bfv[vt][1] = wl[kk][vt][1]; bfv[vt][2] = wl[kk][vt][2]; bfv[vt][3] = wl[kk][vt][3];
                        bfv[vt][4] = wh[kk][vt][0]; bfv[vt][5] = wh[kk][vt][1]; bfv[vt][6] = wh[kk][vt][2]; bfv[vt][7] = wh[kk][vt][3]; }
#pragma unroll
                    for (int i = 0; i < 2; ++i) {
                        bf16x8 af; af[0] = kl[kk][i][0]; af[1] = kl[kk][i][1]; af[2] = kl[kk][i][2]; af[3] = kl[kk][i][3]; af[4] = kh[kk][i][0]; af[5] = kh[kk][i][1]; af[6] = kh[kk][i][2]; af[7] = kh[kk][i][3];
#pragma unroll
                        for (int vt = 0; vt < 3; ++vt) cacc[i][vt] = __builtin_amdgcn_mfma_f32_16x16x32_bf16(af, bfv[vt], cacc[i][vt], 0, 0, 0);
                    }
                }
            }
            __syncthreads();
            if (wid < 4 && !(SKIP & 16)) {
                const f32x4 pm4 = *(const LAS f32x4*)(tp + j * 64 + 16 * tt + 4 * fq);
                const f32x4 bc4 = *(const LAS f32x4*)(tb + j * 64 + 16 * tt + 4 * fq);
#pragma unroll
                for (int vt = 0; vt < 3; ++vt)
#pragma unroll
                    for (int r = 0; r < 4; ++r) nacc[vt][r] += part[(16 * tt + 4 * fq + r) * PRS + 16 * vt + fr];
#pragma unroll
                for (int r = 0; r < 4; ++r) {
                    const float den = __shfl(nacc[2][r], lane & 48);
                    const float inv = __builtin_amdgcn_rcpf(fmaxf(fabsf(den), __expf(-(bc4[r] + fmaxf(m_prev, pm4[r])))));
                    LAS bf16_t* hrow = (LAS bf16_t*)(shm + HST + (16 * tt + 4 * fq + r) * 80);
                    hrow[fr] = f2bf(nacc[0][r] * inv);
                    hrow[16 + fr] = f2bf(nacc[1][r] * inv);
                }
                asm volatile("s_waitcnt lgkmcnt(0)" ::: "memory");
                {
                    const int rw = 16 * tt + (lane >> 2), pc = lane & 3;
                    const u32x4 hv = *(const LAS u32x4*)(shm + HST + rw * 80 + pc * 16);
                    *(uint4*)(hc + cb + (size_t)rw * DM + vs * 32 + pc * 8) = make_uint4(hv[0], hv[1], hv[2], hv[3]);
                }
            }
#pragma unroll
            for (int i = 0; i < 2; ++i)
#pragma unroll
                for (int vt = 0; vt < 3; ++vt) {
                    u32x2 o; o[0] = pk2(cacc[i][vt][0], cacc[i][vt][1]); o[1] = pk2(cacc[i][vt][2], cacc[i][vt][3]);
                    *(LAS u32x2*)(shm + CB + (16 * vt + fr) * RS + (16 * (2 * wid + i) + 4 * fq) * 2) = o;
                }
            m_prev = btot + mxc;
        }
    }
}

constexpr int S5L = 32, S5NCH = SEQ / S5L;
constexpr size_t T_KT_OFF = 0, T_WS_OFF = 2u << 20, T_V_OFF = 10u << 20, T_AL_OFF = 18u << 20;
constexpr int KT_G = 33 * 256, WS_G = 128 * 512, V_G = 512 * 128;

DEV void s5_tables(LAS char* shm, char* tab, const float* lam_re, const float* lam_im, const float* log_dt, const float* b_re, const float* b_im,
                   const float* c_re, const float* c_im) {
    const int tid = opaque_tid();
    LAS f32x2* apw = (LAS f32x2*)shm;
    LAS f32x2* bb = (LAS f32x2*)(shm + 64 * 33 * 8);
    LAS f32x2* cc = (LAS f32x2*)(shm + 64 * 33 * 8 + 8192);
    bf16_t* KT = (bf16_t*)(tab + T_KT_OFF); bf16_t* WS = (bf16_t*)(tab + T_WS_OFF); bf16_t* VV = (bf16_t*)(tab + T_V_OFF); float2* AL = (float2*)(tab + T_AL_OFF);
    for (int it = blockIdx.x; it < 256; it += gridDim.x) {
        const int g = it & 63, qd = it >> 6;
        __syncthreads();
        if (tid < 64) {
            const int pp = tid;
            const double lr = lam_re[g * NP + pp], li = lam_im[g * NP + pp], dt = exp((double)log_dt[g]);
            const double er = exp(lr * dt);
            const double ar = er * cos(li * dt), ai = er * sin(li * dt);
            const double dr = ar - 1.0, di = ai, den = lr * lr + li * li;
            const double cr = (dr * lr + di * li) / den, ci = (di * lr - dr * li) / den;
            double pr = 1.0, pi_ = 0.0;
            for (int e = 0; e <= 32; ++e) {
                apw[pp * 33 + e] = (f32x2){(float)pr, (float)pi_};
                const double nr = pr * ar - pi_ * ai, ni = pr * ai + pi_ * ar; pr = nr; pi_ = ni;
            }
            if (qd == 0) { const f32x2 t_ = apw[pp * 33 + 32]; AL[g * NP + pp] = make_float2(t_.x, t_.y); }
            for (int c = 0; c < 16; ++c) {
                const double br = b_re[(g * NP + pp) * GC + c], bi = b_im[(g * NP + pp) * GC + c];
                bb[pp * 16 + c] = (f32x2){(float)(cr * br - ci * bi), (float)(cr * bi + ci * br)};
                cc[c * 64 + pp] = (f32x2){c_re[(g * GC + c) * NP + pp], c_im[(g * GC + c) * NP + pp]};
            }
        }
        __syncthreads();
        for (int o = tid; o < 8 * 256; o += 512) {
            const int d = 8 * qd + (o >> 8), c1 = (o >> 4) & 15, c0 = o & 15;
            float acc = 0.f;
            for (int pp = 0; pp < 64; ++pp) {
                const f32x2 a = apw[pp * 33 + d], b = bb[pp * 16 + c0], c = cc[c1 * 64 + pp];
                const float mr = a.x * b.x - a.y * b.y, mi = a.x * b.y + a.y * b.x;
                acc += c.x * mr - c.y * mi;
            }
            KT[(size_t)g * KT_G + (d + 1) * 256 + c1 * 16 + c0] = f2bf(acc);
        }
        if (qd == 0 && tid < 256) KT[(size_t)g * KT_G + tid] = 0;
        for (int o = tid; o < 2 * 16 * 64; o += 512) {
            const int mt = 2 * qd + (o >> 10), sp = (o >> 6) & 15, ln = o & 63;
            const int row = 16 * mt + (ln & 15), ri = row >> 6, pp = row & 63, s_ = 2 * sp + (ln >> 5), c0 = 8 * ((ln >> 4) & 1);
            const f32x2 a = apw[pp * 33 + 31 - s_];
            unsigned w[4];
#pragma unroll
            for (int jj = 0; jj < 8; jj += 2) {
                const f32x2 b0 = bb[pp * 16 + c0 + jj], b1 = bb[pp * 16 + c0 + jj + 1];
                const float v0 = ri ? (a.x * b0.y + a.y * b0.x) : (a.x * b0.x - a.y * b0.y);
                const float v1 = ri ? (a.x * b1.y + a.y * b1.x) : (a.x * b1.x - a.y * b1.y);
                w[jj >> 1] = pk2(v0, v1);
            }
            *(uint4*)(WS + (size_t)g * WS_G + ((size_t)(mt * 16 + sp) * 64 + ln) * 8) = make_uint4(w[0], w[1], w[2], w[3]);
        }
        for (int o = tid; o < 8 * 4 * 64; o += 512) {
            const int i = 8 * qd + (o >> 8), ks = (o >> 6) & 3, ln = o & 63;
            const int c1 = ln & 15, k0 = 32 * ks + 8 * (ln >> 4);
            unsigned w[4];
#pragma unroll
            for (int jj = 0; jj < 8; jj += 2) {
                float v[2];
#pragma unroll
                for (int e = 0; e < 2; ++e) {
                    const int kk = k0 + jj + e, ri = kk >> 6, pp = kk & 63;
                    const f32x2 a = apw[pp * 33 + i + 1], c = cc[c1 * 64 + pp];
                    v[e] = ri ? -(c.x * a.y + c.y * a.x) : (c.x * a.x - c.y * a.y);
                }
                w[jj >> 1] = pk2(v[0], v[1]);
            }
            *(uint4*)(VV + (size_t)g * V_G + ((size_t)(i * 4 + ks) * 64 + ln) * 8) = make_uint4(w[0], w[1], w[2], w[3]);
        }
    }
}

template <int NQ>
DEV void s5_p1_range(LAS char* shm, int lo, int hi, int wid, int fr, int fq, const bf16_t* wsp, f32x4 (&acc)[4][4], f32x4 (&sac)[4]) {
    constexpr int PLANE = 64 * 528, KTL = 2 * PLANE, Q0 = 4 - NQ;
    if (lo > hi) return;
    const LAS char* ub = shm + (fq & 1) * PLANE + fr * 528 + (fq >> 1) * 16;
    const LAS char* kb = shm + KTL + (1 - (fq >> 1)) * 512 + fr * 32 + (fq & 1) * 16;
    bf16x8 bu[4], kf[NQ], wcur;
#pragma unroll
    for (int nt = 0; nt < 4; ++nt) bu[nt] = *(const LAS bf16x8*)(ub + nt * 16 * 528 + lo * 32);
#pragma unroll
    for (int q = 0; q < NQ; ++q) kf[q] = *(const LAS bf16x8*)(kb + (wid + 8 * (Q0 + q) - 2 * lo) * 512);
    wcur = *(const bf16x8*)(wsp + (size_t)lo * 64 * 8);
#pragma nounroll
    for (int sp = lo; sp <= hi; ++sp) {
        bf16x8 bn[4], kn[NQ], wn = wcur;
        const int sn = (sp < hi) ? sp + 1 : sp;
#pragma unroll
        for (int nt = 0; nt < 4; ++nt) bn[nt] = *(const LAS bf16x8*)(ub + nt * 16 * 528 + sn * 32);
#pragma unroll
        for (int q = 0; q < NQ; ++q) kn[q] = *(const LAS bf16x8*)(kb + (wid + 8 * (Q0 + q) - 2 * sn) * 512);
        wn = *(const bf16x8*)(wsp + (size_t)sn * 64 * 8);
#pragma unroll
        for (int nt = 0; nt < 4; ++nt) sac[nt] = __builtin_amdgcn_mfma_f32_16x16x32_bf16(wcur, bu[nt], sac[nt], 0, 0, 0);
#pragma unroll
        for (int q = 0; q < NQ; ++q)
#pragma unroll
            for (int nt = 0; nt < 4; ++nt) acc[Q0 + q][nt] = __builtin_amdgcn_mfma_f32_16x16x32_bf16(kf[q], bu[nt], acc[Q0 + q][nt], 0, 0, 0);
#pragma unroll
        for (int nt = 0; nt < 4; ++nt) bu[nt] = bn[nt];
#pragma unroll
        for (int q = 0; q < NQ; ++q) kf[q] = kn[q];
        wcur = wn;
    }
}
DEV void s5_phase(LAS char* shm, const bf16_t* Uin, bf16_t* Yout, const char* tab, const float* dskip) {
    const int tid = opaque_tid(), wid = __builtin_amdgcn_readfirstlane(tid >> 6), lane = tid & 63, fr = lane & 15, fq = lane >> 4;
    constexpr int PLANE = 64 * 528, KTL = 2 * PLANE, SL = KTL + 33 * 512, HB = SL + 64 * 528, SRS = 528, HRS = 272, TSEG = HB + 64 * 272;
    const bf16_t* KT = (const bf16_t*)(tab + T_KT_OFF); const bf16_t* WS = (const bf16_t*)(tab + T_WS_OFF); const bf16_t* VV = (const bf16_t*)(tab + T_V_OFF);
    const float2* AL = (const float2*)(tab + T_AL_OFF);
    for (int item = blockIdx.x; item < BATCH * NG; item += gridDim.x) {
        const int xcd_ = item & 7, j_ = (item >> 3) & 31, g = xcd_ * 8 + (j_ & 7), b = (j_ >> 3) + 4 * (item >> 8);
        const bf16_t* Ub = Uin + ((size_t)g * MTOK + (size_t)b * SEQ) * 16;
        bf16_t* Yb = Yout + ((size_t)g * MTOK + (size_t)b * SEQ) * 16;
        __syncthreads();
#pragma unroll
        for (int i = 0; i < 8; ++i) {
            const int idx = tid + 512 * i, tok = idx >> 1, hf = idx & 1;
            const uint4 uv = *(const uint4*)(Ub + (size_t)tok * 16 + hf * 8);
            *(LAS u32x4*)(shm + hf * PLANE + (tok >> 5) * 528 + (tok & 31) * 16) = (u32x4){uv.x, uv.y, uv.z, uv.w};
        }
        for (int idx = tid; idx < 33 * 32; idx += 512) {
            const uint4 kv = *(const uint4*)(KT + (size_t)g * KT_G + idx * 8);
            *(LAS u32x4*)(shm + KTL + idx * 16) = (u32x4){kv.x, kv.y, kv.z, kv.w};
        }
        __syncthreads();
        f32x4 acc[4][4], sac[4];
#pragma unroll
        for (int q = 0; q < 4; ++q)
#pragma unroll
            for (int nt = 0; nt < 4; ++nt) acc[q][nt] = (f32x4){0.f, 0.f, 0.f, 0.f};
#pragma unroll
        for (int nt = 0; nt < 4; ++nt) sac[nt] = (f32x4){0.f, 0.f, 0.f, 0.f};
        const bf16_t* wsp = WS + (size_t)g * WS_G + ((size_t)(wid * 16) * 64 + lane) * 8;
        const int h2 = wid >> 1;
        s5_p1_range<4>(shm, 0, h2, wid, fr, fq, wsp, acc, sac);
        s5_p1_range<3>(shm, h2 + 1, 4 + h2, wid, fr, fq, wsp, acc, sac);
        s5_p1_range<2>(shm, 5 + h2, 8 + h2, wid, fr, fq, wsp, acc, sac);
        s5_p1_range<1>(shm, 9 + h2, 12 + h2, wid, fr, fq, wsp, acc, sac);
        if (13 + h2 <= 15) {
            const LAS char* ub = shm + (fq & 1) * PLANE + fr * 528 + (fq >> 1) * 16;
            for (int sp = 13 + h2; sp <= 15; ++sp) {
                const bf16x8 wcur = *(const bf16x8*)(wsp + (size_t)sp * 64 * 8);
#pragma unroll
                for (int nt = 0; nt < 4; ++nt) sac[nt] = __builtin_amdgcn_mfma_f32_16x16x32_bf16(wcur, *(const LAS bf16x8*)(ub + nt * 16 * 528 + sp * 32), sac[nt], 0, 0, 0);
            }
        }
#pragma unroll
        for (int nt = 0; nt < 4; ++nt) *(LAS f32x4*)(shm + SL + (16 * nt + fr) * SRS + (16 * wid + 4 * fq) * 4) = sac[nt];
        __syncthreads();
        {
            const float2 al = AL[g * NP + lane];
            float hr = 0.f, hi = 0.f, lr[8], li[8];
#pragma unroll
            for (int n = 0; n < 8; ++n) {
                lr[n] = hr; li[n] = hi;
                const float sr = *(const LAS float*)(shm + SL + (8 * wid + n) * SRS + lane * 4), si = *(const LAS float*)(shm + SL + (8 * wid + n) * SRS + (64 + lane) * 4);
                const float nr = al.x * hr - al.y * hi + sr, ni = al.x * hi + al.y * hr + si; hr = nr; hi = ni;
            }
            *(LAS float*)(shm + TSEG + (wid * 128 + lane) * 4) = hr; *(LAS float*)(shm + TSEG + (wid * 128 + 64 + lane) * 4) = hi;
            float pr = al.x, pi = al.y;
#pragma unroll
            for (int e = 0; e < 3; ++e) { const float nr = pr * pr - pi * pi, ni = 2.f * pr * pi; pr = nr; pi = ni; }
            __syncthreads();
            float cr = 0.f, ci = 0.f;
            for (int w2 = 0; w2 < wid; ++w2) {
                const float tr = *(const LAS float*)(shm + TSEG + (w2 * 128 + lane) * 4), ti = *(const LAS float*)(shm + TSEG + (w2 * 128 + 64 + lane) * 4);
                const float nr = pr * cr - pi * ci + tr, ni = pr * ci + pi * cr + ti; cr = nr; ci = ni;
            }
            float qr = 1.f, qi = 0.f;
#pragma unroll
            for (int n = 0; n < 8; ++n) {
                const float fr_ = lr[n] + qr * cr - qi * ci, fi_ = li[n] + qr * ci + qi * cr;
                *(LAS bf16_t*)(shm + HB + (8 * wid + n) * HRS + lane * 2) = f2bf(fr_);
                *(LAS bf16_t*)(shm + HB + (8 * wid + n) * HRS + (64 + lane) * 2) = f2bf(fi_);
                const float nr = qr * al.x - qi * al.y, ni = qr * al.y + qi * al.x; qr = nr; qi = ni;
            }
        }
        __syncthreads();
        const bf16_t* vvp = VV + (size_t)g * V_G + (size_t)lane * 8;
        bf16x8 va[4];
#pragma unroll
        for (int q = 0; q < 4; ++q) va[q] = *(const bf16x8*)(vvp + ((size_t)((wid + 8 * q) * 4 + 0) * 64) * 8);
#pragma unroll
        for (int ks = 0; ks < 4; ++ks) {
            bf16x8 hb[4], vn[4];
#pragma unroll
            for (int nt = 0; nt < 4; ++nt) hb[nt] = *(const LAS bf16x8*)(shm + HB + (16 * nt + fr) * HRS + (32 * ks + 8 * fq) * 2);
#pragma unroll
            for (int q = 0; q < 4; ++q) vn[q] = (ks < 3) ? *(const bf16x8*)(vvp + ((size_t)((wid + 8 * q) * 4 + ks + 1) * 64) * 8) : va[q];
#pragma unroll
            for (int q = 0; q < 4; ++q)
#pragma unroll
                for (int nt = 0; nt < 4; ++nt) acc[q][nt] = __builtin_amdgcn_mfma_f32_16x16x32_bf16(va[q], hb[nt], acc[q][nt], 0, 0, 0);
#pragma unroll
            for (int q = 0; q < 4; ++q) va[q] = vn[q];
        }
        const float4 dsk = *(const float4*)(dskip + g * GC + 4 * fq);
#pragma unroll
        for (int q = 0; q < 4; ++q) {
            const int i = wid + 8 * q;
#pragma unroll
            for (int nt = 0; nt < 4; ++nt) {
                const int n = 16 * nt + fr;
                const u32x2 uu = *(const LAS u32x2*)(shm + (fq >> 1) * PLANE + n * 528 + i * 16 + ((4 * fq) & 7) * 2);
                f32x4 o;
                o[0] = geluf_(acc[q][nt][0] + dsk.x * bf2f((bf16_t)(uu[0] & 0xffff))); o[1] = geluf_(acc[q][nt][1] + dsk.y * bf2f((bf16_t)(uu[0] >> 16)));
                o[2] = geluf_(acc[q][nt][2] + dsk.z * bf2f((bf16_t)(uu[1] & 0xffff))); o[3] = geluf_(acc[q][nt][3] + dsk.w * bf2f((bf16_t)(uu[1] >> 16)));
                *(uint2*)(Yb + (size_t)(n * 32 + i) * 16 + 4 * fq) = pack4(o);
            }
        }
    }
}


DEV void norm_rows(const float* x, const float* gain, const float* modl, bf16_t* h) {
    const int tid = opaque_tid(), lane = tid & 63, gw = blockIdx.x * 8 + (tid >> 6), NGW = gridDim.x * 8;
    for (int m0 = gw * 2; m0 < MTOK; m0 += NGW * 2) {
        float4 v[2][4]; float ss[2] = {0.f, 0.f};
#pragma unroll
        for (int r = 0; r < 2; ++r) { const float4* xr = (const float4*)(x + (size_t)(m0 + r) * DM) + lane;
#pragma unroll
            for (int j = 0; j < 4; ++j) v[r][j] = xr[64 * j]; }
#pragma unroll
        for (int r = 0; r < 2; ++r) {
#pragma unroll
            for (int j = 0; j < 4; ++j) ss[r] += v[r][j].x * v[r][j].x + v[r][j].y * v[r][j].y + v[r][j].z * v[r][j].z + v[r][j].w * v[r][j].w;
            const float rstd = rsqrtf(wave_sum(ss[r]) * (1.f / DM) + EPS);
            const int m = m0 + r;
            const float* shift = modl + (size_t)(m / SEQ) * 3 * DM; const float* scale = shift + DM;
#pragma unroll
            for (int j = 0; j < 4; ++j) {
                const int n = 4 * lane + 256 * j;
                const float4 g = *(const float4*)(gain + n), sc = *(const float4*)(scale + n), sh = *(const float4*)(shift + n);
                f32x4 o; o[0] = v[r][j].x * rstd * g.x * (1.f + sc.x) + sh.x; o[1] = v[r][j].y * rstd * g.y * (1.f + sc.y) + sh.y;
                o[2] = v[r][j].z * rstd * g.z * (1.f + sc.z) + sh.z; o[3] = v[r][j].w * rstd * g.w * (1.f + sc.w) + sh.w;
                *(uint2*)(h + (size_t)m * DM + n) = pack4(o);
            }
        }
    }
}
DEV void mod_phase(LAS char* shm, const float* c, const float* w_mod, const float* b_mod, float* mod) {
    const int tid = opaque_tid();
    LAS float* sc = (LAS float*)shm;
    LAS float* pr = (LAS float*)(shm + 32768);
    if ((int)blockIdx.x >= 192) return;
    __syncthreads();
    for (int i = tid; i < BATCH * DM; i += 512) sc[i] = siluf_(c[i]);
    __syncthreads();
    for (int it = blockIdx.x; it < 192; it += gridDim.x) {
        const int l = it / 96, n0 = (it % 96) * 32, cq = tid & 7, kg = tid >> 3;
        const float* W = w_mod + (size_t)l * DM * 3 * DM + n0 + 4 * cq;
        float acc[BATCH][4];
#pragma unroll
        for (int b = 0; b < BATCH; ++b) { acc[b][0] = acc[b][1] = acc[b][2] = acc[b][3] = 0.f; }
        float4 w[16];
#pragma unroll
        for (int k = 0; k < 16; ++k) w[k] = *(const float4*)(W + (size_t)(kg * 16 + k) * 3 * DM);
#pragma unroll
        for (int k = 0; k < 16; ++k) {
#pragma unroll
            for (int b = 0; b < BATCH; ++b) { const float s_ = sc[b * DM + kg * 16 + k]; acc[b][0] += s_ * w[k].x; acc[b][1] += s_ * w[k].y; acc[b][2] += s_ * w[k].z; acc[b][3] += s_ * w[k].w; }
        }
#pragma unroll
        for (int b = 0; b < BATCH; ++b) *(LAS f32x4*)(pr + (kg * 8 + b) * 32 + 4 * cq) = (f32x4){acc[b][0], acc[b][1], acc[b][2], acc[b][3]};
        __syncthreads();
        if (tid < 256) {
            const int b = tid >> 5, n = tid & 31; float s_ = 0.f;
#pragma unroll 8
            for (int g2 = 0; g2 < 64; ++g2) s_ += pr[(g2 * 8 + b) * 32 + n];
            mod[((size_t)l * BATCH + b) * 3 * DM + n0 + n] = s_ + b_mod[l * 3 * DM + n0 + n];
        }
        __syncthreads();
    }
}

DEV void wfold_prep(bf16_t* WfT, const float* wq, const float* wk, const float* wv, const float* wg  ) {
    const int tid = opaque_tid(), lane = tid & 63;
    for (int t = blockIdx.x * 8 + (tid >> 6); t < 2048; t += gridDim.x * 8) {
        const int which = t >> 10, ch = t & 1023, hd = ch >> 8, d = ch & 255;
        float acc[8];
#pragma unroll
        for (int j = 0; j < 8; ++j) acc[j] = 0.f;
        if (which == 0) {
            const float4 q4 = *(const float4*)(wq + ((size_t)hd * DH + d) * DH + 4 * lane);
            const float4 k4 = *(const float4*)(wk + ((size_t)hd * DH + d) * DH + 4 * lane);
            const float qv[4] = {q4.x, q4.y, q4.z, q4.w}, kv[4] = {k4.x * 0.0625f, k4.y * 0.0625f, k4.z * 0.0625f, k4.w * 0.0625f};
#pragma unroll
            for (int e = 0; e < 4; ++e) {
                const float* g1 = wg + (size_t)(hd * DH + 4 * lane + e) * 8; const float* g2 = wg + (size_t)(DM + hd * DH + 4 * lane + e) * 8;
                const float4 a0 = *(const float4*)g1, a1 = *(const float4*)(g1 + 4), b0 = *(const float4*)g2, b1 = *(const float4*)(g2 + 4);
                acc[0] += qv[e] * a0.x + kv[e] * b0.x; acc[1] += qv[e] * a0.y + kv[e] * b0.y; acc[2] += qv[e] * a0.z + kv[e] * b0.z; acc[3] += qv[e] * a0.w + kv[e] * b0.w;
                acc[4] += qv[e] * a1.x + kv[e] * b1.x; acc[5] += qv[e] * a1.y + kv[e] * b1.y; acc[6] += qv[e] * a1.z + kv[e] * b1.z; acc[7] += qv[e] * a1.w + kv[e] * b1.w;
            }
        } else {
            const float4 v4 = *(const float4*)(wv + ((size_t)hd * DH + d) * DH + 4 * lane);
            const float vv[4] = {v4.x, v4.y, v4.z, v4.w};
#pragma unroll
            for (int e = 0; e < 4; ++e) {
                const float* g1 = wg + (size_t)(2 * DM + hd * DH + 4 * lane + e) * 8;
                const float4 a0 = *(const float4*)g1, a1 = *(const float4*)(g1 + 4);
                acc[0] += vv[e] * a0.x; acc[1] += vv[e] * a0.y; acc[2] += vv[e] * a0.z; acc[3] += vv[e] * a0.w;
                acc[4] += vv[e] * a1.x; acc[5] += vv[e] * a1.y; acc[6] += vv[e] * a1.z; acc[7] += vv[e] * a1.w;
            }
        }
#pragma unroll
        for (int j = 0; j < 8; ++j) acc[j] = wave_sum(acc[j]);
        if (lane < 16) {
            float v = 0.f;
#pragma unroll
            for (int j = 0; j < 8; ++j) v = (lane == j) ? acc[j] : v;
            WfT[((size_t)which * 16 + lane) * 1024 + ch] = f2bf(v);
        }
    }
}
DEV void xc_gates_phase(LAS char* shm, const bf16_t* mi, bf16_t* xc, const bf16_t* WfT, const float* cw, const float* cb, float* gpart  ) {
    const int tid = opaque_tid(), wid = __builtin_amdgcn_readfirstlane(tid >> 6), lane = tid & 63, fr = lane & 15, fq = lane >> 4;
    constexpr int WRS = 2064, WIMG = 8 * WRS, CWL = 2 * WIMG, STG = CWL + 5 * 4096, SRS_ = 528, STG_W = 19 * SRS_;
    __syncthreads();
    for (int i = tid; i < 2 * 8 * 128; i += 512) {
        const int rowi = i >> 7, pc = i & 127;
        const uint4 v = *(const uint4*)(WfT + (size_t)((rowi >> 3) * 16 + (rowi & 7)) * 1024 + pc * 8);
        *(LAS u32x4*)(shm + rowi * WRS + pc * 16) = (u32x4){v.x, v.y, v.z, v.w};
    }
    for (int i = tid; i < 5 * 256; i += 512) {
        const float4 v = (i < 1024) ? *(const float4*)(cw + i * 4) : *(const float4*)(cb + (i - 1024) * 4);
        *(LAS f32x4*)(shm + CWL + i * 16) = (f32x4){v.x, v.y, v.z, v.w};
    }
    __syncthreads();
    LAS char* stg = shm + STG + wid * STG_W;
    for (int task = blockIdx.x * 8 + wid; task < (MTOK / 16) * 2; task += gridDim.x * 8) {
        const int chalf = task & 1, m0 = (task >> 1) * 16, tpos0 = m0 % SEQ;
        f32x4 acc = (f32x4){0.f, 0.f, 0.f, 0.f};
        uint4 pre[10];
#pragma unroll
        for (int it = 0; it < 10; ++it) {
            const int i = lane + 64 * it, row = i >> 5, pc = i & 31;
            pre[it] = make_uint4(0, 0, 0, 0);
            if (i < 19 * 32 && tpos0 - 3 + row >= 0) pre[it] = *(const uint4*)(mi + (size_t)(m0 - 3 + row) * DM + chalf * 512 + pc * 8);
        }
#pragma nounroll
        for (int sl = 0; sl < 2; ++sl) {
            const int c0 = chalf * 512 + sl * 256;
#pragma unroll
            for (int it = 0; it < 10; ++it) {
                const int i = lane + 64 * it, row = i >> 5, pc = i & 31;
                if (i < 19 * 32) *(LAS u32x4*)(stg + row * SRS_ + pc * 16) = (u32x4){pre[it].x, pre[it].y, pre[it].z, pre[it].w};
            }
            if (sl == 0) {
#pragma unroll
                for (int it = 0; it < 10; ++it) {
                    const int i = lane + 64 * it, row = i >> 5, pc = i & 31;
                    pre[it] = make_uint4(0, 0, 0, 0);
                    if (i < 19 * 32 && tpos0 - 3 + row >= 0) pre[it] = *(const uint4*)(mi + (size_t)(m0 - 3 + row) * DM + c0 + 256 + pc * 8);
                }
            }
#pragma nounroll
            for (int ks = 0; ks < 8; ++ks) {
                const int cl = 32 * ks + 8 * fq, c = c0 + cl;
                float xv[8], t8[8];
                { const f32x4 b0 = *(const LAS f32x4*)(shm + CWL + 16384 + c * 4), b1 = *(const LAS f32x4*)(shm + CWL + 16384 + c * 4 + 16);
                  xv[0] = b0[0]; xv[1] = b0[1]; xv[2] = b0[2]; xv[3] = b0[3]; xv[4] = b1[0]; xv[5] = b1[1]; xv[6] = b1[2]; xv[7] = b1[3]; }
                u32x4 raw3;
#pragma unroll
                for (int tap = 0; tap < 4; ++tap) {
                    const u32x4 rw = *(const LAS u32x4*)(stg + (fr + tap) * SRS_ + cl * 2);
                    if (tap == 3) raw3 = rw;
                    unpack8(make_uint4(rw[0], rw[1], rw[2], rw[3]), t8);
                    const f32x4 w0 = *(const LAS f32x4*)(shm + CWL + tap * 4096 + c * 4), w1 = *(const LAS f32x4*)(shm + CWL + tap * 4096 + c * 4 + 16);
                    xv[0] += t8[0] * w0[0]; xv[1] += t8[1] * w0[1]; xv[2] += t8[2] * w0[2]; xv[3] += t8[3] * w0[3];
                    xv[4] += t8[4] * w1[0]; xv[5] += t8[5] * w1[1]; xv[6] += t8[6] * w1[2]; xv[7] += t8[7] * w1[3];
                }
#pragma unroll
                for (int e = 0; e < 8; ++e) xv[e] = siluf_(xv[e]);
                const uint4 xp = pack8(xv);
                *(uint4*)(xc + (size_t)(m0 + fr) * DM + c) = xp;
                const u32x4 xpu = (u32x4){xp.x, xp.y, xp.z, xp.w};
                const bf16x8 bx = *(const LAS bf16x8*)(shm + (fr & 7) * WRS + c * 2);
                const bf16x8 bv = *(const LAS bf16x8*)(shm + WIMG + (fr & 7) * WRS + c * 2);
                acc = __builtin_amdgcn_mfma_f32_16x16x32_bf16(*(const bf16x8*)&xpu, bx, acc, 0, 0, 0);
                acc = __builtin_amdgcn_mfma_f32_16x16x32_bf16(*(const bf16x8*)&raw3, bv, acc, 0, 0, 0);
            }
        }
        if (fr < 8) {
#pragma unroll
            for (int r = 0; r < 4; ++r) gpart[((size_t)chalf * MTOK + m0 + 4 * fq + r) * 8 + fr] = acc[r];
        }
    }
}

#define XB_TMO      128
#define XB_XCNT(j)  (256  + 64 * (j))
#define XB_XSUB(j)  (1280 + 64 * (j))
#define XB_XGEN(j)  (2304 + 64 * (j))
#define XB_TOP      3328
#define XB_TOPGEN   3392
#define XCD_BAR_WORDS 3456
#define XB_SPIN_CAP (1u << 18)
DEV unsigned xb_ld(unsigned* p) { return __hip_atomic_load(p, __ATOMIC_RELAXED, __HIP_MEMORY_SCOPE_AGENT); }
DEV unsigned xb_add(unsigned* p, unsigned v) { return __hip_atomic_fetch_add(p, v, __ATOMIC_RELAXED, __HIP_MEMORY_SCOPE_AGENT); }
DEV unsigned xb_xcc_id() { return (unsigned)__builtin_amdgcn_s_getreg((3 << 11) | 20) & 0xFu; }
#define XB_SPIN(cond, bar) do { unsigned _sp = 0; while (cond) { __builtin_amdgcn_s_sleep(1); \
    if ((++_sp & 255u) == 0u) { if (xb_ld(&(bar)[XB_TMO])) break; if (_sp > XB_SPIN_CAP) { atomicAdd(&(bar)[XB_TMO], 1u); break; } } } } while (0)
struct XcdBarrier { unsigned* bar; unsigned x; volatile LAS unsigned* st; };
DEV XcdBarrier xcd_barrier_post(unsigned* bar, volatile LAS unsigned* st) {
    XcdBarrier b; b.bar = bar; b.x = xb_xcc_id(); b.st = st;
    if (threadIdx.x == 0) (void)xb_add(&bar[XB_XCNT(b.x)], 1u);
    return b;
}
DEV void xcd_barrier_complete(unsigned* bar, unsigned x, unsigned& nloc, unsigned& nx) {
    const unsigned G = gridDim.x * gridDim.y * gridDim.z;
    unsigned sum, cnt, mine, sp = 0u;
    for (;;) {
        sum = 0u; cnt = 0u; mine = 0u;
#pragma nounroll
        for (unsigned j = 0; j < 16; ++j) { const unsigned c = xb_ld(&bar[XB_XCNT(j)]); sum += c; cnt += (c > 0u) ? 1u : 0u; }
        mine = xb_ld(&bar[XB_XCNT(x)]);
        if (sum == G) break;
        __builtin_amdgcn_s_sleep(1);
        if ((++sp & 255u) == 0u) { if (xb_ld(&bar[XB_TMO])) break; if (sp > XB_SPIN_CAP) { atomicAdd(&bar[XB_TMO], 1u); break; } }
    }
    nloc = mine > 0u ? mine : 1u; nx = cnt > 0u ? cnt : 1u;
}
DEV void xcd_barrier1(const XcdBarrier& b) {
    asm volatile("s_waitcnt vmcnt(0)" ::: "memory");
    __syncthreads();
    if (threadIdx.x == 0) {
        unsigned* bar = b.bar;
        __builtin_amdgcn_s_waitcnt(0);
        unsigned nloc = b.st[0], nx = b.st[1];
        if (nloc == 0u) { xcd_barrier_complete(bar, b.x, nloc, nx); b.st[0] = nloc; b.st[1] = nx; }
        const unsigned old = xb_add(&bar[XB_XSUB(b.x)], 1u);
        const unsigned gen = old / nloc;
        if (old + 1u == (gen + 1u) * nloc) {
            __builtin_amdgcn_fence(__ATOMIC_RELEASE, "agent");
            asm volatile("s_waitcnt vmcnt(0)" ::: "memory");
            const unsigned og = xb_add(&bar[XB_TOP], 1u);
            const unsigned tg = og / nx;
            if (og + 1u == (tg + 1u) * nx) xb_add(&bar[XB_TOPGEN], 1u);
            else XB_SPIN(xb_ld(&bar[XB_TOPGEN]) == tg, bar);
            __builtin_amdgcn_fence(__ATOMIC_ACQUIRE, "agent");
            xb_add(&bar[XB_XGEN(b.x)], 1u);
            asm volatile("s_waitcnt vmcnt(0)" ::: "memory");
        } else {
            XB_SPIN(xb_ld(&bar[XB_XGEN(b.x)]) == gen, bar);
            __builtin_amdgcn_fence(__ATOMIC_ACQUIRE, "agent");
            asm volatile("s_waitcnt vmcnt(0)" ::: "memory");
        }
    }
    __syncthreads();
}

DEV void xcd_barrier(const XcdBarrier& b) { xcd_barrier1(b); if (REPMASK & 2048) xcd_barrier1(b); }
constexpr int LDS_BYTES = 148 * 1024;
DEV const void* ldptr(LAS char* shm, int i) {
    volatile LAS unsigned* pt = (volatile LAS unsigned*)(shm + LDS_BYTES - 512);
    const unsigned lo = __builtin_amdgcn_readfirstlane(pt[2 * i]), hi = __builtin_amdgcn_readfirstlane(pt[2 * i + 1]);
    return (const void*)(const __attribute__((address_space(1))) void*)(((unsigned long long)hi << 32) | lo);
}
#define PF(i) ((const float*)ldptr(shm, (i)))
struct Params {
    const float *x, *c, *norm_gain, *w_mod, *b_mod, *w_in, *lam_re, *lam_im, *log_dt, *sb_re, *sb_im, *sc_re, *sc_im, *ssm_d, *w_glu, *b_glu, *ssm_og,
        *conv_w, *conv_b, *wq, *wk, *wv, *w_gates, *b_ig, *b_fg, *m_ng, *m_skip, *w_out, *final_gain;
    float* out; char* ws;
};
constexpr size_t SLOT = (size_t)MTOK * DM * 2;
constexpr size_t W_IN_OFF = 0, W_GLU_OFF = 10485760, W_QKV_OFF = 12582912, W_OUT_OFF = 14155776, MOD_OFF = 20u << 20, IPRE_OFF = 21u << 20, LOGF_OFF = 22u << 20, BAR_OFF = 23u << 20, WF_OFF = 19u << 20, ROWSS_OFF = 24u << 20, RSTD_OFF = 25u << 20, XSS_OFF = 26u << 20;
#define REP(bit) _Pragma("nounroll") for (int rep_ = 0; rep_ < (((REPMASK) & (bit)) ? 2 : 1); ++rep_)

#define WSB ((char*)ldptr(shm, 30))
#define SL(i) ((bf16_t*)(WSB + SLOT * (i)))
#define S7(off) (WSB + SLOT * 7 + (off))
#define WinT ((bf16_t*)S7(W_IN_OFF))
#define WgluT ((bf16_t*)S7(W_GLU_OFF))
#define WqkvT ((bf16_t*)S7(W_QKV_OFF))
#define WoutT ((bf16_t*)S7(W_OUT_OFF))
#define mod ((float*)S7(MOD_OFF))
#define gpart ((float*)S7(IPRE_OFF))
#define WfT ((bf16_t*)S7(WF_OFF))
#define rowss ((float*)S7(ROWSS_OFF))
#define rstdv ((float*)S7(RSTD_OFF))
#define xssv ((float*)S7(XSS_OFF))
#define MX SL(1)
#define OUTP ((float*)ldptr(shm, 29))
#define H SL(0)
#define U SL(1)
#define Y SL(2)
#define Z SL(3)
#define XC SL(4)
#define MI SL(5)
#define Q SL(6)
#define Kb SL(1)
#define V SL(2)
#define HC SL(5)
template <int l, int PART>
DEV void prep_layer(LAS char* shm) {
    const int wave = opaque_tid() >> 6, lane = opaque_tid() & 63;
    __syncthreads();
    {
        LAS float* scr = (LAS float*)(shm + wave * 16640);
        const float* Win = PF(5) + (size_t)l * DM * INC;
        constexpr int I_IN = 16 * 80, I_GLU = 16 * 16, I_QKV = 12 * 16, I_OUT = 32 * 16;
        constexpr int LO = (PART & 1) ? 0 : (I_IN + I_GLU + I_QKV), HI = (PART & 2) ? (I_IN + I_GLU + I_QKV + I_OUT) : (I_IN + I_GLU + I_QKV);
        for (int it = LO + blockIdx.x * 8 + wave; it < HI; it += gridDim.x * 8) {
            int r = it;
            if (r < I_IN) { transpose_item(Win, INC, INC, WinT, DM, scr, r, lane); continue; } r -= I_IN;
            if (r < I_GLU) { transpose_item(PF(14) + (size_t)l * DM * DM, DM, DM, WgluT, DM, scr, r, lane); continue; } r -= I_GLU;
            if (r < I_QKV) { const int mat = r / 16, which = mat >> 2, hd = mat & 3;
                const float* W = sel3(which, PF(19), PF(20), PF(21)) + ((size_t)l * NH + hd) * DH * DH;
                transpose_item(W, DH, DH, WqkvT + (size_t)mat * DH * DH, DH, scr, r % 16, lane); continue; } r -= I_QKV;
            transpose_item(PF(27) + (size_t)l * 2 * DM * DM, DM, DM, WoutT, 2 * DM, scr, r, lane);
        }
    }
    if (PART & 1) {
        wfold_prep(WfT, PF(19) + (size_t)l * NH * DH * DH, PF(20) + (size_t)l * NH * DH * DH, PF(21) + (size_t)l * NH * DH * DH, PF(22) + (size_t)l * 3 * DM * 8);
        __syncthreads();
        s5_tables(shm, (char*)SL(3), PF(6) + l * NG * NP, PF(7) + l * NG * NP, PF(8) + l * NG, PF(9) + (size_t)l * NG * NP * GC, PF(10) + (size_t)l * NG * NP * GC,
                  PF(11) + (size_t)l * NG * GC * NP, PF(12) + (size_t)l * NG * GC * NP);
    }
    __syncthreads();
}
template <int l>
DEV void layer_body(LAS char* shm, const XcdBarrier& gbar) {
        const float* xin = (l == 0) ? PF(0) : OUTP;
        const float* modl = mod + (size_t)l * BATCH * 3 * DM;
        if (l == 0) { REP(1) norm_rows(xin, PF(2) + l * DM, modl, H); xcd_barrier(gbar); }
        REP(2) { g8::SchedG1 S_{H, WinT, (int)blockIdx.x, (int)gridDim.x}; g8::EpiG1 E_{U, MI}; g8::gemm_phase(shm, S_, E_); }
        if (l == 1) prep_layer<1, 2>(shm);
        xcd_barrier(gbar);
        REP(256) s5_phase(shm, U, Y, (const char*)SL(3), PF(13) + l * DM);
        REP(8) xc_gates_phase(shm, MI, XC, WfT, PF(17) + l * 4 * DM, PF(18) + l * DM, gpart);
        xcd_barrier(gbar);
        REP(4) { g8::SchedGlu S_{Y, WgluT, (int)blockIdx.x, (int)gridDim.x}; g8::EpiGlu E_{Y, Z, PF(15) + l * DM, rowss}; g8::gemm_phase(shm, S_, E_); }
        xcd_barrier(gbar);
        REP(16) { g8::SchedQkv S_{XC, MI, WqkvT, (int)blockIdx.x, (int)gridDim.x}; g8::EpiQkv E_{Q, Kb, V}; g8::gemm_phase(shm, S_, E_); }
        xcd_barrier(gbar);
        rstd_rows(rowss, rstdv);
        REP(32) mlstm_phase<0>(shm, Q, Kb, V, gpart, PF(23) + l * 4, PF(24) + l * 4, HC);
#ifdef MLPROBE
        if (l == 0) mlstm_phase<MLPROBE>(shm, Q, Kb, V, gpart, PF(23) + l * 4, PF(24) + l * 4, (bf16_t*)OUTP);
#endif
        xcd_barrier(gbar);
        { g8::SchedG2s S_{H, WinT, (int)blockIdx.x}; g8::EpiG2s E_{Z, rstdv, PF(16) + l * DM}; g8::gemm_phase(shm, S_, E_); }
        { g8::SchedG2m S_{H, WinT, (int)blockIdx.x}; g8::EpiG2m E_{HC, XC, PF(25) + l * DM, PF(26) + l * DM}; g8::gemm_phase(shm, S_, E_); }
        xcd_barrier(gbar);
        if (l == 0) { g8::SchedOut S_{Z, HC, WoutT, (int)blockIdx.x, (int)gridDim.x};
            g8::EpiOutN<false> E_{xin, OUTP, modl + 2 * DM, PF(2) + DM, mod + (size_t)BATCH * 3 * DM, H, xssv, (unsigned*)S7(BAR_OFF) + 4096, (unsigned*)S7(BAR_OFF) + XB_TMO}; g8::gemm_phase(shm, S_, E_);
            prep_layer<1, 1>(shm); }
        else { g8::SchedOut S_{Z, HC, WoutT, (int)blockIdx.x, (int)gridDim.x};
            g8::EpiOutN<true> E_{xin, OUTP, modl + 2 * DM, PF(28), mod, H, xssv + (size_t)MTOK * 4, (unsigned*)S7(BAR_OFF) + 4096 + 4096, (unsigned*)S7(BAR_OFF) + XB_TMO}; g8::gemm_phase(shm, S_, E_); }
        xcd_barrier(gbar);
    }
__global__ void __launch_bounds__(512, 2) mega(Params Pk) {
    extern __shared__ __attribute__((aligned(16))) unsigned char lds_raw[];
    {
        volatile LAS unsigned long long* pt = (volatile LAS unsigned long long*)((LAS char*)lds_raw + LDS_BYTES - 512);
        if (threadIdx.x == 0) {
            pt[0] = (unsigned long long)Pk.x;
            pt[1] = (unsigned long long)Pk.c;
            pt[2] = (unsigned long long)Pk.norm_gain;
            pt[3] = (unsigned long long)Pk.w_mod;
            pt[4] = (unsigned long long)Pk.b_mod;
            pt[5] = (unsigned long long)Pk.w_in;
            pt[6] = (unsigned long long)Pk.lam_re;
            pt[7] = (unsigned long long)Pk.lam_im;
            pt[8] = (unsigned long long)Pk.log_dt;
            pt[9] = (unsigned long long)Pk.sb_re;
            pt[10] = (unsigned long long)Pk.sb_im;
            pt[11] = (unsigned long long)Pk.sc_re;
            pt[12] = (unsigned long long)Pk.sc_im;
            pt[13] = (unsigned long long)Pk.ssm_d;
            pt[14] = (unsigned long long)Pk.w_glu;
            pt[15] = (unsigned long long)Pk.b_glu;
            pt[16] = (unsigned long long)Pk.ssm_og;
            pt[17] = (unsigned long long)Pk.conv_w;
            pt[18] = (unsigned long long)Pk.conv_b;
            pt[19] = (unsigned long long)Pk.wq;
            pt[20] = (unsigned long long)Pk.wk;
            pt[21] = (unsigned long long)Pk.wv;
            pt[22] = (unsigned long long)Pk.w_gates;
            pt[23] = (unsigned long long)Pk.b_ig;
            pt[24] = (unsigned long long)Pk.b_fg;
            pt[25] = (unsigned long long)Pk.m_ng;
            pt[26] = (unsigned long long)Pk.m_skip;
            pt[27] = (unsigned long long)Pk.w_out;
            pt[28] = (unsigned long long)Pk.final_gain;
            pt[29] = (unsigned long long)Pk.out; pt[30] = (unsigned long long)Pk.ws;
        }
    }
    __syncthreads();
    LAS char* shm = (LAS char*)lds_raw;
    volatile LAS unsigned* bst = (volatile LAS unsigned*)(shm + LDS_BYTES - 16);
    if (threadIdx.x < 4) bst[threadIdx.x] = 0u;
    __syncthreads();
    const XcdBarrier gbar = xcd_barrier_post((unsigned*)((char*)ldptr(shm, 30) + SLOT * 7 + BAR_OFF), bst);
    REP(4096) mod_phase(shm, PF(1), PF(3), PF(4), mod);
    prep_layer<0, 3>(shm);
    xcd_barrier(gbar);
    layer_body<0>(shm, gbar);
    layer_body<1>(shm, gbar);
}

#undef WSB
#undef SL
#undef S7
#undef WinT
#undef WgluT
#undef WqkvT
#undef WoutT
#undef mod
#undef gpart
#undef WfT
#undef rowss
#undef rstdv
#undef xssv
#undef MX
#undef OUTP
#undef H
#undef U
#undef Y
#undef Z
#undef XC
#undef MI
#undef Q
#undef Kb
#undef V
#undef HC
extern "C" void kernel_launch(void* const* d_in, const int* in_sizes, int n_in, void* d_out, int out_size, void* d_ws, size_t ws_size, hipStream_t stream) {
    static int grid_blocks = 0;
    if (!grid_blocks) {
        int dev = 0, cus = 0, per_cu = 0;
        (void)hipGetDevice(&dev);
        (void)hipDeviceGetAttribute(&cus, hipDeviceAttributeMultiprocessorCount, dev);
        (void)hipFuncSetAttribute((const void*)mega, hipFuncAttributeMaxDynamicSharedMemorySize, LDS_BYTES);
        (void)hipOccupancyMaxActiveBlocksPerMultiprocessor(&per_cu, (const void*)mega, 512, LDS_BYTES);
        grid_blocks = cus;
        fprintf(stderr, "mega: cus=%d occupancy per_cu=%d grid=%d\n", cus, per_cu, grid_blocks);
    }
    (void)hipMemsetAsync((char*)d_ws + SLOT * 7 + BAR_OFF, 0, 65536, stream);
    Params P{};
    const float** pp = (const float**)&P;
    for (int i = 0; i < 29; ++i) pp[i] = (const float*)d_in[i];
    P.out = (float*)d_out; P.ws = (char*)d_ws;
    void* args[] = {&P};
    hipError_t e = hipLaunchCooperativeKernel((const void*)mega, dim3(grid_blocks), dim3(512), args, LDS_BYTES, stream);
    if (e != hipSuccess) fprintf(stderr, "cooperative launch failed: %s (grid %d)\n", hipGetErrorString(e), grid_blocks);
}
```

```cpp
#include <hip/hip_runtime.h>
#include <cstdio>
#include <cstdint>

#ifndef REPMASK
#define REPMASK 0
#endif
typedef unsigned short bf16_t;
#define DEV __device__ __forceinline__

constexpr int BATCH = 8, SEQ = 2048, DM = 1024, MTOK = BATCH * SEQ;
constexpr int NG = 64, NP = 64, GC = 16, NH = 4, DH = 256, CHUNK = 64, INC = 5120;
constexpr float EPS = 1e-6f;

DEV int opaque_tid() { int t = threadIdx.x; asm volatile("" : "+v"(t)); return t; }
DEV float bf2f(bf16_t v) { return __uint_as_float(((unsigned)v) << 16); }
typedef __bf16 bf16n2 __attribute__((ext_vector_type(2)));
typedef float f32n2 __attribute__((ext_vector_type(2)));
DEV bf16_t f2bf(float f) { __bf16 b = (__bf16)f; return __builtin_bit_cast(unsigned short, b); }
DEV unsigned pk2(float lo, float hi) { f32n2 v = {lo, hi}; bf16n2 b = __builtin_convertvector(v, bf16n2); return __builtin_bit_cast(unsigned, b); }
DEV float sigmoidf_(float x) { return __builtin_amdgcn_rcpf(1.f + __expf(-x)); }
DEV float siluf_(float x) { return x * __builtin_amdgcn_rcpf(1.f + __expf(-x)); }
DEV float geluf_(float x) { const float t2 = 1.5957691216057308f * (x + 0.044715f * x * x * x); return x * __builtin_amdgcn_rcpf(1.f + __expf(-t2)); }
DEV float logsigmoidf_(float x) { return fminf(x, 0.f) - log1pf(__expf(-fabsf(x))); }

DEV float wave_sum(float v) {
#pragma unroll
    for (int o = 1; o < 64; o <<= 1) v += __shfl_xor(v, o);
    return v;
}
#define LAS __attribute__((address_space(3)))
typedef short bf16x8 __attribute__((ext_vector_type(8)));
typedef float f32x4 __attribute__((ext_vector_type(4)));
typedef short s16x4 __attribute__((ext_vector_type(4)));
typedef unsigned u32x4 __attribute__((ext_vector_type(4)));
typedef unsigned u32x2 __attribute__((ext_vector_type(2)));
typedef float f32x2 __attribute__((ext_vector_type(2)));
#define WAIT_V(n) asm volatile("s_waitcnt vmcnt(" #n ")" ::: "memory")
#define WAIT_L(n) asm volatile("s_waitcnt lgkmcnt(" #n ")" ::: "memory")
#define SCHED() __builtin_amdgcn_sched_barrier(0)

DEV int lds_byte(int r, int c) { int st = (r >> 4) * 2 + (c >> 5), ob = (r & 15) * 64 + (c & 31) * 2; return st * 1024 + (ob ^ (((ob >> 9) & 1) << 5)); }
DEV void stage_rc(int b, int& R, int& C) { int st = b >> 10, sb = b & 1023, swz = sb ^ (((sb >> 9) & 1) << 5); R = (st >> 1) * 16 + swz / 64; C = (st & 1) * 32 + (swz % 64) / 2; }
template <class T> DEV T* sel3(int w, T* p0, T* p1, T* p2) { return p0 + ((w >= 1) ? (p1 - p0) : 0) + ((w >= 2) ? (p2 - p1) : 0); }
DEV void unpack8(const uint4 v, float* f) {
    f[0] = bf2f((bf16_t)(v.x & 0xffff)); f[1] = bf2f((bf16_t)(v.x >> 16)); f[2] = bf2f((bf16_t)(v.y & 0xffff)); f[3] = bf2f((bf16_t)(v.y >> 16));
    f[4] = bf2f((bf16_t)(v.z & 0xffff)); f[5] = bf2f((bf16_t)(v.z >> 16)); f[6] = bf2f((bf16_t)(v.w & 0xffff)); f[7] = bf2f((bf16_t)(v.w >> 16));
}
DEV uint4 pack8(const float* f) { return make_uint4(pk2(f[0], f[1]), pk2(f[2], f[3]), pk2(f[4], f[5]), pk2(f[6], f[7])); }
DEV uint2 pack4(f32x4 v) { uint2 r; r.x = pk2(v[0], v[1]); r.y = pk2(v[2], v[3]); return r; }

DEV void tile_map(int t, int nN, int& pm, int& pn) {
    const int base = t & ~255, loc = t & 255;
    const int w = base + (loc & 7) * 32 + (loc >> 3);
    const int nig = 8 * nN, gid = w / nig;
    pm = gid * 8 + (w % nig) % 8; pn = (w % nig) / 8;
}
DEV void xcd_wait_lds(LAS char* lds);
namespace g8 {
constexpr int BK = 64, HALFT = 128, HTB = HALFT * BK * 2;
#define G8_A_ROWMAJOR_NOB static constexpr int ksplit = 1 << 20; static constexpr size_t kstepA = 128, hstepA = (size_t)128 * lda * 2; static DEV unsigned aoff(int R, int C) { return (unsigned)(R * lda + C) * 2u; }
#define G8_A_ROWMAJOR G8_A_ROWMAJOR_NOB static constexpr size_t hstepB = (size_t)128 * ldb * 2;
DEV int perm32(int rho) { const int n = rho >> 4, i = rho & 15; return 8 * (i >> 2) + 4 * n + (i & 3); }
struct Unit { const char* A; const char* A2; const char* B; int pm, pn, tag; };
template <class Epi, class Sched>
DEV void gemm_phase(LAS char* lds, const Sched& S, const Epi& E) {
    const int tid = opaque_tid(), wid = __builtin_amdgcn_readfirstlane(tid >> 6), lane = tid & 63, wr = wid >> 2, wc = wid & 3, fr = lane & 15, fq = lane >> 4;
    constexpr int lda = Sched::lda, ldb = Sched::ldb, nt = Sched::K / BK;
    unsigned voffA[2], voffB[2];
#pragma unroll
    for (int i = 0; i < 2; ++i) { int R, C; stage_rc(tid * 16 + i * 8192, R, C); const int Rb = (R & ~31) + perm32(R & 31);
        voffA[i] = Sched::aoff(R, C); voffB[i] = (unsigned)(Rb * ldb + C) * 2u; asm volatile("" : "+v"(voffA[i]), "+v"(voffB[i])); }
    constexpr size_t kstep = (size_t)(BK * 2), kstepA = Sched::kstepA, hstepA = Sched::hstepA, hstepB = Sched::hstepB;
    const unsigned ldsw = (unsigned)wid * 1024u;
    const int aoff = lds_byte(wr * 64 + fr, fq * 8), boff = lds_byte(wc * 32 + fr, fq * 8);
#define G8_SA(b, h) (((b) * 2 + (h)) * HTB)
#define G8_SB(b, h) ((4 + (b) * 2 + (h)) * HTB)
#define G8_STAGE(bufoff, gbase, voff) do { _Pragma("unroll") for (int _i = 0; _i < 2; ++_i) \
        __builtin_amdgcn_global_load_lds((const unsigned*)((const char*)(gbase) + (voff)[_i]), (LAS unsigned*)(lds + (bufoff) + ldsw + _i * 8192), 16, 0, 0); } while (0)
#define G8_LDA(dst, b, h) do { _Pragma("unroll") for (int m = 0; m < 4; ++m) _Pragma("unroll") for (int k = 0; k < 2; ++k) dst[m][k] = *(const LAS bf16x8*)(lds + G8_SA(b, h) + aoff + m * 2048 + k * 1024); } while (0)
#define G8_LDB(dst, b, h) do { _Pragma("unroll") for (int n = 0; n < 2; ++n) _Pragma("unroll") for (int k = 0; k < 2; ++k) dst[n][k] = *(const LAS bf16x8*)(lds + G8_SB(b, h) + boff + n * 2048 + k * 1024); } while (0)
#define G8_MMA(ai, bj, At, Bt) do { __builtin_amdgcn_s_setprio(1); _Pragma("unroll") for (int m = 0; m < 4; ++m) _Pragma("unroll") for (int n = 0; n < 2; ++n) _Pragma("unroll") for (int k = 0; k < 2; ++k) \
        acc[ai][bj][m][n] = __builtin_amdgcn_mfma_f32_16x16x32_bf16(Bt[n][k], At[m][k], acc[ai][bj][m][n], 0, 0, 0); __builtin_amdgcn_s_setprio(0); } while (0)
#define G8_WAIT_V(n) asm volatile("s_waitcnt vmcnt(" #n ")" ::: "memory")
#define G8_WAIT_L(n) asm volatile("s_waitcnt lgkmcnt(" #n ")" ::: "memory")
#define G8_BAR __builtin_amdgcn_s_barrier()
#define G8_SCHED __builtin_amdgcn_sched_barrier(0)
    Unit cur, nxt; int ui = 0;
    __syncthreads();
    if (!S.next(0, cur)) return;
    f32x4 acc[2][2][4][2];
#pragma unroll
    for (int a = 0; a < 2; ++a)
#pragma unroll
        for (int b = 0; b < 2; ++b)
#pragma unroll
            for (int m = 0; m < 4; ++m)
#pragma unroll
                for (int n = 0; n < 2; ++n) acc[a][b][m][n] = (f32x4){0.f, 0.f, 0.f, 0.f};
    bf16x8 At[4][2], B0[2][2], B1[2][2];
    const char* cA = cur.A; const char* cA2 = cur.A2; const char* cB = cur.B;
    constexpr int KSP = Sched::ksplit;
#define G8_AK(t_) (((t_) < KSP) ? cA + (size_t)(t_) * kstepA : cA2 + (size_t)((t_) - KSP) * kstepA)
    G8_STAGE(G8_SB(0, 0), cB, voffB); G8_STAGE(G8_SB(0, 1), cB + hstepB, voffB); G8_STAGE(G8_SA(0, 0), cA, voffA); G8_STAGE(G8_SA(0, 1), cA + hstepA, voffA);
    if (wr == 1) G8_BAR;
    G8_WAIT_V(2); G8_BAR;
    G8_STAGE(G8_SB(1, 0), cB + kstep, voffB); G8_STAGE(G8_SA(1, 0), cA + kstepA, voffA); G8_STAGE(G8_SB(1, 1), cB + hstepB + kstep, voffB);
    G8_WAIT_V(6); G8_BAR;
    for (;;) {
        const bool has_next = S.next(ui + 1, nxt);
        const char* nA = has_next ? nxt.A : cA; const char* nB = has_next ? nxt.B : cB;
#pragma nounroll
        for (int t = 0; t < nt; t += 2) {
            const bool last = (t == nt - 2);
            const char* a1 = G8_AK(t + 1);
            const char* a2 = last ? nA : G8_AK(t + 2); const char* b2 = last ? nB : cB + (size_t)(t + 2) * kstep;
            const char* a3 = last ? nA + kstepA : G8_AK(t + 3); const char* b3 = b2 + kstep;
            G8_LDB(B0, 0, 0); G8_LDB(B1, 0, 1); G8_SCHED; G8_LDA(At, 0, 0); G8_STAGE(G8_SA(1, 1), a1 + hstepA, voffA);
            G8_WAIT_V(8); G8_WAIT_L(0); G8_BAR; G8_MMA(0, 0, At, B0); G8_MMA(0, 1, At, B1); G8_BAR; G8_SCHED;
            G8_LDA(At, 0, 1); G8_STAGE(G8_SB(0, 0), b2, voffB); G8_STAGE(G8_SB(0, 1), b2 + hstepB, voffB); G8_STAGE(G8_SA(0, 0), a2, voffA);
            G8_WAIT_V(8); G8_WAIT_L(0); G8_BAR; G8_MMA(1, 0, At, B0); G8_MMA(1, 1, At, B1); G8_BAR; G8_SCHED;
            G8_LDB(B0, 1, 0); G8_LDB(B1, 1, 1); G8_SCHED; G8_LDA(At, 1, 0); G8_STAGE(G8_SA(0, 1), a2 + hstepA, voffA);
            G8_WAIT_V(8); G8_WAIT_L(0); G8_BAR; G8_MMA(0, 0, At, B0); G8_MMA(0, 1, At, B1); G8_BAR; G8_SCHED;
            G8_LDA(At, 1, 1); G8_STAGE(G8_SB(1, 0), b3, voffB); G8_STAGE(G8_SB(1, 1), b3 + hstepB, voffB); G8_STAGE(G8_SA(1, 0), a3, voffA);
            G8_WAIT_V(8); G8_WAIT_L(0); G8_BAR; G8_MMA(1, 0, At, B0); G8_MMA(1, 1, At, B1); G8_BAR; G8_SCHED;
        }
        if (wr == 0) G8_BAR;
        E(lds, acc, cur, wr, wc, fr, fq, wid, lane);
        if (!has_next) break;
#pragma unroll
        for (int a = 0; a < 2; ++a)
#pragma unroll
            for (int b = 0; b < 2; ++b)
#pragma unroll
                for (int m = 0; m < 4; ++m)
#pragma unroll
                    for (int n = 0; n < 2; ++n) acc[a][b][m][n] = (f32x4){0.f, 0.f, 0.f, 0.f};
        cur = nxt; cA = nA; cA2 = nxt.A2; cB = nB; ++ui;
        if (wr == 1) G8_BAR;
    }
    G8_WAIT_V(0);
    G8_BAR;
#undef G8_AK
#undef G8_SA
#undef G8_SB
#undef G8_STAGE
#undef G8_LDA
#undef G8_LDB
#undef G8_MMA
#undef G8_WAIT_V
#undef G8_WAIT_L
#undef G8_BAR
#undef G8_SCHED
}
DEV u32x4 pk8(const f32x4 a, const f32x4 b) { return (u32x4){pk2(a[0], a[1]), pk2(a[2], a[3]), pk2(b[0], b[1]), pk2(b[2], b[3])}; }
DEV void un8(const u32x4 v, float* f) { unpack8(make_uint4(v[0], v[1], v[2], v[3]), f); }
#define G8_ROWS_BEGIN _Pragma("unroll") for (int ai = 0; ai < 2; ++ai) _Pragma("unroll") for (int m = 0; m < 4; ++m) { const int rl = 128 * ai + 64 * wr + 16 * m + fr;
#define G8_ROWS_END }

struct SchedG1 { static constexpr int K = 1024, lda = 1024, ldb = 1024; G8_A_ROWMAJOR const bf16_t* H; const bf16_t* Wt; int bid, G;
    DEV bool next(int i, Unit& u) const { const int t = bid + i * G; if (t >= 512) return false; int pm, pn; tile_map(t, 8, pm, pn);
        u.pm = pm; u.pn = pn; u.tag = 0; u.A = (const char*)(H + (size_t)pm * 256 * DM); u.A2 = u.A; u.B = (const char*)(Wt + (size_t)((pn < 4) ? pn * 256 : 2048 + (pn - 4) * 256) * DM); return true; } };
struct EpiG1 { bf16_t* U; bf16_t* MI;
    DEV void operator()(LAS char*, const f32x4 (&acc)[2][2][4][2], const Unit& u, int wr, int wc, int fr, int fq, int, int) const {
        const int c0 = (u.pn & 3) * 256 + 32 * wc + 8 * fq;
        if (u.pn < 4) {
            G8_ROWS_BEGIN const int row = u.pm * 256 + rl;
#pragma unroll
                for (int bj = 0; bj < 2; ++bj) { const int cc = c0 + 128 * bj; *(u32x4*)(U + (size_t)(cc >> 4) * MTOK * 16 + (size_t)row * 16 + (cc & 15)) = pk8(acc[ai][bj][m][0], acc[ai][bj][m][1]); } G8_ROWS_END
        } else {
            G8_ROWS_BEGIN bf16_t* rp = MI + (size_t)(u.pm * 256 + rl) * DM + c0;
#pragma unroll
                for (int bj = 0; bj < 2; ++bj) *(u32x4*)(rp + 128 * bj) = pk8(acc[ai][bj][m][0], acc[ai][bj][m][1]); G8_ROWS_END
        } } };
struct SchedGlu { static constexpr int K = 1024, lda = 1024, ldb = 1024; static constexpr size_t hstepB = (size_t)128 * ldb * 2; static constexpr int ksplit = 1 << 20; static constexpr size_t kstepA = (size_t)4 * MTOK * 32, hstepA = (size_t)128 * 32; static DEV unsigned aoff(int R, int C) { return (unsigned)((C >> 4) * (MTOK * 32) + R * 32 + (C & 15) * 2); } const bf16_t* Y; const bf16_t* Wt; int bid, G;
    DEV bool next(int i, Unit& u) const { const int t = bid + i * G; if (t >= 256) return false; int pm, pn; tile_map(t, 4, pm, pn);
        u.pm = pm; u.pn = pn; u.tag = 0; u.A = (const char*)(Y + (size_t)pm * 256 * 16); u.A2 = u.A; u.B = (const char*)(Wt + (size_t)pn * 256 * DM); return true; } };
struct EpiGlu { const bf16_t* Y; bf16_t* Z; const float* bias; float* xss; unsigned* cnt;
    DEV void operator()(LAS char* lds, const f32x4 (&acc)[2][2][4][2], const Unit& u, int wr, int wc, int fr, int fq, int wid, int lane) const {
        asm volatile("" : "+v"(fr), "+v"(fq));
        LAS float* red = (LAS float*)(lds + 131072);
        const int c0 = u.pn * 256 + 32 * wc + 8 * fq;
        float4 bb[2][2];
#pragma unroll
        for (int bj = 0; bj < 2; ++bj) { bb[bj][0] = *(const float4*)(bias + c0 + 128 * bj); bb[bj][1] = *(const float4*)(bias + c0 + 128 * bj + 4); }
        u32x4 yv[2][4][2];
#pragma unroll
        for (int ai = 0; ai < 2; ++ai)
#pragma unroll
            for (int m = 0; m < 4; ++m)
#pragma unroll
                for (int bj = 0; bj < 2; ++bj) { const int rl = 128 * ai + 64 * wr + 16 * m + fr, cc = c0 + 128 * bj;
                    yv[ai][m][bj] = *(const u32x4*)(Y + (size_t)(cc >> 4) * MTOK * 16 + (size_t)(u.pm * 256 + rl) * 16 + (cc & 15)); }
        G8_ROWS_BEGIN const size_t ro = (size_t)(u.pm * 256 + rl) * DM + c0; float ss = 0.f;
#pragma unroll
            for (int bj = 0; bj < 2; ++bj) {
                float y8[8]; un8(yv[ai][m][bj], y8);
                const float4 b0 = bb[bj][0], b1 = bb[bj][1];
                f32x4 o0, o1;
                o0[0] = y8[0] * sigmoidf_(acc[ai][bj][m][0][0] + b0.x); o0[1] = y8[1] * sigmoidf_(acc[ai][bj][m][0][1] + b0.y); o0[2] = y8[2] * sigmoidf_(acc[ai][bj][m][0][2] + b0.z); o0[3] = y8[3] * sigmoidf_(acc[ai][bj][m][0][3] + b0.w);
                o1[0] = y8[4] * sigmoidf_(acc[ai][bj][m][1][0] + b1.x); o1[1] = y8[5] * sigmoidf_(acc[ai][bj][m][1][1] + b1.y); o1[2] = y8[6] * sigmoidf_(acc[ai][bj][m][1][2] + b1.z); o1[3] = y8[7] * sigmoidf_(acc[ai][bj][m][1][3] + b1.w);
                const u32x4 pk = pk8(o0, o1); *(u32x4*)(Z + ro + 128 * bj) = pk;
                float r8[8]; un8(pk, r8);
#pragma unroll
                for (int e = 0; e < 8; ++e) ss += r8[e] * r8[e];
            }
            ss += __shfl_xor(ss, 16); ss += __shfl_xor(ss, 32);
            if (fq == 0) red[wid * 128 + 64 * ai + 16 * m + fr] = ss; G8_ROWS_END
        asm volatile("s_waitcnt lgkmcnt(0)" ::: "memory"); __builtin_amdgcn_s_barrier();
        const int tid = wid * 64 + lane;
        if (tid < 256) {
            const int r_ = tid, w0 = (r_ >> 6) & 1, ix = (r_ & 63) + 64 * (r_ >> 7);
            const float t_ = red[(w0 * 4 + 0) * 128 + ix] + red[(w0 * 4 + 1) * 128 + ix] + red[(w0 * 4 + 2) * 128 + ix] + red[(w0 * 4 + 3) * 128 + ix];
            __hip_atomic_store(xss + ((size_t)(u.pm * 256 + r_) * 4 + u.pn), t_, __ATOMIC_RELAXED, __HIP_MEMORY_SCOPE_AGENT);
        }
        asm volatile("s_waitcnt vmcnt(0)" ::: "memory"); __builtin_amdgcn_s_barrier();
        if (tid == 0) __hip_atomic_fetch_add(cnt + 32 * u.pm, 1u, __ATOMIC_RELAXED, __HIP_MEMORY_SCOPE_AGENT);
    } };
struct SchedQkv { static constexpr int K = 256, lda = 1024, ldb = 256; G8_A_ROWMAJOR const bf16_t* XC; const bf16_t* MI; const bf16_t* Wt; int bid, G;
    DEV bool next(int i, Unit& u) const { const int t = bid + i * G; if (t >= 768) return false; int pm, pp; tile_map(t, 12, pm, pp);
        const int pn = (pp < 8) ? (pp & 1) * 4 + (pp >> 1) : pp;
        u.pm = pm; u.pn = pn; u.tag = 0; u.A = (const char*)(((pn >> 2) == 2 ? MI : XC) + (size_t)pm * 256 * DM + (pn & 3) * 256); u.A2 = u.A; u.B = (const char*)(Wt + (size_t)pn * 256 * 256); return true; } };
struct EpiQkv { bf16_t* Q; bf16_t* Kk; bf16_t* V;
    DEV void operator()(LAS char*, const f32x4 (&acc)[2][2][4][2], const Unit& u, int wr, int wc, int fr, int fq, int, int) const {
        const int which = u.pn >> 2;
        if (which == 0) {
            G8_ROWS_BEGIN const int row = u.pm * 256 + rl, b_ = row >> 11, t_ = row & 2047;
                bf16_t* rp = Q + ((size_t)((((b_ * 4 + (u.pn & 3)) * 32 + (t_ >> 6)) * 4 + ((t_ >> 4) & 3)) * 8) * 512) + fq * 128 + fr * 8;
#pragma unroll
                for (int bj = 0; bj < 2; ++bj) *(u32x4*)(rp + (wc + 4 * bj) * 512) = pk8(acc[ai][bj][m][0], acc[ai][bj][m][1]); G8_ROWS_END
        } else {
            bf16_t* C = (which == 1) ? Kk : V; const float sc = (which == 1) ? 0.0625f : 1.f;
            const int c0 = (u.pn & 3) * 256 + 32 * wc + 8 * fq;
            G8_ROWS_BEGIN bf16_t* rp = C + (size_t)(u.pm * 256 + rl) * DM + c0;
#pragma unroll
                for (int bj = 0; bj < 2; ++bj) *(u32x4*)(rp + 128 * bj) = pk8(acc[ai][bj][m][0] * sc, acc[ai][bj][m][1] * sc); G8_ROWS_END
        } } };
struct SchedOut { static constexpr int K = 2048, lda = 1024, ldb = 2048, ksplit = 16; static constexpr size_t hstepB = (size_t)128 * ldb * 2; static constexpr size_t kstepA = 128, hstepA = (size_t)128 * lda * 2; static DEV unsigned aoff(int R, int C) { return (unsigned)(R * lda + C) * 2u; }
    const bf16_t* MS; const bf16_t* MM; const bf16_t* Wt; int bid, G;
    DEV bool next(int i, Unit& u) const { const int t = bid + i * G; if (t >= 256) return false; int pm, pn; tile_map(t, 4, pm, pn);
        u.pm = pm; u.pn = pn; u.tag = 0; u.A = (const char*)(MS + (size_t)pm * 256 * DM); u.A2 = (const char*)(MM + (size_t)pm * 256 * DM); u.B = (const char*)(Wt + (size_t)pn * 256 * 2048); return true; } };
template <bool FINAL>
struct EpiOutN { const float* xin; float* xout; const float* gate; const float* ngain; const float* modn; bf16_t* Hn; float* xss; unsigned* cnt; unsigned* tmo;
    DEV void operator()(LAS char* lds, f32x4 (&acc)[2][2][4][2], const Unit& u, int wr, int wc, int fr, int fq, int wid, int lane) const {
        asm volatile("" : "+v"(fr), "+v"(fq));
        LAS float* red = (LAS float*)(lds + 131072);
        LAS float* rst = (LAS float*)(lds + 131072 + 4096);
        const int c0 = u.pn * 256 + 32 * wc + 8 * fq, bidx = (u.pm * 256) / SEQ; const float* gp = gate + (size_t)bidx * 3 * DM + c0;
        float4 gg4[2][2];
#pragma unroll
        for (int bj = 0; bj < 2; ++bj)
#pragma unroll
            for (int n = 0; n < 2; ++n) gg4[bj][n] = *(const float4*)(gp + 128 * bj + 4 * n);
#pragma unroll
        for (int aih = 0; aih < 4; ++aih) { const int ai = aih >> 1, mh = (aih & 1) * 2;
        float4 xiv[4][2][2]; u32x4 xbv[4][2];
#pragma unroll
        for (int m = mh; m < mh + 2; ++m)
#pragma unroll
            for (int bj = 0; bj < 2; ++bj) { const int rl = 128 * ai + 64 * wr + 16 * m + fr;
                if (FINAL) xbv[m][bj] = *(const u32x4*)((const char*)xin + (size_t)(u.pm * 256 + rl) * 4096 + (size_t)(c0 + 128 * bj) * 2);
                else {
#pragma unroll
                    for (int n = 0; n < 2; ++n) xiv[m][bj][n] = *(const float4*)(xin + (size_t)(u.pm * 256 + rl) * DM + c0 + 128 * bj + 4 * n); } }
#pragma unroll
        for (int m = mh; m < mh + 2; ++m) { const int rl = 128 * ai + 64 * wr + 16 * m + fr;
            const size_t ro = (size_t)(u.pm * 256 + rl) * DM + c0; float ss = 0.f;
#pragma unroll
            for (int bj = 0; bj < 2; ++bj) {
                float x8[8];
                if (FINAL) un8(xbv[m][bj], x8);
                else { x8[0] = xiv[m][bj][0].x; x8[1] = xiv[m][bj][0].y; x8[2] = xiv[m][bj][0].z; x8[3] = xiv[m][bj][0].w; x8[4] = xiv[m][bj][1].x; x8[5] = xiv[m][bj][1].y; x8[6] = xiv[m][bj][1].z; x8[7] = xiv[m][bj][1].w; }
#pragma unroll
                for (int n = 0; n < 2; ++n) {
                    const float4 g4 = gg4[bj][n];
                    f32x4 o; o[0] = x8[4 * n] + g4.x * acc[ai][bj][m][n][0]; o[1] = x8[4 * n + 1] + g4.y * acc[ai][bj][m][n][1]; o[2] = x8[4 * n + 2] + g4.z * acc[ai][bj][m][n][2]; o[3] = x8[4 * n + 3] + g4.w * acc[ai][bj][m][n][3];
                    acc[ai][bj][m][n] = o; ss += (o[0] * o[0] + o[1] * o[1]) + (o[2] * o[2] + o[3] * o[3]); }
                if (!FINAL) *(u32x4*)((char*)xout + (size_t)(u.pm * 256 + rl) * 4096 + (size_t)(c0 + 128 * bj) * 2) = pk8(acc[ai][bj][m][0], acc[ai][bj][m][1]);
            }
            ss += __shfl_xor(ss, 16); ss += __shfl_xor(ss, 32);
            if (fq == 0) red[wid * 128 + 64 * ai + 16 * m + fr] = ss; }
        }
        const float* shp = modn + (size_t)bidx * 3 * DM + c0;
        float4 ng[2][2], hs[2][4];
#pragma unroll
        for (int bj = 0; bj < 2; ++bj) { ng[bj][0] = *(const float4*)(ngain + c0 + 128 * bj); ng[bj][1] = *(const float4*)(ngain + c0 + 128 * bj + 4);
            if (!FINAL) { hs[bj][0] = *(const float4*)(shp + 128 * bj); hs[bj][1] = *(const float4*)(shp + 128 * bj + 4); hs[bj][2] = *(const float4*)(shp + DM + 128 * bj); hs[bj][3] = *(const float4*)(shp + DM + 128 * bj + 4); } }
        asm volatile("s_waitcnt lgkmcnt(0)" ::: "memory"); __builtin_amdgcn_s_barrier();
        const int tid = wid * 64 + lane;
        if (tid < 256) {
            const int r_ = tid, w0 = (r_ >> 6) & 1, ix = (r_ & 63) + 64 * (r_ >> 7);
            const float t_ = red[(w0 * 4 + 0) * 128 + ix] + red[(w0 * 4 + 1) * 128 + ix] + red[(w0 * 4 + 2) * 128 + ix] + red[(w0 * 4 + 3) * 128 + ix];
            __hip_atomic_store(xss + ((size_t)(u.pm * 256 + r_) * 4 + u.pn), t_, __ATOMIC_RELAXED, __HIP_MEMORY_SCOPE_AGENT);
        }
        asm volatile("s_waitcnt vmcnt(0)" ::: "memory"); __builtin_amdgcn_s_barrier();
        if (tid == 0) {
            __hip_atomic_fetch_add(cnt + 64 * u.pm, 1u, __ATOMIC_RELAXED, __HIP_MEMORY_SCOPE_AGENT);
            unsigned sp_ = 0;
            while (__hip_atomic_load(cnt + 64 * u.pm, __ATOMIC_RELAXED, __HIP_MEMORY_SCOPE_AGENT) < 4u) { __builtin_amdgcn_s_sleep(1); if (++sp_ > (1u << 22)) { atomicAdd(tmo, 1u); break; } }
        }
        __builtin_amdgcn_s_barrier();
        if (tid < 256) {
            const float* xp = xss + (size_t)(u.pm * 256 + tid) * 4;
            const float t_ = __hip_atomic_load(xp, __ATOMIC_RELAXED, __HIP_MEMORY_SCOPE_AGENT) + __hip_atomic_load(xp + 1, __ATOMIC_RELAXED, __HIP_MEMORY_SCOPE_AGENT)
                           + __hip_atomic_load(xp + 2, __ATOMIC_RELAXED, __HIP_MEMORY_SCOPE_AGENT) + __hip_atomic_load(xp + 3, __ATOMIC_RELAXED, __HIP_MEMORY_SCOPE_AGENT);
            rst[tid] = rsqrtf(t_ * (1.f / DM) + EPS);
        }
        asm volatile("s_waitcnt vmcnt(0) lgkmcnt(0)" ::: "memory"); __builtin_amdgcn_s_barrier();
        G8_ROWS_BEGIN const size_t ro = (size_t)(u.pm * 256 + rl) * DM + c0; const float rs = rst[rl];
#pragma unroll
            for (int bj = 0; bj < 2; ++bj) {
                const float4 g0 = ng[bj][0], g1 = ng[bj][1];
                if (FINAL) {
                    *(float4*)(xout + ro + 128 * bj) = make_float4(acc[ai][bj][m][0][0] * rs * g0.x, acc[ai][bj][m][0][1] * rs * g0.y, acc[ai][bj][m][0][2] * rs * g0.z, acc[ai][bj][m][0][3] * rs * g0.w);
                    *(float4*)(xout + ro + 128 * bj + 4) = make_float4(acc[ai][bj][m][1][0] * rs * g1.x, acc[ai][bj][m][1][1] * rs * g1.y, acc[ai][bj][m][1][2] * rs * g1.z, acc[ai][bj][m][1][3] * rs * g1.w);
                } else {
                    const float4 h0 = hs[bj][0], h1 = hs[bj][1], s0 = hs[bj][2], s1 = hs[bj][3];
                    f32x4 o0, o1;
                    o0[0] = acc[ai][bj][m][0][0] * rs * g0.x * (1.f + s0.x) + h0.x; o0[1] = acc[ai][bj][m][0][1] * rs * g0.y * (1.f + s0.y) + h0.y; o0[2] = acc[ai][bj][m][0][2] * rs * g0.z * (1.f + s0.z) + h0.z; o0[3] = acc[ai][bj][m][0][3] * rs * g0.w * (1.f + s0.w) + h0.w;
                    o1[0] = acc[ai][bj][m][1][0] * rs * g1.x * (1.f + s1.x) + h1.x; o1[1] = acc[ai][bj][m][1][1] * rs * g1.y * (1.f + s1.y) + h1.y; o1[2] = acc[ai][bj][m][1][2] * rs * g1.z * (1.f + s1.z) + h1.z; o1[3] = acc[ai][bj][m][1][3] * rs * g1.w * (1.f + s1.w) + h1.w;
                    *(u32x4*)(Hn + ro + 128 * bj) = pk8(o0, o1);
                } } G8_ROWS_END
    } };
struct SchedG2s { static constexpr int K = 1024, lda = 1024, ldb = 1024; G8_A_ROWMAJOR const bf16_t* H; const bf16_t* Wt; int bid;
    DEV bool next(int i, Unit& u) const { if (i >= 1) return false; int pm, pn; tile_map(bid, 4, pm, pn);
        u.pm = pm; u.pn = pn; u.tag = 0; u.A = (const char*)(H + (size_t)pm * 256 * DM); u.A2 = u.A; u.B = (const char*)(Wt + (size_t)(1024 + pn * 256) * DM); return true; } };
struct SchedG2m { static constexpr int K = 1024, lda = 1024, ldb = 1024; G8_A_ROWMAJOR_NOB static constexpr size_t hstepB = (size_t)1024 * ldb * 2; const bf16_t* H; const bf16_t* Wt; int bid, G;
    DEV bool next(int i, Unit& u) const { const int t = bid + i * G; if (t >= 512) return false; int pm, pn; tile_map(t, 8, pm, pn);
        u.pm = pm; u.pn = pn; u.tag = 0; u.A = (const char*)(H + (size_t)pm * 256 * DM); u.A2 = u.A; u.B = (const char*)(Wt + (size_t)(3072 + pn * 128) * DM); return true; } };
struct EpiG2s { bf16_t* Z; const float* xss; unsigned* cnt; const float* og; unsigned* tmo;
    DEV void operator()(LAS char* lds, f32x4 (&acc)[2][2][4][2], const Unit& u, int wr, int wc, int fr, int fq, int wid, int lane) const {
        asm volatile("" : "+v"(fr), "+v"(fq));
        LAS float* rst = (LAS float*)(lds + 131072 + 4096);
        const int c0 = u.pn * 256 + 32 * wc + 8 * fq, tid = wid * 64 + lane;
        if (tid == 0) { unsigned sp_ = 0;
            while (__hip_atomic_load(cnt + 32 * u.pm, __ATOMIC_RELAXED, __HIP_MEMORY_SCOPE_AGENT) < 4u) { __builtin_amdgcn_s_sleep(1); if (++sp_ > (1u << 22)) { atomicAdd(tmo, 1u); break; } } }
        __builtin_amdgcn_s_barrier();
        if (tid < 256) {
            const float* xp = xss + (size_t)(u.pm * 256 + tid) * 4;
            const float t_ = __hip_atomic_load(xp, __ATOMIC_RELAXED, __HIP_MEMORY_SCOPE_AGENT) + __hip_atomic_load(xp + 1, __ATOMIC_RELAXED, __HIP_MEMORY_SCOPE_AGENT)
                           + __hip_atomic_load(xp + 2, __ATOMIC_RELAXED, __HIP_MEMORY_SCOPE_AGENT) + __hip_atomic_load(xp + 3, __ATOMIC_RELAXED, __HIP_MEMORY_SCOPE_AGENT);
            rst[tid] = rsqrtf(t_ * (1.f / DM) + EPS);
        }
        asm volatile("s_waitcnt vmcnt(0) lgkmcnt(0)" ::: "memory"); __builtin_amdgcn_s_barrier();
        {
            float4 gg[2][2];
#pragma unroll
            for (int bj = 0; bj < 2; ++bj) { gg[bj][0] = *(const float4*)(og + c0 + 128 * bj); gg[bj][1] = *(const float4*)(og + c0 + 128 * bj + 4); }
            u32x4 zv[2][4][2];
#pragma unroll
            for (int ai = 0; ai < 2; ++ai)
#pragma unroll
                for (int m = 0; m < 4; ++m)
#pragma unroll
                    for (int bj = 0; bj < 2; ++bj) { const int rl = 128 * ai + 64 * wr + 16 * m + fr; zv[ai][m][bj] = *(const u32x4*)(Z + (size_t)(u.pm * 256 + rl) * DM + c0 + 128 * bj); }
            G8_ROWS_BEGIN const int row = u.pm * 256 + rl; const float rs = rst[rl];
#pragma unroll
                for (int bj = 0; bj < 2; ++bj) {
                    float z8[8]; un8(zv[ai][m][bj], z8);
                    const float4 g0 = gg[bj][0], g1 = gg[bj][1];
                    f32x4 o0, o1;
                    o0[0] = z8[0] * rs * g0.x * siluf_(acc[ai][bj][m][0][0]); o0[1] = z8[1] * rs * g0.y * siluf_(acc[ai][bj][m][0][1]); o0[2] = z8[2] * rs * g0.z * siluf_(acc[ai][bj][m][0][2]); o0[3] = z8[3] * rs * g0.w * siluf_(acc[ai][bj][m][0][3]);
                    o1[0] = z8[4] * rs * g1.x * siluf_(acc[ai][bj][m][1][0]); o1[1] = z8[5] * rs * g1.y * siluf_(acc[ai][bj][m][1][1]); o1[2] = z8[6] * rs * g1.z * siluf_(acc[ai][bj][m][1][2]); o1[3] = z8[7] * rs * g1.w * siluf_(acc[ai][bj][m][1][3]);
                    *(u32x4*)(Z + (size_t)row * DM + c0 + 128 * bj) = pk8(o0, o1); } G8_ROWS_END
        }
    } };
struct EpiG2m { bf16_t* HC; const bf16_t* XC; const float* ngain; const float* skip; float* xs; unsigned* cnt; unsigned* tmo;
    DEV void operator()(LAS char* lds, f32x4 (&acc)[2][2][4][2], const Unit& u, int wr, int wc, int fr, int fq, int wid, int lane) const {
        asm volatile("" : "+v"(fr), "+v"(fq));
        if (__builtin_amdgcn_readfirstlane(*(volatile LAS unsigned*)(lds + (148 * 1024 - 16) + 8)) != 0u) xcd_wait_lds(lds);
        LAS float* red = (LAS float*)(lds + 131072);
        LAS float* rst = (LAS float*)(lds + 131072 + 8192);
        const int c0 = u.pn * 128 + 32 * wc + 8 * fq, tid = wid * 64 + lane;
        G8_ROWS_BEGIN const int row = u.pm * 256 + rl; float s1 = 0.f, s2 = 0.f;
            float h8[8]; un8(*(const u32x4*)(HC + (size_t)row * DM + c0), h8);
#pragma unroll
            for (int n = 0; n < 2; ++n)
#pragma unroll
                for (int j = 0; j < 4; ++j) { const float v = h8[4 * n + j] * sigmoidf_(acc[ai][0][m][n][j]); acc[ai][0][m][n][j] = v; s1 += v; s2 += v * v; }
            s1 += __shfl_xor(s1, 16); s1 += __shfl_xor(s1, 32); s2 += __shfl_xor(s2, 16); s2 += __shfl_xor(s2, 32);
            if (fq == 0) *(LAS f32x2*)(red + ((wid * 128) + 64 * ai + 16 * m + fr) * 2) = (f32x2){s1, s2}; G8_ROWS_END
        u32x4 xv[2][4];
#pragma unroll
        for (int ai = 0; ai < 2; ++ai)
#pragma unroll
            for (int m = 0; m < 4; ++m) { const int rl = 128 * ai + 64 * wr + 16 * m + fr; xv[ai][m] = *(const u32x4*)(XC + (size_t)(u.pm * 256 + rl) * DM + c0); }
        const float4 g0 = *(const float4*)(ngain + c0), g1 = *(const float4*)(ngain + c0 + 4), k0 = *(const float4*)(skip + c0), k1 = *(const float4*)(skip + c0 + 4);
        asm volatile("s_waitcnt lgkmcnt(0)" ::: "memory"); __builtin_amdgcn_s_barrier();
        float t1 = 0.f, t2 = 0.f;
        if (tid < 256) {
            const int r_ = tid, w0 = (r_ >> 6) & 1, ix = (r_ & 63) + 64 * (r_ >> 7);
#pragma unroll
            for (int w2 = 0; w2 < 4; ++w2) { const f32x2 p_ = *(const LAS f32x2*)(red + ((w0 * 4 + w2) * 128 + ix) * 2); t1 += p_.x; t2 += p_.y; }
            float* xp = xs + ((size_t)(u.pm * 256 + r_) * 8 + u.pn) * 2;
            __hip_atomic_store(xp, t1, __ATOMIC_RELAXED, __HIP_MEMORY_SCOPE_AGENT); __hip_atomic_store(xp + 1, t2, __ATOMIC_RELAXED, __HIP_MEMORY_SCOPE_AGENT);
        }
        asm volatile("s_waitcnt vmcnt(0)" ::: "memory"); __builtin_amdgcn_s_barrier();
        if (tid == 0) {
            unsigned* cp = cnt + (u.pm * 4 + (u.pn >> 1)) * 32;
            __hip_atomic_fetch_add(cp, 1u, __ATOMIC_RELAXED, __HIP_MEMORY_SCOPE_AGENT);
            unsigned sp_ = 0;
            while (__hip_atomic_load(cp, __ATOMIC_RELAXED, __HIP_MEMORY_SCOPE_AGENT) < 2u) { __builtin_amdgcn_s_sleep(1); if (++sp_ > (1u << 22)) { atomicAdd(tmo, 1u); break; } }
        }
        __builtin_amdgcn_s_barrier();
        if (tid < 256) {
            const float* xq = xs + ((size_t)(u.pm * 256 + tid) * 8 + (u.pn ^ 1)) * 2;
            t1 += __hip_atomic_load(xq, __ATOMIC_RELAXED, __HIP_MEMORY_SCOPE_AGENT); t2 += __hip_atomic_load(xq + 1, __ATOMIC_RELAXED, __HIP_MEMORY_SCOPE_AGENT);
            const float mu = t1 * (1.f / DH), rs = rsqrtf(fmaxf(t2 * (1.f / DH) - mu * mu, 0.f) + EPS);
            *(LAS f32x2*)(rst + 2 * tid) = (f32x2){mu, rs};
        }
        asm volatile("s_waitcnt vmcnt(0) lgkmcnt(0)" ::: "memory"); __builtin_amdgcn_s_barrier();
        G8_ROWS_BEGIN const int row = u.pm * 256 + rl; const f32x2 mr = *(const LAS f32x2*)(rst + 2 * rl); const float mu = mr.x, rs = mr.y;
            float x8[8]; un8(xv[ai][m], x8);
            f32x4 o0, o1;
            o0[0] = ((acc[ai][0][m][0][0] - mu) * rs * g0.x + k0.x * x8[0]) * siluf_(acc[ai][1][m][0][0]); o0[1] = ((acc[ai][0][m][0][1] - mu) * rs * g0.y + k0.y * x8[1]) * siluf_(acc[ai][1][m][0][1]);
            o0[2] = ((acc[ai][0][m][0][2] - mu) * rs * g0.z + k0.z * x8[2]) * siluf_(acc[ai][1][m][0][2]); o0[3] = ((acc[ai][0][m][0][3] - mu) * rs * g0.w + k0.w * x8[3]) * siluf_(acc[ai][1][m][0][3]);
            o1[0] = ((acc[ai][0][m][1][0] - mu) * rs * g1.x + k1.x * x8[4]) * siluf_(acc[ai][1][m][1][0]); o1[1] = ((acc[ai][0][m][1][1] - mu) * rs * g1.y + k1.y * x8[5]) * siluf_(acc[ai][1][m][1][1]);
            o1[2] = ((acc[ai][0][m][1][2] - mu) * rs * g1.z + k1.z * x8[6]) * siluf_(acc[ai][1][m][1][2]); o1[3] = ((acc[ai][0][m][1][3] - mu) * rs * g1.w + k1.w * x8[7]) * siluf_(acc[ai][1][m][1][3]);
            *(u32x4*)(HC + (size_t)row * DM + c0) = pk8(o0, o1); G8_ROWS_END
    } };
}
DEV void rstd_rows(const float* rowss, float* rstd) {
    const int tid = opaque_tid();
    for (int r = blockIdx.x * 512 + tid; r < MTOK; r += gridDim.x * 512) { float s_ = 0.f;
#pragma unroll
        for (int p_ = 0; p_ < 16; ++p_) s_ += rowss[(size_t)p_ * MTOK + r];
        rstd[r] = rsqrtf(s_ * (1.f / DM) + EPS); }
}

DEV void transpose_item(const float* W, int ldw, int ncols, bf16_t* WT, int ldwt, LAS float* scr_, int item, int lane) {
    LAS char* scr = (LAS char*)scr_;
    constexpr int RSB = 144;
    const int nblk = ncols / 64, kb = item / nblk, nb = item % nblk, k0 = 64 * kb, n0 = 64 * nb;
    float4 v[16];
#pragma unroll
    for (int i = 0; i < 16; ++i) v[i] = *(const float4*)(W + (size_t)(k0 + 4 * i + (lane >> 4)) * ldw + n0 + 4 * (lane & 15));
#pragma unroll
    for (int i = 0; i < 16; ++i) *(LAS u32x2*)(scr + (4 * i + (lane >> 4)) * RSB + (lane & 15) * 8) = (u32x2){pk2(v[i].x, v[i].y), pk2(v[i].z, v[i].w)};
    asm volatile("s_waitcnt lgkmcnt(0)" ::: "memory");
    const int i_ = lane & 15, fq = lane >> 4;
#pragma unroll
    for (int j = 0; j < 8; ++j) {
        const int nt = j & 3, kh = j >> 2;
        const LAS char* a0 = scr + (32 * kh + 8 * fq + (i_ >> 2)) * RSB + (16 * nt + 4 * (i_ & 3)) * 2;
        const s16x4 lo = __builtin_amdgcn_ds_read_tr16_b64_v4i16((LAS s16x4*)a0), hi = __builtin_amdgcn_ds_read_tr16_b64_v4i16((LAS s16x4*)(a0 + 4 * RSB));
        bf16x8 o8; o8[0] = lo[0]; o8[1] = lo[1]; o8[2] = lo[2]; o8[3] = lo[3]; o8[4] = hi[0]; o8[5] = hi[1]; o8[6] = hi[2]; o8[7] = hi[3];
        *(bf16x8*)(WT + (size_t)(n0 + 16 * nt + i_) * ldwt + k0 + 32 * kh + 8 * fq) = o8;
    }
    asm volatile("s_waitcnt lgkmcnt(0)" ::: "memory");
}

DEV float wave_scan_add(float v, int lane) {
#pragma unroll
    for (int o = 1; o < 64; o <<= 1) { const float u = __shfl_up(v, o); if (lane >= o) v += u; }
    return v;
}
DEV float wave_scan_max(float v, int lane) {
#pragma unroll
    for (int o = 1; o < 64; o <<= 1) { const float u = __shfl_up(v, o); if (lane >= o) v = fmaxf(v, u); }
    return v;
}

template <int TT>
DEV void mlstm_a_wave(LAS char* shm, const LAS char* kbuf, const bf16x8 (&qfr)[8], int fr, int fq, float m_prev, const LAS float* tpj, const LAS float* taj, f32x4 (&nacc)[3]) {
    constexpr int VT = 67584, VRS = 96, NT = TT + 1;
    const LAS char* kb = kbuf + fr * 512 + ((fq ^ (fr & 3)) << 4);
    int xo[4];
#pragma unroll
    for (int b_ = 0; b_ < 4; ++b_) xo[b_] = ((b_ ^ (fr >> 2)) << 6);
#define MLK_ADDR(jj, ks) (kb + (jj) * 8192 + ((ks) >> 2) * 256 + xo[(ks) & 3])
    f32x4 sacc[NT];
#pragma unroll
    for (int jj = 0; jj < NT; ++jj) sacc[jj] = (f32x4){0.f, 0.f, 0.f, 0.f};
    bf16x8 kf[NT];
#pragma unroll
    for (int jj = 0; jj < NT; ++jj) kf[jj] = *(const LAS bf16x8*)MLK_ADDR(jj, 0);
#pragma unroll
    for (int ks = 0; ks < 8; ++ks) {
        bf16x8 kn[NT];
#pragma unroll
        for (int jj = 0; jj < NT; ++jj) kn[jj] = kf[jj];
        if (ks < 7) {
#pragma unroll
            for (int jj = 0; jj < NT; ++jj) kn[jj] = *(const LAS bf16x8*)MLK_ADDR(jj, ks + 1);
        }
#pragma unroll
        for (int jj = 0; jj < NT; ++jj) sacc[jj] = __builtin_amdgcn_mfma_f32_16x16x32_bf16(kf[jj], qfr[ks], sacc[jj], 0, 0, 0);
#pragma unroll
        for (int jj = 0; jj < NT; ++jj) kf[jj] = kn[jj];
    }
#undef MLK_ADDR
    constexpr int NK = (TT >= 2) ? 2 : 1;
    s16x4 vlo[NK][3], vhi[NK][3];
#pragma unroll
    for (int kk = 0; kk < NK; ++kk)
#pragma unroll
        for (int vt = 0; vt < 3; ++vt) {
            vlo[kk][vt] = __builtin_amdgcn_ds_read_tr16_b64_v4i16((LAS s16x4*)(shm + VT + (32 * kk + 4 * fq + (fr >> 2)) * VRS + (16 * vt + 4 * (fr & 3)) * 2));
            vhi[kk][vt] = __builtin_amdgcn_ds_read_tr16_b64_v4i16((LAS s16x4*)(shm + VT + (32 * kk + 16 + 4 * fq + (fr >> 2)) * VRS + (16 * vt + 4 * (fr & 3)) * 2));
        }
    const int t = 16 * TT + fr;
    const float btm = -fmaxf(m_prev, tpj[t]);
    f32x4 sm[2 * NK];
#pragma unroll
    for (int jj = 0; jj < 2 * NK; ++jj) {
        if (jj < NT) {
            const f32x4 a4 = *(const LAS f32x4*)(taj + 16 * jj + 4 * fq);
#pragma unroll
            for (int r = 0; r < 4; ++r) {
                const int s_ = 16 * jj + 4 * fq + r;
                sm[jj][r] = (jj < TT || s_ <= t) ? sacc[jj < NT ? jj : 0][r] * __expf(btm + a4[r]) : 0.f;
            }
        } else sm[jj] = (f32x4){0.f, 0.f, 0.f, 0.f};
    }
#pragma unroll
    for (int kk = 0; kk < NK; ++kk) {
        const u32x4 u = (u32x4){pk2(sm[2 * kk][0], sm[2 * kk][1]), pk2(sm[2 * kk][2], sm[2 * kk][3]), pk2(sm[2 * kk + 1][0], sm[2 * kk + 1][1]), pk2(sm[2 * kk + 1][2], sm[2 * kk + 1][3])};
        const bf16x8 af = *(const bf16x8*)&u;
#pragma unroll
        for (int vt = 0; vt < 3; ++vt) {
            bf16x8 bv8; bv8[0] = vlo[kk][vt][0]; bv8[1] = vlo[kk][vt][1]; bv8[2] = vlo[kk][vt][2]; bv8[3] = vlo[kk][vt][3];
            bv8[4] = vhi[kk][vt][0]; bv8[5] = vhi[kk][vt][1]; bv8[6] = vhi[kk][vt][2]; bv8[7] = vhi[kk][vt][3];
            nacc[vt] = __builtin_amdgcn_mfma_f32_16x16x32_bf16(af, bv8, nacc[vt], 0, 0, 0);
        }
    }
}
DEV void mlstm_b_wave(LAS char* shm, const bf16x8 (&qfr)[8], int fr, int fq, f32x4 (&nacc)[3]) {
    constexpr int CB = 81408, RS = 528;
    const LAS char* cbp = shm + CB + fr * RS + fq * 16;
    bf16x8 cf[3];
#pragma unroll
    for (int vt = 0; vt < 3; ++vt) cf[vt] = *(const LAS bf16x8*)(cbp + vt * 16 * RS);
#pragma unroll
    for (int ks = 0; ks < 8; ++ks) {
        bf16x8 cn[3] = {cf[0], cf[1], cf[2]};
        if (ks < 7) {
#pragma unroll
            for (int vt = 0; vt < 3; ++vt) cn[vt] = *(const LAS bf16x8*)(cbp + vt * 16 * RS + (ks + 1) * 64);
        }
#pragma unroll
        for (int vt = 0; vt < 3; ++vt) nacc[vt] = __builtin_amdgcn_mfma_f32_16x16x32_bf16(qfr[ks], cf[vt], nacc[vt], 0, 0, 0);
#pragma unroll
        for (int vt = 0; vt < 3; ++vt) cf[vt] = cn[vt];
    }
}
DEV void mlstm_gate_scans(LAS char* shm, const float* gpart, const float* b_ig, const float* b_fg, int item) {
    const int tid = opaque_tid(), wid = __builtin_amdgcn_readfirstlane(tid >> 6), lane = tid & 63;
    constexpr int TB = 120064, TA = 128256, TP = 136448, TC = 144640;
    LAS float* tb = (LAS float*)(shm + TB); LAS float* ta = (LAS float*)(shm + TA); LAS float* tp = (LAS float*)(shm + TP); LAS float* tc = (LAS float*)(shm + TC);
    const int bh = (item & 7) + 8 * (item >> 6), h = bh & 3, b = bh >> 2;
    {
            const float big = b_ig[h], bfg = b_fg[h];
            int lane_s = lane; asm volatile("" : "+v"(lane_s));
#pragma nounroll
            for (int jh = 0; jh < 2; ++jh) {
                float gi0[2], gi1[2], gf0[2], gf1[2];
#pragma unroll
                for (int jj = 0; jj < 2; ++jj) {
                    const float* gp = gpart + (size_t)(b * SEQ + (wid + 8 * (2 * jh + jj)) * CHUNK + lane_s) * 8;
                    gi0[jj] = gp[h]; gi1[jj] = gp[(size_t)MTOK * 8 + h]; gf0[jj] = gp[4 + h]; gf1[jj] = gp[(size_t)MTOK * 8 + 4 + h];
                }
#pragma unroll
                for (int jj = 0; jj < 2; ++jj) {
                    const int j = wid + 8 * (2 * jh + jj);
                    const float ig = gi0[jj] + gi1[jj] + big;
                    const float lf = logsigmoidf_(gf0[jj] + gf1[jj] + bfg);
                    const float bc = wave_scan_add(lf, lane_s);
                    const float a_ = ig - bc;
                    const float pm = wave_scan_max(a_, lane_s);
                    tb[j * 64 + lane_s] = bc; ta[j * 64 + lane_s] = a_; tp[j * 64 + lane_s] = pm;
                    if (lane_s == 63) { tc[2 * j] = bc; tc[2 * j + 1] = pm; }
                }
            }
    }
}
template <int SKIP>
DEV void mlstm_phase(LAS char* shm, const bf16_t* q, const bf16_t* k, const bf16_t* v, const float* gpart, const float* b_ig, const float* b_fg, bf16_t* hc, const bool pre) {
    const int tid = opaque_tid(), wid = __builtin_amdgcn_readfirstlane(tid >> 6), lane = tid & 63, fr = lane & 15, fq = lane >> 4;
    constexpr int VT = 67584, VWT = 74496, CB = 81408, PART = 106752, TB = 120064, TA = 128256, TP = 136448, TC = 144640, HST = 144896, RS = 528, VRS = 96, PRS = 52;
    LAS float* part = (LAS float*)(shm + PART);
    LAS float* tb = (LAS float*)(shm + TB); LAS float* ta = (LAS float*)(shm + TA); LAS float* tp = (LAS float*)(shm + TP); LAS float* tc = (LAS float*)(shm + TC);
    for (int item = blockIdx.x; item < BATCH * NH * 8; item += gridDim.x) {
        const int vs = (item >> 3) & 7, bh = (item & 7) + 8 * (item >> 6), h = bh & 3, b = bh >> 2;
        const size_t cb0 = ((size_t)(b * SEQ)) * DM + h * DH;
        __syncthreads();
        unsigned kvoff; { const int rw = 2 * wid + (lane >> 5); kvoff = (unsigned)(rw * DM + (((lane & 31) ^ rw) * 8)) * 2u; asm volatile("" : "+v"(kvoff)); }
#define MLK_ISSUE(chunk_off_elems, buf) do { const char* kg_ = (const char*)(k + (chunk_off_elems)); _Pragma("unroll") for (int i_ = 0; i_ < 4; ++i_) \
            __builtin_amdgcn_global_load_lds((const unsigned*)(kg_ + kvoff + (size_t)i_ * 16 * DM * 2), (LAS unsigned*)(shm + (buf) * 32768 + (i_ * 8 + wid) * 1024), 16, 0, 0); } while (0)
        MLK_ISSUE(cb0, 0);
        bf16x8 qfr[8];
        const bf16_t* qfb = q + ((size_t)((b * 4 + h) * 32) * 4 + (wid & 3)) * 4096 + lane * 8;
#pragma unroll
        for (int ks = 0; ks < 8; ++ks) qfr[ks] = *(const bf16x8*)(qfb + ks * 512);
        uint4 vv = make_uint4(0, 0, 0, 0);
        if (wid < 4) vv = *(const uint4*)(v + cb0 + (size_t)(tid >> 2) * DM + vs * 32 + (tid & 3) * 8);
        for (int i = tid; i < (CB + 25344 - VT) / 4; i += 512) ((LAS unsigned*)(shm + VT))[i] = 0u;
        if (!(pre && item == (int)blockIdx.x)) mlstm_gate_scans(shm, gpart, b_ig, b_fg, item);
        __syncthreads();
        if (wid == 0) *(LAS unsigned*)(shm + VT + tid * VRS + 64) = 0x3F80u;
        const int ndt = (wid == 0 || wid == 4 || wid == 1) ? 3 : ((wid == 5 || wid == 2) ? 2 : 1);
        const int dt0 = (wid == 0) ? 0 : (wid == 4) ? 3 : (wid == 1) ? 6 : (wid == 5) ? 9 : (wid == 2) ? 11 : (wid == 6) ? 13 : (wid == 3) ? 14 : 15;
        f32x4 cacc[3][3];
#pragma unroll
        for (int i = 0; i < 3; ++i)
#pragma unroll
            for (int vt = 0; vt < 3; ++vt) cacc[i][vt] = (f32x4){0.f, 0.f, 0.f, 0.f};
        float m_prev = 0.f;
#pragma nounroll
        for (int j = 0; j < SEQ / CHUNK; ++j) {
            const size_t cb = cb0 + (size_t)j * CHUNK * DM;
            const float btot = __int_as_float(__builtin_amdgcn_readfirstlane(__float_as_int(tc[2 * j]))), amax = __int_as_float(__builtin_amdgcn_readfirstlane(__float_as_int(tc[2 * j + 1])));
            const float mxc = __int_as_float(__builtin_amdgcn_readfirstlane(__float_as_int(fmaxf(m_prev, amax))));
            const LAS char* kbuf = shm + ((j & 1) << 15);
            if (wid < 4) asm volatile("s_waitcnt vmcnt(1)" ::: "memory");
            else asm volatile("s_waitcnt vmcnt(0)" ::: "memory");
            if (wid < 4) {
                const int s_ = tid >> 2, v0 = (tid & 3) * 8;
                const float ws = __expf(ta[j * 64 + s_] - mxc);
                float f8[8]; unpack8(vv, f8);
#pragma unroll
                for (int e = 0; e < 8; ++e) f8[e] *= ws;
                const uint4 wv = pack8(f8);
                *(LAS u32x4*)(shm + VT + s_ * VRS + v0 * 2) = (u32x4){vv.x, vv.y, vv.z, vv.w};
                *(LAS u32x4*)(shm + VWT + s_ * VRS + v0 * 2) = (u32x4){wv.x, wv.y, wv.z, wv.w};
            } else if (wid == 4) {
                const int s_ = tid - 256;
                *(LAS u32x4*)(shm + VWT + s_ * VRS + 64) = (u32x4){(unsigned)f2bf(__expf(ta[j * 64 + s_] - mxc)), 0u, 0u, 0u};
            }
            bf16x8 qnx[8];
#pragma unroll
            for (int ks = 0; ks < 8; ++ks) qnx[ks] = qfr[ks];
            if (j + 1 < SEQ / CHUNK) {
                const size_t cn = cb + (size_t)CHUNK * DM;
                MLK_ISSUE(cn, (j + 1) & 1);
#pragma unroll
                for (int ks = 0; ks < 8; ++ks) qnx[ks] = *(const bf16x8*)(qfb + (size_t)(j + 1) * 16384 + ks * 512);
                if (wid < 4) vv = *(const uint4*)(v + cn + (size_t)(tid >> 2) * DM + vs * 32 + (tid & 3) * 8);
            }
            asm volatile("s_waitcnt lgkmcnt(0)\n\ts_barrier" ::: "memory");
            f32x4 nacc[3];
#pragma unroll
            for (int vt = 0; vt < 3; ++vt) nacc[vt] = (f32x4){0.f, 0.f, 0.f, 0.f};
            const int tt = wid & 3;
            if (wid < 4) { if (!(SKIP & 1)) {
                const LAS float* tpj = tp + j * 64; const LAS float* taj = ta + j * 64;
                if (tt == 0) mlstm_a_wave<0>(shm, kbuf, qfr, fr, fq, m_prev, tpj, taj, nacc);
                else if (tt == 1) mlstm_a_wave<1>(shm, kbuf, qfr, fr, fq, m_prev, tpj, taj, nacc);
                else if (tt == 2) mlstm_a_wave<2>(shm, kbuf, qfr, fr, fq, m_prev, tpj, taj, nacc);
                else mlstm_a_wave<3>(shm, kbuf, qfr, fr, fq, m_prev, tpj, taj, nacc);
            } } else if (!(SKIP & 2)) {
                mlstm_b_wave(shm, qfr, fr, fq, nacc);
                const f32x4 pm4 = *(const LAS f32x4*)(tp + j * 64 + 16 * tt + 4 * fq);
#pragma unroll
                for (int vt = 0; vt < 3; ++vt)
#pragma unroll
                    for (int r = 0; r < 4; ++r) part[(16 * tt + 4 * fq + r) * PRS + 16 * vt + fr] = __expf(m_prev - fmaxf(m_prev, pm4[r])) * nacc[vt][r];
            }
            if (!(SKIP & 4)) {
                const float decay = __expf(m_prev - mxc);
#pragma unroll
                for (int i = 0; i < 3; ++i)
#pragma unroll
                    for (int vt = 0; vt < 3; ++vt) cacc[i][vt] *= decay;
                const int q_ = fr >> 2, p_ = fr & 3;
                s16x4 wl[2][3], wh[2][3];
#pragma unroll
                for (int kk = 0; kk < 2; ++kk)
#pragma unroll
                    for (int vt = 0; vt < 3; ++vt) {
                        wl[kk][vt] = __builtin_amdgcn_ds_read_tr16_b64_v4i16((LAS s16x4*)(shm + VWT + (32 * kk + 8 * fq + q_) * VRS + (16 * vt + 4 * p_) * 2));
                        wh[kk][vt] = __builtin_amdgcn_ds_read_tr16_b64_v4i16((LAS s16x4*)(shm + VWT + (32 * kk + 8 * fq + 4 + q_) * VRS + (16 * vt + 4 * p_) * 2));
                    }
                bf16x8 bfv[2][3];
#pragma unroll
                for (int kk = 0; kk < 2; ++kk)
#pragma unroll
                    for (int vt = 0; vt < 3; ++vt) { bfv[kk][vt][0] = wl[kk][vt][0]; bfv[kk][vt][1] = wl[kk][vt][1]; bfv[kk][vt][2] = wl[kk][vt][2]; bfv[kk][vt][3] = wl[kk][vt][3];
                        bfv[kk][vt][4] = wh[kk][vt][0]; bfv[kk][vt][5] = wh[kk][vt][1]; bfv[kk][vt][6] = wh[kk][vt][2]; bfv[kk][vt][7] = wh[kk][vt][3]; }
                const int rl_ = 8 * fq + q_, rh_ = rl_ + 4;
#pragma unroll
                for (int i = 0; i < 3; ++i) {
                    if (i < ndt) {
                        const int un = 2 * (dt0 + i) + (p_ >> 1);
                        s16x4 kl[2], kh[2];
#pragma unroll
                        for (int kk = 0; kk < 2; ++kk) {
                            kl[kk] = __builtin_amdgcn_ds_read_tr16_b64_v4i16((LAS s16x4*)(kbuf + (32 * kk + rl_) * 512 + ((un ^ (rl_ & 15)) << 4) + (p_ & 1) * 8));
                            kh[kk] = __builtin_amdgcn_ds_read_tr16_b64_v4i16((LAS s16x4*)(kbuf + (32 * kk + rh_) * 512 + ((un ^ (rh_ & 15)) << 4) + (p_ & 1) * 8));
                        }
#pragma unroll
                        for (int kk = 0; kk < 2; ++kk) {
                            bf16x8 af; af[0] = kl[kk][0]; af[1] = kl[kk][1]; af[2] = kl[kk][2]; af[3] = kl[kk][3]; af[4] = kh[kk][0]; af[5] = kh[kk][1]; af[6] = kh[kk][2]; af[7] = kh[kk][3];
#pragma unroll
                            for (int vt = 0; vt < 3; ++vt) cacc[i][vt] = __builtin_amdgcn_mfma_f32_16x16x32_bf16(af, bfv[kk][vt], cacc[i][vt], 0, 0, 0);
                        }
                    }
                }
            }
            asm volatile("s_waitcnt lgkmcnt(0)\n\ts_barrier" ::: "memory");
            if (wid < 4 && !(SKIP & 16)) {
                const f32x4 pm4 = *(const LAS f32x4*)(tp + j * 64 + 16 * tt + 4 * fq);
                const f32x4 bc4 = *(const LAS f32x4*)(tb + j * 64 + 16 * tt + 4 * fq);
#pragma unroll
                for (int vt = 0; vt < 3; ++vt)
#pragma unroll
                    for (int r = 0; r < 4; ++r) nacc[vt][r] += part[(16 * tt + 4 * fq + r) * PRS + 16 * vt + fr];
#pragma unroll
                for (int r = 0; r < 4; ++r) {
                    const float den = __shfl(nacc[2][r], lane & 48);
                    const float inv = __builtin_amdgcn_rcpf(fmaxf(fabsf(den), __expf(-(bc4[r] + fmaxf(m_prev, pm4[r])))));
                    LAS bf16_t* hrow = (LAS bf16_t*)(shm + HST + (16 * tt + 4 * fq + r) * 80);
                    hrow[fr] = f2bf(nacc[0][r] * inv);
                    hrow[16 + fr] = f2bf(nacc[1][r] * inv);
                }
                asm volatile("s_waitcnt lgkmcnt(0)" ::: "memory");
                {
                    const int rw = 16 * tt + (lane >> 2), pc = lane & 3;
                    const u32x4 hv = *(const LAS u32x4*)(shm + HST + rw * 80 + pc * 16);
                    *(uint4*)(hc + cb + (size_t)rw * DM + vs * 32 + pc * 8) = make_uint4(hv[0], hv[1], hv[2], hv[3]);
                }
            }
#pragma unroll
            for (int i = 0; i < 3; ++i)
                if (i < ndt) {
#pragma unroll
                    for (int vt = 0; vt < 3; ++vt) {
                        u32x2 o; o[0] = pk2(cacc[i][vt][0], cacc[i][vt][1]); o[1] = pk2(cacc[i][vt][2], cacc[i][vt][3]);
                        *(LAS u32x2*)(shm + CB + (16 * vt + fr) * RS + (16 * (dt0 + i) + 4 * fq) * 2) = o;
                    }
                }
            m_prev = __int_as_float(__builtin_amdgcn_readfirstlane(__float_as_int(btot + mxc)));
#pragma unroll
            for (int ks = 0; ks < 8; ++ks) qfr[ks] = qnx[ks];
        }
        asm volatile("s_waitcnt vmcnt(0)" ::: "memory");
#undef MLK_ISSUE
    }
}

constexpr int S5L = 32, S5NCH = SEQ / S5L;
constexpr size_t T_KT_OFF = 0, T_WS_OFF = 2u << 20, T_V_OFF = 10u << 20, T_AL_OFF = 18u << 20;
constexpr int KT_G = 33 * 256, WS_G = 128 * 512, V_G = 512 * 128;

DEV void s5_tables(LAS char* shm, char* tab, const float* lam_re, const float* lam_im, const float* log_dt, const float* b_re, const float* b_im,
                   const float* c_re, const float* c_im) {
    const int tid = opaque_tid();
    LAS f32x2* apw = (LAS f32x2*)shm;
    LAS f32x2* bb = (LAS f32x2*)(shm + 64 * 33 * 8);
    LAS f32x2* cc = (LAS f32x2*)(shm + 64 * 33 * 8 + 8192);
    LAS f32x2* crv = (LAS f32x2*)(shm + 64 * 33 * 8 + 16384);
    bf16_t* KT = (bf16_t*)(tab + T_KT_OFF); bf16_t* WS = (bf16_t*)(tab + T_WS_OFF); bf16_t* VV = (bf16_t*)(tab + T_V_OFF); float2* AL = (float2*)(tab + T_AL_OFF);
    for (int it = blockIdx.x; it < 256; it += gridDim.x) {
        const int g = it & 63, qd = it >> 6;
        __syncthreads();
        {
            const int pp = tid & 63, eg = tid >> 6;
            const float lr = lam_re[g * NP + pp], li = lam_im[g * NP + pp], dt = expf(log_dt[g]);
            const float xr = lr * dt, xi = li * dt;
#pragma unroll
            for (int k = 0; k < 5; ++k) {
                const int e = eg + 8 * k;
                if (e <= 32) {
                    const float m_ = expf((float)e * xr); float sn, cs; sincosf((float)e * xi, &sn, &cs);
                    apw[pp * 33 + e] = (f32x2){m_ * cs, m_ * sn};
                    if (e == 32 && qd == 0) AL[g * NP + pp] = make_float2(m_ * cs, m_ * sn);
                }
            }
            if (eg == 0) {
                float sn, cs; sincosf(xi, &sn, &cs); const float sh = sinf(0.5f * xi);
                const float dr = expm1f(xr) * cs - 2.f * sh * sh, di = expf(xr) * sn, den = lr * lr + li * li;
                crv[pp] = (f32x2){(dr * lr + di * li) / den, (di * lr - dr * li) / den};
            }
#pragma unroll
            for (int e = 0; e < 2; ++e) { const int o = tid + 512 * e, c = o >> 6, p2 = o & 63;
                cc[p2 * 16 + c] = (f32x2){c_re[(g * GC + c) * NP + p2], c_im[(g * GC + c) * NP + p2]}; }
        }
        __syncthreads();
        for (int o = tid; o < 1024; o += 512) {
            const int pp = o >> 4, c = o & 15; const f32x2 z = crv[pp];
            const float br = b_re[(g * NP + pp) * GC + c], bi = b_im[(g * NP + pp) * GC + c];
            bb[pp * 16 + c] = (f32x2){z.x * br - z.y * bi, z.x * bi + z.y * br};
        }
        __syncthreads();
        {
            const int pq = tid & 3, blk = tid >> 2, d = 8 * qd + (blk >> 4), c1b = (blk >> 2) & 3, c0b = blk & 3;
            float acc[4][4];
#pragma unroll
            for (int i = 0; i < 4; ++i)
#pragma unroll
                for (int j = 0; j < 4; ++j) acc[i][j] = 0.f;
#pragma unroll 4
            for (int k = 0; k < 16; ++k) {
                const int pp = 4 * k + pq;
                const f32x2 a = apw[pp * 33 + d];
                const f32x4 b01 = *(const LAS f32x4*)&bb[pp * 16 + 4 * c0b], b23 = *(const LAS f32x4*)&bb[pp * 16 + 4 * c0b + 2];
                const f32x4 c01 = *(const LAS f32x4*)&cc[pp * 16 + 4 * c1b], c23 = *(const LAS f32x4*)&cc[pp * 16 + 4 * c1b + 2];
                const float bx[4] = {b01[0], b01[2], b23[0], b23[2]}, by[4] = {b01[1], b01[3], b23[1], b23[3]};
                const float cx[4] = {c01[0], c01[2], c23[0], c23[2]}, cy[4] = {c01[1], c01[3], c23[1], c23[3]};
#pragma unroll
                for (int j = 0; j < 4; ++j) {
                    const float mr = a.x * bx[j] - a.y * by[j], mi = a.x * by[j] + a.y * bx[j];
#pragma unroll
                    for (int i = 0; i < 4; ++i) acc[i][j] += cx[i] * mr - cy[i] * mi;
                }
            }
#pragma unroll
            for (int i = 0; i < 4; ++i)
#pragma unroll
                for (int j = 0; j < 4; ++j) { acc[i][j] += __shfl_xor(acc[i][j], 1); acc[i][j] += __shfl_xor(acc[i][j], 2); }
            float r4[4];
#pragma unroll
            for (int j = 0; j < 4; ++j) r4[j] = (pq == 0) ? acc[0][j] : (pq == 1) ? acc[1][j] : (pq == 2) ? acc[2][j] : acc[3][j];
            *(uint2*)(KT + (size_t)g * KT_G + (d + 1) * 256 + (4 * c1b + pq) * 16 + 4 * c0b) = make_uint2(pk2(r4[0], r4[1]), pk2(r4[2], r4[3]));
        }
        if (qd == 0 && tid < 256) KT[(size_t)g * KT_G + tid] = 0;
        for (int o = tid; o < 2 * 16 * 64; o += 512) {
            const int mt = 2 * qd + (o >> 10), sp = (o >> 6) & 15, ln = o & 63;
            const int row = 16 * mt + (ln & 15), ri = row >> 6, pp = row & 63, s_ = 2 * sp + (ln >> 5), c0 = 8 * ((ln >> 4) & 1);
            const f32x2 a = apw[pp * 33 + 31 - s_];
            unsigned w[4];
#pragma unroll
            for (int jj = 0; jj < 8; jj += 2) {
                const f32x2 b0 = bb[pp * 16 + c0 + jj], b1 = bb[pp * 16 + c0 + jj + 1];
                const float v0 = ri ? (a.x * b0.y + a.y * b0.x) : (a.x * b0.x - a.y * b0.y);
                const float v1 = ri ? (a.x * b1.y + a.y * b1.x) : (a.x * b1.x - a.y * b1.y);
                w[jj >> 1] = pk2(v0, v1);
            }
            *(uint4*)(WS + (size_t)g * WS_G + ((size_t)(mt * 16 + sp) * 64 + ln) * 8) = make_uint4(w[0], w[1], w[2], w[3]);
        }
        for (int o = tid; o < 8 * 4 * 64; o += 512) {
            const int i = 8 * qd + (o >> 8), ks = (o >> 6) & 3, ln = o & 63;
            const int c1 = ln & 15, k0 = 32 * ks + 8 * (ln >> 4);
            unsigned w[4];
#pragma unroll
            for (int jj = 0; jj < 8; jj += 2) {
                float v[2];
#pragma unroll
                for (int e = 0; e < 2; ++e) {
                    const int kk = k0 + jj + e, ri = kk >> 6, pp = kk & 63;
                    const f32x2 a = apw[pp * 33 + i + 1], c = cc[pp * 16 + c1];
                    v[e] = ri ? -(c.x * a.y + c.y * a.x) : (c.x * a.x - c.y * a.y);
                }
                w[jj >> 1] = pk2(v[0], v[1]);
            }
            *(uint4*)(VV + (size_t)g * V_G + ((size_t)(i * 4 + ks) * 64 + ln) * 8) = make_uint4(w[0], w[1], w[2], w[3]);
        }
    }
}

template <int NQ>
DEV void s5_p1_range(LAS char* shm, int lo, int hi, int wid, int fr, int fq, const bf16_t* wsp, f32x4 (&acc)[4][4], f32x4 (&sac)[4]) {
    constexpr int PLANE = 64 * 528, KTL = 2 * PLANE, Q0 = 4 - NQ;
    if (lo > hi) return;
    const LAS char* ub = shm + (fq & 1) * PLANE + fr * 528 + (fq >> 1) * 16;
    const LAS char* kb = shm + KTL + (1 - (fq >> 1)) * 512 + fr * 32 + (fq & 1) * 16;
    bf16x8 bu[4], kf[NQ], wcur;
#pragma unroll
    for (int nt = 0; nt < 4; ++nt) bu[nt] = *(const LAS bf16x8*)(ub + nt * 16 * 528 + lo * 32);
#pragma unroll
    for (int q = 0; q < NQ; ++q) kf[q] = *(const LAS bf16x8*)(kb + (wid + 8 * (Q0 + q) - 2 * lo) * 512);
    wcur = *(const bf16x8*)(wsp + (size_t)lo * 64 * 8);
#pragma nounroll
    for (int sp = lo; sp <= hi; ++sp) {
        bf16x8 bn[4], kn[NQ], wn = wcur;
        const int sn = (sp < hi) ? sp + 1 : sp;
#pragma unroll
        for (int nt = 0; nt < 4; ++nt) bn[nt] = *(const LAS bf16x8*)(ub + nt * 16 * 528 + sn * 32);
#pragma unroll
        for (int q = 0; q < NQ; ++q) kn[q] = *(const LAS bf16x8*)(kb + (wid + 8 * (Q0 + q) - 2 * sn) * 512);
        wn = *(const bf16x8*)(wsp + (size_t)sn * 64 * 8);
#pragma unroll
        for (int nt = 0; nt < 4; ++nt) sac[nt] = __builtin_amdgcn_mfma_f32_16x16x32_bf16(wcur, bu[nt], sac[nt], 0, 0, 0);
#pragma unroll
        for (int q = 0; q < NQ; ++q)
#pragma unroll
            for (int nt = 0; nt < 4; ++nt) acc[Q0 + q][nt] = __builtin_amdgcn_mfma_f32_16x16x32_bf16(kf[q], bu[nt], acc[Q0 + q][nt], 0, 0, 0);
#pragma unroll
        for (int nt = 0; nt < 4; ++nt) bu[nt] = bn[nt];
#pragma unroll
        for (int q = 0; q < NQ; ++q) kf[q] = kn[q];
        wcur = wn;
    }
}
template <int H2>
DEV void s5_p1_all(LAS char* shm, int wid, int fr, int fq, bf16x8 (&wfr)[8], const bf16_t* wsp, f32x4 (&acc)[4][4], f32x4 (&sac)[4]) {
    constexpr int PLANE = 64 * 528, KTL = 2 * PLANE;
    const LAS char* ub = shm + (fq & 1) * PLANE + fr * 528 + (fq >> 1) * 16;
    const LAS char* kb = shm + KTL + (1 - (fq >> 1)) * 512 + fr * 32 + (fq & 1) * 16 + (wid - 30) * 512;
#define S5_Q0(sp_) (((sp_) <= H2) ? 0 : ((sp_) - H2 + 3) / 4)
    bf16x8 bu[4];
#pragma unroll
    for (int nt = 0; nt < 4; ++nt) bu[nt] = *(const LAS bf16x8*)(ub + nt * 16 * 528);
#pragma unroll
    for (int sp = 0; sp < 16; ++sp) {
        bf16x8 bn[4], kf[4];
#pragma unroll
        for (int q = 0; q < 4; ++q) if (q >= S5_Q0(sp)) kf[q] = *(const LAS bf16x8*)(kb + (8 * q - 2 * sp + 30) * 512);
#pragma unroll
        for (int nt = 0; nt < 4; ++nt) bn[nt] = bu[nt];
        if (sp < 15) {
#pragma unroll
            for (int nt = 0; nt < 4; ++nt) bn[nt] = *(const LAS bf16x8*)(ub + nt * 16 * 528 + (sp + 1) * 32);
        }
#pragma unroll
        for (int nt = 0; nt < 4; ++nt) sac[nt] = __builtin_amdgcn_mfma_f32_16x16x32_bf16(wfr[sp & 7], bu[nt], sac[nt], 0, 0, 0);
        if (sp < 8) wfr[sp & 7] = *(const bf16x8*)(wsp + (size_t)(sp + 8) * 64 * 8);
#pragma unroll
        for (int q = 0; q < 4; ++q) {
            if (q >= S5_Q0(sp)) {
#pragma unroll
                for (int nt = 0; nt < 4; ++nt) acc[q][nt] = __builtin_amdgcn_mfma_f32_16x16x32_bf16(kf[q], bu[nt], acc[q][nt], 0, 0, 0);
            }
        }
#pragma unroll
        for (int nt = 0; nt < 4; ++nt) bu[nt] = bn[nt];
        __builtin_amdgcn_sched_barrier(0);
    }
#undef S5_Q0
}
DEV void s5_phase(LAS char* shm, const bf16_t* Uin, bf16_t* Yout, const char* tab, const float* dskip) {
    constexpr int PLANE = 64 * 528, KTL = 2 * PLANE, SL = KTL + 33 * 512, HB = SL + 64 * 528, SRS = 528, HRS = 272, TSEG = HB + 64 * 272;
    const bf16_t* KT = (const bf16_t*)(tab + T_KT_OFF); const bf16_t* WS = (const bf16_t*)(tab + T_WS_OFF); const bf16_t* VV = (const bf16_t*)(tab + T_V_OFF);
    const float2* AL = (const float2*)(tab + T_AL_OFF);
    for (int item = blockIdx.x; item < BATCH * NG; item += gridDim.x) {
        const int tid = opaque_tid(), wid = __builtin_amdgcn_readfirstlane(tid >> 6), lane = tid & 63, fr = lane & 15, fq = lane >> 4;
        const int xcd_ = item & 7, j_ = (item >> 3) & 31, g = xcd_ * 8 + (j_ & 7), b = (j_ >> 3) + 4 * (item >> 8);
        const bf16_t* Ub = Uin + ((size_t)g * MTOK + (size_t)b * SEQ) * 16;
        bf16_t* Yb = Yout + ((size_t)g * MTOK + (size_t)b * SEQ) * 16;
        bf16x8 wfr[8];
        const bf16_t* wsp = WS + (size_t)g * WS_G + ((size_t)(wid * 16) * 64 + lane) * 8; asm volatile("" : "+v"(wsp));
#pragma unroll
        for (int sp = 0; sp < 8; ++sp) wfr[sp] = *(const bf16x8*)(wsp + (size_t)sp * 64 * 8);
        __syncthreads();
#pragma unroll
        for (int i = 0; i < 8; ++i) {
            const int idx = tid + 512 * i, tok = idx >> 1, hf = idx & 1;
            const uint4 uv = *(const uint4*)(Ub + (size_t)tok * 16 + hf * 8);
            *(LAS u32x4*)(shm + hf * PLANE + (tok >> 5) * 528 + (tok & 31) * 16) = (u32x4){uv.x, uv.y, uv.z, uv.w};
        }
        for (int idx = tid; idx < 33 * 32; idx += 512) {
            const uint4 kv = *(const uint4*)(KT + (size_t)g * KT_G + idx * 8);
            *(LAS u32x4*)(shm + KTL + idx * 16) = (u32x4){kv.x, kv.y, kv.z, kv.w};
        }
        __syncthreads();
        f32x4 acc[4][4], sac[4];
#pragma unroll
        for (int q = 0; q < 4; ++q)
#pragma unroll
            for (int nt = 0; nt < 4; ++nt) acc[q][nt] = (f32x4){0.f, 0.f, 0.f, 0.f};
#pragma unroll
        for (int nt = 0; nt < 4; ++nt) sac[nt] = (f32x4){0.f, 0.f, 0.f, 0.f};
        {
            const int h2 = wid >> 1;
            if (h2 == 0) s5_p1_all<0>(shm, wid, fr, fq, wfr, wsp, acc, sac);
            else if (h2 == 1) s5_p1_all<1>(shm, wid, fr, fq, wfr, wsp, acc, sac);
            else if (h2 == 2) s5_p1_all<2>(shm, wid, fr, fq, wfr, wsp, acc, sac);
            else s5_p1_all<3>(shm, wid, fr, fq, wfr, wsp, acc, sac);
        }
        const float2 al = AL[g * NP + lane];
        const float4 dsk = *(const float4*)(dskip + g * GC + 4 * fq);
        const bf16_t* vvp = VV + (size_t)g * V_G + ((size_t)(wid * 4) * 64 + lane) * 8; asm volatile("" : "+v"(vvp));
        bf16x8 va[4][4];
#pragma unroll
        for (int q = 0; q < 4; ++q)
#pragma unroll
            for (int ks = 0; ks < 4; ++ks) va[q][ks] = *(const bf16x8*)(vvp + ((size_t)((8 * q) * 4 + ks) * 64) * 8);
#pragma unroll
        for (int nt = 0; nt < 4; ++nt) *(LAS f32x4*)(shm + SL + (16 * nt + fr) * SRS + (16 * wid + 4 * fq) * 4) = sac[nt];
        __syncthreads();
        {
            float hr = 0.f, hi = 0.f, lr[8], li[8];
#pragma unroll
            for (int n = 0; n < 8; ++n) {
                lr[n] = hr; li[n] = hi;
                const float sr = *(const LAS float*)(shm + SL + (8 * wid + n) * SRS + lane * 4), si = *(const LAS float*)(shm + SL + (8 * wid + n) * SRS + (64 + lane) * 4);
                const float nr = al.x * hr - al.y * hi + sr, ni = al.x * hi + al.y * hr + si; hr = nr; hi = ni;
            }
            *(LAS float*)(shm + TSEG + (wid * 128 + lane) * 4) = hr; *(LAS float*)(shm + TSEG + (wid * 128 + 64 + lane) * 4) = hi;
            float pr = al.x, pi = al.y;
#pragma unroll
            for (int e = 0; e < 3; ++e) { const float nr = pr * pr - pi * pi, ni = 2.f * pr * pi; pr = nr; pi = ni; }
            __syncthreads();
            float cr = 0.f, ci = 0.f;
            for (int w2 = 0; w2 < wid; ++w2) {
                const float tr = *(const LAS float*)(shm + TSEG + (w2 * 128 + lane) * 4), ti = *(const LAS float*)(shm + TSEG + (w2 * 128 + 64 + lane) * 4);
                const float nr = pr * cr - pi * ci + tr, ni = pr * ci + pi * cr + ti; cr = nr; ci = ni;
            }
            float qr = 1.f, qi = 0.f;
#pragma unroll
            for (int n = 0; n < 8; ++n) {
                const float fr_ = lr[n] + qr * cr - qi * ci, fi_ = li[n] + qr * ci + qi * cr;
                *(LAS bf16_t*)(shm + HB + (8 * wid + n) * HRS + lane * 2) = f2bf(fr_);
                *(LAS bf16_t*)(shm + HB + (8 * wid + n) * HRS + (64 + lane) * 2) = f2bf(fi_);
                const float nr = qr * al.x - qi * al.y, ni = qr * al.y + qi * al.x; qr = nr; qi = ni;
            }
        }
        __syncthreads();
#pragma unroll
        for (int ks = 0; ks < 4; ++ks) {
            bf16x8 hb[4];
#pragma unroll
            for (int nt = 0; nt < 4; ++nt) hb[nt] = *(const LAS bf16x8*)(shm + HB + (16 * nt + fr) * HRS + (32 * ks + 8 * fq) * 2);
#pragma unroll
            for (int q = 0; q < 4; ++q)
#pragma unroll
                for (int nt = 0; nt < 4; ++nt) acc[q][nt] = __builtin_amdgcn_mfma_f32_16x16x32_bf16(va[q][ks], hb[nt], acc[q][nt], 0, 0, 0);
        }
#pragma unroll
        for (int q = 0; q < 4; ++q) {
            const int i = wid + 8 * q;
#pragma unroll
            for (int nt = 0; nt < 4; ++nt) {
                const int n = 16 * nt + fr;
                const u32x2 uu = *(const LAS u32x2*)(shm + (fq >> 1) * PLANE + n * 528 + i * 16 + ((4 * fq) & 7) * 2);
                f32x4 o;
                o[0] = geluf_(acc[q][nt][0] + dsk.x * bf2f((bf16_t)(uu[0] & 0xffff))); o[1] = geluf_(acc[q][nt][1] + dsk.y * bf2f((bf16_t)(uu[0] >> 16)));
                o[2] = geluf_(acc[q][nt][2] + dsk.z * bf2f((bf16_t)(uu[1] & 0xffff))); o[3] = geluf_(acc[q][nt][3] + dsk.w * bf2f((bf16_t)(uu[1] >> 16)));
                *(uint2*)(Yb + (size_t)(n * 32 + i) * 16 + 4 * fq) = pack4(o);
            }
        }
    }
}


DEV void norm_rows(const float* x, const float* gain, const float* modl, bf16_t* h) {
    const int tid = opaque_tid(), lane = tid & 63, gw = blockIdx.x * 8 + (tid >> 6), NGW = gridDim.x * 8;
    float4 g[4];
#pragma unroll
    for (int j = 0; j < 4; ++j) g[j] = *(const float4*)(gain + 4 * lane + 256 * j);
    for (int m0 = gw * 2; m0 < MTOK; m0 += NGW * 2) {
        float4 v[2][4], sc[4], sh[4]; float ss[2] = {0.f, 0.f};
        const float* shift = modl + (size_t)(m0 / SEQ) * 3 * DM; const float* scale = shift + DM;
#pragma unroll
        for (int r = 0; r < 2; ++r) { const float4* xr = (const float4*)(x + (size_t)(m0 + r) * DM) + lane;
#pragma unroll
            for (int j = 0; j < 4; ++j) v[r][j] = xr[64 * j]; }
#pragma unroll
        for (int j = 0; j < 4; ++j) { sc[j] = *(const float4*)(scale + 4 * lane + 256 * j); sh[j] = *(const float4*)(shift + 4 * lane + 256 * j); }
#pragma unroll
        for (int r = 0; r < 2; ++r) {
#pragma unroll
            for (int j = 0; j < 4; ++j) ss[r] += v[r][j].x * v[r][j].x + v[r][j].y * v[r][j].y + v[r][j].z * v[r][j].z + v[r][j].w * v[r][j].w;
            const float rstd = rsqrtf(wave_sum(ss[r]) * (1.f / DM) + EPS);
            const int m = m0 + r;
#pragma unroll
            for (int j = 0; j < 4; ++j) {
                const int n = 4 * lane + 256 * j;
                f32x4 o; o[0] = v[r][j].x * rstd * g[j].x * (1.f + sc[j].x) + sh[j].x; o[1] = v[r][j].y * rstd * g[j].y * (1.f + sc[j].y) + sh[j].y;
                o[2] = v[r][j].z * rstd * g[j].z * (1.f + sc[j].z) + sh[j].z; o[3] = v[r][j].w * rstd * g[j].w * (1.f + sc[j].w) + sh[j].w;
                *(uint2*)(h + (size_t)m * DM + n) = pack4(o);
            }
        }
    }
}
DEV void mod_phase(LAS char* shm, const float* c, const float* w_mod, const float* b_mod, float* mod, unsigned* modcnt) {
    const int tid = opaque_tid();
    LAS float* sc = (LAS float*)shm;
    LAS float* pr = (LAS float*)(shm + 32768);
    if ((int)blockIdx.x >= 192) return;
    __syncthreads();
    {
        float cv[16];
#pragma unroll
        for (int i = 0; i < 16; ++i) cv[i] = c[tid + 512 * i];
#pragma unroll
        for (int i = 0; i < 16; ++i) sc[tid + 512 * i] = siluf_(cv[i]);
    }
    __syncthreads();
    for (int it = blockIdx.x; it < 192; it += gridDim.x) {
        const int l = it / 96, n0 = (it % 96) * 32, cq = tid & 7, kg = tid >> 3;
        const float* W = w_mod + (size_t)l * DM * 3 * DM + n0 + 4 * cq;
        float acc[BATCH][4];
#pragma unroll
        for (int b = 0; b < BATCH; ++b) { acc[b][0] = acc[b][1] = acc[b][2] = acc[b][3] = 0.f; }
        float4 w[16];
#pragma unroll
        for (int k = 0; k < 16; ++k) w[k] = *(const float4*)(W + (size_t)(kg * 16 + k) * 3 * DM);
#pragma unroll
        for (int k = 0; k < 16; ++k) {
#pragma unroll
            for (int b = 0; b < BATCH; ++b) { const float s_ = sc[b * DM + kg * 16 + k]; acc[b][0] += s_ * w[k].x; acc[b][1] += s_ * w[k].y; acc[b][2] += s_ * w[k].z; acc[b][3] += s_ * w[k].w; }
        }
#pragma unroll
        for (int b = 0; b < BATCH; ++b) *(LAS f32x4*)(pr + (kg * 8 + b) * 32 + 4 * cq) = (f32x4){acc[b][0], acc[b][1], acc[b][2], acc[b][3]};
        __syncthreads();
        if (tid < 256) {
            const int b = tid >> 5, n = tid & 31; float s_ = 0.f;
#pragma unroll 8
            for (int g2 = 0; g2 < 64; ++g2) s_ += pr[(g2 * 8 + b) * 32 + n];
            __hip_atomic_store(mod + ((size_t)l * BATCH + b) * 3 * DM + n0 + n, s_ + b_mod[l * 3 * DM + n0 + n], __ATOMIC_RELAXED, __HIP_MEMORY_SCOPE_AGENT);
        }
        __syncthreads();
        if (it < 64) {
            asm volatile("s_waitcnt vmcnt(0)" ::: "memory"); __syncthreads();
            if (tid == 0) __hip_atomic_fetch_add(modcnt, 1u, __ATOMIC_RELAXED, __HIP_MEMORY_SCOPE_AGENT);
        }
    }
}

DEV void wfold_prep(bf16_t* WfT, const float* wq, const float* wk, const float* wv, const float* wg  ) {
    const int tid = opaque_tid(), lane = tid & 63;
    for (int t = blockIdx.x * 8 + (tid >> 6); t < 2048; t += gridDim.x * 8) {
        const int which = t >> 10, ch = t & 1023, hd = ch >> 8, d = ch & 255;
        float acc[8];
#pragma unroll
        for (int j = 0; j < 8; ++j) acc[j] = 0.f;
        if (which == 0) {
            const float4 q4 = *(const float4*)(wq + ((size_t)hd * DH + d) * DH + 4 * lane);
            const float4 k4 = *(const float4*)(wk + ((size_t)hd * DH + d) * DH + 4 * lane);
            const float qv[4] = {q4.x, q4.y, q4.z, q4.w}, kv[4] = {k4.x * 0.0625f, k4.y * 0.0625f, k4.z * 0.0625f, k4.w * 0.0625f};
#pragma unroll
            for (int e = 0; e < 4; ++e) {
                const float* g1 = wg + (size_t)(hd * DH + 4 * lane + e) * 8; const float* g2 = wg + (size_t)(DM + hd * DH + 4 * lane + e) * 8;
                const float4 a0 = *(const float4*)g1, a1 = *(const float4*)(g1 + 4), b0 = *(const float4*)g2, b1 = *(const float4*)(g2 + 4);
                acc[0] += qv[e] * a0.x + kv[e] * b0.x; acc[1] += qv[e] * a0.y + kv[e] * b0.y; acc[2] += qv[e] * a0.z + kv[e] * b0.z; acc[3] += qv[e] * a0.w + kv[e] * b0.w;
                acc[4] += qv[e] * a1.x + kv[e] * b1.x; acc[5] += qv[e] * a1.y + kv[e] * b1.y; acc[6] += qv[e] * a1.z + kv[e] * b1.z; acc[7] += qv[e] * a1.w + kv[e] * b1.w;
            }
        } else {
            const float4 v4 = *(const float4*)(wv + ((size_t)hd * DH + d) * DH + 4 * lane);
            const float vv[4] = {v4.x, v4.y, v4.z, v4.w};
#pragma unroll
            for (int e = 0; e < 4; ++e) {
                const float* g1 = wg + (size_t)(2 * DM + hd * DH + 4 * lane + e) * 8;
                const float4 a0 = *(const float4*)g1, a1 = *(const float4*)(g1 + 4);
                acc[0] += vv[e] * a0.x; acc[1] += vv[e] * a0.y; acc[2] += vv[e] * a0.z; acc[3] += vv[e] * a0.w;
                acc[4] += vv[e] * a1.x; acc[5] += vv[e] * a1.y; acc[6] += vv[e] * a1.z; acc[7] += vv[e] * a1.w;
            }
        }
#pragma unroll
        for (int j = 0; j < 8; ++j) acc[j] = wave_sum(acc[j]);
        if (lane < 16) {
            float v = 0.f;
#pragma unroll
            for (int j = 0; j < 8; ++j) v = (lane == j) ? acc[j] : v;
            WfT[((size_t)which * 16 + lane) * 1024 + ch] = f2bf(v);
        }
    }
}
DEV void xc_gates_phase(LAS char* shm, const bf16_t* mi, bf16_t* xc, const bf16_t* WfT, const float* cw, const float* cb, float* gpart  ) {
    const int tid = opaque_tid(), wid = __builtin_amdgcn_readfirstlane(tid >> 6), lane = tid & 63, fr = lane & 15, fq = lane >> 4;
    constexpr int WRS = 2064, WIMG = 8 * WRS, CWL = 2 * WIMG, STG = CWL + 5 * 4096, SRS_ = 528, STG_W = 19 * SRS_;
    __syncthreads();
    for (int i = tid; i < 2 * 8 * 128; i += 512) {
        const int rowi = i >> 7, pc = i & 127;
        const uint4 v = *(const uint4*)(WfT + (size_t)((rowi >> 3) * 16 + (rowi & 7)) * 1024 + pc * 8);
        *(LAS u32x4*)(shm + rowi * WRS + pc * 16) = (u32x4){v.x, v.y, v.z, v.w};
    }
    for (int i = tid; i < 5 * 256; i += 512) {
        const float4 v = (i < 1024) ? *(const float4*)(cw + i * 4) : *(const float4*)(cb + (i - 1024) * 4);
        *(LAS f32x4*)(shm + CWL + i * 16) = (f32x4){v.x, v.y, v.z, v.w};
    }
    __syncthreads();
    LAS char* stg = shm + STG + wid * STG_W;
    for (int task = blockIdx.x * 8 + wid; task < (MTOK / 16) * 2; task += gridDim.x * 8) {
        const int chalf = task & 1, m0 = (task >> 1) * 16, tpos0 = m0 % SEQ;
        f32x4 acc = (f32x4){0.f, 0.f, 0.f, 0.f};
        uint4 pr0[5], pr1[5];
#define XC_LOAD(pr_, sl_) do { _Pragma("unroll") for (int it = 0; it < 5; ++it) { const int i = lane + 64 * it, row = i >> 4, pc = i & 15; pr_[it] = make_uint4(0, 0, 0, 0); \
            if (i < 19 * 16 && tpos0 - 3 + row >= 0) pr_[it] = *(const uint4*)(mi + (size_t)(m0 - 3 + row) * DM + chalf * 512 + (sl_) * 128 + pc * 8); } } while (0)
#define XC_STAGE(pr_) do { _Pragma("unroll") for (int it = 0; it < 5; ++it) { const int i = lane + 64 * it, row = i >> 4, pc = i & 15; \
            if (i < 19 * 16) *(LAS u32x4*)(stg + row * SRS_ + pc * 16) = (u32x4){pr_[it].x, pr_[it].y, pr_[it].z, pr_[it].w}; } } while (0)
        auto compute = [&](int c0) {
#pragma nounroll
            for (int ks = 0; ks < 4; ++ks) {
                const int cl = 32 * ks + 8 * fq, c = c0 + cl;
                float xv[8], t8[8];
                { const f32x4 b0 = *(const LAS f32x4*)(shm + CWL + 16384 + c * 4), b1 = *(const LAS f32x4*)(shm + CWL + 16384 + c * 4 + 16);
                  xv[0] = b0[0]; xv[1] = b0[1]; xv[2] = b0[2]; xv[3] = b0[3]; xv[4] = b1[0]; xv[5] = b1[1]; xv[6] = b1[2]; xv[7] = b1[3]; }
                u32x4 raw3;
#pragma unroll
                for (int tap = 0; tap < 4; ++tap) {
                    const u32x4 rw = *(const LAS u32x4*)(stg + (fr + tap) * SRS_ + cl * 2);
                    if (tap == 3) raw3 = rw;
                    unpack8(make_uint4(rw[0], rw[1], rw[2], rw[3]), t8);
                    const f32x4 w0 = *(const LAS f32x4*)(shm + CWL + tap * 4096 + c * 4), w1 = *(const LAS f32x4*)(shm + CWL + tap * 4096 + c * 4 + 16);
                    xv[0] += t8[0] * w0[0]; xv[1] += t8[1] * w0[1]; xv[2] += t8[2] * w0[2]; xv[3] += t8[3] * w0[3];
                    xv[4] += t8[4] * w1[0]; xv[5] += t8[5] * w1[1]; xv[6] += t8[6] * w1[2]; xv[7] += t8[7] * w1[3];
                }
#pragma unroll
                for (int e = 0; e < 8; ++e) xv[e] = siluf_(xv[e]);
                const uint4 xp = pack8(xv);
                *(uint4*)(xc + (size_t)(m0 + fr) * DM + c) = xp;
                const u32x4 xpu = (u32x4){xp.x, xp.y, xp.z, xp.w};
                const bf16x8 bx = *(const LAS bf16x8*)(shm + (fr & 7) * WRS + c * 2);
                const bf16x8 bv = *(const LAS bf16x8*)(shm + WIMG + (fr & 7) * WRS + c * 2);
                acc = __builtin_amdgcn_mfma_f32_16x16x32_bf16(*(const bf16x8*)&xpu, bx, acc, 0, 0, 0);
                acc = __builtin_amdgcn_mfma_f32_16x16x32_bf16(*(const bf16x8*)&raw3, bv, acc, 0, 0, 0);
            }
        };
        XC_LOAD(pr0, 0); XC_LOAD(pr1, 1);
#pragma nounroll
        for (int sp = 0; sp < 2; ++sp) {
            XC_STAGE(pr0); if (sp == 0) XC_LOAD(pr0, 2);
            compute(chalf * 512 + (2 * sp) * 128);
            XC_STAGE(pr1); if (sp == 0) XC_LOAD(pr1, 3);
            compute(chalf * 512 + (2 * sp + 1) * 128);
        }
#undef XC_LOAD
#undef XC_STAGE
        if (fr < 8) {
#pragma unroll
            for (int r = 0; r < 4; ++r) gpart[((size_t)chalf * MTOK + m0 + 4 * fq + r) * 8 + fr] = acc[r];
        }
    }
}

#define XB_TMO      128
#define XB_XCNT(j)  (256  + 64 * (j))
#define XB_XSUB(j)  (1280 + 64 * (j))
#define XB_XGEN(j)  (2304 + 64 * (j))
#define XB_TOP      3328
#define XB_TOPGEN   3392
#define XCD_BAR_WORDS 3456
#define XB_SPIN_CAP (1u << 18)
DEV unsigned xb_ld(unsigned* p) { return __hip_atomic_load(p, __ATOMIC_RELAXED, __HIP_MEMORY_SCOPE_AGENT); }
DEV unsigned xb_add(unsigned* p, unsigned v) { return __hip_atomic_fetch_add(p, v, __ATOMIC_RELAXED, __HIP_MEMORY_SCOPE_AGENT); }
DEV unsigned xb_xcc_id() { return (unsigned)__builtin_amdgcn_s_getreg((3 << 11) | 20) & 0xFu; }
#define XB_SPIN(cond, bar) do { unsigned _sp = 0; while (cond) { __builtin_amdgcn_s_sleep(1); \
    if ((++_sp & 255u) == 0u) { if (xb_ld(&(bar)[XB_TMO])) break; if (_sp > XB_SPIN_CAP) { atomicAdd(&(bar)[XB_TMO], 1u); break; } } } } while (0)
struct XcdBarrier { unsigned* bar; unsigned x; volatile LAS unsigned* st; };
DEV XcdBarrier xcd_barrier_post(unsigned* bar, volatile LAS unsigned* st) {
    XcdBarrier b; b.bar = bar; b.x = xb_xcc_id(); b.st = st;
    if (threadIdx.x == 0) (void)xb_add(&bar[XB_XCNT(b.x)], 1u);
    return b;
}
DEV void xcd_barrier_complete(unsigned* bar, unsigned x, unsigned& nloc, unsigned& nx) {
    const unsigned G = gridDim.x * gridDim.y * gridDim.z;
    unsigned sum, cnt, mine, sp = 0u;
    for (;;) {
        sum = 0u; cnt = 0u; mine = 0u;
#pragma nounroll
        for (unsigned h = 0; h < 2; ++h) {
            unsigned cv[8];
#pragma unroll
            for (unsigned j = 0; j < 8; ++j) cv[j] = xb_ld(&bar[XB_XCNT(8u * h + j)]);
#pragma unroll
            for (unsigned j = 0; j < 8; ++j) { sum += cv[j]; cnt += (cv[j] > 0u) ? 1u : 0u; if (8u * h + j == x) mine = cv[j]; }
        }
        if (sum == G) break;
        __builtin_amdgcn_s_sleep(1);
        if ((++sp & 255u) == 0u) { if (xb_ld(&bar[XB_TMO])) break; if (sp > XB_SPIN_CAP) { atomicAdd(&bar[XB_TMO], 1u); break; } }
    }
    nloc = mine > 0u ? mine : 1u; nx = cnt > 0u ? cnt : 1u;
}
DEV void xcd_barrier1(const XcdBarrier& b) {
    asm volatile("s_waitcnt vmcnt(0)" ::: "memory");
    __syncthreads();
    const int tid_ = opaque_tid();
    if (tid_ == 64) asm volatile("buffer_inv sc1\n\ts_waitcnt vmcnt(0)" ::: "memory");
    if (tid_ == 0) {
        unsigned* bar = b.bar;
        __builtin_amdgcn_s_waitcnt(0);
        unsigned nloc = b.st[0], nx = b.st[1];
        if (nloc == 0u) { xcd_barrier_complete(bar, b.x, nloc, nx); b.st[0] = nloc; b.st[1] = nx; }
        const unsigned old = xb_add(&bar[XB_XSUB(b.x)], 1u);
        const unsigned gen = old / nloc;
        if (old + 1u == (gen + 1u) * nloc) {
            __builtin_amdgcn_fence(__ATOMIC_RELEASE, "agent");
            asm volatile("s_waitcnt vmcnt(0)" ::: "memory");
            const unsigned og = xb_add(&bar[XB_TOP], 1u);
            const unsigned tg = og / nx;
            if (og + 1u == (tg + 1u) * nx) xb_add(&bar[XB_TOPGEN], 1u);
            else XB_SPIN(xb_ld(&bar[XB_TOPGEN]) <= tg, bar);
            xb_add(&bar[XB_XGEN(b.x)], 1u);
            asm volatile("s_waitcnt vmcnt(0)" ::: "memory");
        } else {
            XB_SPIN(xb_ld(&bar[XB_XGEN(b.x)]) <= gen, bar);
            asm volatile("s_waitcnt vmcnt(0)" ::: "memory");
        }
    }
    __syncthreads();
}

DEV void xcd_barrier(const XcdBarrier& b) { xcd_barrier1(b); if (REPMASK & 2048) xcd_barrier1(b); }
DEV void xcd_barrier_arrive(const XcdBarrier& b) {
    asm volatile("s_waitcnt vmcnt(0)" ::: "memory");
    __syncthreads();
    const int tid_ = opaque_tid();
    if (tid_ == 0) {
        unsigned* bar = b.bar;
        __builtin_amdgcn_s_waitcnt(0);
        unsigned nloc = b.st[0], nx = b.st[1];
        if (nloc == 0u) { xcd_barrier_complete(bar, b.x, nloc, nx); b.st[0] = nloc; b.st[1] = nx; }
        const unsigned old = xb_add(&bar[XB_XSUB(b.x)], 1u);
        const unsigned gen = old / nloc;
        unsigned mode = 1u, val = gen;
        if (old + 1u == (gen + 1u) * nloc) {
            __builtin_amdgcn_fence(__ATOMIC_RELEASE, "agent");
            asm volatile("s_waitcnt vmcnt(0)" ::: "memory");
            const unsigned og = xb_add(&bar[XB_TOP], 1u);
            const unsigned tg = og / nx;
            if (og + 1u == (tg + 1u) * nx) { xb_add(&bar[XB_TOPGEN], 1u); xb_add(&bar[XB_XGEN(b.x)], 1u); mode = 3u; }
            else { mode = 2u; val = tg; }
            asm volatile("s_waitcnt vmcnt(0)" ::: "memory");
        }
        b.st[3] = val; b.st[2] = mode;
    }
}
constexpr int LDS_BYTES = 148 * 1024;
DEV const void* ldptr(LAS char* shm, int i) {
    volatile LAS unsigned* pt = (volatile LAS unsigned*)(shm + LDS_BYTES - 512);
    const unsigned lo = __builtin_amdgcn_readfirstlane(pt[2 * i]), hi = __builtin_amdgcn_readfirstlane(pt[2 * i + 1]);
    return (const void*)(const __attribute__((address_space(1))) void*)(((unsigned long long)hi << 32) | lo);
}
#define PF(i) ((const float*)ldptr(shm, (i)))
struct Params {
    const float *x, *c, *norm_gain, *w_mod, *b_mod, *w_in, *lam_re, *lam_im, *log_dt, *sb_re, *sb_im, *sc_re, *sc_im, *ssm_d, *w_glu, *b_glu, *ssm_og,
        *conv_w, *conv_b, *wq, *wk, *wv, *w_gates, *b_ig, *b_fg, *m_ng, *m_skip, *w_out, *final_gain;
    float* out; char* ws;
};
constexpr size_t SLOT = (size_t)MTOK * DM * 2;
constexpr size_t SLOTS = SLOT + 73728;
constexpr size_t W_IN_OFF = 0, W_GLU_OFF = 10485760, W_QKV_OFF = 12582912, W_OUT_OFF = 14155776, MOD_OFF = 20u << 20, IPRE_OFF = 21u << 20, LOGF_OFF = 22u << 20, BAR_OFF = 23u << 20, WF_OFF = 19u << 20, ROWSS_OFF = 24u << 20, RSTD_OFF = 25u << 20, XSS_OFF = 26u << 20;
#define REP(bit) _Pragma("nounroll") for (int rep_ = 0; rep_ < (((REPMASK) & (bit)) ? 2 : 1); ++rep_)

#define WSB ((char*)ldptr(shm, 30))
#define SL(i) ((bf16_t*)(WSB + SLOTS * (i)))
#define S7(off) (WSB + SLOTS * 7 + (off))
#define WinT ((bf16_t*)S7(W_IN_OFF))
#define WgluT ((bf16_t*)S7(W_GLU_OFF))
#define WqkvT ((bf16_t*)S7(W_QKV_OFF))
#define WoutT ((bf16_t*)S7(W_OUT_OFF))
#define mod ((float*)S7(MOD_OFF))
#define gpart ((float*)S7(IPRE_OFF))
#define WfT ((bf16_t*)S7(WF_OFF))
#define rowss ((float*)S7(ROWSS_OFF))
#define rstdv ((float*)S7(RSTD_OFF))
#define xssv ((float*)S7(XSS_OFF))
#define MX SL(1)
#define OUTP ((float*)ldptr(shm, 29))
#define H SL(0)
#define U SL(1)
#define Y SL(2)
#define Z SL(3)
#define XC SL(4)
#define MI SL(5)
#define Q SL(6)
#define Kb SL(1)
#define V SL(5)
#define HC SL(2)
template <int l, int LO, int HI, int FL>
DEV void prep_range(LAS char* shm) {
    const int wave = opaque_tid() >> 6, lane = opaque_tid() & 63;
    __syncthreads();
    if (HI > LO) {
        LAS float* scr = (LAS float*)(shm + wave * 16640);
        const int wv_ = (wave - ((FL >> 5) & 7)) & 7;
        const float* Win = PF(5) + (size_t)l * DM * INC;
        constexpr int I_IN = 16 * 80, I_GLU = 16 * 16, I_QKV = 12 * 16, I_OUT = 32 * 16;
        constexpr int REV = (FL & 4) ? 1 : 0;
        for (int rnd = 0; ; ++rnd) {
            const int bb_ = ((rnd & 1) ^ REV) ? (int)(gridDim.x - 1 - blockIdx.x) : (int)blockIdx.x;
            constexpr bool WM = (HI - LO) <= 1024;
            const int nper = (HI - LO + (int)gridDim.x - 1) / (int)gridDim.x;
            const int it = (FL & 512) ? ((wave < nper) ? LO + bb_ * nper + wave : HI) : WM ? LO + (rnd * 8 + wv_) * (int)gridDim.x + bb_ : LO + (rnd * (int)gridDim.x + bb_) * 8 + wave;
            if (LO + rnd * (int)gridDim.x * 8 >= HI) break;
            if (it >= HI) continue;
            int r = it;
            if (r < I_IN) { transpose_item(Win, INC, INC, WinT, DM, scr, r, lane); continue; } r -= I_IN;
            if (r < I_GLU) { transpose_item(PF(14) + (size_t)l * DM * DM, DM, DM, WgluT, DM, scr, r, lane); continue; } r -= I_GLU;
            if (r < I_QKV) { const int mat = r / 16, which = mat >> 2, hd = mat & 3;
                const float* W = sel3(which, PF(19), PF(20), PF(21)) + ((size_t)l * NH + hd) * DH * DH;
                transpose_item(W, DH, DH, WqkvT + (size_t)mat * DH * DH, DH, scr, r % 16, lane); continue; } r -= I_QKV;
            transpose_item(PF(27) + (size_t)l * 2 * DM * DM, DM, DM, WoutT, 2 * DM, scr, r, lane);
        }
    }
    if (FL & 1) wfold_prep(WfT, PF(19) + (size_t)l * NH * DH * DH, PF(20) + (size_t)l * NH * DH * DH, PF(21) + (size_t)l * NH * DH * DH, PF(22) + (size_t)l * 3 * DM * 8);
    if (FL & 2) {
        __syncthreads();
        s5_tables(shm, (char*)SL(l == 0 ? 3 : 6), PF(6) + l * NG * NP, PF(7) + l * NG * NP, PF(8) + l * NG, PF(9) + (size_t)l * NG * NP * GC, PF(10) + (size_t)l * NG * NP * GC,
                  PF(11) + (size_t)l * NG * GC * NP, PF(12) + (size_t)l * NG * GC * NP);
    }
    __syncthreads();
}
DEV void xcd_wait_lds(LAS char* lds) {
    volatile LAS unsigned* st = (volatile LAS unsigned*)(lds + LDS_BYTES - 16);
    const int tid_ = opaque_tid();
    if (tid_ == 64) asm volatile("buffer_inv sc1\n\ts_waitcnt vmcnt(0)" ::: "memory");
    if (tid_ == 0) {
        unsigned* bar = (unsigned*)((char*)ldptr(lds, 30) + SLOTS * 7 + BAR_OFF);
        const unsigned x = xb_xcc_id();
        const unsigned mode = st[2], val = st[3];
        if (mode != 3u) XB_SPIN(xb_ld(&bar[XB_TOPGEN]) <= val, bar);
        if (mode == 2u) xb_add(&bar[XB_XGEN(x)], 1u);
        asm volatile("s_waitcnt vmcnt(0)" ::: "memory");
    }
    asm volatile("s_waitcnt lgkmcnt(0)\n\ts_barrier" ::: "memory");
    if (tid_ == 0) st[2] = 0u;
}
template <int l>
DEV void layer_body(LAS char* shm, const XcdBarrier& gbar) {
        const float* xin = (l == 0) ? PF(0) : OUTP;
        const float* modl = mod + (size_t)l * BATCH * 3 * DM;
        if (l == 0) { REP(1) norm_rows(xin, PF(2) + l * DM, modl, H); xcd_barrier_arrive(gbar); prep_range<0, 0, 0, 3>(shm); xcd_wait_lds(shm); }
        REP(2) { g8::SchedG1 S_{H, WinT, (int)blockIdx.x, (int)gridDim.x}; g8::EpiG1 E_{U, MI}; g8::gemm_phase(shm, S_, E_); }
        xcd_barrier_arrive(gbar); prep_range<l, 1280, 1728, (1 << 5)>(shm); xcd_wait_lds(shm);
        REP(256) s5_phase(shm, U, Y, (const char*)SL(l == 0 ? 3 : 6), PF(13) + l * DM);
        REP(8) xc_gates_phase(shm, MI, XC, WfT, PF(17) + l * 4 * DM, PF(18) + l * DM, gpart);
        xcd_barrier_arrive(gbar); prep_range<l, 1728, 2240, (1 << 5)>(shm); xcd_wait_lds(shm);
        unsigned* gcnt = (unsigned*)S7(BAR_OFF) + 12288 + l * 2048; float* gxss = xssv + (size_t)(2 + l) * MTOK * 4;
        REP(4) { g8::SchedGlu S_{Y, WgluT, (int)blockIdx.x, (int)gridDim.x}; g8::EpiGlu E_{Y, Z, PF(15) + l * DM, gxss, gcnt}; g8::gemm_phase(shm, S_, E_); }
        { g8::SchedG2s S_{H, WinT, (int)blockIdx.x}; g8::EpiG2s E_{Z, gxss, gcnt, PF(16) + l * DM, (unsigned*)S7(BAR_OFF) + XB_TMO}; g8::gemm_phase(shm, S_, E_); }
        REP(16) { g8::SchedQkv S_{XC, MI, WqkvT, (int)blockIdx.x, (int)gridDim.x}; g8::EpiQkv E_{Q, Kb, V}; g8::gemm_phase(shm, S_, E_); }
        xcd_barrier_arrive(gbar);
        if ((int)blockIdx.x < BATCH * NH * 8) mlstm_gate_scans(shm, gpart, PF(23) + l * 4, PF(24) + l * 4, (int)blockIdx.x);
        xcd_wait_lds(shm);
        REP(32) mlstm_phase<0>(shm, Q, Kb, V, gpart, PF(23) + l * 4, PF(24) + l * 4, HC, true);
        xcd_barrier_arrive(gbar);
        { g8::SchedG2m S_{H, WinT, (int)blockIdx.x, (int)gridDim.x};
          g8::EpiG2m E_{HC, XC, PF(25) + l * DM, PF(26) + l * DM, (float*)S7(XSS_OFF + (1u << 20)) + (size_t)l * MTOK * 16, (unsigned*)S7(BAR_OFF) + 16384 + l * 8192, (unsigned*)S7(BAR_OFF) + XB_TMO}; g8::gemm_phase(shm, S_, E_); }
        if (l == 0) { xcd_barrier_arrive(gbar); prep_range<1, 0, 0, 1>(shm); xcd_wait_lds(shm); }
        else xcd_barrier(gbar);
        if (l == 0) { g8::SchedOut S_{Z, HC, WoutT, (int)blockIdx.x, (int)gridDim.x};
            g8::EpiOutN<false> E_{xin, OUTP, modl + 2 * DM, PF(2) + DM, mod + (size_t)BATCH * 3 * DM, H, xssv, (unsigned*)S7(BAR_OFF) + 4096, (unsigned*)S7(BAR_OFF) + XB_TMO}; g8::gemm_phase(shm, S_, E_);
            prep_range<1, 0, 1280, 512>(shm); }
        else { g8::SchedOut S_{Z, HC, WoutT, (int)blockIdx.x, (int)gridDim.x};
            g8::EpiOutN<true> E_{xin, OUTP, modl + 2 * DM, PF(28), mod, H, xssv + (size_t)MTOK * 4, (unsigned*)S7(BAR_OFF) + 4096 + 4096, (unsigned*)S7(BAR_OFF) + XB_TMO}; g8::gemm_phase(shm, S_, E_); }
        if (l == 0) { xcd_barrier_arrive(gbar); prep_range<1, 0, 0, 2>(shm); xcd_wait_lds(shm); }
    }
__global__ void __launch_bounds__(512, 2) mega(Params Pk) {
    extern __shared__ __attribute__((aligned(16))) unsigned char lds_raw[];
    {
        volatile LAS unsigned long long* pt = (volatile LAS unsigned long long*)((LAS char*)lds_raw + LDS_BYTES - 512);
        if (threadIdx.x == 0) {
            pt[0] = (unsigned long long)Pk.x;
            pt[1] = (unsigned long long)Pk.c;
            pt[2] = (unsigned long long)Pk.norm_gain;
            pt[3] = (unsigned long long)Pk.w_mod;
            pt[4] = (unsigned long long)Pk.b_mod;
            pt[5] = (unsigned long long)Pk.w_in;
            pt[6] = (unsigned long long)Pk.lam_re;
            pt[7] = (unsigned long long)Pk.lam_im;
            pt[8] = (unsigned long long)Pk.log_dt;
            pt[9] = (unsigned long long)Pk.sb_re;
            pt[10] = (unsigned long long)Pk.sb_im;
            pt[11] = (unsigned long long)Pk.sc_re;
            pt[12] = (unsigned long long)Pk.sc_im;
            pt[13] = (unsigned long long)Pk.ssm_d;
            pt[14] = (unsigned long long)Pk.w_glu;
            pt[15] = (unsigned long long)Pk.b_glu;
            pt[16] = (unsigned long long)Pk.ssm_og;
            pt[17] = (unsigned long long)Pk.conv_w;
            pt[18] = (unsigned long long)Pk.conv_b;
            pt[19] = (unsigned long long)Pk.wq;
            pt[20] = (unsigned long long)Pk.wk;
            pt[21] = (unsigned long long)Pk.wv;
            pt[22] = (unsigned long long)Pk.w_gates;
            pt[23] = (unsigned long long)Pk.b_ig;
            pt[24] = (unsigned long long)Pk.b_fg;
            pt[25] = (unsigned long long)Pk.m_ng;
            pt[26] = (unsigned long long)Pk.m_skip;
            pt[27] = (unsigned long long)Pk.w_out;
            pt[28] = (unsigned long long)Pk.final_gain;
            pt[29] = (unsigned long long)Pk.out; pt[30] = (unsigned long long)Pk.ws;
        }
    }
    __syncthreads();
    LAS char* shm = (LAS char*)lds_raw;
    volatile LAS unsigned* bst = (volatile LAS unsigned*)(shm + LDS_BYTES - 16);
    if (threadIdx.x < 4) bst[threadIdx.x] = 0u;
    __syncthreads();
    const XcdBarrier gbar = xcd_barrier_post((unsigned*)((char*)ldptr(shm, 30) + SLOTS * 7 + BAR_OFF), bst);
    REP(4096) mod_phase(shm, PF(1), PF(3), PF(4), mod, (unsigned*)S7(BAR_OFF) + 3584);
    prep_range<0, 0, 1280, 4>(shm);
    {
        if (threadIdx.x == 0) { unsigned* mc = (unsigned*)S7(BAR_OFF) + 3584; unsigned sp_ = 0;
            while (__hip_atomic_load(mc, __ATOMIC_RELAXED, __HIP_MEMORY_SCOPE_AGENT) < 64u) { __builtin_amdgcn_s_sleep(1); if (++sp_ > (1u << 22)) { atomicAdd((unsigned*)S7(BAR_OFF) + XB_TMO, 1u); break; } }
            __builtin_amdgcn_fence(__ATOMIC_ACQUIRE, "agent"); asm volatile("s_waitcnt vmcnt(0)" ::: "memory"); }
        __syncthreads();
    }
    layer_body<0>(shm, gbar);
    layer_body<1>(shm, gbar);
}

#undef WSB
#undef SL
#undef S7
#undef WinT
#undef WgluT
#undef WqkvT
#undef WoutT
#undef mod
#undef gpart
#undef WfT
#undef rowss
#undef rstdv
#undef xssv
#undef MX
#undef OUTP
#undef H
#undef U
#undef Y
#undef Z
#undef XC
#undef MI
#undef Q
#undef Kb
#undef V
#undef HC
extern "C" void kernel_launch(void* const* d_in, const int* in_sizes, int n_in, void* d_out, int out_size, void* d_ws, size_t ws_size, hipStream_t stream) {
    static int grid_blocks = 0;
    if (!grid_blocks) {
        int dev = 0, cus = 0, per_cu = 0;
        (void)hipGetDevice(&dev);
        (void)hipDeviceGetAttribute(&cus, hipDeviceAttributeMultiprocessorCount, dev);
        (void)hipFuncSetAttribute((const void*)mega, hipFuncAttributeMaxDynamicSharedMemorySize, LDS_BYTES);
        (void)hipOccupancyMaxActiveBlocksPerMultiprocessor(&per_cu, (const void*)mega, 512, LDS_BYTES);
        grid_blocks = cus;
        fprintf(stderr, "mega: cus=%d occupancy per_cu=%d grid=%d\n", cus, per_cu, grid_blocks);
    }
    (void)hipMemsetAsync((char*)d_ws + SLOTS * 7 + BAR_OFF, 0, 131072, stream);
    Params P{};
    const float** pp = (const float**)&P;
    for (int i = 0; i < 29; ++i) pp[i] = (const float*)d_in[i];
    P.out = (float*)d_out; P.ws = (char*)d_ws;
    void* args[] = {&P};
    hipError_t e = hipLaunchCooperativeKernel((const void*)mega, dim3(grid_blocks), dim3(512), args, LDS_BYTES, stream);
    if (e != hipSuccess) fprintf(stderr, "cooperative launch failed: %s (grid %d)\n", hipGetErrorString(e), grid_blocks);
}
```
